# Optimizing an MI355X kernel written in HIP

```python
import jax, jax.numpy as jnp
from jax import lax
import numpy as np

D_MODEL = 1024
BATCH = 8
SEQ = 4096
DEPTH = 4

GRID_W = 64
CTX_LEN = 256
N_MIXERS = 3
D_FF = 2816
N_MOD = 9
ALPHA = (2 * DEPTH) ** 0.25
BETA = (8 * DEPTH) ** -0.25
LN_EPS = 1e-5

ML_INNER = 2 * D_MODEL
ML_HEADS = 4
ML_HEAD_DIM = ML_INNER // ML_HEADS
ML_QKV_BLOCK = 4
ML_CHUNK = 64
ML_CONV = 3

AT_HEADS = 16
AT_KV_HEADS = 4
AT_HEAD_DIM = 64
AT_WINDOW = 128
AT_BLOCK = 128
AT_SIDE_BLOCKS = -(-AT_WINDOW // AT_BLOCK)
ROPE_BASE = 10000.0

SC_WIDTH = 3

N_A = (DEPTH + 2) // N_MIXERS
N_B = (DEPTH + 1) // N_MIXERS
N_C = DEPTH // N_MIXERS

kernel_name = 'hybrid_mlstm_swa_shortconv_flow_backbone'


def layer_norm(x, g, b):
    xf = x.astype(jnp.float32)
    mu = xf.mean(-1, keepdims=True)
    var = jnp.mean(jnp.square(xf - mu), -1, keepdims=True)
    return ((xf - mu) * lax.rsqrt(var + LN_EPS) * g.astype(jnp.float32) + b.astype(jnp.float32)).astype(x.dtype)


def modulate(s, m, slot):
    return s * (1 + m[..., 3 * slot + 1, :]) + m[..., 3 * slot, :]


def gate_of(m, slot):
    return m[..., 3 * slot + 2, :]


def residual_post_norm(s, y, gate, weight, g, b):
    return layer_norm(ALPHA * s + weight * gate * y, g, b)


def swiglu(u, w_in, w_out):
    g, v = jnp.split(u @ w_in, 2, axis=-1)
    return (jax.nn.silu(g) * v) @ w_out


def dwconv_centred(u, w):
    K, C = w.shape
    return lax.conv_general_dilated(u, w[:, None, :], window_strides=(1,), padding=[(K // 2, K // 2)],
                                    dimension_numbers=('NWC', 'WIO', 'NWC'), feature_group_count=C)


def blockdiag(u, w):
    nblk, bs, _ = w.shape
    return jnp.einsum('blnc,ncd->blnd', u.reshape(u.shape[:2] + (nblk, bs)), w).reshape(u.shape)


def axial_rope(n_tokens, head_dim):
    rows_n = n_tokens // GRID_W
    rows = jnp.repeat(jnp.arange(rows_n), GRID_W).astype(jnp.float32)
    cols = jnp.tile(jnp.arange(GRID_W), rows_n).astype(jnp.float32)
    axis_dim = head_dim // 2
    freqs = ROPE_BASE ** (-jnp.arange(0, axis_dim, 2, dtype=jnp.float32) / axis_dim)
    ang = jnp.concatenate([rows[:, None] * freqs, cols[:, None] * freqs], axis=-1)
    return jnp.cos(ang), jnp.sin(ang)


def apply_rope(x, cos, sin):
    xf = x.astype(jnp.float32).reshape(x.shape[:-1] + (-1, 2))
    x1, x2 = xf[..., 0], xf[..., 1]
    return jnp.stack([x1 * cos - x2 * sin, x1 * sin + x2 * cos], axis=-1).reshape(x.shape).astype(x.dtype)


def sink_attend(q, k, v, mask, sink):
    G, R = q.shape[2], q.shape[3]
    s = jnp.einsum('bqgrd,bkgd->bgrqk', q, k).astype(jnp.float32)
    if mask is not None:
        s = jnp.where(mask, s, -jnp.inf)
    sk = sink.astype(jnp.float32).reshape(1, G, R, 1, 1)
    mx = jnp.maximum(s.max(-1, keepdims=True), sk)
    p = jnp.exp(s - mx)
    den = p.sum(-1, keepdims=True) + jnp.exp(sk - mx)
    return jnp.einsum('bgrqk,bkgd->bqgrd', (p / den).astype(v.dtype), v)


def window_attention(ul, uc, w_qkv, sink, w_o, ctx_out):
    B, S, _ = ul.shape
    Lc = uc.shape[1]
    H, G, d = AT_HEADS, AT_KV_HEADS, AT_HEAD_DIM
    R = H // G
    P = AT_SIDE_BLOCKS * AT_BLOCK
    nb = S // AT_BLOCK
    KW = (2 * AT_SIDE_BLOCKS + 1) * AT_BLOCK

    def proj(u):
        L = u.shape[1]
        q, k, v = jnp.split(u @ w_qkv, [H * d, (H + G) * d], axis=-1)
        return q.reshape(B, L, G, R, d) * d ** -0.5, k.reshape(B, L, G, d), v.reshape(B, L, G, d)

    ql, kl, vl = proj(ul)
    qc, kc, vc = proj(uc)
    cos, sin = axial_rope(S, d)
    ql = apply_rope(ql, cos[:, None, None], sin[:, None, None])
    kl = apply_rope(kl, cos[:, None], sin[:, None])

    def band(a):
        ab = jnp.pad(a, ((0, 0), (P, P), (0, 0), (0, 0))).reshape(B, nb + 2 * AT_SIDE_BLOCKS, AT_BLOCK, G, d)
        win = jnp.concatenate([ab[:, o:o + nb] for o in range(2 * AT_SIDE_BLOCKS + 1)], axis=2)
        return jnp.moveaxis(win, 1, 0)

    qb = jnp.moveaxis(ql.reshape(B, nb, AT_BLOCK, G, R, d), 1, 0)
    q_pos = jnp.arange(nb)[:, None] * AT_BLOCK + jnp.arange(AT_BLOCK)
    k_pos = jnp.arange(nb)[:, None] * AT_BLOCK - P + jnp.arange(KW)
    valid = ((jnp.abs(q_pos[:, :, None] - k_pos[:, None, :]) <= AT_WINDOW)
             & (k_pos >= 0)[:, None, :] & (k_pos < S)[:, None, :])
    mask = jnp.concatenate([valid, jnp.ones((nb, AT_BLOCK, Lc), dtype=bool)], axis=-1)

    def attend_block(args):
        q, kw, vw, m = args
        return sink_attend(q, jnp.concatenate([kw, kc], axis=1), jnp.concatenate([vw, vc], axis=1), m, sink)

    ol = lax.map(attend_block, (qb, band(kl), band(vl), mask))
    yl = jnp.moveaxis(ol, 0, 1).reshape(B, S, H * d) @ w_o
    yc = sink_attend(qc, kc, vc, None, sink).reshape(B, Lc, H * d) @ w_o if ctx_out else None
    return yl, yc


def mlstm_chunked(q, k, v, ig, fg, state):
    B, H, L, dh = q.shape
    T = ML_CHUNK
    nc = L // T
    k = k * dh ** -0.5
    chunk = lambda a: jnp.moveaxis(a.reshape((B, H, nc, T) + a.shape[3:]), 2, 0)
    logf = jax.nn.log_sigmoid(fg)
    causal = jnp.tril(jnp.ones((T, T), dtype=bool))

    def step(carry, inp):
        C, n, m = carry
        qc, kc, vc, ic, lf = inp
        b = jnp.cumsum(lf, axis=-1)
        g = b[..., -1]
        d_intra = jnp.where(causal, b[..., :, None] - b[..., None, :] + ic[..., None, :], -jnp.inf)
        d_inter = b + m[..., None]
        m_t = jnp.maximum(d_inter, d_intra.max(-1))
        w_intra = jnp.einsum('bhtd,bhsd->bhts', qc, kc) * jnp.exp(d_intra - m_t[..., None])
        w_inter = jnp.exp(d_inter - m_t)
        num = jnp.einsum('bhts,bhse->bhte', w_intra, vc) + w_inter[..., None] * jnp.einsum('bhtd,bhde->bhte', qc, C)
        den = w_intra.sum(-1) + w_inter * jnp.einsum('bhtd,bhd->bht', qc, n)
        h = num / jnp.maximum(jnp.abs(den), jnp.exp(-m_t))[..., None]
        a = g[..., None] - b + ic
        m_new = jnp.maximum(g + m, a.max(-1))
        w_s = jnp.exp(a - m_new[..., None])
        decay = jnp.exp(g + m - m_new)
        C = decay[..., None, None] * C + jnp.einsum('bhsd,bhse->bhde', kc * w_s[..., None], vc)
        n = decay[..., None] * n + jnp.einsum('bhs,bhsd->bhd', w_s, kc)
        return (C, n, m_new), h

    state, hs = lax.scan(step, state, (chunk(q), chunk(k), chunk(v), chunk(ig), chunk(logf)))
    return state, jnp.moveaxis(hs, 0, 2).reshape(B, H, L, dh)


def mlstm_mixer(ul, uc, w_up, conv_w, conv_b, w_qkv, w_if, b_if, skip, norm_g, w_down, ctx_out):
    E, H, dh = ML_INNER, ML_HEADS, ML_HEAD_DIM
    B = ul.shape[0]

    def prep(u):
        L = u.shape[1]
        xm, z = jnp.split(u @ w_up, 2, axis=-1)
        xc = jax.nn.silu(dwconv_centred(xm, conv_w) + conv_b)
        q, k, v = blockdiag(xc, w_qkv[0]), blockdiag(xc, w_qkv[1]), blockdiag(xm, w_qkv[2])
        gates = (jnp.einsum('ble,xeg->xbgl', q, w_if[:, :E]) + jnp.einsum('ble,xeg->xbgl', k, w_if[:, E:2 * E])
                 + jnp.einsum('ble,xeg->xbgl', v, w_if[:, 2 * E:])).astype(jnp.float32) \
            + b_if.astype(jnp.float32)[:, None, :, None]
        heads = lambda a: a.reshape(B, L, H, dh).transpose(0, 2, 1, 3).astype(jnp.float32)
        return xc, z, heads(q), heads(k), heads(v), gates

    p_c, p_l = prep(uc), prep(ul)
    zero = (jnp.zeros((B, H, dh, dh), jnp.float32), jnp.zeros((B, H, dh), jnp.float32), jnp.zeros((B, H), jnp.float32))

    def scan_dir(p, direction, state):
        q, k, v, gates = p[2:]
        ig, fg = gates[direction, :, :H], gates[direction, :, H:]
        if direction == 1:
            q, k, v, ig, fg = [jnp.flip(a, axis=2) for a in (q, k, v, ig, fg)]
        state, h = mlstm_chunked(q, k, v, ig, fg, state)
        return state, (jnp.flip(h, axis=2) if direction == 1 else h)

    st_f, hc_f = scan_dir(p_c, 0, zero)
    st_b, hc_b = scan_dir(p_c, 1, zero)
    _, hl_f = scan_dir(p_l, 0, st_f)
    _, hl_b = scan_dir(p_l, 1, st_b)

    def finish(p, h):
        xc, z = p[0], p[1]
        L = xc.shape[1]
        h = jax.nn.sigmoid(z.astype(jnp.float32)).reshape(B, L, H, dh) * h.transpose(0, 2, 1, 3)
        mu = h.mean(-1, keepdims=True)
        var = jnp.mean(jnp.square(h - mu), -1, keepdims=True)
        h = ((h - mu) * lax.rsqrt(var + LN_EPS) * norm_g.astype(jnp.float32).reshape(H, dh)).reshape(B, L, E)
        return (h.astype(xc.dtype) + skip * xc) @ w_down

    return finish(p_l, hl_f + hl_b), (finish(p_c, hc_f + hc_b) if ctx_out else None)


def short_conv_mixer(u, w_in, conv_w, w_out):
    bg, cg, xt = jnp.split(u @ w_in, 3, axis=-1)
    return (bg * dwconv_centred(cg * xt, conv_w)) @ w_out


def setup_inputs(seed: int = 0) -> dict:
    key = jax.random.key(seed)
    ks = jax.random.split(key, 26)
    f32 = jnp.float32
    nrm = lambda k, shape, s: jax.random.normal(k, shape, f32) * s
    D, E, H, F = D_MODEL, ML_INNER, ML_HEADS, D_FF
    at_cols = (AT_HEADS + 2 * AT_KV_HEADS) * AT_HEAD_DIM
    ml_b_if = jnp.concatenate([nrm(ks[15], (N_A, 2, H), 0.1),
                               jnp.linspace(3.0, 6.0, H, dtype=f32) + nrm(ks[16], (N_A, 2, H), 0.1)], axis=-1)
    return {
        'x': nrm(ks[0], (BATCH, SEQ, D), 1.0),
        'c': nrm(ks[1], (BATCH, D), 1.0),
        'ctx': nrm(ks[2], (BATCH, CTX_LEN, D), 1.0),
        'c_ctx': nrm(ks[3], (D,), 1.0),
        'mod_w': nrm(ks[4], (DEPTH, D, N_MOD * D), 0.5 * D ** -0.5),
        'mod_b': nrm(ks[5], (DEPTH, N_MOD * D), 0.02),
        'ln_g': 1.0 + nrm(ks[6], (DEPTH, 3, D), 0.02),
        'ln_b': nrm(ks[7], (DEPTH, 3, D), 0.02),
        'ffn_w_in': nrm(ks[8], (DEPTH, 2, D, 2 * F), D ** -0.5),
        'ffn_w_out': nrm(ks[9], (DEPTH, 2, F, D), BETA * F ** -0.5),
        'ml_w_up': nrm(ks[10], (N_A, D, 2 * E), D ** -0.5),
        'ml_conv_w': nrm(ks[11], (N_A, ML_CONV, E), ML_CONV ** -0.5),
        'ml_conv_b': nrm(ks[12], (N_A, E), 0.02),
        'ml_w_qkv': nrm(ks[13], (N_A, 3, E // ML_QKV_BLOCK, ML_QKV_BLOCK, ML_QKV_BLOCK), ML_QKV_BLOCK ** -0.5),
        'ml_w_if': nrm(ks[14], (N_A, 2, 3 * E, 2 * H), 0.1 * (3 * E) ** -0.5),
        'ml_b_if': ml_b_if,
        'ml_skip': 1.0 + nrm(ks[17], (N_A, E), 0.02),
        'ml_norm_g': 1.0 + nrm(ks[18], (N_A, E), 0.02),
        'ml_w_down': nrm(ks[19], (N_A, E, D), BETA * E ** -0.5),
        'at_w_qkv': nrm(ks[20], (N_B, D, at_cols), D ** -0.5),
        'at_sink': nrm(ks[21], (N_B, AT_HEADS), 0.5),
        'at_w_o': nrm(ks[22], (N_B, AT_HEADS * AT_HEAD_DIM, D), BETA * (AT_HEADS * AT_HEAD_DIM) ** -0.5),
        'sc_w_in': nrm(ks[23], (N_C, D, 3 * D), D ** -0.5),
        'sc_conv_w': nrm(ks[24], (N_C, SC_WIDTH, D), SC_WIDTH ** -0.5),
        'sc_w_out': nrm(ks[25], (N_C, D, D), BETA * D ** -0.5),
    }


def reference(x, c, ctx, c_ctx, mod_w, mod_b, ln_g, ln_b, ffn_w_in, ffn_w_out,
              ml_w_up, ml_conv_w, ml_conv_b, ml_w_qkv, ml_w_if, ml_b_if, ml_skip, ml_norm_g, ml_w_down,
              at_w_qkv, at_sink, at_w_o, sc_w_in, sc_conv_w, sc_w_out):
    B = x.shape[0]
    lat_cond = jax.nn.silu(c)
    ctx_cond = jax.nn.silu(c_ctx)
    h, hc = x, ctx
    for i in range(DEPTH):
        kind, j, last = i % N_MIXERS, i // N_MIXERS, i == DEPTH - 1
        m_l = (lat_cond @ mod_w[i] + mod_b[i]).reshape(B, 1, N_MOD, D_MODEL)
        m_c = (ctx_cond @ mod_w[i] + mod_b[i]).reshape(N_MOD, D_MODEL)
        h = residual_post_norm(h, swiglu(modulate(h, m_l, 0), ffn_w_in[i, 0], ffn_w_out[i, 0]),
                               gate_of(m_l, 0), 0.5, ln_g[i, 0], ln_b[i, 0])
        hc = residual_post_norm(hc, swiglu(modulate(hc, m_c, 0), ffn_w_in[i, 0], ffn_w_out[i, 0]),
                                gate_of(m_c, 0), 0.5, ln_g[i, 0], ln_b[i, 0])
        ul, uc = modulate(h, m_l, 1), modulate(hc, m_c, 1)
        if kind == 0:
            yl, yc = mlstm_mixer(ul, uc, ml_w_up[j], ml_conv_w[j], ml_conv_b[j], ml_w_qkv[j], ml_w_if[j],
                                 ml_b_if[j], ml_skip[j], ml_norm_g[j], ml_w_down[j], not last)
        elif kind == 1:
            yl, yc = window_attention(ul, uc, at_w_qkv[j], at_sink[j], at_w_o[j], not last)
        else:
            yl = short_conv_mixer(ul, sc_w_in[j], sc_conv_w[j], sc_w_out[j])
            yc = None if last else short_conv_mixer(uc, sc_w_in[j], sc_conv_w[j], sc_w_out[j])
        h = residual_post_norm(h, yl, gate_of(m_l, 1), 1.0, ln_g[i, 1], ln_b[i, 1])
        h = residual_post_norm(h, swiglu(modulate(h, m_l, 2), ffn_w_in[i, 1], ffn_w_out[i, 1]),
                               gate_of(m_l, 2), 0.5, ln_g[i, 2], ln_b[i, 2])
        if not last:
            hc = residual_post_norm(hc, yc, gate_of(m_c, 1), 1.0, ln_g[i, 1], ln_b[i, 1])
            hc = residual_post_norm(hc, swiglu(modulate(hc, m_c, 2), ffn_w_in[i, 1], ffn_w_out[i, 1]),
                                    gate_of(m_c, 2), 0.5, ln_g[i, 2], ln_b[i, 2])
    return h
```

```cpp
#include <hip/hip_runtime.h>
#include <hip/hip_cooperative_groups.h>
#include <cstdio>
#include <cstdint>
namespace cg = cooperative_groups;

typedef unsigned short bf16_t;
typedef short bf16x8 __attribute__((ext_vector_type(8)));
typedef short bf16x4 __attribute__((ext_vector_type(4)));
typedef float f32x4 __attribute__((ext_vector_type(4)));
typedef unsigned u32x2 __attribute__((ext_vector_type(2)));
typedef unsigned u32x4 __attribute__((ext_vector_type(4)));

constexpr int D = 1024, NB = 8, SEQ = 4096, LC = 256, DEPTH = 4, FF = 2816, EI = 2048, DH = 512;
constexpr int NLAT = NB * SEQ, NCTX = NB * LC, MROWS = NLAT + NCTX;
constexpr int TOKB = LC + SEQ;
constexpr int NCH = TOKB / 64;
constexpr int GB = 2, NG = NB / GB, RG = GB * TOKB;
constexpr int NSEQ = GB * 8;
constexpr float ALPHA = 1.681792830507429f, LN_EPS = 1e-5f;
constexpr int LDS_BYTES = 144 * 1024;

constexpr size_t al256(size_t x) { return (x + 255) & ~(size_t)255; }
constexpr size_t O_WFI = 0;
constexpr size_t O_WFO = O_WFI + (size_t)8 * 5632 * 1024 * 2;
constexpr size_t O_WUP = O_WFO + (size_t)8 * 1024 * 2816 * 2;
constexpr size_t O_WDN = O_WUP + (size_t)2 * 4096 * 1024 * 2;
constexpr size_t O_WAQ = O_WDN + (size_t)2 * 1024 * 2048 * 2;
constexpr size_t O_WAO = O_WAQ + (size_t)1536 * 1024 * 2;
constexpr size_t O_WSI = O_WAO + (size_t)1024 * 1024 * 2;
constexpr size_t O_WSO = O_WSI + (size_t)3072 * 1024 * 2;
constexpr size_t O_WG = O_WSO + (size_t)1024 * 1024 * 2;
constexpr size_t O_MODT = O_WG + (size_t)2 * 16 * 6144 * 2;
constexpr size_t O_ROPE = O_MODT + (size_t)4 * 9 * 9216 * 4;
constexpr size_t O_HCTX = O_ROPE + (size_t)2 * 4096 * 32 * 4;
constexpr size_t O_U = O_HCTX + (size_t)NCTX * D * 4;
constexpr size_t O_R = O_U + (size_t)MROWS * D * 2;
constexpr size_t O_XZ = O_R;
constexpr size_t O_QK = O_XZ + (size_t)RG * 4096 * 2;
constexpr size_t O_KT = O_QK + (size_t)RG * 4096 * 2;
constexpr size_t O_VT = O_KT + (size_t)GB * EI * TOKB * 2;
constexpr size_t O_SP = O_VT + (size_t)GB * EI * TOKB * 2;
constexpr size_t O_HD = O_SP + (size_t)NSEQ * NCH * 4096 * 2;
constexpr size_t O_FIN = O_HD + (size_t)2 * RG * EI * 2;
constexpr size_t O_GAT = O_FIN + (size_t)RG * EI * 2;
constexpr size_t SZ_ST = (size_t)NSEQ * TOKB * 4;
constexpr size_t O_BL = O_GAT, O_IG = O_BL + SZ_ST, O_WIN = O_IG + SZ_ST, O_FLO = O_WIN + SZ_ST, O_DEN = O_FLO + SZ_ST, O_WSS = O_DEN + SZ_ST;
constexpr size_t O_GC = O_WSS + SZ_ST;
constexpr size_t O_REND_ML = O_GC + (size_t)3 * NSEQ * NCH * 4 + 256;
constexpr size_t O_ACT = O_R;
constexpr size_t O_AKR = O_R + (size_t)MROWS * 3072 * 2;
constexpr size_t O_AVT = O_AKR + (size_t)NB * 4 * TOKB * 64 * 2;
constexpr size_t O_REND_AT = O_AVT + (size_t)NB * 4 * TOKB * 64 * 2;
constexpr size_t WS_END = (O_REND_ML > O_REND_AT ? O_REND_ML : O_REND_AT);

struct Params {
  const float* in[25];
  float* out;
  char* ws;
  int nph; int pad0;
  unsigned prog[126];
};

struct Ctx { int tid, bid, nb, z; char* ws; float* out; };
extern __shared__ __attribute__((aligned(16))) char lds_raw[];

__device__ __forceinline__ unsigned pk2(float lo, float hi) { unsigned r; asm volatile("v_cvt_pk_bf16_f32 %0, %1, %2" : "=v"(r) : "v"(lo), "v"(hi)); return r; }
__device__ __forceinline__ float bf2f(unsigned short v) { return __uint_as_float(((unsigned)v) << 16); }
__device__ __forceinline__ float bflo(unsigned v) { return __uint_as_float(v << 16); }
__device__ __forceinline__ float bfhi(unsigned v) { return __uint_as_float(v & 0xffff0000u); }
__device__ __forceinline__ float silu_f(float x) { return x * __builtin_amdgcn_rcpf(1.f + __expf(-x)); }
__device__ __forceinline__ float sigm_f(float x) { return __builtin_amdgcn_rcpf(1.f + __expf(-x)); }
__device__ __forceinline__ float wave_sum(float v) {
#pragma unroll
  for (int o = 1; o < 64; o <<= 1) v += __shfl_xor(v, o);
  return v;
}
__device__ __forceinline__ bf16x8 mk8(u32x4 v) { union { u32x4 u; bf16x8 b; } x; x.u = v; return x.b; }
__device__ __forceinline__ bf16x8 mk8(u32x2 a, u32x2 b) { union { u32x4 u; bf16x8 b; } x; x.u = (u32x4){a.x, a.y, b.x, b.y}; return x.b; }
__device__ __forceinline__ float* hrow(const Ctx& cx, int row) { return row < NLAT ? cx.out + (size_t)row * D : (float*)(cx.ws + O_HCTX) + (size_t)(row - NLAT) * D; }
#define MFMA16(a, b, c) __builtin_amdgcn_mfma_f32_16x16x32_bf16(a, b, c, 0, 0, 0)

constexpr int BM = 256, BK = 64, HALF = 128, HT = HALF * BK, NXCD = 8, WGM = 8;
__device__ __forceinline__ int lds_byte(int r, int c) {
  int st = (r >> 4) * 2 + (c >> 5), rr = r & 15, cc = c & 31, ob = rr * 64 + cc * 2;
  return st * 1024 + (ob ^ (((ob >> 9) & 1) << 5));
}
__device__ __forceinline__ void stage_rc(int b, int& R, int& C) {
  int st = b / 1024, sb = b % 1024, swz = sb ^ (((sb >> 9) & 1) << 5);
  R = (st >> 1) * 16 + swz / 64; C = (st & 1) * 32 + (swz % 64) / 2;
}
struct RowMap { int lat0, ctx0, nlat; __device__ __forceinline__ int row0(int pm) const { return pm < nlat ? lat0 + pm * 256 : ctx0 + (pm - nlat) * 256; } };

typedef f32x4 Acc[2][2][4][2];

struct Epi {
  int kind; bf16_t* O; int ldc; const float* modl; int slot; float wgt;
};
__device__ __forceinline__ void run_epi(const Ctx& cx, const Epi& E, const Acc& acc, int r0, int pn, int wr, int wc, int fr, int fq) {
  if (E.kind == 0) {
#pragma unroll
    for (int ai = 0; ai < 2; ++ai)
#pragma unroll
      for (int m = 0; m < 4; ++m) {
        bf16_t* rp = E.O + (size_t)(r0 + ai * HALF + wr * 64 + m * 16 + fr) * E.ldc + pn * 256 + wc * 32 + 4 * fq;
#pragma unroll
        for (int bj = 0; bj < 2; ++bj)
#pragma unroll
          for (int n = 0; n < 2; ++n) {
            f32x4 v = acc[ai][bj][m][n];
            u32x2 o; o.x = pk2(v[0], v[1]); o.y = pk2(v[2], v[3]);
            *(u32x2*)(rp + bj * HALF + n * 16) = o;
          }
      }
  } else if (E.kind == 1) {
#pragma unroll
    for (int ai = 0; ai < 2; ++ai)
#pragma unroll
      for (int m = 0; m < 4; ++m) {
        bf16_t* rp = E.O + (size_t)(r0 + ai * HALF + wr * 64 + m * 16 + fr) * FF + pn * 128 + wc * 16 + 4 * fq;
#pragma unroll
        for (int bj = 0; bj < 2; ++bj) {
          f32x4 g = acc[ai][bj][m][0], v = acc[ai][bj][m][1];
          u32x2 o; o.x = pk2(silu_f(g[0]) * v[0], silu_f(g[1]) * v[1]); o.y = pk2(silu_f(g[2]) * v[2], silu_f(g[3]) * v[3]);
          *(u32x2*)(rp + bj * 64) = o;
        }
      }
  } else {
    const int midx = r0 < NLAT ? (r0 >> 12) : 8;
    const float* gp = E.modl + (size_t)midx * 9216 + (3 * E.slot + 2) * D + pn * 256 + wc * 32 + 4 * fq;
    f32x4 gv[2][2];
#pragma unroll
    for (int bj = 0; bj < 2; ++bj)
#pragma unroll
      for (int n = 0; n < 2; ++n) gv[bj][n] = *(const f32x4*)(gp + bj * HALF + n * 16) * E.wgt;
#pragma unroll
    for (int ai = 0; ai < 2; ++ai)
#pragma unroll
      for (int m = 0; m < 4; ++m) {
        float* rp = hrow(cx, r0 + ai * HALF + wr * 64 + m * 16 + fr) + pn * 256 + wc * 32 + 4 * fq;
        f32x4 h[2][2];
#pragma unroll
        for (int bj = 0; bj < 2; ++bj)
#pragma unroll
          for (int n = 0; n < 2; ++n) h[bj][n] = *(const f32x4*)(rp + bj * HALF + n * 16);
#pragma unroll
        for (int bj = 0; bj < 2; ++bj)
#pragma unroll
          for (int n = 0; n < 2; ++n) *(f32x4*)(rp + bj * HALF + n * 16) = h[bj][n] * ALPHA + gv[bj][n] * acc[ai][bj][m][n];
        __builtin_amdgcn_sched_barrier(0);
      }
  }
}

#define LAS __attribute__((address_space(3)))
__device__ __forceinline__ void gemm_phase(const Ctx& cx, const bf16_t* __restrict__ A, RowMap am, const bf16_t* __restrict__ Bt, int K, int nM, int nN, RowMap cm, const Epi& epi) {
  LAS unsigned char* lds = (LAS unsigned char*)lds_raw;
  constexpr int HTB = HT * 2;
  const int tid = cx.tid, wid = tid >> 6, lane = tid & 63, wr = wid >> 2, wc = wid & 3, fr = lane & 15, fq = lane >> 4;
  unsigned voff[2];
#pragma unroll
  for (int i = 0; i < 2; ++i) { int R, C; stage_rc(tid * 16 + i * 8192, R, C); voff[i] = (unsigned)(R * K + C) * 2u; }
  const size_t kstep = (size_t)(BK * 2), hstep = (size_t)HALF * K * 2;
  const unsigned ldsw = (unsigned)wid * 1024u;
  const int aoff = lds_byte(wr * 64 + fr, fq * 8), boff = lds_byte(wc * 32 + fr, fq * 8);
#define G_SA(b, h) (((b) * 2 + (h)) * HTB)
#define G_SB(b, h) ((4 + (b) * 2 + (h)) * HTB)
#define STAGE(bufoff, gbase) do { _Pragma("unroll") for (int _i = 0; _i < 2; ++_i) \
    __builtin_amdgcn_global_load_lds((const unsigned*)((const char*)(gbase) + voff[_i]), (LAS unsigned*)(lds + (bufoff) + ldsw + _i * 8192), 16, 0, 0); } while (0)
#define LDA(dst, b, h) do { _Pragma("unroll") for (int m = 0; m < 4; ++m) _Pragma("unroll") for (int k = 0; k < 2; ++k) dst[m][k] = *(const LAS bf16x8*)(lds + G_SA(b, h) + aoff + m * 2048 + k * 1024); } while (0)
#define LDB(dst, b, h) do { _Pragma("unroll") for (int n = 0; n < 2; ++n) _Pragma("unroll") for (int k = 0; k < 2; ++k) dst[n][k] = *(const LAS bf16x8*)(lds + G_SB(b, h) + boff + n * 2048 + k * 1024); } while (0)
#define MMA(ai, bj, At, Bt_) do { __builtin_amdgcn_s_setprio(1); _Pragma("unroll") for (int m = 0; m < 4; ++m) _Pragma("unroll") for (int n = 0; n < 2; ++n) _Pragma("unroll") for (int k = 0; k < 2; ++k) \
      acc[ai][bj][m][n] = MFMA16(Bt_[n][k], At[m][k], acc[ai][bj][m][n]); \
    __builtin_amdgcn_s_setprio(0); } while (0)
#define WAIT_V(n) asm volatile("s_waitcnt vmcnt(" #n ")" ::: "memory")
#define WAIT_L(n) asm volatile("s_waitcnt lgkmcnt(" #n ")" ::: "memory")
#define BAR __builtin_amdgcn_s_barrier()
#define SCHED __builtin_amdgcn_sched_barrier(0)
  const int nwg = nM * nN;
  const int nt = K / BK;
  const int wid_s = __builtin_amdgcn_readfirstlane(wid);
  for (int L = cx.bid; L < nwg; L += cx.nb) {
    int wgid = L;
    { int q = nwg / NXCD, r = nwg % NXCD, xcd = wgid % NXCD, off = wgid / NXCD; wgid = (xcd < r ? xcd * (q + 1) : r * (q + 1) + (xcd - r) * q) + off; }
    const int nig = WGM * nN, gid = wgid / nig, fm = gid * WGM, gsz = min(nM - fm, WGM);
    const int pm = fm + ((wgid % nig) % gsz), pn = (wgid % nig) / gsz;
    asm volatile("" : "+v"(voff[0]), "+v"(voff[1]));
    const char* cA = (const char*)A + (size_t)am.row0(pm) * K * 2; const char* cB = (const char*)Bt + (size_t)pn * BM * K * 2;
    Acc acc;
#pragma unroll
    for (int a = 0; a < 2; ++a)
#pragma unroll
      for (int b = 0; b < 2; ++b)
#pragma unroll
        for (int m = 0; m < 4; ++m)
#pragma unroll
          for (int n = 0; n < 2; ++n) acc[a][b][m][n] = (f32x4){0.f, 0.f, 0.f, 0.f};
    bf16x8 At[4][2], B0[2][2], B1[2][2];
    STAGE(G_SB(0, 0), cB); STAGE(G_SA(0, 0), cA); STAGE(G_SB(0, 1), cB + hstep); STAGE(G_SA(0, 1), cA + hstep);
    if (wr == 1) BAR;
    WAIT_V(4); BAR;
    STAGE(G_SB(1, 0), cB + kstep); STAGE(G_SA(1, 0), cA + kstep); STAGE(G_SB(1, 1), cB + hstep + kstep);
    WAIT_V(6); BAR;
    for (int t = 0; t < nt - 2; t += 2) {
      const char* a1 = cA + (size_t)(t + 1) * kstep; const char* a2 = a1 + kstep; const char* a3 = a2 + kstep;
      const char* b2 = cB + (size_t)(t + 2) * kstep; const char* b3 = b2 + kstep;
      LDB(B0, 0, 0); SCHED; LDA(At, 0, 0); STAGE(G_SA(1, 1), a1 + hstep);
      WAIT_L(8); BAR; WAIT_L(0); MMA(0, 0, At, B0); BAR; SCHED;
      LDB(B1, 0, 1); STAGE(G_SB(0, 0), b2);
      BAR; WAIT_L(0); MMA(0, 1, At, B1); BAR;
      LDA(At, 0, 1); STAGE(G_SA(0, 0), a2);
      BAR; WAIT_L(0); MMA(1, 0, At, B0); BAR; SCHED;
      STAGE(G_SB(0, 1), b2 + hstep);
      WAIT_V(6); BAR; MMA(1, 1, At, B1); BAR;
      LDB(B0, 1, 0); SCHED; LDA(At, 1, 0); STAGE(G_SA(0, 1), a2 + hstep);
      WAIT_L(8); BAR; WAIT_L(0); MMA(0, 0, At, B0); BAR; SCHED;
      LDB(B1, 1, 1); STAGE(G_SB(1, 0), b3);
      BAR; WAIT_L(0); MMA(0, 1, At, B1); BAR;
      LDA(At, 1, 1); STAGE(G_SA(1, 0), a3);
      BAR; WAIT_L(0); MMA(1, 0, At, B0); BAR; SCHED;
      STAGE(G_SB(1, 1), b3 + hstep);
      WAIT_V(6); BAR; MMA(1, 1, At, B1); BAR;
    }
    { LDB(B0, 0, 0); LDA(At, 0, 0); STAGE(G_SA(1, 1), cA + (size_t)(nt - 1) * kstep + hstep);
      BAR; WAIT_L(0); MMA(0, 0, At, B0); BAR;
      LDB(B1, 0, 1); BAR; WAIT_L(0); MMA(0, 1, At, B1); BAR;
      LDA(At, 0, 1); WAIT_V(4); BAR; WAIT_L(0); MMA(1, 0, At, B0); MMA(1, 1, At, B1); BAR; }
    { LDB(B0, 1, 0); LDA(At, 1, 0); WAIT_V(2); BAR; WAIT_L(0); MMA(0, 0, At, B0); BAR;
      LDB(B1, 1, 1); WAIT_V(0); BAR; WAIT_L(0); MMA(0, 1, At, B1); BAR;
      LDA(At, 1, 1); BAR; WAIT_L(0); MMA(1, 0, At, B0); MMA(1, 1, At, B1); BAR; }
    if (wr == 0) BAR;
    { int t2 = wid_s * 64 + (int)__builtin_amdgcn_mbcnt_hi(~0u, __builtin_amdgcn_mbcnt_lo(~0u, (unsigned)cx.z)); asm volatile("" : "+v"(t2));
      const int w2 = t2 >> 6, l2 = t2 & 63;
      run_epi(cx, epi, acc, cm.row0(pm), pn, w2 >> 2, w2 & 3, l2 & 15, l2 >> 4); }
  }
  __syncthreads();
}

template <int MODE>
__device__ __forceinline__ int wrow(int c) {
  if (MODE == 0) return c;
  const int isv = c >= FF ? 1 : 0, f = c - isv * FF;
  return (f >> 7) * 256 + ((f >> 6) & 1) * 128 + ((f >> 4) & 3) * 32 + isv * 16 + (f & 15);
}
template <int MODE>
__device__ __forceinline__ void transpose_item(const float* __restrict__ W, int K, int N, bf16_t* __restrict__ WT, float* scr, int item, int lane) {
  const int nblk = N / 32, kb = item / nblk, nb = item % nblk, k0 = 64 * kb, n0 = 32 * nb;
#pragma unroll 8
  for (int i = 0; i < 32; ++i) { const int kk = 2 * i + (lane >> 5); scr[kk * 33 + (lane & 31)] = W[(size_t)(k0 + kk) * N + n0 + (lane & 31)]; }
  __builtin_amdgcn_wave_barrier(); asm volatile("s_waitcnt lgkmcnt(0)" ::: "memory");
  const int c = lane & 7;
#pragma unroll
  for (int j = 0; j < 4; ++j) {
    const int n = (lane >> 3) + 8 * j; const float* s = scr + (8 * c) * 33 + n;
    u32x4 o; o.x = pk2(s[0 * 33], s[1 * 33]); o.y = pk2(s[2 * 33], s[3 * 33]); o.z = pk2(s[4 * 33], s[5 * 33]); o.w = pk2(s[6 * 33], s[7 * 33]);
    *(u32x4*)(WT + (size_t)wrow<MODE>(n0 + n) * K + k0 + 8 * c) = o;
  }
  asm volatile("s_waitcnt lgkmcnt(0)" ::: "memory"); __builtin_amdgcn_wave_barrier();
}

__device__ __forceinline__ void prologue(const Params& p, const Ctx& cx) {
  const int tid = cx.tid, lane = tid & 63, wave = tid >> 6;
  char* ws = cx.ws;
  {
    float* cond = (float*)lds_raw;
    float* red = (float*)(lds_raw + 9 * 1024 * 4);
    for (int i = tid; i < 9 * 1024; i += 512) { const int j = i >> 10, k = i & 1023; cond[i] = silu_f(j < 8 ? p.in[1 + cx.z][j * 1024 + k] : p.in[3 + cx.z][k]); }
    __syncthreads();
    for (int u = cx.bid; u < 4 * 36; u += cx.nb) {
      const int layer = u / 36, ct = u % 36, c0 = ct * 256 + 4 * lane;
      const float* wp = p.in[4 + cx.z] + (size_t)layer * D * 9216 + c0;
      f32x4 a[9];
#pragma unroll
      for (int j = 0; j < 9; ++j) a[j] = (f32x4){0.f, 0.f, 0.f, 0.f};
#pragma unroll 4
      for (int k = wave * 128; k < wave * 128 + 128; ++k) {
        const f32x4 w = *(const f32x4*)(wp + (size_t)k * 9216);
#pragma unroll
        for (int j = 0; j < 9; ++j) a[j] += w * cond[j * 1024 + k];
      }
#pragma unroll
      for (int j = 0; j < 9; ++j) *(f32x4*)(red + (wave * 9 + j) * 256 + 4 * lane) = a[j];
      __syncthreads();
      float* mt = (float*)(ws + O_MODT) + (size_t)layer * 9 * 9216;
      for (int i = tid; i < 9 * 256; i += 512) {
        const int j = i >> 8, c = i & 255; float s = 0.f;
#pragma unroll
        for (int w = 0; w < 8; ++w) s += red[(w * 9 + j) * 256 + c];
        mt[(size_t)j * 9216 + ct * 256 + c] = s + p.in[5 + cx.z][layer * 9216 + ct * 256 + c];
      }
      __syncthreads();
    }
    __syncthreads();
  }
  {
    float* scr = (float*)lds_raw + wave * (64 * 33);
    const int gw = cx.bid * 8 + wave, NGW = cx.nb * 8;
    constexpr int I_FI = 16 * 176, I_FO = 44 * 32, I_UP = 16 * 128, I_DN = 32 * 32, I_AQ = 16 * 48, I_AO = 16 * 32, I_SI = 16 * 96, I_SO = 16 * 32;
    constexpr int NITEMS = 8 * I_FI + 8 * I_FO + 2 * I_UP + 2 * I_DN + I_AQ + I_AO + I_SI + I_SO;
    for (int it = gw; it < NITEMS; it += NGW) {
      int r = it;
      if (r < 8 * I_FI) { const int mi = r / I_FI; transpose_item<1>(p.in[8 + cx.z] + (size_t)mi * 1024 * 5632, 1024, 5632, (bf16_t*)(ws + O_WFI) + (size_t)mi * 5632 * 1024, scr, r % I_FI, lane); continue; } r -= 8 * I_FI;
      if (r < 8 * I_FO) { const int mi = r / I_FO; transpose_item<0>(p.in[9 + cx.z] + (size_t)mi * 2816 * 1024, 2816, 1024, (bf16_t*)(ws + O_WFO) + (size_t)mi * 1024 * 2816, scr, r % I_FO, lane); continue; } r -= 8 * I_FO;
      if (r < 2 * I_UP) { const int mi = r / I_UP; transpose_item<0>(p.in[10 + cx.z] + (size_t)mi * 1024 * 4096, 1024, 4096, (bf16_t*)(ws + O_WUP) + (size_t)mi * 4096 * 1024, scr, r % I_UP, lane); continue; } r -= 2 * I_UP;
      if (r < 2 * I_DN) { const int mi = r / I_DN; transpose_item<0>(p.in[18 + cx.z] + (size_t)mi * 2048 * 1024, 2048, 1024, (bf16_t*)(ws + O_WDN) + (size_t)mi * 1024 * 2048, scr, r % I_DN, lane); continue; } r -= 2 * I_DN;
      if (r < I_AQ) { transpose_item<0>(p.in[19 + cx.z], 1024, 1536, (bf16_t*)(ws + O_WAQ), scr, r, lane); continue; } r -= I_AQ;
      if (r < I_AO) { transpose_item<0>(p.in[21 + cx.z], 1024, 1024, (bf16_t*)(ws + O_WAO), scr, r, lane); continue; } r -= I_AO;
      if (r < I_SI) { transpose_item<0>(p.in[22 + cx.z], 1024, 3072, (bf16_t*)(ws + O_WSI), scr, r, lane); continue; } r -= I_SI;
      transpose_item<0>(p.in[24 + cx.z], 1024, 1024, (bf16_t*)(ws + O_WSO), scr, r, lane);
    }
  }
  {
    const int gt = cx.bid * 512 + tid, gs = cx.nb * 512;
    bf16_t* wg = (bf16_t*)(ws + O_WG);
    for (int i = gt; i < 2 * 16 * 6144; i += gs) {
      const int j = i / (16 * 6144), xg = (i / 6144) & 15, k = i % 6144, x = xg >> 3, g = xg & 7;
      const float* wif = p.in[14 + cx.z] + (size_t)(j * 2 + x) * 6144 * 8;
      float v;
      if (k < 2048) v = wif[(size_t)k * 8 + g];
      else if (k < 4096) v = wif[(size_t)k * 8 + g] * 22.627416997969522f;
      else {
        const int c = k - 4096, blk = c >> 2, cc = c & 3;
        const float* wv = p.in[13 + cx.z] + ((size_t)(j * 3 + 2) * 512 + blk) * 16 + cc * 4;
        v = 0.f;
        for (int d2 = 0; d2 < 4; ++d2) v += wv[d2] * wif[(size_t)(4096 + 4 * blk + d2) * 8 + g];
      }
      wg[i] = (bf16_t)(pk2(v, 0.f) & 0xffff);
    }
    float* rc = (float*)(ws + O_ROPE); float* rs = rc + 4096 * 32;
    for (int i = gt; i < 4096 * 32; i += gs) {
      const int pos = i >> 5, pp = i & 31, jf = pp & 15;
      const float fr_ = __builtin_amdgcn_exp2f(-(float)jf * (13.287712379549449f / 16.f));
      float rev = (float)(pp < 16 ? (pos >> 6) : (pos & 63)) * fr_ * 0.15915494309189535f;
      rev -= rintf(rev);
      rc[i] = __builtin_amdgcn_cosf(rev); rs[i] = __builtin_amdgcn_sinf(rev);
    }
  }
}

template <int MODE>
__device__ __forceinline__ void lnmod_phase(const Params& p, const Ctx& cx, int lnidx  , int layer, int slot) {
  const int lane = cx.tid & 63, gw = cx.bid * 8 + (cx.tid >> 6), NGW = cx.nb * 8;
  const int nrows = MODE == 2 ? NLAT : MROWS;
  const float* lg = p.in[6 + cx.z] + (size_t)lnidx * D; const float* lb = p.in[7 + cx.z] + (size_t)lnidx * D;
  const float* modl = (const float*)(cx.ws + O_MODT) + (size_t)layer * 9 * 9216;
  bf16_t* U = (bf16_t*)(cx.ws + O_U);
  for (int row = gw; row < nrows; row += NGW) {
    float* hp = hrow(cx, row);
    const float* src = MODE == 0 ? (row < NLAT ? p.in[0 + cx.z] + (size_t)row * D : p.in[2 + cx.z] + (size_t)(row - NLAT) * D) : hp;
    f32x4 v[4];
#pragma unroll
    for (int j = 0; j < 4; ++j) v[j] = *(const f32x4*)(src + 4 * lane + 256 * j);
    if (MODE != 0) {
      float s = 0.f;
#pragma unroll
      for (int j = 0; j < 4; ++j) s += (v[j][0] + v[j][1]) + (v[j][2] + v[j][3]);
      const float mean = wave_sum(s) * (1.f / D); float s2 = 0.f;
#pragma unroll
      for (int j = 0; j < 4; ++j) { v[j] = v[j] - mean; s2 += (v[j][0] * v[j][0] + v[j][1] * v[j][1]) + (v[j][2] * v[j][2] + v[j][3] * v[j][3]); }
      const float rstd = __builtin_amdgcn_rsqf(wave_sum(s2) * (1.f / D) + LN_EPS);
#pragma unroll
      for (int j = 0; j < 4; ++j) v[j] = v[j] * rstd * *(const f32x4*)(lg + 4 * lane + 256 * j) + *(const f32x4*)(lb + 4 * lane + 256 * j);
    }
#pragma unroll
    for (int j = 0; j < 4; ++j) *(f32x4*)(hp + 4 * lane + 256 * j) = v[j];
    if (MODE != 2) {
      const int midx = row < NLAT ? (row >> 12) : 8;
      const float* sh = modl + (size_t)midx * 9216 + (3 * slot) * D; const float* sc = sh + D;
#pragma unroll
      for (int j = 0; j < 4; ++j) {
        const f32x4 u = v[j] * (*(const f32x4*)(sc + 4 * lane + 256 * j) + 1.f) + *(const f32x4*)(sh + 4 * lane + 256 * j);
        u32x2 o; o.x = pk2(u[0], u[1]); o.y = pk2(u[2], u[3]);
        *(u32x2*)(U + (size_t)row * D + 4 * lane + 256 * j) = o;
      }
    }
  }
}

__device__ __forceinline__ int ml_lrow(int bl, int tok) { return tok < LC ? GB * SEQ + bl * LC + tok : bl * SEQ + (tok - LC); }
__device__ __forceinline__ int ml_nchunk(int x, int st) { return x == 0 ? st : (st < 4 ? 3 - st : 71 - st); }

__device__ __forceinline__ void ml_m0(const Params& p, const Ctx& cx, int j) {
  const int tid = cx.tid;
  char* ws = cx.ws;
  const bf16_t* XZ = (const bf16_t*)(ws + O_XZ);
  bf16_t* QK = (bf16_t*)(ws + O_QK); bf16_t* KT = (bf16_t*)(ws + O_KT); bf16_t* VT = (bf16_t*)(ws + O_VT);
  bf16_t* lk = (bf16_t*)lds_raw;
  bf16_t* lv = lk + 256 * 72;
  const int blk_l = tid & 63, tq = tid >> 6;
  for (int u = cx.bid; u < GB * NCH * 8; u += cx.nb) {
    const int slab = u & 7, ch = (u >> 3) % NCH, bl = u / (8 * NCH);
    const int f0 = slab * 256 + blk_l * 4, blk = f0 >> 2;
    float cw[3][4], cb[4], wq[16], wk[16], wv[16];
#pragma unroll
    for (int k = 0; k < 3; ++k)
#pragma unroll
      for (int c = 0; c < 4; ++c) cw[k][c] = p.in[11 + cx.z][(size_t)(j * 3 + k) * EI + f0 + c];
#pragma unroll
    for (int c = 0; c < 4; ++c) cb[c] = p.in[12 + cx.z][(size_t)j * EI + f0 + c];
#pragma unroll
    for (int i = 0; i < 16; ++i) {
      wq[i] = p.in[13 + cx.z][((size_t)(j * 3 + 0) * 512 + blk) * 16 + i];
      wk[i] = p.in[13 + cx.z][((size_t)(j * 3 + 1) * 512 + blk) * 16 + i] * 0.04419417382415922f;
      wv[i] = p.in[13 + cx.z][((size_t)(j * 3 + 2) * 512 + blk) * 16 + i];
    }
    const int tok0 = ch * 64, seg_lo = tok0 < LC ? 0 : LC, seg_hi = tok0 < LC ? LC : TOKB;
    for (int tt = 0; tt < 8; ++tt) {
      const int tl = tq + 8 * tt, tok = tok0 + tl;
      float xm[3][4];
#pragma unroll
      for (int k = 0; k < 3; ++k) {
        const int t2 = tok + k - 1;
        if (t2 >= seg_lo && t2 < seg_hi) {
          const u32x2 r = *(const u32x2*)(XZ + (size_t)ml_lrow(bl, t2) * 4096 + f0);
          xm[k][0] = bflo(r.x); xm[k][1] = bfhi(r.x); xm[k][2] = bflo(r.y); xm[k][3] = bfhi(r.y);
        } else { xm[k][0] = xm[k][1] = xm[k][2] = xm[k][3] = 0.f; }
      }
      float xc[4], q[4], kk[4], vv[4];
#pragma unroll
      for (int c = 0; c < 4; ++c) xc[c] = silu_f(cw[0][c] * xm[0][c] + cw[1][c] * xm[1][c] + cw[2][c] * xm[2][c] + cb[c]);
#pragma unroll
      for (int d2 = 0; d2 < 4; ++d2) {
        q[d2] = xc[0] * wq[d2] + xc[1] * wq[4 + d2] + xc[2] * wq[8 + d2] + xc[3] * wq[12 + d2];
        kk[d2] = xc[0] * wk[d2] + xc[1] * wk[4 + d2] + xc[2] * wk[8 + d2] + xc[3] * wk[12 + d2];
        vv[d2] = xm[1][0] * wv[d2] + xm[1][1] * wv[4 + d2] + xm[1][2] * wv[8 + d2] + xm[1][3] * wv[12 + d2];
      }
      const size_t lr = ml_lrow(bl, tok);
      u32x2 oq, ok, ov; oq.x = pk2(q[0], q[1]); oq.y = pk2(q[2], q[3]); ok.x = pk2(kk[0], kk[1]); ok.y = pk2(kk[2], kk[3]); ov.x = pk2(vv[0], vv[1]); ov.y = pk2(vv[2], vv[3]);
      *(u32x2*)(QK + lr * 4096 + f0) = oq;
      *(u32x2*)(QK + lr * 4096 + 2048 + f0) = ok;
      const int fl = blk_l * 4;
      lk[(fl + 0) * 72 + tl] = (bf16_t)(ok.x & 0xffff); lk[(fl + 1) * 72 + tl] = (bf16_t)(ok.x >> 16); lk[(fl + 2) * 72 + tl] = (bf16_t)(ok.y & 0xffff); lk[(fl + 3) * 72 + tl] = (bf16_t)(ok.y >> 16);
      lv[(fl + 0) * 72 + tl] = (bf16_t)(ov.x & 0xffff); lv[(fl + 1) * 72 + tl] = (bf16_t)(ov.x >> 16); lv[(fl + 2) * 72 + tl] = (bf16_t)(ov.y & 0xffff); lv[(fl + 3) * 72 + tl] = (bf16_t)(ov.y >> 16);
    }
    __syncthreads();
    {
      const int arr = tid >> 8, fr_ = tid & 255;
      const bf16_t* src = (arr ? lv : lk) + fr_ * 72;
      bf16_t* dst = (arr ? VT : KT) + ((size_t)bl * EI + slab * 256 + fr_) * TOKB + tok0;
#pragma unroll
      for (int i = 0; i < 8; ++i) *(u32x4*)(dst + 8 * i) = *(const u32x4*)(src + 8 * i);
    }
    __syncthreads();
  }
}

__device__ __forceinline__ void ml_gates(const Params& p, const Ctx& cx, int j) {
  const int lane = cx.tid & 63, wave = cx.tid >> 6, fr = lane & 15, fq = lane >> 4;
  char* ws = cx.ws;
  const bf16_t* XZ = (const bf16_t*)(ws + O_XZ); const bf16_t* QK = (const bf16_t*)(ws + O_QK);
  const bf16_t* WG = (const bf16_t*)(ws + O_WG) + (size_t)j * 16 * 6144;
  float* BL = (float*)(ws + O_BL); float* IG = (float*)(ws + O_IG);
  float* GC = (float*)(ws + O_GC); float* AC = GC + NSEQ * NCH;
  float* gl = (float*)lds_raw + wave * (64 * 17);
  const int gw = cx.bid * 8 + wave, NGW = cx.nb * 8;
  for (int u = gw; u < GB * NCH; u += NGW) {
    const int bl = u / NCH, nc = u % NCH, tok0 = nc * 64;
    f32x4 acc[4];
#pragma unroll
    for (int m = 0; m < 4; ++m) acc[m] = (f32x4){0.f, 0.f, 0.f, 0.f};
    size_t lr[4];
#pragma unroll
    for (int m = 0; m < 4; ++m) lr[m] = ml_lrow(bl, tok0 + m * 16 + fr);
    for (int ks = 0; ks < 192; ++ks) {
      const int k = ks * 32 + fq * 8;
      const bf16x8 bfr = *(const bf16x8*)(WG + (size_t)fr * 6144 + k);
#pragma unroll
      for (int m = 0; m < 4; ++m) {
        const bf16_t* ap = k < 4096 ? QK + lr[m] * 4096 + k : XZ + lr[m] * 4096 + (k - 4096);
        const bf16x8 afr = *(const bf16x8*)ap;
        acc[m] = MFMA16(afr, bfr, acc[m]);
      }
    }
    const float bias = p.in[15 + cx.z][(size_t)j * 16 + fr];
#pragma unroll
    for (int m = 0; m < 4; ++m)
#pragma unroll
      for (int jj = 0; jj < 4; ++jj) gl[(m * 16 + 4 * fq + jj) * 17 + fr] = acc[m][jj] + bias;
    __builtin_amdgcn_wave_barrier(); asm volatile("s_waitcnt lgkmcnt(0)" ::: "memory");
    if (lane < 8) {
      const int x = lane >> 2, h = lane & 3, seq = (bl * 2 + x) * 4 + h;
      float b = 0.f, mx = -3.0e38f;
      for (int pp = 0; pp < 64; ++pp) {
        const int tl = x == 0 ? pp : 63 - pp;
        const float ig = gl[tl * 17 + x * 8 + h], fg = gl[tl * 17 + x * 8 + 4 + h];
        const float lf = fg > 0.f ? -__logf(1.f + __expf(-fg)) : fg - __logf(1.f + __expf(fg));
        b += lf;
        BL[(size_t)seq * TOKB + tok0 + tl] = b; IG[(size_t)seq * TOKB + tok0 + tl] = ig;
        mx = fmaxf(mx, ig - b);
      }
      GC[seq * NCH + nc] = b; AC[seq * NCH + nc] = b + mx;
    }
    __builtin_amdgcn_wave_barrier(); asm volatile("s_waitcnt lgkmcnt(0)" ::: "memory");
  }
}

__device__ __forceinline__ void ml_s(const Params& p, const Ctx& cx) {
  const int tid = cx.tid, lane = tid & 63, wave = tid >> 6, fr = lane & 15, fq = lane >> 4;
  char* ws = cx.ws;
  const bf16_t* QK = (const bf16_t*)(ws + O_QK);
  bf16_t* SP = (bf16_t*)(ws + O_SP);
  const float* BL = (const float*)(ws + O_BL); const float* IG = (const float*)(ws + O_IG);
  float* WIN = (float*)(ws + O_WIN); float* FLO = (float*)(ws + O_FLO); float* DEN = (float*)(ws + O_DEN); float* WSS = (float*)(ws + O_WSS);
  const float* GC = (const float*)(ws + O_GC); const float* AC = GC + NSEQ * NCH; float* DEC = (float*)(ws + O_GC) + 2 * NSEQ * NCH;
  float* sb_ = (float*)lds_raw; float* si_ = sb_ + 64; float* smt = si_ + 64; float* sden = smt + 64;
  for (int u = cx.bid; u < NSEQ * NCH; u += cx.nb) {
    const int seq = u / NCH, st = u % NCH, x = (seq >> 2) & 1, h = seq & 3, bl = seq >> 3;
    const int nc = ml_nchunk(x, st), tok0 = nc * 64;
    if (wave == 0) {
      float mc = 0.f;
      for (int s2 = 0; s2 < st; ++s2) { const int n2 = ml_nchunk(x, s2); mc = fmaxf(GC[seq * NCH + n2] + mc, AC[seq * NCH + n2]); }
      const float gc = GC[seq * NCH + nc], ac = AC[seq * NCH + nc];
      const float mnew = fmaxf(gc + mc, ac);
      const int tl = x == 0 ? lane : 63 - lane;
      const float b = BL[(size_t)seq * TOKB + tok0 + tl], ig = IG[(size_t)seq * TOKB + tok0 + tl];
      float cm = ig - b;
#pragma unroll
      for (int o = 1; o < 64; o <<= 1) { const float t2 = __shfl_up(cm, o); if (lane >= o) cm = fmaxf(cm, t2); }
      const float mt = b + fmaxf(mc, cm);
      sb_[tl] = b; si_[tl] = ig; smt[tl] = mt; sden[tl] = 0.f;
      WIN[(size_t)seq * TOKB + tok0 + tl] = __expf(b + mc - mt);
      FLO[(size_t)seq * TOKB + tok0 + tl] = __expf(-mt);
      WSS[(size_t)seq * TOKB + tok0 + tl] = __expf(gc - b + ig - mnew);
      if (lane == 0) DEC[seq * NCH + nc] = __expf(gc + mc - mnew);
    }
    __syncthreads();
    const int sbk = wave >> 1;
    const bf16_t* kp = QK + (size_t)ml_lrow(bl, tok0 + sbk * 16 + fr) * 4096 + 2048 + h * DH + fq * 8;
    const bf16_t* qp0 = QK + (size_t)ml_lrow(bl, tok0 + (2 * (wave & 1)) * 16 + fr) * 4096 + h * DH + fq * 8;
    const bf16_t* qp1 = QK + (size_t)ml_lrow(bl, tok0 + (2 * (wave & 1) + 1) * 16 + fr) * 4096 + h * DH + fq * 8;
    f32x4 a0 = {0.f, 0.f, 0.f, 0.f}, a1 = {0.f, 0.f, 0.f, 0.f};
#pragma unroll 4
    for (int ks = 0; ks < 16; ++ks) {
      const bf16x8 kf = *(const bf16x8*)(kp + ks * 32), q0 = *(const bf16x8*)(qp0 + ks * 32), q1 = *(const bf16x8*)(qp1 + ks * 32);
      a0 = MFMA16(kf, q0, a0); a1 = MFMA16(kf, q1, a1);
    }
    bf16_t* spu = SP + (size_t)(seq * NCH + nc) * 4096;
#pragma unroll
    for (int tbi = 0; tbi < 2; ++tbi) {
      const int t = (2 * (wave & 1) + tbi) * 16 + fr;
      const f32x4 a = tbi ? a1 : a0;
      const float bt = sb_[t], mt = smt[t];
      float vals[4];
#pragma unroll
      for (int jj = 0; jj < 4; ++jj) {
        const int s = sbk * 16 + 4 * fq + jj;
        const bool ok = x == 0 ? (s <= t) : (s >= t);
        vals[jj] = ok ? a[jj] * __expf(bt - sb_[s] + si_[s] - mt) : 0.f;
      }
      u32x2 o; o.x = pk2(vals[0], vals[1]); o.y = pk2(vals[2], vals[3]);
      *(u32x2*)(spu + t * 64 + sbk * 16 + 4 * fq) = o;
      float ds = (bflo(o.x) + bfhi(o.x)) + (bflo(o.y) + bfhi(o.y));
      ds += __shfl_xor(ds, 16); ds += __shfl_xor(ds, 32);
      if (fq == 0) atomicAdd(&sden[t], ds);
    }
    __syncthreads();
    if (tid < 64) DEN[(size_t)seq * TOKB + tok0 + tid] = sden[tid];
    __syncthreads();
  }
}

__device__ __forceinline__ void ml_m2(const Params& p, const Ctx& cx) {
  const int tid = cx.tid, lane = tid & 63, wave = tid >> 6, fr = lane & 15, fq = lane >> 4;
  char* ws = cx.ws;
  const bf16_t* QK = (const bf16_t*)(ws + O_QK); const bf16_t* KT = (const bf16_t*)(ws + O_KT); const bf16_t* VT = (const bf16_t*)(ws + O_VT);
  const bf16_t* SP = (const bf16_t*)(ws + O_SP);
  bf16_t* HD = (bf16_t*)(ws + O_HD);
  const float* WIN = (const float*)(ws + O_WIN); const float* FLO = (const float*)(ws + O_FLO); const float* DEN = (const float*)(ws + O_DEN); const float* WSS = (const float*)(ws + O_WSS);
  const float* DEC = (const float*)(ws + O_GC) + 2 * NSEQ * NCH;
  f32x4* red = (f32x4*)lds_raw;
  for (int u = cx.bid; u < NSEQ * 16; u += cx.nb) {
    const int seq = u >> 4, es = u & 15, x = (seq >> 2) & 1, h = seq & 3, bl = seq >> 3;
    const int d0 = wave * 64, e0 = es * 32;
    f32x4 C[4][3];
#pragma unroll
    for (int a = 0; a < 4; ++a)
#pragma unroll
      for (int b = 0; b < 3; ++b) C[a][b] = (f32x4){0.f, 0.f, 0.f, 0.f};
    const int tbo = wave >> 1, ebo = wave & 1;
    for (int st = 0; st < NCH; ++st) {
      const int nc = ml_nchunk(x, st), tok0 = nc * 64;
      bf16x8 Cb[2][3];
#pragma unroll
      for (int ks = 0; ks < 2; ++ks)
#pragma unroll
        for (int eb = 0; eb < 3; ++eb) {
          const f32x4 lo = C[2 * ks][eb], hi = C[2 * ks + 1][eb];
          Cb[ks][eb] = mk8((u32x4){pk2(lo[0], lo[1]), pk2(lo[2], lo[3]), pk2(hi[0], hi[1]), pk2(hi[2], hi[3])});
        }
#pragma unroll
      for (int tb = 0; tb < 4; ++tb) {
        const bf16_t* qp = QK + (size_t)ml_lrow(bl, tok0 + tb * 16 + fr) * 4096 + h * DH + d0 + 4 * fq;
        const bf16x8 q0 = mk8(*(const u32x2*)(qp), *(const u32x2*)(qp + 16));
        const bf16x8 q1 = mk8(*(const u32x2*)(qp + 32), *(const u32x2*)(qp + 48));
#pragma unroll
        for (int eb = 0; eb < 3; ++eb) {
          f32x4 pa = {0.f, 0.f, 0.f, 0.f};
          pa = MFMA16(q0, Cb[0][eb], pa); pa = MFMA16(q1, Cb[1][eb], pa);
          red[((wave * 4 + tb) * 3 + eb) * 64 + lane] = pa;
        }
      }
      const float decay = DEC[seq * NCH + nc];
      bf16x8 vf[2][2], vw[3][2];
#pragma unroll
      for (int ks = 0; ks < 2; ++ks) {
        const float* wp = WSS + (size_t)seq * TOKB + tok0 + 32 * ks + 8 * fq;
        const f32x4 w0 = *(const f32x4*)wp, w1 = *(const f32x4*)(wp + 4);
#pragma unroll
        for (int eb = 0; eb < 2; ++eb) {
          const u32x4 r = *(const u32x4*)(VT + ((size_t)bl * EI + h * DH + e0 + eb * 16 + fr) * TOKB + tok0 + 32 * ks + 8 * fq);
          vf[eb][ks] = mk8(r);
          vw[eb][ks] = mk8((u32x4){pk2(bflo(r.x) * w0[0], bfhi(r.x) * w0[1]), pk2(bflo(r.y) * w0[2], bfhi(r.y) * w0[3]),
                                   pk2(bflo(r.z) * w1[0], bfhi(r.z) * w1[1]), pk2(bflo(r.w) * w1[2], bfhi(r.w) * w1[3])});
        }
        vw[2][ks] = mk8((u32x4){pk2(w0[0], w0[1]), pk2(w0[2], w0[3]), pk2(w1[0], w1[1]), pk2(w1[2], w1[3])});
      }
#pragma unroll
      for (int db = 0; db < 4; ++db) {
        const bf16_t* kp = KT + ((size_t)bl * EI + h * DH + d0 + db * 16 + fr) * TOKB + tok0 + 8 * fq;
        const bf16x8 k0 = *(const bf16x8*)kp, k1 = *(const bf16x8*)(kp + 32);
#pragma unroll
        for (int eb = 0; eb < 3; ++eb) {
          f32x4 c = C[db][eb] * decay;
          c = MFMA16(k0, vw[eb][0], c); c = MFMA16(k1, vw[eb][1], c);
          C[db][eb] = c;
        }
      }
      const bf16_t* sp = SP + (size_t)(seq * NCH + nc) * 4096 + (tbo * 16 + fr) * 64 + 8 * fq;
      f32x4 oi = {0.f, 0.f, 0.f, 0.f};
      oi = MFMA16(*(const bf16x8*)sp, vf[ebo][0], oi); oi = MFMA16(*(const bf16x8*)(sp + 32), vf[ebo][1], oi);
      const size_t tix = (size_t)seq * TOKB + tok0 + tbo * 16 + 4 * fq;
      const f32x4 win = *(const f32x4*)(WIN + tix), flo = *(const f32x4*)(FLO + tix), deni = *(const f32x4*)(DEN + tix);
      __syncthreads();
      f32x4 pi = {0.f, 0.f, 0.f, 0.f}, pn = {0.f, 0.f, 0.f, 0.f};
#pragma unroll
      for (int w = 0; w < 8; ++w) { pi += red[((w * 4 + tbo) * 3 + ebo) * 64 + lane]; pn += red[((w * 4 + tbo) * 3 + 2) * 64 + lane]; }
#pragma unroll
      for (int jj = 0; jj < 4; ++jj) {
        const float num = oi[jj] + win[jj] * pi[jj], den = deni[jj] + win[jj] * pn[jj];
        const float hv = num * __builtin_amdgcn_rcpf(fmaxf(fabsf(den), flo[jj]));
        HD[((size_t)x * RG + ml_lrow(bl, tok0 + tbo * 16 + 4 * fq + jj)) * EI + h * DH + e0 + ebo * 16 + fr] = (bf16_t)(pk2(hv, 0.f) & 0xffff);
      }
      __syncthreads();
    }
  }
}

__device__ __forceinline__ void ml_fin(const Params& p, const Ctx& cx, int j) {
  const int lane = cx.tid & 63, gw = cx.bid * 8 + (cx.tid >> 6), NGW = cx.nb * 8;
  char* ws = cx.ws;
  const bf16_t* XZ = (const bf16_t*)(ws + O_XZ); const bf16_t* HD = (const bf16_t*)(ws + O_HD);
  bf16_t* FIN = (bf16_t*)(ws + O_FIN);
  for (int u = gw; u < RG * 4; u += NGW) {
    const int lr = u >> 2, h = u & 3, f0 = h * DH + lane * 8;
    int pos, seglen;
    if (lr < GB * SEQ) { pos = lr & (SEQ - 1); seglen = SEQ; } else { pos = (lr - GB * SEQ) & (LC - 1); seglen = LC; }
    const u32x4 hf = *(const u32x4*)(HD + (size_t)lr * EI + f0), hb = *(const u32x4*)(HD + ((size_t)RG + lr) * EI + f0);
    const u32x4 zz = *(const u32x4*)(XZ + (size_t)lr * 4096 + 2048 + f0);
    const u32x4 x1 = *(const u32x4*)(XZ + (size_t)lr * 4096 + f0);
    u32x4 x0 = {0u, 0u, 0u, 0u}, x2 = {0u, 0u, 0u, 0u};
    if (pos > 0) x0 = *(const u32x4*)(XZ + (size_t)(lr - 1) * 4096 + f0);
    if (pos < seglen - 1) x2 = *(const u32x4*)(XZ + (size_t)(lr + 1) * 4096 + f0);
    float hv[8], xm0[8], xm1[8], xm2[8];
    const unsigned hfu[4] = {hf.x, hf.y, hf.z, hf.w}, hbu[4] = {hb.x, hb.y, hb.z, hb.w}, zu[4] = {zz.x, zz.y, zz.z, zz.w};
    const unsigned x0u[4] = {x0.x, x0.y, x0.z, x0.w}, x1u[4] = {x1.x, x1.y, x1.z, x1.w}, x2u[4] = {x2.x, x2.y, x2.z, x2.w};
    float s = 0.f;
#pragma unroll
    for (int i = 0; i < 4; ++i) {
      hv[2 * i] = (bflo(hfu[i]) + bflo(hbu[i])) * sigm_f(bflo(zu[i]));
      hv[2 * i + 1] = (bfhi(hfu[i]) + bfhi(hbu[i])) * sigm_f(bfhi(zu[i]));
      xm0[2 * i] = bflo(x0u[i]); xm0[2 * i + 1] = bfhi(x0u[i]); xm1[2 * i] = bflo(x1u[i]); xm1[2 * i + 1] = bfhi(x1u[i]); xm2[2 * i] = bflo(x2u[i]); xm2[2 * i + 1] = bfhi(x2u[i]);
      s += hv[2 * i] + hv[2 * i + 1];
    }
    const float mean = wave_sum(s) * (1.f / DH); float s2 = 0.f;
#pragma unroll
    for (int i = 0; i < 8; ++i) { hv[i] -= mean; s2 += hv[i] * hv[i]; }
    const float rstd = __builtin_amdgcn_rsqf(wave_sum(s2) * (1.f / DH) + LN_EPS);
    float o[8];
#pragma unroll
    for (int i = 0; i < 8; ++i) {
      const int f = f0 + i;
      const float xc = silu_f(p.in[11 + cx.z][(size_t)(j * 3 + 0) * EI + f] * xm0[i] + p.in[11 + cx.z][(size_t)(j * 3 + 1) * EI + f] * xm1[i] + p.in[11 + cx.z][(size_t)(j * 3 + 2) * EI + f] * xm2[i] + p.in[12 + cx.z][(size_t)j * EI + f]);
      o[i] = hv[i] * rstd * p.in[17 + cx.z][(size_t)j * EI + f] + p.in[16 + cx.z][(size_t)j * EI + f] * xc;
    }
    u32x4 ov; ov.x = pk2(o[0], o[1]); ov.y = pk2(o[2], o[3]); ov.z = pk2(o[4], o[5]); ov.w = pk2(o[6], o[7]);
    *(u32x4*)(FIN + (size_t)lr * EI + f0) = ov;
  }
}

__device__ __forceinline__ void at_prep(const Params& p, const Ctx& cx) {
  const int lane = cx.tid & 63, gw = cx.bid * 8 + (cx.tid >> 6), NGW = cx.nb * 8;
  char* ws = cx.ws;
  bf16_t* ACT = (bf16_t*)(ws + O_ACT); bf16_t* KR = (bf16_t*)(ws + O_AKR); bf16_t* VT = (bf16_t*)(ws + O_AVT);
  const float* rc = (const float*)(ws + O_ROPE); const float* rs = rc + 4096 * 32;
  for (int row = gw; row < MROWS; row += NGW) {
    const bool lat = row < NLAT;
    const int b = lat ? row >> 12 : (row - NLAT) >> 8, pos = lat ? row & 4095 : (row - NLAT) & 255, tok = lat ? LC + pos : pos;
    bf16_t* rp = ACT + (size_t)row * 1536;
    {
      const u32x4 a = *(const u32x4*)(rp + 16 * lane), b2 = *(const u32x4*)(rp + 16 * lane + 8);
      const unsigned w[8] = {a.x, a.y, a.z, a.w, b2.x, b2.y, b2.z, b2.w};
      unsigned o[8];
      const int pp0 = (lane & 3) * 8;
#pragma unroll
      for (int i = 0; i < 8; ++i) {
        float x1 = bflo(w[i]) * 0.125f, x2 = bfhi(w[i]) * 0.125f;
        if (lat) { const float c = rc[pos * 32 + pp0 + i], s = rs[pos * 32 + pp0 + i]; const float y1 = x1 * c - x2 * s, y2 = x1 * s + x2 * c; x1 = y1; x2 = y2; }
        o[i] = pk2(x1, x2);
      }
      *(u32x4*)(rp + 16 * lane) = (u32x4){o[0], o[1], o[2], o[3]}; *(u32x4*)(rp + 16 * lane + 8) = (u32x4){o[4], o[5], o[6], o[7]};
    }
    {
      const u32x2 a = *(const u32x2*)(rp + 1024 + 4 * lane);
      const unsigned w[2] = {a.x, a.y}; unsigned o[2];
      const int g = lane >> 4, dd = (lane & 15) * 4, pp0 = dd >> 1;
#pragma unroll
      for (int i = 0; i < 2; ++i) {
        float x1 = bflo(w[i]), x2 = bfhi(w[i]);
        if (lat) { const float c = rc[pos * 32 + pp0 + i], s = rs[pos * 32 + pp0 + i]; const float y1 = x1 * c - x2 * s, y2 = x1 * s + x2 * c; x1 = y1; x2 = y2; }
        o[i] = pk2(x1, x2);
      }
      *(u32x2*)(KR + (((size_t)b * 4 + g) * TOKB + tok) * 64 + dd) = (u32x2){o[0], o[1]};
      const u32x2 v = *(const u32x2*)(rp + 1280 + 4 * lane);
      bf16_t* vp = VT + (((size_t)b * 4 + g) * 64 + dd) * TOKB + tok;
      vp[0] = (bf16_t)(v.x & 0xffff); vp[TOKB] = (bf16_t)(v.x >> 16); vp[2 * TOKB] = (bf16_t)(v.y & 0xffff); vp[3 * TOKB] = (bf16_t)(v.y >> 16);
    }
  }
}

__device__ __forceinline__ void at_core(const Params& p, const Ctx& cx) {
  const int lane = cx.tid & 63, gw = cx.bid * 8 + (cx.tid >> 6), NGW = cx.nb * 8, fr = lane & 15, fq = lane >> 4;
  char* ws = cx.ws;
  const bf16_t* ACT = (const bf16_t*)(ws + O_ACT); const bf16_t* KR = (const bf16_t*)(ws + O_AKR); const bf16_t* VT = (const bf16_t*)(ws + O_AVT);
  bf16_t* O = (bf16_t*)(ws + O_U);
  for (int u = gw; u < (MROWS / 16) * 16; u += NGW) {
    const int hq = u & 15, qb = u >> 4, row0 = qb * 16, g = hq >> 2;
    const bool lat = row0 < NLAT;
    const int b = lat ? row0 >> 12 : (row0 - NLAT) >> 8, q0 = lat ? row0 & 4095 : 0;
    const bf16_t* qp = ACT + (size_t)(row0 + fr) * 1536 + hq * 64 + 8 * fq;
    const bf16x8 qf0 = *(const bf16x8*)qp, qf1 = *(const bf16x8*)(qp + 32);
    const bf16_t* kbase = KR + ((size_t)b * 4 + g) * TOKB * 64;
    const bf16_t* vbase = VT + ((size_t)b * 4 + g) * 64 * TOKB;
    float mrun = p.in[20 + cx.z][hq], lrun = 0.f;
    const float sink = mrun;
    f32x4 oacc[4];
#pragma unroll
    for (int d2 = 0; d2 < 4; ++d2) oacc[d2] = (f32x4){0.f, 0.f, 0.f, 0.f};
    int wlo = 0, whi = -1;
    if (lat) { wlo = max(0, q0 - 128) & ~31; whi = min(SEQ - 1, q0 + 143); }
    const int nwin = lat ? (whi - wlo) / 32 + 1 : 0;
    for (int ti = 0; ti < 8 + nwin; ++ti) {
      const bool isw = ti >= 8;
      const int kpos0 = isw ? wlo + (ti - 8) * 32 : 0;
      const int tk0 = isw ? LC + kpos0 : ti * 32;
      f32x4 s0 = {0.f, 0.f, 0.f, 0.f}, s1 = {0.f, 0.f, 0.f, 0.f};
      {
        const bf16_t* kp = kbase + (size_t)(tk0 + fr) * 64 + 8 * fq;
        s0 = MFMA16(*(const bf16x8*)kp, qf0, s0); s0 = MFMA16(*(const bf16x8*)(kp + 32), qf1, s0);
        s1 = MFMA16(*(const bf16x8*)(kp + 16 * 64), qf0, s1); s1 = MFMA16(*(const bf16x8*)(kp + 16 * 64 + 32), qf1, s1);
      }
      float sv[8]; float tmax = -3.0e38f;
#pragma unroll
      for (int i = 0; i < 8; ++i) {
        float v = i < 4 ? s0[i] : s1[i - 4];
        if (isw) { const int kpos = kpos0 + (i >> 2) * 16 + 4 * fq + (i & 3), dlt = (q0 + fr) - kpos; if (dlt > 128 || dlt < -128) v = -3.0e38f; }
        sv[i] = v; tmax = fmaxf(tmax, v);
      }
      tmax = fmaxf(tmax, __shfl_xor(tmax, 16)); tmax = fmaxf(tmax, __shfl_xor(tmax, 32));
      const float mnew = fmaxf(mrun, tmax), scale = __expf(mrun - mnew);
      mrun = mnew;
      float ps = 0.f; float pv[8];
#pragma unroll
      for (int i = 0; i < 8; ++i) { pv[i] = sv[i] > -1.0e38f ? __expf(sv[i] - mnew) : 0.f; }
      const bf16x8 pf = mk8((u32x4){pk2(pv[0], pv[1]), pk2(pv[2], pv[3]), pk2(pv[4], pv[5]), pk2(pv[6], pv[7])});
      {
        union { bf16x8 b; unsigned u[4]; } cv; cv.b = pf;
#pragma unroll
        for (int i = 0; i < 4; ++i) ps += bflo(cv.u[i]) + bfhi(cv.u[i]);
      }
      lrun = lrun * scale + ps;
      float scq[4];
#pragma unroll
      for (int jj = 0; jj < 4; ++jj) scq[jj] = __shfl(scale, 4 * fq + jj);
#pragma unroll
      for (int d2 = 0; d2 < 4; ++d2) {
        const bf16_t* vp = vbase + (size_t)(d2 * 16 + fr) * TOKB + tk0 + 4 * fq;
        const bf16x8 vfr = mk8(*(const u32x2*)vp, *(const u32x2*)(vp + 16));
        f32x4 o = oacc[d2];
        o[0] *= scq[0]; o[1] *= scq[1]; o[2] *= scq[2]; o[3] *= scq[3];
        oacc[d2] = MFMA16(pf, vfr, o);
      }
    }
    lrun += __shfl_xor(lrun, 16); lrun += __shfl_xor(lrun, 32);
    lrun += __expf(sink - mrun);
    const float inv = __builtin_amdgcn_rcpf(lrun);
    float iq[4];
#pragma unroll
    for (int jj = 0; jj < 4; ++jj) iq[jj] = __shfl(inv, 4 * fq + jj);
#pragma unroll
    for (int d2 = 0; d2 < 4; ++d2)
#pragma unroll
      for (int jj = 0; jj < 4; ++jj)
        O[(size_t)(row0 + 4 * fq + jj) * D + hq * 64 + d2 * 16 + fr] = (bf16_t)(pk2(oacc[d2][jj] * iq[jj], 0.f) & 0xffff);
  }
}

__device__ __forceinline__ void sc_conv(const Params& p, const Ctx& cx) {
  const int gt = cx.bid * 512 + cx.tid, gs = cx.nb * 512;
  const bf16_t* ACT = (const bf16_t*)(cx.ws + O_ACT); bf16_t* O = (bf16_t*)(cx.ws + O_U);
  const float* cw = p.in[23 + cx.z];
  for (int i = gt; i < MROWS * 128; i += gs) {
    const int row = i >> 7, c0 = (i & 127) * 8;
    int pos, seglen;
    if (row < NLAT) { pos = row & (SEQ - 1); seglen = SEQ; } else { pos = (row - NLAT) & (LC - 1); seglen = LC; }
    float accv[8];
#pragma unroll
    for (int e = 0; e < 8; ++e) accv[e] = 0.f;
#pragma unroll
    for (int k = 0; k < 3; ++k) {
      const int pp = pos + k - 1;
      if (pp < 0 || pp >= seglen) continue;
      const bf16_t* rp = ACT + (size_t)(row + k - 1) * 3072;
      const u32x4 cgv = *(const u32x4*)(rp + 1024 + c0), xtv = *(const u32x4*)(rp + 2048 + c0);
      const unsigned cu[4] = {cgv.x, cgv.y, cgv.z, cgv.w}, xu[4] = {xtv.x, xtv.y, xtv.z, xtv.w};
#pragma unroll
      for (int e = 0; e < 4; ++e) {
        accv[2 * e] += cw[k * D + c0 + 2 * e] * (bflo(cu[e]) * bflo(xu[e]));
        accv[2 * e + 1] += cw[k * D + c0 + 2 * e + 1] * (bfhi(cu[e]) * bfhi(xu[e]));
      }
    }
    const u32x4 bgv = *(const u32x4*)(ACT + (size_t)row * 3072 + c0);
    const unsigned bu[4] = {bgv.x, bgv.y, bgv.z, bgv.w};
    u32x4 o;
    o.x = pk2(bflo(bu[0]) * accv[0], bfhi(bu[0]) * accv[1]); o.y = pk2(bflo(bu[1]) * accv[2], bfhi(bu[1]) * accv[3]);
    o.z = pk2(bflo(bu[2]) * accv[4], bfhi(bu[2]) * accv[5]); o.w = pk2(bflo(bu[3]) * accv[6], bfhi(bu[3]) * accv[7]);
    *(u32x4*)(O + (size_t)row * D + c0) = o;
  }
}

#ifndef ENMASK
#define ENMASK 0xffff
#endif
#define EN(i) ((ENMASK >> (i)) & 1)
enum { OP_PRO = 0, OP_LN0, OP_LN1, OP_LNF, OP_FFI, OP_FFO, OP_UP, OP_M0, OP_GAT, OP_S, OP_M2, OP_FIN, OP_DN, OP_AQ, OP_APREP, OP_ACORE, OP_AO, OP_SI, OP_SCONV, OP_SO };
__global__ void __launch_bounds__(512) fwd_megakernel(Params p) {
  cg::grid_group grid = cg::this_grid();
  const int wave_s = __builtin_amdgcn_readfirstlane((int)threadIdx.x >> 6);
  for (int ph = 0; ph < p.nph; ++ph) {
    const unsigned w = p.prog[ph];
    const int op = w & 255, a = (w >> 8) & 255, b = (w >> 16) & 255, c = (w >> 24) & 255;
    int z; asm volatile("s_mov_b32 %0, 0" : "=s"(z));
    char* wsq = p.ws; float* outq = p.out; int bidq = (int)blockIdx.x, nbq = (int)gridDim.x;
    asm volatile("" : "+s"(wsq), "+s"(outq), "+s"(bidq), "+s"(nbq));
    const Ctx cx{wave_s * 64 + (int)__builtin_amdgcn_mbcnt_hi(~0u, __builtin_amdgcn_mbcnt_lo(~0u, (unsigned)z)), bidq, nbq, z, wsq, outq};
    char* ws = cx.ws;
    const RowMap idm{0, 0, 1 << 30};
    bf16_t* U = (bf16_t*)(ws + O_U); bf16_t* ACT = (bf16_t*)(ws + O_ACT);
    const float* MODT = (const float*)(ws + O_MODT);
    if (EN(0) && op == OP_PRO) prologue(p, cx);
    else if (EN(1) && op == OP_LN0) lnmod_phase<0>(p, cx, 0, 0, 0);
    else if (EN(1) && op == OP_LN1) lnmod_phase<1>(p, cx, a, b, c);
    else if (EN(1) && op == OP_LNF) lnmod_phase<2>(p, cx, a, 0, 0);
    else if (EN(2) && op == OP_M0) ml_m0(p, cx, a);
    else if (EN(3) && op == OP_GAT) ml_gates(p, cx, a);
    else if (EN(4) && op == OP_S) ml_s(p, cx);
    else if (EN(5) && op == OP_M2) ml_m2(p, cx);
    else if (EN(6) && op == OP_FIN) ml_fin(p, cx, a);
    else if (EN(7) && op == OP_APREP) at_prep(p, cx);
    else if (EN(8) && op == OP_ACORE) at_core(p, cx);
    else if (EN(9) && op == OP_SCONV) sc_conv(p, cx);
    else if (EN(10)) {
      const bf16_t* A = U; const bf16_t* Bt; int K = 1024, nM = MROWS / 256, nN; RowMap am = idm, cm = idm;
      Epi E; E.kind = 2; E.O = ACT; E.ldc = 0; E.modl = MODT + (size_t)b * 9 * 9216; E.slot = 1; E.wgt = 1.0f;
      if (op == OP_FFI) { Bt = (const bf16_t*)(ws + O_WFI) + (size_t)a * 5632 * 1024; nN = 22; E.kind = 1; }
      else if (op == OP_FFO) { A = ACT; Bt = (const bf16_t*)(ws + O_WFO) + (size_t)a * 1024 * 2816; K = 2816; nN = 4; E.slot = c; E.wgt = 0.5f; }
      else if (op == OP_UP) { Bt = (const bf16_t*)(ws + O_WUP) + (size_t)a * 4096 * 1024; nM = RG / 256; nN = 16; am = RowMap{c * GB * SEQ, NLAT + c * GB * LC, GB * SEQ / 256}; E.kind = 0; E.O = (bf16_t*)(ws + O_XZ); E.ldc = 4096; }
      else if (op == OP_DN) { A = (const bf16_t*)(ws + O_FIN); Bt = (const bf16_t*)(ws + O_WDN) + (size_t)a * 1024 * 2048; K = 2048; nM = RG / 256; nN = 4; cm = RowMap{c * GB * SEQ, NLAT + c * GB * LC, GB * SEQ / 256}; }
      else if (op == OP_AQ) { Bt = (const bf16_t*)(ws + O_WAQ); nN = 6; E.kind = 0; E.ldc = 1536; }
      else if (op == OP_AO) { Bt = (const bf16_t*)(ws + O_WAO); nN = 4; }
      else if (op == OP_SI) { Bt = (const bf16_t*)(ws + O_WSI); nN = 12; E.kind = 0; E.ldc = 3072; }
      else { Bt = (const bf16_t*)(ws + O_WSO); nN = 4; }
      gemm_phase(cx, A, am, Bt, K, nM, nN, cm, E);
    }
    grid.sync();
  }
}

static int build_program(unsigned* prog) {
  int n = 0;
  auto W = [&](int op, int a, int b, int c) { prog[n++] = (unsigned)op | ((unsigned)a << 8) | ((unsigned)b << 16) | ((unsigned)c << 24); };
  W(OP_PRO, 0, 0, 0);
  W(OP_LN0, 0, 0, 0);
  for (int layer = 0; layer < DEPTH; ++layer) {
    const int kind = layer % 3, j = layer / 3;
    W(OP_FFI, layer * 2, layer, 0); W(OP_FFO, layer * 2, layer, 0);
    W(OP_LN1, layer * 3 + 0, layer, 1);
    if (kind == 0) {
      for (int g = 0; g < NG; ++g) { W(OP_UP, j, layer, g); W(OP_M0, j, 0, 0); W(OP_GAT, j, 0, 0); W(OP_S, 0, 0, 0); W(OP_M2, 0, 0, 0); W(OP_FIN, j, 0, 0); W(OP_DN, j, layer, g); }
    } else if (kind == 1) { W(OP_AQ, 0, layer, 0); W(OP_APREP, 0, 0, 0); W(OP_ACORE, 0, 0, 0); W(OP_AO, 0, layer, 0); }
    else { W(OP_SI, 0, layer, 0); W(OP_SCONV, 0, 0, 0); W(OP_SO, 0, layer, 0); }
    W(OP_LN1, layer * 3 + 1, layer, 2);
    W(OP_FFI, layer * 2 + 1, layer, 0); W(OP_FFO, layer * 2 + 1, layer, 2);
    if (layer + 1 < DEPTH) W(OP_LN1, layer * 3 + 2, layer + 1, 0); else W(OP_LNF, layer * 3 + 2, 0, 0);
  }
  return n;
}

extern "C" void kernel_launch(void* const* d_in, const int* in_sizes, int n_in, void* d_out, int out_size, void* d_ws, size_t ws_size, hipStream_t stream) {
  static int grid_blocks = 0;
  if (!grid_blocks) {
    int dev = 0, cus = 0, per_cu = 0;
    (void)hipGetDevice(&dev);
    (void)hipDeviceGetAttribute(&cus, hipDeviceAttributeMultiprocessorCount, dev);
    (void)hipFuncSetAttribute((const void*)fwd_megakernel, hipFuncAttributeMaxDynamicSharedMemorySize, LDS_BYTES);
    (void)hipOccupancyMaxActiveBlocksPerMultiprocessor(&per_cu, fwd_megakernel, 512, LDS_BYTES);
    if (cus <= 0) cus = 256;
    grid_blocks = cus;
    if (ws_size < WS_END || n_in != 25) fprintf(stderr, "kernel_launch: workspace %zu < %zu or n_in %d != 25\n", ws_size, (size_t)WS_END, n_in);
    if (per_cu < 1) fprintf(stderr, "kernel_launch: occupancy query says %d blocks per CU\n", per_cu);
  }
  Params p{};
  for (int i = 0; i < 25; ++i) p.in[i] = (const float*)d_in[i];
  p.out = (float*)d_out; p.ws = (char*)d_ws;
  p.nph = build_program(p.prog);
  void* args[] = {&p};
  hipError_t e = hipLaunchCooperativeKernel((void*)fwd_megakernel, dim3(grid_blocks), dim3(512), args, LDS_BYTES, stream);
  if (e != hipSuccess) fprintf(stderr, "cooperative launch failed: %s (grid %d)\n", hipGetErrorString(e), grid_blocks);
}
```

```cpp
#include <hip/hip_runtime.h>
#include <hip/hip_cooperative_groups.h>
#include <cstdio>
#include <cstdint>
namespace cg = cooperative_groups;

typedef unsigned short bf16_t;
typedef short bf16x8 __attribute__((ext_vector_type(8)));
typedef short bf16x4 __attribute__((ext_vector_type(4)));
typedef float f32x4 __attribute__((ext_vector_type(4)));
typedef unsigned u32x2 __attribute__((ext_vector_type(2)));
typedef unsigned u32x4 __attribute__((ext_vector_type(4)));

constexpr int D = 1024, NB = 8, SEQ = 4096, LC = 256, DEPTH = 4, FF = 2816, EI = 2048, DH = 512;
constexpr int NLAT = NB * SEQ, NCTX = NB * LC, MROWS = NLAT + NCTX;
constexpr int TOKB = LC + SEQ;
constexpr int NCH = TOKB / 64;
constexpr int GB = 2, NG = NB / GB, RG = GB * TOKB;
constexpr int NSEQ = GB * 8;
constexpr float ALPHA = 1.681792830507429f, LN_EPS = 1e-5f;
constexpr int LDS_BYTES = 144 * 1024;

constexpr size_t al256(size_t x) { return (x + 255) & ~(size_t)255; }
constexpr size_t O_WFI = 0;
constexpr size_t O_WFO = O_WFI + (size_t)8 * 5632 * 1024 * 2;
constexpr size_t O_WUP = O_WFO + (size_t)8 * 1024 * 2816 * 2;
constexpr size_t O_WDN = O_WUP + (size_t)2 * 4096 * 1024 * 2;
constexpr size_t O_WAQ = O_WDN + (size_t)2 * 1024 * 2048 * 2;
constexpr size_t O_WAO = O_WAQ + (size_t)1536 * 1024 * 2;
constexpr size_t O_WSI = O_WAO + (size_t)1024 * 1024 * 2;
constexpr size_t O_WSO = O_WSI + (size_t)3072 * 1024 * 2;
constexpr size_t O_WG = O_WSO + (size_t)1024 * 1024 * 2;
constexpr size_t O_MODT = O_WG + (size_t)2 * 16 * 6144 * 2;
constexpr size_t O_ROPE = O_MODT + (size_t)4 * 9 * 9216 * 4;
constexpr size_t O_HCTX = O_ROPE + (size_t)2 * 4096 * 32 * 4;
constexpr size_t O_U = O_HCTX + (size_t)NCTX * D * 4;
constexpr size_t O_R = O_U + (size_t)MROWS * D * 2;
constexpr size_t O_XZ = O_R;
constexpr size_t O_QK = O_XZ + (size_t)RG * 4096 * 2;
constexpr size_t O_KT = O_QK + (size_t)RG * 4096 * 2;
constexpr size_t O_VT = O_KT + (size_t)GB * EI * TOKB * 2;
constexpr size_t O_SP = O_VT + (size_t)GB * EI * TOKB * 2;
constexpr size_t O_HD = O_SP + (size_t)NSEQ * NCH * 4096 * 2;
constexpr size_t O_FIN = O_HD + (size_t)2 * RG * EI * 2;
constexpr size_t O_GAT = O_FIN + (size_t)RG * EI * 2;
constexpr size_t SZ_ST = (size_t)NSEQ * TOKB * 4;
constexpr size_t O_BL = O_GAT, O_IG = O_BL + SZ_ST, O_WIN = O_IG + SZ_ST, O_FLO = O_WIN + SZ_ST, O_DEN = O_FLO + SZ_ST, O_WSS = O_DEN + SZ_ST;
constexpr size_t O_GC = O_WSS + SZ_ST;
constexpr size_t O_REND_ML = O_GC + (size_t)3 * NSEQ * NCH * 4 + 256;
constexpr size_t O_ACT = O_R;
constexpr size_t O_AKR = O_R + (size_t)MROWS * 3072 * 2;
constexpr size_t O_AVT = O_AKR + (size_t)NB * 4 * TOKB * 64 * 2;
constexpr size_t O_REND_AT = O_AVT + (size_t)NB * 4 * TOKB * 64 * 2;
constexpr size_t O_BAR = (O_REND_ML > O_REND_AT ? O_REND_ML : O_REND_AT);
constexpr size_t WS_END = O_BAR + 3456 * 4 + 256;

struct Params {
  const float* in[25];
  float* out;
  char* ws;
  int nph; int pad0;
  unsigned prog[126];
};

#define GAS __attribute__((address_space(1)))
#define IN(k) ((const float*)(const GAS float*)p.in[(k) + cx.z])
struct Ctx { int tid, bid, nb, z; char* ws; float* out; };
extern __shared__ __attribute__((aligned(16))) char lds_raw[];

__device__ __forceinline__ unsigned pk2(float lo, float hi) { unsigned r; asm volatile("v_cvt_pk_bf16_f32 %0, %1, %2" : "=v"(r) : "v"(lo), "v"(hi)); return r; }
__device__ __forceinline__ float bf2f(unsigned short v) { return __uint_as_float(((unsigned)v) << 16); }
__device__ __forceinline__ float bflo(unsigned v) { return __uint_as_float(v << 16); }
__device__ __forceinline__ float bfhi(unsigned v) { return __uint_as_float(v & 0xffff0000u); }
__device__ __forceinline__ float silu_f(float x) { return x * __builtin_amdgcn_rcpf(1.f + __expf(-x)); }
__device__ __forceinline__ float sigm_f(float x) { return __builtin_amdgcn_rcpf(1.f + __expf(-x)); }
__device__ __forceinline__ float shi(float v, int srclane) { return __int_as_float(__builtin_amdgcn_ds_bpermute(srclane << 2, __float_as_int(v))); }
__device__ __forceinline__ float shx(float v, int m, int lane) { return shi(v, lane ^ m); }
__device__ __forceinline__ float wave_sum(float v, int lane) {
#pragma unroll
  for (int o = 1; o < 64; o <<= 1) v += shx(v, o, lane);
  return v;
}
__device__ __forceinline__ bf16x8 mk8(u32x4 v) { union { u32x4 u; bf16x8 b; } x; x.u = v; return x.b; }
__device__ __forceinline__ bf16x8 mk8(u32x2 a, u32x2 b) { union { u32x4 u; bf16x8 b; } x; x.u = (u32x4){a.x, a.y, b.x, b.y}; return x.b; }
__device__ __forceinline__ float* hrow(const Ctx& cx, int row) { return row < NLAT ? cx.out + (size_t)row * D : (float*)(cx.ws + O_HCTX) + (size_t)(row - NLAT) * D; }
#define MFMA16(a, b, c) __builtin_amdgcn_mfma_f32_16x16x32_bf16(a, b, c, 0, 0, 0)

constexpr int BM = 256, BK = 64, HALF = 128, HT = HALF * BK, NXCD = 8, WGM = 8;
__device__ __forceinline__ int lds_byte(int r, int c) {
  int st = (r >> 4) * 2 + (c >> 5), rr = r & 15, cc = c & 31, ob = rr * 64 + cc * 2;
  return st * 1024 + (ob ^ (((ob >> 9) & 1) << 5));
}
__device__ __forceinline__ void stage_rc(int b, int& R, int& C) {
  int st = b / 1024, sb = b % 1024, swz = sb ^ (((sb >> 9) & 1) << 5);
  R = (st >> 1) * 16 + swz / 64; C = (st & 1) * 32 + (swz % 64) / 2;
}
struct RowMap { int lat0, ctx0, nlat; __device__ __forceinline__ int row0(int pm) const { return pm < nlat ? lat0 + pm * 256 : ctx0 + (pm - nlat) * 256; } };

typedef f32x4 Acc[2][2][4][2];

struct Epi {
  int kind; bf16_t* O; int ldc; const float* modl; int slot; float wgt;
};
__device__ __forceinline__ void run_epi(const Ctx& cx, const Epi& E, const Acc& acc, int r0, int pn, int wr, int wc, int fr, int fq) {
  if (E.kind == 0) {
#pragma unroll
    for (int ai = 0; ai < 2; ++ai)
#pragma unroll
      for (int m = 0; m < 4; ++m) {
        bf16_t* rp = E.O + (size_t)(r0 + ai * HALF + wr * 64 + m * 16 + fr) * E.ldc + pn * 256 + wc * 32 + 4 * fq;
#pragma unroll
        for (int bj = 0; bj < 2; ++bj)
#pragma unroll
          for (int n = 0; n < 2; ++n) {
            f32x4 v = acc[ai][bj][m][n];
            u32x2 o; o.x = pk2(v[0], v[1]); o.y = pk2(v[2], v[3]);
            *(u32x2*)(rp + bj * HALF + n * 16) = o;
          }
      }
  } else if (E.kind == 1) {
#pragma unroll
    for (int ai = 0; ai < 2; ++ai)
#pragma unroll
      for (int m = 0; m < 4; ++m) {
        bf16_t* rp = E.O + (size_t)(r0 + ai * HALF + wr * 64 + m * 16 + fr) * FF + pn * 128 + wc * 16 + 4 * fq;
#pragma unroll
        for (int bj = 0; bj < 2; ++bj) {
          f32x4 g = acc[ai][bj][m][0], v = acc[ai][bj][m][1];
          u32x2 o; o.x = pk2(silu_f(g[0]) * v[0], silu_f(g[1]) * v[1]); o.y = pk2(silu_f(g[2]) * v[2], silu_f(g[3]) * v[3]);
          *(u32x2*)(rp + bj * 64) = o;
        }
      }
  } else {
    const int midx = r0 < NLAT ? (r0 >> 12) : 8;
    const float* gp = E.modl + (size_t)midx * 9216 + (3 * E.slot + 2) * D + pn * 256 + wc * 32 + 4 * fq;
    f32x4 gv[2][2];
#pragma unroll
    for (int bj = 0; bj < 2; ++bj)
#pragma unroll
      for (int n = 0; n < 2; ++n) gv[bj][n] = *(const f32x4*)(gp + bj * HALF + n * 16) * E.wgt;
#pragma unroll
    for (int ai = 0; ai < 2; ++ai)
#pragma unroll
      for (int m = 0; m < 4; ++m) {
        float* rp = hrow(cx, r0 + ai * HALF + wr * 64 + m * 16 + fr) + pn * 256 + wc * 32 + 4 * fq;
        f32x4 h[2][2];
#pragma unroll
        for (int bj = 0; bj < 2; ++bj)
#pragma unroll
          for (int n = 0; n < 2; ++n) h[bj][n] = *(const f32x4*)(rp + bj * HALF + n * 16);
#pragma unroll
        for (int bj = 0; bj < 2; ++bj)
#pragma unroll
          for (int n = 0; n < 2; ++n) *(f32x4*)(rp + bj * HALF + n * 16) = h[bj][n] * ALPHA + gv[bj][n] * acc[ai][bj][m][n];
        __builtin_amdgcn_sched_barrier(0);
      }
  }
}

#define LAS __attribute__((address_space(3)))
__device__ __forceinline__ void gemm_phase(const Ctx& cx, const bf16_t* __restrict__ A, RowMap am, const bf16_t* __restrict__ Bt, int K, int nM, int nN, RowMap cm, const Epi& epi) {
  LAS unsigned char* lds = (LAS unsigned char*)lds_raw;
  constexpr int HTB = HT * 2;
  const int tid = cx.tid, wid = tid >> 6, lane = tid & 63, wr = wid >> 2, wc = wid & 3, fr = lane & 15, fq = lane >> 4;
  unsigned voff[2];
#pragma unroll
  for (int i = 0; i < 2; ++i) { int R, C; stage_rc(tid * 16 + i * 8192, R, C); voff[i] = (unsigned)(R * K + C) * 2u; }
  const size_t kstep = (size_t)(BK * 2), hstep = (size_t)HALF * K * 2;
  const unsigned ldsw = (unsigned)wid * 1024u;
  const int aoff = lds_byte(wr * 64 + fr, fq * 8), boff = lds_byte(wc * 32 + fr, fq * 8);
#define G_SA(b, h) (((b) * 2 + (h)) * HTB)
#define G_SB(b, h) ((4 + (b) * 2 + (h)) * HTB)
#define STAGE(bufoff, gbase) do { _Pragma("unroll") for (int _i = 0; _i < 2; ++_i) \
    __builtin_amdgcn_global_load_lds((const unsigned*)((const char*)(gbase) + voff[_i]), (LAS unsigned*)(lds + (bufoff) + ldsw + _i * 8192), 16, 0, 0); } while (0)
#define LDA(dst, b, h) do { _Pragma("unroll") for (int m = 0; m < 4; ++m) _Pragma("unroll") for (int k = 0; k < 2; ++k) dst[m][k] = *(const LAS bf16x8*)(lds + G_SA(b, h) + aoff + m * 2048 + k * 1024); } while (0)
#define LDB(dst, b, h) do { _Pragma("unroll") for (int n = 0; n < 2; ++n) _Pragma("unroll") for (int k = 0; k < 2; ++k) dst[n][k] = *(const LAS bf16x8*)(lds + G_SB(b, h) + boff + n * 2048 + k * 1024); } while (0)
#define MMA(ai, bj, At, Bt_) do { __builtin_amdgcn_s_setprio(1); _Pragma("unroll") for (int m = 0; m < 4; ++m) _Pragma("unroll") for (int n = 0; n < 2; ++n) _Pragma("unroll") for (int k = 0; k < 2; ++k) \
      acc[ai][bj][m][n] = MFMA16(Bt_[n][k], At[m][k], acc[ai][bj][m][n]); \
    __builtin_amdgcn_s_setprio(0); } while (0)
#define WAIT_V(n) asm volatile("s_waitcnt vmcnt(" #n ")" ::: "memory")
#define WAIT_L(n) asm volatile("s_waitcnt lgkmcnt(" #n ")" ::: "memory")
#define BAR __builtin_amdgcn_s_barrier()
#define SCHED __builtin_amdgcn_sched_barrier(0)
  const int nwg = nM * nN;
  const int nt = K / BK;
  const int wid_s = __builtin_amdgcn_readfirstlane(wid);
  for (int L = cx.bid; L < nwg; L += cx.nb) {
    int wgid = L;
    { int q = nwg / NXCD, r = nwg % NXCD, xcd = wgid % NXCD, off = wgid / NXCD; wgid = (xcd < r ? xcd * (q + 1) : r * (q + 1) + (xcd - r) * q) + off; }
    const int nig = WGM * nN, gid = wgid / nig, fm = gid * WGM, gsz = min(nM - fm, WGM);
    const int pm = fm + ((wgid % nig) % gsz), pn = (wgid % nig) / gsz;
    asm volatile("" : "+v"(voff[0]), "+v"(voff[1]));
    const char* cA = (const char*)A + (size_t)am.row0(pm) * K * 2; const char* cB = (const char*)Bt + (size_t)pn * BM * K * 2;
    Acc acc;
#pragma unroll
    for (int a = 0; a < 2; ++a)
#pragma unroll
      for (int b = 0; b < 2; ++b)
#pragma unroll
        for (int m = 0; m < 4; ++m)
#pragma unroll
          for (int n = 0; n < 2; ++n) acc[a][b][m][n] = (f32x4){0.f, 0.f, 0.f, 0.f};
    bf16x8 At[4][2], B0[2][2], B1[2][2];
    STAGE(G_SB(0, 0), cB); STAGE(G_SA(0, 0), cA); STAGE(G_SB(0, 1), cB + hstep); STAGE(G_SA(0, 1), cA + hstep);
    if (wr == 1) BAR;
    WAIT_V(4); BAR;
    STAGE(G_SB(1, 0), cB + kstep); STAGE(G_SA(1, 0), cA + kstep); STAGE(G_SB(1, 1), cB + hstep + kstep);
    WAIT_V(6); BAR;
    for (int t = 0; t < nt - 2; t += 2) {
      const char* a1 = cA + (size_t)(t + 1) * kstep; const char* a2 = a1 + kstep; const char* a3 = a2 + kstep;
      const char* b2 = cB + (size_t)(t + 2) * kstep; const char* b3 = b2 + kstep;
      LDB(B0, 0, 0); SCHED; LDA(At, 0, 0); STAGE(G_SA(1, 1), a1 + hstep);
      WAIT_L(8); BAR; WAIT_L(0); MMA(0, 0, At, B0); BAR; SCHED;
      LDB(B1, 0, 1); STAGE(G_SB(0, 0), b2);
      BAR; WAIT_L(0); MMA(0, 1, At, B1); BAR;
      LDA(At, 0, 1); STAGE(G_SA(0, 0), a2);
      BAR; WAIT_L(0); MMA(1, 0, At, B0); BAR; SCHED;
      STAGE(G_SB(0, 1), b2 + hstep);
      WAIT_V(6); BAR; MMA(1, 1, At, B1); BAR;
      LDB(B0, 1, 0); SCHED; LDA(At, 1, 0); STAGE(G_SA(0, 1), a2 + hstep);
      WAIT_L(8); BAR; WAIT_L(0); MMA(0, 0, At, B0); BAR; SCHED;
      LDB(B1, 1, 1); STAGE(G_SB(1, 0), b3);
      BAR; WAIT_L(0); MMA(0, 1, At, B1); BAR;
      LDA(At, 1, 1); STAGE(G_SA(1, 0), a3);
      BAR; WAIT_L(0); MMA(1, 0, At, B0); BAR; SCHED;
      STAGE(G_SB(1, 1), b3 + hstep);
      WAIT_V(6); BAR; MMA(1, 1, At, B1); BAR;
    }
    { LDB(B0, 0, 0); LDA(At, 0, 0); STAGE(G_SA(1, 1), cA + (size_t)(nt - 1) * kstep + hstep);
      BAR; WAIT_L(0); MMA(0, 0, At, B0); BAR;
      LDB(B1, 0, 1); BAR; WAIT_L(0); MMA(0, 1, At, B1); BAR;
      LDA(At, 0, 1); WAIT_V(4); BAR; WAIT_L(0); MMA(1, 0, At, B0); MMA(1, 1, At, B1); BAR; }
    { LDB(B0, 1, 0); LDA(At, 1, 0); WAIT_V(2); BAR; WAIT_L(0); MMA(0, 0, At, B0); BAR;
      LDB(B1, 1, 1); WAIT_V(0); BAR; WAIT_L(0); MMA(0, 1, At, B1); BAR;
      LDA(At, 1, 1); BAR; WAIT_L(0); MMA(1, 0, At, B0); MMA(1, 1, At, B1); BAR; }
    if (wr == 0) BAR;
    { int t2 = wid_s * 64 + (int)__builtin_amdgcn_mbcnt_hi(~0u, __builtin_amdgcn_mbcnt_lo(~0u, (unsigned)cx.z)); asm volatile("" : "+v"(t2));
      const int w2 = t2 >> 6, l2 = t2 & 63;
      run_epi(cx, epi, acc, cm.row0(pm), pn, w2 >> 2, w2 & 3, l2 & 15, l2 >> 4); }
  }
  __syncthreads();
}

template <int MODE>
__device__ __forceinline__ int wrow(int c) {
  if (MODE == 0) return c;
  const int isv = c >= FF ? 1 : 0, f = c - isv * FF;
  return (f >> 7) * 256 + ((f >> 6) & 1) * 128 + ((f >> 4) & 3) * 32 + isv * 16 + (f & 15);
}
template <int MODE>
__device__ __forceinline__ void transpose_item(const float* __restrict__ W, int K, int N, bf16_t* __restrict__ WT, float* scr, int item, int lane) {
  const int nblk = N / 32, kb = item / nblk, nb = item % nblk, k0 = 64 * kb, n0 = 32 * nb;
#pragma unroll 8
  for (int i = 0; i < 32; ++i) { const int kk = 2 * i + (lane >> 5); scr[kk * 33 + (lane & 31)] = W[(size_t)(k0 + kk) * N + n0 + (lane & 31)]; }
  __builtin_amdgcn_wave_barrier(); asm volatile("s_waitcnt lgkmcnt(0)" ::: "memory");
  const int c = lane & 7;
#pragma unroll
  for (int j = 0; j < 4; ++j) {
    const int n = (lane >> 3) + 8 * j; const float* s = scr + (8 * c) * 33 + n;
    u32x4 o; o.x = pk2(s[0 * 33], s[1 * 33]); o.y = pk2(s[2 * 33], s[3 * 33]); o.z = pk2(s[4 * 33], s[5 * 33]); o.w = pk2(s[6 * 33], s[7 * 33]);
    *(u32x4*)(WT + (size_t)wrow<MODE>(n0 + n) * K + k0 + 8 * c) = o;
  }
  asm volatile("s_waitcnt lgkmcnt(0)" ::: "memory"); __builtin_amdgcn_wave_barrier();
}

__device__ __forceinline__ void prologue(const Params& p, const Ctx& cx) {
  const int tid = cx.tid, lane = tid & 63, wave = tid >> 6;
  char* ws = cx.ws;
  {
    float* cond = (float*)lds_raw;
    float* red = (float*)(lds_raw + 9 * 1024 * 4);
    for (int i = tid; i < 9 * 1024; i += 512) { const int j = i >> 10, k = i & 1023; cond[i] = silu_f(j < 8 ? IN(1)[j * 1024 + k] : IN(3)[k]); }
    __syncthreads();
    for (int u = cx.bid; u < 4 * 36; u += cx.nb) {
      const int layer = u / 36, ct = u % 36, c0 = ct * 256 + 4 * lane;
      const float* wp = IN(4) + (size_t)layer * D * 9216 + c0;
      f32x4 a[9];
#pragma unroll
      for (int j = 0; j < 9; ++j) a[j] = (f32x4){0.f, 0.f, 0.f, 0.f};
#pragma unroll 4
      for (int k = wave * 128; k < wave * 128 + 128; ++k) {
        const f32x4 w = *(const f32x4*)(wp + (size_t)k * 9216);
#pragma unroll
        for (int j = 0; j < 9; ++j) a[j] += w * cond[j * 1024 + k];
      }
#pragma unroll
      for (int j = 0; j < 9; ++j) *(f32x4*)(red + (wave * 9 + j) * 256 + 4 * lane) = a[j];
      __syncthreads();
      float* mt = (float*)(ws + O_MODT) + (size_t)layer * 9 * 9216;
      for (int i = tid; i < 9 * 256; i += 512) {
        const int j = i >> 8, c = i & 255; float s = 0.f;
#pragma unroll
        for (int w = 0; w < 8; ++w) s += red[(w * 9 + j) * 256 + c];
        mt[(size_t)j * 9216 + ct * 256 + c] = s + IN(5)[layer * 9216 + ct * 256 + c];
      }
      __syncthreads();
    }
    __syncthreads();
  }
  {
    float* scr = (float*)lds_raw + wave * (64 * 33);
    const int gw = cx.bid * 8 + wave, NGW = cx.nb * 8;
    constexpr int I_FI = 16 * 176, I_FO = 44 * 32, I_UP = 16 * 128, I_DN = 32 * 32, I_AQ = 16 * 48, I_AO = 16 * 32, I_SI = 16 * 96, I_SO = 16 * 32;
    constexpr int NITEMS = 8 * I_FI + 8 * I_FO + 2 * I_UP + 2 * I_DN + I_AQ + I_AO + I_SI + I_SO;
    for (int it = gw; it < NITEMS; it += NGW) {
      int r = it;
      if (r < 8 * I_FI) { const int mi = r / I_FI; transpose_item<1>(IN(8) + (size_t)mi * 1024 * 5632, 1024, 5632, (bf16_t*)(ws + O_WFI) + (size_t)mi * 5632 * 1024, scr, r % I_FI, lane); continue; } r -= 8 * I_FI;
      if (r < 8 * I_FO) { const int mi = r / I_FO; transpose_item<0>(IN(9) + (size_t)mi * 2816 * 1024, 2816, 1024, (bf16_t*)(ws + O_WFO) + (size_t)mi * 1024 * 2816, scr, r % I_FO, lane); continue; } r -= 8 * I_FO;
      if (r < 2 * I_UP) { const int mi = r / I_UP; transpose_item<0>(IN(10) + (size_t)mi * 1024 * 4096, 1024, 4096, (bf16_t*)(ws + O_WUP) + (size_t)mi * 4096 * 1024, scr, r % I_UP, lane); continue; } r -= 2 * I_UP;
      if (r < 2 * I_DN) { const int mi = r / I_DN; transpose_item<0>(IN(18) + (size_t)mi * 2048 * 1024, 2048, 1024, (bf16_t*)(ws + O_WDN) + (size_t)mi * 1024 * 2048, scr, r % I_DN, lane); continue; } r -= 2 * I_DN;
      if (r < I_AQ) { transpose_item<0>(IN(19), 1024, 1536, (bf16_t*)(ws + O_WAQ), scr, r, lane); continue; } r -= I_AQ;
      if (r < I_AO) { transpose_item<0>(IN(21), 1024, 1024, (bf16_t*)(ws + O_WAO), scr, r, lane); continue; } r -= I_AO;
      if (r < I_SI) { transpose_item<0>(IN(22), 1024, 3072, (bf16_t*)(ws + O_WSI), scr, r, lane); continue; } r -= I_SI;
      transpose_item<0>(IN(24), 1024, 1024, (bf16_t*)(ws + O_WSO), scr, r, lane);
    }
  }
  {
    const int gt = cx.bid * 512 + tid, gs = cx.nb * 512;
    bf16_t* wg = (bf16_t*)(ws + O_WG);
    for (int i = gt; i < 2 * 16 * 6144; i += gs) {
      const int j = i / (16 * 6144), xg = (i / 6144) & 15, k = i % 6144, x = xg >> 3, g = xg & 7;
      const float* wif = IN(14) + (size_t)(j * 2 + x) * 6144 * 8;
      float v;
      if (k < 2048) v = wif[(size_t)k * 8 + g];
      else if (k < 4096) v = wif[(size_t)k * 8 + g] * 22.627416997969522f;
      else {
        const int c = k - 4096, blk = c >> 2, cc = c & 3;
        const float* wv = IN(13) + ((size_t)(j * 3 + 2) * 512 + blk) * 16 + cc * 4;
        v = 0.f;
        for (int d2 = 0; d2 < 4; ++d2) v += wv[d2] * wif[(size_t)(4096 + 4 * blk + d2) * 8 + g];
      }
      wg[i] = (bf16_t)(pk2(v, 0.f) & 0xffff);
    }
    float* rc = (float*)(ws + O_ROPE); float* rs = rc + 4096 * 32;
    for (int i = gt; i < 4096 * 32; i += gs) {
      const int pos = i >> 5, pp = i & 31, jf = pp & 15;
      const float fr_ = __builtin_amdgcn_exp2f(-(float)jf * (13.287712379549449f / 16.f));
      float rev = (float)(pp < 16 ? (pos >> 6) : (pos & 63)) * fr_ * 0.15915494309189535f;
      rev -= rintf(rev);
      rc[i] = __builtin_amdgcn_cosf(rev); rs[i] = __builtin_amdgcn_sinf(rev);
    }
  }
}

template <int MODE>
__device__ __forceinline__ void lnmod_phase(const Params& p, const Ctx& cx, int lnidx  , int layer, int slot) {
  const int lane = cx.tid & 63, gw = cx.bid * 8 + (cx.tid >> 6), NGW = cx.nb * 8;
  const int nrows = MODE == 2 ? NLAT : MROWS;
  const float* lg = IN(6) + (size_t)lnidx * D; const float* lb = IN(7) + (size_t)lnidx * D;
  const float* modl = (const float*)(cx.ws + O_MODT) + (size_t)layer * 9 * 9216;
  bf16_t* U = (bf16_t*)(cx.ws + O_U);
  for (int row = gw; row < nrows; row += NGW) {
    float* hp = hrow(cx, row);
    const float* src = MODE == 0 ? (row < NLAT ? IN(0) + (size_t)row * D : IN(2) + (size_t)(row - NLAT) * D) : hp;
    f32x4 v[4];
#pragma unroll
    for (int j = 0; j < 4; ++j) v[j] = *(const f32x4*)(src + 4 * lane + 256 * j);
    if (MODE != 0) {
      float s = 0.f;
#pragma unroll
      for (int j = 0; j < 4; ++j) s += (v[j][0] + v[j][1]) + (v[j][2] + v[j][3]);
      const float mean = wave_sum(s, lane) * (1.f / D); float s2 = 0.f;
#pragma unroll
      for (int j = 0; j < 4; ++j) { v[j] = v[j] - mean; s2 += (v[j][0] * v[j][0] + v[j][1] * v[j][1]) + (v[j][2] * v[j][2] + v[j][3] * v[j][3]); }
      const float rstd = __builtin_amdgcn_rsqf(wave_sum(s2, lane) * (1.f / D) + LN_EPS);
#pragma unroll
      for (int j = 0; j < 4; ++j) v[j] = v[j] * rstd * *(const f32x4*)(lg + 4 * lane + 256 * j) + *(const f32x4*)(lb + 4 * lane + 256 * j);
    }
#pragma unroll
    for (int j = 0; j < 4; ++j) *(f32x4*)(hp + 4 * lane + 256 * j) = v[j];
    if (MODE != 2) {
      const int midx = row < NLAT ? (row >> 12) : 8;
      const float* sh = modl + (size_t)midx * 9216 + (3 * slot) * D; const float* sc = sh + D;
#pragma unroll
      for (int j = 0; j < 4; ++j) {
        const f32x4 u = v[j] * (*(const f32x4*)(sc + 4 * lane + 256 * j) + 1.f) + *(const f32x4*)(sh + 4 * lane + 256 * j);
        u32x2 o; o.x = pk2(u[0], u[1]); o.y = pk2(u[2], u[3]);
        *(u32x2*)(U + (size_t)row * D + 4 * lane + 256 * j) = o;
      }
    }
  }
}

__device__ __forceinline__ int ml_lrow(int bl, int tok) { return tok < LC ? GB * SEQ + bl * LC + tok : bl * SEQ + (tok - LC); }
__device__ __forceinline__ int ml_nchunk(int x, int st) { return x == 0 ? st : (st < 4 ? 3 - st : 71 - st); }

__device__ __forceinline__ void ml_m0(const Params& p, const Ctx& cx, int j) {
  const int tid = cx.tid;
  char* ws = cx.ws;
  const bf16_t* XZ = (const bf16_t*)(ws + O_XZ);
  bf16_t* QK = (bf16_t*)(ws + O_QK); bf16_t* KT = (bf16_t*)(ws + O_KT); bf16_t* VT = (bf16_t*)(ws + O_VT);
  bf16_t* lk = (bf16_t*)lds_raw;
  bf16_t* lv = lk + 256 * 72;
  const int blk_l = tid & 63, tq = tid >> 6;
  for (int u = cx.bid; u < GB * NCH * 8; u += cx.nb) {
    const int slab = u & 7, ch = (u >> 3) % NCH, bl = u / (8 * NCH);
    const int f0 = slab * 256 + blk_l * 4, blk = f0 >> 2;
    float cw[3][4], cb[4], wq[16], wk[16], wv[16];
#pragma unroll
    for (int k = 0; k < 3; ++k)
#pragma unroll
      for (int c = 0; c < 4; ++c) cw[k][c] = IN(11)[(size_t)(j * 3 + k) * EI + f0 + c];
#pragma unroll
    for (int c = 0; c < 4; ++c) cb[c] = IN(12)[(size_t)j * EI + f0 + c];
#pragma unroll
    for (int i = 0; i < 16; ++i) {
      wq[i] = IN(13)[((size_t)(j * 3 + 0) * 512 + blk) * 16 + i];
      wk[i] = IN(13)[((size_t)(j * 3 + 1) * 512 + blk) * 16 + i] * 0.04419417382415922f;
      wv[i] = IN(13)[((size_t)(j * 3 + 2) * 512 + blk) * 16 + i];
    }
    const int tok0 = ch * 64, seg_lo = tok0 < LC ? 0 : LC, seg_hi = tok0 < LC ? LC : TOKB;
    for (int tt = 0; tt < 8; ++tt) {
      const int tl = tq + 8 * tt, tok = tok0 + tl;
      float xm[3][4];
#pragma unroll
      for (int k = 0; k < 3; ++k) {
        const int t2 = tok + k - 1;
        if (t2 >= seg_lo && t2 < seg_hi) {
          const u32x2 r = *(const u32x2*)(XZ + (size_t)ml_lrow(bl, t2) * 4096 + f0);
          xm[k][0] = bflo(r.x); xm[k][1] = bfhi(r.x); xm[k][2] = bflo(r.y); xm[k][3] = bfhi(r.y);
        } else { xm[k][0] = xm[k][1] = xm[k][2] = xm[k][3] = 0.f; }
      }
      float xc[4], q[4], kk[4], vv[4];
#pragma unroll
      for (int c = 0; c < 4; ++c) xc[c] = silu_f(cw[0][c] * xm[0][c] + cw[1][c] * xm[1][c] + cw[2][c] * xm[2][c] + cb[c]);
#pragma unroll
      for (int d2 = 0; d2 < 4; ++d2) {
        q[d2] = xc[0] * wq[d2] + xc[1] * wq[4 + d2] + xc[2] * wq[8 + d2] + xc[3] * wq[12 + d2];
        kk[d2] = xc[0] * wk[d2] + xc[1] * wk[4 + d2] + xc[2] * wk[8 + d2] + xc[3] * wk[12 + d2];
        vv[d2] = xm[1][0] * wv[d2] + xm[1][1] * wv[4 + d2] + xm[1][2] * wv[8 + d2] + xm[1][3] * wv[12 + d2];
      }
      const size_t lr = ml_lrow(bl, tok);
      u32x2 oq, ok, ov; oq.x = pk2(q[0], q[1]); oq.y = pk2(q[2], q[3]); ok.x = pk2(kk[0], kk[1]); ok.y = pk2(kk[2], kk[3]); ov.x = pk2(vv[0], vv[1]); ov.y = pk2(vv[2], vv[3]);
      *(u32x2*)(QK + lr * 4096 + f0) = oq;
      *(u32x2*)(QK + lr * 4096 + 2048 + f0) = ok;
      const int fl = blk_l * 4;
      lk[(fl + 0) * 72 + tl] = (bf16_t)(ok.x & 0xffff); lk[(fl + 1) * 72 + tl] = (bf16_t)(ok.x >> 16); lk[(fl + 2) * 72 + tl] = (bf16_t)(ok.y & 0xffff); lk[(fl + 3) * 72 + tl] = (bf16_t)(ok.y >> 16);
      lv[(fl + 0) * 72 + tl] = (bf16_t)(ov.x & 0xffff); lv[(fl + 1) * 72 + tl] = (bf16_t)(ov.x >> 16); lv[(fl + 2) * 72 + tl] = (bf16_t)(ov.y & 0xffff); lv[(fl + 3) * 72 + tl] = (bf16_t)(ov.y >> 16);
    }
    __syncthreads();
    {
      const int arr = tid >> 8, fr_ = tid & 255;
      const bf16_t* src = (arr ? lv : lk) + fr_ * 72;
      bf16_t* dst = (arr ? VT : KT) + ((size_t)bl * EI + slab * 256 + fr_) * TOKB + tok0;
#pragma unroll
      for (int i = 0; i < 8; ++i) *(u32x4*)(dst + 8 * i) = *(const u32x4*)(src + 8 * i);
    }
    __syncthreads();
  }
}

__device__ __forceinline__ void ml_gates(const Params& p, const Ctx& cx, int j) {
  const int tid = cx.tid, lane = tid & 63, wave = tid >> 6, fr = lane & 15, fq = lane >> 4;
  char* ws = cx.ws;
  const bf16_t* XZ = (const bf16_t*)(ws + O_XZ); const bf16_t* QK = (const bf16_t*)(ws + O_QK);
  const bf16_t* WG = (const bf16_t*)(ws + O_WG) + (size_t)j * 16 * 6144;
  float* BL = (float*)(ws + O_BL); float* IG = (float*)(ws + O_IG);
  float* GC = (float*)(ws + O_GC); float* AC = GC + NSEQ * NCH;
  float* part = (float*)lds_raw;
  float* gl = part + 8 * 64 * 16;
  for (int u = cx.bid; u < GB * NCH; u += cx.nb) {
    const int bl = u / NCH, nc = u % NCH, tok0 = nc * 64;
    f32x4 acc[4];
#pragma unroll
    for (int m = 0; m < 4; ++m) acc[m] = (f32x4){0.f, 0.f, 0.f, 0.f};
    size_t lr[4];
#pragma unroll
    for (int m = 0; m < 4; ++m) lr[m] = ml_lrow(bl, tok0 + m * 16 + fr);
#pragma unroll 4
    for (int ks = wave * 24; ks < wave * 24 + 24; ++ks) {
      const int k = ks * 32 + fq * 8;
      const bf16x8 bfr = *(const bf16x8*)(WG + (size_t)fr * 6144 + k);
#pragma unroll
      for (int m = 0; m < 4; ++m) {
        const bf16_t* ap = k < 4096 ? QK + lr[m] * 4096 + k : XZ + lr[m] * 4096 + (k - 4096);
        const bf16x8 afr = *(const bf16x8*)ap;
        acc[m] = MFMA16(afr, bfr, acc[m]);
      }
    }
#pragma unroll
    for (int m = 0; m < 4; ++m)
#pragma unroll
      for (int jj = 0; jj < 4; ++jj) part[(wave * 64 + m * 16 + 4 * fq + jj) * 16 + fr] = acc[m][jj];
    __syncthreads();
    for (int i = tid; i < 1024; i += 512) {
      float s = IN(15)[(size_t)j * 16 + (i & 15)];
#pragma unroll
      for (int w = 0; w < 8; ++w) s += part[w * 1024 + i];
      gl[(i >> 4) * 17 + (i & 15)] = s;
    }
    __syncthreads();
    if (tid < 8) {
      const int x = tid >> 2, h = tid & 3, seq = (bl * 2 + x) * 4 + h;
      float b = 0.f, mx = -3.0e38f;
      for (int pp = 0; pp < 64; ++pp) {
        const int tl = x == 0 ? pp : 63 - pp;
        const float ig = gl[tl * 17 + x * 8 + h], fg = gl[tl * 17 + x * 8 + 4 + h];
        const float lf = fg > 0.f ? -__logf(1.f + __expf(-fg)) : fg - __logf(1.f + __expf(fg));
        b += lf;
        BL[(size_t)seq * TOKB + tok0 + tl] = b; IG[(size_t)seq * TOKB + tok0 + tl] = ig;
        mx = fmaxf(mx, ig - b);
      }
      GC[seq * NCH + nc] = b; AC[seq * NCH + nc] = b + mx;
    }
    __syncthreads();
  }
}

__device__ __forceinline__ void ml_s(const Params& p, const Ctx& cx) {
  const int tid = cx.tid, lane = tid & 63, wave = tid >> 6, fr = lane & 15, fq = lane >> 4;
  char* ws = cx.ws;
  const bf16_t* QK = (const bf16_t*)(ws + O_QK);
  bf16_t* SP = (bf16_t*)(ws + O_SP);
  const float* BL = (const float*)(ws + O_BL); const float* IG = (const float*)(ws + O_IG);
  float* WIN = (float*)(ws + O_WIN); float* FLO = (float*)(ws + O_FLO); float* DEN = (float*)(ws + O_DEN); float* WSS = (float*)(ws + O_WSS);
  const float* GC = (const float*)(ws + O_GC); const float* AC = GC + NSEQ * NCH; float* DEC = (float*)(ws + O_GC) + 2 * NSEQ * NCH;
  float* sb_ = (float*)lds_raw; float* si_ = sb_ + 64; float* smt = si_ + 64; float* sden = smt + 64;
  for (int u = cx.bid; u < NSEQ * NCH; u += cx.nb) {
    const int seq = u / NCH, st = u % NCH, x = (seq >> 2) & 1, h = seq & 3, bl = seq >> 3;
    const int nc = ml_nchunk(x, st), tok0 = nc * 64;
    if (wave == 0) {
      float mc = 0.f;
      for (int s2 = 0; s2 < st; ++s2) { const int n2 = ml_nchunk(x, s2); mc = fmaxf(GC[seq * NCH + n2] + mc, AC[seq * NCH + n2]); }
      const float gc = GC[seq * NCH + nc], ac = AC[seq * NCH + nc];
      const float mnew = fmaxf(gc + mc, ac);
      const int tl = x == 0 ? lane : 63 - lane;
      const float b = BL[(size_t)seq * TOKB + tok0 + tl], ig = IG[(size_t)seq * TOKB + tok0 + tl];
      float cm = ig - b;
#pragma unroll
      for (int o = 1; o < 64; o <<= 1) { const float t2 = shi(cm, lane - o); if (lane >= o) cm = fmaxf(cm, t2); }
      const float mt = b + fmaxf(mc, cm);
      sb_[tl] = b; si_[tl] = ig; smt[tl] = mt;
      WIN[(size_t)seq * TOKB + tok0 + tl] = __expf(b + mc - mt);
      FLO[(size_t)seq * TOKB + tok0 + tl] = __expf(-mt);
      WSS[(size_t)seq * TOKB + tok0 + tl] = __expf(gc - b + ig - mnew);
      if (lane == 0) DEC[seq * NCH + nc] = __expf(gc + mc - mnew);
    }
    __syncthreads();
    const int sbk = wave >> 1;
    const bf16_t* kp = QK + (size_t)ml_lrow(bl, tok0 + sbk * 16 + fr) * 4096 + 2048 + h * DH + fq * 8;
    const bf16_t* qp0 = QK + (size_t)ml_lrow(bl, tok0 + (2 * (wave & 1)) * 16 + fr) * 4096 + h * DH + fq * 8;
    const bf16_t* qp1 = QK + (size_t)ml_lrow(bl, tok0 + (2 * (wave & 1) + 1) * 16 + fr) * 4096 + h * DH + fq * 8;
    f32x4 a0 = {0.f, 0.f, 0.f, 0.f}, a1 = {0.f, 0.f, 0.f, 0.f};
#pragma unroll 4
    for (int ks = 0; ks < 16; ++ks) {
      const bf16x8 kf = *(const bf16x8*)(kp + ks * 32), q0 = *(const bf16x8*)(qp0 + ks * 32), q1 = *(const bf16x8*)(qp1 + ks * 32);
      a0 = MFMA16(kf, q0, a0); a1 = MFMA16(kf, q1, a1);
    }
    bf16_t* spu = SP + (size_t)(seq * NCH + nc) * 4096;
#pragma unroll
    for (int tbi = 0; tbi < 2; ++tbi) {
      const int t = (2 * (wave & 1) + tbi) * 16 + fr;
      const f32x4 a = tbi ? a1 : a0;
      const float bt = sb_[t], mt = smt[t];
      float vals[4];
#pragma unroll
      for (int jj = 0; jj < 4; ++jj) {
        const int s = sbk * 16 + 4 * fq + jj;
        const bool ok = x == 0 ? (s <= t) : (s >= t);
        vals[jj] = ok ? a[jj] * __expf(bt - sb_[s] + si_[s] - mt) : 0.f;
      }
      u32x2 o; o.x = pk2(vals[0], vals[1]); o.y = pk2(vals[2], vals[3]);
      *(u32x2*)(spu + t * 64 + sbk * 16 + 4 * fq) = o;
      float ds = (bflo(o.x) + bfhi(o.x)) + (bflo(o.y) + bfhi(o.y));
      ds += shx(ds, 16, lane); ds += shx(ds, 32, lane);
      if (fq == 0) sden[sbk * 64 + t] = ds;
    }
    __syncthreads();
    if (tid < 64) DEN[(size_t)seq * TOKB + tok0 + tid] = (sden[tid] + sden[64 + tid]) + (sden[128 + tid] + sden[192 + tid]);
    __syncthreads();
  }
}

__device__ __forceinline__ void ml_m2(const Params& p, const Ctx& cx) {
  const int tid = cx.tid, lane = tid & 63, wave = tid >> 6, fr = lane & 15, fq = lane >> 4;
  char* ws = cx.ws;
  const bf16_t* QK = (const bf16_t*)(ws + O_QK); const bf16_t* KT = (const bf16_t*)(ws + O_KT); const bf16_t* VT = (const bf16_t*)(ws + O_VT);
  const bf16_t* SP = (const bf16_t*)(ws + O_SP);
  bf16_t* HD = (bf16_t*)(ws + O_HD);
  const float* WIN = (const float*)(ws + O_WIN); const float* FLO = (const float*)(ws + O_FLO); const float* DEN = (const float*)(ws + O_DEN); const float* WSS = (const float*)(ws + O_WSS);
  const float* DEC = (const float*)(ws + O_GC) + 2 * NSEQ * NCH;
  f32x4* red = (f32x4*)lds_raw;
  f32x4* rn = (f32x4*)(lds_raw + 131072);
  for (int idx = cx.bid >> 3; idx < 16; idx += cx.nb >> 3) {
    const int seq = (cx.bid & 7) * 2 + (idx >> 3), es = idx & 7, x = (seq >> 2) & 1, h = seq & 3, bl = seq >> 3;
    const int d0 = wave * 64, e0 = es * 64;
    f32x4 C[4][5];
#pragma unroll
    for (int a = 0; a < 4; ++a)
#pragma unroll
      for (int b = 0; b < 5; ++b) C[a][b] = (f32x4){0.f, 0.f, 0.f, 0.f};
    const int tbo = wave >> 1, ebo0 = 2 * (wave & 1);
    int junk = 0;
    for (int st = 0; st < NCH; ++st) {
      const int nc = ml_nchunk(x, st), tok0 = nc * 64;
      bf16x8 qc[4][2];
#pragma unroll
      for (int tb = 0; tb < 4; ++tb) {
        const bf16_t* qp = QK + (size_t)ml_lrow(bl, tok0 + tb * 16 + fr) * 4096 + h * DH + d0 + 4 * fq;
        qc[tb][0] = mk8(*(const u32x2*)(qp), *(const u32x2*)(qp + 16));
        qc[tb][1] = mk8(*(const u32x2*)(qp + 32), *(const u32x2*)(qp + 48));
      }
      bf16x8 kf[4][2];
#pragma unroll
      for (int db = 0; db < 4; ++db) {
        const bf16_t* kp = KT + ((size_t)bl * EI + h * DH + d0 + db * 16 + fr) * TOKB + tok0 + 8 * fq;
        kf[db][0] = *(const bf16x8*)kp; kf[db][1] = *(const bf16x8*)(kp + 32);
      }
      const float decay = DEC[seq * NCH + nc];
      int pfa = 0, pfb = 0, pfc = 0;
#pragma unroll
      for (int eb = 0; eb < 5; ++eb) {
        bf16x8 cb0, cb1;
        { const f32x4 lo = C[0][eb], hi = C[1][eb]; cb0 = mk8((u32x4){pk2(lo[0], lo[1]), pk2(lo[2], lo[3]), pk2(hi[0], hi[1]), pk2(hi[2], hi[3])}); }
        { const f32x4 lo = C[2][eb], hi = C[3][eb]; cb1 = mk8((u32x4){pk2(lo[0], lo[1]), pk2(lo[2], lo[3]), pk2(hi[0], hi[1]), pk2(hi[2], hi[3])}); }
#pragma unroll
        for (int tb = 0; tb < 4; ++tb) {
          f32x4 pa = {0.f, 0.f, 0.f, 0.f};
          pa = MFMA16(qc[tb][0], cb0, pa); pa = MFMA16(qc[tb][1], cb1, pa);
          if (eb < 4) red[((wave * 4 + tb) * 4 + eb) * 64 + lane] = pa;
          else if (fr == 0) rn[(wave * 4 + tb) * 4 + fq] = pa;
        }
      }
      u32x4 vr[4][2];
#pragma unroll
      for (int eb = 0; eb < 4; ++eb) {
        const bf16_t* vp = VT + ((size_t)bl * EI + h * DH + e0 + eb * 16 + fr) * TOKB + tok0 + 8 * fq;
        vr[eb][0] = *(const u32x4*)vp; vr[eb][1] = *(const u32x4*)(vp + 32);
      }
      f32x4 wv[2][2];
#pragma unroll
      for (int ks = 0; ks < 2; ++ks) {
        const float* wp = WSS + (size_t)seq * TOKB + tok0 + 32 * ks + 8 * fq;
        wv[ks][0] = *(const f32x4*)wp; wv[ks][1] = *(const f32x4*)(wp + 4);
      }
      const bf16_t* sp = SP + (size_t)(seq * NCH + nc) * 4096 + (tbo * 16 + fr) * 64 + 8 * fq;
      const bf16x8 sf0 = *(const bf16x8*)sp, sf1 = *(const bf16x8*)(sp + 32);
      f32x4 oi[2];
      oi[0] = (f32x4){0.f, 0.f, 0.f, 0.f}; oi[1] = (f32x4){0.f, 0.f, 0.f, 0.f};
#pragma unroll
      for (int eb = 0; eb < 5; ++eb) {
        bf16x8 vw0, vw1;
        if (eb < 4) {
          const u32x4 r0 = vr[eb][0], r1 = vr[eb][1];
          if (eb == ebo0) { oi[0] = MFMA16(sf0, mk8(r0), oi[0]); oi[0] = MFMA16(sf1, mk8(r1), oi[0]); }
          if (eb == ebo0 + 1) { oi[1] = MFMA16(sf0, mk8(r0), oi[1]); oi[1] = MFMA16(sf1, mk8(r1), oi[1]); }
          vw0 = mk8((u32x4){pk2(bflo(r0.x) * wv[0][0][0], bfhi(r0.x) * wv[0][0][1]), pk2(bflo(r0.y) * wv[0][0][2], bfhi(r0.y) * wv[0][0][3]),
                            pk2(bflo(r0.z) * wv[0][1][0], bfhi(r0.z) * wv[0][1][1]), pk2(bflo(r0.w) * wv[0][1][2], bfhi(r0.w) * wv[0][1][3])});
          vw1 = mk8((u32x4){pk2(bflo(r1.x) * wv[1][0][0], bfhi(r1.x) * wv[1][0][1]), pk2(bflo(r1.y) * wv[1][0][2], bfhi(r1.y) * wv[1][0][3]),
                            pk2(bflo(r1.z) * wv[1][1][0], bfhi(r1.z) * wv[1][1][1]), pk2(bflo(r1.w) * wv[1][1][2], bfhi(r1.w) * wv[1][1][3])});
        } else {
          vw0 = mk8((u32x4){pk2(wv[0][0][0], wv[0][0][1]), pk2(wv[0][0][2], wv[0][0][3]), pk2(wv[0][1][0], wv[0][1][1]), pk2(wv[0][1][2], wv[0][1][3])});
          vw1 = mk8((u32x4){pk2(wv[1][0][0], wv[1][0][1]), pk2(wv[1][0][2], wv[1][0][3]), pk2(wv[1][1][0], wv[1][1][1]), pk2(wv[1][1][2], wv[1][1][3])});
        }
#pragma unroll
        for (int db = 0; db < 4; ++db) {
          f32x4 c = C[db][eb] * decay;
          c = MFMA16(kf[db][0], vw0, c); c = MFMA16(kf[db][1], vw1, c);
          C[db][eb] = c;
        }
      }
      const size_t tix = (size_t)seq * TOKB + tok0 + tbo * 16 + 4 * fq;
      const f32x4 win = *(const f32x4*)(WIN + tix), flo = *(const f32x4*)(FLO + tix), deni = *(const f32x4*)(DEN + tix);
      __syncthreads();
      f32x4 pn = {0.f, 0.f, 0.f, 0.f};
#pragma unroll
      for (int w = 0; w < 8; ++w) pn += rn[(w * 4 + tbo) * 4 + fq];
#pragma unroll
      for (int ob = 0; ob < 2; ++ob) {
        f32x4 pi = {0.f, 0.f, 0.f, 0.f};
#pragma unroll
        for (int w = 0; w < 8; ++w) pi += red[((w * 4 + tbo) * 4 + ebo0 + ob) * 64 + lane];
#pragma unroll
        for (int jj = 0; jj < 4; ++jj) {
          const float num = oi[ob][jj] + win[jj] * pi[jj], den = deni[jj] + win[jj] * pn[jj];
          const float hv = num * __builtin_amdgcn_rcpf(fmaxf(fabsf(den), flo[jj]));
          HD[((size_t)x * RG + ml_lrow(bl, tok0 + tbo * 16 + 4 * fq + jj)) * EI + h * DH + e0 + (ebo0 + ob) * 16 + fr] = (bf16_t)(pk2(hv, 0.f) & 0xffff);
        }
      }
      junk += pfa + pfb + pfc;
      __syncthreads();
    }
    if (junk == 0x7fffffff && tid > 4096) HD[0] = 0;
  }
}

__device__ __forceinline__ void ml_fin(const Params& p, const Ctx& cx, int j) {
  const int lane = cx.tid & 63, gw = cx.bid * 8 + (cx.tid >> 6), NGW = cx.nb * 8;
  char* ws = cx.ws;
  const bf16_t* XZ = (const bf16_t*)(ws + O_XZ); const bf16_t* HD = (const bf16_t*)(ws + O_HD);
  bf16_t* FIN = (bf16_t*)(ws + O_FIN);
  for (int u = gw; u < RG * 4; u += NGW) {
    const int lr = u >> 2, h = u & 3, f0 = h * DH + lane * 8;
    int pos, seglen;
    if (lr < GB * SEQ) { pos = lr & (SEQ - 1); seglen = SEQ; } else { pos = (lr - GB * SEQ) & (LC - 1); seglen = LC; }
    const u32x4 hf = *(const u32x4*)(HD + (size_t)lr * EI + f0), hb = *(const u32x4*)(HD + ((size_t)RG + lr) * EI + f0);
    const u32x4 zz = *(const u32x4*)(XZ + (size_t)lr * 4096 + 2048 + f0);
    const u32x4 x1 = *(const u32x4*)(XZ + (size_t)lr * 4096 + f0);
    u32x4 x0 = {0u, 0u, 0u, 0u}, x2 = {0u, 0u, 0u, 0u};
    if (pos > 0) x0 = *(const u32x4*)(XZ + (size_t)(lr - 1) * 4096 + f0);
    if (pos < seglen - 1) x2 = *(const u32x4*)(XZ + (size_t)(lr + 1) * 4096 + f0);
    float hv[8], xm0[8], xm1[8], xm2[8];
    const unsigned hfu[4] = {hf.x, hf.y, hf.z, hf.w}, hbu[4] = {hb.x, hb.y, hb.z, hb.w}, zu[4] = {zz.x, zz.y, zz.z, zz.w};
    const unsigned x0u[4] = {x0.x, x0.y, x0.z, x0.w}, x1u[4] = {x1.x, x1.y, x1.z, x1.w}, x2u[4] = {x2.x, x2.y, x2.z, x2.w};
    float s = 0.f;
#pragma unroll
    for (int i = 0; i < 4; ++i) {
      hv[2 * i] = (bflo(hfu[i]) + bflo(hbu[i])) * sigm_f(bflo(zu[i]));
      hv[2 * i + 1] = (bfhi(hfu[i]) + bfhi(hbu[i])) * sigm_f(bfhi(zu[i]));
      xm0[2 * i] = bflo(x0u[i]); xm0[2 * i + 1] = bfhi(x0u[i]); xm1[2 * i] = bflo(x1u[i]); xm1[2 * i + 1] = bfhi(x1u[i]); xm2[2 * i] = bflo(x2u[i]); xm2[2 * i + 1] = bfhi(x2u[i]);
      s += hv[2 * i] + hv[2 * i + 1];
    }
    const float mean = wave_sum(s, lane) * (1.f / DH); float s2 = 0.f;
#pragma unroll
    for (int i = 0; i < 8; ++i) { hv[i] -= mean; s2 += hv[i] * hv[i]; }
    const float rstd = __builtin_amdgcn_rsqf(wave_sum(s2, lane) * (1.f / DH) + LN_EPS);
    float o[8];
#pragma unroll
    for (int i = 0; i < 8; ++i) {
      const int f = f0 + i;
      const float xc = silu_f(IN(11)[(size_t)(j * 3 + 0) * EI + f] * xm0[i] + IN(11)[(size_t)(j * 3 + 1) * EI + f] * xm1[i] + IN(11)[(size_t)(j * 3 + 2) * EI + f] * xm2[i] + IN(12)[(size_t)j * EI + f]);
      o[i] = hv[i] * rstd * IN(17)[(size_t)j * EI + f] + IN(16)[(size_t)j * EI + f] * xc;
    }
    u32x4 ov; ov.x = pk2(o[0], o[1]); ov.y = pk2(o[2], o[3]); ov.z = pk2(o[4], o[5]); ov.w = pk2(o[6], o[7]);
    *(u32x4*)(FIN + (size_t)lr * EI + f0) = ov;
  }
}

__device__ __forceinline__ void at_prep(const Params& p, const Ctx& cx) {
  const int lane = cx.tid & 63, gw = cx.bid * 8 + (cx.tid >> 6), NGW = cx.nb * 8;
  char* ws = cx.ws;
  bf16_t* ACT = (bf16_t*)(ws + O_ACT); bf16_t* KR = (bf16_t*)(ws + O_AKR); bf16_t* VT = (bf16_t*)(ws + O_AVT);
  const float* rc = (const float*)(ws + O_ROPE); const float* rs = rc + 4096 * 32;
  for (int row = gw; row < MROWS; row += NGW) {
    const bool lat = row < NLAT;
    const int b = lat ? row >> 12 : (row - NLAT) >> 8, pos = lat ? row & 4095 : (row - NLAT) & 255, tok = lat ? LC + pos : pos;
    bf16_t* rp = ACT + (size_t)row * 1536;
    {
      const u32x4 a = *(const u32x4*)(rp + 16 * lane), b2 = *(const u32x4*)(rp + 16 * lane + 8);
      const unsigned w[8] = {a.x, a.y, a.z, a.w, b2.x, b2.y, b2.z, b2.w};
      unsigned o[8];
      const int pp0 = (lane & 3) * 8;
#pragma unroll
      for (int i = 0; i < 8; ++i) {
        float x1 = bflo(w[i]) * 0.125f, x2 = bfhi(w[i]) * 0.125f;
        if (lat) { const float c = rc[pos * 32 + pp0 + i], s = rs[pos * 32 + pp0 + i]; const float y1 = x1 * c - x2 * s, y2 = x1 * s + x2 * c; x1 = y1; x2 = y2; }
        o[i] = pk2(x1, x2);
      }
      *(u32x4*)(rp + 16 * lane) = (u32x4){o[0], o[1], o[2], o[3]}; *(u32x4*)(rp + 16 * lane + 8) = (u32x4){o[4], o[5], o[6], o[7]};
    }
    {
      const u32x2 a = *(const u32x2*)(rp + 1024 + 4 * lane);
      const unsigned w[2] = {a.x, a.y}; unsigned o[2];
      const int g = lane >> 4, dd = (lane & 15) * 4, pp0 = dd >> 1;
#pragma unroll
      for (int i = 0; i < 2; ++i) {
        float x1 = bflo(w[i]), x2 = bfhi(w[i]);
        if (lat) { const float c = rc[pos * 32 + pp0 + i], s = rs[pos * 32 + pp0 + i]; const float y1 = x1 * c - x2 * s, y2 = x1 * s + x2 * c; x1 = y1; x2 = y2; }
        o[i] = pk2(x1, x2);
      }
      *(u32x2*)(KR + (((size_t)b * 4 + g) * TOKB + tok) * 64 + dd) = (u32x2){o[0], o[1]};
      const u32x2 v = *(const u32x2*)(rp + 1280 + 4 * lane);
      bf16_t* vp = VT + (((size_t)b * 4 + g) * 64 + dd) * TOKB + tok;
      vp[0] = (bf16_t)(v.x & 0xffff); vp[TOKB] = (bf16_t)(v.x >> 16); vp[2 * TOKB] = (bf16_t)(v.y & 0xffff); vp[3 * TOKB] = (bf16_t)(v.y >> 16);
    }
  }
}

__device__ __forceinline__ void at_core(const Params& p, const Ctx& cx) {
  const int lane = cx.tid & 63, gw = cx.bid * 8 + (cx.tid >> 6), NGW = cx.nb * 8, fr = lane & 15, fq = lane >> 4;
  char* ws = cx.ws;
  const bf16_t* ACT = (const bf16_t*)(ws + O_ACT); const bf16_t* KR = (const bf16_t*)(ws + O_AKR); const bf16_t* VT = (const bf16_t*)(ws + O_AVT);
  bf16_t* O = (bf16_t*)(ws + O_U);
  for (int u = gw; u < (MROWS / 16) * 16; u += NGW) {
    const int hq = u & 15, qb = u >> 4, row0 = qb * 16, g = hq >> 2;
    const bool lat = row0 < NLAT;
    const int b = lat ? row0 >> 12 : (row0 - NLAT) >> 8, q0 = lat ? row0 & 4095 : 0;
    const bf16_t* qp = ACT + (size_t)(row0 + fr) * 1536 + hq * 64 + 8 * fq;
    const bf16x8 qf0 = *(const bf16x8*)qp, qf1 = *(const bf16x8*)(qp + 32);
    const bf16_t* kbase = KR + ((size_t)b * 4 + g) * TOKB * 64;
    const bf16_t* vbase = VT + ((size_t)b * 4 + g) * 64 * TOKB;
    float mrun = IN(20)[hq], lrun = 0.f;
    const float sink = mrun;
    f32x4 oacc[4];
#pragma unroll
    for (int d2 = 0; d2 < 4; ++d2) oacc[d2] = (f32x4){0.f, 0.f, 0.f, 0.f};
    int wlo = 0, whi = -1;
    if (lat) { wlo = max(0, q0 - 128) & ~31; whi = min(SEQ - 1, q0 + 143); }
    const int nwin = lat ? (whi - wlo) / 32 + 1 : 0;
    for (int ti = 0; ti < 8 + nwin; ++ti) {
      const bool isw = ti >= 8;
      const int kpos0 = isw ? wlo + (ti - 8) * 32 : 0;
      const int tk0 = isw ? LC + kpos0 : ti * 32;
      f32x4 s0 = {0.f, 0.f, 0.f, 0.f}, s1 = {0.f, 0.f, 0.f, 0.f};
      {
        const bf16_t* kp = kbase + (size_t)(tk0 + fr) * 64 + 8 * fq;
        s0 = MFMA16(*(const bf16x8*)kp, qf0, s0); s0 = MFMA16(*(const bf16x8*)(kp + 32), qf1, s0);
        s1 = MFMA16(*(const bf16x8*)(kp + 16 * 64), qf0, s1); s1 = MFMA16(*(const bf16x8*)(kp + 16 * 64 + 32), qf1, s1);
      }
      float sv[8]; float tmax = -3.0e38f;
#pragma unroll
      for (int i = 0; i < 8; ++i) {
        float v = i < 4 ? s0[i] : s1[i - 4];
        if (isw) { const int kpos = kpos0 + (i >> 2) * 16 + 4 * fq + (i & 3), dlt = (q0 + fr) - kpos; if (dlt > 128 || dlt < -128) v = -3.0e38f; }
        sv[i] = v; tmax = fmaxf(tmax, v);
      }
      tmax = fmaxf(tmax, shx(tmax, 16, lane)); tmax = fmaxf(tmax, shx(tmax, 32, lane));
      const float mnew = fmaxf(mrun, tmax), scale = __expf(mrun - mnew);
      mrun = mnew;
      float ps = 0.f; float pv[8];
#pragma unroll
      for (int i = 0; i < 8; ++i) { pv[i] = sv[i] > -1.0e38f ? __expf(sv[i] - mnew) : 0.f; }
      const bf16x8 pf = mk8((u32x4){pk2(pv[0], pv[1]), pk2(pv[2], pv[3]), pk2(pv[4], pv[5]), pk2(pv[6], pv[7])});
      {
        union { bf16x8 b; unsigned u[4]; } cv; cv.b = pf;
#pragma unroll
        for (int i = 0; i < 4; ++i) ps += bflo(cv.u[i]) + bfhi(cv.u[i]);
      }
      lrun = lrun * scale + ps;
      float scq[4];
#pragma unroll
      for (int jj = 0; jj < 4; ++jj) scq[jj] = shi(scale, 4 * fq + jj);
#pragma unroll
      for (int d2 = 0; d2 < 4; ++d2) {
        const bf16_t* vp = vbase + (size_t)(d2 * 16 + fr) * TOKB + tk0 + 4 * fq;
        const bf16x8 vfr = mk8(*(const u32x2*)vp, *(const u32x2*)(vp + 16));
        f32x4 o = oacc[d2];
        o[0] *= scq[0]; o[1] *= scq[1]; o[2] *= scq[2]; o[3] *= scq[3];
        oacc[d2] = MFMA16(pf, vfr, o);
      }
    }
    lrun += shx(lrun, 16, lane); lrun += shx(lrun, 32, lane);
    lrun += __expf(sink - mrun);
    const float inv = __builtin_amdgcn_rcpf(lrun);
    float iq[4];
#pragma unroll
    for (int jj = 0; jj < 4; ++jj) iq[jj] = shi(inv, 4 * fq + jj);
#pragma unroll
    for (int d2 = 0; d2 < 4; ++d2)
#pragma unroll
      for (int jj = 0; jj < 4; ++jj)
        O[(size_t)(row0 + 4 * fq + jj) * D + hq * 64 + d2 * 16 + fr] = (bf16_t)(pk2(oacc[d2][jj] * iq[jj], 0.f) & 0xffff);
  }
}

__device__ __forceinline__ void sc_conv(const Params& p, const Ctx& cx) {
  const int gt = cx.bid * 512 + cx.tid, gs = cx.nb * 512;
  const bf16_t* ACT = (const bf16_t*)(cx.ws + O_ACT); bf16_t* O = (bf16_t*)(cx.ws + O_U);
  const float* cw = IN(23);
  for (int i = gt; i < MROWS * 128; i += gs) {
    const int row = i >> 7, c0 = (i & 127) * 8;
    int pos, seglen;
    if (row < NLAT) { pos = row & (SEQ - 1); seglen = SEQ; } else { pos = (row - NLAT) & (LC - 1); seglen = LC; }
    float accv[8];
#pragma unroll
    for (int e = 0; e < 8; ++e) accv[e] = 0.f;
#pragma unroll
    for (int k = 0; k < 3; ++k) {
      const int pp = pos + k - 1;
      if (pp < 0 || pp >= seglen) continue;
      const bf16_t* rp = ACT + (size_t)(row + k - 1) * 3072;
      const u32x4 cgv = *(const u32x4*)(rp + 1024 + c0), xtv = *(const u32x4*)(rp + 2048 + c0);
      const unsigned cu[4] = {cgv.x, cgv.y, cgv.z, cgv.w}, xu[4] = {xtv.x, xtv.y, xtv.z, xtv.w};
#pragma unroll
      for (int e = 0; e < 4; ++e) {
        accv[2 * e] += cw[k * D + c0 + 2 * e] * (bflo(cu[e]) * bflo(xu[e]));
        accv[2 * e + 1] += cw[k * D + c0 + 2 * e + 1] * (bfhi(cu[e]) * bfhi(xu[e]));
      }
    }
    const u32x4 bgv = *(const u32x4*)(ACT + (size_t)row * 3072 + c0);
    const unsigned bu[4] = {bgv.x, bgv.y, bgv.z, bgv.w};
    u32x4 o;
    o.x = pk2(bflo(bu[0]) * accv[0], bfhi(bu[0]) * accv[1]); o.y = pk2(bflo(bu[1]) * accv[2], bfhi(bu[1]) * accv[3]);
    o.z = pk2(bflo(bu[2]) * accv[4], bfhi(bu[2]) * accv[5]); o.w = pk2(bflo(bu[3]) * accv[6], bfhi(bu[3]) * accv[7]);
    *(u32x4*)(O + (size_t)row * D + c0) = o;
  }
}

#define XB_TMO      128
#define XB_XCNT(j)  (256  + 64 * (j))
#define XB_XSUB(j)  (1280 + 64 * (j))
#define XB_XGEN(j)  (2304 + 64 * (j))
#define XB_TOP      3328
#define XB_TOPGEN   3392
#define XCD_BAR_WORDS 3456
#define XB_SPIN_CAP (1u << 18)
__device__ __forceinline__ unsigned xb_ld(unsigned* p)              { return __hip_atomic_load(p, __ATOMIC_RELAXED, __HIP_MEMORY_SCOPE_AGENT); }
__device__ __forceinline__ unsigned xb_add(unsigned* p, unsigned v) { return __hip_atomic_fetch_add(p, v, __ATOMIC_RELAXED, __HIP_MEMORY_SCOPE_AGENT); }
__device__ __forceinline__ unsigned xb_xcc_id() { return (unsigned)__builtin_amdgcn_s_getreg((3 << 11) | 20) & 0xFu; }
#define XB_SPIN(cond, bar) do { unsigned _sp = 0; while (cond) { __builtin_amdgcn_s_sleep(1); \
    if ((++_sp & 255u) == 0u) { if (xb_ld(&(bar)[XB_TMO])) break; if (_sp > XB_SPIN_CAP) { atomicAdd(&(bar)[XB_TMO], 1u); break; } } } } while (0)
__device__ __forceinline__ void xcd_barrier_complete(unsigned* bar, unsigned x, unsigned& nloc, unsigned& nx) {
  const unsigned G = gridDim.x;
  unsigned sum, cnt, mine, sp = 0u;
  for (;;) {
    sum = 0u; cnt = 0u; mine = 0u;
#pragma unroll
    for (unsigned j = 0; j < 16; ++j) { const unsigned c = xb_ld(&bar[XB_XCNT(j)]); sum += c; cnt += (c > 0u) ? 1u : 0u; mine = (j == x) ? c : mine; }
    if (sum == G) break;
    __builtin_amdgcn_s_sleep(1);
    if ((++sp & 255u) == 0u) { if (xb_ld(&bar[XB_TMO])) break; if (sp > XB_SPIN_CAP) { atomicAdd(&bar[XB_TMO], 1u); break; } }
  }
  nloc = mine > 0u ? mine : 1u; nx = cnt > 0u ? cnt : 1u;
}
__device__ __forceinline__ void xcd_barrier(unsigned* bar, unsigned x, volatile LAS unsigned* st) {
  asm volatile("s_waitcnt vmcnt(0)" ::: "memory");
  __syncthreads();
  if (threadIdx.x == 0) {
    __builtin_amdgcn_s_waitcnt(0);
    unsigned nloc = st[0], nx = st[1];
    if (nloc == 0u) { xcd_barrier_complete(bar, x, nloc, nx); st[0] = nloc; st[1] = nx; }
    const unsigned old = xb_add(&bar[XB_XSUB(x)], 1u);
    const unsigned gen = old / nloc;
    if (old + 1u == (gen + 1u) * nloc) {
      __builtin_amdgcn_fence(__ATOMIC_RELEASE, "agent");
      asm volatile("s_waitcnt vmcnt(0)" ::: "memory");
      const unsigned og = xb_add(&bar[XB_TOP], 1u);
      const unsigned tg = og / nx;
      if (og + 1u == (tg + 1u) * nx) xb_add(&bar[XB_TOPGEN], 1u);
      else XB_SPIN(xb_ld(&bar[XB_TOPGEN]) == tg, bar);
      __builtin_amdgcn_fence(__ATOMIC_ACQUIRE, "agent");
      xb_add(&bar[XB_XGEN(x)], 1u);
      asm volatile("s_waitcnt vmcnt(0)" ::: "memory");
    } else {
      XB_SPIN(xb_ld(&bar[XB_XGEN(x)]) == gen, bar);
      __builtin_amdgcn_fence(__ATOMIC_ACQUIRE, "agent");
      asm volatile("s_waitcnt vmcnt(0)" ::: "memory");
    }
  }
  __syncthreads();
}

#ifndef ENMASK
#define ENMASK 0xffff
#endif
#define EN(i) ((ENMASK >> (i)) & 1)
enum { OP_PRO = 0, OP_LN0, OP_LN1, OP_LNF, OP_FFI, OP_FFO, OP_UP, OP_M0, OP_GAT, OP_S, OP_M2, OP_FIN, OP_DN, OP_AQ, OP_APREP, OP_ACORE, OP_AO, OP_SI, OP_SCONV, OP_SO };
__global__ void __launch_bounds__(512) fwd_megakernel(Params p) {
  cg::grid_group grid = cg::this_grid();
  const int wave_s = __builtin_amdgcn_readfirstlane((int)threadIdx.x >> 6);
  volatile LAS unsigned* xst = (volatile LAS unsigned*)((LAS unsigned char*)lds_raw + (LDS_BYTES - 16));
  if (threadIdx.x == 0) { xst[0] = 0u; xst[1] = 0u; }
  __syncthreads();
  unsigned* xbar = (unsigned*)(p.ws + O_BAR);
  const unsigned xcc = xb_xcc_id();
  if (threadIdx.x == 0) (void)xb_add(&xbar[XB_XCNT(xcc)], 1u);
#ifdef DUP_OP
  int rep = 0;
#endif
  for (int ph = 0; ph < p.nph; ++ph) {
    const unsigned w = p.prog[ph];
    const int op = w & 255, a = (w >> 8) & 255, b = (w >> 16) & 255, c = (w >> 24) & 255;
#define MKCTX int z; asm volatile("s_mov_b32 %0, 0" : "=s"(z)); \
    GAS char* wsq = (GAS char*)p.ws; GAS float* outq = (GAS float*)p.out; int bidq = (int)blockIdx.x, nbq = (int)gridDim.x; \
    asm volatile("" : "+s"(wsq), "+s"(outq), "+s"(bidq), "+s"(nbq)); \
    const Ctx cx{wave_s * 64 + (int)__builtin_amdgcn_mbcnt_hi(~0u, __builtin_amdgcn_mbcnt_lo(~0u, (unsigned)z)), bidq, nbq, z, (char*)wsq, (float*)outq};
    if (EN(0) && op == OP_PRO) { MKCTX prologue(p, cx); }
    else if (EN(1) && op == OP_LN0) { MKCTX lnmod_phase<0>(p, cx, 0, 0, 0); }
    else if (EN(1) && op == OP_LN1) { MKCTX lnmod_phase<1>(p, cx, a, b, c); }
    else if (EN(1) && op == OP_LNF) { MKCTX lnmod_phase<2>(p, cx, a, 0, 0); }
    else if (EN(2) && op == OP_M0) { MKCTX ml_m0(p, cx, a); }
    else if (EN(3) && op == OP_GAT) { MKCTX ml_gates(p, cx, a); }
    else if (EN(4) && op == OP_S) { MKCTX ml_s(p, cx); }
    else if (EN(5) && op == OP_M2) { MKCTX ml_m2(p, cx); }
    else if (EN(6) && op == OP_FIN) { MKCTX ml_fin(p, cx, a); }
    else if (EN(7) && op == OP_APREP) { MKCTX at_prep(p, cx); }
    else if (EN(8) && op == OP_ACORE) { MKCTX at_core(p, cx); }
    else if (EN(9) && op == OP_SCONV) { MKCTX sc_conv(p, cx); }
    else if (EN(10)) {
      MKCTX
      char* ws = cx.ws;
      const RowMap idm{0, 0, 1 << 30};
      bf16_t* U = (bf16_t*)(ws + O_U); bf16_t* ACT = (bf16_t*)(ws + O_ACT);
      const float* MODT = (const float*)(ws + O_MODT);
      const bf16_t* A = U; const bf16_t* Bt; int K = 1024, nM = MROWS / 256, nN; RowMap am = idm, cm = idm;
      Epi E; E.kind = 2; E.O = ACT; E.ldc = 0; E.modl = MODT + (size_t)b * 9 * 9216; E.slot = 1; E.wgt = 1.0f;
      if (op == OP_FFI) { Bt = (const bf16_t*)(ws + O_WFI) + (size_t)a * 5632 * 1024; nN = 22; E.kind = 1; }
      else if (op == OP_FFO) { A = ACT; Bt = (const bf16_t*)(ws + O_WFO) + (size_t)a * 1024 * 2816; K = 2816; nN = 4; E.slot = c; E.wgt = 0.5f; }
      else if (op == OP_UP) { Bt = (const bf16_t*)(ws + O_WUP) + (size_t)a * 4096 * 1024; nM = RG / 256; nN = 16; am = RowMap{c * GB * SEQ, NLAT + c * GB * LC, GB * SEQ / 256}; E.kind = 0; E.O = (bf16_t*)(ws + O_XZ); E.ldc = 4096; }
      else if (op == OP_DN) { A = (const bf16_t*)(ws + O_FIN); Bt = (const bf16_t*)(ws + O_WDN) + (size_t)a * 1024 * 2048; K = 2048; nM = RG / 256; nN = 4; cm = RowMap{c * GB * SEQ, NLAT + c * GB * LC, GB * SEQ / 256}; }
      else if (op == OP_AQ) { Bt = (const bf16_t*)(ws + O_WAQ); nN = 6; E.kind = 0; E.ldc = 1536; }
      else if (op == OP_AO) { Bt = (const bf16_t*)(ws + O_WAO); nN = 4; }
      else if (op == OP_SI) { Bt = (const bf16_t*)(ws + O_WSI); nN = 12; E.kind = 0; E.ldc = 3072; }
      else { Bt = (const bf16_t*)(ws + O_WSO); nN = 4; }
      gemm_phase(cx, A, am, Bt, K, nM, nN, cm, E);
    }
    if (ph == 0) grid.sync(); else xcd_barrier(xbar, xcc, xst);
#ifdef DUP_OP
    if (op == DUP_OP && rep + 1 < DUP_N) { ++rep; --ph; } else rep = 0;
#endif
  }
}

static int build_program(unsigned* prog) {
  int n = 0;
  auto W = [&](int op, int a, int b, int c) { prog[n++] = (unsigned)op | ((unsigned)a << 8) | ((unsigned)b << 16) | ((unsigned)c << 24); };
  W(OP_PRO, 0, 0, 0);
  W(OP_LN0, 0, 0, 0);
  for (int layer = 0; layer < DEPTH; ++layer) {
    const int kind = layer % 3, j = layer / 3;
    W(OP_FFI, layer * 2, layer, 0); W(OP_FFO, layer * 2, layer, 0);
    W(OP_LN1, layer * 3 + 0, layer, 1);
    if (kind == 0) {
      for (int g = 0; g < NG; ++g) { W(OP_UP, j, layer, g); W(OP_M0, j, 0, 0); W(OP_GAT, j, 0, 0); W(OP_S, 0, 0, 0); W(OP_M2, 0, 0, 0); W(OP_FIN, j, 0, 0); W(OP_DN, j, layer, g); }
    } else if (kind == 1) { W(OP_AQ, 0, layer, 0); W(OP_APREP, 0, 0, 0); W(OP_ACORE, 0, 0, 0); W(OP_AO, 0, layer, 0); }
    else { W(OP_SI, 0, layer, 0); W(OP_SCONV, 0, 0, 0); W(OP_SO, 0, layer, 0); }
    W(OP_LN1, layer * 3 + 1, layer, 2);
    W(OP_FFI, layer * 2 + 1, layer, 0); W(OP_FFO, layer * 2 + 1, layer, 2);
    if (layer + 1 < DEPTH) W(OP_LN1, layer * 3 + 2, layer + 1, 0); else W(OP_LNF, layer * 3 + 2, 0, 0);
  }
  return n;
}

extern "C" void kernel_launch(void* const* d_in, const int* in_sizes, int n_in, void* d_out, int out_size, void* d_ws, size_t ws_size, hipStream_t stream) {
  static int grid_blocks = 0;
  if (!grid_blocks) {
    int dev = 0, cus = 0, per_cu = 0;
    (void)hipGetDevice(&dev);
    (void)hipDeviceGetAttribute(&cus, hipDeviceAttributeMultiprocessorCount, dev);
    (void)hipFuncSetAttribute((const void*)fwd_megakernel, hipFuncAttributeMaxDynamicSharedMemorySize, LDS_BYTES);
    (void)hipOccupancyMaxActiveBlocksPerMultiprocessor(&per_cu, fwd_megakernel, 512, LDS_BYTES);
    if (cus <= 0) cus = 256;
    grid_blocks = cus;
    if (ws_size < WS_END || n_in != 25) fprintf(stderr, "kernel_launch: workspace %zu < %zu or n_in %d != 25\n", ws_size, (size_t)WS_END, n_in);
    if (per_cu < 1) fprintf(stderr, "kernel_launch: occupancy query says %d blocks per CU\n", per_cu);
  }
  Params p{};
  for (int i = 0; i < 25; ++i) p.in[i] = (const float*)d_in[i];
  p.out = (float*)d_out; p.ws = (char*)d_ws;
  p.nph = build_program(p.prog);
  (void)hipMemsetAsync((char*)d_ws + O_BAR, 0, XCD_BAR_WORDS * 4, stream);
  void* args[] = {&p};
  hipError_t e = hipLaunchCooperativeKernel((void*)fwd_megakernel, dim3(grid_blocks), dim3(512), args, LDS_BYTES, stream);
  if (e != hipSuccess) fprintf(stderr, "cooperative launch failed: %s (grid %d)\n", hipGetErrorString(e), grid_blocks);
}
```

```cpp
#include <hip/hip_runtime.h>
#include <hip/hip_cooperative_groups.h>
#include <cstdio>
#include <cstdint>
namespace cg = cooperative_groups;

typedef unsigned short bf16_t;
typedef short bf16x8 __attribute__((ext_vector_type(8)));
typedef short bf16x4 __attribute__((ext_vector_type(4)));
typedef float f32x4 __attribute__((ext_vector_type(4)));
typedef unsigned u32x2 __attribute__((ext_vector_type(2)));
typedef unsigned u32x4 __attribute__((ext_vector_type(4)));

constexpr int D = 1024, NB = 8, SEQ = 4096, LC = 256, DEPTH = 4, FF = 2816, EI = 2048, DH = 512;
constexpr int NLAT = NB * SEQ, NCTX = NB * LC, MROWS = NLAT + NCTX;
constexpr int TOKB = LC + SEQ;
constexpr int NCH = TOKB / 64;
constexpr int GB = 2, NG = NB / GB, RG = GB * TOKB;
constexpr int NSEQ = GB * 8;
constexpr float ALPHA = 1.681792830507429f, LN_EPS = 1e-5f;
constexpr int LDS_BYTES = 144 * 1024;

constexpr size_t al256(size_t x) { return (x + 255) & ~(size_t)255; }
constexpr size_t O_WFI = 0;
constexpr size_t O_WFO = O_WFI + (size_t)8 * 5632 * 1024 * 2;
constexpr size_t O_WUP = O_WFO + (size_t)8 * 1024 * 2816 * 2;
constexpr size_t O_WDN = O_WUP + (size_t)2 * 4096 * 1024 * 2;
constexpr size_t O_WAQ = O_WDN + (size_t)2 * 1024 * 2048 * 2;
constexpr size_t O_WAO = O_WAQ + (size_t)1536 * 1024 * 2;
constexpr size_t O_WSI = O_WAO + (size_t)1024 * 1024 * 2;
constexpr size_t O_WSO = O_WSI + (size_t)3072 * 1024 * 2;
constexpr size_t O_WG = O_WSO + (size_t)1024 * 1024 * 2;
constexpr size_t O_MODT = O_WG + (size_t)2 * 16 * 6144 * 2;
constexpr size_t O_ROPE = O_MODT + (size_t)4 * 9 * 9216 * 4;
constexpr size_t O_HCTX = O_ROPE + (size_t)2 * 4096 * 32 * 4;
constexpr size_t O_U = O_HCTX + (size_t)NCTX * D * 4;
constexpr size_t O_R = O_U + (size_t)MROWS * D * 2;
constexpr size_t O_XZ = O_R;
constexpr size_t O_QK = O_XZ + (size_t)RG * 4096 * 2;
constexpr size_t O_KT = O_QK + (size_t)RG * 4096 * 2;
constexpr size_t O_VT = O_KT + (size_t)GB * EI * TOKB * 2;
constexpr size_t O_SP = O_VT + (size_t)GB * EI * TOKB * 2;
constexpr size_t O_HD = O_SP + (size_t)NSEQ * NCH * 4096 * 2;
constexpr size_t O_FIN = O_HD + (size_t)2 * RG * EI * 2;
constexpr size_t O_GAT = O_FIN + (size_t)RG * EI * 2;
constexpr size_t SZ_ST = (size_t)NSEQ * TOKB * 4;
constexpr size_t O_BL = O_GAT, O_IG = O_BL + SZ_ST, O_WIN = O_IG + SZ_ST, O_FLO = O_WIN + SZ_ST, O_DEN = O_FLO + SZ_ST, O_WSS = O_DEN + SZ_ST;
constexpr size_t O_GC = O_WSS + SZ_ST;
constexpr size_t O_REND_ML = O_GC + (size_t)3 * NSEQ * NCH * 4 + 256;
constexpr size_t O_ACT = O_R;
constexpr size_t O_AKR = O_R + (size_t)MROWS * 3072 * 2;
constexpr size_t O_AVT = O_AKR + (size_t)NB * 4 * TOKB * 64 * 2;
constexpr size_t O_REND_AT = O_AVT + (size_t)NB * 4 * TOKB * 64 * 2;
constexpr size_t O_BAR = (O_REND_ML > O_REND_AT ? O_REND_ML : O_REND_AT);
constexpr size_t WS_END = O_BAR + 3456 * 4 + 256;

struct Params {
  const float* in[25];
  float* out;
  char* ws;
  int nph; int pad0;
  unsigned prog[126];
};

#define GAS __attribute__((address_space(1)))
#define IN(k) ((const float*)(const GAS float*)p.in[(k) + cx.z])
struct Ctx { int tid, bid, nb, z; char* ws; float* out; };
extern __shared__ __attribute__((aligned(16))) char lds_raw[];

__device__ __forceinline__ unsigned pk2(float lo, float hi) { unsigned r; asm volatile("v_cvt_pk_bf16_f32 %0, %1, %2" : "=v"(r) : "v"(lo), "v"(hi)); return r; }
__device__ __forceinline__ float bf2f(unsigned short v) { return __uint_as_float(((unsigned)v) << 16); }
__device__ __forceinline__ float bflo(unsigned v) { return __uint_as_float(v << 16); }
__device__ __forceinline__ float bfhi(unsigned v) { return __uint_as_float(v & 0xffff0000u); }
__device__ __forceinline__ float silu_f(float x) { return x * __builtin_amdgcn_rcpf(1.f + __expf(-x)); }
__device__ __forceinline__ float sigm_f(float x) { return __builtin_amdgcn_rcpf(1.f + __expf(-x)); }
__device__ __forceinline__ float shi(float v, int srclane) { return __int_as_float(__builtin_amdgcn_ds_bpermute(srclane << 2, __float_as_int(v))); }
__device__ __forceinline__ float shx(float v, int m, int lane) { return shi(v, lane ^ m); }
__device__ __forceinline__ float wave_sum(float v, int lane) {
#pragma unroll
  for (int o = 1; o < 64; o <<= 1) v += shx(v, o, lane);
  return v;
}
__device__ __forceinline__ bf16x8 mk8(u32x4 v) { union { u32x4 u; bf16x8 b; } x; x.u = v; return x.b; }
__device__ __forceinline__ bf16x8 mk8(u32x2 a, u32x2 b) { union { u32x4 u; bf16x8 b; } x; x.u = (u32x4){a.x, a.y, b.x, b.y}; return x.b; }
__device__ __forceinline__ float* hrow(const Ctx& cx, int row) { return row < NLAT ? cx.out + (size_t)row * D : (float*)(cx.ws + O_HCTX) + (size_t)(row - NLAT) * D; }
#define MFMA16(a, b, c) __builtin_amdgcn_mfma_f32_16x16x32_bf16(a, b, c, 0, 0, 0)

constexpr int BM = 256, BK = 64, HALF = 128, HT = HALF * BK, NXCD = 8, WGM = 8;
__device__ __forceinline__ int lds_byte(int r, int c) {
  int st = (r >> 4) * 2 + (c >> 5), rr = r & 15, cc = c & 31, ob = rr * 64 + cc * 2;
  return st * 1024 + (ob ^ (((ob >> 9) & 1) << 5));
}
__device__ __forceinline__ void stage_rc(int b, int& R, int& C) {
  int st = b / 1024, sb = b % 1024, swz = sb ^ (((sb >> 9) & 1) << 5);
  R = (st >> 1) * 16 + swz / 64; C = (st & 1) * 32 + (swz % 64) / 2;
}
struct RowMap { int lat0, ctx0, nlat; __device__ __forceinline__ int row0(int pm) const { return pm < nlat ? lat0 + pm * 256 : ctx0 + (pm - nlat) * 256; } };

typedef f32x4 Acc[2][2][4][2];

struct Epi {
  int kind; bf16_t* O; int ldc; const float* modl; int slot; float wgt;
};
__device__ __forceinline__ void run_epi(const Ctx& cx, const Epi& E, const Acc& acc, int r0, int pn, int wr, int wc, int fr, int fq) {
  if (E.kind == 0) {
#pragma unroll
    for (int ai = 0; ai < 2; ++ai)
#pragma unroll
      for (int m = 0; m < 4; ++m) {
        bf16_t* rp = E.O + (size_t)(r0 + ai * HALF + wr * 64 + m * 16 + fr) * E.ldc + pn * 256 + wc * 32 + 4 * fq;
#pragma unroll
        for (int bj = 0; bj < 2; ++bj)
#pragma unroll
          for (int n = 0; n < 2; ++n) {
            f32x4 v = acc[ai][bj][m][n];
            u32x2 o; o.x = pk2(v[0], v[1]); o.y = pk2(v[2], v[3]);
            *(u32x2*)(rp + bj * HALF + n * 16) = o;
          }
      }
  } else if (E.kind == 1) {
#pragma unroll
    for (int ai = 0; ai < 2; ++ai)
#pragma unroll
      for (int m = 0; m < 4; ++m) {
        bf16_t* rp = E.O + (size_t)(r0 + ai * HALF + wr * 64 + m * 16 + fr) * FF + pn * 128 + wc * 16 + 4 * fq;
#pragma unroll
        for (int bj = 0; bj < 2; ++bj) {
          f32x4 g = acc[ai][bj][m][0], v = acc[ai][bj][m][1];
          u32x2 o; o.x = pk2(silu_f(g[0]) * v[0], silu_f(g[1]) * v[1]); o.y = pk2(silu_f(g[2]) * v[2], silu_f(g[3]) * v[3]);
          *(u32x2*)(rp + bj * 64) = o;
        }
      }
  } else {
    const int midx = r0 < NLAT ? (r0 >> 12) : 8;
    const float* gp = E.modl + (size_t)midx * 9216 + (3 * E.slot + 2) * D + pn * 256 + wc * 32 + 4 * fq;
    f32x4 gv[2][2];
#pragma unroll
    for (int bj = 0; bj < 2; ++bj)
#pragma unroll
      for (int n = 0; n < 2; ++n) gv[bj][n] = *(const f32x4*)(gp + bj * HALF + n * 16) * E.wgt;
#pragma unroll
    for (int ai = 0; ai < 2; ++ai)
#pragma unroll
      for (int m = 0; m < 4; ++m) {
        float* rp = hrow(cx, r0 + ai * HALF + wr * 64 + m * 16 + fr) + pn * 256 + wc * 32 + 4 * fq;
        f32x4 h[2][2];
#pragma unroll
        for (int bj = 0; bj < 2; ++bj)
#pragma unroll
          for (int n = 0; n < 2; ++n) h[bj][n] = *(const f32x4*)(rp + bj * HALF + n * 16);
#pragma unroll
        for (int bj = 0; bj < 2; ++bj)
#pragma unroll
          for (int n = 0; n < 2; ++n) *(f32x4*)(rp + bj * HALF + n * 16) = h[bj][n] * ALPHA + gv[bj][n] * acc[ai][bj][m][n];
        __builtin_amdgcn_sched_barrier(0);
      }
  }
}

#define LAS __attribute__((address_space(3)))
__device__ __forceinline__ void gemm_phase(const Ctx& cx, const bf16_t* __restrict__ A, RowMap am, const bf16_t* __restrict__ Bt, int K, int nM, int nN, RowMap cm, const Epi& epi) {
  LAS unsigned char* lds = (LAS unsigned char*)lds_raw;
  constexpr int HTB = HT * 2;
  const int tid = cx.tid, wid = tid >> 6, lane = tid & 63, wr = wid >> 2, wc = wid & 3, fr = lane & 15, fq = lane >> 4;
  unsigned voff[2];
#pragma unroll
  for (int i = 0; i < 2; ++i) { int R, C; stage_rc(tid * 16 + i * 8192, R, C); voff[i] = (unsigned)(R * K + C) * 2u; }
  const size_t kstep = (size_t)(BK * 2), hstep = (size_t)HALF * K * 2;
  const unsigned ldsw = (unsigned)wid * 1024u;
  const int aoff = lds_byte(wr * 64 + fr, fq * 8), boff = lds_byte(wc * 32 + fr, fq * 8);
#define G_SA(b, h) (((b) * 2 + (h)) * HTB)
#define G_SB(b, h) ((4 + (b) * 2 + (h)) * HTB)
#define STAGE(bufoff, gbase) do { _Pragma("unroll") for (int _i = 0; _i < 2; ++_i) \
    __builtin_amdgcn_global_load_lds((const unsigned*)((const char*)(gbase) + voff[_i]), (LAS unsigned*)(lds + (bufoff) + ldsw + _i * 8192), 16, 0, 0); } while (0)
#define LDA(dst, b, h) do { _Pragma("unroll") for (int m = 0; m < 4; ++m) _Pragma("unroll") for (int k = 0; k < 2; ++k) dst[m][k] = *(const LAS bf16x8*)(lds + G_SA(b, h) + aoff + m * 2048 + k * 1024); } while (0)
#define LDB(dst, b, h) do { _Pragma("unroll") for (int n = 0; n < 2; ++n) _Pragma("unroll") for (int k = 0; k < 2; ++k) dst[n][k] = *(const LAS bf16x8*)(lds + G_SB(b, h) + boff + n * 2048 + k * 1024); } while (0)
#define MMA(ai, bj, At, Bt_) do { __builtin_amdgcn_s_setprio(1); _Pragma("unroll") for (int m = 0; m < 4; ++m) _Pragma("unroll") for (int n = 0; n < 2; ++n) _Pragma("unroll") for (int k = 0; k < 2; ++k) \
      acc[ai][bj][m][n] = MFMA16(Bt_[n][k], At[m][k], acc[ai][bj][m][n]); \
    __builtin_amdgcn_s_setprio(0); } while (0)
#define WAIT_V(n) asm volatile("s_waitcnt vmcnt(" #n ")" ::: "memory")
#define WAIT_L(n) asm volatile("s_waitcnt lgkmcnt(" #n ")" ::: "memory")
#define BAR __builtin_amdgcn_s_barrier()
#define SCHED __builtin_amdgcn_sched_barrier(0)
  const int nwg = nM * nN;
  const int nt = K / BK;
  const int wid_s = __builtin_amdgcn_readfirstlane(wid);
#define DECODE(L_, pm_, pn_) do { int wgid = (L_); \
    { int q = nwg / NXCD, r = nwg % NXCD, xcd = wgid % NXCD, off = wgid / NXCD; wgid = (xcd < r ? xcd * (q + 1) : r * (q + 1) + (xcd - r) * q) + off; } \
    const int nig = WGM * nN, gid = wgid / nig, fm = gid * WGM, gsz = min(nM - fm, WGM); \
    pm_ = fm + ((wgid % nig) % gsz); pn_ = (wgid % nig) / gsz; } while (0)
  int L = cx.bid;
  if (L < nwg) {
    int pm, pn;
    DECODE(L, pm, pn);
    const char* cA = (const char*)A + (size_t)am.row0(pm) * K * 2; const char* cB = (const char*)Bt + (size_t)pn * BM * K * 2;
    Acc acc;
#pragma unroll
    for (int a = 0; a < 2; ++a)
#pragma unroll
      for (int b = 0; b < 2; ++b)
#pragma unroll
        for (int m = 0; m < 4; ++m)
#pragma unroll
          for (int n = 0; n < 2; ++n) acc[a][b][m][n] = (f32x4){0.f, 0.f, 0.f, 0.f};
    bf16x8 At[4][2], B0[2][2], B1[2][2];
    STAGE(G_SB(0, 0), cB); STAGE(G_SA(0, 0), cA); STAGE(G_SB(0, 1), cB + hstep); STAGE(G_SA(0, 1), cA + hstep);
    if (wr == 1) BAR;
    WAIT_V(4); BAR;
    STAGE(G_SB(1, 0), cB + kstep); STAGE(G_SA(1, 0), cA + kstep); STAGE(G_SB(1, 1), cB + hstep + kstep);
    WAIT_V(6); BAR;
    for (;;) {
      const int Ln = L + cx.nb;
      const bool has_next = Ln < nwg;
      int pmn = pm, pnn = pn;
      if (has_next) DECODE(Ln, pmn, pnn);
      const char* nA = has_next ? (const char*)A + (size_t)am.row0(pmn) * K * 2 : cA; const char* nB = has_next ? (const char*)Bt + (size_t)pnn * BM * K * 2 : cB;
      for (int t = 0; t < nt; t += 2) {
        const bool last = (t == nt - 2);
        const char* a1 = cA + (size_t)(t + 1) * kstep;
        const char* a2 = last ? nA : cA + (size_t)(t + 2) * kstep; const char* b2 = last ? nB : cB + (size_t)(t + 2) * kstep;
        const char* a3 = a2 + kstep; const char* b3 = b2 + kstep;
        LDB(B0, 0, 0); SCHED; LDA(At, 0, 0); STAGE(G_SA(1, 1), a1 + hstep);
        WAIT_L(8); BAR; WAIT_L(0); MMA(0, 0, At, B0); BAR; SCHED;
        LDB(B1, 0, 1); STAGE(G_SB(0, 0), b2);
        BAR; WAIT_L(0); MMA(0, 1, At, B1); BAR;
        LDA(At, 0, 1); STAGE(G_SA(0, 0), a2);
        BAR; WAIT_L(0); MMA(1, 0, At, B0); BAR; SCHED;
        STAGE(G_SB(0, 1), b2 + hstep);
        WAIT_V(6); BAR; MMA(1, 1, At, B1); BAR;
        LDB(B0, 1, 0); SCHED; LDA(At, 1, 0); STAGE(G_SA(0, 1), a2 + hstep);
        WAIT_L(8); BAR; WAIT_L(0); MMA(0, 0, At, B0); BAR; SCHED;
        LDB(B1, 1, 1); STAGE(G_SB(1, 0), b3);
        BAR; WAIT_L(0); MMA(0, 1, At, B1); BAR;
        LDA(At, 1, 1); STAGE(G_SA(1, 0), a3);
        BAR; WAIT_L(0); MMA(1, 0, At, B0); BAR; SCHED;
        STAGE(G_SB(1, 1), b3 + hstep);
        WAIT_V(6); BAR; MMA(1, 1, At, B1); BAR;
      }
      { int t2 = wid_s * 64 + (int)__builtin_amdgcn_mbcnt_hi(~0u, __builtin_amdgcn_mbcnt_lo(~0u, (unsigned)cx.z)); asm volatile("" : "+v"(t2));
        const int w2 = t2 >> 6, l2 = t2 & 63;
        run_epi(cx, epi, acc, cm.row0(pm), pn, w2 >> 2, w2 & 3, l2 & 15, l2 >> 4); }
      if (!has_next) break;
#pragma unroll
      for (int a = 0; a < 2; ++a)
#pragma unroll
        for (int b = 0; b < 2; ++b)
#pragma unroll
          for (int m = 0; m < 4; ++m)
#pragma unroll
            for (int n = 0; n < 2; ++n) acc[a][b][m][n] = (f32x4){0.f, 0.f, 0.f, 0.f};
      pm = pmn; pn = pnn; cA = nA; cB = nB; L = Ln;
    }
    WAIT_V(0);
    if (wr == 0) BAR;
    BAR;
  }
  __syncthreads();
}

template <int MODE>
__device__ __forceinline__ int wrow(int c) {
  if (MODE == 0) return c;
  const int isv = c >= FF ? 1 : 0, f = c - isv * FF;
  return (f >> 7) * 256 + ((f >> 6) & 1) * 128 + ((f >> 4) & 3) * 32 + isv * 16 + (f & 15);
}
template <int MODE>
__device__ __forceinline__ void transpose_item(const float* __restrict__ W, int K, int N, bf16_t* __restrict__ WT, float* scr, int item, int lane) {
  const int nblk = N / 32, kb = item / nblk, nb = item % nblk, k0 = 64 * kb, n0 = 32 * nb;
#pragma unroll 8
  for (int i = 0; i < 32; ++i) { const int kk = 2 * i + (lane >> 5); scr[kk * 33 + (lane & 31)] = W[(size_t)(k0 + kk) * N + n0 + (lane & 31)]; }
  __builtin_amdgcn_wave_barrier(); asm volatile("s_waitcnt lgkmcnt(0)" ::: "memory");
  const int c = lane & 7;
#pragma unroll
  for (int j = 0; j < 4; ++j) {
    const int n = (lane >> 3) + 8 * j; const float* s = scr + (8 * c) * 33 + n;
    u32x4 o; o.x = pk2(s[0 * 33], s[1 * 33]); o.y = pk2(s[2 * 33], s[3 * 33]); o.z = pk2(s[4 * 33], s[5 * 33]); o.w = pk2(s[6 * 33], s[7 * 33]);
    *(u32x4*)(WT + (size_t)wrow<MODE>(n0 + n) * K + k0 + 8 * c) = o;
  }
  asm volatile("s_waitcnt lgkmcnt(0)" ::: "memory"); __builtin_amdgcn_wave_barrier();
}

__device__ __forceinline__ void prologue(const Params& p, const Ctx& cx) {
  const int tid = cx.tid, lane = tid & 63, wave = tid >> 6;
  char* ws = cx.ws;
  {
    float* cond = (float*)lds_raw;
    float* red = (float*)(lds_raw + 9 * 1024 * 4);
    for (int i = tid; i < 9 * 1024; i += 512) { const int j = i >> 10, k = i & 1023; cond[i] = silu_f(j < 8 ? IN(1)[j * 1024 + k] : IN(3)[k]); }
    __syncthreads();
    for (int u = cx.bid; u < 4 * 36; u += cx.nb) {
      const int layer = u / 36, ct = u % 36, c0 = ct * 256 + 4 * lane;
      const float* wp = IN(4) + (size_t)layer * D * 9216 + c0;
      f32x4 a[9];
#pragma unroll
      for (int j = 0; j < 9; ++j) a[j] = (f32x4){0.f, 0.f, 0.f, 0.f};
#pragma unroll 4
      for (int k = wave * 128; k < wave * 128 + 128; ++k) {
        const f32x4 w = *(const f32x4*)(wp + (size_t)k * 9216);
#pragma unroll
        for (int j = 0; j < 9; ++j) a[j] += w * cond[j * 1024 + k];
      }
#pragma unroll
      for (int j = 0; j < 9; ++j) *(f32x4*)(red + (wave * 9 + j) * 256 + 4 * lane) = a[j];
      __syncthreads();
      float* mt = (float*)(ws + O_MODT) + (size_t)layer * 9 * 9216;
      for (int i = tid; i < 9 * 256; i += 512) {
        const int j = i >> 8, c = i & 255; float s = 0.f;
#pragma unroll
        for (int w = 0; w < 8; ++w) s += red[(w * 9 + j) * 256 + c];
        mt[(size_t)j * 9216 + ct * 256 + c] = s + IN(5)[layer * 9216 + ct * 256 + c];
      }
      __syncthreads();
    }
    __syncthreads();
  }
  {
    float* scr = (float*)lds_raw + wave * (64 * 33);
    const int gw = cx.bid * 8 + wave, NGW = cx.nb * 8;
    constexpr int I_FI = 16 * 176, I_FO = 44 * 32, I_UP = 16 * 128, I_DN = 32 * 32, I_AQ = 16 * 48, I_AO = 16 * 32, I_SI = 16 * 96, I_SO = 16 * 32;
    constexpr int NITEMS = 8 * I_FI + 8 * I_FO + 2 * I_UP + 2 * I_DN + I_AQ + I_AO + I_SI + I_SO;
    for (int it = gw; it < NITEMS; it += NGW) {
      int r = it;
      if (r < 8 * I_FI) { const int mi = r / I_FI; transpose_item<1>(IN(8) + (size_t)mi * 1024 * 5632, 1024, 5632, (bf16_t*)(ws + O_WFI) + (size_t)mi * 5632 * 1024, scr, r % I_FI, lane); continue; } r -= 8 * I_FI;
      if (r < 8 * I_FO) { const int mi = r / I_FO; transpose_item<0>(IN(9) + (size_t)mi * 2816 * 1024, 2816, 1024, (bf16_t*)(ws + O_WFO) + (size_t)mi * 1024 * 2816, scr, r % I_FO, lane); continue; } r -= 8 * I_FO;
      if (r < 2 * I_UP) { const int mi = r / I_UP; transpose_item<0>(IN(10) + (size_t)mi * 1024 * 4096, 1024, 4096, (bf16_t*)(ws + O_WUP) + (size_t)mi * 4096 * 1024, scr, r % I_UP, lane); continue; } r -= 2 * I_UP;
      if (r < 2 * I_DN) { const int mi = r / I_DN; transpose_item<0>(IN(18) + (size_t)mi * 2048 * 1024, 2048, 1024, (bf16_t*)(ws + O_WDN) + (size_t)mi * 1024 * 2048, scr, r % I_DN, lane); continue; } r -= 2 * I_DN;
      if (r < I_AQ) { transpose_item<0>(IN(19), 1024, 1536, (bf16_t*)(ws + O_WAQ), scr, r, lane); continue; } r -= I_AQ;
      if (r < I_AO) { transpose_item<0>(IN(21), 1024, 1024, (bf16_t*)(ws + O_WAO), scr, r, lane); continue; } r -= I_AO;
      if (r < I_SI) { transpose_item<0>(IN(22), 1024, 3072, (bf16_t*)(ws + O_WSI), scr, r, lane); continue; } r -= I_SI;
      transpose_item<0>(IN(24), 1024, 1024, (bf16_t*)(ws + O_WSO), scr, r, lane);
    }
  }
  {
    const int gt = cx.bid * 512 + tid, gs = cx.nb * 512;
    bf16_t* wg = (bf16_t*)(ws + O_WG);
    for (int i = gt; i < 2 * 16 * 6144; i += gs) {
      const int j = i / (16 * 6144), xg = (i / 6144) & 15, k = i % 6144, x = xg >> 3, g = xg & 7;
      const float* wif = IN(14) + (size_t)(j * 2 + x) * 6144 * 8;
      float v;
      if (k < 2048) v = wif[(size_t)k * 8 + g];
      else if (k < 4096) v = wif[(size_t)k * 8 + g] * 22.627416997969522f;
      else {
        const int c = k - 4096, blk = c >> 2, cc = c & 3;
        const float* wv = IN(13) + ((size_t)(j * 3 + 2) * 512 + blk) * 16 + cc * 4;
        v = 0.f;
        for (int d2 = 0; d2 < 4; ++d2) v += wv[d2] * wif[(size_t)(4096 + 4 * blk + d2) * 8 + g];
      }
      wg[i] = (bf16_t)(pk2(v, 0.f) & 0xffff);
    }
    float* rc = (float*)(ws + O_ROPE); float* rs = rc + 4096 * 32;
    for (int i = gt; i < 4096 * 32; i += gs) {
      const int pos = i >> 5, pp = i & 31, jf = pp & 15;
      const float fr_ = __builtin_amdgcn_exp2f(-(float)jf * (13.287712379549449f / 16.f));
      float rev = (float)(pp < 16 ? (pos >> 6) : (pos & 63)) * fr_ * 0.15915494309189535f;
      rev -= rintf(rev);
      rc[i] = __builtin_amdgcn_cosf(rev); rs[i] = __builtin_amdgcn_sinf(rev);
    }
  }
}

template <int MODE>
__device__ __forceinline__ void lnmod_phase(const Params& p, const Ctx& cx, int lnidx  , int layer, int slot) {
  const int lane = cx.tid & 63, gw = cx.bid * 8 + (cx.tid >> 6), NGW = cx.nb * 8;
  const int nrows = MODE == 2 ? NLAT : MROWS;
  const float* lg = IN(6) + (size_t)lnidx * D; const float* lb = IN(7) + (size_t)lnidx * D;
  const float* modl = (const float*)(cx.ws + O_MODT) + (size_t)layer * 9 * 9216;
  bf16_t* U = (bf16_t*)(cx.ws + O_U);
  for (int row = gw; row < nrows; row += NGW) {
    float* hp = hrow(cx, row);
    const float* src = MODE == 0 ? (row < NLAT ? IN(0) + (size_t)row * D : IN(2) + (size_t)(row - NLAT) * D) : hp;
    f32x4 v[4];
#pragma unroll
    for (int j = 0; j < 4; ++j) v[j] = *(const f32x4*)(src + 4 * lane + 256 * j);
    if (MODE != 0) {
      float s = 0.f;
#pragma unroll
      for (int j = 0; j < 4; ++j) s += (v[j][0] + v[j][1]) + (v[j][2] + v[j][3]);
      const float mean = wave_sum(s, lane) * (1.f / D); float s2 = 0.f;
#pragma unroll
      for (int j = 0; j < 4; ++j) { v[j] = v[j] - mean; s2 += (v[j][0] * v[j][0] + v[j][1] * v[j][1]) + (v[j][2] * v[j][2] + v[j][3] * v[j][3]); }
      const float rstd = __builtin_amdgcn_rsqf(wave_sum(s2, lane) * (1.f / D) + LN_EPS);
#pragma unroll
      for (int j = 0; j < 4; ++j) v[j] = v[j] * rstd * *(const f32x4*)(lg + 4 * lane + 256 * j) + *(const f32x4*)(lb + 4 * lane + 256 * j);
    }
#pragma unroll
    for (int j = 0; j < 4; ++j) *(f32x4*)(hp + 4 * lane + 256 * j) = v[j];
    if (MODE != 2) {
      const int midx = row < NLAT ? (row >> 12) : 8;
      const float* sh = modl + (size_t)midx * 9216 + (3 * slot) * D; const float* sc = sh + D;
#pragma unroll
      for (int j = 0; j < 4; ++j) {
        const f32x4 u = v[j] * (*(const f32x4*)(sc + 4 * lane + 256 * j) + 1.f) + *(const f32x4*)(sh + 4 * lane + 256 * j);
        u32x2 o; o.x = pk2(u[0], u[1]); o.y = pk2(u[2], u[3]);
        *(u32x2*)(U + (size_t)row * D + 4 * lane + 256 * j) = o;
      }
    }
  }
}

__device__ __forceinline__ int ml_lrow(int bl, int tok) { return tok < LC ? GB * SEQ + bl * LC + tok : bl * SEQ + (tok - LC); }
__device__ __forceinline__ int ml_nchunk(int x, int st) { return x == 0 ? st : (st < 4 ? 3 - st : 71 - st); }

__device__ __forceinline__ void ml_m0(const Params& p, const Ctx& cx, int j) {
  const int tid = cx.tid;
  char* ws = cx.ws;
  const bf16_t* XZ = (const bf16_t*)(ws + O_XZ);
  bf16_t* QK = (bf16_t*)(ws + O_QK); bf16_t* KT = (bf16_t*)(ws + O_KT); bf16_t* VT = (bf16_t*)(ws + O_VT);
  bf16_t* lk = (bf16_t*)lds_raw;
  bf16_t* lv = lk + 256 * 72;
  const int blk_l = tid & 63, tq = tid >> 6;
  for (int u = cx.bid; u < GB * NCH * 8; u += cx.nb) {
    const int slab = u & 7, ch = (u >> 3) % NCH, bl = u / (8 * NCH);
    const int f0 = slab * 256 + blk_l * 4, blk = f0 >> 2;
    float cw[3][4], cb[4], wq[16], wk[16], wv[16];
#pragma unroll
    for (int k = 0; k < 3; ++k)
#pragma unroll
      for (int c = 0; c < 4; ++c) cw[k][c] = IN(11)[(size_t)(j * 3 + k) * EI + f0 + c];
#pragma unroll
    for (int c = 0; c < 4; ++c) cb[c] = IN(12)[(size_t)j * EI + f0 + c];
#pragma unroll
    for (int i = 0; i < 16; ++i) {
      wq[i] = IN(13)[((size_t)(j * 3 + 0) * 512 + blk) * 16 + i];
      wk[i] = IN(13)[((size_t)(j * 3 + 1) * 512 + blk) * 16 + i] * 0.04419417382415922f;
      wv[i] = IN(13)[((size_t)(j * 3 + 2) * 512 + blk) * 16 + i];
    }
    const int tok0 = ch * 64, seg_lo = tok0 < LC ? 0 : LC, seg_hi = tok0 < LC ? LC : TOKB;
    for (int tt = 0; tt < 8; ++tt) {
      const int tl = tq + 8 * tt, tok = tok0 + tl;
      float xm[3][4];
#pragma unroll
      for (int k = 0; k < 3; ++k) {
        const int t2 = tok + k - 1;
        if (t2 >= seg_lo && t2 < seg_hi) {
          const u32x2 r = *(const u32x2*)(XZ + (size_t)ml_lrow(bl, t2) * 4096 + f0);
          xm[k][0] = bflo(r.x); xm[k][1] = bfhi(r.x); xm[k][2] = bflo(r.y); xm[k][3] = bfhi(r.y);
        } else { xm[k][0] = xm[k][1] = xm[k][2] = xm[k][3] = 0.f; }
      }
      float xc[4], q[4], kk[4], vv[4];
#pragma unroll
      for (int c = 0; c < 4; ++c) xc[c] = silu_f(cw[0][c] * xm[0][c] + cw[1][c] * xm[1][c] + cw[2][c] * xm[2][c] + cb[c]);
#pragma unroll
      for (int d2 = 0; d2 < 4; ++d2) {
        q[d2] = xc[0] * wq[d2] + xc[1] * wq[4 + d2] + xc[2] * wq[8 + d2] + xc[3] * wq[12 + d2];
        kk[d2] = xc[0] * wk[d2] + xc[1] * wk[4 + d2] + xc[2] * wk[8 + d2] + xc[3] * wk[12 + d2];
        vv[d2] = xm[1][0] * wv[d2] + xm[1][1] * wv[4 + d2] + xm[1][2] * wv[8 + d2] + xm[1][3] * wv[12 + d2];
      }
      const size_t lr = ml_lrow(bl, tok);
      u32x2 oq, ok, ov; oq.x = pk2(q[0], q[1]); oq.y = pk2(q[2], q[3]); ok.x = pk2(kk[0], kk[1]); ok.y = pk2(kk[2], kk[3]); ov.x = pk2(vv[0], vv[1]); ov.y = pk2(vv[2], vv[3]);
      *(u32x2*)(QK + lr * 4096 + f0) = oq;
      *(u32x2*)(QK + lr * 4096 + 2048 + f0) = ok;
      const int fl = blk_l * 4;
      lk[(fl + 0) * 72 + tl] = (bf16_t)(ok.x & 0xffff); lk[(fl + 1) * 72 + tl] = (bf16_t)(ok.x >> 16); lk[(fl + 2) * 72 + tl] = (bf16_t)(ok.y & 0xffff); lk[(fl + 3) * 72 + tl] = (bf16_t)(ok.y >> 16);
      lv[(fl + 0) * 72 + tl] = (bf16_t)(ov.x & 0xffff); lv[(fl + 1) * 72 + tl] = (bf16_t)(ov.x >> 16); lv[(fl + 2) * 72 + tl] = (bf16_t)(ov.y & 0xffff); lv[(fl + 3) * 72 + tl] = (bf16_t)(ov.y >> 16);
    }
    __syncthreads();
    {
      const int arr = tid >> 8, fr_ = tid & 255;
      const bf16_t* src = (arr ? lv : lk) + fr_ * 72;
      bf16_t* dst = (arr ? VT : KT) + ((size_t)bl * EI + slab * 256 + fr_) * TOKB + tok0;
#pragma unroll
      for (int i = 0; i < 8; ++i) *(u32x4*)(dst + 8 * i) = *(const u32x4*)(src + 8 * i);
    }
    __syncthreads();
  }
}

__device__ __forceinline__ void ml_gates(const Params& p, const Ctx& cx, int j) {
  const int tid = cx.tid, lane = tid & 63, wave = tid >> 6, fr = lane & 15, fq = lane >> 4;
  char* ws = cx.ws;
  const bf16_t* XZ = (const bf16_t*)(ws + O_XZ); const bf16_t* QK = (const bf16_t*)(ws + O_QK);
  const bf16_t* WG = (const bf16_t*)(ws + O_WG) + (size_t)j * 16 * 6144;
  float* BL = (float*)(ws + O_BL); float* IG = (float*)(ws + O_IG);
  float* GC = (float*)(ws + O_GC); float* AC = GC + NSEQ * NCH;
  float* part = (float*)lds_raw;
  float* gl = part + 8 * 64 * 16;
  for (int u = cx.bid; u < GB * NCH; u += cx.nb) {
    const int bl = u / NCH, nc = u % NCH, tok0 = nc * 64;
    f32x4 acc[4];
#pragma unroll
    for (int m = 0; m < 4; ++m) acc[m] = (f32x4){0.f, 0.f, 0.f, 0.f};
    size_t lr[4];
#pragma unroll
    for (int m = 0; m < 4; ++m) lr[m] = ml_lrow(bl, tok0 + m * 16 + fr);
#pragma unroll 4
    for (int ks = wave * 24; ks < wave * 24 + 24; ++ks) {
      const int k = ks * 32 + fq * 8;
      const bf16x8 bfr = *(const bf16x8*)(WG + (size_t)fr * 6144 + k);
#pragma unroll
      for (int m = 0; m < 4; ++m) {
        const bf16_t* ap = k < 4096 ? QK + lr[m] * 4096 + k : XZ + lr[m] * 4096 + (k - 4096);
        const bf16x8 afr = *(const bf16x8*)ap;
        acc[m] = MFMA16(afr, bfr, acc[m]);
      }
    }
#pragma unroll
    for (int m = 0; m < 4; ++m)
#pragma unroll
      for (int jj = 0; jj < 4; ++jj) part[(wave * 64 + m * 16 + 4 * fq + jj) * 16 + fr] = acc[m][jj];
    __syncthreads();
    for (int i = tid; i < 1024; i += 512) {
      float s = IN(15)[(size_t)j * 16 + (i & 15)];
#pragma unroll
      for (int w = 0; w < 8; ++w) s += part[w * 1024 + i];
      gl[(i >> 4) * 17 + (i & 15)] = s;
    }
    __syncthreads();
    if (tid < 8) {
      const int x = tid >> 2, h = tid & 3, seq = (bl * 2 + x) * 4 + h;
      float b = 0.f, mx = -3.0e38f;
      for (int pp = 0; pp < 64; ++pp) {
        const int tl = x == 0 ? pp : 63 - pp;
        const float ig = gl[tl * 17 + x * 8 + h], fg = gl[tl * 17 + x * 8 + 4 + h];
        const float lf = fg > 0.f ? -__logf(1.f + __expf(-fg)) : fg - __logf(1.f + __expf(fg));
        b += lf;
        BL[(size_t)seq * TOKB + tok0 + tl] = b; IG[(size_t)seq * TOKB + tok0 + tl] = ig;
        mx = fmaxf(mx, ig - b);
      }
      GC[seq * NCH + nc] = b; AC[seq * NCH + nc] = b + mx;
    }
    __syncthreads();
  }
}

__device__ __forceinline__ void ml_s(const Params& p, const Ctx& cx) {
  const int tid = cx.tid, lane = tid & 63, wave = tid >> 6, fr = lane & 15, fq = lane >> 4;
  char* ws = cx.ws;
  const bf16_t* QK = (const bf16_t*)(ws + O_QK);
  bf16_t* SP = (bf16_t*)(ws + O_SP);
  const float* BL = (const float*)(ws + O_BL); const float* IG = (const float*)(ws + O_IG);
  float* WIN = (float*)(ws + O_WIN); float* FLO = (float*)(ws + O_FLO); float* DEN = (float*)(ws + O_DEN); float* WSS = (float*)(ws + O_WSS);
  const float* GC = (const float*)(ws + O_GC); const float* AC = GC + NSEQ * NCH; float* DEC = (float*)(ws + O_GC) + 2 * NSEQ * NCH;
  float* sb_ = (float*)lds_raw; float* si_ = sb_ + 64; float* smt = si_ + 64; float* sden = smt + 64;
  for (int u = cx.bid; u < NSEQ * NCH; u += cx.nb) {
    const int seq = u / NCH, st = u % NCH, x = (seq >> 2) & 1, h = seq & 3, bl = seq >> 3;
    const int nc = ml_nchunk(x, st), tok0 = nc * 64;
    if (wave == 0) {
      const int nl0 = ml_nchunk(x, lane), nl1 = ml_nchunk(x, 64 + (lane & 3));
      const float g0 = GC[seq * NCH + nl0], a0 = AC[seq * NCH + nl0], g1 = GC[seq * NCH + nl1], a1 = AC[seq * NCH + nl1];
      float mc = 0.f;
      for (int s2 = 0; s2 < st; ++s2) {
        const float gg = __int_as_float(__builtin_amdgcn_readlane(__float_as_int(s2 < 64 ? g0 : g1), s2 & 63));
        const float aa = __int_as_float(__builtin_amdgcn_readlane(__float_as_int(s2 < 64 ? a0 : a1), s2 & 63));
        mc = fmaxf(gg + mc, aa);
      }
      const float gc = GC[seq * NCH + nc], ac = AC[seq * NCH + nc];
      const float mnew = fmaxf(gc + mc, ac);
      const int tl = x == 0 ? lane : 63 - lane;
      const float b = BL[(size_t)seq * TOKB + tok0 + tl], ig = IG[(size_t)seq * TOKB + tok0 + tl];
      float cm = ig - b;
#pragma unroll
      for (int o = 1; o < 64; o <<= 1) { const float t2 = shi(cm, lane - o); if (lane >= o) cm = fmaxf(cm, t2); }
      const float mt = b + fmaxf(mc, cm);
      sb_[tl] = b; si_[tl] = ig; smt[tl] = mt;
      WIN[(size_t)seq * TOKB + tok0 + tl] = __expf(b + mc - mt);
      FLO[(size_t)seq * TOKB + tok0 + tl] = __expf(-mt);
      WSS[(size_t)seq * TOKB + tok0 + tl] = __expf(gc - b + ig - mnew);
      if (lane == 0) DEC[seq * NCH + nc] = __expf(gc + mc - mnew);
    }
    __syncthreads();
    const int sbk = wave >> 1;
    const bf16_t* kp = QK + (size_t)ml_lrow(bl, tok0 + sbk * 16 + fr) * 4096 + 2048 + h * DH + fq * 8;
    const bf16_t* qp0 = QK + (size_t)ml_lrow(bl, tok0 + (2 * (wave & 1)) * 16 + fr) * 4096 + h * DH + fq * 8;
    const bf16_t* qp1 = QK + (size_t)ml_lrow(bl, tok0 + (2 * (wave & 1) + 1) * 16 + fr) * 4096 + h * DH + fq * 8;
    f32x4 a0 = {0.f, 0.f, 0.f, 0.f}, a1 = {0.f, 0.f, 0.f, 0.f};
#pragma unroll 4
    for (int ks = 0; ks < 16; ++ks) {
      const bf16x8 kf = *(const bf16x8*)(kp + ks * 32), q0 = *(const bf16x8*)(qp0 + ks * 32), q1 = *(const bf16x8*)(qp1 + ks * 32);
      a0 = MFMA16(kf, q0, a0); a1 = MFMA16(kf, q1, a1);
    }
    bf16_t* spu = SP + (size_t)(seq * NCH + nc) * 4096;
#pragma unroll
    for (int tbi = 0; tbi < 2; ++tbi) {
      const int t = (2 * (wave & 1) + tbi) * 16 + fr;
      const f32x4 a = tbi ? a1 : a0;
      const float bt = sb_[t], mt = smt[t];
      float vals[4];
#pragma unroll
      for (int jj = 0; jj < 4; ++jj) {
        const int s = sbk * 16 + 4 * fq + jj;
        const bool ok = x == 0 ? (s <= t) : (s >= t);
        vals[jj] = ok ? a[jj] * __expf(bt - sb_[s] + si_[s] - mt) : 0.f;
      }
      u32x2 o; o.x = pk2(vals[0], vals[1]); o.y = pk2(vals[2], vals[3]);
      *(u32x2*)(spu + t * 64 + sbk * 16 + 4 * fq) = o;
      float ds = (bflo(o.x) + bfhi(o.x)) + (bflo(o.y) + bfhi(o.y));
      ds += shx(ds, 16, lane); ds += shx(ds, 32, lane);
      if (fq == 0) sden[sbk * 64 + t] = ds;
    }
    __syncthreads();
    if (tid < 64) DEN[(size_t)seq * TOKB + tok0 + tid] = (sden[tid] + sden[64 + tid]) + (sden[128 + tid] + sden[192 + tid]);
    __syncthreads();
  }
}

constexpr int NEB = 2, NSL = 512 / (16 * NEB);
__device__ __forceinline__ void ml_m2(const Params& p, const Ctx& cx) {
  const int tid = cx.tid, lane = tid & 63, wave = tid >> 6, fr = lane & 15, fq = lane >> 4;
  char* ws = cx.ws;
  const bf16_t* QK = (const bf16_t*)(ws + O_QK); const bf16_t* KT = (const bf16_t*)(ws + O_KT); const bf16_t* VT = (const bf16_t*)(ws + O_VT);
  const bf16_t* SP = (const bf16_t*)(ws + O_SP);
  bf16_t* HD = (bf16_t*)(ws + O_HD);
  const float* WIN = (const float*)(ws + O_WIN); const float* FLO = (const float*)(ws + O_FLO); const float* DEN = (const float*)(ws + O_DEN); const float* WSS = (const float*)(ws + O_WSS);
  const float* DEC = (const float*)(ws + O_GC) + 2 * NSEQ * NCH;
  f32x4* red = (f32x4*)lds_raw;
  f32x4* rn = (f32x4*)(lds_raw + 131072);
  for (int idx = cx.bid >> 3; idx < 2 * NSL; idx += cx.nb >> 3) {
    const int seq = (cx.bid & 7) * 2 + idx / NSL, es = idx % NSL, x = (seq >> 2) & 1, h = seq & 3, bl = seq >> 3;
    const int d0 = wave * 64, e0 = es * 16 * NEB;
    f32x4 C[4][NEB + 1];
#pragma unroll
    for (int a = 0; a < 4; ++a)
#pragma unroll
      for (int b = 0; b < NEB + 1; ++b) C[a][b] = (f32x4){0.f, 0.f, 0.f, 0.f};
    const int tbo = wave >> 1, ebo = wave & 1;
    for (int st = 0; st < NCH; ++st) {
      const int nc = ml_nchunk(x, st), tok0 = nc * 64;
      bf16x8 qc[4][2];
#pragma unroll
      for (int tb = 0; tb < 4; ++tb) {
        const bf16_t* qp = QK + (size_t)ml_lrow(bl, tok0 + tb * 16 + fr) * 4096 + h * DH + d0 + 4 * fq;
        qc[tb][0] = mk8(*(const u32x2*)(qp), *(const u32x2*)(qp + 16));
        qc[tb][1] = mk8(*(const u32x2*)(qp + 32), *(const u32x2*)(qp + 48));
      }
      bf16x8 kf[4][2];
#pragma unroll
      for (int db = 0; db < 4; ++db) {
        const bf16_t* kp = KT + ((size_t)bl * EI + h * DH + d0 + db * 16 + fr) * TOKB + tok0 + 8 * fq;
        kf[db][0] = *(const bf16x8*)kp; kf[db][1] = *(const bf16x8*)(kp + 32);
      }
      u32x4 vr[NEB][2];
#pragma unroll
      for (int eb = 0; eb < NEB; ++eb) {
        const bf16_t* vp = VT + ((size_t)bl * EI + h * DH + e0 + eb * 16 + fr) * TOKB + tok0 + 8 * fq;
        vr[eb][0] = *(const u32x4*)vp; vr[eb][1] = *(const u32x4*)(vp + 32);
      }
      f32x4 wv[2][2];
#pragma unroll
      for (int ks = 0; ks < 2; ++ks) {
        const float* wp = WSS + (size_t)seq * TOKB + tok0 + 32 * ks + 8 * fq;
        wv[ks][0] = *(const f32x4*)wp; wv[ks][1] = *(const f32x4*)(wp + 4);
      }
      const bf16_t* sp = SP + (size_t)(seq * NCH + nc) * 4096 + (tbo * 16 + fr) * 64 + 8 * fq;
      const bf16x8 sf0 = *(const bf16x8*)sp, sf1 = *(const bf16x8*)(sp + 32);
      const size_t tix = (size_t)seq * TOKB + tok0 + tbo * 16 + 4 * fq;
      const f32x4 win = *(const f32x4*)(WIN + tix), flo = *(const f32x4*)(FLO + tix), deni = *(const f32x4*)(DEN + tix);
      const float decay = DEC[seq * NCH + nc];
#pragma unroll
      for (int eb = 0; eb < NEB + 1; ++eb) {
        bf16x8 cb0, cb1;
        { const f32x4 lo = C[0][eb], hi = C[1][eb]; cb0 = mk8((u32x4){pk2(lo[0], lo[1]), pk2(lo[2], lo[3]), pk2(hi[0], hi[1]), pk2(hi[2], hi[3])}); }
        { const f32x4 lo = C[2][eb], hi = C[3][eb]; cb1 = mk8((u32x4){pk2(lo[0], lo[1]), pk2(lo[2], lo[3]), pk2(hi[0], hi[1]), pk2(hi[2], hi[3])}); }
        f32x4 pa[4];
#pragma unroll
        for (int tb = 0; tb < 4; ++tb) pa[tb] = MFMA16(qc[tb][0], cb0, ((f32x4){0.f, 0.f, 0.f, 0.f}));
#pragma unroll
        for (int tb = 0; tb < 4; ++tb) pa[tb] = MFMA16(qc[tb][1], cb1, pa[tb]);
#pragma unroll
        for (int tb = 0; tb < 4; ++tb) {
          if (eb < NEB) red[((wave * 4 + tb) * NEB + eb) * 64 + lane] = pa[tb];
          else if (fr == 0) rn[(wave * 4 + tb) * 4 + fq] = pa[tb];
        }
      }
      f32x4 oi = {0.f, 0.f, 0.f, 0.f};
#pragma unroll
      for (int eb = 0; eb < NEB + 1; ++eb) {
        bf16x8 vw0, vw1;
        if (eb < NEB) {
          const u32x4 r0 = vr[eb][0], r1 = vr[eb][1];
          if (eb == ebo) { oi = MFMA16(sf0, mk8(r0), oi); oi = MFMA16(sf1, mk8(r1), oi); }
          vw0 = mk8((u32x4){pk2(bflo(r0.x) * wv[0][0][0], bfhi(r0.x) * wv[0][0][1]), pk2(bflo(r0.y) * wv[0][0][2], bfhi(r0.y) * wv[0][0][3]),
                            pk2(bflo(r0.z) * wv[0][1][0], bfhi(r0.z) * wv[0][1][1]), pk2(bflo(r0.w) * wv[0][1][2], bfhi(r0.w) * wv[0][1][3])});
          vw1 = mk8((u32x4){pk2(bflo(r1.x) * wv[1][0][0], bfhi(r1.x) * wv[1][0][1]), pk2(bflo(r1.y) * wv[1][0][2], bfhi(r1.y) * wv[1][0][3]),
                            pk2(bflo(r1.z) * wv[1][1][0], bfhi(r1.z) * wv[1][1][1]), pk2(bflo(r1.w) * wv[1][1][2], bfhi(r1.w) * wv[1][1][3])});
        } else {
          vw0 = mk8((u32x4){pk2(wv[0][0][0], wv[0][0][1]), pk2(wv[0][0][2], wv[0][0][3]), pk2(wv[0][1][0], wv[0][1][1]), pk2(wv[0][1][2], wv[0][1][3])});
          vw1 = mk8((u32x4){pk2(wv[1][0][0], wv[1][0][1]), pk2(wv[1][0][2], wv[1][0][3]), pk2(wv[1][1][0], wv[1][1][1]), pk2(wv[1][1][2], wv[1][1][3])});
        }
#pragma unroll
        for (int db = 0; db < 4; ++db) {
          f32x4 c = C[db][eb] * decay;
          c = MFMA16(kf[db][0], vw0, c); c = MFMA16(kf[db][1], vw1, c);
          C[db][eb] = c;
        }
      }
      __syncthreads();
      f32x4 rdn[8], rd0[8];
#pragma unroll
      for (int w = 0; w < 8; ++w) { rdn[w] = rn[(w * 4 + tbo) * 4 + fq]; rd0[w] = red[((w * 4 + tbo) * NEB + ebo) * 64 + lane]; }
      const f32x4 pn = ((rdn[0] + rdn[1]) + (rdn[2] + rdn[3])) + ((rdn[4] + rdn[5]) + (rdn[6] + rdn[7]));
      const f32x4 pi = ((rd0[0] + rd0[1]) + (rd0[2] + rd0[3])) + ((rd0[4] + rd0[5]) + (rd0[6] + rd0[7]));
#pragma unroll
      for (int jj = 0; jj < 4; ++jj) {
        const float num = oi[jj] + win[jj] * pi[jj], den = deni[jj] + win[jj] * pn[jj];
        const float hv = num * __builtin_amdgcn_rcpf(fmaxf(fabsf(den), flo[jj]));
        HD[((size_t)x * RG + ml_lrow(bl, tok0 + tbo * 16 + 4 * fq + jj)) * EI + h * DH + e0 + ebo * 16 + fr] = (bf16_t)(pk2(hv, 0.f) & 0xffff);
      }
      __syncthreads();
    }
  }
}

__device__ __forceinline__ void ml_fin(const Params& p, const Ctx& cx, int j) {
  const int lane = cx.tid & 63, gw = cx.bid * 8 + (cx.tid >> 6), NGW = cx.nb * 8;
  char* ws = cx.ws;
  const bf16_t* XZ = (const bf16_t*)(ws + O_XZ); const bf16_t* HD = (const bf16_t*)(ws + O_HD);
  bf16_t* FIN = (bf16_t*)(ws + O_FIN);
  for (int u = gw; u < RG * 4; u += NGW) {
    const int lr = u >> 2, h = u & 3, f0 = h * DH + lane * 8;
    int pos, seglen;
    if (lr < GB * SEQ) { pos = lr & (SEQ - 1); seglen = SEQ; } else { pos = (lr - GB * SEQ) & (LC - 1); seglen = LC; }
    const u32x4 hf = *(const u32x4*)(HD + (size_t)lr * EI + f0), hb = *(const u32x4*)(HD + ((size_t)RG + lr) * EI + f0);
    const u32x4 zz = *(const u32x4*)(XZ + (size_t)lr * 4096 + 2048 + f0);
    const u32x4 x1 = *(const u32x4*)(XZ + (size_t)lr * 4096 + f0);
    u32x4 x0 = {0u, 0u, 0u, 0u}, x2 = {0u, 0u, 0u, 0u};
    if (pos > 0) x0 = *(const u32x4*)(XZ + (size_t)(lr - 1) * 4096 + f0);
    if (pos < seglen - 1) x2 = *(const u32x4*)(XZ + (size_t)(lr + 1) * 4096 + f0);
    float hv[8], xm0[8], xm1[8], xm2[8];
    const unsigned hfu[4] = {hf.x, hf.y, hf.z, hf.w}, hbu[4] = {hb.x, hb.y, hb.z, hb.w}, zu[4] = {zz.x, zz.y, zz.z, zz.w};
    const unsigned x0u[4] = {x0.x, x0.y, x0.z, x0.w}, x1u[4] = {x1.x, x1.y, x1.z, x1.w}, x2u[4] = {x2.x, x2.y, x2.z, x2.w};
    float s = 0.f;
#pragma unroll
    for (int i = 0; i < 4; ++i) {
      hv[2 * i] = (bflo(hfu[i]) + bflo(hbu[i])) * sigm_f(bflo(zu[i]));
      hv[2 * i + 1] = (bfhi(hfu[i]) + bfhi(hbu[i])) * sigm_f(bfhi(zu[i]));
      xm0[2 * i] = bflo(x0u[i]); xm0[2 * i + 1] = bfhi(x0u[i]); xm1[2 * i] = bflo(x1u[i]); xm1[2 * i + 1] = bfhi(x1u[i]); xm2[2 * i] = bflo(x2u[i]); xm2[2 * i + 1] = bfhi(x2u[i]);
      s += hv[2 * i] + hv[2 * i + 1];
    }
    const float mean = wave_sum(s, lane) * (1.f / DH); float s2 = 0.f;
#pragma unroll
    for (int i = 0; i < 8; ++i) { hv[i] -= mean; s2 += hv[i] * hv[i]; }
    const float rstd = __builtin_amdgcn_rsqf(wave_sum(s2, lane) * (1.f / DH) + LN_EPS);
    float o[8];
#pragma unroll
    for (int i = 0; i < 8; ++i) {
      const int f = f0 + i;
      const float xc = silu_f(IN(11)[(size_t)(j * 3 + 0) * EI + f] * xm0[i] + IN(11)[(size_t)(j * 3 + 1) * EI + f] * xm1[i] + IN(11)[(size_t)(j * 3 + 2) * EI + f] * xm2[i] + IN(12)[(size_t)j * EI + f]);
      o[i] = hv[i] * rstd * IN(17)[(size_t)j * EI + f] + IN(16)[(size_t)j * EI + f] * xc;
    }
    u32x4 ov; ov.x = pk2(o[0], o[1]); ov.y = pk2(o[2], o[3]); ov.z = pk2(o[4], o[5]); ov.w = pk2(o[6], o[7]);
    *(u32x4*)(FIN + (size_t)lr * EI + f0) = ov;
  }
}

__device__ __forceinline__ void at_prep(const Params& p, const Ctx& cx) {
  const int lane = cx.tid & 63, gw = cx.bid * 8 + (cx.tid >> 6), NGW = cx.nb * 8;
  char* ws = cx.ws;
  bf16_t* ACT = (bf16_t*)(ws + O_ACT); bf16_t* KR = (bf16_t*)(ws + O_AKR); bf16_t* VT = (bf16_t*)(ws + O_AVT);
  const float* rc = (const float*)(ws + O_ROPE); const float* rs = rc + 4096 * 32;
  for (int row = gw; row < MROWS; row += NGW) {
    const bool lat = row < NLAT;
    const int b = lat ? row >> 12 : (row - NLAT) >> 8, pos = lat ? row & 4095 : (row - NLAT) & 255, tok = lat ? LC + pos : pos;
    bf16_t* rp = ACT + (size_t)row * 1536;
    {
      const u32x4 a = *(const u32x4*)(rp + 16 * lane), b2 = *(const u32x4*)(rp + 16 * lane + 8);
      const unsigned w[8] = {a.x, a.y, a.z, a.w, b2.x, b2.y, b2.z, b2.w};
      unsigned o[8];
      const int pp0 = (lane & 3) * 8;
#pragma unroll
      for (int i = 0; i < 8; ++i) {
        float x1 = bflo(w[i]) * 0.125f, x2 = bfhi(w[i]) * 0.125f;
        if (lat) { const float c = rc[pos * 32 + pp0 + i], s = rs[pos * 32 + pp0 + i]; const float y1 = x1 * c - x2 * s, y2 = x1 * s + x2 * c; x1 = y1; x2 = y2; }
        o[i] = pk2(x1, x2);
      }
      *(u32x4*)(rp + 16 * lane) = (u32x4){o[0], o[1], o[2], o[3]}; *(u32x4*)(rp + 16 * lane + 8) = (u32x4){o[4], o[5], o[6], o[7]};
    }
    {
      const u32x2 a = *(const u32x2*)(rp + 1024 + 4 * lane);
      const unsigned w[2] = {a.x, a.y}; unsigned o[2];
      const int g = lane >> 4, dd = (lane & 15) * 4, pp0 = dd >> 1;
#pragma unroll
      for (int i = 0; i < 2; ++i) {
        float x1 = bflo(w[i]), x2 = bfhi(w[i]);
        if (lat) { const float c = rc[pos * 32 + pp0 + i], s = rs[pos * 32 + pp0 + i]; const float y1 = x1 * c - x2 * s, y2 = x1 * s + x2 * c; x1 = y1; x2 = y2; }
        o[i] = pk2(x1, x2);
      }
      *(u32x2*)(KR + (((size_t)b * 4 + g) * TOKB + tok) * 64 + dd) = (u32x2){o[0], o[1]};
      const u32x2 v = *(const u32x2*)(rp + 1280 + 4 * lane);
      bf16_t* vp = VT + (((size_t)b * 4 + g) * 64 + dd) * TOKB + tok;
      vp[0] = (bf16_t)(v.x & 0xffff); vp[TOKB] = (bf16_t)(v.x >> 16); vp[2 * TOKB] = (bf16_t)(v.y & 0xffff); vp[3 * TOKB] = (bf16_t)(v.y >> 16);
    }
  }
}

__device__ __forceinline__ void at_core(const Params& p, const Ctx& cx) {
  const int lane = cx.tid & 63, gw = cx.bid * 8 + (cx.tid >> 6), NGW = cx.nb * 8, fr = lane & 15, fq = lane >> 4;
  char* ws = cx.ws;
  const bf16_t* ACT = (const bf16_t*)(ws + O_ACT); const bf16_t* KR = (const bf16_t*)(ws + O_AKR); const bf16_t* VT = (const bf16_t*)(ws + O_AVT);
  bf16_t* O = (bf16_t*)(ws + O_U);
  for (int u = gw; u < (MROWS / 16) * 4; u += NGW) {
    const int g = u & 3, qb = u >> 2, row0 = qb * 16;
    const bool lat = row0 < NLAT;
    const int b = lat ? row0 >> 12 : (row0 - NLAT) >> 8, q0 = lat ? row0 & 4095 : 0;
    bf16x8 qf[4][2];
    float mrun[4], lrun[4], sink[4];
    f32x4 oacc[4][4];
#pragma unroll
    for (int hh = 0; hh < 4; ++hh) {
      const bf16_t* qp = ACT + (size_t)(row0 + fr) * 1536 + (g * 4 + hh) * 64 + 8 * fq;
      qf[hh][0] = *(const bf16x8*)qp; qf[hh][1] = *(const bf16x8*)(qp + 32);
      sink[hh] = IN(20)[g * 4 + hh]; mrun[hh] = sink[hh]; lrun[hh] = 0.f;
#pragma unroll
      for (int d2 = 0; d2 < 4; ++d2) oacc[hh][d2] = (f32x4){0.f, 0.f, 0.f, 0.f};
    }
    const bf16_t* kbase = KR + ((size_t)b * 4 + g) * TOKB * 64;
    const bf16_t* vbase = VT + ((size_t)b * 4 + g) * 64 * TOKB;
    int wlo = 0, whi = -1;
    if (lat) { wlo = max(0, q0 - 128) & ~31; whi = min(SEQ - 1, q0 + 143); }
    const int nwin = lat ? (whi - wlo) / 32 + 1 : 0;
    for (int ti = 0; ti < 8 + nwin; ++ti) {
      const bool isw = ti >= 8;
      const int kpos0 = isw ? wlo + (ti - 8) * 32 : 0;
      const int tk0 = isw ? LC + kpos0 : ti * 32;
      const bf16_t* kp = kbase + (size_t)(tk0 + fr) * 64 + 8 * fq;
      const bf16x8 k00 = *(const bf16x8*)kp, k01 = *(const bf16x8*)(kp + 32), k10 = *(const bf16x8*)(kp + 16 * 64), k11 = *(const bf16x8*)(kp + 16 * 64 + 32);
      bf16x8 vfr[4];
#pragma unroll
      for (int d2 = 0; d2 < 4; ++d2) {
        const bf16_t* vp = vbase + (size_t)(d2 * 16 + fr) * TOKB + tk0 + 4 * fq;
        vfr[d2] = mk8(*(const u32x2*)vp, *(const u32x2*)(vp + 16));
      }
      bool okm[8];
#pragma unroll
      for (int i = 0; i < 8; ++i) {
        const int kpos = kpos0 + (i >> 2) * 16 + 4 * fq + (i & 3), dlt = (q0 + fr) - kpos;
        okm[i] = !isw || (dlt <= 128 && dlt >= -128);
      }
#pragma unroll
      for (int hh = 0; hh < 4; ++hh) {
        f32x4 s0 = {0.f, 0.f, 0.f, 0.f}, s1 = {0.f, 0.f, 0.f, 0.f};
        s0 = MFMA16(k00, qf[hh][0], s0); s0 = MFMA16(k01, qf[hh][1], s0);
        s1 = MFMA16(k10, qf[hh][0], s1); s1 = MFMA16(k11, qf[hh][1], s1);
        float sv[8]; float tmax = -3.0e38f;
#pragma unroll
        for (int i = 0; i < 8; ++i) { sv[i] = okm[i] ? (i < 4 ? s0[i] : s1[i - 4]) : -3.0e38f; tmax = fmaxf(tmax, sv[i]); }
        tmax = fmaxf(tmax, shx(tmax, 16, lane)); tmax = fmaxf(tmax, shx(tmax, 32, lane));
        const float mnew = fmaxf(mrun[hh], tmax), scale = __expf(mrun[hh] - mnew);
        mrun[hh] = mnew;
        float pv[8];
#pragma unroll
        for (int i = 0; i < 8; ++i) pv[i] = okm[i] ? __expf(sv[i] - mnew) : 0.f;
        const u32x4 pu = {pk2(pv[0], pv[1]), pk2(pv[2], pv[3]), pk2(pv[4], pv[5]), pk2(pv[6], pv[7])};
        const float ps = ((bflo(pu.x) + bfhi(pu.x)) + (bflo(pu.y) + bfhi(pu.y))) + ((bflo(pu.z) + bfhi(pu.z)) + (bflo(pu.w) + bfhi(pu.w)));
        lrun[hh] = lrun[hh] * scale + ps;
        const bf16x8 pf = mk8(pu);
        float scq[4];
#pragma unroll
        for (int jj = 0; jj < 4; ++jj) scq[jj] = shi(scale, 4 * fq + jj);
#pragma unroll
        for (int d2 = 0; d2 < 4; ++d2) {
          f32x4 o = oacc[hh][d2];
          o[0] *= scq[0]; o[1] *= scq[1]; o[2] *= scq[2]; o[3] *= scq[3];
          oacc[hh][d2] = MFMA16(pf, vfr[d2], o);
        }
      }
    }
#pragma unroll
    for (int hh = 0; hh < 4; ++hh) {
      float l = lrun[hh];
      l += shx(l, 16, lane); l += shx(l, 32, lane);
      l += __expf(sink[hh] - mrun[hh]);
      const float inv = __builtin_amdgcn_rcpf(l);
      float iq[4];
#pragma unroll
      for (int jj = 0; jj < 4; ++jj) iq[jj] = shi(inv, 4 * fq + jj);
#pragma unroll
      for (int d2 = 0; d2 < 4; ++d2)
#pragma unroll
        for (int jj = 0; jj < 4; ++jj)
          O[(size_t)(row0 + 4 * fq + jj) * D + (g * 4 + hh) * 64 + d2 * 16 + fr] = (bf16_t)(pk2(oacc[hh][d2][jj] * iq[jj], 0.f) & 0xffff);
    }
  }
}

__device__ __forceinline__ void sc_conv(const Params& p, const Ctx& cx) {
  const int gt = cx.bid * 512 + cx.tid, gs = cx.nb * 512;
  const bf16_t* ACT = (const bf16_t*)(cx.ws + O_ACT); bf16_t* O = (bf16_t*)(cx.ws + O_U);
  const float* cw = IN(23);
  for (int i = gt; i < MROWS * 128; i += gs) {
    const int row = i >> 7, c0 = (i & 127) * 8;
    int pos, seglen;
    if (row < NLAT) { pos = row & (SEQ - 1); seglen = SEQ; } else { pos = (row - NLAT) & (LC - 1); seglen = LC; }
    float accv[8];
#pragma unroll
    for (int e = 0; e < 8; ++e) accv[e] = 0.f;
#pragma unroll
    for (int k = 0; k < 3; ++k) {
      const int pp = pos + k - 1;
      if (pp < 0 || pp >= seglen) continue;
      const bf16_t* rp = ACT + (size_t)(row + k - 1) * 3072;
      const u32x4 cgv = *(const u32x4*)(rp + 1024 + c0), xtv = *(const u32x4*)(rp + 2048 + c0);
      const unsigned cu[4] = {cgv.x, cgv.y, cgv.z, cgv.w}, xu[4] = {xtv.x, xtv.y, xtv.z, xtv.w};
#pragma unroll
      for (int e = 0; e < 4; ++e) {
        accv[2 * e] += cw[k * D + c0 + 2 * e] * (bflo(cu[e]) * bflo(xu[e]));
        accv[2 * e + 1] += cw[k * D + c0 + 2 * e + 1] * (bfhi(cu[e]) * bfhi(xu[e]));
      }
    }
    const u32x4 bgv = *(const u32x4*)(ACT + (size_t)row * 3072 + c0);
    const unsigned bu[4] = {bgv.x, bgv.y, bgv.z, bgv.w};
    u32x4 o;
    o.x = pk2(bflo(bu[0]) * accv[0], bfhi(bu[0]) * accv[1]); o.y = pk2(bflo(bu[1]) * accv[2], bfhi(bu[1]) * accv[3]);
    o.z = pk2(bflo(bu[2]) * accv[4], bfhi(bu[2]) * accv[5]); o.w = pk2(bflo(bu[3]) * accv[6], bfhi(bu[3]) * accv[7]);
    *(u32x4*)(O + (size_t)row * D + c0) = o;
  }
}

#define XB_TMO      128
#define XB_XCNT(j)  (256  + 64 * (j))
#define XB_XSUB(j)  (1280 + 64 * (j))
#define XB_XGEN(j)  (2304 + 64 * (j))
#define XB_TOP      3328
#define XB_TOPGEN   3392
#define XCD_BAR_WORDS 3456
#define XB_SPIN_CAP (1u << 18)
__device__ __forceinline__ unsigned xb_ld(unsigned* p)              { return __hip_atomic_load(p, __ATOMIC_RELAXED, __HIP_MEMORY_SCOPE_AGENT); }
__device__ __forceinline__ unsigned xb_add(unsigned* p, unsigned v) { return __hip_atomic_fetch_add(p, v, __ATOMIC_RELAXED, __HIP_MEMORY_SCOPE_AGENT); }
__device__ __forceinline__ unsigned xb_xcc_id() { return (unsigned)__builtin_amdgcn_s_getreg((3 << 11) | 20) & 0xFu; }
#define XB_SPIN(cond, bar) do { unsigned _sp = 0; while (cond) { __builtin_amdgcn_s_sleep(1); \
    if ((++_sp & 255u) == 0u) { if (xb_ld(&(bar)[XB_TMO])) break; if (_sp > XB_SPIN_CAP) { atomicAdd(&(bar)[XB_TMO], 1u); break; } } } } while (0)
__device__ __forceinline__ void xcd_barrier_complete(unsigned* bar, unsigned x, unsigned& nloc, unsigned& nx) {
  const unsigned G = gridDim.x;
  unsigned sum, cnt, mine, sp = 0u;
  for (;;) {
    sum = 0u; cnt = 0u; mine = 0u;
#pragma unroll
    for (unsigned j = 0; j < 16; ++j) { const unsigned c = xb_ld(&bar[XB_XCNT(j)]); sum += c; cnt += (c > 0u) ? 1u : 0u; mine = (j == x) ? c : mine; }
    if (sum == G) break;
    __builtin_amdgcn_s_sleep(1);
    if ((++sp & 255u) == 0u) { if (xb_ld(&bar[XB_TMO])) break; if (sp > XB_SPIN_CAP) { atomicAdd(&bar[XB_TMO], 1u); break; } }
  }
  nloc = mine > 0u ? mine : 1u; nx = cnt > 0u ? cnt : 1u;
}
__device__ __forceinline__ void xcd_barrier(unsigned* bar, unsigned x, volatile LAS unsigned* st) {
  asm volatile("s_waitcnt vmcnt(0)" ::: "memory");
  __syncthreads();
  if (threadIdx.x == 0) {
    __builtin_amdgcn_s_waitcnt(0);
    unsigned nloc = st[0], nx = st[1];
    if (nloc == 0u) { xcd_barrier_complete(bar, x, nloc, nx); st[0] = nloc; st[1] = nx; }
    const unsigned old = xb_add(&bar[XB_XSUB(x)], 1u);
    const unsigned gen = old / nloc;
    if (old + 1u == (gen + 1u) * nloc) {
      __builtin_amdgcn_fence(__ATOMIC_RELEASE, "agent");
      asm volatile("s_waitcnt vmcnt(0)" ::: "memory");
      const unsigned og = xb_add(&bar[XB_TOP], 1u);
      const unsigned tg = og / nx;
      if (og + 1u == (tg + 1u) * nx) xb_add(&bar[XB_TOPGEN], 1u);
      else XB_SPIN(xb_ld(&bar[XB_TOPGEN]) == tg, bar);
      __builtin_amdgcn_fence(__ATOMIC_ACQUIRE, "agent");
      xb_add(&bar[XB_XGEN(x)], 1u);
      asm volatile("s_waitcnt vmcnt(0)" ::: "memory");
    } else {
      XB_SPIN(xb_ld(&bar[XB_XGEN(x)]) == gen, bar);
      __builtin_amdgcn_fence(__ATOMIC_ACQUIRE, "agent");
      asm volatile("s_waitcnt vmcnt(0)" ::: "memory");
    }
  }
  __syncthreads();
}

#ifndef ENMASK
#define ENMASK 0xffff
#endif
#define EN(i) ((ENMASK >> (i)) & 1)
enum { OP_PRO = 0, OP_LN0, OP_LN1, OP_LNF, OP_FFI, OP_FFO, OP_UP, OP_M0, OP_GAT, OP_S, OP_M2, OP_FIN, OP_DN, OP_AQ, OP_APREP, OP_ACORE, OP_AO, OP_SI, OP_SCONV, OP_SO };
__global__ void __launch_bounds__(512) fwd_megakernel(Params p) {
  cg::grid_group grid = cg::this_grid();
  const int wave_s = __builtin_amdgcn_readfirstlane((int)threadIdx.x >> 6);
  volatile LAS unsigned* xst = (volatile LAS unsigned*)((LAS unsigned char*)lds_raw + (LDS_BYTES - 16));
  if (threadIdx.x == 0) { xst[0] = 0u; xst[1] = 0u; }
  __syncthreads();
  unsigned* xbar = (unsigned*)(p.ws + O_BAR);
  const unsigned xcc = xb_xcc_id();
  if (threadIdx.x == 0) (void)xb_add(&xbar[XB_XCNT(xcc)], 1u);
#ifdef DUP_OP
  int rep = 0;
#endif
  for (int ph = 0; ph < p.nph; ++ph) {
    const unsigned w = p.prog[ph];
    const int op = w & 255, a = (w >> 8) & 255, b = (w >> 16) & 255, c = (w >> 24) & 255;
#define MKCTX int z; asm volatile("s_mov_b32 %0, 0" : "=s"(z)); \
    GAS char* wsq = (GAS char*)p.ws; GAS float* outq = (GAS float*)p.out; int bidq = (int)blockIdx.x, nbq = (int)gridDim.x; \
    asm volatile("" : "+s"(wsq), "+s"(outq), "+s"(bidq), "+s"(nbq)); \
    const Ctx cx{wave_s * 64 + (int)__builtin_amdgcn_mbcnt_hi(~0u, __builtin_amdgcn_mbcnt_lo(~0u, (unsigned)z)), bidq, nbq, z, (char*)wsq, (float*)outq};
    if (EN(0) && op == OP_PRO) { MKCTX prologue(p, cx); }
    else if (EN(1) && op == OP_LN0) { MKCTX lnmod_phase<0>(p, cx, 0, 0, 0); }
    else if (EN(1) && op == OP_LN1) { MKCTX lnmod_phase<1>(p, cx, a, b, c); }
    else if (EN(1) && op == OP_LNF) { MKCTX lnmod_phase<2>(p, cx, a, 0, 0); }
    else if (EN(2) && op == OP_M0) { MKCTX ml_m0(p, cx, a); }
    else if (EN(3) && op == OP_GAT) { MKCTX ml_gates(p, cx, a); }
    else if (EN(4) && op == OP_S) { MKCTX ml_s(p, cx); }
    else if (EN(5) && op == OP_M2) { MKCTX ml_m2(p, cx); }
    else if (EN(6) && op == OP_FIN) { MKCTX ml_fin(p, cx, a); }
    else if (EN(7) && op == OP_APREP) { MKCTX at_prep(p, cx); }
    else if (EN(8) && op == OP_ACORE) { MKCTX at_core(p, cx); }
    else if (EN(9) && op == OP_SCONV) { MKCTX sc_conv(p, cx); }
    else if (EN(10)) {
      MKCTX
      char* ws = cx.ws;
      const RowMap idm{0, 0, 1 << 30};
      bf16_t* U = (bf16_t*)(ws + O_U); bf16_t* ACT = (bf16_t*)(ws + O_ACT);
      const float* MODT = (const float*)(ws + O_MODT);
      const bf16_t* A = U; const bf16_t* Bt; int K = 1024, nM = MROWS / 256, nN; RowMap am = idm, cm = idm;
      Epi E; E.kind = 2; E.O = ACT; E.ldc = 0; E.modl = MODT + (size_t)b * 9 * 9216; E.slot = 1; E.wgt = 1.0f;
      if (op == OP_FFI) { Bt = (const bf16_t*)(ws + O_WFI) + (size_t)a * 5632 * 1024; nN = 22; E.kind = 1; }
      else if (op == OP_FFO) { A = ACT; Bt = (const bf16_t*)(ws + O_WFO) + (size_t)a * 1024 * 2816; K = 2816; nN = 4; E.slot = c; E.wgt = 0.5f; }
      else if (op == OP_UP) { Bt = (const bf16_t*)(ws + O_WUP) + (size_t)a * 4096 * 1024; nM = RG / 256; nN = 16; am = RowMap{c * GB * SEQ, NLAT + c * GB * LC, GB * SEQ / 256}; E.kind = 0; E.O = (bf16_t*)(ws + O_XZ); E.ldc = 4096; }
      else if (op == OP_DN) { A = (const bf16_t*)(ws + O_FIN); Bt = (const bf16_t*)(ws + O_WDN) + (size_t)a * 1024 * 2048; K = 2048; nM = RG / 256; nN = 4; cm = RowMap{c * GB * SEQ, NLAT + c * GB * LC, GB * SEQ / 256}; }
      else if (op == OP_AQ) { Bt = (const bf16_t*)(ws + O_WAQ); nN = 6; E.kind = 0; E.ldc = 1536; }
      else if (op == OP_AO) { Bt = (const bf16_t*)(ws + O_WAO); nN = 4; }
      else if (op == OP_SI) { Bt = (const bf16_t*)(ws + O_WSI); nN = 12; E.kind = 0; E.ldc = 3072; }
      else { Bt = (const bf16_t*)(ws + O_WSO); nN = 4; }
      gemm_phase(cx, A, am, Bt, K, nM, nN, cm, E);
    }
    if (ph == 0) grid.sync(); else xcd_barrier(xbar, xcc, xst);
#ifdef DUP_OP
    if (op == DUP_OP && rep + 1 < DUP_N) { ++rep; --ph; } else rep = 0;
#endif
  }
}

static int build_program(unsigned* prog) {
  int n = 0;
  auto W = [&](int op, int a, int b, int c) { prog[n++] = (unsigned)op | ((unsigned)a << 8) | ((unsigned)b << 16) | ((unsigned)c << 24); };
  W(OP_PRO, 0, 0, 0);
  W(OP_LN0, 0, 0, 0);
  for (int layer = 0; layer < DEPTH; ++layer) {
    const int kind = layer % 3, j = layer / 3;
    W(OP_FFI, layer * 2, layer, 0); W(OP_FFO, layer * 2, layer, 0);
    W(OP_LN1, layer * 3 + 0, layer, 1);
    if (kind == 0) {
      for (int g = 0; g < NG; ++g) { W(OP_UP, j, layer, g); W(OP_M0, j, 0, 0); W(OP_GAT, j, 0, 0); W(OP_S, 0, 0, 0); W(OP_M2, 0, 0, 0); W(OP_FIN, j, 0, 0); W(OP_DN, j, layer, g); }
    } else if (kind == 1) { W(OP_AQ, 0, layer, 0); W(OP_APREP, 0, 0, 0); W(OP_ACORE, 0, 0, 0); W(OP_AO, 0, layer, 0); }
    else { W(OP_SI, 0, layer, 0); W(OP_SCONV, 0, 0, 0); W(OP_SO, 0, layer, 0); }
    W(OP_LN1, layer * 3 + 1, layer, 2);
    W(OP_FFI, layer * 2 + 1, layer, 0); W(OP_FFO, layer * 2 + 1, layer, 2);
    if (layer + 1 < DEPTH) W(OP_LN1, layer * 3 + 2, layer + 1, 0); else W(OP_LNF, layer * 3 + 2, 0, 0);
  }
  return n;
}

extern "C" void kernel_launch(void* const* d_in, const int* in_sizes, int n_in, void* d_out, int out_size, void* d_ws, size_t ws_size, hipStream_t stream) {
  static int grid_blocks = 0;
  if (!grid_blocks) {
    int dev = 0, cus = 0, per_cu = 0;
    (void)hipGetDevice(&dev);
    (void)hipDeviceGetAttribute(&cus, hipDeviceAttributeMultiprocessorCount, dev);
    (void)hipFuncSetAttribute((const void*)fwd_megakernel, hipFuncAttributeMaxDynamicSharedMemorySize, LDS_BYTES);
    (void)hipOccupancyMaxActiveBlocksPerMultiprocessor(&per_cu, fwd_megakernel, 512, LDS_BYTES);
    if (cus <= 0) cus = 256;
    grid_blocks = cus;
    if (ws_size < WS_END || n_in != 25) fprintf(stderr, "kernel_launch: workspace %zu < %zu or n_in %d != 25\n", ws_size, (size_t)WS_END, n_in);
    if (per_cu < 1) fprintf(stderr, "kernel_launch: occupancy query says %d blocks per CU\n", per_cu);
  }
  Params p{};
  for (int i = 0; i < 25; ++i) p.in[i] = (const float*)d_in[i];
  p.out = (float*)d_out; p.ws = (char*)d_ws;
  p.nph = build_program(p.prog);
  (void)hipMemsetAsync((char*)d_ws + O_BAR, 0, XCD_BAR_WORDS * 4, stream);
  void* args[] = {&p};
  hipError_t e = hipLaunchCooperativeKernel((void*)fwd_megakernel, dim3(grid_blocks), dim3(512), args, LDS_BYTES, stream);
  if (e != hipSuccess) fprintf(stderr, "cooperative launch failed: %s (grid %d)\n", hipGetErrorString(e), grid_blocks);
}
```

```cpp
#include <hip/hip_runtime.h>
#include <hip/hip_cooperative_groups.h>
#include <cstdio>
#include <cstdint>
namespace cg = cooperative_groups;

typedef unsigned short bf16_t;
typedef short bf16x8 __attribute__((ext_vector_type(8)));
typedef short bf16x4 __attribute__((ext_vector_type(4)));
typedef float f32x4 __attribute__((ext_vector_type(4)));
typedef unsigned u32x2 __attribute__((ext_vector_type(2)));
typedef unsigned u32x4 __attribute__((ext_vector_type(4)));

constexpr int D = 1024, NB = 8, SEQ = 4096, LC = 256, DEPTH = 4, FF = 2816, EI = 2048, DH = 512;
constexpr int NLAT = NB * SEQ, NCTX = NB * LC, MROWS = NLAT + NCTX;
constexpr int TOKB = LC + SEQ;
constexpr int NCH = TOKB / 64;
constexpr int GB = 2, NG = NB / GB, RG = GB * TOKB;
constexpr int NSEQ = GB * 8;
constexpr float ALPHA = 1.681792830507429f, LN_EPS = 1e-5f;
constexpr int LDS_BYTES = 144 * 1024;

constexpr size_t al256(size_t x) { return (x + 255) & ~(size_t)255; }
constexpr size_t O_WFI = 0;
constexpr size_t O_WFO = O_WFI + (size_t)8 * 5632 * 1024 * 2;
constexpr size_t O_WUP = O_WFO + (size_t)8 * 1024 * 2816 * 2;
constexpr size_t O_WDN = O_WUP + (size_t)2 * 4096 * 1024 * 2;
constexpr size_t O_WAQ = O_WDN + (size_t)2 * 1024 * 2048 * 2;
constexpr size_t O_WAO = O_WAQ + (size_t)1536 * 1024 * 2;
constexpr size_t O_WSI = O_WAO + (size_t)1024 * 1024 * 2;
constexpr size_t O_WSO = O_WSI + (size_t)3072 * 1024 * 2;
constexpr size_t O_WG = O_WSO + (size_t)1024 * 1024 * 2;
constexpr size_t O_MODT = O_WG + (size_t)2 * 16 * 6144 * 2;
constexpr size_t O_ROPE = O_MODT + (size_t)4 * 9 * 9216 * 4;
constexpr size_t O_HCTX = O_ROPE + (size_t)2 * 4096 * 32 * 4;
constexpr size_t O_U = O_HCTX + (size_t)NCTX * D * 4;
constexpr size_t O_R = O_U + (size_t)MROWS * D * 2;
constexpr size_t O_XZ = O_R;
constexpr size_t O_QK = O_XZ + (size_t)RG * 4096 * 2;
constexpr size_t O_KT = O_QK + (size_t)RG * 4096 * 2;
constexpr size_t O_VT = O_KT + (size_t)GB * EI * TOKB * 2;
constexpr size_t O_SP = O_VT + (size_t)GB * EI * TOKB * 2;
constexpr size_t O_HD = O_SP + (size_t)NSEQ * NCH * 4096 * 2;
constexpr size_t O_FIN = O_HD + (size_t)2 * RG * EI * 2;
constexpr size_t O_GAT = O_FIN + (size_t)RG * EI * 2;
constexpr size_t SZ_ST = (size_t)NSEQ * TOKB * 4;
constexpr size_t O_BL = O_GAT, O_IG = O_BL + SZ_ST, O_WIN = O_IG + SZ_ST, O_FLO = O_WIN + SZ_ST, O_DEN = O_FLO + SZ_ST, O_WSS = O_DEN + SZ_ST;
constexpr size_t O_GC = O_WSS + SZ_ST;
constexpr size_t O_REND_ML = O_GC + (size_t)3 * NSEQ * NCH * 4 + 256;
constexpr size_t O_ACT = O_R;
constexpr size_t O_AKR = O_R + (size_t)MROWS * 3072 * 2;
constexpr size_t O_AVT = O_AKR + (size_t)NB * 4 * TOKB * 64 * 2;
constexpr size_t O_REND_AT = O_AVT + (size_t)NB * 4 * TOKB * 64 * 2;
constexpr size_t O_BAR = (O_REND_ML > O_REND_AT ? O_REND_ML : O_REND_AT);
constexpr size_t WS_END = O_BAR + 3456 * 4 + 256;

struct Params {
  const float* in[25];
  float* out;
  char* ws;
  int nph; int pad0;
  unsigned prog[126];
};

#define GAS __attribute__((address_space(1)))
#define IN(k) ((const float*)(const GAS float*)p.in[(k) + cx.z])
struct Ctx { int tid, bid, nb, z; char* ws; float* out; };
extern __shared__ __attribute__((aligned(16))) char lds_raw[];

__device__ __forceinline__ unsigned pk2(float lo, float hi) { unsigned r; asm volatile("v_cvt_pk_bf16_f32 %0, %1, %2" : "=v"(r) : "v"(lo), "v"(hi)); return r; }
__device__ __forceinline__ float bf2f(unsigned short v) { return __uint_as_float(((unsigned)v) << 16); }
__device__ __forceinline__ float bflo(unsigned v) { return __uint_as_float(v << 16); }
__device__ __forceinline__ float bfhi(unsigned v) { return __uint_as_float(v & 0xffff0000u); }
__device__ __forceinline__ float silu_f(float x) { return x * __builtin_amdgcn_rcpf(1.f + __expf(-x)); }
__device__ __forceinline__ float sigm_f(float x) { return __builtin_amdgcn_rcpf(1.f + __expf(-x)); }
__device__ __forceinline__ float shi(float v, int srclane) { return __int_as_float(__builtin_amdgcn_ds_bpermute(srclane << 2, __float_as_int(v))); }
__device__ __forceinline__ float shx(float v, int m, int lane) { return shi(v, lane ^ m); }
__device__ __forceinline__ float wave_sum(float v, int lane) {
#pragma unroll
  for (int o = 1; o < 64; o <<= 1) v += shx(v, o, lane);
  return v;
}
__device__ __forceinline__ bf16x8 mk8(u32x4 v) { union { u32x4 u; bf16x8 b; } x; x.u = v; return x.b; }
__device__ __forceinline__ bf16x8 mk8(u32x2 a, u32x2 b) { union { u32x4 u; bf16x8 b; } x; x.u = (u32x4){a.x, a.y, b.x, b.y}; return x.b; }
__device__ __forceinline__ float* hrow(const Ctx& cx, int row) { return row < NLAT ? cx.out + (size_t)row * D : (float*)(cx.ws + O_HCTX) + (size_t)(row - NLAT) * D; }
#define MFMA16(a, b, c) __builtin_amdgcn_mfma_f32_16x16x32_bf16(a, b, c, 0, 0, 0)

constexpr int BM = 256, BK = 64, HALF = 128, HT = HALF * BK, NXCD = 8, WGM = 8;
__device__ __forceinline__ int lds_byte(int r, int c) {
  int st = (r >> 4) * 2 + (c >> 5), rr = r & 15, cc = c & 31, ob = rr * 64 + cc * 2;
  return st * 1024 + (ob ^ (((ob >> 9) & 1) << 5));
}
__device__ __forceinline__ void stage_rc(int b, int& R, int& C) {
  int st = b / 1024, sb = b % 1024, swz = sb ^ (((sb >> 9) & 1) << 5);
  R = (st >> 1) * 16 + swz / 64; C = (st & 1) * 32 + (swz % 64) / 2;
}
struct RowMap { int lat0, ctx0, nlat; __device__ __forceinline__ int row0(int pm) const { return pm < nlat ? lat0 + pm * 256 : ctx0 + (pm - nlat) * 256; } };

typedef f32x4 Acc[2][2][4][2];

struct Epi {
  int kind; bf16_t* O; int ldc; const float* modl; int slot; float wgt;
};
__device__ __forceinline__ void run_epi(const Ctx& cx, const Epi& E, const Acc& acc, int r0, int pn, int wr, int wc, int fr, int fq) {
  if (E.kind == 0) {
#pragma unroll
    for (int ai = 0; ai < 2; ++ai)
#pragma unroll
      for (int m = 0; m < 4; ++m) {
        bf16_t* rp = E.O + (size_t)(r0 + ai * HALF + wr * 64 + m * 16 + fr) * E.ldc + pn * 256 + wc * 32 + 4 * fq;
#pragma unroll
        for (int bj = 0; bj < 2; ++bj)
#pragma unroll
          for (int n = 0; n < 2; ++n) {
            f32x4 v = acc[ai][bj][m][n];
            u32x2 o; o.x = pk2(v[0], v[1]); o.y = pk2(v[2], v[3]);
            *(u32x2*)(rp + bj * HALF + n * 16) = o;
          }
      }
  } else if (E.kind == 1) {
#pragma unroll
    for (int ai = 0; ai < 2; ++ai)
#pragma unroll
      for (int m = 0; m < 4; ++m) {
        bf16_t* rp = E.O + (size_t)(r0 + ai * HALF + wr * 64 + m * 16 + fr) * FF + pn * 128 + wc * 16 + 4 * fq;
#pragma unroll
        for (int bj = 0; bj < 2; ++bj) {
          f32x4 g = acc[ai][bj][m][0], v = acc[ai][bj][m][1];
          u32x2 o; o.x = pk2(silu_f(g[0]) * v[0], silu_f(g[1]) * v[1]); o.y = pk2(silu_f(g[2]) * v[2], silu_f(g[3]) * v[3]);
          *(u32x2*)(rp + bj * 64) = o;
        }
      }
  } else {
    const int midx = r0 < NLAT ? (r0 >> 12) : 8;
    const float* gp = E.modl + (size_t)midx * 9216 + (3 * E.slot + 2) * D + pn * 256 + wc * 32 + 4 * fq;
    f32x4 gv[2][2];
#pragma unroll
    for (int bj = 0; bj < 2; ++bj)
#pragma unroll
      for (int n = 0; n < 2; ++n) gv[bj][n] = *(const f32x4*)(gp + bj * HALF + n * 16) * E.wgt;
#pragma unroll
    for (int ai = 0; ai < 2; ++ai)
#pragma unroll
      for (int m = 0; m < 4; ++m) {
        float* rp = hrow(cx, r0 + ai * HALF + wr * 64 + m * 16 + fr) + pn * 256 + wc * 32 + 4 * fq;
        f32x4 h[2][2];
#pragma unroll
        for (int bj = 0; bj < 2; ++bj)
#pragma unroll
          for (int n = 0; n < 2; ++n) h[bj][n] = *(const f32x4*)(rp + bj * HALF + n * 16);
#pragma unroll
        for (int bj = 0; bj < 2; ++bj)
#pragma unroll
          for (int n = 0; n < 2; ++n) *(f32x4*)(rp + bj * HALF + n * 16) = h[bj][n] * ALPHA + gv[bj][n] * acc[ai][bj][m][n];
        __builtin_amdgcn_sched_barrier(0);
      }
  }
}

#define LAS __attribute__((address_space(3)))
__device__ __forceinline__ void gemm_phase(const Ctx& cx, const bf16_t* __restrict__ A, RowMap am, const bf16_t* __restrict__ Bt, int K, int nM, int nN, RowMap cm, const Epi& epi) {
  LAS unsigned char* lds = (LAS unsigned char*)lds_raw;
  constexpr int HTB = HT * 2;
  const int tid = cx.tid, wid = tid >> 6, lane = tid & 63, wr = wid >> 2, wc = wid & 3, fr = lane & 15, fq = lane >> 4;
  unsigned voff[2];
#pragma unroll
  for (int i = 0; i < 2; ++i) { int R, C; stage_rc(tid * 16 + i * 8192, R, C); voff[i] = (unsigned)(R * K + C) * 2u; }
  const size_t kstep = (size_t)(BK * 2), hstep = (size_t)HALF * K * 2;
  const unsigned ldsw = (unsigned)wid * 1024u;
  const int aoff = lds_byte(wr * 64 + fr, fq * 8), boff = lds_byte(wc * 32 + fr, fq * 8);
#define G_SA(b, h) (((b) * 2 + (h)) * HTB)
#define G_SB(b, h) ((4 + (b) * 2 + (h)) * HTB)
#define STAGE(bufoff, gbase) do { _Pragma("unroll") for (int _i = 0; _i < 2; ++_i) \
    __builtin_amdgcn_global_load_lds((const unsigned*)((const char*)(gbase) + voff[_i]), (LAS unsigned*)(lds + (bufoff) + ldsw + _i * 8192), 16, 0, 0); } while (0)
#define LDA(dst, b, h) do { _Pragma("unroll") for (int m = 0; m < 4; ++m) _Pragma("unroll") for (int k = 0; k < 2; ++k) dst[m][k] = *(const LAS bf16x8*)(lds + G_SA(b, h) + aoff + m * 2048 + k * 1024); } while (0)
#define LDB(dst, b, h) do { _Pragma("unroll") for (int n = 0; n < 2; ++n) _Pragma("unroll") for (int k = 0; k < 2; ++k) dst[n][k] = *(const LAS bf16x8*)(lds + G_SB(b, h) + boff + n * 2048 + k * 1024); } while (0)
#define MMA(ai, bj, At, Bt_) do { __builtin_amdgcn_s_setprio(1); _Pragma("unroll") for (int m = 0; m < 4; ++m) _Pragma("unroll") for (int n = 0; n < 2; ++n) _Pragma("unroll") for (int k = 0; k < 2; ++k) \
      acc[ai][bj][m][n] = MFMA16(Bt_[n][k], At[m][k], acc[ai][bj][m][n]); \
    __builtin_amdgcn_s_setprio(0); } while (0)
#define WAIT_V(n) asm volatile("s_waitcnt vmcnt(" #n ")" ::: "memory")
#define WAIT_L(n) asm volatile("s_waitcnt lgkmcnt(" #n ")" ::: "memory")
#define BAR __builtin_amdgcn_s_barrier()
#define SCHED __builtin_amdgcn_sched_barrier(0)
  const int nwg = nM * nN;
  const int nt = K / BK;
  const int wid_s = __builtin_amdgcn_readfirstlane(wid);
#define DECODE(L_, pm_, pn_) do { int wgid = (L_); \
    { int q = nwg / NXCD, r = nwg % NXCD, xcd = wgid % NXCD, off = wgid / NXCD; wgid = (xcd < r ? xcd * (q + 1) : r * (q + 1) + (xcd - r) * q) + off; } \
    const int nig = WGM * nN, gid = wgid / nig, fm = gid * WGM, gsz = min(nM - fm, WGM); \
    pm_ = fm + ((wgid % nig) % gsz); pn_ = (wgid % nig) / gsz; } while (0)
  int L = cx.bid;
  if (L < nwg) {
    int pm, pn;
    DECODE(L, pm, pn);
    const char* cA = (const char*)A + (size_t)am.row0(pm) * K * 2; const char* cB = (const char*)Bt + (size_t)pn * BM * K * 2;
    Acc acc;
#pragma unroll
    for (int a = 0; a < 2; ++a)
#pragma unroll
      for (int b = 0; b < 2; ++b)
#pragma unroll
        for (int m = 0; m < 4; ++m)
#pragma unroll
          for (int n = 0; n < 2; ++n) acc[a][b][m][n] = (f32x4){0.f, 0.f, 0.f, 0.f};
    bf16x8 At[4][2], B0[2][2], B1[2][2];
    STAGE(G_SB(0, 0), cB); STAGE(G_SA(0, 0), cA); STAGE(G_SB(0, 1), cB + hstep); STAGE(G_SA(0, 1), cA + hstep);
    if (wr == 1) BAR;
    WAIT_V(4); BAR;
    STAGE(G_SB(1, 0), cB + kstep); STAGE(G_SA(1, 0), cA + kstep); STAGE(G_SB(1, 1), cB + hstep + kstep);
    WAIT_V(6); BAR;
    for (;;) {
      const int Ln = L + cx.nb;
      const bool has_next = Ln < nwg;
      int pmn = pm, pnn = pn;
      if (has_next) DECODE(Ln, pmn, pnn);
      const char* nA = has_next ? (const char*)A + (size_t)am.row0(pmn) * K * 2 : cA; const char* nB = has_next ? (const char*)Bt + (size_t)pnn * BM * K * 2 : cB;
      for (int t = 0; t < nt; t += 2) {
        const bool last = (t == nt - 2);
        const char* a1 = cA + (size_t)(t + 1) * kstep;
        const char* a2 = last ? nA : cA + (size_t)(t + 2) * kstep; const char* b2 = last ? nB : cB + (size_t)(t + 2) * kstep;
        const char* a3 = a2 + kstep; const char* b3 = b2 + kstep;
        LDB(B0, 0, 0); SCHED; LDA(At, 0, 0); STAGE(G_SA(1, 1), a1 + hstep);
        WAIT_L(8); BAR; WAIT_L(0); MMA(0, 0, At, B0); BAR; SCHED;
        LDB(B1, 0, 1); STAGE(G_SB(0, 0), b2);
        BAR; WAIT_L(0); MMA(0, 1, At, B1); BAR;
        LDA(At, 0, 1); STAGE(G_SA(0, 0), a2);
        BAR; WAIT_L(0); MMA(1, 0, At, B0); BAR; SCHED;
        STAGE(G_SB(0, 1), b2 + hstep);
        WAIT_V(6); BAR; MMA(1, 1, At, B1); BAR;
        LDB(B0, 1, 0); SCHED; LDA(At, 1, 0); STAGE(G_SA(0, 1), a2 + hstep);
        WAIT_L(8); BAR; WAIT_L(0); MMA(0, 0, At, B0); BAR; SCHED;
        LDB(B1, 1, 1); STAGE(G_SB(1, 0), b3);
        BAR; WAIT_L(0); MMA(0, 1, At, B1); BAR;
        LDA(At, 1, 1); STAGE(G_SA(1, 0), a3);
        BAR; WAIT_L(0); MMA(1, 0, At, B0); BAR; SCHED;
        STAGE(G_SB(1, 1), b3 + hstep);
        WAIT_V(6); BAR; MMA(1, 1, At, B1); BAR;
      }
      { int t2 = wid_s * 64 + (int)__builtin_amdgcn_mbcnt_hi(~0u, __builtin_amdgcn_mbcnt_lo(~0u, (unsigned)cx.z)); asm volatile("" : "+v"(t2));
        const int w2 = t2 >> 6, l2 = t2 & 63;
        run_epi(cx, epi, acc, cm.row0(pm), pn, w2 >> 2, w2 & 3, l2 & 15, l2 >> 4); }
      if (!has_next) break;
#pragma unroll
      for (int a = 0; a < 2; ++a)
#pragma unroll
        for (int b = 0; b < 2; ++b)
#pragma unroll
          for (int m = 0; m < 4; ++m)
#pragma unroll
            for (int n = 0; n < 2; ++n) acc[a][b][m][n] = (f32x4){0.f, 0.f, 0.f, 0.f};
      pm = pmn; pn = pnn; cA = nA; cB = nB; L = Ln;
    }
    WAIT_V(0);
    if (wr == 0) BAR;
    BAR;
  }
  __syncthreads();
}

template <int MODE>
__device__ __forceinline__ int wrow(int c) {
  if (MODE == 0) return c;
  const int isv = c >= FF ? 1 : 0, f = c - isv * FF;
  return (f >> 7) * 256 + ((f >> 6) & 1) * 128 + ((f >> 4) & 3) * 32 + isv * 16 + (f & 15);
}
template <int MODE>
__device__ __forceinline__ void transpose_item(const float* __restrict__ W, int K, int N, bf16_t* __restrict__ WT, float* scr, int item, int lane) {
  const int nblk = N / 32, kb = item / nblk, nb = item % nblk, k0 = 64 * kb, n0 = 32 * nb;
#pragma unroll 8
  for (int i = 0; i < 32; ++i) { const int kk = 2 * i + (lane >> 5); scr[kk * 33 + (lane & 31)] = W[(size_t)(k0 + kk) * N + n0 + (lane & 31)]; }
  __builtin_amdgcn_wave_barrier(); asm volatile("s_waitcnt lgkmcnt(0)" ::: "memory");
  const int c = lane & 7;
#pragma unroll
  for (int j = 0; j < 4; ++j) {
    const int n = (lane >> 3) + 8 * j; const float* s = scr + (8 * c) * 33 + n;
    u32x4 o; o.x = pk2(s[0 * 33], s[1 * 33]); o.y = pk2(s[2 * 33], s[3 * 33]); o.z = pk2(s[4 * 33], s[5 * 33]); o.w = pk2(s[6 * 33], s[7 * 33]);
    *(u32x4*)(WT + (size_t)wrow<MODE>(n0 + n) * K + k0 + 8 * c) = o;
  }
  asm volatile("s_waitcnt lgkmcnt(0)" ::: "memory"); __builtin_amdgcn_wave_barrier();
}

__device__ __forceinline__ void prologue(const Params& p, const Ctx& cx) {
  const int tid = cx.tid, lane = tid & 63, wave = tid >> 6;
  char* ws = cx.ws;
  {
    float* cond = (float*)lds_raw;
    float* red = (float*)(lds_raw + 9 * 1024 * 4);
    for (int i = tid; i < 9 * 1024; i += 512) { const int j = i >> 10, k = i & 1023; cond[i] = silu_f(j < 8 ? IN(1)[j * 1024 + k] : IN(3)[k]); }
    __syncthreads();
    for (int u = cx.bid; u < 4 * 36; u += cx.nb) {
      const int layer = u / 36, ct = u % 36, c0 = ct * 256 + 4 * lane;
      const float* wp = IN(4) + (size_t)layer * D * 9216 + c0;
      f32x4 a[9];
#pragma unroll
      for (int j = 0; j < 9; ++j) a[j] = (f32x4){0.f, 0.f, 0.f, 0.f};
#pragma unroll 4
      for (int k = wave * 128; k < wave * 128 + 128; ++k) {
        const f32x4 w = *(const f32x4*)(wp + (size_t)k * 9216);
#pragma unroll
        for (int j = 0; j < 9; ++j) a[j] += w * cond[j * 1024 + k];
      }
#pragma unroll
      for (int j = 0; j < 9; ++j) *(f32x4*)(red + (wave * 9 + j) * 256 + 4 * lane) = a[j];
      __syncthreads();
      float* mt = (float*)(ws + O_MODT) + (size_t)layer * 9 * 9216;
      for (int i = tid; i < 9 * 256; i += 512) {
        const int j = i >> 8, c = i & 255; float s = 0.f;
#pragma unroll
        for (int w = 0; w < 8; ++w) s += red[(w * 9 + j) * 256 + c];
        mt[(size_t)j * 9216 + ct * 256 + c] = s + IN(5)[layer * 9216 + ct * 256 + c];
      }
      __syncthreads();
    }
    __syncthreads();
  }
  {
    float* scr = (float*)lds_raw + wave * (64 * 33);
    const int gw = cx.bid * 8 + wave, NGW = cx.nb * 8;
    constexpr int I_FI = 16 * 176, I_FO = 44 * 32, I_UP = 16 * 128, I_DN = 32 * 32, I_AQ = 16 * 48, I_AO = 16 * 32, I_SI = 16 * 96, I_SO = 16 * 32;
    constexpr int NITEMS = 8 * I_FI + 8 * I_FO + 2 * I_UP + 2 * I_DN + I_AQ + I_AO + I_SI + I_SO;
    for (int it = gw; it < NITEMS; it += NGW) {
      int r = it;
      if (r < 8 * I_FI) { const int mi = r / I_FI; transpose_item<1>(IN(8) + (size_t)mi * 1024 * 5632, 1024, 5632, (bf16_t*)(ws + O_WFI) + (size_t)mi * 5632 * 1024, scr, r % I_FI, lane); continue; } r -= 8 * I_FI;
      if (r < 8 * I_FO) { const int mi = r / I_FO; transpose_item<0>(IN(9) + (size_t)mi * 2816 * 1024, 2816, 1024, (bf16_t*)(ws + O_WFO) + (size_t)mi * 1024 * 2816, scr, r % I_FO, lane); continue; } r -= 8 * I_FO;
      if (r < 2 * I_UP) { const int mi = r / I_UP; transpose_item<0>(IN(10) + (size_t)mi * 1024 * 4096, 1024, 4096, (bf16_t*)(ws + O_WUP) + (size_t)mi * 4096 * 1024, scr, r % I_UP, lane); continue; } r -= 2 * I_UP;
      if (r < 2 * I_DN) { const int mi = r / I_DN; transpose_item<0>(IN(18) + (size_t)mi * 2048 * 1024, 2048, 1024, (bf16_t*)(ws + O_WDN) + (size_t)mi * 1024 * 2048, scr, r % I_DN, lane); continue; } r -= 2 * I_DN;
      if (r < I_AQ) { transpose_item<0>(IN(19), 1024, 1536, (bf16_t*)(ws + O_WAQ), scr, r, lane); continue; } r -= I_AQ;
      if (r < I_AO) { transpose_item<0>(IN(21), 1024, 1024, (bf16_t*)(ws + O_WAO), scr, r, lane); continue; } r -= I_AO;
      if (r < I_SI) { transpose_item<0>(IN(22), 1024, 3072, (bf16_t*)(ws + O_WSI), scr, r, lane); continue; } r -= I_SI;
      transpose_item<0>(IN(24), 1024, 1024, (bf16_t*)(ws + O_WSO), scr, r, lane);
    }
  }
  {
    const int gt = cx.bid * 512 + tid, gs = cx.nb * 512;
    bf16_t* wg = (bf16_t*)(ws + O_WG);
    for (int i = gt; i < 2 * 16 * 6144; i += gs) {
      const int j = i / (16 * 6144), xg = (i / 6144) & 15, k = i % 6144, x = xg >> 3, g = xg & 7;
      const float* wif = IN(14) + (size_t)(j * 2 + x) * 6144 * 8;
      float v;
      if (k < 2048) v = wif[(size_t)k * 8 + g];
      else if (k < 4096) v = wif[(size_t)k * 8 + g] * 22.627416997969522f;
      else {
        const int c = k - 4096, blk = c >> 2, cc = c & 3;
        const float* wv = IN(13) + ((size_t)(j * 3 + 2) * 512 + blk) * 16 + cc * 4;
        v = 0.f;
        for (int d2 = 0; d2 < 4; ++d2) v += wv[d2] * wif[(size_t)(4096 + 4 * blk + d2) * 8 + g];
      }
      wg[i] = (bf16_t)(pk2(v, 0.f) & 0xffff);
    }
    float* rc = (float*)(ws + O_ROPE); float* rs = rc + 4096 * 32;
    for (int i = gt; i < 4096 * 32; i += gs) {
      const int pos = i >> 5, pp = i & 31, jf = pp & 15;
      const float fr_ = __builtin_amdgcn_exp2f(-(float)jf * (13.287712379549449f / 16.f));
      float rev = (float)(pp < 16 ? (pos >> 6) : (pos & 63)) * fr_ * 0.15915494309189535f;
      rev -= rintf(rev);
      rc[i] = __builtin_amdgcn_cosf(rev); rs[i] = __builtin_amdgcn_sinf(rev);
    }
  }
}

template <int MODE>
__device__ __forceinline__ void lnmod_phase(const Params& p, const Ctx& cx, int lnidx  , int layer, int slot) {
  const int lane = cx.tid & 63, gw = cx.bid * 8 + (cx.tid >> 6), NGW = cx.nb * 8;
  const int nrows = MODE == 2 ? NLAT : MROWS;
  const float* lg = IN(6) + (size_t)lnidx * D; const float* lb = IN(7) + (size_t)lnidx * D;
  const float* modl = (const float*)(cx.ws + O_MODT) + (size_t)layer * 9 * 9216;
  bf16_t* U = (bf16_t*)(cx.ws + O_U);
  for (int row = gw; row < nrows; row += NGW) {
    float* hp = hrow(cx, row);
    const float* src = MODE == 0 ? (row < NLAT ? IN(0) + (size_t)row * D : IN(2) + (size_t)(row - NLAT) * D) : hp;
    f32x4 v[4];
#pragma unroll
    for (int j = 0; j < 4; ++j) v[j] = *(const f32x4*)(src + 4 * lane + 256 * j);
    if (MODE != 0) {
      float s = 0.f;
#pragma unroll
      for (int j = 0; j < 4; ++j) s += (v[j][0] + v[j][1]) + (v[j][2] + v[j][3]);
      const float mean = wave_sum(s, lane) * (1.f / D); float s2 = 0.f;
#pragma unroll
      for (int j = 0; j < 4; ++j) { v[j] = v[j] - mean; s2 += (v[j][0] * v[j][0] + v[j][1] * v[j][1]) + (v[j][2] * v[j][2] + v[j][3] * v[j][3]); }
      const float rstd = __builtin_amdgcn_rsqf(wave_sum(s2, lane) * (1.f / D) + LN_EPS);
#pragma unroll
      for (int j = 0; j < 4; ++j) v[j] = v[j] * rstd * *(const f32x4*)(lg + 4 * lane + 256 * j) + *(const f32x4*)(lb + 4 * lane + 256 * j);
    }
#pragma unroll
    for (int j = 0; j < 4; ++j) *(f32x4*)(hp + 4 * lane + 256 * j) = v[j];
    if (MODE != 2) {
      const int midx = row < NLAT ? (row >> 12) : 8;
      const float* sh = modl + (size_t)midx * 9216 + (3 * slot) * D; const float* sc = sh + D;
#pragma unroll
      for (int j = 0; j < 4; ++j) {
        const f32x4 u = v[j] * (*(const f32x4*)(sc + 4 * lane + 256 * j) + 1.f) + *(const f32x4*)(sh + 4 * lane + 256 * j);
        u32x2 o; o.x = pk2(u[0], u[1]); o.y = pk2(u[2], u[3]);
        *(u32x2*)(U + (size_t)row * D + 4 * lane + 256 * j) = o;
      }
    }
  }
}

__device__ __forceinline__ int ml_lrow(int bl, int tok) { return tok < LC ? GB * SEQ + bl * LC + tok : bl * SEQ + (tok - LC); }
__device__ __forceinline__ int ml_nchunk(int x, int st) { return x == 0 ? st : (st < 4 ? 3 - st : 71 - st); }

__device__ __forceinline__ void ml_m0(const Params& p, const Ctx& cx, int j) {
  const int tid = cx.tid;
  char* ws = cx.ws;
  const bf16_t* XZ = (const bf16_t*)(ws + O_XZ);
  bf16_t* QK = (bf16_t*)(ws + O_QK); bf16_t* KT = (bf16_t*)(ws + O_KT); bf16_t* VT = (bf16_t*)(ws + O_VT);
  bf16_t* lk = (bf16_t*)lds_raw;
  bf16_t* lv = lk + 256 * 72;
  const int blk_l = tid & 63, tq = tid >> 6;
  for (int u = cx.bid; u < GB * NCH * 8; u += cx.nb) {
    const int slab = u & 7, ch = (u >> 3) % NCH, bl = u / (8 * NCH);
    const int f0 = slab * 256 + blk_l * 4, blk = f0 >> 2;
    float cw[3][4], cb[4], wq[16], wk[16], wv[16];
#pragma unroll
    for (int k = 0; k < 3; ++k)
#pragma unroll
      for (int c = 0; c < 4; ++c) cw[k][c] = IN(11)[(size_t)(j * 3 + k) * EI + f0 + c];
#pragma unroll
    for (int c = 0; c < 4; ++c) cb[c] = IN(12)[(size_t)j * EI + f0 + c];
#pragma unroll
    for (int i = 0; i < 16; ++i) {
      wq[i] = IN(13)[((size_t)(j * 3 + 0) * 512 + blk) * 16 + i];
      wk[i] = IN(13)[((size_t)(j * 3 + 1) * 512 + blk) * 16 + i] * 0.04419417382415922f;
      wv[i] = IN(13)[((size_t)(j * 3 + 2) * 512 + blk) * 16 + i];
    }
    const int tok0 = ch * 64, seg_lo = tok0 < LC ? 0 : LC, seg_hi = tok0 < LC ? LC : TOKB;
    for (int tt = 0; tt < 8; ++tt) {
      const int tl = tq + 8 * tt, tok = tok0 + tl;
      float xm[3][4];
#pragma unroll
      for (int k = 0; k < 3; ++k) {
        const int t2 = tok + k - 1;
        if (t2 >= seg_lo && t2 < seg_hi) {
          const u32x2 r = *(const u32x2*)(XZ + (size_t)ml_lrow(bl, t2) * 4096 + f0);
          xm[k][0] = bflo(r.x); xm[k][1] = bfhi(r.x); xm[k][2] = bflo(r.y); xm[k][3] = bfhi(r.y);
        } else { xm[k][0] = xm[k][1] = xm[k][2] = xm[k][3] = 0.f; }
      }
      float xc[4], q[4], kk[4], vv[4];
#pragma unroll
      for (int c = 0; c < 4; ++c) xc[c] = silu_f(cw[0][c] * xm[0][c] + cw[1][c] * xm[1][c] + cw[2][c] * xm[2][c] + cb[c]);
#pragma unroll
      for (int d2 = 0; d2 < 4; ++d2) {
        q[d2] = xc[0] * wq[d2] + xc[1] * wq[4 + d2] + xc[2] * wq[8 + d2] + xc[3] * wq[12 + d2];
        kk[d2] = xc[0] * wk[d2] + xc[1] * wk[4 + d2] + xc[2] * wk[8 + d2] + xc[3] * wk[12 + d2];
        vv[d2] = xm[1][0] * wv[d2] + xm[1][1] * wv[4 + d2] + xm[1][2] * wv[8 + d2] + xm[1][3] * wv[12 + d2];
      }
      const size_t lr = ml_lrow(bl, tok);
      u32x2 oq, ok, ov; oq.x = pk2(q[0], q[1]); oq.y = pk2(q[2], q[3]); ok.x = pk2(kk[0], kk[1]); ok.y = pk2(kk[2], kk[3]); ov.x = pk2(vv[0], vv[1]); ov.y = pk2(vv[2], vv[3]);
      *(u32x2*)(QK + lr * 4096 + f0) = oq;
      *(u32x2*)(QK + lr * 4096 + 2048 + f0) = ok;
      const int fl = blk_l * 4;
      lk[(fl + 0) * 72 + tl] = (bf16_t)(ok.x & 0xffff); lk[(fl + 1) * 72 + tl] = (bf16_t)(ok.x >> 16); lk[(fl + 2) * 72 + tl] = (bf16_t)(ok.y & 0xffff); lk[(fl + 3) * 72 + tl] = (bf16_t)(ok.y >> 16);
      lv[(fl + 0) * 72 + tl] = (bf16_t)(ov.x & 0xffff); lv[(fl + 1) * 72 + tl] = (bf16_t)(ov.x >> 16); lv[(fl + 2) * 72 + tl] = (bf16_t)(ov.y & 0xffff); lv[(fl + 3) * 72 + tl] = (bf16_t)(ov.y >> 16);
    }
    __syncthreads();
    {
      const int arr = tid >> 8, fr_ = tid & 255;
      const bf16_t* src = (arr ? lv : lk) + fr_ * 72;
      bf16_t* dst = (arr ? VT : KT) + ((size_t)bl * EI + slab * 256 + fr_) * TOKB + tok0;
#pragma unroll
      for (int i = 0; i < 8; ++i) *(u32x4*)(dst + 8 * i) = *(const u32x4*)(src + 8 * i);
    }
    __syncthreads();
  }
}

__device__ __forceinline__ void ml_gates(const Params& p, const Ctx& cx, int j) {
  const int tid = cx.tid, lane = tid & 63, wave = tid >> 6, fr = lane & 15, fq = lane >> 4;
  char* ws = cx.ws;
  const bf16_t* XZ = (const bf16_t*)(ws + O_XZ); const bf16_t* QK = (const bf16_t*)(ws + O_QK);
  const bf16_t* WG = (const bf16_t*)(ws + O_WG) + (size_t)j * 16 * 6144;
  float* BL = (float*)(ws + O_BL); float* IG = (float*)(ws + O_IG);
  float* GC = (float*)(ws + O_GC); float* AC = GC + NSEQ * NCH;
  float* part = (float*)lds_raw;
  float* gl = part + 8 * 64 * 16;
  for (int u = cx.bid; u < GB * NCH; u += cx.nb) {
    const int bl = u / NCH, nc = u % NCH, tok0 = nc * 64;
    f32x4 acc[4];
#pragma unroll
    for (int m = 0; m < 4; ++m) acc[m] = (f32x4){0.f, 0.f, 0.f, 0.f};
    size_t lr[4];
#pragma unroll
    for (int m = 0; m < 4; ++m) lr[m] = ml_lrow(bl, tok0 + m * 16 + fr);
#pragma unroll 4
    for (int ks = wave * 24; ks < wave * 24 + 24; ++ks) {
      const int k = ks * 32 + fq * 8;
      const bf16x8 bfr = *(const bf16x8*)(WG + (size_t)fr * 6144 + k);
#pragma unroll
      for (int m = 0; m < 4; ++m) {
        const bf16_t* ap = k < 4096 ? QK + lr[m] * 4096 + k : XZ + lr[m] * 4096 + (k - 4096);
        const bf16x8 afr = *(const bf16x8*)ap;
        acc[m] = MFMA16(afr, bfr, acc[m]);
      }
    }
#pragma unroll
    for (int m = 0; m < 4; ++m)
#pragma unroll
      for (int jj = 0; jj < 4; ++jj) part[(wave * 64 + m * 16 + 4 * fq + jj) * 16 + fr] = acc[m][jj];
    __syncthreads();
    for (int i = tid; i < 1024; i += 512) {
      float s = IN(15)[(size_t)j * 16 + (i & 15)];
#pragma unroll
      for (int w = 0; w < 8; ++w) s += part[w * 1024 + i];
      gl[(i >> 4) * 17 + (i & 15)] = s;
    }
    __syncthreads();
    if (tid < 8) {
      const int x = tid >> 2, h = tid & 3, seq = (bl * 2 + x) * 4 + h;
      float b = 0.f, mx = -3.0e38f;
      for (int pp = 0; pp < 64; ++pp) {
        const int tl = x == 0 ? pp : 63 - pp;
        const float ig = gl[tl * 17 + x * 8 + h], fg = gl[tl * 17 + x * 8 + 4 + h];
        const float lf = fg > 0.f ? -__logf(1.f + __expf(-fg)) : fg - __logf(1.f + __expf(fg));
        b += lf;
        BL[(size_t)seq * TOKB + tok0 + tl] = b; IG[(size_t)seq * TOKB + tok0 + tl] = ig;
        mx = fmaxf(mx, ig - b);
      }
      GC[seq * NCH + nc] = b; AC[seq * NCH + nc] = b + mx;
    }
    __syncthreads();
  }
}

__device__ __forceinline__ void ml_s(const Params& p, const Ctx& cx) {
  const int tid = cx.tid, lane = tid & 63, wave = tid >> 6, fr = lane & 15, fq = lane >> 4;
  char* ws = cx.ws;
  const bf16_t* QK = (const bf16_t*)(ws + O_QK);
  bf16_t* SP = (bf16_t*)(ws + O_SP);
  const float* BL = (const float*)(ws + O_BL); const float* IG = (const float*)(ws + O_IG);
  float* WIN = (float*)(ws + O_WIN); float* FLO = (float*)(ws + O_FLO); float* DEN = (float*)(ws + O_DEN); float* WSS = (float*)(ws + O_WSS);
  const float* GC = (const float*)(ws + O_GC); const float* AC = GC + NSEQ * NCH; float* DEC = (float*)(ws + O_GC) + 2 * NSEQ * NCH;
  float* sb_ = (float*)lds_raw; float* si_ = sb_ + 64; float* smt = si_ + 64; float* sden = smt + 64;
  for (int u = cx.bid; u < NSEQ * NCH; u += cx.nb) {
    const int seq = u / NCH, st = u % NCH, x = (seq >> 2) & 1, h = seq & 3, bl = seq >> 3;
    const int nc = ml_nchunk(x, st), tok0 = nc * 64;
    if (wave == 0) {
      const int nl0 = ml_nchunk(x, lane), nl1 = ml_nchunk(x, 64 + (lane & 3));
      const float g0 = GC[seq * NCH + nl0], a0 = AC[seq * NCH + nl0], g1 = GC[seq * NCH + nl1], a1 = AC[seq * NCH + nl1];
      float mc = 0.f;
      for (int s2 = 0; s2 < st; ++s2) {
        const float gg = __int_as_float(__builtin_amdgcn_readlane(__float_as_int(s2 < 64 ? g0 : g1), s2 & 63));
        const float aa = __int_as_float(__builtin_amdgcn_readlane(__float_as_int(s2 < 64 ? a0 : a1), s2 & 63));
        mc = fmaxf(gg + mc, aa);
      }
      const float gc = GC[seq * NCH + nc], ac = AC[seq * NCH + nc];
      const float mnew = fmaxf(gc + mc, ac);
      const int tl = x == 0 ? lane : 63 - lane;
      const float b = BL[(size_t)seq * TOKB + tok0 + tl], ig = IG[(size_t)seq * TOKB + tok0 + tl];
      float cm = ig - b;
#pragma unroll
      for (int o = 1; o < 64; o <<= 1) { const float t2 = shi(cm, lane - o); if (lane >= o) cm = fmaxf(cm, t2); }
      const float mt = b + fmaxf(mc, cm);
      sb_[tl] = b; si_[tl] = ig; smt[tl] = mt;
      WIN[(size_t)seq * TOKB + tok0 + tl] = __expf(b + mc - mt);
      FLO[(size_t)seq * TOKB + tok0 + tl] = __expf(-mt);
      WSS[(size_t)seq * TOKB + tok0 + tl] = __expf(gc - b + ig - mnew);
      if (lane == 0) DEC[seq * NCH + nc] = __expf(gc + mc - mnew);
    }
    __syncthreads();
    const int sbk = wave >> 1;
    const bf16_t* kp = QK + (size_t)ml_lrow(bl, tok0 + sbk * 16 + fr) * 4096 + 2048 + h * DH + fq * 8;
    const bf16_t* qp0 = QK + (size_t)ml_lrow(bl, tok0 + (2 * (wave & 1)) * 16 + fr) * 4096 + h * DH + fq * 8;
    const bf16_t* qp1 = QK + (size_t)ml_lrow(bl, tok0 + (2 * (wave & 1) + 1) * 16 + fr) * 4096 + h * DH + fq * 8;
    f32x4 a0 = {0.f, 0.f, 0.f, 0.f}, a1 = {0.f, 0.f, 0.f, 0.f};
#pragma unroll 4
    for (int ks = 0; ks < 16; ++ks) {
      const bf16x8 kf = *(const bf16x8*)(kp + ks * 32), q0 = *(const bf16x8*)(qp0 + ks * 32), q1 = *(const bf16x8*)(qp1 + ks * 32);
      a0 = MFMA16(kf, q0, a0); a1 = MFMA16(kf, q1, a1);
    }
    bf16_t* spu = SP + (size_t)(seq * NCH + nc) * 4096;
#pragma unroll
    for (int tbi = 0; tbi < 2; ++tbi) {
      const int t = (2 * (wave & 1) + tbi) * 16 + fr;
      const f32x4 a = tbi ? a1 : a0;
      const float bt = sb_[t], mt = smt[t];
      float vals[4];
#pragma unroll
      for (int jj = 0; jj < 4; ++jj) {
        const int s = sbk * 16 + 4 * fq + jj;
        const bool ok = x == 0 ? (s <= t) : (s >= t);
        vals[jj] = ok ? a[jj] * __expf(bt - sb_[s] + si_[s] - mt) : 0.f;
      }
      u32x2 o; o.x = pk2(vals[0], vals[1]); o.y = pk2(vals[2], vals[3]);
      *(u32x2*)(spu + t * 64 + sbk * 16 + 4 * fq) = o;
      float ds = (bflo(o.x) + bfhi(o.x)) + (bflo(o.y) + bfhi(o.y));
      ds += shx(ds, 16, lane); ds += shx(ds, 32, lane);
      if (fq == 0) sden[sbk * 64 + t] = ds;
    }
    __syncthreads();
    if (tid < 64) DEN[(size_t)seq * TOKB + tok0 + tid] = (sden[tid] + sden[64 + tid]) + (sden[128 + tid] + sden[192 + tid]);
    __syncthreads();
  }
}

constexpr int NEB = 2, NSL = 512 / (16 * NEB);
__device__ __forceinline__ void ml_m2(const Params& p, const Ctx& cx) {
  const int tid = cx.tid, lane = tid & 63, wave = tid >> 6, fr = lane & 15, fq = lane >> 4;
  char* ws = cx.ws;
  const bf16_t* QK = (const bf16_t*)(ws + O_QK); const bf16_t* KT = (const bf16_t*)(ws + O_KT); const bf16_t* VT = (const bf16_t*)(ws + O_VT);
  const bf16_t* SP = (const bf16_t*)(ws + O_SP);
  bf16_t* HD = (bf16_t*)(ws + O_HD);
  const float* WIN = (const float*)(ws + O_WIN); const float* FLO = (const float*)(ws + O_FLO); const float* DEN = (const float*)(ws + O_DEN); const float* WSS = (const float*)(ws + O_WSS);
  const float* DEC = (const float*)(ws + O_GC) + 2 * NSEQ * NCH;
  f32x4* red = (f32x4*)lds_raw;
  f32x4* rn = (f32x4*)(lds_raw + 131072);
  for (int idx = cx.bid >> 3; idx < 2 * NSL; idx += cx.nb >> 3) {
    const int seq = (cx.bid & 7) * 2 + idx / NSL, es = idx % NSL, x = (seq >> 2) & 1, h = seq & 3, bl = seq >> 3;
    const int d0 = wave * 64, e0 = es * 16 * NEB;
    f32x4 C[4][NEB + 1];
#pragma unroll
    for (int a = 0; a < 4; ++a)
#pragma unroll
      for (int b = 0; b < NEB + 1; ++b) C[a][b] = (f32x4){0.f, 0.f, 0.f, 0.f};
    const int tbo = wave >> 1, ebo = wave & 1;
    for (int st = 0; st < NCH; ++st) {
      const int nc = ml_nchunk(x, st), tok0 = nc * 64;
      bf16x8 qc[4][2];
#pragma unroll
      for (int tb = 0; tb < 4; ++tb) {
        const bf16_t* qp = QK + (size_t)ml_lrow(bl, tok0 + tb * 16 + fr) * 4096 + h * DH + d0 + 4 * fq;
        qc[tb][0] = mk8(*(const u32x2*)(qp), *(const u32x2*)(qp + 16));
        qc[tb][1] = mk8(*(const u32x2*)(qp + 32), *(const u32x2*)(qp + 48));
      }
      bf16x8 kf[4][2];
#pragma unroll
      for (int db = 0; db < 4; ++db) {
        const bf16_t* kp = KT + ((size_t)bl * EI + h * DH + d0 + db * 16 + fr) * TOKB + tok0 + 8 * fq;
        kf[db][0] = *(const bf16x8*)kp; kf[db][1] = *(const bf16x8*)(kp + 32);
      }
      u32x4 vr[NEB][2];
#pragma unroll
      for (int eb = 0; eb < NEB; ++eb) {
        const bf16_t* vp = VT + ((size_t)bl * EI + h * DH + e0 + eb * 16 + fr) * TOKB + tok0 + 8 * fq;
        vr[eb][0] = *(const u32x4*)vp; vr[eb][1] = *(const u32x4*)(vp + 32);
      }
      f32x4 wv[2][2];
#pragma unroll
      for (int ks = 0; ks < 2; ++ks) {
        const float* wp = WSS + (size_t)seq * TOKB + tok0 + 32 * ks + 8 * fq;
        wv[ks][0] = *(const f32x4*)wp; wv[ks][1] = *(const f32x4*)(wp + 4);
      }
      const bf16_t* sp = SP + (size_t)(seq * NCH + nc) * 4096 + (tbo * 16 + fr) * 64 + 8 * fq;
      const bf16x8 sf0 = *(const bf16x8*)sp, sf1 = *(const bf16x8*)(sp + 32);
      const size_t tix = (size_t)seq * TOKB + tok0 + tbo * 16 + 4 * fq;
      const f32x4 win = *(const f32x4*)(WIN + tix), flo = *(const f32x4*)(FLO + tix), deni = *(const f32x4*)(DEN + tix);
      const float decay = DEC[seq * NCH + nc];
#pragma unroll
      for (int eb = 0; eb < NEB + 1; ++eb) {
        bf16x8 cb0, cb1;
        { const f32x4 lo = C[0][eb], hi = C[1][eb]; cb0 = mk8((u32x4){pk2(lo[0], lo[1]), pk2(lo[2], lo[3]), pk2(hi[0], hi[1]), pk2(hi[2], hi[3])}); }
        { const f32x4 lo = C[2][eb], hi = C[3][eb]; cb1 = mk8((u32x4){pk2(lo[0], lo[1]), pk2(lo[2], lo[3]), pk2(hi[0], hi[1]), pk2(hi[2], hi[3])}); }
        f32x4 pa[4];
#pragma unroll
        for (int tb = 0; tb < 4; ++tb) pa[tb] = MFMA16(qc[tb][0], cb0, ((f32x4){0.f, 0.f, 0.f, 0.f}));
#pragma unroll
        for (int tb = 0; tb < 4; ++tb) pa[tb] = MFMA16(qc[tb][1], cb1, pa[tb]);
#pragma unroll
        for (int tb = 0; tb < 4; ++tb) {
          if (eb < NEB) red[((wave * 4 + tb) * NEB + eb) * 64 + lane] = pa[tb];
          else if (fr == 0) rn[(wave * 4 + tb) * 4 + fq] = pa[tb];
        }
      }
      f32x4 oi = {0.f, 0.f, 0.f, 0.f};
#pragma unroll
      for (int eb = 0; eb < NEB + 1; ++eb) {
        bf16x8 vw0, vw1;
        if (eb < NEB) {
          const u32x4 r0 = vr[eb][0], r1 = vr[eb][1];
          if (eb == ebo) { oi = MFMA16(sf0, mk8(r0), oi); oi = MFMA16(sf1, mk8(r1), oi); }
          vw0 = mk8((u32x4){pk2(bflo(r0.x) * wv[0][0][0], bfhi(r0.x) * wv[0][0][1]), pk2(bflo(r0.y) * wv[0][0][2], bfhi(r0.y) * wv[0][0][3]),
                            pk2(bflo(r0.z) * wv[0][1][0], bfhi(r0.z) * wv[0][1][1]), pk2(bflo(r0.w) * wv[0][1][2], bfhi(r0.w) * wv[0][1][3])});
          vw1 = mk8((u32x4){pk2(bflo(r1.x) * wv[1][0][0], bfhi(r1.x) * wv[1][0][1]), pk2(bflo(r1.y) * wv[1][0][2], bfhi(r1.y) * wv[1][0][3]),
                            pk2(bflo(r1.z) * wv[1][1][0], bfhi(r1.z) * wv[1][1][1]), pk2(bflo(r1.w) * wv[1][1][2], bfhi(r1.w) * wv[1][1][3])});
        } else {
          vw0 = mk8((u32x4){pk2(wv[0][0][0], wv[0][0][1]), pk2(wv[0][0][2], wv[0][0][3]), pk2(wv[0][1][0], wv[0][1][1]), pk2(wv[0][1][2], wv[0][1][3])});
          vw1 = mk8((u32x4){pk2(wv[1][0][0], wv[1][0][1]), pk2(wv[1][0][2], wv[1][0][3]), pk2(wv[1][1][0], wv[1][1][1]), pk2(wv[1][1][2], wv[1][1][3])});
        }
#pragma unroll
        for (int db = 0; db < 4; ++db) {
          f32x4 c = C[db][eb] * decay;
          c = MFMA16(kf[db][0], vw0, c); c = MFMA16(kf[db][1], vw1, c);
          C[db][eb] = c;
        }
      }
      __syncthreads();
      f32x4 rdn[8], rd0[8];
#pragma unroll
      for (int w = 0; w < 8; ++w) { rdn[w] = rn[(w * 4 + tbo) * 4 + fq]; rd0[w] = red[((w * 4 + tbo) * NEB + ebo) * 64 + lane]; }
      const f32x4 pn = ((rdn[0] + rdn[1]) + (rdn[2] + rdn[3])) + ((rdn[4] + rdn[5]) + (rdn[6] + rdn[7]));
      const f32x4 pi = ((rd0[0] + rd0[1]) + (rd0[2] + rd0[3])) + ((rd0[4] + rd0[5]) + (rd0[6] + rd0[7]));
#pragma unroll
      for (int jj = 0; jj < 4; ++jj) {
        const float num = oi[jj] + win[jj] * pi[jj], den = deni[jj] + win[jj] * pn[jj];
        const float hv = num * __builtin_amdgcn_rcpf(fmaxf(fabsf(den), flo[jj]));
        HD[((size_t)x * RG + ml_lrow(bl, tok0 + tbo * 16 + 4 * fq + jj)) * EI + h * DH + e0 + ebo * 16 + fr] = (bf16_t)(pk2(hv, 0.f) & 0xffff);
      }
      __syncthreads();
    }
  }
}

__device__ __forceinline__ void ml_fin(const Params& p, const Ctx& cx, int j) {
  const int lane = cx.tid & 63, gw = cx.bid * 8 + (cx.tid >> 6), NGW = cx.nb * 8;
  char* ws = cx.ws;
  const bf16_t* XZ = (const bf16_t*)(ws + O_XZ); const bf16_t* HD = (const bf16_t*)(ws + O_HD);
  bf16_t* FIN = (bf16_t*)(ws + O_FIN);
  for (int u = gw; u < RG * 4; u += NGW) {
    const int lr = u >> 2, h = u & 3, f0 = h * DH + lane * 8;
    int pos, seglen;
    if (lr < GB * SEQ) { pos = lr & (SEQ - 1); seglen = SEQ; } else { pos = (lr - GB * SEQ) & (LC - 1); seglen = LC; }
    const u32x4 hf = *(const u32x4*)(HD + (size_t)lr * EI + f0), hb = *(const u32x4*)(HD + ((size_t)RG + lr) * EI + f0);
    const u32x4 zz = *(const u32x4*)(XZ + (size_t)lr * 4096 + 2048 + f0);
    const u32x4 x1 = *(const u32x4*)(XZ + (size_t)lr * 4096 + f0);
    u32x4 x0 = {0u, 0u, 0u, 0u}, x2 = {0u, 0u, 0u, 0u};
    if (pos > 0) x0 = *(const u32x4*)(XZ + (size_t)(lr - 1) * 4096 + f0);
    if (pos < seglen - 1) x2 = *(const u32x4*)(XZ + (size_t)(lr + 1) * 4096 + f0);
    float hv[8], xm0[8], xm1[8], xm2[8];
    const unsigned hfu[4] = {hf.x, hf.y, hf.z, hf.w}, hbu[4] = {hb.x, hb.y, hb.z, hb.w}, zu[4] = {zz.x, zz.y, zz.z, zz.w};
    const unsigned x0u[4] = {x0.x, x0.y, x0.z, x0.w}, x1u[4] = {x1.x, x1.y, x1.z, x1.w}, x2u[4] = {x2.x, x2.y, x2.z, x2.w};
    float s = 0.f;
#pragma unroll
    for (int i = 0; i < 4; ++i) {
      hv[2 * i] = (bflo(hfu[i]) + bflo(hbu[i])) * sigm_f(bflo(zu[i]));
      hv[2 * i + 1] = (bfhi(hfu[i]) + bfhi(hbu[i])) * sigm_f(bfhi(zu[i]));
      xm0[2 * i] = bflo(x0u[i]); xm0[2 * i + 1] = bfhi(x0u[i]); xm1[2 * i] = bflo(x1u[i]); xm1[2 * i + 1] = bfhi(x1u[i]); xm2[2 * i] = bflo(x2u[i]); xm2[2 * i + 1] = bfhi(x2u[i]);
      s += hv[2 * i] + hv[2 * i + 1];
    }
    const float mean = wave_sum(s, lane) * (1.f / DH); float s2 = 0.f;
#pragma unroll
    for (int i = 0; i < 8; ++i) { hv[i] -= mean; s2 += hv[i] * hv[i]; }
    const float rstd = __builtin_amdgcn_rsqf(wave_sum(s2, lane) * (1.f / DH) + LN_EPS);
    float o[8];
#pragma unroll
    for (int i = 0; i < 8; ++i) {
      const int f = f0 + i;
      const float xc = silu_f(IN(11)[(size_t)(j * 3 + 0) * EI + f] * xm0[i] + IN(11)[(size_t)(j * 3 + 1) * EI + f] * xm1[i] + IN(11)[(size_t)(j * 3 + 2) * EI + f] * xm2[i] + IN(12)[(size_t)j * EI + f]);
      o[i] = hv[i] * rstd * IN(17)[(size_t)j * EI + f] + IN(16)[(size_t)j * EI + f] * xc;
    }
    u32x4 ov; ov.x = pk2(o[0], o[1]); ov.y = pk2(o[2], o[3]); ov.z = pk2(o[4], o[5]); ov.w = pk2(o[6], o[7]);
    *(u32x4*)(FIN + (size_t)lr * EI + f0) = ov;
  }
}

__device__ __forceinline__ void at_prep(const Params& p, const Ctx& cx) {
  const int lane = cx.tid & 63, gw = cx.bid * 8 + (cx.tid >> 6), NGW = cx.nb * 8;
  char* ws = cx.ws;
  bf16_t* ACT = (bf16_t*)(ws + O_ACT); bf16_t* KR = (bf16_t*)(ws + O_AKR); bf16_t* VT = (bf16_t*)(ws + O_AVT);
  const float* rc = (const float*)(ws + O_ROPE); const float* rs = rc + 4096 * 32;
  for (int row = gw; row < MROWS; row += NGW) {
    const bool lat = row < NLAT;
    const int b = lat ? row >> 12 : (row - NLAT) >> 8, pos = lat ? row & 4095 : (row - NLAT) & 255, tok = lat ? LC + pos : pos;
    bf16_t* rp = ACT + (size_t)row * 1536;
    {
      const u32x4 a = *(const u32x4*)(rp + 16 * lane), b2 = *(const u32x4*)(rp + 16 * lane + 8);
      const unsigned w[8] = {a.x, a.y, a.z, a.w, b2.x, b2.y, b2.z, b2.w};
      unsigned o[8];
      const int pp0 = (lane & 3) * 8;
#pragma unroll
      for (int i = 0; i < 8; ++i) {
        float x1 = bflo(w[i]) * 0.125f, x2 = bfhi(w[i]) * 0.125f;
        if (lat) { const float c = rc[pos * 32 + pp0 + i], s = rs[pos * 32 + pp0 + i]; const float y1 = x1 * c - x2 * s, y2 = x1 * s + x2 * c; x1 = y1; x2 = y2; }
        o[i] = pk2(x1, x2);
      }
      *(u32x4*)(rp + 16 * lane) = (u32x4){o[0], o[1], o[2], o[3]}; *(u32x4*)(rp + 16 * lane + 8) = (u32x4){o[4], o[5], o[6], o[7]};
    }
    {
      const u32x2 a = *(const u32x2*)(rp + 1024 + 4 * lane);
      const unsigned w[2] = {a.x, a.y}; unsigned o[2];
      const int g = lane >> 4, dd = (lane & 15) * 4, pp0 = dd >> 1;
#pragma unroll
      for (int i = 0; i < 2; ++i) {
        float x1 = bflo(w[i]), x2 = bfhi(w[i]);
        if (lat) { const float c = rc[pos * 32 + pp0 + i], s = rs[pos * 32 + pp0 + i]; const float y1 = x1 * c - x2 * s, y2 = x1 * s + x2 * c; x1 = y1; x2 = y2; }
        o[i] = pk2(x1, x2);
      }
      *(u32x2*)(KR + (((size_t)b * 4 + g) * TOKB + tok) * 64 + dd) = (u32x2){o[0], o[1]};
      const u32x2 v = *(const u32x2*)(rp + 1280 + 4 * lane);
      bf16_t* vp = VT + (((size_t)b * 4 + g) * 64 + dd) * TOKB + tok;
      vp[0] = (bf16_t)(v.x & 0xffff); vp[TOKB] = (bf16_t)(v.x >> 16); vp[2 * TOKB] = (bf16_t)(v.y & 0xffff); vp[3 * TOKB] = (bf16_t)(v.y >> 16);
    }
  }
}

__device__ __forceinline__ void at_core(const Params& p, const Ctx& cx) {
  const int lane = cx.tid & 63, gw = cx.bid * 8 + (cx.tid >> 6), NGW = cx.nb * 8, fr = lane & 15, fq = lane >> 4;
  char* ws = cx.ws;
  const bf16_t* ACT = (const bf16_t*)(ws + O_ACT); const bf16_t* KR = (const bf16_t*)(ws + O_AKR); const bf16_t* VT = (const bf16_t*)(ws + O_AVT);
  bf16_t* O = (bf16_t*)(ws + O_U);
  for (int u = gw; u < (MROWS / 16) * 4; u += NGW) {
    const int g = u & 3, qb = u >> 2, row0 = qb * 16;
    const bool lat = row0 < NLAT;
    const int b = lat ? row0 >> 12 : (row0 - NLAT) >> 8, q0 = lat ? row0 & 4095 : 0;
    bf16x8 qf[4][2];
    float mrun[4], lrun[4], sink[4];
    f32x4 oacc[4][4];
#pragma unroll
    for (int hh = 0; hh < 4; ++hh) {
      const bf16_t* qp = ACT + (size_t)(row0 + fr) * 1536 + (g * 4 + hh) * 64 + 8 * fq;
      qf[hh][0] = *(const bf16x8*)qp; qf[hh][1] = *(const bf16x8*)(qp + 32);
      sink[hh] = IN(20)[g * 4 + hh]; mrun[hh] = sink[hh]; lrun[hh] = 0.f;
#pragma unroll
      for (int d2 = 0; d2 < 4; ++d2) oacc[hh][d2] = (f32x4){0.f, 0.f, 0.f, 0.f};
    }
    const bf16_t* kbase = KR + ((size_t)b * 4 + g) * TOKB * 64;
    const bf16_t* vbase = VT + ((size_t)b * 4 + g) * 64 * TOKB;
    int wlo = 0, whi = -1;
    if (lat) { wlo = max(0, q0 - 128) & ~31; whi = min(SEQ - 1, q0 + 143); }
    const int nwin = lat ? (whi - wlo) / 32 + 1 : 0;
    for (int ti = 0; ti < 8 + nwin; ++ti) {
      const bool isw = ti >= 8;
      const int kpos0 = isw ? wlo + (ti - 8) * 32 : 0;
      const int tk0 = isw ? LC + kpos0 : ti * 32;
      const bf16_t* kp = kbase + (size_t)(tk0 + fr) * 64 + 8 * fq;
      const bf16x8 k00 = *(const bf16x8*)kp, k01 = *(const bf16x8*)(kp + 32), k10 = *(const bf16x8*)(kp + 16 * 64), k11 = *(const bf16x8*)(kp + 16 * 64 + 32);
      bf16x8 vfr[4];
#pragma unroll
      for (int d2 = 0; d2 < 4; ++d2) {
        const bf16_t* vp = vbase + (size_t)(d2 * 16 + fr) * TOKB + tk0 + 4 * fq;
        vfr[d2] = mk8(*(const u32x2*)vp, *(const u32x2*)(vp + 16));
      }
      bool okm[8];
#pragma unroll
      for (int i = 0; i < 8; ++i) {
        const int kpos = kpos0 + (i >> 2) * 16 + 4 * fq + (i & 3), dlt = (q0 + fr) - kpos;
        okm[i] = !isw || (dlt <= 128 && dlt >= -128);
      }
#pragma unroll
      for (int hh = 0; hh < 4; ++hh) {
        f32x4 s0 = {0.f, 0.f, 0.f, 0.f}, s1 = {0.f, 0.f, 0.f, 0.f};
        s0 = MFMA16(k00, qf[hh][0], s0); s0 = MFMA16(k01, qf[hh][1], s0);
        s1 = MFMA16(k10, qf[hh][0], s1); s1 = MFMA16(k11, qf[hh][1], s1);
        float sv[8]; float tmax = -3.0e38f;
#pragma unroll
        for (int i = 0; i < 8; ++i) { sv[i] = okm[i] ? (i < 4 ? s0[i] : s1[i - 4]) : -3.0e38f; tmax = fmaxf(tmax, sv[i]); }
        tmax = fmaxf(tmax, shx(tmax, 16, lane)); tmax = fmaxf(tmax, shx(tmax, 32, lane));
        const float mnew = fmaxf(mrun[hh], tmax), scale = __expf(mrun[hh] - mnew);
        mrun[hh] = mnew;
        float pv[8];
#pragma unroll
        for (int i = 0; i < 8; ++i) pv[i] = okm[i] ? __expf(sv[i] - mnew) : 0.f;
        const u32x4 pu = {pk2(pv[0], pv[1]), pk2(pv[2], pv[3]), pk2(pv[4], pv[5]), pk2(pv[6], pv[7])};
        const float ps = ((bflo(pu.x) + bfhi(pu.x)) + (bflo(pu.y) + bfhi(pu.y))) + ((bflo(pu.z) + bfhi(pu.z)) + (bflo(pu.w) + bfhi(pu.w)));
        lrun[hh] = lrun[hh] * scale + ps;
        const bf16x8 pf = mk8(pu);
        float scq[4];
#pragma unroll
        for (int jj = 0; jj < 4; ++jj) scq[jj] = shi(scale, 4 * fq + jj);
#pragma unroll
        for (int d2 = 0; d2 < 4; ++d2) {
          f32x4 o = oacc[hh][d2];
          o[0] *= scq[0]; o[1] *= scq[1]; o[2] *= scq[2]; o[3] *= scq[3];
          oacc[hh][d2] = MFMA16(pf, vfr[d2], o);
        }
      }
    }
#pragma unroll
    for (int hh = 0; hh < 4; ++hh) {
      float l = lrun[hh];
      l += shx(l, 16, lane); l += shx(l, 32, lane);
      l += __expf(sink[hh] - mrun[hh]);
      const float inv = __builtin_amdgcn_rcpf(l);
      float iq[4];
#pragma unroll
      for (int jj = 0; jj < 4; ++jj) iq[jj] = shi(inv, 4 * fq + jj);
#pragma unroll
      for (int d2 = 0; d2 < 4; ++d2)
#pragma unroll
        for (int jj = 0; jj < 4; ++jj)
          O[(size_t)(row0 + 4 * fq + jj) * D + (g * 4 + hh) * 64 + d2 * 16 + fr] = (bf16_t)(pk2(oacc[hh][d2][jj] * iq[jj], 0.f) & 0xffff);
    }
  }
}

__device__ __forceinline__ void sc_conv(const Params& p, const Ctx& cx) {
  const int gt = cx.bid * 512 + cx.tid, gs = cx.nb * 512;
  const bf16_t* ACT = (const bf16_t*)(cx.ws + O_ACT); bf16_t* O = (bf16_t*)(cx.ws + O_U);
  const float* cw = IN(23);
  for (int i = gt; i < MROWS * 128; i += gs) {
    const int row = i >> 7, c0 = (i & 127) * 8;
    int pos, seglen;
    if (row < NLAT) { pos = row & (SEQ - 1); seglen = SEQ; } else { pos = (row - NLAT) & (LC - 1); seglen = LC; }
    float accv[8];
#pragma unroll
    for (int e = 0; e < 8; ++e) accv[e] = 0.f;
#pragma unroll
    for (int k = 0; k < 3; ++k) {
      const int pp = pos + k - 1;
      if (pp < 0 || pp >= seglen) continue;
      const bf16_t* rp = ACT + (size_t)(row + k - 1) * 3072;
      const u32x4 cgv = *(const u32x4*)(rp + 1024 + c0), xtv = *(const u32x4*)(rp + 2048 + c0);
      const unsigned cu[4] = {cgv.x, cgv.y, cgv.z, cgv.w}, xu[4] = {xtv.x, xtv.y, xtv.z, xtv.w};
#pragma unroll
      for (int e = 0; e < 4; ++e) {
        accv[2 * e] += cw[k * D + c0 + 2 * e] * (bflo(cu[e]) * bflo(xu[e]));
        accv[2 * e + 1] += cw[k * D + c0 + 2 * e + 1] * (bfhi(cu[e]) * bfhi(xu[e]));
      }
    }
    const u32x4 bgv = *(const u32x4*)(ACT + (size_t)row * 3072 + c0);
    const unsigned bu[4] = {bgv.x, bgv.y, bgv.z, bgv.w};
    u32x4 o;
    o.x = pk2(bflo(bu[0]) * accv[0], bfhi(bu[0]) * accv[1]); o.y = pk2(bflo(bu[1]) * accv[2], bfhi(bu[1]) * accv[3]);
    o.z = pk2(bflo(bu[2]) * accv[4], bfhi(bu[2]) * accv[5]); o.w = pk2(bflo(bu[3]) * accv[6], bfhi(bu[3]) * accv[7]);
    *(u32x4*)(O + (size_t)row * D + c0) = o;
  }
}

#define XB_TMO      128
#define XB_XCNT(j)  (256  + 64 * (j))
#define XB_XSUB(j)  (1280 + 64 * (j))
#define XB_XGEN(j)  (2304 + 64 * (j))
#define XB_TOP      3328
#define XB_TOPGEN   3392
#define XCD_BAR_WORDS 3456
#define XB_SPIN_CAP (1u << 18)
__device__ __forceinline__ unsigned xb_ld(unsigned* p)              { return __hip_atomic_load(p, __ATOMIC_RELAXED, __HIP_MEMORY_SCOPE_AGENT); }
__device__ __forceinline__ unsigned xb_add(unsigned* p, unsigned v) { return __hip_atomic_fetch_add(p, v, __ATOMIC_RELAXED, __HIP_MEMORY_SCOPE_AGENT); }
__device__ __forceinline__ unsigned xb_xcc_id() { return (unsigned)__builtin_amdgcn_s_getreg((3 << 11) | 20) & 0xFu; }
#define XB_SPIN(cond, bar) do { unsigned _sp = 0; while (cond) { __builtin_amdgcn_s_sleep(1); \
    if ((++_sp & 255u) == 0u) { if (xb_ld(&(bar)[XB_TMO])) break; if (_sp > XB_SPIN_CAP) { atomicAdd(&(bar)[XB_TMO], 1u); break; } } } } while (0)
__device__ __forceinline__ void xcd_barrier_complete(unsigned* bar, unsigned x, unsigned& nloc, unsigned& nx) {
  const unsigned G = gridDim.x;
  unsigned sum, cnt, mine, sp = 0u;
  for (;;) {
    sum = 0u; cnt = 0u; mine = 0u;
#pragma unroll
    for (unsigned j = 0; j < 16; ++j) { const unsigned c = xb_ld(&bar[XB_XCNT(j)]); sum += c; cnt += (c > 0u) ? 1u : 0u; mine = (j == x) ? c : mine; }
    if (sum == G) break;
    __builtin_amdgcn_s_sleep(1);
    if ((++sp & 255u) == 0u) { if (xb_ld(&bar[XB_TMO])) break; if (sp > XB_SPIN_CAP) { atomicAdd(&bar[XB_TMO], 1u); break; } }
  }
  nloc = mine > 0u ? mine : 1u; nx = cnt > 0u ? cnt : 1u;
}
__device__ __forceinline__ void xcd_barrier(unsigned* bar, unsigned x, volatile LAS unsigned* st) {
  asm volatile("s_waitcnt vmcnt(0)" ::: "memory");
  __syncthreads();
  if (threadIdx.x == 0) {
    __builtin_amdgcn_s_waitcnt(0);
    unsigned nloc = st[0], nx = st[1];
    if (nloc == 0u) { xcd_barrier_complete(bar, x, nloc, nx); st[0] = nloc; st[1] = nx; }
    const unsigned old = xb_add(&bar[XB_XSUB(x)], 1u);
    const unsigned gen = old / nloc;
    if (old + 1u == (gen + 1u) * nloc) {
      __builtin_amdgcn_fence(__ATOMIC_RELEASE, "agent");
      asm volatile("s_waitcnt vmcnt(0)" ::: "memory");
      const unsigned og = xb_add(&bar[XB_TOP], 1u);
      const unsigned tg = og / nx;
      if (og + 1u == (tg + 1u) * nx) xb_add(&bar[XB_TOPGEN], 1u);
      else XB_SPIN(xb_ld(&bar[XB_TOPGEN]) == tg, bar);
      __builtin_amdgcn_fence(__ATOMIC_ACQUIRE, "agent");
      xb_add(&bar[XB_XGEN(x)], 1u);
      asm volatile("s_waitcnt vmcnt(0)" ::: "memory");
    } else {
      XB_SPIN(xb_ld(&bar[XB_XGEN(x)]) == gen, bar);
      __builtin_amdgcn_fence(__ATOMIC_ACQUIRE, "agent");
      asm volatile("s_waitcnt vmcnt(0)" ::: "memory");
    }
  }
  __syncthreads();
}

#ifndef ENMASK
#define ENMASK 0xffff
#endif
#define EN(i) ((ENMASK >> (i)) & 1)
enum { OP_PRO = 0, OP_LN0, OP_LN1, OP_LNF, OP_FFI, OP_FFO, OP_UP, OP_M0, OP_GAT, OP_S, OP_M2, OP_FIN, OP_DN, OP_AQ, OP_APREP, OP_ACORE, OP_AO, OP_SI, OP_SCONV, OP_SO };
__global__ void __launch_bounds__(512) fwd_megakernel(Params p) {
  cg::grid_group grid = cg::this_grid();
  const int wave_s = __builtin_amdgcn_readfirstlane((int)threadIdx.x >> 6);
  volatile LAS unsigned* xst = (volatile LAS unsigned*)((LAS unsigned char*)lds_raw + (LDS_BYTES - 16));
  if (threadIdx.x == 0) { xst[0] = 0u; xst[1] = 0u; }
  __syncthreads();
  unsigned* xbar = (unsigned*)(p.ws + O_BAR);
  const unsigned xcc = xb_xcc_id();
  if (threadIdx.x == 0) (void)xb_add(&xbar[XB_XCNT(xcc)], 1u);
#ifdef DUP_OP
  int rep = 0;
#endif
  for (int ph = 0; ph < p.nph; ++ph) {
    const unsigned w = p.prog[ph];
    const int op = w & 255, a = (w >> 8) & 255, b = (w >> 16) & 255, c = (w >> 24) & 255;
#define MKCTX int z; asm volatile("s_mov_b32 %0, 0" : "=s"(z)); \
    GAS char* wsq = (GAS char*)p.ws; GAS float* outq = (GAS float*)p.out; int bidq = (int)blockIdx.x, nbq = (int)gridDim.x; \
    asm volatile("" : "+s"(wsq), "+s"(outq), "+s"(bidq), "+s"(nbq)); \
    const Ctx cx{wave_s * 64 + (int)__builtin_amdgcn_mbcnt_hi(~0u, __builtin_amdgcn_mbcnt_lo(~0u, (unsigned)z)), bidq, nbq, z, (char*)wsq, (float*)outq};
    if (EN(0) && op == OP_PRO) { MKCTX prologue(p, cx); }
    else if (EN(1) && op == OP_LN0) { MKCTX lnmod_phase<0>(p, cx, 0, 0, 0); }
    else if (EN(1) && op == OP_LN1) { MKCTX lnmod_phase<1>(p, cx, a, b, c); }
    else if (EN(1) && op == OP_LNF) { MKCTX lnmod_phase<2>(p, cx, a, 0, 0); }
    else if (EN(2) && op == OP_M0) { MKCTX ml_m0(p, cx, a); }
    else if (EN(3) && op == OP_GAT) { MKCTX ml_gates(p, cx, a); }
    else if (EN(4) && op == OP_S) { MKCTX ml_s(p, cx); }
    else if (EN(5) && op == OP_M2) { MKCTX ml_m2(p, cx); }
    else if (EN(6) && op == OP_FIN) { MKCTX ml_fin(p, cx, a); }
    else if (EN(7) && op == OP_APREP) { MKCTX at_prep(p, cx); }
    else if (EN(8) && op == OP_ACORE) { MKCTX at_core(p, cx); }
    else if (EN(9) && op == OP_SCONV) { MKCTX sc_conv(p, cx); }
    else if (EN(10)) {
      MKCTX
      char* ws = cx.ws;
      const RowMap idm{0, 0, 1 << 30};
      bf16_t* U = (bf16_t*)(ws + O_U); bf16_t* ACT = (bf16_t*)(ws + O_ACT);
      const float* MODT = (const float*)(ws + O_MODT);
      const bf16_t* A = U; const bf16_t* Bt; int K = 1024, nM = MROWS / 256, nN; RowMap am = idm, cm = idm;
      Epi E; E.kind = 2; E.O = ACT; E.ldc = 0; E.modl = MODT + (size_t)b * 9 * 9216; E.slot = 1; E.wgt = 1.0f;
      if (op == OP_FFI) { Bt = (const bf16_t*)(ws + O_WFI) + (size_t)a * 5632 * 1024; nN = 22; E.kind = 1; if (c) nM = NLAT / 256; }
      else if (op == OP_FFO) { A = ACT; Bt = (const bf16_t*)(ws + O_WFO) + (size_t)a * 1024 * 2816; K = 2816; nN = 4; E.slot = c & 3; E.wgt = 0.5f; if (c & 4) nM = NLAT / 256; }
      else if (op == OP_UP) { Bt = (const bf16_t*)(ws + O_WUP) + (size_t)a * 4096 * 1024; nM = RG / 256; nN = 16; am = RowMap{c * GB * SEQ, NLAT + c * GB * LC, GB * SEQ / 256}; E.kind = 0; E.O = (bf16_t*)(ws + O_XZ); E.ldc = 4096; }
      else if (op == OP_DN) { A = (const bf16_t*)(ws + O_FIN); Bt = (const bf16_t*)(ws + O_WDN) + (size_t)a * 1024 * 2048; K = 2048; nM = RG / 256; nN = 4; cm = RowMap{c * GB * SEQ, NLAT + c * GB * LC, GB * SEQ / 256}; }
      else if (op == OP_AQ) { Bt = (const bf16_t*)(ws + O_WAQ); nN = 6; E.kind = 0; E.ldc = 1536; }
      else if (op == OP_AO) { Bt = (const bf16_t*)(ws + O_WAO); nN = 4; }
      else if (op == OP_SI) { Bt = (const bf16_t*)(ws + O_WSI); nN = 12; E.kind = 0; E.ldc = 3072; }
      else { Bt = (const bf16_t*)(ws + O_WSO); nN = 4; }
      gemm_phase(cx, A, am, Bt, K, nM, nN, cm, E);
    }
    if (ph == 0) grid.sync(); else xcd_barrier(xbar, xcc, xst);
#ifdef DUP_OP
    if (op == DUP_OP && rep + 1 < DUP_N) { ++rep; --ph; } else rep = 0;
#endif
  }
}

static int build_program(unsigned* prog) {
  int n = 0;
  auto W = [&](int op, int a, int b, int c) { prog[n++] = (unsigned)op | ((unsigned)a << 8) | ((unsigned)b << 16) | ((unsigned)c << 24); };
  W(OP_PRO, 0, 0, 0);
  W(OP_LN0, 0, 0, 0);
  for (int layer = 0; layer < DEPTH; ++layer) {
    const int kind = layer % 3, j = layer / 3;
    W(OP_FFI, layer * 2, layer, 0); W(OP_FFO, layer * 2, layer, 0);
    W(OP_LN1, layer * 3 + 0, layer, 1);
    if (kind == 0) {
      for (int g = 0; g < NG; ++g) { W(OP_UP, j, layer, g); W(OP_M0, j, 0, 0); W(OP_GAT, j, 0, 0); W(OP_S, 0, 0, 0); W(OP_M2, 0, 0, 0); W(OP_FIN, j, 0, 0); W(OP_DN, j, layer, g); }
    } else if (kind == 1) { W(OP_AQ, 0, layer, 0); W(OP_APREP, 0, 0, 0); W(OP_ACORE, 0, 0, 0); W(OP_AO, 0, layer, 0); }
    else { W(OP_SI, 0, layer, 0); W(OP_SCONV, 0, 0, 0); W(OP_SO, 0, layer, 0); }
    W(OP_LN1, layer * 3 + 1, layer, 2);
    const int lo = (layer + 1 == DEPTH) ? 1 : 0;
    W(OP_FFI, layer * 2 + 1, layer, lo); W(OP_FFO, layer * 2 + 1, layer, 2 | (lo << 2));
    if (layer + 1 < DEPTH) W(OP_LN1, layer * 3 + 2, layer + 1, 0); else W(OP_LNF, layer * 3 + 2, 0, 0);
  }
  return n;
}

extern "C" void kernel_launch(void* const* d_in, const int* in_sizes, int n_in, void* d_out, int out_size, void* d_ws, size_t ws_size, hipStream_t stream) {
  static int grid_blocks = 0;
  if (!grid_blocks) {
    int dev = 0, cus = 0, per_cu = 0;
    (void)hipGetDevice(&dev);
    (void)hipDeviceGetAttribute(&cus, hipDeviceAttributeMultiprocessorCount, dev);
    (void)hipFuncSetAttribute((const void*)fwd_megakernel, hipFuncAttributeMaxDynamicSharedMemorySize, LDS_BYTES);
    (void)hipOccupancyMaxActiveBlocksPerMultiprocessor(&per_cu, fwd_megakernel, 512, LDS_BYTES);
    if (cus <= 0) cus = 256;
    grid_blocks = cus;
    if (ws_size < WS_END || n_in != 25) fprintf(stderr, "kernel_launch: workspace %zu < %zu or n_in %d != 25\n", ws_size, (size_t)WS_END, n_in);
    if (per_cu < 1) fprintf(stderr, "kernel_launch: occupancy query says %d blocks per CU\n", per_cu);
  }
  Params p{};
  for (int i = 0; i < 25; ++i) p.in[i] = (const float*)d_in[i];
  p.out = (float*)d_out; p.ws = (char*)d_ws;
  p.nph = build_program(p.prog);
  (void)hipMemsetAsync((char*)d_ws + O_BAR, 0, XCD_BAR_WORDS * 4, stream);
  void* args[] = {&p};
  hipError_t e = hipLaunchCooperativeKernel((void*)fwd_megakernel, dim3(grid_blocks), dim3(512), args, LDS_BYTES, stream);
  if (e != hipSuccess) fprintf(stderr, "cooperative launch failed: %s (grid %d)\n", hipGetErrorString(e), grid_blocks);
}
```

```cpp
#include <hip/hip_runtime.h>
#include <hip/hip_cooperative_groups.h>
#include <cstdio>
#include <cstdint>
namespace cg = cooperative_groups;

typedef unsigned short bf16_t;
typedef short bf16x8 __attribute__((ext_vector_type(8)));
typedef short bf16x4 __attribute__((ext_vector_type(4)));
typedef float f32x4 __attribute__((ext_vector_type(4)));
typedef unsigned u32x2 __attribute__((ext_vector_type(2)));
typedef unsigned u32x4 __attribute__((ext_vector_type(4)));

constexpr int D = 1024, NB = 8, SEQ = 4096, LC = 256, DEPTH = 4, FF = 2816, EI = 2048, DH = 512;
constexpr int NLAT = NB * SEQ, NCTX = NB * LC, MROWS = NLAT + NCTX;
constexpr int TOKB = LC + SEQ;
constexpr int NCH = TOKB / 64;
constexpr int GB = 2, NG = NB / GB, RG = GB * TOKB;
constexpr int NSEQ = GB * 8;
constexpr float ALPHA = 1.681792830507429f, LN_EPS = 1e-5f;
constexpr int LDS_BYTES = 144 * 1024;

constexpr size_t al256(size_t x) { return (x + 255) & ~(size_t)255; }
constexpr size_t O_WFI = 0;
constexpr size_t O_WFO = O_WFI + (size_t)8 * 5632 * 1024 * 2;
constexpr size_t O_WUP = O_WFO + (size_t)8 * 1024 * 2816 * 2;
constexpr size_t O_WDN = O_WUP + (size_t)2 * 4096 * 1024 * 2;
constexpr size_t O_WAQ = O_WDN + (size_t)2 * 1024 * 2048 * 2;
constexpr size_t O_WAO = O_WAQ + (size_t)1536 * 1024 * 2;
constexpr size_t O_WSI = O_WAO + (size_t)1024 * 1024 * 2;
constexpr size_t O_WSO = O_WSI + (size_t)3072 * 1024 * 2;
constexpr size_t O_WG = O_WSO + (size_t)1024 * 1024 * 2;
constexpr size_t O_MODT = O_WG + (size_t)2 * 16 * 6144 * 2;
constexpr size_t O_ROPE = O_MODT + (size_t)4 * 9 * 9216 * 4;
constexpr size_t O_HCTX = O_ROPE + (size_t)2 * 4096 * 32 * 4;
constexpr size_t O_U = O_HCTX + (size_t)NCTX * D * 4;
constexpr size_t O_R = O_U + (size_t)MROWS * D * 2;
constexpr size_t O_XZ = O_R;
constexpr size_t O_QK = O_XZ + (size_t)RG * 4096 * 2;
constexpr size_t O_KT = O_QK + (size_t)RG * 4096 * 2;
constexpr size_t O_VT = O_KT + (size_t)GB * EI * TOKB * 2;
constexpr size_t O_SP = O_VT + (size_t)GB * EI * TOKB * 2;
constexpr size_t O_HD = O_SP + (size_t)NSEQ * NCH * 4096 * 2;
constexpr size_t O_FIN = O_HD + (size_t)2 * RG * EI * 2;
constexpr size_t O_GAT = O_FIN + (size_t)RG * EI * 2;
constexpr size_t SZ_ST = (size_t)NSEQ * TOKB * 4;
constexpr size_t O_BL = O_GAT, O_IG = O_BL + SZ_ST, O_WIN = O_IG + SZ_ST, O_FLO = O_WIN + SZ_ST, O_DEN = O_FLO + SZ_ST, O_WSS = O_DEN + SZ_ST;
constexpr size_t O_GC = O_WSS + SZ_ST;
constexpr size_t O_REND_ML = O_GC + (size_t)3 * NSEQ * NCH * 4 + 256;
constexpr size_t O_ACT = O_R;
constexpr size_t O_AKR = O_R + (size_t)MROWS * 3072 * 2;
constexpr size_t O_AVT = O_AKR + (size_t)NB * 4 * TOKB * 64 * 2;
constexpr size_t O_REND_AT = O_AVT + (size_t)NB * 4 * TOKB * 64 * 2;
constexpr size_t O_BAR = (O_REND_ML > O_REND_AT ? O_REND_ML : O_REND_AT);
constexpr size_t WS_END = O_BAR + 3456 * 4 + 256;

struct Params {
  const float* in[25];
  float* out;
  char* ws;
  int nph; int pad0;
  unsigned prog[126];
};

#define GAS __attribute__((address_space(1)))
#define IN(k) ((const float*)(const GAS float*)p.in[(k) + cx.z])
struct Ctx { int tid, bid, nb, z; char* ws; float* out; };
extern __shared__ __attribute__((aligned(16))) char lds_raw[];

__device__ __forceinline__ unsigned pk2(float lo, float hi) { unsigned r; asm volatile("v_cvt_pk_bf16_f32 %0, %1, %2" : "=v"(r) : "v"(lo), "v"(hi)); return r; }
__device__ __forceinline__ float bf2f(unsigned short v) { return __uint_as_float(((unsigned)v) << 16); }
__device__ __forceinline__ float bflo(unsigned v) { return __uint_as_float(v << 16); }
__device__ __forceinline__ float bfhi(unsigned v) { return __uint_as_float(v & 0xffff0000u); }
__device__ __forceinline__ float silu_f(float x) { return x * __builtin_amdgcn_rcpf(1.f + __expf(-x)); }
__device__ __forceinline__ float sigm_f(float x) { return __builtin_amdgcn_rcpf(1.f + __expf(-x)); }
__device__ __forceinline__ float shi(float v, int srclane) { return __int_as_float(__builtin_amdgcn_ds_bpermute(srclane << 2, __float_as_int(v))); }
__device__ __forceinline__ float shx(float v, int m, int lane) { return shi(v, lane ^ m); }
__device__ __forceinline__ float wave_sum(float v, int lane) {
#pragma unroll
  for (int o = 1; o < 64; o <<= 1) v += shx(v, o, lane);
  return v;
}
__device__ __forceinline__ bf16x8 mk8(u32x4 v) { union { u32x4 u; bf16x8 b; } x; x.u = v; return x.b; }
__device__ __forceinline__ bf16x8 mk8(u32x2 a, u32x2 b) { union { u32x4 u; bf16x8 b; } x; x.u = (u32x4){a.x, a.y, b.x, b.y}; return x.b; }
__device__ __forceinline__ float* hrow(const Ctx& cx, int row) { return row < NLAT ? cx.out + (size_t)row * D : (float*)(cx.ws + O_HCTX) + (size_t)(row - NLAT) * D; }
#define MFMA16(a, b, c) __builtin_amdgcn_mfma_f32_16x16x32_bf16(a, b, c, 0, 0, 0)

constexpr int BM = 256, BK = 64, HALF = 128, HT = HALF * BK, NXCD = 8, WGM = 8;
__device__ __forceinline__ int lds_byte(int r, int c) {
  int st = (r >> 4) * 2 + (c >> 5), rr = r & 15, cc = c & 31, ob = rr * 64 + cc * 2;
  return st * 1024 + (ob ^ (((ob >> 9) & 1) << 5));
}
__device__ __forceinline__ void stage_rc(int b, int& R, int& C) {
  int st = b / 1024, sb = b % 1024, swz = sb ^ (((sb >> 9) & 1) << 5);
  R = (st >> 1) * 16 + swz / 64; C = (st & 1) * 32 + (swz % 64) / 2;
}
struct RowMap { int lat0, ctx0, nlat; __device__ __forceinline__ int row0(int pm) const { return pm < nlat ? lat0 + pm * 256 : ctx0 + (pm - nlat) * 256; } };

typedef f32x4 Acc[2][2][4][2];

struct Epi {
  int kind; bf16_t* O; int ldc; const float* modl; int slot; float wgt;
};
__device__ __forceinline__ void run_epi(const Ctx& cx, const Epi& E, const Acc& acc, int r0, int pn, int wr, int wc, int fr, int fq) {
  if (E.kind == 0) {
#pragma unroll
    for (int ai = 0; ai < 2; ++ai)
#pragma unroll
      for (int m = 0; m < 4; ++m) {
        bf16_t* rp = E.O + (size_t)(r0 + ai * HALF + wr * 64 + m * 16 + fr) * E.ldc + pn * 256 + wc * 32 + 4 * fq;
#pragma unroll
        for (int bj = 0; bj < 2; ++bj)
#pragma unroll
          for (int n = 0; n < 2; ++n) {
            f32x4 v = acc[ai][bj][m][n];
            u32x2 o; o.x = pk2(v[0], v[1]); o.y = pk2(v[2], v[3]);
            *(u32x2*)(rp + bj * HALF + n * 16) = o;
          }
      }
  } else if (E.kind == 1) {
#pragma unroll
    for (int ai = 0; ai < 2; ++ai)
#pragma unroll
      for (int m = 0; m < 4; ++m) {
        bf16_t* rp = E.O + (size_t)(r0 + ai * HALF + wr * 64 + m * 16 + fr) * FF + pn * 128 + wc * 16 + 4 * fq;
#pragma unroll
        for (int bj = 0; bj < 2; ++bj) {
          f32x4 g = acc[ai][bj][m][0], v = acc[ai][bj][m][1];
          u32x2 o; o.x = pk2(silu_f(g[0]) * v[0], silu_f(g[1]) * v[1]); o.y = pk2(silu_f(g[2]) * v[2], silu_f(g[3]) * v[3]);
          *(u32x2*)(rp + bj * 64) = o;
        }
      }
  } else {
    const int midx = r0 < NLAT ? (r0 >> 12) : 8;
    const float* gp = E.modl + (size_t)midx * 9216 + (3 * E.slot + 2) * D + pn * 256 + wc * 32 + 4 * fq;
    f32x4 gv[2][2];
#pragma unroll
    for (int bj = 0; bj < 2; ++bj)
#pragma unroll
      for (int n = 0; n < 2; ++n) gv[bj][n] = *(const f32x4*)(gp + bj * HALF + n * 16) * E.wgt;
#pragma unroll
    for (int ai = 0; ai < 2; ++ai)
#pragma unroll
      for (int m = 0; m < 4; ++m) {
        float* rp = hrow(cx, r0 + ai * HALF + wr * 64 + m * 16 + fr) + pn * 256 + wc * 32 + 4 * fq;
        f32x4 h[2][2];
#pragma unroll
        for (int bj = 0; bj < 2; ++bj)
#pragma unroll
          for (int n = 0; n < 2; ++n) h[bj][n] = *(const f32x4*)(rp + bj * HALF + n * 16);
#pragma unroll
        for (int bj = 0; bj < 2; ++bj)
#pragma unroll
          for (int n = 0; n < 2; ++n) *(f32x4*)(rp + bj * HALF + n * 16) = h[bj][n] * ALPHA + gv[bj][n] * acc[ai][bj][m][n];
        __builtin_amdgcn_sched_barrier(0);
      }
  }
}

#define LAS __attribute__((address_space(3)))
__device__ __forceinline__ void gemm_phase(const Ctx& cx, const bf16_t* __restrict__ A, RowMap am, const bf16_t* __restrict__ Bt, int K, int nM, int nN, RowMap cm, const Epi& epi) {
  LAS unsigned char* lds = (LAS unsigned char*)lds_raw;
  constexpr int HTB = HT * 2;
  const int tid = cx.tid, wid = tid >> 6, lane = tid & 63, wr = wid >> 2, wc = wid & 3, fr = lane & 15, fq = lane >> 4;
  unsigned voff[2];
#pragma unroll
  for (int i = 0; i < 2; ++i) { int R, C; stage_rc(tid * 16 + i * 8192, R, C); voff[i] = (unsigned)(R * K + C) * 2u; }
  const size_t kstep = (size_t)(BK * 2), hstep = (size_t)HALF * K * 2;
  const unsigned ldsw = (unsigned)wid * 1024u;
  const int aoff = lds_byte(wr * 64 + fr, fq * 8), boff = lds_byte(wc * 32 + fr, fq * 8);
#define G_SA(b, h) (((b) * 2 + (h)) * HTB)
#define G_SB(b, h) ((4 + (b) * 2 + (h)) * HTB)
#define STAGE(bufoff, gbase) do { _Pragma("unroll") for (int _i = 0; _i < 2; ++_i) \
    __builtin_amdgcn_global_load_lds((const unsigned*)((const char*)(gbase) + voff[_i]), (LAS unsigned*)(lds + (bufoff) + ldsw + _i * 8192), 16, 0, 0); } while (0)
#define LDA(dst, b, h) do { _Pragma("unroll") for (int m = 0; m < 4; ++m) _Pragma("unroll") for (int k = 0; k < 2; ++k) dst[m][k] = *(const LAS bf16x8*)(lds + G_SA(b, h) + aoff + m * 2048 + k * 1024); } while (0)
#define LDB(dst, b, h) do { _Pragma("unroll") for (int n = 0; n < 2; ++n) _Pragma("unroll") for (int k = 0; k < 2; ++k) dst[n][k] = *(const LAS bf16x8*)(lds + G_SB(b, h) + boff + n * 2048 + k * 1024); } while (0)
#define MMA(ai, bj, At, Bt_) do { __builtin_amdgcn_s_setprio(1); _Pragma("unroll") for (int m = 0; m < 4; ++m) _Pragma("unroll") for (int n = 0; n < 2; ++n) _Pragma("unroll") for (int k = 0; k < 2; ++k) \
      acc[ai][bj][m][n] = MFMA16(Bt_[n][k], At[m][k], acc[ai][bj][m][n]); \
    __builtin_amdgcn_s_setprio(0); } while (0)
#define WAIT_V(n) asm volatile("s_waitcnt vmcnt(" #n ")" ::: "memory")
#define WAIT_L(n) asm volatile("s_waitcnt lgkmcnt(" #n ")" ::: "memory")
#define BAR __builtin_amdgcn_s_barrier()
#define SCHED __builtin_amdgcn_sched_barrier(0)
  const int nwg = nM * nN;
  const int nt = K / BK;
  const int wid_s = __builtin_amdgcn_readfirstlane(wid);
#define DECODE(L_, pm_, pn_) do { int wgid = (L_); \
    { int q = nwg / NXCD, r = nwg % NXCD, xcd = wgid % NXCD, off = wgid / NXCD; wgid = (xcd < r ? xcd * (q + 1) : r * (q + 1) + (xcd - r) * q) + off; } \
    const int nig = WGM * nN, gid = wgid / nig, fm = gid * WGM, gsz = min(nM - fm, WGM); \
    pm_ = fm + ((wgid % nig) % gsz); pn_ = (wgid % nig) / gsz; } while (0)
  int L = cx.bid;
  if (L < nwg) {
    int pm, pn;
    DECODE(L, pm, pn);
    const char* cA = (const char*)A + (size_t)am.row0(pm) * K * 2; const char* cB = (const char*)Bt + (size_t)pn * BM * K * 2;
    Acc acc;
#pragma unroll
    for (int a = 0; a < 2; ++a)
#pragma unroll
      for (int b = 0; b < 2; ++b)
#pragma unroll
        for (int m = 0; m < 4; ++m)
#pragma unroll
          for (int n = 0; n < 2; ++n) acc[a][b][m][n] = (f32x4){0.f, 0.f, 0.f, 0.f};
    bf16x8 At[4][2], B0[2][2], B1[2][2];
    STAGE(G_SB(0, 0), cB); STAGE(G_SA(0, 0), cA); STAGE(G_SB(0, 1), cB + hstep); STAGE(G_SA(0, 1), cA + hstep);
    if (wr == 1) BAR;
    WAIT_V(4); BAR;
    STAGE(G_SB(1, 0), cB + kstep); STAGE(G_SA(1, 0), cA + kstep); STAGE(G_SB(1, 1), cB + hstep + kstep);
    WAIT_V(6); BAR;
    for (;;) {
      const int Ln = L + cx.nb;
      const bool has_next = Ln < nwg;
      int pmn = pm, pnn = pn;
      if (has_next) DECODE(Ln, pmn, pnn);
      const char* nA = has_next ? (const char*)A + (size_t)am.row0(pmn) * K * 2 : cA; const char* nB = has_next ? (const char*)Bt + (size_t)pnn * BM * K * 2 : cB;
      for (int t = 0; t < nt; t += 2) {
        const bool last = (t == nt - 2);
        const char* a1 = cA + (size_t)(t + 1) * kstep;
        const char* a2 = last ? nA : cA + (size_t)(t + 2) * kstep; const char* b2 = last ? nB : cB + (size_t)(t + 2) * kstep;
        const char* a3 = a2 + kstep; const char* b3 = b2 + kstep;
        LDB(B0, 0, 0); SCHED; LDA(At, 0, 0); STAGE(G_SA(1, 1), a1 + hstep);
        WAIT_L(8); BAR; WAIT_L(0); MMA(0, 0, At, B0); BAR; SCHED;
        LDB(B1, 0, 1); STAGE(G_SB(0, 0), b2);
        BAR; WAIT_L(0); MMA(0, 1, At, B1); BAR;
        LDA(At, 0, 1); STAGE(G_SA(0, 0), a2);
        BAR; WAIT_L(0); MMA(1, 0, At, B0); BAR; SCHED;
        STAGE(G_SB(0, 1), b2 + hstep);
        WAIT_V(6); BAR; MMA(1, 1, At, B1); BAR;
        LDB(B0, 1, 0); SCHED; LDA(At, 1, 0); STAGE(G_SA(0, 1), a2 + hstep);
        WAIT_L(8); BAR; WAIT_L(0); MMA(0, 0, At, B0); BAR; SCHED;
        LDB(B1, 1, 1); STAGE(G_SB(1, 0), b3);
        BAR; WAIT_L(0); MMA(0, 1, At, B1); BAR;
        LDA(At, 1, 1); STAGE(G_SA(1, 0), a3);
        BAR; WAIT_L(0); MMA(1, 0, At, B0); BAR; SCHED;
        STAGE(G_SB(1, 1), b3 + hstep);
        WAIT_V(6); BAR; MMA(1, 1, At, B1); BAR;
      }
      { int t2 = wid_s * 64 + (int)__builtin_amdgcn_mbcnt_hi(~0u, __builtin_amdgcn_mbcnt_lo(~0u, (unsigned)cx.z)); asm volatile("" : "+v"(t2));
        const int w2 = t2 >> 6, l2 = t2 & 63;
        run_epi(cx, epi, acc, cm.row0(pm), pn, w2 >> 2, w2 & 3, l2 & 15, l2 >> 4); }
      if (!has_next) break;
#pragma unroll
      for (int a = 0; a < 2; ++a)
#pragma unroll
        for (int b = 0; b < 2; ++b)
#pragma unroll
          for (int m = 0; m < 4; ++m)
#pragma unroll
            for (int n = 0; n < 2; ++n) acc[a][b][m][n] = (f32x4){0.f, 0.f, 0.f, 0.f};
      pm = pmn; pn = pnn; cA = nA; cB = nB; L = Ln;
    }
    WAIT_V(0);
    if (wr == 0) BAR;
    BAR;
  }
  __syncthreads();
}

template <int MODE>
__device__ __forceinline__ int wrow(int c) {
  if (MODE == 0) return c;
  const int isv = c >= FF ? 1 : 0, f = c - isv * FF;
  return (f >> 7) * 256 + ((f >> 6) & 1) * 128 + ((f >> 4) & 3) * 32 + isv * 16 + (f & 15);
}
template <int MODE>
__device__ __forceinline__ void transpose_item(const float* __restrict__ W, int K, int N, bf16_t* __restrict__ WT, float* scr, int item, int lane) {
  const int nblk = N / 32, kb = item / nblk, nb = item % nblk, k0 = 64 * kb, n0 = 32 * nb;
#pragma unroll 8
  for (int i = 0; i < 32; ++i) { const int kk = 2 * i + (lane >> 5); scr[kk * 33 + (lane & 31)] = W[(size_t)(k0 + kk) * N + n0 + (lane & 31)]; }
  __builtin_amdgcn_wave_barrier(); asm volatile("s_waitcnt lgkmcnt(0)" ::: "memory");
  const int c = lane & 7;
#pragma unroll
  for (int j = 0; j < 4; ++j) {
    const int n = (lane >> 3) + 8 * j; const float* s = scr + (8 * c) * 33 + n;
    u32x4 o; o.x = pk2(s[0 * 33], s[1 * 33]); o.y = pk2(s[2 * 33], s[3 * 33]); o.z = pk2(s[4 * 33], s[5 * 33]); o.w = pk2(s[6 * 33], s[7 * 33]);
    *(u32x4*)(WT + (size_t)wrow<MODE>(n0 + n) * K + k0 + 8 * c) = o;
  }
  asm volatile("s_waitcnt lgkmcnt(0)" ::: "memory"); __builtin_amdgcn_wave_barrier();
}

__device__ __forceinline__ void prologue(const Params& p, const Ctx& cx) {
  const int tid = cx.tid, lane = tid & 63, wave = tid >> 6;
  char* ws = cx.ws;
  {
    float* cond = (float*)lds_raw;
    float* red = (float*)(lds_raw + 9 * 1024 * 4);
    for (int i = tid; i < 9 * 1024; i += 512) { const int j = i >> 10, k = i & 1023; cond[i] = silu_f(j < 8 ? IN(1)[j * 1024 + k] : IN(3)[k]); }
    __syncthreads();
    for (int u = cx.bid; u < 4 * 36; u += cx.nb) {
      const int layer = u / 36, ct = u % 36, c0 = ct * 256 + 4 * lane;
      const float* wp = IN(4) + (size_t)layer * D * 9216 + c0;
      f32x4 a[9];
#pragma unroll
      for (int j = 0; j < 9; ++j) a[j] = (f32x4){0.f, 0.f, 0.f, 0.f};
#pragma unroll 4
      for (int k = wave * 128; k < wave * 128 + 128; ++k) {
        const f32x4 w = *(const f32x4*)(wp + (size_t)k * 9216);
#pragma unroll
        for (int j = 0; j < 9; ++j) a[j] += w * cond[j * 1024 + k];
      }
#pragma unroll
      for (int j = 0; j < 9; ++j) *(f32x4*)(red + (wave * 9 + j) * 256 + 4 * lane) = a[j];
      __syncthreads();
      float* mt = (float*)(ws + O_MODT) + (size_t)layer * 9 * 9216;
      for (int i = tid; i < 9 * 256; i += 512) {
        const int j = i >> 8, c = i & 255; float s = 0.f;
#pragma unroll
        for (int w = 0; w < 8; ++w) s += red[(w * 9 + j) * 256 + c];
        mt[(size_t)j * 9216 + ct * 256 + c] = s + IN(5)[layer * 9216 + ct * 256 + c];
      }
      __syncthreads();
    }
    __syncthreads();
  }
  {
    float* scr = (float*)lds_raw + wave * (64 * 33);
    const int gw = cx.bid * 8 + wave, NGW = cx.nb * 8;
    constexpr int I_FI = 16 * 176, I_FO = 44 * 32, I_UP = 16 * 128, I_DN = 32 * 32, I_AQ = 16 * 48, I_AO = 16 * 32, I_SI = 16 * 96, I_SO = 16 * 32;
    constexpr int NITEMS = 8 * I_FI + 8 * I_FO + 2 * I_UP + 2 * I_DN + I_AQ + I_AO + I_SI + I_SO;
    for (int it = gw; it < NITEMS; it += NGW) {
      int r = it;
      if (r < 8 * I_FI) { const int mi = r / I_FI; transpose_item<1>(IN(8) + (size_t)mi * 1024 * 5632, 1024, 5632, (bf16_t*)(ws + O_WFI) + (size_t)mi * 5632 * 1024, scr, r % I_FI, lane); continue; } r -= 8 * I_FI;
      if (r < 8 * I_FO) { const int mi = r / I_FO; transpose_item<0>(IN(9) + (size_t)mi * 2816 * 1024, 2816, 1024, (bf16_t*)(ws + O_WFO) + (size_t)mi * 1024 * 2816, scr, r % I_FO, lane); continue; } r -= 8 * I_FO;
      if (r < 2 * I_UP) { const int mi = r / I_UP; transpose_item<0>(IN(10) + (size_t)mi * 1024 * 4096, 1024, 4096, (bf16_t*)(ws + O_WUP) + (size_t)mi * 4096 * 1024, scr, r % I_UP, lane); continue; } r -= 2 * I_UP;
      if (r < 2 * I_DN) { const int mi = r / I_DN; transpose_item<0>(IN(18) + (size_t)mi * 2048 * 1024, 2048, 1024, (bf16_t*)(ws + O_WDN) + (size_t)mi * 1024 * 2048, scr, r % I_DN, lane); continue; } r -= 2 * I_DN;
      if (r < I_AQ) { transpose_item<0>(IN(19), 1024, 1536, (bf16_t*)(ws + O_WAQ), scr, r, lane); continue; } r -= I_AQ;
      if (r < I_AO) { transpose_item<0>(IN(21), 1024, 1024, (bf16_t*)(ws + O_WAO), scr, r, lane); continue; } r -= I_AO;
      if (r < I_SI) { transpose_item<0>(IN(22), 1024, 3072, (bf16_t*)(ws + O_WSI), scr, r, lane); continue; } r -= I_SI;
      transpose_item<0>(IN(24), 1024, 1024, (bf16_t*)(ws + O_WSO), scr, r, lane);
    }
  }
  {
    const int gt = cx.bid * 512 + tid, gs = cx.nb * 512;
    bf16_t* wg = (bf16_t*)(ws + O_WG);
    for (int i = gt; i < 2 * 16 * 6144; i += gs) {
      const int j = i / (16 * 6144), xg = (i / 6144) & 15, k = i % 6144, x = xg >> 3, g = xg & 7;
      const float* wif = IN(14) + (size_t)(j * 2 + x) * 6144 * 8;
      float v;
      if (k < 2048) v = wif[(size_t)k * 8 + g];
      else if (k < 4096) v = wif[(size_t)k * 8 + g] * 22.627416997969522f;
      else {
        const int c = k - 4096, blk = c >> 2, cc = c & 3;
        const float* wv = IN(13) + ((size_t)(j * 3 + 2) * 512 + blk) * 16 + cc * 4;
        v = 0.f;
        for (int d2 = 0; d2 < 4; ++d2) v += wv[d2] * wif[(size_t)(4096 + 4 * blk + d2) * 8 + g];
      }
      wg[i] = (bf16_t)(pk2(v, 0.f) & 0xffff);
    }
    float* rc = (float*)(ws + O_ROPE); float* rs = rc + 4096 * 32;
    for (int i = gt; i < 4096 * 32; i += gs) {
      const int pos = i >> 5, pp = i & 31, jf = pp & 15;
      const float fr_ = __builtin_amdgcn_exp2f(-(float)jf * (13.287712379549449f / 16.f));
      float rev = (float)(pp < 16 ? (pos >> 6) : (pos & 63)) * fr_ * 0.15915494309189535f;
      rev -= rintf(rev);
      rc[i] = __builtin_amdgcn_cosf(rev); rs[i] = __builtin_amdgcn_sinf(rev);
    }
  }
}

template <int MODE>
__device__ __forceinline__ void lnmod_phase(const Params& p, const Ctx& cx, int lnidx  , int layer, int slot) {
  const int lane = cx.tid & 63, gw = cx.bid * 8 + (cx.tid >> 6), NGW = cx.nb * 8;
  const int nrows = MODE == 2 ? NLAT : MROWS;
  const float* lg = IN(6) + (size_t)lnidx * D; const float* lb = IN(7) + (size_t)lnidx * D;
  const float* modl = (const float*)(cx.ws + O_MODT) + (size_t)layer * 9 * 9216;
  bf16_t* U = (bf16_t*)(cx.ws + O_U);
  for (int row = gw; row < nrows; row += NGW) {
    float* hp = hrow(cx, row);
    const float* src = MODE == 0 ? (row < NLAT ? IN(0) + (size_t)row * D : IN(2) + (size_t)(row - NLAT) * D) : hp;
    f32x4 v[4];
#pragma unroll
    for (int j = 0; j < 4; ++j) v[j] = *(const f32x4*)(src + 4 * lane + 256 * j);
    if (MODE != 0) {
      float s = 0.f;
#pragma unroll
      for (int j = 0; j < 4; ++j) s += (v[j][0] + v[j][1]) + (v[j][2] + v[j][3]);
      const float mean = wave_sum(s, lane) * (1.f / D); float s2 = 0.f;
#pragma unroll
      for (int j = 0; j < 4; ++j) { v[j] = v[j] - mean; s2 += (v[j][0] * v[j][0] + v[j][1] * v[j][1]) + (v[j][2] * v[j][2] + v[j][3] * v[j][3]); }
      const float rstd = __builtin_amdgcn_rsqf(wave_sum(s2, lane) * (1.f / D) + LN_EPS);
#pragma unroll
      for (int j = 0; j < 4; ++j) v[j] = v[j] * rstd * *(const f32x4*)(lg + 4 * lane + 256 * j) + *(const f32x4*)(lb + 4 * lane + 256 * j);
    }
#pragma unroll
    for (int j = 0; j < 4; ++j) *(f32x4*)(hp + 4 * lane + 256 * j) = v[j];
    if (MODE != 2) {
      const int midx = row < NLAT ? (row >> 12) : 8;
      const float* sh = modl + (size_t)midx * 9216 + (3 * slot) * D; const float* sc = sh + D;
#pragma unroll
      for (int j = 0; j < 4; ++j) {
        const f32x4 u = v[j] * (*(const f32x4*)(sc + 4 * lane + 256 * j) + 1.f) + *(const f32x4*)(sh + 4 * lane + 256 * j);
        u32x2 o; o.x = pk2(u[0], u[1]); o.y = pk2(u[2], u[3]);
        *(u32x2*)(U + (size_t)row * D + 4 * lane + 256 * j) = o;
      }
    }
  }
}

__device__ __forceinline__ int ml_lrow(int bl, int tok) { return tok < LC ? GB * SEQ + bl * LC + tok : bl * SEQ + (tok - LC); }
__device__ __forceinline__ int ml_nchunk(int x, int st) { return x == 0 ? st : (st < 4 ? 3 - st : 71 - st); }

__device__ __forceinline__ void ml_m0(const Params& p, const Ctx& cx, int j) {
  const int tid = cx.tid;
  char* ws = cx.ws;
  const bf16_t* XZ = (const bf16_t*)(ws + O_XZ);
  bf16_t* QK = (bf16_t*)(ws + O_QK); bf16_t* KT = (bf16_t*)(ws + O_KT); bf16_t* VT = (bf16_t*)(ws + O_VT);
  bf16_t* lk = (bf16_t*)lds_raw;
  bf16_t* lv = lk + 256 * 72;
  const int blk_l = tid & 63, tq = tid >> 6;
  for (int u = cx.bid; u < GB * NCH * 8; u += cx.nb) {
    const int slab = u & 7, ch = (u >> 3) % NCH, bl = u / (8 * NCH);
    const int f0 = slab * 256 + blk_l * 4, blk = f0 >> 2;
    float cw[3][4], cb[4], wq[16], wk[16], wv[16];
#pragma unroll
    for (int k = 0; k < 3; ++k)
#pragma unroll
      for (int c = 0; c < 4; ++c) cw[k][c] = IN(11)[(size_t)(j * 3 + k) * EI + f0 + c];
#pragma unroll
    for (int c = 0; c < 4; ++c) cb[c] = IN(12)[(size_t)j * EI + f0 + c];
#pragma unroll
    for (int i = 0; i < 16; ++i) {
      wq[i] = IN(13)[((size_t)(j * 3 + 0) * 512 + blk) * 16 + i];
      wk[i] = IN(13)[((size_t)(j * 3 + 1) * 512 + blk) * 16 + i] * 0.04419417382415922f;
      wv[i] = IN(13)[((size_t)(j * 3 + 2) * 512 + blk) * 16 + i];
    }
    const int tok0 = ch * 64, seg_lo = tok0 < LC ? 0 : LC, seg_hi = tok0 < LC ? LC : TOKB;
    for (int tt = 0; tt < 8; ++tt) {
      const int tl = tq + 8 * tt, tok = tok0 + tl;
      float xm[3][4];
#pragma unroll
      for (int k = 0; k < 3; ++k) {
        const int t2 = tok + k - 1;
        if (t2 >= seg_lo && t2 < seg_hi) {
          const u32x2 r = *(const u32x2*)(XZ + (size_t)ml_lrow(bl, t2) * 4096 + f0);
          xm[k][0] = bflo(r.x); xm[k][1] = bfhi(r.x); xm[k][2] = bflo(r.y); xm[k][3] = bfhi(r.y);
        } else { xm[k][0] = xm[k][1] = xm[k][2] = xm[k][3] = 0.f; }
      }
      float xc[4], q[4], kk[4], vv[4];
#pragma unroll
      for (int c = 0; c < 4; ++c) xc[c] = silu_f(cw[0][c] * xm[0][c] + cw[1][c] * xm[1][c] + cw[2][c] * xm[2][c] + cb[c]);
#pragma unroll
      for (int d2 = 0; d2 < 4; ++d2) {
        q[d2] = xc[0] * wq[d2] + xc[1] * wq[4 + d2] + xc[2] * wq[8 + d2] + xc[3] * wq[12 + d2];
        kk[d2] = xc[0] * wk[d2] + xc[1] * wk[4 + d2] + xc[2] * wk[8 + d2] + xc[3] * wk[12 + d2];
        vv[d2] = xm[1][0] * wv[d2] + xm[1][1] * wv[4 + d2] + xm[1][2] * wv[8 + d2] + xm[1][3] * wv[12 + d2];
      }
      const size_t lr = ml_lrow(bl, tok);
      u32x2 oq, ok, ov; oq.x = pk2(q[0], q[1]); oq.y = pk2(q[2], q[3]); ok.x = pk2(kk[0], kk[1]); ok.y = pk2(kk[2], kk[3]); ov.x = pk2(vv[0], vv[1]); ov.y = pk2(vv[2], vv[3]);
      *(u32x2*)(QK + lr * 4096 + f0) = oq;
      *(u32x2*)(QK + lr * 4096 + 2048 + f0) = ok;
      const int fl = blk_l * 4;
      lk[(fl + 0) * 72 + tl] = (bf16_t)(ok.x & 0xffff); lk[(fl + 1) * 72 + tl] = (bf16_t)(ok.x >> 16); lk[(fl + 2) * 72 + tl] = (bf16_t)(ok.y & 0xffff); lk[(fl + 3) * 72 + tl] = (bf16_t)(ok.y >> 16);
      lv[(fl + 0) * 72 + tl] = (bf16_t)(ov.x & 0xffff); lv[(fl + 1) * 72 + tl] = (bf16_t)(ov.x >> 16); lv[(fl + 2) * 72 + tl] = (bf16_t)(ov.y & 0xffff); lv[(fl + 3) * 72 + tl] = (bf16_t)(ov.y >> 16);
    }
    __syncthreads();
    {
      const int arr = tid >> 8, fr_ = tid & 255;
      const bf16_t* src = (arr ? lv : lk) + fr_ * 72;
      bf16_t* dst = (arr ? VT : KT) + ((size_t)bl * EI + slab * 256 + fr_) * TOKB + tok0;
#pragma unroll
      for (int i = 0; i < 8; ++i) *(u32x4*)(dst + 8 * i) = *(const u32x4*)(src + 8 * i);
    }
    __syncthreads();
  }
}

__device__ __forceinline__ void ml_gates(const Params& p, const Ctx& cx, int j) {
  const int tid = cx.tid, lane = tid & 63, wave = tid >> 6, fr = lane & 15, fq = lane >> 4;
  char* ws = cx.ws;
  const bf16_t* XZ = (const bf16_t*)(ws + O_XZ); const bf16_t* QK = (const bf16_t*)(ws + O_QK);
  const bf16_t* WG = (const bf16_t*)(ws + O_WG) + (size_t)j * 16 * 6144;
  float* BL = (float*)(ws + O_BL); float* IG = (float*)(ws + O_IG);
  float* GC = (float*)(ws + O_GC); float* AC = GC + NSEQ * NCH;
  float* part = (float*)lds_raw;
  float* gl = part + 8 * 64 * 16;
  for (int u = cx.bid; u < GB * NCH; u += cx.nb) {
    const int bl = u / NCH, nc = u % NCH, tok0 = nc * 64;
    f32x4 acc[4];
#pragma unroll
    for (int m = 0; m < 4; ++m) acc[m] = (f32x4){0.f, 0.f, 0.f, 0.f};
    size_t lr[4];
#pragma unroll
    for (int m = 0; m < 4; ++m) lr[m] = ml_lrow(bl, tok0 + m * 16 + fr);
#pragma unroll 4
    for (int ks = wave * 24; ks < wave * 24 + 24; ++ks) {
      const int k = ks * 32 + fq * 8;
      const bf16x8 bfr = *(const bf16x8*)(WG + (size_t)fr * 6144 + k);
#pragma unroll
      for (int m = 0; m < 4; ++m) {
        const bf16_t* ap = k < 4096 ? QK + lr[m] * 4096 + k : XZ + lr[m] * 4096 + (k - 4096);
        const bf16x8 afr = *(const bf16x8*)ap;
        acc[m] = MFMA16(afr, bfr, acc[m]);
      }
    }
#pragma unroll
    for (int m = 0; m < 4; ++m)
#pragma unroll
      for (int jj = 0; jj < 4; ++jj) part[(wave * 64 + m * 16 + 4 * fq + jj) * 16 + fr] = acc[m][jj];
    __syncthreads();
    for (int i = tid; i < 1024; i += 512) {
      float s = IN(15)[(size_t)j * 16 + (i & 15)];
#pragma unroll
      for (int w = 0; w < 8; ++w) s += part[w * 1024 + i];
      gl[(i >> 4) * 17 + (i & 15)] = s;
    }
    __syncthreads();
    if (tid < 8) {
      const int x = tid >> 2, h = tid & 3, seq = (bl * 2 + x) * 4 + h;
      float b = 0.f, mx = -3.0e38f;
      for (int pp = 0; pp < 64; ++pp) {
        const int tl = x == 0 ? pp : 63 - pp;
        const float ig = gl[tl * 17 + x * 8 + h], fg = gl[tl * 17 + x * 8 + 4 + h];
        const float lf = fg > 0.f ? -__logf(1.f + __expf(-fg)) : fg - __logf(1.f + __expf(fg));
        b += lf;
        BL[(size_t)seq * TOKB + tok0 + tl] = b; IG[(size_t)seq * TOKB + tok0 + tl] = ig;
        mx = fmaxf(mx, ig - b);
      }
      GC[seq * NCH + nc] = b; AC[seq * NCH + nc] = b + mx;
    }
    __syncthreads();
  }
}

__device__ __forceinline__ void ml_s(const Params& p, const Ctx& cx) {
  const int tid = cx.tid, lane = tid & 63, wave = tid >> 6, fr = lane & 15, fq = lane >> 4;
  char* ws = cx.ws;
  const bf16_t* QK = (const bf16_t*)(ws + O_QK);
  bf16_t* SP = (bf16_t*)(ws + O_SP);
  const float* BL = (const float*)(ws + O_BL); const float* IG = (const float*)(ws + O_IG);
  float* WIN = (float*)(ws + O_WIN); float* FLO = (float*)(ws + O_FLO); float* DEN = (float*)(ws + O_DEN); float* WSS = (float*)(ws + O_WSS);
  const float* GC = (const float*)(ws + O_GC); const float* AC = GC + NSEQ * NCH; float* DEC = (float*)(ws + O_GC) + 2 * NSEQ * NCH;
  float* sb_ = (float*)lds_raw; float* si_ = sb_ + 64; float* smt = si_ + 64; float* sden = smt + 64;
  for (int u = cx.bid; u < NSEQ * NCH; u += cx.nb) {
    const int seq = u / NCH, st = u % NCH, x = (seq >> 2) & 1, h = seq & 3, bl = seq >> 3;
    const int nc = ml_nchunk(x, st), tok0 = nc * 64;
    if (wave == 0) {
      const int nl0 = ml_nchunk(x, lane), nl1 = ml_nchunk(x, 64 + (lane & 3));
      const float g0 = GC[seq * NCH + nl0], a0 = AC[seq * NCH + nl0], g1 = GC[seq * NCH + nl1], a1 = AC[seq * NCH + nl1];
      float mc = 0.f;
      for (int s2 = 0; s2 < st; ++s2) {
        const float gg = __int_as_float(__builtin_amdgcn_readlane(__float_as_int(s2 < 64 ? g0 : g1), s2 & 63));
        const float aa = __int_as_float(__builtin_amdgcn_readlane(__float_as_int(s2 < 64 ? a0 : a1), s2 & 63));
        mc = fmaxf(gg + mc, aa);
      }
      const float gc = GC[seq * NCH + nc], ac = AC[seq * NCH + nc];
      const float mnew = fmaxf(gc + mc, ac);
      const int tl = x == 0 ? lane : 63 - lane;
      const float b = BL[(size_t)seq * TOKB + tok0 + tl], ig = IG[(size_t)seq * TOKB + tok0 + tl];
      float cm = ig - b;
#pragma unroll
      for (int o = 1; o < 64; o <<= 1) { const float t2 = shi(cm, lane - o); if (lane >= o) cm = fmaxf(cm, t2); }
      const float mt = b + fmaxf(mc, cm);
      sb_[tl] = b; si_[tl] = ig; smt[tl] = mt;
      WIN[(size_t)seq * TOKB + tok0 + tl] = __expf(b + mc - mt);
      FLO[(size_t)seq * TOKB + tok0 + tl] = __expf(-mt);
      WSS[(size_t)seq * TOKB + tok0 + tl] = __expf(gc - b + ig - mnew);
      if (lane == 0) DEC[seq * NCH + nc] = __expf(gc + mc - mnew);
    }
    __syncthreads();
    const int sbk = wave >> 1;
    const bf16_t* kp = QK + (size_t)ml_lrow(bl, tok0 + sbk * 16 + fr) * 4096 + 2048 + h * DH + fq * 8;
    const bf16_t* qp0 = QK + (size_t)ml_lrow(bl, tok0 + (2 * (wave & 1)) * 16 + fr) * 4096 + h * DH + fq * 8;
    const bf16_t* qp1 = QK + (size_t)ml_lrow(bl, tok0 + (2 * (wave & 1) + 1) * 16 + fr) * 4096 + h * DH + fq * 8;
    f32x4 a0 = {0.f, 0.f, 0.f, 0.f}, a1 = {0.f, 0.f, 0.f, 0.f};
#pragma unroll 4
    for (int ks = 0; ks < 16; ++ks) {
      const bf16x8 kf = *(const bf16x8*)(kp + ks * 32), q0 = *(const bf16x8*)(qp0 + ks * 32), q1 = *(const bf16x8*)(qp1 + ks * 32);
      a0 = MFMA16(kf, q0, a0); a1 = MFMA16(kf, q1, a1);
    }
    bf16_t* spu = SP + (size_t)(seq * NCH + nc) * 4096;
#pragma unroll
    for (int tbi = 0; tbi < 2; ++tbi) {
      const int t = (2 * (wave & 1) + tbi) * 16 + fr;
      const f32x4 a = tbi ? a1 : a0;
      const float bt = sb_[t], mt = smt[t];
      float vals[4];
#pragma unroll
      for (int jj = 0; jj < 4; ++jj) {
        const int s = sbk * 16 + 4 * fq + jj;
        const bool ok = x == 0 ? (s <= t) : (s >= t);
        vals[jj] = ok ? a[jj] * __expf(bt - sb_[s] + si_[s] - mt) : 0.f;
      }
      u32x2 o; o.x = pk2(vals[0], vals[1]); o.y = pk2(vals[2], vals[3]);
      *(u32x2*)(spu + t * 64 + sbk * 16 + 4 * fq) = o;
      float ds = (bflo(o.x) + bfhi(o.x)) + (bflo(o.y) + bfhi(o.y));
      ds += shx(ds, 16, lane); ds += shx(ds, 32, lane);
      if (fq == 0) sden[sbk * 64 + t] = ds;
    }
    __syncthreads();
    if (tid < 64) DEN[(size_t)seq * TOKB + tok0 + tid] = (sden[tid] + sden[64 + tid]) + (sden[128 + tid] + sden[192 + tid]);
    __syncthreads();
  }
}

constexpr int NEB = 2, NSL = 512 / (16 * NEB);
__device__ __forceinline__ void ml_m2(const Params& p, const Ctx& cx) {
  const int tid = cx.tid, lane = tid & 63, wave = tid >> 6, fr = lane & 15, fq = lane >> 4;
  char* ws = cx.ws;
  const bf16_t* QK = (const bf16_t*)(ws + O_QK); const bf16_t* KT = (const bf16_t*)(ws + O_KT); const bf16_t* VT = (const bf16_t*)(ws + O_VT);
  const bf16_t* SP = (const bf16_t*)(ws + O_SP);
  bf16_t* HD = (bf16_t*)(ws + O_HD);
  const float* WIN = (const float*)(ws + O_WIN); const float* FLO = (const float*)(ws + O_FLO); const float* DEN = (const float*)(ws + O_DEN); const float* WSS = (const float*)(ws + O_WSS);
  const float* DEC = (const float*)(ws + O_GC) + 2 * NSEQ * NCH;
  f32x4* red = (f32x4*)lds_raw;
  f32x4* rn = (f32x4*)(lds_raw + 131072);
  for (int idx = cx.bid >> 3; idx < 2 * NSL; idx += cx.nb >> 3) {
    const int seq = (cx.bid & 7) * 2 + idx / NSL, es = idx % NSL, x = (seq >> 2) & 1, h = seq & 3, bl = seq >> 3;
    const int d0 = wave * 64, e0 = es * 16 * NEB;
    f32x4 C[4][NEB + 1];
#pragma unroll
    for (int a = 0; a < 4; ++a)
#pragma unroll
      for (int b = 0; b < NEB + 1; ++b) C[a][b] = (f32x4){0.f, 0.f, 0.f, 0.f};
    const int tbo = wave >> 1, ebo = wave & 1;
    bf16x8 qc[4][2], kf[4][2], sf0, sf1;
    u32x4 vr[NEB][2];
    f32x4 wv[2][2];
#define M2_LOAD_Q(ST) do { const int _t0 = ml_nchunk(x, (ST)) * 64; _Pragma("unroll") for (int tb = 0; tb < 4; ++tb) { \
        const bf16_t* qp = QK + (size_t)ml_lrow(bl, _t0 + tb * 16 + fr) * 4096 + h * DH + d0 + 4 * fq; \
        qc[tb][0] = mk8(*(const u32x2*)(qp), *(const u32x2*)(qp + 16)); qc[tb][1] = mk8(*(const u32x2*)(qp + 32), *(const u32x2*)(qp + 48)); } } while (0)
#define M2_LOAD_KV(ST) do { const int _nc = ml_nchunk(x, (ST)), _t0 = _nc * 64; \
        _Pragma("unroll") for (int db = 0; db < 4; ++db) { const bf16_t* kp = KT + ((size_t)bl * EI + h * DH + d0 + db * 16 + fr) * TOKB + _t0 + 8 * fq; \
          kf[db][0] = *(const bf16x8*)kp; kf[db][1] = *(const bf16x8*)(kp + 32); } \
        _Pragma("unroll") for (int eb = 0; eb < NEB; ++eb) { const bf16_t* vp = VT + ((size_t)bl * EI + h * DH + e0 + eb * 16 + fr) * TOKB + _t0 + 8 * fq; \
          vr[eb][0] = *(const u32x4*)vp; vr[eb][1] = *(const u32x4*)(vp + 32); } \
        _Pragma("unroll") for (int ks = 0; ks < 2; ++ks) { const float* wp = WSS + (size_t)seq * TOKB + _t0 + 32 * ks + 8 * fq; \
          wv[ks][0] = *(const f32x4*)wp; wv[ks][1] = *(const f32x4*)(wp + 4); } \
        const bf16_t* sp = SP + (size_t)(seq * NCH + _nc) * 4096 + (tbo * 16 + fr) * 64 + 8 * fq; \
        sf0 = *(const bf16x8*)sp; sf1 = *(const bf16x8*)(sp + 32); } while (0)
    M2_LOAD_Q(0);
    for (int st = 0; st < NCH; ++st) {
      const int nc = ml_nchunk(x, st), tok0 = nc * 64, stn = st + 1 < NCH ? st + 1 : st;
      const size_t tix = (size_t)seq * TOKB + tok0 + tbo * 16 + 4 * fq;
      const f32x4 win = *(const f32x4*)(WIN + tix), flo = *(const f32x4*)(FLO + tix), deni = *(const f32x4*)(DEN + tix);
      const float decay = DEC[seq * NCH + nc];
      M2_LOAD_KV(st);
#pragma unroll
      for (int eb = 0; eb < NEB + 1; ++eb) {
        bf16x8 cb0, cb1;
        { const f32x4 lo = C[0][eb], hi = C[1][eb]; cb0 = mk8((u32x4){pk2(lo[0], lo[1]), pk2(lo[2], lo[3]), pk2(hi[0], hi[1]), pk2(hi[2], hi[3])}); }
        { const f32x4 lo = C[2][eb], hi = C[3][eb]; cb1 = mk8((u32x4){pk2(lo[0], lo[1]), pk2(lo[2], lo[3]), pk2(hi[0], hi[1]), pk2(hi[2], hi[3])}); }
        f32x4 pa[4];
#pragma unroll
        for (int tb = 0; tb < 4; ++tb) pa[tb] = MFMA16(qc[tb][0], cb0, ((f32x4){0.f, 0.f, 0.f, 0.f}));
#pragma unroll
        for (int tb = 0; tb < 4; ++tb) pa[tb] = MFMA16(qc[tb][1], cb1, pa[tb]);
#pragma unroll
        for (int tb = 0; tb < 4; ++tb) {
          if (eb < NEB) red[((wave * 4 + tb) * NEB + eb) * 64 + lane] = pa[tb];
          else if (fr == 0) rn[(wave * 4 + tb) * 4 + fq] = pa[tb];
        }
      }
      M2_LOAD_Q(stn);
      f32x4 oi = {0.f, 0.f, 0.f, 0.f};
#pragma unroll
      for (int eb = 0; eb < NEB + 1; ++eb) {
        bf16x8 vw0, vw1;
        if (eb < NEB) {
          const u32x4 r0 = vr[eb][0], r1 = vr[eb][1];
          if (eb == ebo) { oi = MFMA16(sf0, mk8(r0), oi); oi = MFMA16(sf1, mk8(r1), oi); }
          vw0 = mk8((u32x4){pk2(bflo(r0.x) * wv[0][0][0], bfhi(r0.x) * wv[0][0][1]), pk2(bflo(r0.y) * wv[0][0][2], bfhi(r0.y) * wv[0][0][3]),
                            pk2(bflo(r0.z) * wv[0][1][0], bfhi(r0.z) * wv[0][1][1]), pk2(bflo(r0.w) * wv[0][1][2], bfhi(r0.w) * wv[0][1][3])});
          vw1 = mk8((u32x4){pk2(bflo(r1.x) * wv[1][0][0], bfhi(r1.x) * wv[1][0][1]), pk2(bflo(r1.y) * wv[1][0][2], bfhi(r1.y) * wv[1][0][3]),
                            pk2(bflo(r1.z) * wv[1][1][0], bfhi(r1.z) * wv[1][1][1]), pk2(bflo(r1.w) * wv[1][1][2], bfhi(r1.w) * wv[1][1][3])});
        } else {
          vw0 = mk8((u32x4){pk2(wv[0][0][0], wv[0][0][1]), pk2(wv[0][0][2], wv[0][0][3]), pk2(wv[0][1][0], wv[0][1][1]), pk2(wv[0][1][2], wv[0][1][3])});
          vw1 = mk8((u32x4){pk2(wv[1][0][0], wv[1][0][1]), pk2(wv[1][0][2], wv[1][0][3]), pk2(wv[1][1][0], wv[1][1][1]), pk2(wv[1][1][2], wv[1][1][3])});
        }
#pragma unroll
        for (int db = 0; db < 4; ++db) {
          f32x4 c = C[db][eb] * decay;
          c = MFMA16(kf[db][0], vw0, c); c = MFMA16(kf[db][1], vw1, c);
          C[db][eb] = c;
        }
      }
      __syncthreads();
      f32x4 rdn[8], rd0[8];
#pragma unroll
      for (int w = 0; w < 8; ++w) { rdn[w] = rn[(w * 4 + tbo) * 4 + fq]; rd0[w] = red[((w * 4 + tbo) * NEB + ebo) * 64 + lane]; }
      const f32x4 pn = ((rdn[0] + rdn[1]) + (rdn[2] + rdn[3])) + ((rdn[4] + rdn[5]) + (rdn[6] + rdn[7]));
      const f32x4 pi = ((rd0[0] + rd0[1]) + (rd0[2] + rd0[3])) + ((rd0[4] + rd0[5]) + (rd0[6] + rd0[7]));
#pragma unroll
      for (int jj = 0; jj < 4; ++jj) {
        const float num = oi[jj] + win[jj] * pi[jj], den = deni[jj] + win[jj] * pn[jj];
        const float hv = num * __builtin_amdgcn_rcpf(fmaxf(fabsf(den), flo[jj]));
        HD[((size_t)x * RG + ml_lrow(bl, tok0 + tbo * 16 + 4 * fq + jj)) * EI + h * DH + e0 + ebo * 16 + fr] = (bf16_t)(pk2(hv, 0.f) & 0xffff);
      }
      __syncthreads();
    }
    __syncthreads();
#undef M2_LOAD_Q
#undef M2_LOAD_KV
  }
}

__device__ __forceinline__ void ml_fin(const Params& p, const Ctx& cx, int j) {
  const int lane = cx.tid & 63, gw = cx.bid * 8 + (cx.tid >> 6), NGW = cx.nb * 8;
  char* ws = cx.ws;
  const bf16_t* XZ = (const bf16_t*)(ws + O_XZ); const bf16_t* HD = (const bf16_t*)(ws + O_HD);
  bf16_t* FIN = (bf16_t*)(ws + O_FIN);
  for (int u = gw; u < RG * 4; u += NGW) {
    const int lr = u >> 2, h = u & 3, f0 = h * DH + lane * 8;
    int pos, seglen;
    if (lr < GB * SEQ) { pos = lr & (SEQ - 1); seglen = SEQ; } else { pos = (lr - GB * SEQ) & (LC - 1); seglen = LC; }
    const u32x4 hf = *(const u32x4*)(HD + (size_t)lr * EI + f0), hb = *(const u32x4*)(HD + ((size_t)RG + lr) * EI + f0);
    const u32x4 zz = *(const u32x4*)(XZ + (size_t)lr * 4096 + 2048 + f0);
    const u32x4 x1 = *(const u32x4*)(XZ + (size_t)lr * 4096 + f0);
    u32x4 x0 = {0u, 0u, 0u, 0u}, x2 = {0u, 0u, 0u, 0u};
    if (pos > 0) x0 = *(const u32x4*)(XZ + (size_t)(lr - 1) * 4096 + f0);
    if (pos < seglen - 1) x2 = *(const u32x4*)(XZ + (size_t)(lr + 1) * 4096 + f0);
    float hv[8], xm0[8], xm1[8], xm2[8];
    const unsigned hfu[4] = {hf.x, hf.y, hf.z, hf.w}, hbu[4] = {hb.x, hb.y, hb.z, hb.w}, zu[4] = {zz.x, zz.y, zz.z, zz.w};
    const unsigned x0u[4] = {x0.x, x0.y, x0.z, x0.w}, x1u[4] = {x1.x, x1.y, x1.z, x1.w}, x2u[4] = {x2.x, x2.y, x2.z, x2.w};
    float s = 0.f;
#pragma unroll
    for (int i = 0; i < 4; ++i) {
      hv[2 * i] = (bflo(hfu[i]) + bflo(hbu[i])) * sigm_f(bflo(zu[i]));
      hv[2 * i + 1] = (bfhi(hfu[i]) + bfhi(hbu[i])) * sigm_f(bfhi(zu[i]));
      xm0[2 * i] = bflo(x0u[i]); xm0[2 * i + 1] = bfhi(x0u[i]); xm1[2 * i] = bflo(x1u[i]); xm1[2 * i + 1] = bfhi(x1u[i]); xm2[2 * i] = bflo(x2u[i]); xm2[2 * i + 1] = bfhi(x2u[i]);
      s += hv[2 * i] + hv[2 * i + 1];
    }
    const float mean = wave_sum(s, lane) * (1.f / DH); float s2 = 0.f;
#pragma unroll
    for (int i = 0; i < 8; ++i) { hv[i] -= mean; s2 += hv[i] * hv[i]; }
    const float rstd = __builtin_amdgcn_rsqf(wave_sum(s2, lane) * (1.f / DH) + LN_EPS);
    float o[8];
#pragma unroll
    for (int i = 0; i < 8; ++i) {
      const int f = f0 + i;
      const float xc = silu_f(IN(11)[(size_t)(j * 3 + 0) * EI + f] * xm0[i] + IN(11)[(size_t)(j * 3 + 1) * EI + f] * xm1[i] + IN(11)[(size_t)(j * 3 + 2) * EI + f] * xm2[i] + IN(12)[(size_t)j * EI + f]);
      o[i] = hv[i] * rstd * IN(17)[(size_t)j * EI + f] + IN(16)[(size_t)j * EI + f] * xc;
    }
    u32x4 ov; ov.x = pk2(o[0], o[1]); ov.y = pk2(o[2], o[3]); ov.z = pk2(o[4], o[5]); ov.w = pk2(o[6], o[7]);
    *(u32x4*)(FIN + (size_t)lr * EI + f0) = ov;
  }
}

__device__ __forceinline__ void at_prep(const Params& p, const Ctx& cx) {
  const int lane = cx.tid & 63, gw = cx.bid * 8 + (cx.tid >> 6), NGW = cx.nb * 8;
  char* ws = cx.ws;
  bf16_t* ACT = (bf16_t*)(ws + O_ACT); bf16_t* KR = (bf16_t*)(ws + O_AKR); bf16_t* VT = (bf16_t*)(ws + O_AVT);
  const float* rc = (const float*)(ws + O_ROPE); const float* rs = rc + 4096 * 32;
  for (int row = gw; row < MROWS; row += NGW) {
    const bool lat = row < NLAT;
    const int b = lat ? row >> 12 : (row - NLAT) >> 8, pos = lat ? row & 4095 : (row - NLAT) & 255, tok = lat ? LC + pos : pos;
    bf16_t* rp = ACT + (size_t)row * 1536;
    {
      const u32x4 a = *(const u32x4*)(rp + 16 * lane), b2 = *(const u32x4*)(rp + 16 * lane + 8);
      const unsigned w[8] = {a.x, a.y, a.z, a.w, b2.x, b2.y, b2.z, b2.w};
      unsigned o[8];
      const int pp0 = (lane & 3) * 8;
#pragma unroll
      for (int i = 0; i < 8; ++i) {
        float x1 = bflo(w[i]) * 0.125f, x2 = bfhi(w[i]) * 0.125f;
        if (lat) { const float c = rc[pos * 32 + pp0 + i], s = rs[pos * 32 + pp0 + i]; const float y1 = x1 * c - x2 * s, y2 = x1 * s + x2 * c; x1 = y1; x2 = y2; }
        o[i] = pk2(x1, x2);
      }
      *(u32x4*)(rp + 16 * lane) = (u32x4){o[0], o[1], o[2], o[3]}; *(u32x4*)(rp + 16 * lane + 8) = (u32x4){o[4], o[5], o[6], o[7]};
    }
    {
      const u32x2 a = *(const u32x2*)(rp + 1024 + 4 * lane);
      const unsigned w[2] = {a.x, a.y}; unsigned o[2];
      const int g = lane >> 4, dd = (lane & 15) * 4, pp0 = dd >> 1;
#pragma unroll
      for (int i = 0; i < 2; ++i) {
        float x1 = bflo(w[i]), x2 = bfhi(w[i]);
        if (lat) { const float c = rc[pos * 32 + pp0 + i], s = rs[pos * 32 + pp0 + i]; const float y1 = x1 * c - x2 * s, y2 = x1 * s + x2 * c; x1 = y1; x2 = y2; }
        o[i] = pk2(x1, x2);
      }
      *(u32x2*)(KR + (((size_t)b * 4 + g) * TOKB + tok) * 64 + dd) = (u32x2){o[0], o[1]};
      const u32x2 v = *(const u32x2*)(rp + 1280 + 4 * lane);
      bf16_t* vp = VT + (((size_t)b * 4 + g) * 64 + dd) * TOKB + tok;
      vp[0] = (bf16_t)(v.x & 0xffff); vp[TOKB] = (bf16_t)(v.x >> 16); vp[2 * TOKB] = (bf16_t)(v.y & 0xffff); vp[3 * TOKB] = (bf16_t)(v.y >> 16);
    }
  }
}

__device__ __forceinline__ void at_core(const Params& p, const Ctx& cx) {
  const int lane = cx.tid & 63, gw = cx.bid * 8 + (cx.tid >> 6), NGW = cx.nb * 8, fr = lane & 15, fq = lane >> 4;
  char* ws = cx.ws;
  const bf16_t* ACT = (const bf16_t*)(ws + O_ACT); const bf16_t* KR = (const bf16_t*)(ws + O_AKR); const bf16_t* VT = (const bf16_t*)(ws + O_AVT);
  bf16_t* O = (bf16_t*)(ws + O_U);
  for (int u = gw; u < (MROWS / 16) * 4; u += NGW) {
    const int g = u & 3, qb = u >> 2, row0 = qb * 16;
    const bool lat = row0 < NLAT;
    const int b = lat ? row0 >> 12 : (row0 - NLAT) >> 8, q0 = lat ? row0 & 4095 : 0;
    bf16x8 qf[4][2];
    float mrun[4], lrun[4], sink[4];
    f32x4 oacc[4][4];
#pragma unroll
    for (int hh = 0; hh < 4; ++hh) {
      const bf16_t* qp = ACT + (size_t)(row0 + fr) * 1536 + (g * 4 + hh) * 64 + 8 * fq;
      qf[hh][0] = *(const bf16x8*)qp; qf[hh][1] = *(const bf16x8*)(qp + 32);
      sink[hh] = IN(20)[g * 4 + hh]; mrun[hh] = sink[hh]; lrun[hh] = 0.f;
#pragma unroll
      for (int d2 = 0; d2 < 4; ++d2) oacc[hh][d2] = (f32x4){0.f, 0.f, 0.f, 0.f};
    }
    const bf16_t* kbase = KR + ((size_t)b * 4 + g) * TOKB * 64;
    const bf16_t* vbase = VT + ((size_t)b * 4 + g) * 64 * TOKB;
    int wlo = 0, whi = -1;
    if (lat) { wlo = max(0, q0 - 128) & ~31; whi = min(SEQ - 1, q0 + 143); }
    const int nwin = lat ? (whi - wlo) / 32 + 1 : 0;
    for (int ti = 0; ti < 8 + nwin; ++ti) {
      const bool isw = ti >= 8;
      const int kpos0 = isw ? wlo + (ti - 8) * 32 : 0;
      const int tk0 = isw ? LC + kpos0 : ti * 32;
      const bf16_t* kp = kbase + (size_t)(tk0 + fr) * 64 + 8 * fq;
      const bf16x8 k00 = *(const bf16x8*)kp, k01 = *(const bf16x8*)(kp + 32), k10 = *(const bf16x8*)(kp + 16 * 64), k11 = *(const bf16x8*)(kp + 16 * 64 + 32);
      bf16x8 vfr[4];
#pragma unroll
      for (int d2 = 0; d2 < 4; ++d2) {
        const bf16_t* vp = vbase + (size_t)(d2 * 16 + fr) * TOKB + tk0 + 4 * fq;
        vfr[d2] = mk8(*(const u32x2*)vp, *(const u32x2*)(vp + 16));
      }
      bool okm[8];
#pragma unroll
      for (int i = 0; i < 8; ++i) {
        const int kpos = kpos0 + (i >> 2) * 16 + 4 * fq + (i & 3), dlt = (q0 + fr) - kpos;
        okm[i] = !isw || (dlt <= 128 && dlt >= -128);
      }
#pragma unroll
      for (int hh = 0; hh < 4; ++hh) {
        f32x4 s0 = {0.f, 0.f, 0.f, 0.f}, s1 = {0.f, 0.f, 0.f, 0.f};
        s0 = MFMA16(k00, qf[hh][0], s0); s0 = MFMA16(k01, qf[hh][1], s0);
        s1 = MFMA16(k10, qf[hh][0], s1); s1 = MFMA16(k11, qf[hh][1], s1);
        float sv[8]; float tmax = -3.0e38f;
#pragma unroll
        for (int i = 0; i < 8; ++i) { sv[i] = okm[i] ? (i < 4 ? s0[i] : s1[i - 4]) : -3.0e38f; tmax = fmaxf(tmax, sv[i]); }
        tmax = fmaxf(tmax, shx(tmax, 16, lane)); tmax = fmaxf(tmax, shx(tmax, 32, lane));
        const float mnew = fmaxf(mrun[hh], tmax), scale = __expf(mrun[hh] - mnew);
        mrun[hh] = mnew;
        float pv[8];
#pragma unroll
        for (int i = 0; i < 8; ++i) pv[i] = okm[i] ? __expf(sv[i] - mnew) : 0.f;
        const u32x4 pu = {pk2(pv[0], pv[1]), pk2(pv[2], pv[3]), pk2(pv[4], pv[5]), pk2(pv[6], pv[7])};
        const float ps = ((bflo(pu.x) + bfhi(pu.x)) + (bflo(pu.y) + bfhi(pu.y))) + ((bflo(pu.z) + bfhi(pu.z)) + (bflo(pu.w) + bfhi(pu.w)));
        lrun[hh] = lrun[hh] * scale + ps;
        const bf16x8 pf = mk8(pu);
        float scq[4];
#pragma unroll
        for (int jj = 0; jj < 4; ++jj) scq[jj] = shi(scale, 4 * fq + jj);
#pragma unroll
        for (int d2 = 0; d2 < 4; ++d2) {
          f32x4 o = oacc[hh][d2];
          o[0] *= scq[0]; o[1] *= scq[1]; o[2] *= scq[2]; o[3] *= scq[3];
          oacc[hh][d2] = MFMA16(pf, vfr[d2], o);
        }
      }
    }
#pragma unroll
    for (int hh = 0; hh < 4; ++hh) {
      float l = lrun[hh];
      l += shx(l, 16, lane); l += shx(l, 32, lane);
      l += __expf(sink[hh] - mrun[hh]);
      const float inv = __builtin_amdgcn_rcpf(l);
      float iq[4];
#pragma unroll
      for (int jj = 0; jj < 4; ++jj) iq[jj] = shi(inv, 4 * fq + jj);
#pragma unroll
      for (int d2 = 0; d2 < 4; ++d2)
#pragma unroll
        for (int jj = 0; jj < 4; ++jj)
          O[(size_t)(row0 + 4 * fq + jj) * D + (g * 4 + hh) * 64 + d2 * 16 + fr] = (bf16_t)(pk2(oacc[hh][d2][jj] * iq[jj], 0.f) & 0xffff);
    }
  }
}

__device__ __forceinline__ void sc_conv(const Params& p, const Ctx& cx) {
  const int gt = cx.bid * 512 + cx.tid, gs = cx.nb * 512;
  const bf16_t* ACT = (const bf16_t*)(cx.ws + O_ACT); bf16_t* O = (bf16_t*)(cx.ws + O_U);
  const float* cw = IN(23);
  for (int i = gt; i < MROWS * 128; i += gs) {
    const int row = i >> 7, c0 = (i & 127) * 8;
    int pos, seglen;
    if (row < NLAT) { pos = row & (SEQ - 1); seglen = SEQ; } else { pos = (row - NLAT) & (LC - 1); seglen = LC; }
    float accv[8];
#pragma unroll
    for (int e = 0; e < 8; ++e) accv[e] = 0.f;
#pragma unroll
    for (int k = 0; k < 3; ++k) {
      const int pp = pos + k - 1;
      if (pp < 0 || pp >= seglen) continue;
      const bf16_t* rp = ACT + (size_t)(row + k - 1) * 3072;
      const u32x4 cgv = *(const u32x4*)(rp + 1024 + c0), xtv = *(const u32x4*)(rp + 2048 + c0);
      const unsigned cu[4] = {cgv.x, cgv.y, cgv.z, cgv.w}, xu[4] = {xtv.x, xtv.y, xtv.z, xtv.w};
#pragma unroll
      for (int e = 0; e < 4; ++e) {
        accv[2 * e] += cw[k * D + c0 + 2 * e] * (bflo(cu[e]) * bflo(xu[e]));
        accv[2 * e + 1] += cw[k * D + c0 + 2 * e + 1] * (bfhi(cu[e]) * bfhi(xu[e]));
      }
    }
    const u32x4 bgv = *(const u32x4*)(ACT + (size_t)row * 3072 + c0);
    const unsigned bu[4] = {bgv.x, bgv.y, bgv.z, bgv.w};
    u32x4 o;
    o.x = pk2(bflo(bu[0]) * accv[0], bfhi(bu[0]) * accv[1]); o.y = pk2(bflo(bu[1]) * accv[2], bfhi(bu[1]) * accv[3]);
    o.z = pk2(bflo(bu[2]) * accv[4], bfhi(bu[2]) * accv[5]); o.w = pk2(bflo(bu[3]) * accv[6], bfhi(bu[3]) * accv[7]);
    *(u32x4*)(O + (size_t)row * D + c0) = o;
  }
}

#define XB_TMO      128
#define XB_XCNT(j)  (256  + 64 * (j))
#define XB_XSUB(j)  (1280 + 64 * (j))
#define XB_XGEN(j)  (2304 + 64 * (j))
#define XB_TOP      3328
#define XB_TOPGEN   3392
#define XCD_BAR_WORDS 3456
#define XB_SPIN_CAP (1u << 18)
__device__ __forceinline__ unsigned xb_ld(unsigned* p)              { return __hip_atomic_load(p, __ATOMIC_RELAXED, __HIP_MEMORY_SCOPE_AGENT); }
__device__ __forceinline__ unsigned xb_add(unsigned* p, unsigned v) { return __hip_atomic_fetch_add(p, v, __ATOMIC_RELAXED, __HIP_MEMORY_SCOPE_AGENT); }
__device__ __forceinline__ unsigned xb_xcc_id() { return (unsigned)__builtin_amdgcn_s_getreg((3 << 11) | 20) & 0xFu; }
#define XB_SPIN(cond, bar) do { unsigned _sp = 0; while (cond) { __builtin_amdgcn_s_sleep(1); \
    if ((++_sp & 255u) == 0u) { if (xb_ld(&(bar)[XB_TMO])) break; if (_sp > XB_SPIN_CAP) { atomicAdd(&(bar)[XB_TMO], 1u); break; } } } } while (0)
__device__ __forceinline__ void xcd_barrier_complete(unsigned* bar, unsigned x, unsigned& nloc, unsigned& nx) {
  const unsigned G = gridDim.x;
  unsigned sum, cnt, mine, sp = 0u;
  for (;;) {
    sum = 0u; cnt = 0u; mine = 0u;
#pragma unroll
    for (unsigned j = 0; j < 16; ++j) { const unsigned c = xb_ld(&bar[XB_XCNT(j)]); sum += c; cnt += (c > 0u) ? 1u : 0u; mine = (j == x) ? c : mine; }
    if (sum == G) break;
    __builtin_amdgcn_s_sleep(1);
    if ((++sp & 255u) == 0u) { if (xb_ld(&bar[XB_TMO])) break; if (sp > XB_SPIN_CAP) { atomicAdd(&bar[XB_TMO], 1u); break; } }
  }
  nloc = mine > 0u ? mine : 1u; nx = cnt > 0u ? cnt : 1u;
}
__device__ __forceinline__ void xcd_barrier(unsigned* bar, unsigned x, volatile LAS unsigned* st) {
  asm volatile("s_waitcnt vmcnt(0)" ::: "memory");
  __syncthreads();
  if (threadIdx.x == 0) {
    __builtin_amdgcn_s_waitcnt(0);
    unsigned nloc = st[0], nx = st[1];
    if (nloc == 0u) { xcd_barrier_complete(bar, x, nloc, nx); st[0] = nloc; st[1] = nx; }
    const unsigned old = xb_add(&bar[XB_XSUB(x)], 1u);
    const unsigned gen = old / nloc;
    if (old + 1u == (gen + 1u) * nloc) {
      __builtin_amdgcn_fence(__ATOMIC_RELEASE, "agent");
      asm volatile("s_waitcnt vmcnt(0)" ::: "memory");
      const unsigned og = xb_add(&bar[XB_TOP], 1u);
      const unsigned tg = og / nx;
      if (og + 1u == (tg + 1u) * nx) xb_add(&bar[XB_TOPGEN], 1u);
      else XB_SPIN(xb_ld(&bar[XB_TOPGEN]) == tg, bar);
      __builtin_amdgcn_fence(__ATOMIC_ACQUIRE, "agent");
      xb_add(&bar[XB_XGEN(x)], 1u);
      asm volatile("s_waitcnt vmcnt(0)" ::: "memory");
    } else {
      XB_SPIN(xb_ld(&bar[XB_XGEN(x)]) == gen, bar);
      __builtin_amdgcn_fence(__ATOMIC_ACQUIRE, "agent");
      asm volatile("s_waitcnt vmcnt(0)" ::: "memory");
    }
  }
  __syncthreads();
}

#ifndef ENMASK
#define ENMASK 0xffff
#endif
#define EN(i) ((ENMASK >> (i)) & 1)
enum { OP_PRO = 0, OP_LN0, OP_LN1, OP_LNF, OP_FFI, OP_FFO, OP_UP, OP_M0, OP_GAT, OP_S, OP_M2, OP_FIN, OP_DN, OP_AQ, OP_APREP, OP_ACORE, OP_AO, OP_SI, OP_SCONV, OP_SO };
__global__ void __launch_bounds__(512) fwd_megakernel(Params p) {
  cg::grid_group grid = cg::this_grid();
  const int wave_s = __builtin_amdgcn_readfirstlane((int)threadIdx.x >> 6);
  volatile LAS unsigned* xst = (volatile LAS unsigned*)((LAS unsigned char*)lds_raw + (LDS_BYTES - 16));
  if (threadIdx.x == 0) { xst[0] = 0u; xst[1] = 0u; }
  __syncthreads();
  unsigned* xbar = (unsigned*)(p.ws + O_BAR);
  const unsigned xcc = xb_xcc_id();
  if (threadIdx.x == 0) (void)xb_add(&xbar[XB_XCNT(xcc)], 1u);
#ifdef DUP_OP
  int rep = 0;
#endif
  for (int ph = 0; ph < p.nph; ++ph) {
    const unsigned w = p.prog[ph];
    const int op = w & 255, a = (w >> 8) & 255, b = (w >> 16) & 255, c = (w >> 24) & 255;
#define MKCTX int z; asm volatile("s_mov_b32 %0, 0" : "=s"(z)); \
    GAS char* wsq = (GAS char*)p.ws; GAS float* outq = (GAS float*)p.out; int bidq = (int)blockIdx.x, nbq = (int)gridDim.x; \
    asm volatile("" : "+s"(wsq), "+s"(outq), "+s"(bidq), "+s"(nbq)); \
    const Ctx cx{wave_s * 64 + (int)__builtin_amdgcn_mbcnt_hi(~0u, __builtin_amdgcn_mbcnt_lo(~0u, (unsigned)z)), bidq, nbq, z, (char*)wsq, (float*)outq};
    if (EN(0) && op == OP_PRO) { MKCTX prologue(p, cx); }
    else if (EN(1) && op == OP_LN0) { MKCTX lnmod_phase<0>(p, cx, 0, 0, 0); }
    else if (EN(1) && op == OP_LN1) { MKCTX lnmod_phase<1>(p, cx, a, b, c); }
    else if (EN(1) && op == OP_LNF) { MKCTX lnmod_phase<2>(p, cx, a, 0, 0); }
    else if (EN(2) && op == OP_M0) { MKCTX ml_m0(p, cx, a); }
    else if (EN(3) && op == OP_GAT) { MKCTX ml_gates(p, cx, a); }
    else if (EN(4) && op == OP_S) { MKCTX ml_s(p, cx); }
    else if (EN(5) && op == OP_M2) { MKCTX ml_m2(p, cx); }
    else if (EN(6) && op == OP_FIN) { MKCTX ml_fin(p, cx, a); }
    else if (EN(7) && op == OP_APREP) { MKCTX at_prep(p, cx); }
    else if (EN(8) && op == OP_ACORE) { MKCTX at_core(p, cx); }
    else if (EN(9) && op == OP_SCONV) { MKCTX sc_conv(p, cx); }
    else if (EN(10)) {
      MKCTX
      char* ws = cx.ws;
      const RowMap idm{0, 0, 1 << 30};
      bf16_t* U = (bf16_t*)(ws + O_U); bf16_t* ACT = (bf16_t*)(ws + O_ACT);
      const float* MODT = (const float*)(ws + O_MODT);
      const bf16_t* A = U; const bf16_t* Bt; int K = 1024, nM = MROWS / 256, nN; RowMap am = idm, cm = idm;
      Epi E; E.kind = 2; E.O = ACT; E.ldc = 0; E.modl = MODT + (size_t)b * 9 * 9216; E.slot = 1; E.wgt = 1.0f;
      if (op == OP_FFI) { Bt = (const bf16_t*)(ws + O_WFI) + (size_t)a * 5632 * 1024; nN = 22; E.kind = 1; if (c) nM = NLAT / 256; }
      else if (op == OP_FFO) { A = ACT; Bt = (const bf16_t*)(ws + O_WFO) + (size_t)a * 1024 * 2816; K = 2816; nN = 4; E.slot = c & 3; E.wgt = 0.5f; if (c & 4) nM = NLAT / 256; }
      else if (op == OP_UP) { Bt = (const bf16_t*)(ws + O_WUP) + (size_t)a * 4096 * 1024; nM = RG / 256; nN = 16; am = RowMap{c * GB * SEQ, NLAT + c * GB * LC, GB * SEQ / 256}; E.kind = 0; E.O = (bf16_t*)(ws + O_XZ); E.ldc = 4096; }
      else if (op == OP_DN) { A = (const bf16_t*)(ws + O_FIN); Bt = (const bf16_t*)(ws + O_WDN) + (size_t)a * 1024 * 2048; K = 2048; nM = RG / 256; nN = 4; cm = RowMap{c * GB * SEQ, NLAT + c * GB * LC, GB * SEQ / 256}; }
      else if (op == OP_AQ) { Bt = (const bf16_t*)(ws + O_WAQ); nN = 6; E.kind = 0; E.ldc = 1536; }
      else if (op == OP_AO) { Bt = (const bf16_t*)(ws + O_WAO); nN = 4; }
      else if (op == OP_SI) { Bt = (const bf16_t*)(ws + O_WSI); nN = 12; E.kind = 0; E.ldc = 3072; }
      else { Bt = (const bf16_t*)(ws + O_WSO); nN = 4; }
      gemm_phase(cx, A, am, Bt, K, nM, nN, cm, E);
    }
    if (ph == 0) grid.sync(); else xcd_barrier(xbar, xcc, xst);
#ifdef DUP_OP
    if (op == DUP_OP && rep + 1 < DUP_N) { ++rep; --ph; } else rep = 0;
#endif
  }
}

static int build_program(unsigned* prog) {
  int n = 0;
  auto W = [&](int op, int a, int b, int c) { prog[n++] = (unsigned)op | ((unsigned)a << 8) | ((unsigned)b << 16) | ((unsigned)c << 24); };
  W(OP_PRO, 0, 0, 0);
  W(OP_LN0, 0, 0, 0);
  for (int layer = 0; layer < DEPTH; ++layer) {
    const int kind = layer % 3, j = layer / 3;
    W(OP_FFI, layer * 2, layer, 0); W(OP_FFO, layer * 2, layer, 0);
    W(OP_LN1, layer * 3 + 0, layer, 1);
    if (kind == 0) {
      for (int g = 0; g < NG; ++g) { W(OP_UP, j, layer, g); W(OP_M0, j, 0, 0); W(OP_GAT, j, 0, 0); W(OP_S, 0, 0, 0); W(OP_M2, 0, 0, 0); W(OP_FIN, j, 0, 0); W(OP_DN, j, layer, g); }
    } else if (kind == 1) { W(OP_AQ, 0, layer, 0); W(OP_APREP, 0, 0, 0); W(OP_ACORE, 0, 0, 0); W(OP_AO, 0, layer, 0); }
    else { W(OP_SI, 0, layer, 0); W(OP_SCONV, 0, 0, 0); W(OP_SO, 0, layer, 0); }
    W(OP_LN1, layer * 3 + 1, layer, 2);
    const int lo = (layer + 1 == DEPTH) ? 1 : 0;
    W(OP_FFI, layer * 2 + 1, layer, lo); W(OP_FFO, layer * 2 + 1, layer, 2 | (lo << 2));
    if (layer + 1 < DEPTH) W(OP_LN1, layer * 3 + 2, layer + 1, 0); else W(OP_LNF, layer * 3 + 2, 0, 0);
  }
  return n;
}

extern "C" void kernel_launch(void* const* d_in, const int* in_sizes, int n_in, void* d_out, int out_size, void* d_ws, size_t ws_size, hipStream_t stream) {
  static int grid_blocks = 0;
  if (!grid_blocks) {
    int dev = 0, cus = 0, per_cu = 0;
    (void)hipGetDevice(&dev);
    (void)hipDeviceGetAttribute(&cus, hipDeviceAttributeMultiprocessorCount, dev);
    (void)hipFuncSetAttribute((const void*)fwd_megakernel, hipFuncAttributeMaxDynamicSharedMemorySize, LDS_BYTES);
    (void)hipOccupancyMaxActiveBlocksPerMultiprocessor(&per_cu, fwd_megakernel, 512, LDS_BYTES);
    if (cus <= 0) cus = 256;
    grid_blocks = cus;
    if (ws_size < WS_END || n_in != 25) fprintf(stderr, "kernel_launch: workspace %zu < %zu or n_in %d != 25\n", ws_size, (size_t)WS_END, n_in);
    if (per_cu < 1) fprintf(stderr, "kernel_launch: occupancy query says %d blocks per CU\n", per_cu);
  }
  Params p{};
  for (int i = 0; i < 25; ++i) p.in[i] = (const float*)d_in[i];
  p.out = (float*)d_out; p.ws = (char*)d_ws;
  p.nph = build_program(p.prog);
  (void)hipMemsetAsync((char*)d_ws + O_BAR, 0, XCD_BAR_WORDS * 4, stream);
  void* args[] = {&p};
  hipError_t e = hipLaunchCooperativeKernel((void*)fwd_megakernel, dim3(grid_blocks), dim3(512), args, LDS_BYTES, stream);
  if (e != hipSuccess) fprintf(stderr, "cooperative launch failed: %s (grid %d)\n", hipGetErrorString(e), grid_blocks);
}
```

```cpp
#include <hip/hip_runtime.h>
#include <hip/hip_cooperative_groups.h>
#include <cstdio>
#include <cstdint>
namespace cg = cooperative_groups;

typedef unsigned short bf16_t;
typedef short bf16x8 __attribute__((ext_vector_type(8)));
typedef short bf16x4 __attribute__((ext_vector_type(4)));
typedef float f32x4 __attribute__((ext_vector_type(4)));
typedef unsigned u32x2 __attribute__((ext_vector_type(2)));
typedef unsigned u32x4 __attribute__((ext_vector_type(4)));

constexpr int D = 1024, NB = 8, SEQ = 4096, LC = 256, DEPTH = 4, FF = 2816, EI = 2048, DH = 512;
constexpr int NLAT = NB * SEQ, NCTX = NB * LC, MROWS = NLAT + NCTX;
constexpr int TOKB = LC + SEQ;
constexpr int NCH = TOKB / 64;
constexpr int GB = 2, NG = NB / GB, RG = GB * TOKB;
constexpr int NSEQ = GB * 8;
constexpr float ALPHA = 1.681792830507429f, LN_EPS = 1e-5f;
constexpr int LDS_BYTES = 144 * 1024;

constexpr size_t al256(size_t x) { return (x + 255) & ~(size_t)255; }
constexpr size_t O_WFI = 0;
constexpr size_t O_WFO = O_WFI + (size_t)8 * 5632 * 1024 * 2;
constexpr size_t O_WUP = O_WFO + (size_t)8 * 1024 * 2816 * 2;
constexpr size_t O_WDN = O_WUP + (size_t)2 * 4096 * 1024 * 2;
constexpr size_t O_WAQ = O_WDN + (size_t)2 * 1024 * 2048 * 2;
constexpr size_t O_WAO = O_WAQ + (size_t)1536 * 1024 * 2;
constexpr size_t O_WSI = O_WAO + (size_t)1024 * 1024 * 2;
constexpr size_t O_WSO = O_WSI + (size_t)3072 * 1024 * 2;
constexpr size_t O_WG = O_WSO + (size_t)1024 * 1024 * 2;
constexpr size_t O_MODT = O_WG + (size_t)2 * 16 * 6144 * 2;
constexpr size_t O_ROPE = O_MODT + (size_t)4 * 9 * 9216 * 4;
constexpr size_t O_HCTX = O_ROPE + (size_t)2 * 4096 * 32 * 4;
constexpr size_t O_U = O_HCTX + (size_t)NCTX * D * 4;
constexpr size_t O_R = O_U + (size_t)MROWS * D * 2;
constexpr size_t O_XZ = O_R;
constexpr size_t O_QK = O_XZ + (size_t)RG * 4096 * 2;
constexpr size_t O_KT = O_QK + (size_t)RG * 4096 * 2;
constexpr size_t O_VT = O_KT + (size_t)GB * EI * TOKB * 2;
constexpr size_t O_SP = O_VT + (size_t)GB * EI * TOKB * 2;
constexpr size_t O_HD = O_SP + (size_t)NSEQ * NCH * 4096 * 2;
constexpr size_t O_FIN = O_HD + (size_t)2 * RG * EI * 2;
constexpr size_t O_GAT = O_FIN + (size_t)RG * EI * 2;
constexpr size_t SZ_ST = (size_t)NSEQ * TOKB * 4;
constexpr size_t O_BL = O_GAT, O_IG = O_BL + SZ_ST, O_WIN = O_IG + SZ_ST, O_FLO = O_WIN + SZ_ST, O_DEN = O_FLO + SZ_ST, O_WSS = O_DEN + SZ_ST;
constexpr size_t O_GC = O_WSS + SZ_ST;
constexpr size_t O_REND_ML = O_GC + (size_t)3 * NSEQ * NCH * 4 + 256;
constexpr size_t O_ACT = O_R;
constexpr size_t O_AKR = O_R + (size_t)MROWS * 3072 * 2;
constexpr size_t O_AVT = O_AKR + (size_t)NB * 4 * TOKB * 64 * 2;
constexpr size_t O_REND_AT = O_AVT + (size_t)NB * 4 * TOKB * 64 * 2;
constexpr size_t O_BAR = (O_REND_ML > O_REND_AT ? O_REND_ML : O_REND_AT);
constexpr size_t WS_END = O_BAR + 3456 * 4 + 256;

struct Params {
  const float* in[25];
  float* out;
  char* ws;
  int nph; int pad0;
  unsigned prog[126];
};

#define GAS __attribute__((address_space(1)))
#define IN(k) ((const float*)(const GAS float*)p.in[(k) + cx.z])
struct Ctx { int tid, bid, nb, z; char* ws; float* out; };
extern __shared__ __attribute__((aligned(16))) char lds_raw[];

__device__ __forceinline__ unsigned pk2(float lo, float hi) { unsigned r; asm volatile("v_cvt_pk_bf16_f32 %0, %1, %2" : "=v"(r) : "v"(lo), "v"(hi)); return r; }
__device__ __forceinline__ float bf2f(unsigned short v) { return __uint_as_float(((unsigned)v) << 16); }
__device__ __forceinline__ float bflo(unsigned v) { return __uint_as_float(v << 16); }
__device__ __forceinline__ float bfhi(unsigned v) { return __uint_as_float(v & 0xffff0000u); }
__device__ __forceinline__ float silu_f(float x) { return x * __builtin_amdgcn_rcpf(1.f + __expf(-x)); }
__device__ __forceinline__ float sigm_f(float x) { return __builtin_amdgcn_rcpf(1.f + __expf(-x)); }
__device__ __forceinline__ float shi(float v, int srclane) { return __int_as_float(__builtin_amdgcn_ds_bpermute(srclane << 2, __float_as_int(v))); }
__device__ __forceinline__ float shx(float v, int m, int lane) { return shi(v, lane ^ m); }
__device__ __forceinline__ float wave_sum(float v, int lane) {
#pragma unroll
  for (int o = 1; o < 64; o <<= 1) v += shx(v, o, lane);
  return v;
}
__device__ __forceinline__ bf16x8 mk8(u32x4 v) { union { u32x4 u; bf16x8 b; } x; x.u = v; return x.b; }
__device__ __forceinline__ bf16x8 mk8(u32x2 a, u32x2 b) { union { u32x4 u; bf16x8 b; } x; x.u = (u32x4){a.x, a.y, b.x, b.y}; return x.b; }
__device__ __forceinline__ float* hrow(const Ctx& cx, int row) { return row < NLAT ? cx.out + (size_t)row * D : (float*)(cx.ws + O_HCTX) + (size_t)(row - NLAT) * D; }
#define MFMA16(a, b, c) __builtin_amdgcn_mfma_f32_16x16x32_bf16(a, b, c, 0, 0, 0)

constexpr int BM = 256, BK = 64, HALF = 128, HT = HALF * BK, NXCD = 8, WGM = 8;
__device__ __forceinline__ int lds_byte(int r, int c) {
  int st = (r >> 4) * 2 + (c >> 5), rr = r & 15, cc = c & 31, ob = rr * 64 + cc * 2;
  return st * 1024 + (ob ^ (((ob >> 9) & 1) << 5));
}
__device__ __forceinline__ void stage_rc(int b, int& R, int& C) {
  int st = b / 1024, sb = b % 1024, swz = sb ^ (((sb >> 9) & 1) << 5);
  R = (st >> 1) * 16 + swz / 64; C = (st & 1) * 32 + (swz % 64) / 2;
}
struct RowMap { int lat0, ctx0, nlat; __device__ __forceinline__ int row0(int pm) const { return pm < nlat ? lat0 + pm * 256 : ctx0 + (pm - nlat) * 256; } };

typedef f32x4 Acc[2][2][4][2];

struct Epi {
  int kind; bf16_t* O; int ldc; const float* modl; int slot; float wgt;
};
__device__ __forceinline__ void run_epi(const Ctx& cx, const Epi& E, const Acc& acc, int r0, int pn, int wr, int wc, int fr, int fq) {
  if (E.kind == 0) {
#pragma unroll
    for (int ai = 0; ai < 2; ++ai)
#pragma unroll
      for (int m = 0; m < 4; ++m) {
        bf16_t* rp = E.O + (size_t)(r0 + ai * HALF + wr * 64 + m * 16 + fr) * E.ldc + pn * 256 + wc * 32 + 4 * fq;
#pragma unroll
        for (int bj = 0; bj < 2; ++bj)
#pragma unroll
          for (int n = 0; n < 2; ++n) {
            f32x4 v = acc[ai][bj][m][n];
            u32x2 o; o.x = pk2(v[0], v[1]); o.y = pk2(v[2], v[3]);
            *(u32x2*)(rp + bj * HALF + n * 16) = o;
          }
      }
  } else if (E.kind == 1) {
#pragma unroll
    for (int ai = 0; ai < 2; ++ai)
#pragma unroll
      for (int m = 0; m < 4; ++m) {
        bf16_t* rp = E.O + (size_t)(r0 + ai * HALF + wr * 64 + m * 16 + fr) * FF + pn * 128 + wc * 16 + 4 * fq;
#pragma unroll
        for (int bj = 0; bj < 2; ++bj) {
          f32x4 g = acc[ai][bj][m][0], v = acc[ai][bj][m][1];
          u32x2 o; o.x = pk2(silu_f(g[0]) * v[0], silu_f(g[1]) * v[1]); o.y = pk2(silu_f(g[2]) * v[2], silu_f(g[3]) * v[3]);
          *(u32x2*)(rp + bj * 64) = o;
        }
      }
  } else {
    const int midx = r0 < NLAT ? (r0 >> 12) : 8;
    const float* gp = E.modl + (size_t)midx * 9216 + (3 * E.slot + 2) * D + pn * 256 + wc * 32 + 4 * fq;
    f32x4 gv[2][2];
#pragma unroll
    for (int bj = 0; bj < 2; ++bj)
#pragma unroll
      for (int n = 0; n < 2; ++n) gv[bj][n] = *(const f32x4*)(gp + bj * HALF + n * 16) * E.wgt;
#pragma unroll
    for (int ai = 0; ai < 2; ++ai)
#pragma unroll
      for (int m = 0; m < 4; ++m) {
        float* rp = hrow(cx, r0 + ai * HALF + wr * 64 + m * 16 + fr) + pn * 256 + wc * 32 + 4 * fq;
        f32x4 h[2][2];
#pragma unroll
        for (int bj = 0; bj < 2; ++bj)
#pragma unroll
          for (int n = 0; n < 2; ++n) h[bj][n] = *(const f32x4*)(rp + bj * HALF + n * 16);
#pragma unroll
        for (int bj = 0; bj < 2; ++bj)
#pragma unroll
          for (int n = 0; n < 2; ++n) *(f32x4*)(rp + bj * HALF + n * 16) = h[bj][n] * ALPHA + gv[bj][n] * acc[ai][bj][m][n];
        __builtin_amdgcn_sched_barrier(0);
      }
  }
}

#define LAS __attribute__((address_space(3)))
__device__ __forceinline__ void gemm_phase(const Ctx& cx, const bf16_t* __restrict__ A, RowMap am, const bf16_t* __restrict__ Bt, int K, int nM, int nN, RowMap cm, const Epi& epi) {
  LAS unsigned char* lds = (LAS unsigned char*)lds_raw;
  constexpr int HTB = HT * 2;
  const int tid = cx.tid, wid = tid >> 6, lane = tid & 63, wr = wid >> 2, wc = wid & 3, fr = lane & 15, fq = lane >> 4;
  unsigned voff[2];
#pragma unroll
  for (int i = 0; i < 2; ++i) { int R, C; stage_rc(tid * 16 + i * 8192, R, C); voff[i] = (unsigned)(R * K + C) * 2u; }
  const size_t kstep = (size_t)(BK * 2), hstep = (size_t)HALF * K * 2;
  const unsigned ldsw = (unsigned)wid * 1024u;
  const int aoff = lds_byte(wr * 64 + fr, fq * 8), boff = lds_byte(wc * 32 + fr, fq * 8);
#define G_SA(b, h) (((b) * 2 + (h)) * HTB)
#define G_SB(b, h) ((4 + (b) * 2 + (h)) * HTB)
#define STAGE(bufoff, gbase) do { _Pragma("unroll") for (int _i = 0; _i < 2; ++_i) \
    __builtin_amdgcn_global_load_lds((const unsigned*)((const char*)(gbase) + voff[_i]), (LAS unsigned*)(lds + (bufoff) + ldsw + _i * 8192), 16, 0, 0); } while (0)
#define LDA(dst, b, h) do { _Pragma("unroll") for (int m = 0; m < 4; ++m) _Pragma("unroll") for (int k = 0; k < 2; ++k) dst[m][k] = *(const LAS bf16x8*)(lds + G_SA(b, h) + aoff + m * 2048 + k * 1024); } while (0)
#define LDB(dst, b, h) do { _Pragma("unroll") for (int n = 0; n < 2; ++n) _Pragma("unroll") for (int k = 0; k < 2; ++k) dst[n][k] = *(const LAS bf16x8*)(lds + G_SB(b, h) + boff + n * 2048 + k * 1024); } while (0)
#define MMA(ai, bj, At, Bt_) do { __builtin_amdgcn_s_setprio(1); _Pragma("unroll") for (int m = 0; m < 4; ++m) _Pragma("unroll") for (int n = 0; n < 2; ++n) _Pragma("unroll") for (int k = 0; k < 2; ++k) \
      acc[ai][bj][m][n] = MFMA16(Bt_[n][k], At[m][k], acc[ai][bj][m][n]); \
    __builtin_amdgcn_s_setprio(0); } while (0)
#define WAIT_V(n) asm volatile("s_waitcnt vmcnt(" #n ")" ::: "memory")
#define WAIT_L(n) asm volatile("s_waitcnt lgkmcnt(" #n ")" ::: "memory")
#define BAR __builtin_amdgcn_s_barrier()
#define SCHED __builtin_amdgcn_sched_barrier(0)
  const int nwg = nM * nN;
  const int nt = K / BK;
  const int wid_s = __builtin_amdgcn_readfirstlane(wid);
#define DECODE(L_, pm_, pn_) do { int wgid = (L_); \
    { int q = nwg / NXCD, r = nwg % NXCD, xcd = wgid % NXCD, off = wgid / NXCD; wgid = (xcd < r ? xcd * (q + 1) : r * (q + 1) + (xcd - r) * q) + off; } \
    const int nig = WGM * nN, gid = wgid / nig, fm = gid * WGM, gsz = min(nM - fm, WGM); \
    pm_ = fm + ((wgid % nig) % gsz); pn_ = (wgid % nig) / gsz; } while (0)
  int L = cx.bid;
  if (L < nwg) {
    int pm, pn;
    DECODE(L, pm, pn);
    const char* cA = (const char*)A + (size_t)am.row0(pm) * K * 2; const char* cB = (const char*)Bt + (size_t)pn * BM * K * 2;
    Acc acc;
#pragma unroll
    for (int a = 0; a < 2; ++a)
#pragma unroll
      for (int b = 0; b < 2; ++b)
#pragma unroll
        for (int m = 0; m < 4; ++m)
#pragma unroll
          for (int n = 0; n < 2; ++n) acc[a][b][m][n] = (f32x4){0.f, 0.f, 0.f, 0.f};
    bf16x8 At[4][2], B0[2][2], B1[2][2];
    STAGE(G_SB(0, 0), cB); STAGE(G_SA(0, 0), cA); STAGE(G_SB(0, 1), cB + hstep); STAGE(G_SA(0, 1), cA + hstep);
    if (wr == 1) BAR;
    WAIT_V(4); BAR;
    STAGE(G_SB(1, 0), cB + kstep); STAGE(G_SA(1, 0), cA + kstep); STAGE(G_SB(1, 1), cB + hstep + kstep);
    WAIT_V(6); BAR;
    for (;;) {
      const int Ln = L + cx.nb;
      const bool has_next = Ln < nwg;
      int pmn = pm, pnn = pn;
      if (has_next) DECODE(Ln, pmn, pnn);
      const char* nA = has_next ? (const char*)A + (size_t)am.row0(pmn) * K * 2 : cA; const char* nB = has_next ? (const char*)Bt + (size_t)pnn * BM * K * 2 : cB;
      for (int t = 0; t < nt; t += 2) {
        const bool last = (t == nt - 2);
        const char* a1 = cA + (size_t)(t + 1) * kstep;
        const char* a2 = last ? nA : cA + (size_t)(t + 2) * kstep; const char* b2 = last ? nB : cB + (size_t)(t + 2) * kstep;
        const char* a3 = a2 + kstep; const char* b3 = b2 + kstep;
        LDB(B0, 0, 0); SCHED; LDA(At, 0, 0); STAGE(G_SA(1, 1), a1 + hstep);
        WAIT_L(8); BAR; WAIT_L(0); MMA(0, 0, At, B0); BAR; SCHED;
        LDB(B1, 0, 1); STAGE(G_SB(0, 0), b2);
        BAR; WAIT_L(0); MMA(0, 1, At, B1); BAR;
        LDA(At, 0, 1); STAGE(G_SA(0, 0), a2);
        BAR; WAIT_L(0); MMA(1, 0, At, B0); BAR; SCHED;
        STAGE(G_SB(0, 1), b2 + hstep);
        WAIT_V(6); BAR; MMA(1, 1, At, B1); BAR;
        LDB(B0, 1, 0); SCHED; LDA(At, 1, 0); STAGE(G_SA(0, 1), a2 + hstep);
        WAIT_L(8); BAR; WAIT_L(0); MMA(0, 0, At, B0); BAR; SCHED;
        LDB(B1, 1, 1); STAGE(G_SB(1, 0), b3);
        BAR; WAIT_L(0); MMA(0, 1, At, B1); BAR;
        LDA(At, 1, 1); STAGE(G_SA(1, 0), a3);
        BAR; WAIT_L(0); MMA(1, 0, At, B0); BAR; SCHED;
        STAGE(G_SB(1, 1), b3 + hstep);
        WAIT_V(6); BAR; MMA(1, 1, At, B1); BAR;
      }
      { int t2 = wid_s * 64 + (int)__builtin_amdgcn_mbcnt_hi(~0u, __builtin_amdgcn_mbcnt_lo(~0u, (unsigned)cx.z)); asm volatile("" : "+v"(t2));
        const int w2 = t2 >> 6, l2 = t2 & 63;
        run_epi(cx, epi, acc, cm.row0(pm), pn, w2 >> 2, w2 & 3, l2 & 15, l2 >> 4); }
      if (!has_next) break;
#pragma unroll
      for (int a = 0; a < 2; ++a)
#pragma unroll
        for (int b = 0; b < 2; ++b)
#pragma unroll
          for (int m = 0; m < 4; ++m)
#pragma unroll
            for (int n = 0; n < 2; ++n) acc[a][b][m][n] = (f32x4){0.f, 0.f, 0.f, 0.f};
      pm = pmn; pn = pnn; cA = nA; cB = nB; L = Ln;
    }
    WAIT_V(0);
    if (wr == 0) BAR;
    BAR;
  }
  __syncthreads();
}

template <int MODE>
__device__ __forceinline__ int wrow(int c) {
  if (MODE == 0) return c;
  const int isv = c >= FF ? 1 : 0, f = c - isv * FF;
  return (f >> 7) * 256 + ((f >> 6) & 1) * 128 + ((f >> 4) & 3) * 32 + isv * 16 + (f & 15);
}
template <int MODE>
__device__ __forceinline__ void transpose_item(const float* __restrict__ W, int K, int N, bf16_t* __restrict__ WT, float* scr, int item, int lane) {
  const int nblk = N / 32, kb = item / nblk, nb = item % nblk, k0 = 64 * kb, n0 = 32 * nb;
#pragma unroll 8
  for (int i = 0; i < 32; ++i) { const int kk = 2 * i + (lane >> 5); scr[kk * 33 + (lane & 31)] = W[(size_t)(k0 + kk) * N + n0 + (lane & 31)]; }
  __builtin_amdgcn_wave_barrier(); asm volatile("s_waitcnt lgkmcnt(0)" ::: "memory");
  const int c = lane & 7;
#pragma unroll
  for (int j = 0; j < 4; ++j) {
    const int n = (lane >> 3) + 8 * j; const float* s = scr + (8 * c) * 33 + n;
    u32x4 o; o.x = pk2(s[0 * 33], s[1 * 33]); o.y = pk2(s[2 * 33], s[3 * 33]); o.z = pk2(s[4 * 33], s[5 * 33]); o.w = pk2(s[6 * 33], s[7 * 33]);
    *(u32x4*)(WT + (size_t)wrow<MODE>(n0 + n) * K + k0 + 8 * c) = o;
  }
  asm volatile("s_waitcnt lgkmcnt(0)" ::: "memory"); __builtin_amdgcn_wave_barrier();
}

__device__ __forceinline__ void prologue(const Params& p, const Ctx& cx) {
  const int tid = cx.tid, lane = tid & 63, wave = tid >> 6;
  char* ws = cx.ws;
  {
    float* cond = (float*)lds_raw;
    float* red = (float*)(lds_raw + 9 * 1024 * 4);
    for (int i = tid; i < 9 * 1024; i += 512) { const int j = i >> 10, k = i & 1023; cond[i] = silu_f(j < 8 ? IN(1)[j * 1024 + k] : IN(3)[k]); }
    __syncthreads();
    for (int u = cx.bid; u < 4 * 36; u += cx.nb) {
      const int layer = u / 36, ct = u % 36, c0 = ct * 256 + 4 * lane;
      const float* wp = IN(4) + (size_t)layer * D * 9216 + c0;
      f32x4 a[9];
#pragma unroll
      for (int j = 0; j < 9; ++j) a[j] = (f32x4){0.f, 0.f, 0.f, 0.f};
#pragma unroll 4
      for (int k = wave * 128; k < wave * 128 + 128; ++k) {
        const f32x4 w = *(const f32x4*)(wp + (size_t)k * 9216);
#pragma unroll
        for (int j = 0; j < 9; ++j) a[j] += w * cond[j * 1024 + k];
      }
#pragma unroll
      for (int j = 0; j < 9; ++j) *(f32x4*)(red + (wave * 9 + j) * 256 + 4 * lane) = a[j];
      __syncthreads();
      float* mt = (float*)(ws + O_MODT) + (size_t)layer * 9 * 9216;
      for (int i = tid; i < 9 * 256; i += 512) {
        const int j = i >> 8, c = i & 255; float s = 0.f;
#pragma unroll
        for (int w = 0; w < 8; ++w) s += red[(w * 9 + j) * 256 + c];
        mt[(size_t)j * 9216 + ct * 256 + c] = s + IN(5)[layer * 9216 + ct * 256 + c];
      }
      __syncthreads();
    }
    __syncthreads();
  }
  {
    float* scr = (float*)lds_raw + wave * (64 * 33);
    const int gw = cx.bid * 8 + wave, NGW = cx.nb * 8;
    constexpr int I_FI = 16 * 176, I_FO = 44 * 32, I_UP = 16 * 128, I_DN = 32 * 32, I_AQ = 16 * 48, I_AO = 16 * 32, I_SI = 16 * 96, I_SO = 16 * 32;
    constexpr int NITEMS = 8 * I_FI + 8 * I_FO + 2 * I_UP + 2 * I_DN + I_AQ + I_AO + I_SI + I_SO;
    for (int it = gw; it < NITEMS; it += NGW) {
      int r = it;
      if (r < 8 * I_FI) { const int mi = r / I_FI; transpose_item<1>(IN(8) + (size_t)mi * 1024 * 5632, 1024, 5632, (bf16_t*)(ws + O_WFI) + (size_t)mi * 5632 * 1024, scr, r % I_FI, lane); continue; } r -= 8 * I_FI;
      if (r < 8 * I_FO) { const int mi = r / I_FO; transpose_item<0>(IN(9) + (size_t)mi * 2816 * 1024, 2816, 1024, (bf16_t*)(ws + O_WFO) + (size_t)mi * 1024 * 2816, scr, r % I_FO, lane); continue; } r -= 8 * I_FO;
      if (r < 2 * I_UP) { const int mi = r / I_UP; transpose_item<0>(IN(10) + (size_t)mi * 1024 * 4096, 1024, 4096, (bf16_t*)(ws + O_WUP) + (size_t)mi * 4096 * 1024, scr, r % I_UP, lane); continue; } r -= 2 * I_UP;
      if (r < 2 * I_DN) { const int mi = r / I_DN; transpose_item<0>(IN(18) + (size_t)mi * 2048 * 1024, 2048, 1024, (bf16_t*)(ws + O_WDN) + (size_t)mi * 1024 * 2048, scr, r % I_DN, lane); continue; } r -= 2 * I_DN;
      if (r < I_AQ) { transpose_item<0>(IN(19), 1024, 1536, (bf16_t*)(ws + O_WAQ), scr, r, lane); continue; } r -= I_AQ;
      if (r < I_AO) { transpose_item<0>(IN(21), 1024, 1024, (bf16_t*)(ws + O_WAO), scr, r, lane); continue; } r -= I_AO;
      if (r < I_SI) { transpose_item<0>(IN(22), 1024, 3072, (bf16_t*)(ws + O_WSI), scr, r, lane); continue; } r -= I_SI;
      transpose_item<0>(IN(24), 1024, 1024, (bf16_t*)(ws + O_WSO), scr, r, lane);
    }
  }
  {
    const int gt = cx.bid * 512 + tid, gs = cx.nb * 512;
    bf16_t* wg = (bf16_t*)(ws + O_WG);
    for (int i = gt; i < 2 * 16 * 6144; i += gs) {
      const int j = i / (16 * 6144), xg = (i / 6144) & 15, k = i % 6144, x = xg >> 3, g = xg & 7;
      const float* wif = IN(14) + (size_t)(j * 2 + x) * 6144 * 8;
      float v;
      if (k < 2048) v = wif[(size_t)k * 8 + g];
      else if (k < 4096) v = wif[(size_t)k * 8 + g] * 22.627416997969522f;
      else {
        const int c = k - 4096, blk = c >> 2, cc = c & 3;
        const float* wv = IN(13) + ((size_t)(j * 3 + 2) * 512 + blk) * 16 + cc * 4;
        v = 0.f;
        for (int d2 = 0; d2 < 4; ++d2) v += wv[d2] * wif[(size_t)(4096 + 4 * blk + d2) * 8 + g];
      }
      wg[i] = (bf16_t)(pk2(v, 0.f) & 0xffff);
    }
    float* rc = (float*)(ws + O_ROPE); float* rs = rc + 4096 * 32;
    for (int i = gt; i < 4096 * 32; i += gs) {
      const int pos = i >> 5, pp = i & 31, jf = pp & 15;
      const float fr_ = __builtin_amdgcn_exp2f(-(float)jf * (13.287712379549449f / 16.f));
      float rev = (float)(pp < 16 ? (pos >> 6) : (pos & 63)) * fr_ * 0.15915494309189535f;
      rev -= rintf(rev);
      rc[i] = __builtin_amdgcn_cosf(rev); rs[i] = __builtin_amdgcn_sinf(rev);
    }
  }
}

template <int MODE>
__device__ __forceinline__ void lnmod_phase(const Params& p, const Ctx& cx, int lnidx  , int layer, int slot) {
  const int lane = cx.tid & 63, gw = cx.bid * 8 + (cx.tid >> 6), NGW = cx.nb * 8;
  const int nrows = MODE == 2 ? NLAT : MROWS;
  const float* lg = IN(6) + (size_t)lnidx * D; const float* lb = IN(7) + (size_t)lnidx * D;
  const float* modl = (const float*)(cx.ws + O_MODT) + (size_t)layer * 9 * 9216;
  bf16_t* U = (bf16_t*)(cx.ws + O_U);
  for (int row = gw; row < nrows; row += NGW) {
    float* hp = hrow(cx, row);
    const float* src = MODE == 0 ? (row < NLAT ? IN(0) + (size_t)row * D : IN(2) + (size_t)(row - NLAT) * D) : hp;
    f32x4 v[4];
#pragma unroll
    for (int j = 0; j < 4; ++j) v[j] = *(const f32x4*)(src + 4 * lane + 256 * j);
    if (MODE != 0) {
      float s = 0.f;
#pragma unroll
      for (int j = 0; j < 4; ++j) s += (v[j][0] + v[j][1]) + (v[j][2] + v[j][3]);
      const float mean = wave_sum(s, lane) * (1.f / D); float s2 = 0.f;
#pragma unroll
      for (int j = 0; j < 4; ++j) { v[j] = v[j] - mean; s2 += (v[j][0] * v[j][0] + v[j][1] * v[j][1]) + (v[j][2] * v[j][2] + v[j][3] * v[j][3]); }
      const float rstd = __builtin_amdgcn_rsqf(wave_sum(s2, lane) * (1.f / D) + LN_EPS);
#pragma unroll
      for (int j = 0; j < 4; ++j) v[j] = v[j] * rstd * *(const f32x4*)(lg + 4 * lane + 256 * j) + *(const f32x4*)(lb + 4 * lane + 256 * j);
    }
#pragma unroll
    for (int j = 0; j < 4; ++j) *(f32x4*)(hp + 4 * lane + 256 * j) = v[j];
    if (MODE != 2) {
      const int midx = row < NLAT ? (row >> 12) : 8;
      const float* sh = modl + (size_t)midx * 9216 + (3 * slot) * D; const float* sc = sh + D;
#pragma unroll
      for (int j = 0; j < 4; ++j) {
        const f32x4 u = v[j] * (*(const f32x4*)(sc + 4 * lane + 256 * j) + 1.f) + *(const f32x4*)(sh + 4 * lane + 256 * j);
        u32x2 o; o.x = pk2(u[0], u[1]); o.y = pk2(u[2], u[3]);
        *(u32x2*)(U + (size_t)row * D + 4 * lane + 256 * j) = o;
      }
    }
  }
}

__device__ __forceinline__ int ml_lrow(int bl, int tok) { return tok < LC ? GB * SEQ + bl * LC + tok : bl * SEQ + (tok - LC); }
__device__ __forceinline__ int ml_nchunk(int x, int st) { return x == 0 ? st : (st < 4 ? 3 - st : 71 - st); }

__device__ __forceinline__ void ml_m0(const Params& p, const Ctx& cx, int j) {
  const int tid = cx.tid;
  char* ws = cx.ws;
  const bf16_t* XZ = (const bf16_t*)(ws + O_XZ);
  bf16_t* QK = (bf16_t*)(ws + O_QK); bf16_t* KT = (bf16_t*)(ws + O_KT); bf16_t* VT = (bf16_t*)(ws + O_VT);
  bf16_t* lk = (bf16_t*)lds_raw;
  bf16_t* lv = lk + 256 * 72;
  const int blk_l = tid & 63, tq = tid >> 6;
  for (int u = cx.bid; u < GB * NCH * 8; u += cx.nb) {
    const int slab = u & 7, ch = (u >> 3) % NCH, bl = u / (8 * NCH);
    const int f0 = slab * 256 + blk_l * 4, blk = f0 >> 2;
    float cw[3][4], cb[4], wq[16], wk[16], wv[16];
#pragma unroll
    for (int k = 0; k < 3; ++k)
#pragma unroll
      for (int c = 0; c < 4; ++c) cw[k][c] = IN(11)[(size_t)(j * 3 + k) * EI + f0 + c];
#pragma unroll
    for (int c = 0; c < 4; ++c) cb[c] = IN(12)[(size_t)j * EI + f0 + c];
#pragma unroll
    for (int i = 0; i < 16; ++i) {
      wq[i] = IN(13)[((size_t)(j * 3 + 0) * 512 + blk) * 16 + i];
      wk[i] = IN(13)[((size_t)(j * 3 + 1) * 512 + blk) * 16 + i] * 0.04419417382415922f;
      wv[i] = IN(13)[((size_t)(j * 3 + 2) * 512 + blk) * 16 + i];
    }
    const int tok0 = ch * 64, seg_lo = tok0 < LC ? 0 : LC, seg_hi = tok0 < LC ? LC : TOKB;
    for (int tt = 0; tt < 8; ++tt) {
      const int tl = tq + 8 * tt, tok = tok0 + tl;
      float xm[3][4];
#pragma unroll
      for (int k = 0; k < 3; ++k) {
        const int t2 = tok + k - 1;
        if (t2 >= seg_lo && t2 < seg_hi) {
          const u32x2 r = *(const u32x2*)(XZ + (size_t)ml_lrow(bl, t2) * 4096 + f0);
          xm[k][0] = bflo(r.x); xm[k][1] = bfhi(r.x); xm[k][2] = bflo(r.y); xm[k][3] = bfhi(r.y);
        } else { xm[k][0] = xm[k][1] = xm[k][2] = xm[k][3] = 0.f; }
      }
      float xc[4], q[4], kk[4], vv[4];
#pragma unroll
      for (int c = 0; c < 4; ++c) xc[c] = silu_f(cw[0][c] * xm[0][c] + cw[1][c] * xm[1][c] + cw[2][c] * xm[2][c] + cb[c]);
#pragma unroll
      for (int d2 = 0; d2 < 4; ++d2) {
        q[d2] = xc[0] * wq[d2] + xc[1] * wq[4 + d2] + xc[2] * wq[8 + d2] + xc[3] * wq[12 + d2];
        kk[d2] = xc[0] * wk[d2] + xc[1] * wk[4 + d2] + xc[2] * wk[8 + d2] + xc[3] * wk[12 + d2];
        vv[d2] = xm[1][0] * wv[d2] + xm[1][1] * wv[4 + d2] + xm[1][2] * wv[8 + d2] + xm[1][3] * wv[12 + d2];
      }
      const size_t lr = ml_lrow(bl, tok);
      u32x2 oq, ok, ov; oq.x = pk2(q[0], q[1]); oq.y = pk2(q[2], q[3]); ok.x = pk2(kk[0], kk[1]); ok.y = pk2(kk[2], kk[3]); ov.x = pk2(vv[0], vv[1]); ov.y = pk2(vv[2], vv[3]);
      *(u32x2*)(QK + lr * 4096 + f0) = oq;
      *(u32x2*)(QK + lr * 4096 + 2048 + f0) = ok;
      const int fl = blk_l * 4;
      lk[(fl + 0) * 72 + tl] = (bf16_t)(ok.x & 0xffff); lk[(fl + 1) * 72 + tl] = (bf16_t)(ok.x >> 16); lk[(fl + 2) * 72 + tl] = (bf16_t)(ok.y & 0xffff); lk[(fl + 3) * 72 + tl] = (bf16_t)(ok.y >> 16);
      lv[(fl + 0) * 72 + tl] = (bf16_t)(ov.x & 0xffff); lv[(fl + 1) * 72 + tl] = (bf16_t)(ov.x >> 16); lv[(fl + 2) * 72 + tl] = (bf16_t)(ov.y & 0xffff); lv[(fl + 3) * 72 + tl] = (bf16_t)(ov.y >> 16);
    }
    __syncthreads();
    {
      const int arr = tid >> 8, fr_ = tid & 255;
      const bf16_t* src = (arr ? lv : lk) + fr_ * 72;
      bf16_t* dst = (arr ? VT : KT) + ((size_t)bl * EI + slab * 256 + fr_) * TOKB + tok0;
#pragma unroll
      for (int i = 0; i < 8; ++i) *(u32x4*)(dst + 8 * i) = *(const u32x4*)(src + 8 * i);
    }
    __syncthreads();
  }
}

__device__ __forceinline__ void ml_gates(const Params& p, const Ctx& cx, int j) {
  const int tid = cx.tid, lane = tid & 63, wave = tid >> 6, fr = lane & 15, fq = lane >> 4;
  char* ws = cx.ws;
  const bf16_t* XZ = (const bf16_t*)(ws + O_XZ); const bf16_t* QK = (const bf16_t*)(ws + O_QK);
  const bf16_t* WG = (const bf16_t*)(ws + O_WG) + (size_t)j * 16 * 6144;
  float* BL = (float*)(ws + O_BL); float* IG = (float*)(ws + O_IG);
  float* GC = (float*)(ws + O_GC); float* AC = GC + NSEQ * NCH;
  float* part = (float*)lds_raw;
  float* gl = part + 8 * 64 * 16;
  for (int u = cx.bid; u < GB * NCH; u += cx.nb) {
    const int bl = u / NCH, nc = u % NCH, tok0 = nc * 64;
    f32x4 acc[4];
#pragma unroll
    for (int m = 0; m < 4; ++m) acc[m] = (f32x4){0.f, 0.f, 0.f, 0.f};
    size_t lr[4];
#pragma unroll
    for (int m = 0; m < 4; ++m) lr[m] = ml_lrow(bl, tok0 + m * 16 + fr);
#pragma unroll 4
    for (int ks = wave * 24; ks < wave * 24 + 24; ++ks) {
      const int k = ks * 32 + fq * 8;
      const bf16x8 bfr = *(const bf16x8*)(WG + (size_t)fr * 6144 + k);
#pragma unroll
      for (int m = 0; m < 4; ++m) {
        const bf16_t* ap = k < 4096 ? QK + lr[m] * 4096 + k : XZ + lr[m] * 4096 + (k - 4096);
        const bf16x8 afr = *(const bf16x8*)ap;
        acc[m] = MFMA16(afr, bfr, acc[m]);
      }
    }
#pragma unroll
    for (int m = 0; m < 4; ++m)
#pragma unroll
      for (int jj = 0; jj < 4; ++jj) part[(wave * 64 + m * 16 + 4 * fq + jj) * 16 + fr] = acc[m][jj];
    __syncthreads();
    for (int i = tid; i < 1024; i += 512) {
      float s = IN(15)[(size_t)j * 16 + (i & 15)];
#pragma unroll
      for (int w = 0; w < 8; ++w) s += part[w * 1024 + i];
      gl[(i >> 4) * 17 + (i & 15)] = s;
    }
    __syncthreads();
    if (tid < 8) {
      const int x = tid >> 2, h = tid & 3, seq = (bl * 2 + x) * 4 + h;
      float b = 0.f, mx = -3.0e38f;
      for (int pp = 0; pp < 64; ++pp) {
        const int tl = x == 0 ? pp : 63 - pp;
        const float ig = gl[tl * 17 + x * 8 + h], fg = gl[tl * 17 + x * 8 + 4 + h];
        const float lf = fg > 0.f ? -__logf(1.f + __expf(-fg)) : fg - __logf(1.f + __expf(fg));
        b += lf;
        BL[(size_t)seq * TOKB + tok0 + tl] = b; IG[(size_t)seq * TOKB + tok0 + tl] = ig;
        mx = fmaxf(mx, ig - b);
      }
      GC[seq * NCH + nc] = b; AC[seq * NCH + nc] = b + mx;
    }
    __syncthreads();
  }
}

__device__ __forceinline__ void ml_s(const Params& p, const Ctx& cx) {
  const int tid = cx.tid, lane = tid & 63, wave = tid >> 6, fr = lane & 15, fq = lane >> 4;
  char* ws = cx.ws;
  const bf16_t* QK = (const bf16_t*)(ws + O_QK);
  bf16_t* SP = (bf16_t*)(ws + O_SP);
  const float* BL = (const float*)(ws + O_BL); const float* IG = (const float*)(ws + O_IG);
  float* WIN = (float*)(ws + O_WIN); float* FLO = (float*)(ws + O_FLO); float* DEN = (float*)(ws + O_DEN); float* WSS = (float*)(ws + O_WSS);
  const float* GC = (const float*)(ws + O_GC); const float* AC = GC + NSEQ * NCH; float* DEC = (float*)(ws + O_GC) + 2 * NSEQ * NCH;
  float* sb_ = (float*)lds_raw; float* si_ = sb_ + 64; float* smt = si_ + 64; float* sden = smt + 64;
  for (int u = cx.bid; u < NSEQ * NCH; u += cx.nb) {
    const int seq = u / NCH, st = u % NCH, x = (seq >> 2) & 1, h = seq & 3, bl = seq >> 3;
    const int nc = ml_nchunk(x, st), tok0 = nc * 64;
    if (wave == 0) {
      const int nl0 = ml_nchunk(x, lane), nl1 = ml_nchunk(x, 64 + (lane & 3));
      const float g0 = GC[seq * NCH + nl0], a0 = AC[seq * NCH + nl0], g1 = GC[seq * NCH + nl1], a1 = AC[seq * NCH + nl1];
      float mc = 0.f;
      for (int s2 = 0; s2 < st; ++s2) {
        const float gg = __int_as_float(__builtin_amdgcn_readlane(__float_as_int(s2 < 64 ? g0 : g1), s2 & 63));
        const float aa = __int_as_float(__builtin_amdgcn_readlane(__float_as_int(s2 < 64 ? a0 : a1), s2 & 63));
        mc = fmaxf(gg + mc, aa);
      }
      const float gc = GC[seq * NCH + nc], ac = AC[seq * NCH + nc];
      const float mnew = fmaxf(gc + mc, ac);
      const int tl = x == 0 ? lane : 63 - lane;
      const float b = BL[(size_t)seq * TOKB + tok0 + tl], ig = IG[(size_t)seq * TOKB + tok0 + tl];
      float cm = ig - b;
#pragma unroll
      for (int o = 1; o < 64; o <<= 1) { const float t2 = shi(cm, lane - o); if (lane >= o) cm = fmaxf(cm, t2); }
      const float mt = b + fmaxf(mc, cm);
      sb_[tl] = b; si_[tl] = ig; smt[tl] = mt;
      WIN[(size_t)seq * TOKB + tok0 + tl] = __expf(b + mc - mt);
      FLO[(size_t)seq * TOKB + tok0 + tl] = __expf(-mt);
      WSS[(size_t)seq * TOKB + tok0 + tl] = __expf(gc - b + ig - mnew);
      if (lane == 0) DEC[seq * NCH + nc] = __expf(gc + mc - mnew);
    }
    __syncthreads();
    const int sbk = wave >> 1;
    const bf16_t* kp = QK + (size_t)ml_lrow(bl, tok0 + sbk * 16 + fr) * 4096 + 2048 + h * DH + fq * 8;
    const bf16_t* qp0 = QK + (size_t)ml_lrow(bl, tok0 + (2 * (wave & 1)) * 16 + fr) * 4096 + h * DH + fq * 8;
    const bf16_t* qp1 = QK + (size_t)ml_lrow(bl, tok0 + (2 * (wave & 1) + 1) * 16 + fr) * 4096 + h * DH + fq * 8;
    f32x4 a0 = {0.f, 0.f, 0.f, 0.f}, a1 = {0.f, 0.f, 0.f, 0.f};
#pragma unroll 4
    for (int ks = 0; ks < 16; ++ks) {
      const bf16x8 kf = *(const bf16x8*)(kp + ks * 32), q0 = *(const bf16x8*)(qp0 + ks * 32), q1 = *(const bf16x8*)(qp1 + ks * 32);
      a0 = MFMA16(kf, q0, a0); a1 = MFMA16(kf, q1, a1);
    }
    bf16_t* spu = SP + (size_t)(seq * NCH + nc) * 4096;
#pragma unroll
    for (int tbi = 0; tbi < 2; ++tbi) {
      const int t = (2 * (wave & 1) + tbi) * 16 + fr;
      const f32x4 a = tbi ? a1 : a0;
      const float bt = sb_[t], mt = smt[t];
      float vals[4];
#pragma unroll
      for (int jj = 0; jj < 4; ++jj) {
        const int s = sbk * 16 + 4 * fq + jj;
        const bool ok = x == 0 ? (s <= t) : (s >= t);
        vals[jj] = ok ? a[jj] * __expf(bt - sb_[s] + si_[s] - mt) : 0.f;
      }
      u32x2 o; o.x = pk2(vals[0], vals[1]); o.y = pk2(vals[2], vals[3]);
      *(u32x2*)(spu + t * 64 + sbk * 16 + 4 * fq) = o;
      float ds = (bflo(o.x) + bfhi(o.x)) + (bflo(o.y) + bfhi(o.y));
      ds += shx(ds, 16, lane); ds += shx(ds, 32, lane);
      if (fq == 0) sden[sbk * 64 + t] = ds;
    }
    __syncthreads();
    if (tid < 64) DEN[(size_t)seq * TOKB + tok0 + tid] = (sden[tid] + sden[64 + tid]) + (sden[128 + tid] + sden[192 + tid]);
    __syncthreads();
  }
}

constexpr int NEB = 2, NSL = 512 / (16 * NEB);
__device__ __forceinline__ void ml_m2(const Params& p, const Ctx& cx) {
  const int tid = cx.tid, lane = tid & 63, wave = tid >> 6, fr = lane & 15, fq = lane >> 4;
  char* ws = cx.ws;
  const bf16_t* QK = (const bf16_t*)(ws + O_QK); const bf16_t* KT = (const bf16_t*)(ws + O_KT); const bf16_t* VT = (const bf16_t*)(ws + O_VT);
  const bf16_t* SP = (const bf16_t*)(ws + O_SP);
  bf16_t* HD = (bf16_t*)(ws + O_HD);
  const float* WIN = (const float*)(ws + O_WIN); const float* FLO = (const float*)(ws + O_FLO); const float* DEN = (const float*)(ws + O_DEN); const float* WSS = (const float*)(ws + O_WSS);
  const float* DEC = (const float*)(ws + O_GC) + 2 * NSEQ * NCH;
  f32x4* red = (f32x4*)lds_raw;
  f32x4* rn = (f32x4*)(lds_raw + 131072);
  for (int idx = cx.bid >> 3; idx < 2 * NSL; idx += cx.nb >> 3) {
    const int seq = (cx.bid & 7) * 2 + idx / NSL, es = idx % NSL, x = (seq >> 2) & 1, h = seq & 3, bl = seq >> 3;
    const int d0 = wave * 64, e0 = es * 16 * NEB;
    f32x4 C[4][NEB + 1];
#pragma unroll
    for (int a = 0; a < 4; ++a)
#pragma unroll
      for (int b = 0; b < NEB + 1; ++b) C[a][b] = (f32x4){0.f, 0.f, 0.f, 0.f};
    const int tbo = wave >> 1, ebo = __builtin_amdgcn_readfirstlane(wave & 1);
    bf16x8 qc[4][2], kf[4][2], sf0, sf1;
    u32x4 vr[NEB][2];
    f32x4 wv[2][2];
#define M2_LOAD_Q(ST) do { const int _t0 = ml_nchunk(x, (ST)) * 64; _Pragma("unroll") for (int tb = 0; tb < 4; ++tb) { \
        const bf16_t* qp = QK + (size_t)ml_lrow(bl, _t0 + tb * 16 + fr) * 4096 + h * DH + d0 + 4 * fq; \
        qc[tb][0] = mk8(*(const u32x2*)(qp), *(const u32x2*)(qp + 16)); qc[tb][1] = mk8(*(const u32x2*)(qp + 32), *(const u32x2*)(qp + 48)); } } while (0)
#define M2_LOAD_KV(ST) do { const int _nc = ml_nchunk(x, (ST)), _t0 = _nc * 64; \
        _Pragma("unroll") for (int db = 0; db < 4; ++db) { const bf16_t* kp = KT + ((size_t)bl * EI + h * DH + d0 + db * 16 + fr) * TOKB + _t0 + 8 * fq; \
          kf[db][0] = *(const bf16x8*)kp; kf[db][1] = *(const bf16x8*)(kp + 32); } \
        _Pragma("unroll") for (int eb = 0; eb < NEB; ++eb) { const bf16_t* vp = VT + ((size_t)bl * EI + h * DH + e0 + eb * 16 + fr) * TOKB + _t0 + 8 * fq; \
          vr[eb][0] = *(const u32x4*)vp; vr[eb][1] = *(const u32x4*)(vp + 32); } \
        _Pragma("unroll") for (int ks = 0; ks < 2; ++ks) { const float* wp = WSS + (size_t)seq * TOKB + _t0 + 32 * ks + 8 * fq; \
          wv[ks][0] = *(const f32x4*)wp; wv[ks][1] = *(const f32x4*)(wp + 4); } \
        const bf16_t* sp = SP + (size_t)(seq * NCH + _nc) * 4096 + (tbo * 16 + fr) * 64 + 8 * fq; \
        sf0 = *(const bf16x8*)sp; sf1 = *(const bf16x8*)(sp + 32); } while (0)
    M2_LOAD_Q(0); M2_LOAD_KV(0);
    for (int st = 0; st < NCH; ++st) {
      const int nc = ml_nchunk(x, st), tok0 = nc * 64, stn = st + 1 < NCH ? st + 1 : st;
      const size_t tix = (size_t)seq * TOKB + tok0 + tbo * 16 + 4 * fq;
      const f32x4 win = *(const f32x4*)(WIN + tix), flo = *(const f32x4*)(FLO + tix), deni = *(const f32x4*)(DEN + tix);
      const float decay = DEC[seq * NCH + nc];
#pragma unroll
      for (int eb = 0; eb < NEB + 1; ++eb) {
        bf16x8 cb0, cb1;
        { const f32x4 lo = C[0][eb], hi = C[1][eb]; cb0 = mk8((u32x4){pk2(lo[0], lo[1]), pk2(lo[2], lo[3]), pk2(hi[0], hi[1]), pk2(hi[2], hi[3])}); }
        { const f32x4 lo = C[2][eb], hi = C[3][eb]; cb1 = mk8((u32x4){pk2(lo[0], lo[1]), pk2(lo[2], lo[3]), pk2(hi[0], hi[1]), pk2(hi[2], hi[3])}); }
        f32x4 pa[4];
#pragma unroll
        for (int tb = 0; tb < 4; ++tb) pa[tb] = MFMA16(qc[tb][0], cb0, ((f32x4){0.f, 0.f, 0.f, 0.f}));
#pragma unroll
        for (int tb = 0; tb < 4; ++tb) pa[tb] = MFMA16(qc[tb][1], cb1, pa[tb]);
#pragma unroll
        for (int tb = 0; tb < 4; ++tb) {
          if (eb < NEB) red[((wave * 4 + tb) * NEB + eb) * 64 + lane] = pa[tb];
          else if (fr == 0) rn[(wave * 4 + tb) * 4 + fq] = pa[tb];
        }
      }
      M2_LOAD_Q(stn);
      f32x4 oi = {0.f, 0.f, 0.f, 0.f};
#pragma unroll
      for (int eb = 0; eb < NEB + 1; ++eb) {
        bf16x8 vw0, vw1;
        if (eb < NEB) {
          const u32x4 r0 = vr[eb][0], r1 = vr[eb][1];
          if (eb == ebo) { oi = MFMA16(sf0, mk8(r0), oi); oi = MFMA16(sf1, mk8(r1), oi); }
          vw0 = mk8((u32x4){pk2(bflo(r0.x) * wv[0][0][0], bfhi(r0.x) * wv[0][0][1]), pk2(bflo(r0.y) * wv[0][0][2], bfhi(r0.y) * wv[0][0][3]),
                            pk2(bflo(r0.z) * wv[0][1][0], bfhi(r0.z) * wv[0][1][1]), pk2(bflo(r0.w) * wv[0][1][2], bfhi(r0.w) * wv[0][1][3])});
          vw1 = mk8((u32x4){pk2(bflo(r1.x) * wv[1][0][0], bfhi(r1.x) * wv[1][0][1]), pk2(bflo(r1.y) * wv[1][0][2], bfhi(r1.y) * wv[1][0][3]),
                            pk2(bflo(r1.z) * wv[1][1][0], bfhi(r1.z) * wv[1][1][1]), pk2(bflo(r1.w) * wv[1][1][2], bfhi(r1.w) * wv[1][1][3])});
        } else {
          vw0 = mk8((u32x4){pk2(wv[0][0][0], wv[0][0][1]), pk2(wv[0][0][2], wv[0][0][3]), pk2(wv[0][1][0], wv[0][1][1]), pk2(wv[0][1][2], wv[0][1][3])});
          vw1 = mk8((u32x4){pk2(wv[1][0][0], wv[1][0][1]), pk2(wv[1][0][2], wv[1][0][3]), pk2(wv[1][1][0], wv[1][1][1]), pk2(wv[1][1][2], wv[1][1][3])});
        }
#pragma unroll
        for (int db = 0; db < 4; ++db) {
          f32x4 c = C[db][eb] * decay;
          c = MFMA16(kf[db][0], vw0, c); c = MFMA16(kf[db][1], vw1, c);
          C[db][eb] = c;
        }
      }
      asm volatile("s_waitcnt lgkmcnt(0)" ::: "memory");
      __builtin_amdgcn_s_barrier();
      asm volatile("" ::: "memory");
      f32x4 rdn[8], rd0[8];
#pragma unroll
      for (int w = 0; w < 8; ++w) { rdn[w] = rn[(w * 4 + tbo) * 4 + fq]; rd0[w] = red[((w * 4 + tbo) * NEB + ebo) * 64 + lane]; }
      const f32x4 pn = ((rdn[0] + rdn[1]) + (rdn[2] + rdn[3])) + ((rdn[4] + rdn[5]) + (rdn[6] + rdn[7]));
      const f32x4 pi = ((rd0[0] + rd0[1]) + (rd0[2] + rd0[3])) + ((rd0[4] + rd0[5]) + (rd0[6] + rd0[7]));
#pragma unroll
      for (int jj = 0; jj < 4; ++jj) {
        const float num = oi[jj] + win[jj] * pi[jj], den = deni[jj] + win[jj] * pn[jj];
        const float hv = num * __builtin_amdgcn_rcpf(fmaxf(fabsf(den), flo[jj]));
        HD[((size_t)x * RG + ml_lrow(bl, tok0 + tbo * 16 + 4 * fq + jj)) * EI + h * DH + e0 + ebo * 16 + fr] = (bf16_t)(pk2(hv, 0.f) & 0xffff);
      }
      M2_LOAD_KV(stn);
      asm volatile("s_waitcnt lgkmcnt(0)" ::: "memory");
      __builtin_amdgcn_s_barrier();
      asm volatile("" ::: "memory");
    }
    __syncthreads();
#undef M2_LOAD_Q
#undef M2_LOAD_KV
  }
}

__device__ __forceinline__ void ml_fin(const Params& p, const Ctx& cx, int j) {
  const int lane = cx.tid & 63, gw = cx.bid * 8 + (cx.tid >> 6), NGW = cx.nb * 8;
  char* ws = cx.ws;
  const bf16_t* XZ = (const bf16_t*)(ws + O_XZ); const bf16_t* HD = (const bf16_t*)(ws + O_HD);
  bf16_t* FIN = (bf16_t*)(ws + O_FIN);
  for (int u = gw; u < RG * 4; u += NGW) {
    const int lr = u >> 2, h = u & 3, f0 = h * DH + lane * 8;
    int pos, seglen;
    if (lr < GB * SEQ) { pos = lr & (SEQ - 1); seglen = SEQ; } else { pos = (lr - GB * SEQ) & (LC - 1); seglen = LC; }
    const u32x4 hf = *(const u32x4*)(HD + (size_t)lr * EI + f0), hb = *(const u32x4*)(HD + ((size_t)RG + lr) * EI + f0);
    const u32x4 zz = *(const u32x4*)(XZ + (size_t)lr * 4096 + 2048 + f0);
    const u32x4 x1 = *(const u32x4*)(XZ + (size_t)lr * 4096 + f0);
    u32x4 x0 = {0u, 0u, 0u, 0u}, x2 = {0u, 0u, 0u, 0u};
    if (pos > 0) x0 = *(const u32x4*)(XZ + (size_t)(lr - 1) * 4096 + f0);
    if (pos < seglen - 1) x2 = *(const u32x4*)(XZ + (size_t)(lr + 1) * 4096 + f0);
    float hv[8], xm0[8], xm1[8], xm2[8];
    const unsigned hfu[4] = {hf.x, hf.y, hf.z, hf.w}, hbu[4] = {hb.x, hb.y, hb.z, hb.w}, zu[4] = {zz.x, zz.y, zz.z, zz.w};
    const unsigned x0u[4] = {x0.x, x0.y, x0.z, x0.w}, x1u[4] = {x1.x, x1.y, x1.z, x1.w}, x2u[4] = {x2.x, x2.y, x2.z, x2.w};
    float s = 0.f;
#pragma unroll
    for (int i = 0; i < 4; ++i) {
      hv[2 * i] = (bflo(hfu[i]) + bflo(hbu[i])) * sigm_f(bflo(zu[i]));
      hv[2 * i + 1] = (bfhi(hfu[i]) + bfhi(hbu[i])) * sigm_f(bfhi(zu[i]));
      xm0[2 * i] = bflo(x0u[i]); xm0[2 * i + 1] = bfhi(x0u[i]); xm1[2 * i] = bflo(x1u[i]); xm1[2 * i + 1] = bfhi(x1u[i]); xm2[2 * i] = bflo(x2u[i]); xm2[2 * i + 1] = bfhi(x2u[i]);
      s += hv[2 * i] + hv[2 * i + 1];
    }
    const float mean = wave_sum(s, lane) * (1.f / DH); float s2 = 0.f;
#pragma unroll
    for (int i = 0; i < 8; ++i) { hv[i] -= mean; s2 += hv[i] * hv[i]; }
    const float rstd = __builtin_amdgcn_rsqf(wave_sum(s2, lane) * (1.f / DH) + LN_EPS);
    float o[8];
#pragma unroll
    for (int i = 0; i < 8; ++i) {
      const int f = f0 + i;
      const float xc = silu_f(IN(11)[(size_t)(j * 3 + 0) * EI + f] * xm0[i] + IN(11)[(size_t)(j * 3 + 1) * EI + f] * xm1[i] + IN(11)[(size_t)(j * 3 + 2) * EI + f] * xm2[i] + IN(12)[(size_t)j * EI + f]);
      o[i] = hv[i] * rstd * IN(17)[(size_t)j * EI + f] + IN(16)[(size_t)j * EI + f] * xc;
    }
    u32x4 ov; ov.x = pk2(o[0], o[1]); ov.y = pk2(o[2], o[3]); ov.z = pk2(o[4], o[5]); ov.w = pk2(o[6], o[7]);
    *(u32x4*)(FIN + (size_t)lr * EI + f0) = ov;
  }
}

__device__ __forceinline__ void at_prep(const Params& p, const Ctx& cx) {
  const int lane = cx.tid & 63, gw = cx.bid * 8 + (cx.tid >> 6), NGW = cx.nb * 8;
  char* ws = cx.ws;
  bf16_t* ACT = (bf16_t*)(ws + O_ACT); bf16_t* KR = (bf16_t*)(ws + O_AKR); bf16_t* VT = (bf16_t*)(ws + O_AVT);
  const float* rc = (const float*)(ws + O_ROPE); const float* rs = rc + 4096 * 32;
  for (int row = gw; row < MROWS; row += NGW) {
    const bool lat = row < NLAT;
    const int b = lat ? row >> 12 : (row - NLAT) >> 8, pos = lat ? row & 4095 : (row - NLAT) & 255, tok = lat ? LC + pos : pos;
    bf16_t* rp = ACT + (size_t)row * 1536;
    {
      const u32x4 a = *(const u32x4*)(rp + 16 * lane), b2 = *(const u32x4*)(rp + 16 * lane + 8);
      const unsigned w[8] = {a.x, a.y, a.z, a.w, b2.x, b2.y, b2.z, b2.w};
      unsigned o[8];
      const int pp0 = (lane & 3) * 8;
#pragma unroll
      for (int i = 0; i < 8; ++i) {
        float x1 = bflo(w[i]) * 0.125f, x2 = bfhi(w[i]) * 0.125f;
        if (lat) { const float c = rc[pos * 32 + pp0 + i], s = rs[pos * 32 + pp0 + i]; const float y1 = x1 * c - x2 * s, y2 = x1 * s + x2 * c; x1 = y1; x2 = y2; }
        o[i] = pk2(x1, x2);
      }
      *(u32x4*)(rp + 16 * lane) = (u32x4){o[0], o[1], o[2], o[3]}; *(u32x4*)(rp + 16 * lane + 8) = (u32x4){o[4], o[5], o[6], o[7]};
    }
    {
      const u32x2 a = *(const u32x2*)(rp + 1024 + 4 * lane);
      const unsigned w[2] = {a.x, a.y}; unsigned o[2];
      const int g = lane >> 4, dd = (lane & 15) * 4, pp0 = dd >> 1;
#pragma unroll
      for (int i = 0; i < 2; ++i) {
        float x1 = bflo(w[i]), x2 = bfhi(w[i]);
        if (lat) { const float c = rc[pos * 32 + pp0 + i], s = rs[pos * 32 + pp0 + i]; const float y1 = x1 * c - x2 * s, y2 = x1 * s + x2 * c; x1 = y1; x2 = y2; }
        o[i] = pk2(x1, x2);
      }
      *(u32x2*)(KR + (((size_t)b * 4 + g) * TOKB + tok) * 64 + dd) = (u32x2){o[0], o[1]};
      const u32x2 v = *(const u32x2*)(rp + 1280 + 4 * lane);
      bf16_t* vp = VT + (((size_t)b * 4 + g) * 64 + dd) * TOKB + tok;
      vp[0] = (bf16_t)(v.x & 0xffff); vp[TOKB] = (bf16_t)(v.x >> 16); vp[2 * TOKB] = (bf16_t)(v.y & 0xffff); vp[3 * TOKB] = (bf16_t)(v.y >> 16);
    }
  }
}

__device__ __forceinline__ void at_core(const Params& p, const Ctx& cx) {
  const int lane = cx.tid & 63, gw = cx.bid * 8 + (cx.tid >> 6), NGW = cx.nb * 8, fr = lane & 15, fq = lane >> 4;
  char* ws = cx.ws;
  const bf16_t* ACT = (const bf16_t*)(ws + O_ACT); const bf16_t* KR = (const bf16_t*)(ws + O_AKR); const bf16_t* VT = (const bf16_t*)(ws + O_AVT);
  bf16_t* O = (bf16_t*)(ws + O_U);
  for (int u = gw; u < (MROWS / 16) * 4; u += NGW) {
    const int g = u & 3, qb = u >> 2, row0 = qb * 16;
    const bool lat = row0 < NLAT;
    const int b = lat ? row0 >> 12 : (row0 - NLAT) >> 8, q0 = lat ? row0 & 4095 : 0;
    bf16x8 qf[4][2];
    float mrun[4], lrun[4], sink[4];
    f32x4 oacc[4][4];
#pragma unroll
    for (int hh = 0; hh < 4; ++hh) {
      const bf16_t* qp = ACT + (size_t)(row0 + fr) * 1536 + (g * 4 + hh) * 64 + 8 * fq;
      qf[hh][0] = *(const bf16x8*)qp; qf[hh][1] = *(const bf16x8*)(qp + 32);
      sink[hh] = IN(20)[g * 4 + hh]; mrun[hh] = sink[hh]; lrun[hh] = 0.f;
#pragma unroll
      for (int d2 = 0; d2 < 4; ++d2) oacc[hh][d2] = (f32x4){0.f, 0.f, 0.f, 0.f};
    }
    const bf16_t* kbase = KR + ((size_t)b * 4 + g) * TOKB * 64;
    const bf16_t* vbase = VT + ((size_t)b * 4 + g) * 64 * TOKB;
    int wlo = 0, whi = -1;
    if (lat) { wlo = max(0, q0 - 128) & ~31; whi = min(SEQ - 1, q0 + 143); }
    const int nwin = lat ? (whi - wlo) / 32 + 1 : 0;
    for (int ti = 0; ti < 8 + nwin; ++ti) {
      const bool isw = ti >= 8;
      const int kpos0 = isw ? wlo + (ti - 8) * 32 : 0;
      const int tk0 = isw ? LC + kpos0 : ti * 32;
      const bf16_t* kp = kbase + (size_t)(tk0 + fr) * 64 + 8 * fq;
      const bf16x8 k00 = *(const bf16x8*)kp, k01 = *(const bf16x8*)(kp + 32), k10 = *(const bf16x8*)(kp + 16 * 64), k11 = *(const bf16x8*)(kp + 16 * 64 + 32);
      bf16x8 vfr[4];
#pragma unroll
      for (int d2 = 0; d2 < 4; ++d2) {
        const bf16_t* vp = vbase + (size_t)(d2 * 16 + fr) * TOKB + tk0 + 4 * fq;
        vfr[d2] = mk8(*(const u32x2*)vp, *(const u32x2*)(vp + 16));
      }
      bool okm[8];
#pragma unroll
      for (int i = 0; i < 8; ++i) {
        const int kpos = kpos0 + (i >> 2) * 16 + 4 * fq + (i & 3), dlt = (q0 + fr) - kpos;
        okm[i] = !isw || (dlt <= 128 && dlt >= -128);
      }
#pragma unroll
      for (int hh = 0; hh < 4; ++hh) {
        f32x4 s0 = {0.f, 0.f, 0.f, 0.f}, s1 = {0.f, 0.f, 0.f, 0.f};
        s0 = MFMA16(k00, qf[hh][0], s0); s0 = MFMA16(k01, qf[hh][1], s0);
        s1 = MFMA16(k10, qf[hh][0], s1); s1 = MFMA16(k11, qf[hh][1], s1);
        float sv[8]; float tmax = -3.0e38f;
#pragma unroll
        for (int i = 0; i < 8; ++i) { sv[i] = okm[i] ? (i < 4 ? s0[i] : s1[i - 4]) : -3.0e38f; tmax = fmaxf(tmax, sv[i]); }
        tmax = fmaxf(tmax, shx(tmax, 16, lane)); tmax = fmaxf(tmax, shx(tmax, 32, lane));
        const float mnew = fmaxf(mrun[hh], tmax), scale = __expf(mrun[hh] - mnew);
        mrun[hh] = mnew;
        float pv[8];
#pragma unroll
        for (int i = 0; i < 8; ++i) pv[i] = okm[i] ? __expf(sv[i] - mnew) : 0.f;
        const u32x4 pu = {pk2(pv[0], pv[1]), pk2(pv[2], pv[3]), pk2(pv[4], pv[5]), pk2(pv[6], pv[7])};
        const float ps = ((bflo(pu.x) + bfhi(pu.x)) + (bflo(pu.y) + bfhi(pu.y))) + ((bflo(pu.z) + bfhi(pu.z)) + (bflo(pu.w) + bfhi(pu.w)));
        lrun[hh] = lrun[hh] * scale + ps;
        const bf16x8 pf = mk8(pu);
        float scq[4];
#pragma unroll
        for (int jj = 0; jj < 4; ++jj) scq[jj] = shi(scale, 4 * fq + jj);
#pragma unroll
        for (int d2 = 0; d2 < 4; ++d2) {
          f32x4 o = oacc[hh][d2];
          o[0] *= scq[0]; o[1] *= scq[1]; o[2] *= scq[2]; o[3] *= scq[3];
          oacc[hh][d2] = MFMA16(pf, vfr[d2], o);
        }
      }
    }
#pragma unroll
    for (int hh = 0; hh < 4; ++hh) {
      float l = lrun[hh];
      l += shx(l, 16, lane); l += shx(l, 32, lane);
      l += __expf(sink[hh] - mrun[hh]);
      const float inv = __builtin_amdgcn_rcpf(l);
      float iq[4];
#pragma unroll
      for (int jj = 0; jj < 4; ++jj) iq[jj] = shi(inv, 4 * fq + jj);
#pragma unroll
      for (int d2 = 0; d2 < 4; ++d2)
#pragma unroll
        for (int jj = 0; jj < 4; ++jj)
          O[(size_t)(row0 + 4 * fq + jj) * D + (g * 4 + hh) * 64 + d2 * 16 + fr] = (bf16_t)(pk2(oacc[hh][d2][jj] * iq[jj], 0.f) & 0xffff);
    }
  }
}

__device__ __forceinline__ void sc_conv(const Params& p, const Ctx& cx) {
  const int gt = cx.bid * 512 + cx.tid, gs = cx.nb * 512;
  const bf16_t* ACT = (const bf16_t*)(cx.ws + O_ACT); bf16_t* O = (bf16_t*)(cx.ws + O_U);
  const float* cw = IN(23);
  for (int i = gt; i < MROWS * 128; i += gs) {
    const int row = i >> 7, c0 = (i & 127) * 8;
    int pos, seglen;
    if (row < NLAT) { pos = row & (SEQ - 1); seglen = SEQ; } else { pos = (row - NLAT) & (LC - 1); seglen = LC; }
    float accv[8];
#pragma unroll
    for (int e = 0; e < 8; ++e) accv[e] = 0.f;
#pragma unroll
    for (int k = 0; k < 3; ++k) {
      const int pp = pos + k - 1;
      if (pp < 0 || pp >= seglen) continue;
      const bf16_t* rp = ACT + (size_t)(row + k - 1) * 3072;
      const u32x4 cgv = *(const u32x4*)(rp + 1024 + c0), xtv = *(const u32x4*)(rp + 2048 + c0);
      const unsigned cu[4] = {cgv.x, cgv.y, cgv.z, cgv.w}, xu[4] = {xtv.x, xtv.y, xtv.z, xtv.w};
#pragma unroll
      for (int e = 0; e < 4; ++e) {
        accv[2 * e] += cw[k * D + c0 + 2 * e] * (bflo(cu[e]) * bflo(xu[e]));
        accv[2 * e + 1] += cw[k * D + c0 + 2 * e + 1] * (bfhi(cu[e]) * bfhi(xu[e]));
      }
    }
    const u32x4 bgv = *(const u32x4*)(ACT + (size_t)row * 3072 + c0);
    const unsigned bu[4] = {bgv.x, bgv.y, bgv.z, bgv.w};
    u32x4 o;
    o.x = pk2(bflo(bu[0]) * accv[0], bfhi(bu[0]) * accv[1]); o.y = pk2(bflo(bu[1]) * accv[2], bfhi(bu[1]) * accv[3]);
    o.z = pk2(bflo(bu[2]) * accv[4], bfhi(bu[2]) * accv[5]); o.w = pk2(bflo(bu[3]) * accv[6], bfhi(bu[3]) * accv[7]);
    *(u32x4*)(O + (size_t)row * D + c0) = o;
  }
}

#define XB_TMO      128
#define XB_XCNT(j)  (256  + 64 * (j))
#define XB_XSUB(j)  (1280 + 64 * (j))
#define XB_XGEN(j)  (2304 + 64 * (j))
#define XB_TOP      3328
#define XB_TOPGEN   3392
#define XCD_BAR_WORDS 3456
#define XB_SPIN_CAP (1u << 18)
__device__ __forceinline__ unsigned xb_ld(unsigned* p)              { return __hip_atomic_load(p, __ATOMIC_RELAXED, __HIP_MEMORY_SCOPE_AGENT); }
__device__ __forceinline__ unsigned xb_add(unsigned* p, unsigned v) { return __hip_atomic_fetch_add(p, v, __ATOMIC_RELAXED, __HIP_MEMORY_SCOPE_AGENT); }
__device__ __forceinline__ unsigned xb_xcc_id() { return (unsigned)__builtin_amdgcn_s_getreg((3 << 11) | 20) & 0xFu; }
#define XB_SPIN(cond, bar) do { unsigned _sp = 0; while (cond) { __builtin_amdgcn_s_sleep(1); \
    if ((++_sp & 255u) == 0u) { if (xb_ld(&(bar)[XB_TMO])) break; if (_sp > XB_SPIN_CAP) { atomicAdd(&(bar)[XB_TMO], 1u); break; } } } } while (0)
__device__ __forceinline__ void xcd_barrier_complete(unsigned* bar, unsigned x, unsigned& nloc, unsigned& nx) {
  const unsigned G = gridDim.x;
  unsigned sum, cnt, mine, sp = 0u;
  for (;;) {
    sum = 0u; cnt = 0u; mine = 0u;
#pragma unroll
    for (unsigned j = 0; j < 16; ++j) { const unsigned c = xb_ld(&bar[XB_XCNT(j)]); sum += c; cnt += (c > 0u) ? 1u : 0u; mine = (j == x) ? c : mine; }
    if (sum == G) break;
    __builtin_amdgcn_s_sleep(1);
    if ((++sp & 255u) == 0u) { if (xb_ld(&bar[XB_TMO])) break; if (sp > XB_SPIN_CAP) { atomicAdd(&bar[XB_TMO], 1u); break; } }
  }
  nloc = mine > 0u ? mine : 1u; nx = cnt > 0u ? cnt : 1u;
}
__device__ __forceinline__ void xcd_barrier(unsigned* bar, unsigned x, volatile LAS unsigned* st) {
  asm volatile("s_waitcnt vmcnt(0)" ::: "memory");
  __syncthreads();
  if (threadIdx.x == 0) {
    __builtin_amdgcn_s_waitcnt(0);
    unsigned nloc = st[0], nx = st[1];
    if (nloc == 0u) { xcd_barrier_complete(bar, x, nloc, nx); st[0] = nloc; st[1] = nx; }
    const unsigned old = xb_add(&bar[XB_XSUB(x)], 1u);
    const unsigned gen = old / nloc;
    if (old + 1u == (gen + 1u) * nloc) {
      __builtin_amdgcn_fence(__ATOMIC_RELEASE, "agent");
      asm volatile("s_waitcnt vmcnt(0)" ::: "memory");
      const unsigned og = xb_add(&bar[XB_TOP], 1u);
      const unsigned tg = og / nx;
      if (og + 1u == (tg + 1u) * nx) xb_add(&bar[XB_TOPGEN], 1u);
      else XB_SPIN(xb_ld(&bar[XB_TOPGEN]) == tg, bar);
      __builtin_amdgcn_fence(__ATOMIC_ACQUIRE, "agent");
      xb_add(&bar[XB_XGEN(x)], 1u);
      asm volatile("s_waitcnt vmcnt(0)" ::: "memory");
    } else {
      XB_SPIN(xb_ld(&bar[XB_XGEN(x)]) == gen, bar);
      __builtin_amdgcn_fence(__ATOMIC_ACQUIRE, "agent");
      asm volatile("s_waitcnt vmcnt(0)" ::: "memory");
    }
  }
  __syncthreads();
}

#ifndef ENMASK
#define ENMASK 0xffff
#endif
#define EN(i) ((ENMASK >> (i)) & 1)
enum { OP_PRO = 0, OP_LN0, OP_LN1, OP_LNF, OP_FFI, OP_FFO, OP_UP, OP_M0, OP_GAT, OP_S, OP_M2, OP_FIN, OP_DN, OP_AQ, OP_APREP, OP_ACORE, OP_AO, OP_SI, OP_SCONV, OP_SO };
__global__ void __launch_bounds__(512) fwd_megakernel(Params p) {
  cg::grid_group grid = cg::this_grid();
  const int wave_s = __builtin_amdgcn_readfirstlane((int)threadIdx.x >> 6);
  volatile LAS unsigned* xst = (volatile LAS unsigned*)((LAS unsigned char*)lds_raw + (LDS_BYTES - 16));
  if (threadIdx.x == 0) { xst[0] = 0u; xst[1] = 0u; }
  __syncthreads();
  unsigned* xbar = (unsigned*)(p.ws + O_BAR);
  const unsigned xcc = xb_xcc_id();
  if (threadIdx.x == 0) (void)xb_add(&xbar[XB_XCNT(xcc)], 1u);
#ifdef DUP_OP
  int rep = 0;
#endif
  for (int ph = 0; ph < p.nph; ++ph) {
    const unsigned w = p.prog[ph];
    const int op = w & 255, a = (w >> 8) & 255, b = (w >> 16) & 255, c = (w >> 24) & 255;
#define MKCTX int z; asm volatile("s_mov_b32 %0, 0" : "=s"(z)); \
    GAS char* wsq = (GAS char*)p.ws; GAS float* outq = (GAS float*)p.out; int bidq = (int)blockIdx.x, nbq = (int)gridDim.x; \
    asm volatile("" : "+s"(wsq), "+s"(outq), "+s"(bidq), "+s"(nbq)); \
    const Ctx cx{wave_s * 64 + (int)__builtin_amdgcn_mbcnt_hi(~0u, __builtin_amdgcn_mbcnt_lo(~0u, (unsigned)z)), bidq, nbq, z, (char*)wsq, (float*)outq};
    if (EN(0) && op == OP_PRO) { MKCTX prologue(p, cx); }
    else if (EN(1) && op == OP_LN0) { MKCTX lnmod_phase<0>(p, cx, 0, 0, 0); }
    else if (EN(1) && op == OP_LN1) { MKCTX lnmod_phase<1>(p, cx, a, b, c); }
    else if (EN(1) && op == OP_LNF) { MKCTX lnmod_phase<2>(p, cx, a, 0, 0); }
    else if (EN(2) && op == OP_M0) { MKCTX ml_m0(p, cx, a); }
    else if (EN(3) && op == OP_GAT) { MKCTX ml_gates(p, cx, a); }
    else if (EN(4) && op == OP_S) { MKCTX ml_s(p, cx); }
    else if (EN(5) && op == OP_M2) { MKCTX ml_m2(p, cx); }
    else if (EN(6) && op == OP_FIN) { MKCTX ml_fin(p, cx, a); }
    else if (EN(7) && op == OP_APREP) { MKCTX at_prep(p, cx); }
    else if (EN(8) && op == OP_ACORE) { MKCTX at_core(p, cx); }
    else if (EN(9) && op == OP_SCONV) { MKCTX sc_conv(p, cx); }
    else if (EN(10)) {
      MKCTX
      char* ws = cx.ws;
      const RowMap idm{0, 0, 1 << 30};
      bf16_t* U = (bf16_t*)(ws + O_U); bf16_t* ACT = (bf16_t*)(ws + O_ACT);
      const float* MODT = (const float*)(ws + O_MODT);
      const bf16_t* A = U; const bf16_t* Bt; int K = 1024, nM = MROWS / 256, nN; RowMap am = idm, cm = idm;
      Epi E; E.kind = 2; E.O = ACT; E.ldc = 0; E.modl = MODT + (size_t)b * 9 * 9216; E.slot = 1; E.wgt = 1.0f;
      if (op == OP_FFI) { Bt = (const bf16_t*)(ws + O_WFI) + (size_t)a * 5632 * 1024; nN = 22; E.kind = 1; if (c) nM = NLAT / 256; }
      else if (op == OP_FFO) { A = ACT; Bt = (const bf16_t*)(ws + O_WFO) + (size_t)a * 1024 * 2816; K = 2816; nN = 4; E.slot = c & 3; E.wgt = 0.5f; if (c & 4) nM = NLAT / 256; }
      else if (op == OP_UP) { Bt = (const bf16_t*)(ws + O_WUP) + (size_t)a * 4096 * 1024; nM = RG / 256; nN = 16; am = RowMap{c * GB * SEQ, NLAT + c * GB * LC, GB * SEQ / 256}; E.kind = 0; E.O = (bf16_t*)(ws + O_XZ); E.ldc = 4096; }
      else if (op == OP_DN) { A = (const bf16_t*)(ws + O_FIN); Bt = (const bf16_t*)(ws + O_WDN) + (size_t)a * 1024 * 2048; K = 2048; nM = RG / 256; nN = 4; cm = RowMap{c * GB * SEQ, NLAT + c * GB * LC, GB * SEQ / 256}; }
      else if (op == OP_AQ) { Bt = (const bf16_t*)(ws + O_WAQ); nN = 6; E.kind = 0; E.ldc = 1536; }
      else if (op == OP_AO) { Bt = (const bf16_t*)(ws + O_WAO); nN = 4; }
      else if (op == OP_SI) { Bt = (const bf16_t*)(ws + O_WSI); nN = 12; E.kind = 0; E.ldc = 3072; }
      else { Bt = (const bf16_t*)(ws + O_WSO); nN = 4; }
      gemm_phase(cx, A, am, Bt, K, nM, nN, cm, E);
    }
    if (ph == 0) grid.sync(); else xcd_barrier(xbar, xcc, xst);
#ifdef DUP_OP
    if (op == DUP_OP && rep + 1 < DUP_N) { ++rep; --ph; } else rep = 0;
#endif
  }
}

static int build_program(unsigned* prog) {
  int n = 0;
  auto W = [&](int op, int a, int b, int c) { prog[n++] = (unsigned)op | ((unsigned)a << 8) | ((unsigned)b << 16) | ((unsigned)c << 24); };
  W(OP_PRO, 0, 0, 0);
  W(OP_LN0, 0, 0, 0);
  for (int layer = 0; layer < DEPTH; ++layer) {
    const int kind = layer % 3, j = layer / 3;
    W(OP_FFI, layer * 2, layer, 0); W(OP_FFO, layer * 2, layer, 0);
    W(OP_LN1, layer * 3 + 0, layer, 1);
    if (kind == 0) {
      for (int g = 0; g < NG; ++g) { W(OP_UP, j, layer, g); W(OP_M0, j, 0, 0); W(OP_GAT, j, 0, 0); W(OP_S, 0, 0, 0); W(OP_M2, 0, 0, 0); W(OP_FIN, j, 0, 0); W(OP_DN, j, layer, g); }
    } else if (kind == 1) { W(OP_AQ, 0, layer, 0); W(OP_APREP, 0, 0, 0); W(OP_ACORE, 0, 0, 0); W(OP_AO, 0, layer, 0); }
    else { W(OP_SI, 0, layer, 0); W(OP_SCONV, 0, 0, 0); W(OP_SO, 0, layer, 0); }
    W(OP_LN1, layer * 3 + 1, layer, 2);
    const int lo = (layer + 1 == DEPTH) ? 1 : 0;
    W(OP_FFI, layer * 2 + 1, layer, lo); W(OP_FFO, layer * 2 + 1, layer, 2 | (lo << 2));
    if (layer + 1 < DEPTH) W(OP_LN1, layer * 3 + 2, layer + 1, 0); else W(OP_LNF, layer * 3 + 2, 0, 0);
  }
  return n;
}

extern "C" void kernel_launch(void* const* d_in, const int* in_sizes, int n_in, void* d_out, int out_size, void* d_ws, size_t ws_size, hipStream_t stream) {
  static int grid_blocks = 0;
  if (!grid_blocks) {
    int dev = 0, cus = 0, per_cu = 0;
    (void)hipGetDevice(&dev);
    (void)hipDeviceGetAttribute(&cus, hipDeviceAttributeMultiprocessorCount, dev);
    (void)hipFuncSetAttribute((const void*)fwd_megakernel, hipFuncAttributeMaxDynamicSharedMemorySize, LDS_BYTES);
    (void)hipOccupancyMaxActiveBlocksPerMultiprocessor(&per_cu, fwd_megakernel, 512, LDS_BYTES);
    if (cus <= 0) cus = 256;
    grid_blocks = cus;
    if (ws_size < WS_END || n_in != 25) fprintf(stderr, "kernel_launch: workspace %zu < %zu or n_in %d != 25\n", ws_size, (size_t)WS_END, n_in);
    if (per_cu < 1) fprintf(stderr, "kernel_launch: occupancy query says %d blocks per CU\n", per_cu);
  }
  Params p{};
  for (int i = 0; i < 25; ++i) p.in[i] = (const float*)d_in[i];
  p.out = (float*)d_out; p.ws = (char*)d_ws;
  p.nph = build_program(p.prog);
  (void)hipMemsetAsync((char*)d_ws + O_BAR, 0, XCD_BAR_WORDS * 4, stream);
  void* args[] = {&p};
  hipError_t e = hipLaunchCooperativeKernel((void*)fwd_megakernel, dim3(grid_blocks), dim3(512), args, LDS_BYTES, stream);
  if (e != hipSuccess) fprintf(stderr, "cooperative launch failed: %s (grid %d)\n", hipGetErrorString(e), grid_blocks);
}
```

```cpp
#include <hip/hip_runtime.h>
#include <hip/hip_cooperative_groups.h>
#include <cstdio>
#include <cstdint>
namespace cg = cooperative_groups;

typedef unsigned short bf16_t;
typedef short bf16x8 __attribute__((ext_vector_type(8)));
typedef short bf16x4 __attribute__((ext_vector_type(4)));
typedef float f32x4 __attribute__((ext_vector_type(4)));
typedef unsigned u32x2 __attribute__((ext_vector_type(2)));
typedef unsigned u32x4 __attribute__((ext_vector_type(4)));

constexpr int D = 1024, NB = 8, SEQ = 4096, LC = 256, DEPTH = 4, FF = 2816, EI = 2048, DH = 512;
constexpr int NLAT = NB * SEQ, NCTX = NB * LC, MROWS = NLAT + NCTX;
constexpr int TOKB = LC + SEQ;
constexpr int NCH = TOKB / 64;
constexpr int GB = 2, NG = NB / GB, RG = GB * TOKB;
constexpr int NSEQ = GB * 8;
constexpr float ALPHA = 1.681792830507429f, LN_EPS = 1e-5f;
constexpr int LDS_BYTES = 144 * 1024;

constexpr size_t al256(size_t x) { return (x + 255) & ~(size_t)255; }
constexpr size_t O_WFI = 0;
constexpr size_t O_WFO = O_WFI + (size_t)8 * 5632 * 1024 * 2;
constexpr size_t O_WUP = O_WFO + (size_t)8 * 1024 * 2816 * 2;
constexpr size_t O_WDN = O_WUP + (size_t)2 * 4096 * 1024 * 2;
constexpr size_t O_WAQ = O_WDN + (size_t)2 * 1024 * 2048 * 2;
constexpr size_t O_WAO = O_WAQ + (size_t)1536 * 1024 * 2;
constexpr size_t O_WSI = O_WAO + (size_t)1024 * 1024 * 2;
constexpr size_t O_WSO = O_WSI + (size_t)3072 * 1024 * 2;
constexpr size_t O_WG = O_WSO + (size_t)1024 * 1024 * 2;
constexpr size_t O_MODT = O_WG + (size_t)2 * 16 * 6144 * 2;
constexpr size_t O_ROPE = O_MODT + (size_t)4 * 9 * 9216 * 4;
constexpr size_t O_HCTX = O_ROPE + (size_t)2 * 4096 * 32 * 4;
constexpr size_t O_U = O_HCTX + (size_t)NCTX * D * 4;
constexpr size_t O_R = O_U + (size_t)MROWS * D * 2;
constexpr size_t O_XZ = O_R;
constexpr size_t O_QK = O_XZ + (size_t)RG * 4096 * 2;
constexpr size_t O_KT = O_QK + (size_t)RG * 4096 * 2;
constexpr size_t O_VT = O_KT + (size_t)GB * EI * TOKB * 2;
constexpr size_t O_SP = O_VT + (size_t)GB * EI * TOKB * 2;
constexpr size_t O_HD = O_SP + (size_t)NSEQ * NCH * 4096 * 2;
constexpr size_t O_FIN = O_HD + (size_t)2 * RG * EI * 2;
constexpr size_t O_GAT = O_FIN + (size_t)RG * EI * 2;
constexpr size_t SZ_ST = (size_t)NSEQ * TOKB * 4;
constexpr size_t O_BL = O_GAT, O_IG = O_BL + SZ_ST, O_WIN = O_IG + SZ_ST, O_FLO = O_WIN + SZ_ST, O_DEN = O_FLO + SZ_ST, O_WSS = O_DEN + SZ_ST;
constexpr size_t O_GC = O_WSS + SZ_ST;
constexpr size_t O_REND_ML = O_GC + (size_t)3 * NSEQ * NCH * 4 + 256;
constexpr size_t O_ACT = O_R;
constexpr size_t O_AKR = O_R + (size_t)MROWS * 3072 * 2;
constexpr size_t O_AVT = O_AKR + (size_t)NB * 4 * TOKB * 64 * 2;
constexpr size_t O_REND_AT = O_AVT + (size_t)NB * 4 * TOKB * 64 * 2;
constexpr size_t O_BAR = (O_REND_ML > O_REND_AT ? O_REND_ML : O_REND_AT);
constexpr size_t WS_END = O_BAR + 3456 * 4 + 256;

struct Params {
  const float* in[25];
  float* out;
  char* ws;
  int nph; int pad0;
  unsigned prog[126];
};

#define GAS __attribute__((address_space(1)))
#define IN(k) ((const float*)(const GAS float*)p.in[(k) + cx.z])
struct Ctx { int tid, bid, nb, z; char* ws; float* out; };
extern __shared__ __attribute__((aligned(16))) char lds_raw[];

__device__ __forceinline__ unsigned pk2(float lo, float hi) { unsigned r; asm volatile("v_cvt_pk_bf16_f32 %0, %1, %2" : "=v"(r) : "v"(lo), "v"(hi)); return r; }
__device__ __forceinline__ float bf2f(unsigned short v) { return __uint_as_float(((unsigned)v) << 16); }
__device__ __forceinline__ float bflo(unsigned v) { return __uint_as_float(v << 16); }
__device__ __forceinline__ float bfhi(unsigned v) { return __uint_as_float(v & 0xffff0000u); }
__device__ __forceinline__ float silu_f(float x) { return x * __builtin_amdgcn_rcpf(1.f + __expf(-x)); }
__device__ __forceinline__ float sigm_f(float x) { return __builtin_amdgcn_rcpf(1.f + __expf(-x)); }
__device__ __forceinline__ float shi(float v, int srclane) { return __int_as_float(__builtin_amdgcn_ds_bpermute(srclane << 2, __float_as_int(v))); }
__device__ __forceinline__ float shx(float v, int m, int lane) { return shi(v, lane ^ m); }
__device__ __forceinline__ float wave_sum(float v, int lane) {
#pragma unroll
  for (int o = 1; o < 64; o <<= 1) v += shx(v, o, lane);
  return v;
}
__device__ __forceinline__ bf16x8 mk8(u32x4 v) { union { u32x4 u; bf16x8 b; } x; x.u = v; return x.b; }
__device__ __forceinline__ bf16x8 mk8(u32x2 a, u32x2 b) { union { u32x4 u; bf16x8 b; } x; x.u = (u32x4){a.x, a.y, b.x, b.y}; return x.b; }
__device__ __forceinline__ float* hrow(const Ctx& cx, int row) { return row < NLAT ? cx.out + (size_t)row * D : (float*)(cx.ws + O_HCTX) + (size_t)(row - NLAT) * D; }
#define MFMA16(a, b, c) __builtin_amdgcn_mfma_f32_16x16x32_bf16(a, b, c, 0, 0, 0)

constexpr int BM = 256, BK = 64, HALF = 128, HT = HALF * BK, NXCD = 8, WGM = 8;
__device__ __forceinline__ int lds_byte(int r, int c) {
  int st = (r >> 4) * 2 + (c >> 5), rr = r & 15, cc = c & 31, ob = rr * 64 + cc * 2;
  return st * 1024 + (ob ^ (((ob >> 9) & 1) << 5));
}
__device__ __forceinline__ void stage_rc(int b, int& R, int& C) {
  int st = b / 1024, sb = b % 1024, swz = sb ^ (((sb >> 9) & 1) << 5);
  R = (st >> 1) * 16 + swz / 64; C = (st & 1) * 32 + (swz % 64) / 2;
}
struct RowMap { int lat0, ctx0, nlat; __device__ __forceinline__ int row0(int pm) const { return pm < nlat ? lat0 + pm * 256 : ctx0 + (pm - nlat) * 256; } };

typedef f32x4 Acc[2][2][4][2];

struct Epi {
  int kind; bf16_t* O; int ldc; const float* modl; int slot; float wgt;
};
__device__ __forceinline__ void run_epi(const Ctx& cx, const Epi& E, const Acc& acc, int r0, int pn, int wr, int wc, int fr, int fq) {
  if (E.kind == 0) {
#pragma unroll
    for (int ai = 0; ai < 2; ++ai)
#pragma unroll
      for (int m = 0; m < 4; ++m) {
        bf16_t* rp = E.O + (size_t)(r0 + ai * HALF + wr * 64 + m * 16 + fr) * E.ldc + pn * 256 + wc * 32 + 4 * fq;
#pragma unroll
        for (int bj = 0; bj < 2; ++bj)
#pragma unroll
          for (int n = 0; n < 2; ++n) {
            f32x4 v = acc[ai][bj][m][n];
            u32x2 o; o.x = pk2(v[0], v[1]); o.y = pk2(v[2], v[3]);
            *(u32x2*)(rp + bj * HALF + n * 16) = o;
          }
      }
  } else if (E.kind == 1) {
#pragma unroll
    for (int ai = 0; ai < 2; ++ai)
#pragma unroll
      for (int m = 0; m < 4; ++m) {
        bf16_t* rp = E.O + (size_t)(r0 + ai * HALF + wr * 64 + m * 16 + fr) * FF + pn * 128 + wc * 16 + 4 * fq;
#pragma unroll
        for (int bj = 0; bj < 2; ++bj) {
          f32x4 g = acc[ai][bj][m][0], v = acc[ai][bj][m][1];
          u32x2 o; o.x = pk2(silu_f(g[0]) * v[0], silu_f(g[1]) * v[1]); o.y = pk2(silu_f(g[2]) * v[2], silu_f(g[3]) * v[3]);
          *(u32x2*)(rp + bj * 64) = o;
        }
      }
  } else {
    const int midx = r0 < NLAT ? (r0 >> 12) : 8;
    const float* gp = E.modl + (size_t)midx * 9216 + (3 * E.slot + 2) * D + pn * 256 + wc * 32 + 4 * fq;
    f32x4 gv[2][2];
#pragma unroll
    for (int bj = 0; bj < 2; ++bj)
#pragma unroll
      for (int n = 0; n < 2; ++n) gv[bj][n] = *(const f32x4*)(gp + bj * HALF + n * 16) * E.wgt;
#pragma unroll
    for (int ai = 0; ai < 2; ++ai)
#pragma unroll
      for (int m = 0; m < 4; ++m) {
        float* rp = hrow(cx, r0 + ai * HALF + wr * 64 + m * 16 + fr) + pn * 256 + wc * 32 + 4 * fq;
        f32x4 h[2][2];
#pragma unroll
        for (int bj = 0; bj < 2; ++bj)
#pragma unroll
          for (int n = 0; n < 2; ++n) h[bj][n] = *(const f32x4*)(rp + bj * HALF + n * 16);
#pragma unroll
        for (int bj = 0; bj < 2; ++bj)
#pragma unroll
          for (int n = 0; n < 2; ++n) *(f32x4*)(rp + bj * HALF + n * 16) = h[bj][n] * ALPHA + gv[bj][n] * acc[ai][bj][m][n];
        __builtin_amdgcn_sched_barrier(0);
      }
  }
}

#define LAS __attribute__((address_space(3)))
__device__ __forceinline__ void gemm_phase(const Ctx& cx, const bf16_t* __restrict__ A, RowMap am, const bf16_t* __restrict__ Bt, int K, int nM, int nN, RowMap cm, const Epi& epi) {
  LAS unsigned char* lds = (LAS unsigned char*)lds_raw;
  constexpr int HTB = HT * 2;
  const int tid = cx.tid, wid = tid >> 6, lane = tid & 63, wr = wid >> 2, wc = wid & 3, fr = lane & 15, fq = lane >> 4;
  unsigned voff[2];
#pragma unroll
  for (int i = 0; i < 2; ++i) { int R, C; stage_rc(tid * 16 + i * 8192, R, C); voff[i] = (unsigned)(R * K + C) * 2u; }
  const size_t kstep = (size_t)(BK * 2), hstep = (size_t)HALF * K * 2;
  const unsigned ldsw = (unsigned)wid * 1024u;
  const int aoff = lds_byte(wr * 64 + fr, fq * 8), boff = lds_byte(wc * 32 + fr, fq * 8);
#define G_SA(b, h) (((b) * 2 + (h)) * HTB)
#define G_SB(b, h) ((4 + (b) * 2 + (h)) * HTB)
#define STAGE(bufoff, gbase) do { _Pragma("unroll") for (int _i = 0; _i < 2; ++_i) \
    __builtin_amdgcn_global_load_lds((const unsigned*)((const char*)(gbase) + voff[_i]), (LAS unsigned*)(lds + (bufoff) + ldsw + _i * 8192), 16, 0, 0); } while (0)
#define LDA(dst, b, h) do { _Pragma("unroll") for (int m = 0; m < 4; ++m) _Pragma("unroll") for (int k = 0; k < 2; ++k) dst[m][k] = *(const LAS bf16x8*)(lds + G_SA(b, h) + aoff + m * 2048 + k * 1024); } while (0)
#define LDB(dst, b, h) do { _Pragma("unroll") for (int n = 0; n < 2; ++n) _Pragma("unroll") for (int k = 0; k < 2; ++k) dst[n][k] = *(const LAS bf16x8*)(lds + G_SB(b, h) + boff + n * 2048 + k * 1024); } while (0)
#define MMA(ai, bj, At, Bt_) do { __builtin_amdgcn_s_setprio(1); _Pragma("unroll") for (int m = 0; m < 4; ++m) _Pragma("unroll") for (int n = 0; n < 2; ++n) _Pragma("unroll") for (int k = 0; k < 2; ++k) \
      acc[ai][bj][m][n] = MFMA16(Bt_[n][k], At[m][k], acc[ai][bj][m][n]); \
    __builtin_amdgcn_s_setprio(0); } while (0)
#define WAIT_V(n) asm volatile("s_waitcnt vmcnt(" #n ")" ::: "memory")
#define WAIT_L(n) asm volatile("s_waitcnt lgkmcnt(" #n ")" ::: "memory")
#define BAR __builtin_amdgcn_s_barrier()
#define SCHED __builtin_amdgcn_sched_barrier(0)
  const int nwg = nM * nN;
  const int nt = K / BK;
  const int wid_s = __builtin_amdgcn_readfirstlane(wid);
#define DECODE(L_, pm_, pn_) do { int wgid = (L_); \
    { int q = nwg / NXCD, r = nwg % NXCD, xcd = wgid % NXCD, off = wgid / NXCD; wgid = (xcd < r ? xcd * (q + 1) : r * (q + 1) + (xcd - r) * q) + off; } \
    const int nig = WGM * nN, gid = wgid / nig, fm = gid * WGM, gsz = min(nM - fm, WGM); \
    pm_ = fm + ((wgid % nig) % gsz); pn_ = (wgid % nig) / gsz; } while (0)
  int L = cx.bid;
  if (L < nwg) {
    int pm, pn;
    DECODE(L, pm, pn);
    const char* cA = (const char*)A + (size_t)am.row0(pm) * K * 2; const char* cB = (const char*)Bt + (size_t)pn * BM * K * 2;
    Acc acc;
#pragma unroll
    for (int a = 0; a < 2; ++a)
#pragma unroll
      for (int b = 0; b < 2; ++b)
#pragma unroll
        for (int m = 0; m < 4; ++m)
#pragma unroll
          for (int n = 0; n < 2; ++n) acc[a][b][m][n] = (f32x4){0.f, 0.f, 0.f, 0.f};
    bf16x8 At[4][2], B0[2][2], B1[2][2];
    STAGE(G_SB(0, 0), cB); STAGE(G_SA(0, 0), cA); STAGE(G_SB(0, 1), cB + hstep); STAGE(G_SA(0, 1), cA + hstep);
    if (wr == 1) BAR;
    WAIT_V(4); BAR;
    STAGE(G_SB(1, 0), cB + kstep); STAGE(G_SA(1, 0), cA + kstep); STAGE(G_SB(1, 1), cB + hstep + kstep);
    WAIT_V(6); BAR;
    for (;;) {
      const int Ln = L + cx.nb;
      const bool has_next = Ln < nwg;
      int pmn = pm, pnn = pn;
      if (has_next) DECODE(Ln, pmn, pnn);
      const char* nA = has_next ? (const char*)A + (size_t)am.row0(pmn) * K * 2 : cA; const char* nB = has_next ? (const char*)Bt + (size_t)pnn * BM * K * 2 : cB;
      for (int t = 0; t < nt; t += 2) {
        const bool last = (t == nt - 2);
        const char* a1 = cA + (size_t)(t + 1) * kstep;
        const char* a2 = last ? nA : cA + (size_t)(t + 2) * kstep; const char* b2 = last ? nB : cB + (size_t)(t + 2) * kstep;
        const char* a3 = a2 + kstep; const char* b3 = b2 + kstep;
        LDB(B0, 0, 0); SCHED; LDA(At, 0, 0); STAGE(G_SA(1, 1), a1 + hstep);
        WAIT_L(8); BAR; WAIT_L(0); MMA(0, 0, At, B0); BAR; SCHED;
        LDB(B1, 0, 1); STAGE(G_SB(0, 0), b2);
        BAR; WAIT_L(0); MMA(0, 1, At, B1); BAR;
        LDA(At, 0, 1); STAGE(G_SA(0, 0), a2);
        BAR; WAIT_L(0); MMA(1, 0, At, B0); BAR; SCHED;
        STAGE(G_SB(0, 1), b2 + hstep);
        WAIT_V(6); BAR; MMA(1, 1, At, B1); BAR;
        LDB(B0, 1, 0); SCHED; LDA(At, 1, 0); STAGE(G_SA(0, 1), a2 + hstep);
        WAIT_L(8); BAR; WAIT_L(0); MMA(0, 0, At, B0); BAR; SCHED;
        LDB(B1, 1, 1); STAGE(G_SB(1, 0), b3);
        BAR; WAIT_L(0); MMA(0, 1, At, B1); BAR;
        LDA(At, 1, 1); STAGE(G_SA(1, 0), a3);
        BAR; WAIT_L(0); MMA(1, 0, At, B0); BAR; SCHED;
        STAGE(G_SB(1, 1), b3 + hstep);
        WAIT_V(6); BAR; MMA(1, 1, At, B1); BAR;
      }
      { int t2 = wid_s * 64 + (int)__builtin_amdgcn_mbcnt_hi(~0u, __builtin_amdgcn_mbcnt_lo(~0u, (unsigned)cx.z)); asm volatile("" : "+v"(t2));
        const int w2 = t2 >> 6, l2 = t2 & 63;
        run_epi(cx, epi, acc, cm.row0(pm), pn, w2 >> 2, w2 & 3, l2 & 15, l2 >> 4); }
      if (!has_next) break;
#pragma unroll
      for (int a = 0; a < 2; ++a)
#pragma unroll
        for (int b = 0; b < 2; ++b)
#pragma unroll
          for (int m = 0; m < 4; ++m)
#pragma unroll
            for (int n = 0; n < 2; ++n) acc[a][b][m][n] = (f32x4){0.f, 0.f, 0.f, 0.f};
      pm = pmn; pn = pnn; cA = nA; cB = nB; L = Ln;
    }
    WAIT_V(0);
    if (wr == 0) BAR;
    BAR;
  }
  __syncthreads();
}

template <int MODE>
__device__ __forceinline__ int wrow(int c) {
  if (MODE == 0) return c;
  const int isv = c >= FF ? 1 : 0, f = c - isv * FF;
  return (f >> 7) * 256 + ((f >> 6) & 1) * 128 + ((f >> 4) & 3) * 32 + isv * 16 + (f & 15);
}
template <int MODE>
__device__ __forceinline__ void transpose_item(const float* __restrict__ W, int K, int N, bf16_t* __restrict__ WT, float* scr, int item, int lane) {
  const int nblk = N / 32, kb = item / nblk, nb = item % nblk, k0 = 64 * kb, n0 = 32 * nb;
#pragma unroll 8
  for (int i = 0; i < 32; ++i) { const int kk = 2 * i + (lane >> 5); scr[kk * 33 + (lane & 31)] = W[(size_t)(k0 + kk) * N + n0 + (lane & 31)]; }
  __builtin_amdgcn_wave_barrier(); asm volatile("s_waitcnt lgkmcnt(0)" ::: "memory");
  const int c = lane & 7;
#pragma unroll
  for (int j = 0; j < 4; ++j) {
    const int n = (lane >> 3) + 8 * j; const float* s = scr + (8 * c) * 33 + n;
    u32x4 o; o.x = pk2(s[0 * 33], s[1 * 33]); o.y = pk2(s[2 * 33], s[3 * 33]); o.z = pk2(s[4 * 33], s[5 * 33]); o.w = pk2(s[6 * 33], s[7 * 33]);
    *(u32x4*)(WT + (size_t)wrow<MODE>(n0 + n) * K + k0 + 8 * c) = o;
  }
  asm volatile("s_waitcnt lgkmcnt(0)" ::: "memory"); __builtin_amdgcn_wave_barrier();
}

__device__ __forceinline__ void prologue(const Params& p, const Ctx& cx) {
  const int tid = cx.tid, lane = tid & 63, wave = tid >> 6;
  char* ws = cx.ws;
  {
    float* cond = (float*)lds_raw;
    float* red = (float*)(lds_raw + 9 * 1024 * 4);
    for (int i = tid; i < 9 * 1024; i += 512) { const int j = i >> 10, k = i & 1023; cond[i] = silu_f(j < 8 ? IN(1)[j * 1024 + k] : IN(3)[k]); }
    __syncthreads();
    for (int u = cx.bid; u < 4 * 36; u += cx.nb) {
      const int layer = u / 36, ct = u % 36, c0 = ct * 256 + 4 * lane;
      const float* wp = IN(4) + (size_t)layer * D * 9216 + c0;
      f32x4 a[9];
#pragma unroll
      for (int j = 0; j < 9; ++j) a[j] = (f32x4){0.f, 0.f, 0.f, 0.f};
#pragma unroll 4
      for (int k = wave * 128; k < wave * 128 + 128; ++k) {
        const f32x4 w = *(const f32x4*)(wp + (size_t)k * 9216);
#pragma unroll
        for (int j = 0; j < 9; ++j) a[j] += w * cond[j * 1024 + k];
      }
#pragma unroll
      for (int j = 0; j < 9; ++j) *(f32x4*)(red + (wave * 9 + j) * 256 + 4 * lane) = a[j];
      __syncthreads();
      float* mt = (float*)(ws + O_MODT) + (size_t)layer * 9 * 9216;
      for (int i = tid; i < 9 * 256; i += 512) {
        const int j = i >> 8, c = i & 255; float s = 0.f;
#pragma unroll
        for (int w = 0; w < 8; ++w) s += red[(w * 9 + j) * 256 + c];
        mt[(size_t)j * 9216 + ct * 256 + c] = s + IN(5)[layer * 9216 + ct * 256 + c];
      }
      __syncthreads();
    }
    __syncthreads();
  }
  {
    float* scr = (float*)lds_raw + wave * (64 * 33);
    const int gw = cx.bid * 8 + wave, NGW = cx.nb * 8;
    constexpr int I_FI = 16 * 176, I_FO = 44 * 32, I_UP = 16 * 128, I_DN = 32 * 32, I_AQ = 16 * 48, I_AO = 16 * 32, I_SI = 16 * 96, I_SO = 16 * 32;
    constexpr int NITEMS = 8 * I_FI + 8 * I_FO + 2 * I_UP + 2 * I_DN + I_AQ + I_AO + I_SI + I_SO;
    for (int it = gw; it < NITEMS; it += NGW) {
      int r = it;
      if (r < 8 * I_FI) { const int mi = r / I_FI; transpose_item<1>(IN(8) + (size_t)mi * 1024 * 5632, 1024, 5632, (bf16_t*)(ws + O_WFI) + (size_t)mi * 5632 * 1024, scr, r % I_FI, lane); continue; } r -= 8 * I_FI;
      if (r < 8 * I_FO) { const int mi = r / I_FO; transpose_item<0>(IN(9) + (size_t)mi * 2816 * 1024, 2816, 1024, (bf16_t*)(ws + O_WFO) + (size_t)mi * 1024 * 2816, scr, r % I_FO, lane); continue; } r -= 8 * I_FO;
      if (r < 2 * I_UP) { const int mi = r / I_UP; transpose_item<0>(IN(10) + (size_t)mi * 1024 * 4096, 1024, 4096, (bf16_t*)(ws + O_WUP) + (size_t)mi * 4096 * 1024, scr, r % I_UP, lane); continue; } r -= 2 * I_UP;
      if (r < 2 * I_DN) { const int mi = r / I_DN; transpose_item<0>(IN(18) + (size_t)mi * 2048 * 1024, 2048, 1024, (bf16_t*)(ws + O_WDN) + (size_t)mi * 1024 * 2048, scr, r % I_DN, lane); continue; } r -= 2 * I_DN;
      if (r < I_AQ) { transpose_item<0>(IN(19), 1024, 1536, (bf16_t*)(ws + O_WAQ), scr, r, lane); continue; } r -= I_AQ;
      if (r < I_AO) { transpose_item<0>(IN(21), 1024, 1024, (bf16_t*)(ws + O_WAO), scr, r, lane); continue; } r -= I_AO;
      if (r < I_SI) { transpose_item<0>(IN(22), 1024, 3072, (bf16_t*)(ws + O_WSI), scr, r, lane); continue; } r -= I_SI;
      transpose_item<0>(IN(24), 1024, 1024, (bf16_t*)(ws + O_WSO), scr, r, lane);
    }
  }
  {
    const int gt = cx.bid * 512 + tid, gs = cx.nb * 512;
    bf16_t* wg = (bf16_t*)(ws + O_WG);
    for (int i = gt; i < 2 * 16 * 6144; i += gs) {
      const int j = i / (16 * 6144), xg = (i / 6144) & 15, k = i % 6144, x = xg >> 3, g = xg & 7;
      const float* wif = IN(14) + (size_t)(j * 2 + x) * 6144 * 8;
      float v;
      if (k < 2048) v = wif[(size_t)k * 8 + g];
      else if (k < 4096) v = wif[(size_t)k * 8 + g] * 22.627416997969522f;
      else {
        const int c = k - 4096, blk = c >> 2, cc = c & 3;
        const float* wv = IN(13) + ((size_t)(j * 3 + 2) * 512 + blk) * 16 + cc * 4;
        v = 0.f;
        for (int d2 = 0; d2 < 4; ++d2) v += wv[d2] * wif[(size_t)(4096 + 4 * blk + d2) * 8 + g];
      }
      wg[i] = (bf16_t)(pk2(v, 0.f) & 0xffff);
    }
    float* rc = (float*)(ws + O_ROPE); float* rs = rc + 4096 * 32;
    for (int i = gt; i < 4096 * 32; i += gs) {
      const int pos = i >> 5, pp = i & 31, jf = pp & 15;
      const float fr_ = __builtin_amdgcn_exp2f(-(float)jf * (13.287712379549449f / 16.f));
      float rev = (float)(pp < 16 ? (pos >> 6) : (pos & 63)) * fr_ * 0.15915494309189535f;
      rev -= rintf(rev);
      rc[i] = __builtin_amdgcn_cosf(rev); rs[i] = __builtin_amdgcn_sinf(rev);
    }
  }
}

template <int MODE>
__device__ __forceinline__ void lnmod_phase(const Params& p, const Ctx& cx, int lnidx  , int layer, int slot) {
  const int lane = cx.tid & 63, gw = cx.bid * 8 + (cx.tid >> 6), NGW = cx.nb * 8;
  const int nrows = MODE == 2 ? NLAT : MROWS;
  const float* lg = IN(6) + (size_t)lnidx * D; const float* lb = IN(7) + (size_t)lnidx * D;
  const float* modl = (const float*)(cx.ws + O_MODT) + (size_t)layer * 9 * 9216;
  bf16_t* U = (bf16_t*)(cx.ws + O_U);
  for (int row = gw; row < nrows; row += NGW) {
    float* hp = hrow(cx, row);
    const float* src = MODE == 0 ? (row < NLAT ? IN(0) + (size_t)row * D : IN(2) + (size_t)(row - NLAT) * D) : hp;
    f32x4 v[4];
#pragma unroll
    for (int j = 0; j < 4; ++j) v[j] = *(const f32x4*)(src + 4 * lane + 256 * j);
    if (MODE != 0) {
      float s = 0.f;
#pragma unroll
      for (int j = 0; j < 4; ++j) s += (v[j][0] + v[j][1]) + (v[j][2] + v[j][3]);
      const float mean = wave_sum(s, lane) * (1.f / D); float s2 = 0.f;
#pragma unroll
      for (int j = 0; j < 4; ++j) { v[j] = v[j] - mean; s2 += (v[j][0] * v[j][0] + v[j][1] * v[j][1]) + (v[j][2] * v[j][2] + v[j][3] * v[j][3]); }
      const float rstd = __builtin_amdgcn_rsqf(wave_sum(s2, lane) * (1.f / D) + LN_EPS);
#pragma unroll
      for (int j = 0; j < 4; ++j) v[j] = v[j] * rstd * *(const f32x4*)(lg + 4 * lane + 256 * j) + *(const f32x4*)(lb + 4 * lane + 256 * j);
    }
#pragma unroll
    for (int j = 0; j < 4; ++j) *(f32x4*)(hp + 4 * lane + 256 * j) = v[j];
    if (MODE != 2) {
      const int midx = row < NLAT ? (row >> 12) : 8;
      const float* sh = modl + (size_t)midx * 9216 + (3 * slot) * D; const float* sc = sh + D;
#pragma unroll
      for (int j = 0; j < 4; ++j) {
        const f32x4 u = v[j] * (*(const f32x4*)(sc + 4 * lane + 256 * j) + 1.f) + *(const f32x4*)(sh + 4 * lane + 256 * j);
        u32x2 o; o.x = pk2(u[0], u[1]); o.y = pk2(u[2], u[3]);
        *(u32x2*)(U + (size_t)row * D + 4 * lane + 256 * j) = o;
      }
    }
  }
}

__device__ __forceinline__ int ml_lrow(int bl, int tok) { return tok < LC ? GB * SEQ + bl * LC + tok : bl * SEQ + (tok - LC); }
__device__ __forceinline__ int ml_nchunk(int x, int st) { return x == 0 ? st : (st < 4 ? 3 - st : 71 - st); }

__device__ __forceinline__ void ml_m0(const Params& p, const Ctx& cx, int j) {
  const int tid = cx.tid;
  char* ws = cx.ws;
  const bf16_t* XZ = (const bf16_t*)(ws + O_XZ);
  bf16_t* QK = (bf16_t*)(ws + O_QK); bf16_t* KT = (bf16_t*)(ws + O_KT); bf16_t* VT = (bf16_t*)(ws + O_VT);
  bf16_t* lk = (bf16_t*)lds_raw;
  bf16_t* lv = lk + 256 * 72;
  const int blk_l = tid & 63, tq = tid >> 6;
  for (int u = cx.bid; u < GB * NCH * 8; u += cx.nb) {
    const int slab = u & 7, ch = (u >> 3) % NCH, bl = u / (8 * NCH);
    const int f0 = slab * 256 + blk_l * 4, blk = f0 >> 2;
    float cw[3][4], cb[4], wq[16], wk[16], wv[16];
#pragma unroll
    for (int k = 0; k < 3; ++k)
#pragma unroll
      for (int c = 0; c < 4; ++c) cw[k][c] = IN(11)[(size_t)(j * 3 + k) * EI + f0 + c];
#pragma unroll
    for (int c = 0; c < 4; ++c) cb[c] = IN(12)[(size_t)j * EI + f0 + c];
#pragma unroll
    for (int i = 0; i < 16; ++i) {
      wq[i] = IN(13)[((size_t)(j * 3 + 0) * 512 + blk) * 16 + i];
      wk[i] = IN(13)[((size_t)(j * 3 + 1) * 512 + blk) * 16 + i] * 0.04419417382415922f;
      wv[i] = IN(13)[((size_t)(j * 3 + 2) * 512 + blk) * 16 + i];
    }
    const int tok0 = ch * 64, seg_lo = tok0 < LC ? 0 : LC, seg_hi = tok0 < LC ? LC : TOKB;
    for (int tt = 0; tt < 8; ++tt) {
      const int tl = tq + 8 * tt, tok = tok0 + tl;
      float xm[3][4];
#pragma unroll
      for (int k = 0; k < 3; ++k) {
        const int t2 = tok + k - 1;
        if (t2 >= seg_lo && t2 < seg_hi) {
          const u32x2 r = *(const u32x2*)(XZ + (size_t)ml_lrow(bl, t2) * 4096 + f0);
          xm[k][0] = bflo(r.x); xm[k][1] = bfhi(r.x); xm[k][2] = bflo(r.y); xm[k][3] = bfhi(r.y);
        } else { xm[k][0] = xm[k][1] = xm[k][2] = xm[k][3] = 0.f; }
      }
      float xc[4], q[4], kk[4], vv[4];
#pragma unroll
      for (int c = 0; c < 4; ++c) xc[c] = silu_f(cw[0][c] * xm[0][c] + cw[1][c] * xm[1][c] + cw[2][c] * xm[2][c] + cb[c]);
#pragma unroll
      for (int d2 = 0; d2 < 4; ++d2) {
        q[d2] = xc[0] * wq[d2] + xc[1] * wq[4 + d2] + xc[2] * wq[8 + d2] + xc[3] * wq[12 + d2];
        kk[d2] = xc[0] * wk[d2] + xc[1] * wk[4 + d2] + xc[2] * wk[8 + d2] + xc[3] * wk[12 + d2];
        vv[d2] = xm[1][0] * wv[d2] + xm[1][1] * wv[4 + d2] + xm[1][2] * wv[8 + d2] + xm[1][3] * wv[12 + d2];
      }
      const size_t lr = ml_lrow(bl, tok);
      u32x2 oq, ok, ov; oq.x = pk2(q[0], q[1]); oq.y = pk2(q[2], q[3]); ok.x = pk2(kk[0], kk[1]); ok.y = pk2(kk[2], kk[3]); ov.x = pk2(vv[0], vv[1]); ov.y = pk2(vv[2], vv[3]);
      *(u32x2*)(QK + lr * 4096 + f0) = oq;
      *(u32x2*)(QK + lr * 4096 + 2048 + f0) = ok;
      const int fl = blk_l * 4;
      lk[(fl + 0) * 72 + tl] = (bf16_t)(ok.x & 0xffff); lk[(fl + 1) * 72 + tl] = (bf16_t)(ok.x >> 16); lk[(fl + 2) * 72 + tl] = (bf16_t)(ok.y & 0xffff); lk[(fl + 3) * 72 + tl] = (bf16_t)(ok.y >> 16);
      lv[(fl + 0) * 72 + tl] = (bf16_t)(ov.x & 0xffff); lv[(fl + 1) * 72 + tl] = (bf16_t)(ov.x >> 16); lv[(fl + 2) * 72 + tl] = (bf16_t)(ov.y & 0xffff); lv[(fl + 3) * 72 + tl] = (bf16_t)(ov.y >> 16);
    }
    __syncthreads();
    {
      const int arr = tid >> 8, fr_ = tid & 255;
      const bf16_t* src = (arr ? lv : lk) + fr_ * 72;
      bf16_t* dst = (arr ? VT : KT) + ((size_t)bl * EI + slab * 256 + fr_) * TOKB + tok0;
#pragma unroll
      for (int i = 0; i < 8; ++i) *(u32x4*)(dst + 8 * i) = *(const u32x4*)(src + 8 * i);
    }
    __syncthreads();
  }
}

__device__ __forceinline__ void ml_gates(const Params& p, const Ctx& cx, int j) {
  const int tid = cx.tid, lane = tid & 63, wave = tid >> 6, fr = lane & 15, fq = lane >> 4;
  char* ws = cx.ws;
  const bf16_t* XZ = (const bf16_t*)(ws + O_XZ); const bf16_t* QK = (const bf16_t*)(ws + O_QK);
  const bf16_t* WG = (const bf16_t*)(ws + O_WG) + (size_t)j * 16 * 6144;
  float* BL = (float*)(ws + O_BL); float* IG = (float*)(ws + O_IG);
  float* GC = (float*)(ws + O_GC); float* AC = GC + NSEQ * NCH;
  float* part = (float*)lds_raw;
  float* gl = part + 8 * 64 * 16;
  for (int u = cx.bid; u < GB * NCH; u += cx.nb) {
    const int bl = u / NCH, nc = u % NCH, tok0 = nc * 64;
    f32x4 acc[4];
#pragma unroll
    for (int m = 0; m < 4; ++m) acc[m] = (f32x4){0.f, 0.f, 0.f, 0.f};
    size_t lr[4];
#pragma unroll
    for (int m = 0; m < 4; ++m) lr[m] = ml_lrow(bl, tok0 + m * 16 + fr);
#pragma unroll 4
    for (int ks = wave * 24; ks < wave * 24 + 24; ++ks) {
      const int k = ks * 32 + fq * 8;
      const bf16x8 bfr = *(const bf16x8*)(WG + (size_t)fr * 6144 + k);
#pragma unroll
      for (int m = 0; m < 4; ++m) {
        const bf16_t* ap = k < 4096 ? QK + lr[m] * 4096 + k : XZ + lr[m] * 4096 + (k - 4096);
        const bf16x8 afr = *(const bf16x8*)ap;
        acc[m] = MFMA16(afr, bfr, acc[m]);
      }
    }
#pragma unroll
    for (int m = 0; m < 4; ++m)
#pragma unroll
      for (int jj = 0; jj < 4; ++jj) part[(wave * 64 + m * 16 + 4 * fq + jj) * 16 + fr] = acc[m][jj];
    __syncthreads();
    for (int i = tid; i < 1024; i += 512) {
      float s = IN(15)[(size_t)j * 16 + (i & 15)];
#pragma unroll
      for (int w = 0; w < 8; ++w) s += part[w * 1024 + i];
      gl[(i >> 4) * 17 + (i & 15)] = s;
    }
    __syncthreads();
    {
      const int x = wave >> 2, h = wave & 3, seq = (bl * 2 + x) * 4 + h;
      const int tl = x == 0 ? lane : 63 - lane;
      const float ig = gl[tl * 17 + x * 8 + h], fg = gl[tl * 17 + x * 8 + 4 + h];
      float b = fg > 0.f ? -__logf(1.f + __expf(-fg)) : fg - __logf(1.f + __expf(fg));
#pragma unroll
      for (int o = 1; o < 64; o <<= 1) { const float t2 = shi(b, lane - o); if (lane >= o) b += t2; }
      BL[(size_t)seq * TOKB + tok0 + tl] = b; IG[(size_t)seq * TOKB + tok0 + tl] = ig;
      float mx = ig - b;
#pragma unroll
      for (int o = 1; o < 64; o <<= 1) mx = fmaxf(mx, shx(mx, o, lane));
      const float g = shi(b, 63);
      if (lane == 0) { GC[seq * NCH + nc] = g; AC[seq * NCH + nc] = g + mx; }
    }
    __syncthreads();
  }
}

__device__ __forceinline__ void ml_s(const Params& p, const Ctx& cx) {
  const int tid = cx.tid, lane = tid & 63, wave = tid >> 6, fr = lane & 15, fq = lane >> 4;
  char* ws = cx.ws;
  const bf16_t* QK = (const bf16_t*)(ws + O_QK);
  bf16_t* SP = (bf16_t*)(ws + O_SP);
  const float* BL = (const float*)(ws + O_BL); const float* IG = (const float*)(ws + O_IG);
  float* WIN = (float*)(ws + O_WIN); float* FLO = (float*)(ws + O_FLO); float* DEN = (float*)(ws + O_DEN); float* WSS = (float*)(ws + O_WSS);
  const float* GC = (const float*)(ws + O_GC); const float* AC = GC + NSEQ * NCH; float* DEC = (float*)(ws + O_GC) + 2 * NSEQ * NCH;
  float* sb_ = (float*)lds_raw + wave * 256; float* si_ = sb_ + 64; float* smt = si_ + 64;
  const int gw = cx.bid * 8 + wave, NGW = cx.nb * 8;
  for (int u = gw; u < NSEQ * NCH; u += NGW) {
    const int seq = u / NCH, st = u % NCH, x = (seq >> 2) & 1, h = seq & 3, bl = seq >> 3;
    const int nc = ml_nchunk(x, st), tok0 = nc * 64;
    const int nl0 = ml_nchunk(x, lane), nl1 = ml_nchunk(x, 64 + (lane & 3));
    const float g0 = GC[seq * NCH + nl0], a0 = AC[seq * NCH + nl0], g1 = GC[seq * NCH + nl1], a1 = AC[seq * NCH + nl1];
    const int tl = x == 0 ? lane : 63 - lane;
    const float b = BL[(size_t)seq * TOKB + tok0 + tl], ig = IG[(size_t)seq * TOKB + tok0 + tl];
    float mc = 0.f;
    for (int s2 = 0; s2 < st; ++s2) {
      const float gg = __int_as_float(__builtin_amdgcn_readlane(__float_as_int(s2 < 64 ? g0 : g1), s2 & 63));
      const float aa = __int_as_float(__builtin_amdgcn_readlane(__float_as_int(s2 < 64 ? a0 : a1), s2 & 63));
      mc = fmaxf(gg + mc, aa);
    }
    const float gc = __int_as_float(__builtin_amdgcn_readlane(__float_as_int(st < 64 ? g0 : g1), st & 63));
    const float ac = __int_as_float(__builtin_amdgcn_readlane(__float_as_int(st < 64 ? a0 : a1), st & 63));
    const float mnew = fmaxf(gc + mc, ac);
    float cm = ig - b;
#pragma unroll
    for (int o = 1; o < 64; o <<= 1) { const float t2 = shi(cm, lane - o); if (lane >= o) cm = fmaxf(cm, t2); }
    const float mt = b + fmaxf(mc, cm);
    sb_[tl] = b; si_[tl] = ig; smt[tl] = mt;
    WIN[(size_t)seq * TOKB + tok0 + tl] = __expf(b + mc - mt);
    FLO[(size_t)seq * TOKB + tok0 + tl] = __expf(-mt);
    WSS[(size_t)seq * TOKB + tok0 + tl] = __expf(gc - b + ig - mnew);
    if (lane == 0) DEC[seq * NCH + nc] = __expf(gc + mc - mnew);
    f32x4 acc[4][4];
#pragma unroll
    for (int a = 0; a < 4; ++a)
#pragma unroll
      for (int c2 = 0; c2 < 4; ++c2) acc[a][c2] = (f32x4){0.f, 0.f, 0.f, 0.f};
    const bf16_t* rowp[4];
#pragma unroll
    for (int a = 0; a < 4; ++a) rowp[a] = QK + (size_t)ml_lrow(bl, tok0 + a * 16 + fr) * 4096 + h * DH + fq * 8;
#pragma unroll 2
    for (int ks = 0; ks < 16; ++ks) {
      bf16x8 kf[4], qf[4];
#pragma unroll
      for (int a = 0; a < 4; ++a) { kf[a] = *(const bf16x8*)(rowp[a] + 2048 + ks * 32); qf[a] = *(const bf16x8*)(rowp[a] + ks * 32); }
#pragma unroll
      for (int a = 0; a < 4; ++a)
#pragma unroll
        for (int c2 = 0; c2 < 4; ++c2) acc[a][c2] = MFMA16(kf[a], qf[c2], acc[a][c2]);
    }
    __builtin_amdgcn_wave_barrier(); asm volatile("s_waitcnt lgkmcnt(0)" ::: "memory");
    bf16_t* spu = SP + (size_t)(seq * NCH + nc) * 4096;
#pragma unroll
    for (int tb = 0; tb < 4; ++tb) {
      const int t = tb * 16 + fr;
      const float bt = sb_[t], mtt = smt[t];
      float dsum = 0.f;
#pragma unroll
      for (int sbk = 0; sbk < 4; ++sbk) {
        float vals[4];
#pragma unroll
        for (int jj = 0; jj < 4; ++jj) {
          const int s = sbk * 16 + 4 * fq + jj;
          const bool ok = x == 0 ? (s <= t) : (s >= t);
          vals[jj] = ok ? acc[sbk][tb][jj] * __expf(bt - sb_[s] + si_[s] - mtt) : 0.f;
        }
        u32x2 o; o.x = pk2(vals[0], vals[1]); o.y = pk2(vals[2], vals[3]);
        *(u32x2*)(spu + t * 64 + sbk * 16 + 4 * fq) = o;
        dsum += (bflo(o.x) + bfhi(o.x)) + (bflo(o.y) + bfhi(o.y));
      }
      dsum += shx(dsum, 16, lane); dsum += shx(dsum, 32, lane);
      if (fq == 0) DEN[(size_t)seq * TOKB + tok0 + t] = dsum;
    }
    __builtin_amdgcn_wave_barrier(); asm volatile("s_waitcnt lgkmcnt(0)" ::: "memory");
  }
}

constexpr int NEB = 2, NSL = 512 / (16 * NEB);
__device__ __forceinline__ void ml_m2(const Params& p, const Ctx& cx) {
  const int tid = cx.tid, lane = tid & 63, wave = tid >> 6, fr = lane & 15, fq = lane >> 4;
  char* ws = cx.ws;
  const bf16_t* QK = (const bf16_t*)(ws + O_QK); const bf16_t* KT = (const bf16_t*)(ws + O_KT); const bf16_t* VT = (const bf16_t*)(ws + O_VT);
  const bf16_t* SP = (const bf16_t*)(ws + O_SP);
  bf16_t* HD = (bf16_t*)(ws + O_HD);
  const float* WIN = (const float*)(ws + O_WIN); const float* FLO = (const float*)(ws + O_FLO); const float* DEN = (const float*)(ws + O_DEN); const float* WSS = (const float*)(ws + O_WSS);
  const float* DEC = (const float*)(ws + O_GC) + 2 * NSEQ * NCH;
  f32x4* red = (f32x4*)lds_raw;
  f32x4* rn = (f32x4*)(lds_raw + 131072);
  for (int idx = cx.bid >> 3; idx < 2 * NSL; idx += cx.nb >> 3) {
    const int seq = (cx.bid & 7) * 2 + idx / NSL, es = idx % NSL, x = (seq >> 2) & 1, h = seq & 3, bl = seq >> 3;
    const int d0 = wave * 64, e0 = es * 16 * NEB;
    f32x4 C[4][NEB + 1];
#pragma unroll
    for (int a = 0; a < 4; ++a)
#pragma unroll
      for (int b = 0; b < NEB + 1; ++b) C[a][b] = (f32x4){0.f, 0.f, 0.f, 0.f};
    const int tbo = wave >> 1, ebo = __builtin_amdgcn_readfirstlane(wave & 1);
    bf16x8 qc[4][2], kf[4][2], sf0, sf1;
    u32x4 vr[NEB][2];
    f32x4 wv[2][2];
#define M2_LOAD_Q(ST) do { const int _t0 = ml_nchunk(x, (ST)) * 64; _Pragma("unroll") for (int tb = 0; tb < 4; ++tb) { \
        const bf16_t* qp = QK + (size_t)ml_lrow(bl, _t0 + tb * 16 + fr) * 4096 + h * DH + d0 + 4 * fq; \
        qc[tb][0] = mk8(*(const u32x2*)(qp), *(const u32x2*)(qp + 16)); qc[tb][1] = mk8(*(const u32x2*)(qp + 32), *(const u32x2*)(qp + 48)); } } while (0)
#define M2_LOAD_KV(ST) do { const int _nc = ml_nchunk(x, (ST)), _t0 = _nc * 64; \
        _Pragma("unroll") for (int db = 0; db < 4; ++db) { const bf16_t* kp = KT + ((size_t)bl * EI + h * DH + d0 + db * 16 + fr) * TOKB + _t0 + 8 * fq; \
          kf[db][0] = *(const bf16x8*)kp; kf[db][1] = *(const bf16x8*)(kp + 32); } \
        _Pragma("unroll") for (int eb = 0; eb < NEB; ++eb) { const bf16_t* vp = VT + ((size_t)bl * EI + h * DH + e0 + eb * 16 + fr) * TOKB + _t0 + 8 * fq; \
          vr[eb][0] = *(const u32x4*)vp; vr[eb][1] = *(const u32x4*)(vp + 32); } \
        _Pragma("unroll") for (int ks = 0; ks < 2; ++ks) { const float* wp = WSS + (size_t)seq * TOKB + _t0 + 32 * ks + 8 * fq; \
          wv[ks][0] = *(const f32x4*)wp; wv[ks][1] = *(const f32x4*)(wp + 4); } \
        const bf16_t* sp = SP + (size_t)(seq * NCH + _nc) * 4096 + (tbo * 16 + fr) * 64 + 8 * fq; \
        sf0 = *(const bf16x8*)sp; sf1 = *(const bf16x8*)(sp + 32); } while (0)
    M2_LOAD_Q(0); M2_LOAD_KV(0);
    for (int st = 0; st < NCH; ++st) {
      const int nc = ml_nchunk(x, st), tok0 = nc * 64, stn = st + 1 < NCH ? st + 1 : st;
      const size_t tix = (size_t)seq * TOKB + tok0 + tbo * 16 + 4 * fq;
      const f32x4 win = *(const f32x4*)(WIN + tix), flo = *(const f32x4*)(FLO + tix), deni = *(const f32x4*)(DEN + tix);
      const float decay = DEC[seq * NCH + nc];
#pragma unroll
      for (int eb = 0; eb < NEB + 1; ++eb) {
        bf16x8 cb0, cb1;
        { const f32x4 lo = C[0][eb], hi = C[1][eb]; cb0 = mk8((u32x4){pk2(lo[0], lo[1]), pk2(lo[2], lo[3]), pk2(hi[0], hi[1]), pk2(hi[2], hi[3])}); }
        { const f32x4 lo = C[2][eb], hi = C[3][eb]; cb1 = mk8((u32x4){pk2(lo[0], lo[1]), pk2(lo[2], lo[3]), pk2(hi[0], hi[1]), pk2(hi[2], hi[3])}); }
        f32x4 pa[4];
#pragma unroll
        for (int tb = 0; tb < 4; ++tb) pa[tb] = MFMA16(qc[tb][0], cb0, ((f32x4){0.f, 0.f, 0.f, 0.f}));
#pragma unroll
        for (int tb = 0; tb < 4; ++tb) pa[tb] = MFMA16(qc[tb][1], cb1, pa[tb]);
#pragma unroll
        for (int tb = 0; tb < 4; ++tb) {
          if (eb < NEB) red[((wave * 4 + tb) * NEB + eb) * 64 + lane] = pa[tb];
          else if (fr == 0) rn[(wave * 4 + tb) * 4 + fq] = pa[tb];
        }
      }
      M2_LOAD_Q(stn);
      f32x4 oi = {0.f, 0.f, 0.f, 0.f};
#pragma unroll
      for (int eb = 0; eb < NEB + 1; ++eb) {
        bf16x8 vw0, vw1;
        if (eb < NEB) {
          const u32x4 r0 = vr[eb][0], r1 = vr[eb][1];
          if (eb == ebo) { oi = MFMA16(sf0, mk8(r0), oi); oi = MFMA16(sf1, mk8(r1), oi); }
          vw0 = mk8((u32x4){pk2(bflo(r0.x) * wv[0][0][0], bfhi(r0.x) * wv[0][0][1]), pk2(bflo(r0.y) * wv[0][0][2], bfhi(r0.y) * wv[0][0][3]),
                            pk2(bflo(r0.z) * wv[0][1][0], bfhi(r0.z) * wv[0][1][1]), pk2(bflo(r0.w) * wv[0][1][2], bfhi(r0.w) * wv[0][1][3])});
          vw1 = mk8((u32x4){pk2(bflo(r1.x) * wv[1][0][0], bfhi(r1.x) * wv[1][0][1]), pk2(bflo(r1.y) * wv[1][0][2], bfhi(r1.y) * wv[1][0][3]),
                            pk2(bflo(r1.z) * wv[1][1][0], bfhi(r1.z) * wv[1][1][1]), pk2(bflo(r1.w) * wv[1][1][2], bfhi(r1.w) * wv[1][1][3])});
        } else {
          vw0 = mk8((u32x4){pk2(wv[0][0][0], wv[0][0][1]), pk2(wv[0][0][2], wv[0][0][3]), pk2(wv[0][1][0], wv[0][1][1]), pk2(wv[0][1][2], wv[0][1][3])});
          vw1 = mk8((u32x4){pk2(wv[1][0][0], wv[1][0][1]), pk2(wv[1][0][2], wv[1][0][3]), pk2(wv[1][1][0], wv[1][1][1]), pk2(wv[1][1][2], wv[1][1][3])});
        }
#pragma unroll
        for (int db = 0; db < 4; ++db) {
          f32x4 c = C[db][eb] * decay;
          c = MFMA16(kf[db][0], vw0, c); c = MFMA16(kf[db][1], vw1, c);
          C[db][eb] = c;
        }
      }
      asm volatile("s_waitcnt lgkmcnt(0)" ::: "memory");
      __builtin_amdgcn_s_barrier();
      asm volatile("" ::: "memory");
      f32x4 rdn[8], rd0[8];
#pragma unroll
      for (int w = 0; w < 8; ++w) { rdn[w] = rn[(w * 4 + tbo) * 4 + fq]; rd0[w] = red[((w * 4 + tbo) * NEB + ebo) * 64 + lane]; }
      const f32x4 pn = ((rdn[0] + rdn[1]) + (rdn[2] + rdn[3])) + ((rdn[4] + rdn[5]) + (rdn[6] + rdn[7]));
      const f32x4 pi = ((rd0[0] + rd0[1]) + (rd0[2] + rd0[3])) + ((rd0[4] + rd0[5]) + (rd0[6] + rd0[7]));
#pragma unroll
      for (int jj = 0; jj < 4; ++jj) {
        const float num = oi[jj] + win[jj] * pi[jj], den = deni[jj] + win[jj] * pn[jj];
        const float hv = num * __builtin_amdgcn_rcpf(fmaxf(fabsf(den), flo[jj]));
        HD[((size_t)x * RG + ml_lrow(bl, tok0 + tbo * 16 + 4 * fq + jj)) * EI + h * DH + e0 + ebo * 16 + fr] = (bf16_t)(pk2(hv, 0.f) & 0xffff);
      }
      M2_LOAD_KV(stn);
      asm volatile("s_waitcnt lgkmcnt(0)" ::: "memory");
      __builtin_amdgcn_s_barrier();
      asm volatile("" ::: "memory");
    }
    __syncthreads();
#undef M2_LOAD_Q
#undef M2_LOAD_KV
  }
}

__device__ __forceinline__ void ml_fin(const Params& p, const Ctx& cx, int j) {
  const int lane = cx.tid & 63, gw = cx.bid * 8 + (cx.tid >> 6), NGW = cx.nb * 8;
  char* ws = cx.ws;
  const bf16_t* XZ = (const bf16_t*)(ws + O_XZ); const bf16_t* HD = (const bf16_t*)(ws + O_HD);
  bf16_t* FIN = (bf16_t*)(ws + O_FIN);
  for (int u = gw; u < RG * 4; u += NGW) {
    const int lr = u >> 2, h = u & 3, f0 = h * DH + lane * 8;
    int pos, seglen;
    if (lr < GB * SEQ) { pos = lr & (SEQ - 1); seglen = SEQ; } else { pos = (lr - GB * SEQ) & (LC - 1); seglen = LC; }
    const u32x4 hf = *(const u32x4*)(HD + (size_t)lr * EI + f0), hb = *(const u32x4*)(HD + ((size_t)RG + lr) * EI + f0);
    const u32x4 zz = *(const u32x4*)(XZ + (size_t)lr * 4096 + 2048 + f0);
    const u32x4 x1 = *(const u32x4*)(XZ + (size_t)lr * 4096 + f0);
    u32x4 x0 = {0u, 0u, 0u, 0u}, x2 = {0u, 0u, 0u, 0u};
    if (pos > 0) x0 = *(const u32x4*)(XZ + (size_t)(lr - 1) * 4096 + f0);
    if (pos < seglen - 1) x2 = *(const u32x4*)(XZ + (size_t)(lr + 1) * 4096 + f0);
    float hv[8], xm0[8], xm1[8], xm2[8];
    const unsigned hfu[4] = {hf.x, hf.y, hf.z, hf.w}, hbu[4] = {hb.x, hb.y, hb.z, hb.w}, zu[4] = {zz.x, zz.y, zz.z, zz.w};
    const unsigned x0u[4] = {x0.x, x0.y, x0.z, x0.w}, x1u[4] = {x1.x, x1.y, x1.z, x1.w}, x2u[4] = {x2.x, x2.y, x2.z, x2.w};
    float s = 0.f;
#pragma unroll
    for (int i = 0; i < 4; ++i) {
      hv[2 * i] = (bflo(hfu[i]) + bflo(hbu[i])) * sigm_f(bflo(zu[i]));
      hv[2 * i + 1] = (bfhi(hfu[i]) + bfhi(hbu[i])) * sigm_f(bfhi(zu[i]));
      xm0[2 * i] = bflo(x0u[i]); xm0[2 * i + 1] = bfhi(x0u[i]); xm1[2 * i] = bflo(x1u[i]); xm1[2 * i + 1] = bfhi(x1u[i]); xm2[2 * i] = bflo(x2u[i]); xm2[2 * i + 1] = bfhi(x2u[i]);
      s += hv[2 * i] + hv[2 * i + 1];
    }
    const float mean = wave_sum(s, lane) * (1.f / DH); float s2 = 0.f;
#pragma unroll
    for (int i = 0; i < 8; ++i) { hv[i] -= mean; s2 += hv[i] * hv[i]; }
    const float rstd = __builtin_amdgcn_rsqf(wave_sum(s2, lane) * (1.f / DH) + LN_EPS);
    float o[8];
#pragma unroll
    for (int i = 0; i < 8; ++i) {
      const int f = f0 + i;
      const float xc = silu_f(IN(11)[(size_t)(j * 3 + 0) * EI + f] * xm0[i] + IN(11)[(size_t)(j * 3 + 1) * EI + f] * xm1[i] + IN(11)[(size_t)(j * 3 + 2) * EI + f] * xm2[i] + IN(12)[(size_t)j * EI + f]);
      o[i] = hv[i] * rstd * IN(17)[(size_t)j * EI + f] + IN(16)[(size_t)j * EI + f] * xc;
    }
    u32x4 ov; ov.x = pk2(o[0], o[1]); ov.y = pk2(o[2], o[3]); ov.z = pk2(o[4], o[5]); ov.w = pk2(o[6], o[7]);
    *(u32x4*)(FIN + (size_t)lr * EI + f0) = ov;
  }
}

__device__ __forceinline__ void at_prep(const Params& p, const Ctx& cx) {
  const int lane = cx.tid & 63, gw = cx.bid * 8 + (cx.tid >> 6), NGW = cx.nb * 8;
  char* ws = cx.ws;
  bf16_t* ACT = (bf16_t*)(ws + O_ACT); bf16_t* KR = (bf16_t*)(ws + O_AKR); bf16_t* VT = (bf16_t*)(ws + O_AVT);
  const float* rc = (const float*)(ws + O_ROPE); const float* rs = rc + 4096 * 32;
  for (int row = gw; row < MROWS; row += NGW) {
    const bool lat = row < NLAT;
    const int b = lat ? row >> 12 : (row - NLAT) >> 8, pos = lat ? row & 4095 : (row - NLAT) & 255, tok = lat ? LC + pos : pos;
    bf16_t* rp = ACT + (size_t)row * 1536;
    {
      const u32x4 a = *(const u32x4*)(rp + 16 * lane), b2 = *(const u32x4*)(rp + 16 * lane + 8);
      const unsigned w[8] = {a.x, a.y, a.z, a.w, b2.x, b2.y, b2.z, b2.w};
      unsigned o[8];
      const int pp0 = (lane & 3) * 8;
#pragma unroll
      for (int i = 0; i < 8; ++i) {
        float x1 = bflo(w[i]) * 0.125f, x2 = bfhi(w[i]) * 0.125f;
        if (lat) { const float c = rc[pos * 32 + pp0 + i], s = rs[pos * 32 + pp0 + i]; const float y1 = x1 * c - x2 * s, y2 = x1 * s + x2 * c; x1 = y1; x2 = y2; }
        o[i] = pk2(x1, x2);
      }
      *(u32x4*)(rp + 16 * lane) = (u32x4){o[0], o[1], o[2], o[3]}; *(u32x4*)(rp + 16 * lane + 8) = (u32x4){o[4], o[5], o[6], o[7]};
    }
    {
      const u32x2 a = *(const u32x2*)(rp + 1024 + 4 * lane);
      const unsigned w[2] = {a.x, a.y}; unsigned o[2];
      const int g = lane >> 4, dd = (lane & 15) * 4, pp0 = dd >> 1;
#pragma unroll
      for (int i = 0; i < 2; ++i) {
        float x1 = bflo(w[i]), x2 = bfhi(w[i]);
        if (lat) { const float c = rc[pos * 32 + pp0 + i], s = rs[pos * 32 + pp0 + i]; const float y1 = x1 * c - x2 * s, y2 = x1 * s + x2 * c; x1 = y1; x2 = y2; }
        o[i] = pk2(x1, x2);
      }
      *(u32x2*)(KR + (((size_t)b * 4 + g) * TOKB + tok) * 64 + dd) = (u32x2){o[0], o[1]};
      const u32x2 v = *(const u32x2*)(rp + 1280 + 4 * lane);
      bf16_t* vp = VT + (((size_t)b * 4 + g) * 64 + dd) * TOKB + tok;
      vp[0] = (bf16_t)(v.x & 0xffff); vp[TOKB] = (bf16_t)(v.x >> 16); vp[2 * TOKB] = (bf16_t)(v.y & 0xffff); vp[3 * TOKB] = (bf16_t)(v.y >> 16);
    }
  }
}

__device__ __forceinline__ void at_core(const Params& p, const Ctx& cx) {
  const int lane = cx.tid & 63, gw = cx.bid * 8 + (cx.tid >> 6), NGW = cx.nb * 8, fr = lane & 15, fq = lane >> 4;
  char* ws = cx.ws;
  const bf16_t* ACT = (const bf16_t*)(ws + O_ACT); const bf16_t* KR = (const bf16_t*)(ws + O_AKR); const bf16_t* VT = (const bf16_t*)(ws + O_AVT);
  bf16_t* O = (bf16_t*)(ws + O_U);
  for (int u = gw; u < (MROWS / 16) * 4; u += NGW) {
    const int g = u & 3, qb = u >> 2, row0 = qb * 16;
    const bool lat = row0 < NLAT;
    const int b = lat ? row0 >> 12 : (row0 - NLAT) >> 8, q0 = lat ? row0 & 4095 : 0;
    bf16x8 qf[4][2];
    float mrun[4], lrun[4], sink[4];
    f32x4 oacc[4][4];
#pragma unroll
    for (int hh = 0; hh < 4; ++hh) {
      const bf16_t* qp = ACT + (size_t)(row0 + fr) * 1536 + (g * 4 + hh) * 64 + 8 * fq;
      qf[hh][0] = *(const bf16x8*)qp; qf[hh][1] = *(const bf16x8*)(qp + 32);
      sink[hh] = IN(20)[g * 4 + hh]; mrun[hh] = sink[hh]; lrun[hh] = 0.f;
#pragma unroll
      for (int d2 = 0; d2 < 4; ++d2) oacc[hh][d2] = (f32x4){0.f, 0.f, 0.f, 0.f};
    }
    const bf16_t* kbase = KR + ((size_t)b * 4 + g) * TOKB * 64;
    const bf16_t* vbase = VT + ((size_t)b * 4 + g) * 64 * TOKB;
    int wlo = 0, whi = -1;
    if (lat) { wlo = max(0, q0 - 128) & ~31; whi = min(SEQ - 1, q0 + 143); }
    const int nwin = lat ? (whi - wlo) / 32 + 1 : 0;
    for (int ti = 0; ti < 8 + nwin; ++ti) {
      const bool isw = ti >= 8;
      const int kpos0 = isw ? wlo + (ti - 8) * 32 : 0;
      const int tk0 = isw ? LC + kpos0 : ti * 32;
      const bf16_t* kp = kbase + (size_t)(tk0 + fr) * 64 + 8 * fq;
      const bf16x8 k00 = *(const bf16x8*)kp, k01 = *(const bf16x8*)(kp + 32), k10 = *(const bf16x8*)(kp + 16 * 64), k11 = *(const bf16x8*)(kp + 16 * 64 + 32);
      bf16x8 vfr[4];
#pragma unroll
      for (int d2 = 0; d2 < 4; ++d2) {
        const bf16_t* vp = vbase + (size_t)(d2 * 16 + fr) * TOKB + tk0 + 4 * fq;
        vfr[d2] = mk8(*(const u32x2*)vp, *(const u32x2*)(vp + 16));
      }
      bool okm[8];
#pragma unroll
      for (int i = 0; i < 8; ++i) {
        const int kpos = kpos0 + (i >> 2) * 16 + 4 * fq + (i & 3), dlt = (q0 + fr) - kpos;
        okm[i] = !isw || (dlt <= 128 && dlt >= -128);
      }
#pragma unroll
      for (int hh = 0; hh < 4; ++hh) {
        f32x4 s0 = {0.f, 0.f, 0.f, 0.f}, s1 = {0.f, 0.f, 0.f, 0.f};
        s0 = MFMA16(k00, qf[hh][0], s0); s0 = MFMA16(k01, qf[hh][1], s0);
        s1 = MFMA16(k10, qf[hh][0], s1); s1 = MFMA16(k11, qf[hh][1], s1);
        float sv[8]; float tmax = -3.0e38f;
#pragma unroll
        for (int i = 0; i < 8; ++i) { sv[i] = okm[i] ? (i < 4 ? s0[i] : s1[i - 4]) : -3.0e38f; tmax = fmaxf(tmax, sv[i]); }
        tmax = fmaxf(tmax, shx(tmax, 16, lane)); tmax = fmaxf(tmax, shx(tmax, 32, lane));
        const float mnew = fmaxf(mrun[hh], tmax), scale = __expf(mrun[hh] - mnew);
        mrun[hh] = mnew;
        float pv[8];
#pragma unroll
        for (int i = 0; i < 8; ++i) pv[i] = okm[i] ? __expf(sv[i] - mnew) : 0.f;
        const u32x4 pu = {pk2(pv[0], pv[1]), pk2(pv[2], pv[3]), pk2(pv[4], pv[5]), pk2(pv[6], pv[7])};
        const float ps = ((bflo(pu.x) + bfhi(pu.x)) + (bflo(pu.y) + bfhi(pu.y))) + ((bflo(pu.z) + bfhi(pu.z)) + (bflo(pu.w) + bfhi(pu.w)));
        lrun[hh] = lrun[hh] * scale + ps;
        const bf16x8 pf = mk8(pu);
        float scq[4];
#pragma unroll
        for (int jj = 0; jj < 4; ++jj) scq[jj] = shi(scale, 4 * fq + jj);
#pragma unroll
        for (int d2 = 0; d2 < 4; ++d2) {
          f32x4 o = oacc[hh][d2];
          o[0] *= scq[0]; o[1] *= scq[1]; o[2] *= scq[2]; o[3] *= scq[3];
          oacc[hh][d2] = MFMA16(pf, vfr[d2], o);
        }
      }
    }
#pragma unroll
    for (int hh = 0; hh < 4; ++hh) {
      float l = lrun[hh];
      l += shx(l, 16, lane); l += shx(l, 32, lane);
      l += __expf(sink[hh] - mrun[hh]);
      const float inv = __builtin_amdgcn_rcpf(l);
      float iq[4];
#pragma unroll
      for (int jj = 0; jj < 4; ++jj) iq[jj] = shi(inv, 4 * fq + jj);
#pragma unroll
      for (int d2 = 0; d2 < 4; ++d2)
#pragma unroll
        for (int jj = 0; jj < 4; ++jj)
          O[(size_t)(row0 + 4 * fq + jj) * D + (g * 4 + hh) * 64 + d2 * 16 + fr] = (bf16_t)(pk2(oacc[hh][d2][jj] * iq[jj], 0.f) & 0xffff);
    }
  }
}

__device__ __forceinline__ void sc_conv(const Params& p, const Ctx& cx) {
  const int gt = cx.bid * 512 + cx.tid, gs = cx.nb * 512;
  const bf16_t* ACT = (const bf16_t*)(cx.ws + O_ACT); bf16_t* O = (bf16_t*)(cx.ws + O_U);
  const float* cw = IN(23);
  for (int i = gt; i < MROWS * 128; i += gs) {
    const int row = i >> 7, c0 = (i & 127) * 8;
    int pos, seglen;
    if (row < NLAT) { pos = row & (SEQ - 1); seglen = SEQ; } else { pos = (row - NLAT) & (LC - 1); seglen = LC; }
    float accv[8];
#pragma unroll
    for (int e = 0; e < 8; ++e) accv[e] = 0.f;
#pragma unroll
    for (int k = 0; k < 3; ++k) {
      const int pp = pos + k - 1;
      if (pp < 0 || pp >= seglen) continue;
      const bf16_t* rp = ACT + (size_t)(row + k - 1) * 3072;
      const u32x4 cgv = *(const u32x4*)(rp + 1024 + c0), xtv = *(const u32x4*)(rp + 2048 + c0);
      const unsigned cu[4] = {cgv.x, cgv.y, cgv.z, cgv.w}, xu[4] = {xtv.x, xtv.y, xtv.z, xtv.w};
#pragma unroll
      for (int e = 0; e < 4; ++e) {
        accv[2 * e] += cw[k * D + c0 + 2 * e] * (bflo(cu[e]) * bflo(xu[e]));
        accv[2 * e + 1] += cw[k * D + c0 + 2 * e + 1] * (bfhi(cu[e]) * bfhi(xu[e]));
      }
    }
    const u32x4 bgv = *(const u32x4*)(ACT + (size_t)row * 3072 + c0);
    const unsigned bu[4] = {bgv.x, bgv.y, bgv.z, bgv.w};
    u32x4 o;
    o.x = pk2(bflo(bu[0]) * accv[0], bfhi(bu[0]) * accv[1]); o.y = pk2(bflo(bu[1]) * accv[2], bfhi(bu[1]) * accv[3]);
    o.z = pk2(bflo(bu[2]) * accv[4], bfhi(bu[2]) * accv[5]); o.w = pk2(bflo(bu[3]) * accv[6], bfhi(bu[3]) * accv[7]);
    *(u32x4*)(O + (size_t)row * D + c0) = o;
  }
}

#define XB_TMO      128
#define XB_XCNT(j)  (256  + 64 * (j))
#define XB_XSUB(j)  (1280 + 64 * (j))
#define XB_XGEN(j)  (2304 + 64 * (j))
#define XB_TOP      3328
#define XB_TOPGEN   3392
#define XCD_BAR_WORDS 3456
#define XB_SPIN_CAP (1u << 18)
__device__ __forceinline__ unsigned xb_ld(unsigned* p)              { return __hip_atomic_load(p, __ATOMIC_RELAXED, __HIP_MEMORY_SCOPE_AGENT); }
__device__ __forceinline__ unsigned xb_add(unsigned* p, unsigned v) { return __hip_atomic_fetch_add(p, v, __ATOMIC_RELAXED, __HIP_MEMORY_SCOPE_AGENT); }
__device__ __forceinline__ unsigned xb_xcc_id() { return (unsigned)__builtin_amdgcn_s_getreg((3 << 11) | 20) & 0xFu; }
#define XB_SPIN(cond, bar) do { unsigned _sp = 0; while (cond) { __builtin_amdgcn_s_sleep(1); \
    if ((++_sp & 255u) == 0u) { if (xb_ld(&(bar)[XB_TMO])) break; if (_sp > XB_SPIN_CAP) { atomicAdd(&(bar)[XB_TMO], 1u); break; } } } } while (0)
__device__ __forceinline__ void xcd_barrier_complete(unsigned* bar, unsigned x, unsigned& nloc, unsigned& nx) {
  const unsigned G = gridDim.x;
  unsigned sum, cnt, mine, sp = 0u;
  for (;;) {
    sum = 0u; cnt = 0u; mine = 0u;
#pragma unroll
    for (unsigned j = 0; j < 16; ++j) { const unsigned c = xb_ld(&bar[XB_XCNT(j)]); sum += c; cnt += (c > 0u) ? 1u : 0u; mine = (j == x) ? c : mine; }
    if (sum == G) break;
    __builtin_amdgcn_s_sleep(1);
    if ((++sp & 255u) == 0u) { if (xb_ld(&bar[XB_TMO])) break; if (sp > XB_SPIN_CAP) { atomicAdd(&bar[XB_TMO], 1u); break; } }
  }
  nloc = mine > 0u ? mine : 1u; nx = cnt > 0u ? cnt : 1u;
}
__device__ __forceinline__ void xcd_barrier(unsigned* bar, unsigned x, volatile LAS unsigned* st) {
  asm volatile("s_waitcnt vmcnt(0)" ::: "memory");
  __syncthreads();
  if (threadIdx.x == 0) {
    __builtin_amdgcn_s_waitcnt(0);
    unsigned nloc = st[0], nx = st[1];
    if (nloc == 0u) { xcd_barrier_complete(bar, x, nloc, nx); st[0] = nloc; st[1] = nx; }
    const unsigned old = xb_add(&bar[XB_XSUB(x)], 1u);
    const unsigned gen = old / nloc;
    if (old + 1u == (gen + 1u) * nloc) {
      __builtin_amdgcn_fence(__ATOMIC_RELEASE, "agent");
      asm volatile("s_waitcnt vmcnt(0)" ::: "memory");
      const unsigned og = xb_add(&bar[XB_TOP], 1u);
      const unsigned tg = og / nx;
      if (og + 1u == (tg + 1u) * nx) xb_add(&bar[XB_TOPGEN], 1u);
      else XB_SPIN(xb_ld(&bar[XB_TOPGEN]) == tg, bar);
      __builtin_amdgcn_fence(__ATOMIC_ACQUIRE, "agent");
      xb_add(&bar[XB_XGEN(x)], 1u);
      asm volatile("s_waitcnt vmcnt(0)" ::: "memory");
    } else {
      XB_SPIN(xb_ld(&bar[XB_XGEN(x)]) == gen, bar);
      __builtin_amdgcn_fence(__ATOMIC_ACQUIRE, "agent");
      asm volatile("s_waitcnt vmcnt(0)" ::: "memory");
    }
  }
  __syncthreads();
}

#ifndef ENMASK
#define ENMASK 0xffff
#endif
#define EN(i) ((ENMASK >> (i)) & 1)
enum { OP_PRO = 0, OP_LN0, OP_LN1, OP_LNF, OP_FFI, OP_FFO, OP_UP, OP_M0, OP_GAT, OP_S, OP_M2, OP_FIN, OP_DN, OP_AQ, OP_APREP, OP_ACORE, OP_AO, OP_SI, OP_SCONV, OP_SO, OP_DNUP };
__global__ void __launch_bounds__(512) fwd_megakernel(Params p) {
  cg::grid_group grid = cg::this_grid();
  const int wave_s = __builtin_amdgcn_readfirstlane((int)threadIdx.x >> 6);
  volatile LAS unsigned* xst = (volatile LAS unsigned*)((LAS unsigned char*)lds_raw + (LDS_BYTES - 16));
  if (threadIdx.x == 0) { xst[0] = 0u; xst[1] = 0u; }
  __syncthreads();
  unsigned* xbar = (unsigned*)(p.ws + O_BAR);
  const unsigned xcc = xb_xcc_id();
  if (threadIdx.x == 0) (void)xb_add(&xbar[XB_XCNT(xcc)], 1u);
#ifdef DUP_OP
  int rep = 0;
#endif
  for (int ph = 0; ph < p.nph; ++ph) {
    const unsigned w = p.prog[ph];
    const int op = w & 255, a = (w >> 8) & 255, b = (w >> 16) & 255, c = (w >> 24) & 255;
#define MKCTX int z; asm volatile("s_mov_b32 %0, 0" : "=s"(z)); \
    GAS char* wsq = (GAS char*)p.ws; GAS float* outq = (GAS float*)p.out; int bidq = (int)blockIdx.x, nbq = (int)gridDim.x; \
    asm volatile("" : "+s"(wsq), "+s"(outq), "+s"(bidq), "+s"(nbq)); \
    const Ctx cx{wave_s * 64 + (int)__builtin_amdgcn_mbcnt_hi(~0u, __builtin_amdgcn_mbcnt_lo(~0u, (unsigned)z)), bidq, nbq, z, (char*)wsq, (float*)outq};
    if (EN(0) && op == OP_PRO) { MKCTX prologue(p, cx); }
    else if (EN(1) && op == OP_LN0) { MKCTX lnmod_phase<0>(p, cx, 0, 0, 0); }
    else if (EN(1) && op == OP_LN1) { MKCTX lnmod_phase<1>(p, cx, a, b, c); }
    else if (EN(1) && op == OP_LNF) { MKCTX lnmod_phase<2>(p, cx, a, 0, 0); }
    else if (EN(2) && op == OP_M0) { MKCTX ml_m0(p, cx, a); }
    else if (EN(3) && op == OP_GAT) { MKCTX ml_gates(p, cx, a); }
    else if (EN(4) && op == OP_S) { MKCTX ml_s(p, cx); }
    else if (EN(5) && op == OP_M2) { MKCTX ml_m2(p, cx); }
    else if (EN(6) && op == OP_FIN) { MKCTX ml_fin(p, cx, a); }
    else if (EN(7) && op == OP_APREP) { MKCTX at_prep(p, cx); }
    else if (EN(8) && op == OP_ACORE) { MKCTX at_core(p, cx); }
    else if (EN(9) && op == OP_SCONV) { MKCTX sc_conv(p, cx); }
    else if (EN(10)) {
      MKCTX
      char* ws = cx.ws;
      const RowMap idm{0, 0, 1 << 30};
      bf16_t* U = (bf16_t*)(ws + O_U); bf16_t* ACT = (bf16_t*)(ws + O_ACT);
      const float* MODT = (const float*)(ws + O_MODT);
      const int nrep = op == OP_DNUP ? 2 : 1;
      for (int rep = 0; rep < nrep; ++rep) {
        const int op2 = op == OP_DNUP ? (rep == 0 ? (int)OP_UP : (int)OP_DN) : op;
        const int c2 = (op == OP_DNUP && rep == 0) ? c + 1 : c;
        Ctx cg_ = cx;
        if (op == OP_DNUP && rep == 1) cg_.bid = (cx.bid + cx.nb - 32) % cx.nb;
        const bf16_t* A = U; const bf16_t* Bt; int K = 1024, nM = MROWS / 256, nN; RowMap am = idm, cm = idm;
        Epi E; E.kind = 2; E.O = ACT; E.ldc = 0; E.modl = MODT + (size_t)b * 9 * 9216; E.slot = 1; E.wgt = 1.0f;
        if (op2 == OP_FFI) { Bt = (const bf16_t*)(ws + O_WFI) + (size_t)a * 5632 * 1024; nN = 22; E.kind = 1; if (c) nM = NLAT / 256; }
        else if (op2 == OP_FFO) { A = ACT; Bt = (const bf16_t*)(ws + O_WFO) + (size_t)a * 1024 * 2816; K = 2816; nN = 4; E.slot = c & 3; E.wgt = 0.5f; if (c & 4) nM = NLAT / 256; }
        else if (op2 == OP_UP) { Bt = (const bf16_t*)(ws + O_WUP) + (size_t)a * 4096 * 1024; nM = RG / 256; nN = 16; am = RowMap{c2 * GB * SEQ, NLAT + c2 * GB * LC, GB * SEQ / 256}; E.kind = 0; E.O = (bf16_t*)(ws + O_XZ); E.ldc = 4096; }
        else if (op2 == OP_DN) { A = (const bf16_t*)(ws + O_FIN); Bt = (const bf16_t*)(ws + O_WDN) + (size_t)a * 1024 * 2048; K = 2048; nM = RG / 256; nN = 4; cm = RowMap{c2 * GB * SEQ, NLAT + c2 * GB * LC, GB * SEQ / 256}; }
        else if (op2 == OP_AQ) { Bt = (const bf16_t*)(ws + O_WAQ); nN = 6; E.kind = 0; E.ldc = 1536; }
        else if (op2 == OP_AO) { Bt = (const bf16_t*)(ws + O_WAO); nN = 4; }
        else if (op2 == OP_SI) { Bt = (const bf16_t*)(ws + O_WSI); nN = 12; E.kind = 0; E.ldc = 3072; }
        else { Bt = (const bf16_t*)(ws + O_WSO); nN = 4; }
        gemm_phase(cg_, A, am, Bt, K, nM, nN, cm, E);
      }
    }
    if (ph == 0) grid.sync(); else xcd_barrier(xbar, xcc, xst);
#ifdef DUP_OP
    if (op == DUP_OP && rep + 1 < DUP_N) { ++rep; --ph; } else rep = 0;
#endif
  }
}

static int build_program(unsigned* prog) {
  int n = 0;
  auto W = [&](int op, int a, int b, int c) { prog[n++] = (unsigned)op | ((unsigned)a << 8) | ((unsigned)b << 16) | ((unsigned)c << 24); };
  W(OP_PRO, 0, 0, 0);
  W(OP_LN0, 0, 0, 0);
  for (int layer = 0; layer < DEPTH; ++layer) {
    const int kind = layer % 3, j = layer / 3;
    W(OP_FFI, layer * 2, layer, 0); W(OP_FFO, layer * 2, layer, 0);
    W(OP_LN1, layer * 3 + 0, layer, 1);
    if (kind == 0) {
      for (int g = 0; g < NG; ++g) { if (g == 0) W(OP_UP, j, layer, g); W(OP_M0, j, 0, 0); W(OP_GAT, j, 0, 0); W(OP_S, 0, 0, 0); W(OP_M2, 0, 0, 0); W(OP_FIN, j, 0, 0); W(g + 1 < NG ? OP_DNUP : OP_DN, j, layer, g); }
    } else if (kind == 1) { W(OP_AQ, 0, layer, 0); W(OP_APREP, 0, 0, 0); W(OP_ACORE, 0, 0, 0); W(OP_AO, 0, layer, 0); }
    else { W(OP_SI, 0, layer, 0); W(OP_SCONV, 0, 0, 0); W(OP_SO, 0, layer, 0); }
    W(OP_LN1, layer * 3 + 1, layer, 2);
    const int lo = (layer + 1 == DEPTH) ? 1 : 0;
    W(OP_FFI, layer * 2 + 1, layer, lo); W(OP_FFO, layer * 2 + 1, layer, 2 | (lo << 2));
    if (layer + 1 < DEPTH) W(OP_LN1, layer * 3 + 2, layer + 1, 0); else W(OP_LNF, layer * 3 + 2, 0, 0);
  }
  return n;
}

extern "C" void kernel_launch(void* const* d_in, const int* in_sizes, int n_in, void* d_out, int out_size, void* d_ws, size_t ws_size, hipStream_t stream) {
  static int grid_blocks = 0;
  if (!grid_blocks) {
    int dev = 0, cus = 0, per_cu = 0;
    (void)hipGetDevice(&dev);
    (void)hipDeviceGetAttribute(&cus, hipDeviceAttributeMultiprocessorCount, dev);
    (void)hipFuncSetAttribute((const void*)fwd_megakernel, hipFuncAttributeMaxDynamicSharedMemorySize, LDS_BYTES);
    (void)hipOccupancyMaxActiveBlocksPerMultiprocessor(&per_cu, fwd_megakernel, 512, LDS_BYTES);
    if (cus <= 0) cus = 256;
    grid_blocks = cus;
    if (ws_size < WS_END || n_in != 25) fprintf(stderr, "kernel_launch: workspace %zu < %zu or n_in %d != 25\n", ws_size, (size_t)WS_END, n_in);
    if (per_cu < 1) fprintf(stderr, "kernel_launch: occupancy query says %d blocks per CU\n", per_cu);
  }
  Params p{};
  for (int i = 0; i < 25; ++i) p.in[i] = (const float*)d_in[i];
  p.out = (float*)d_out; p.ws = (char*)d_ws;
  p.nph = build_program(p.prog);
  (void)hipMemsetAsync((char*)d_ws + O_BAR, 0, XCD_BAR_WORDS * 4, stream);
  void* args[] = {&p};
  hipError_t e = hipLaunchCooperativeKernel((void*)fwd_megakernel, dim3(grid_blocks), dim3(512), args, LDS_BYTES, stream);
  if (e != hipSuccess) fprintf(stderr, "cooperative launch failed: %s (grid %d)\n", hipGetErrorString(e), grid_blocks);
}
```

```cpp
#include <hip/hip_runtime.h>
#include <hip/hip_cooperative_groups.h>
#include <cstdio>
#include <cstdint>
namespace cg = cooperative_groups;

typedef unsigned short bf16_t;
typedef short bf16x8 __attribute__((ext_vector_type(8)));
typedef short bf16x4 __attribute__((ext_vector_type(4)));
typedef float f32x4 __attribute__((ext_vector_type(4)));
typedef unsigned u32x2 __attribute__((ext_vector_type(2)));
typedef unsigned u32x4 __attribute__((ext_vector_type(4)));

constexpr int D = 1024, NB = 8, SEQ = 4096, LC = 256, DEPTH = 4, FF = 2816, EI = 2048, DH = 512;
constexpr int NLAT = NB * SEQ, NCTX = NB * LC, MROWS = NLAT + NCTX;
constexpr int TOKB = LC + SEQ;
constexpr int NCH = TOKB / 64;
constexpr int GB = 2, NG = NB / GB, RG = GB * TOKB;
constexpr int NSEQ = GB * 8;
constexpr float ALPHA = 1.681792830507429f, LN_EPS = 1e-5f;
constexpr int LDS_BYTES = 144 * 1024;

constexpr size_t al256(size_t x) { return (x + 255) & ~(size_t)255; }
constexpr size_t O_WFI = 0;
constexpr size_t O_WFO = O_WFI + (size_t)8 * 5632 * 1024 * 2;
constexpr size_t O_WUP = O_WFO + (size_t)8 * 1024 * 2816 * 2;
constexpr size_t O_WDN = O_WUP + (size_t)2 * 4096 * 1024 * 2;
constexpr size_t O_WAQ = O_WDN + (size_t)2 * 1024 * 2048 * 2;
constexpr size_t O_WAO = O_WAQ + (size_t)1536 * 1024 * 2;
constexpr size_t O_WSI = O_WAO + (size_t)1024 * 1024 * 2;
constexpr size_t O_WSO = O_WSI + (size_t)3072 * 1024 * 2;
constexpr size_t O_WG = O_WSO + (size_t)1024 * 1024 * 2;
constexpr size_t O_MODT = O_WG + (size_t)2 * 16 * 6144 * 2;
constexpr size_t O_ROPE = O_MODT + (size_t)4 * 9 * 9216 * 4;
constexpr size_t O_HCTX = O_ROPE + (size_t)2 * 4096 * 32 * 4;
constexpr size_t O_U = O_HCTX + (size_t)NCTX * D * 4;
constexpr size_t O_R = O_U + (size_t)MROWS * D * 2;
constexpr size_t O_XZ = O_R;
constexpr size_t O_QK = O_XZ + (size_t)RG * 4096 * 2;
constexpr size_t O_KT = O_QK + (size_t)RG * 4096 * 2;
constexpr size_t O_VT = O_KT + (size_t)GB * EI * TOKB * 2;
constexpr size_t O_SP = O_VT + (size_t)GB * EI * TOKB * 2;
constexpr size_t O_HD = O_SP + (size_t)NSEQ * NCH * 4096 * 2;
constexpr size_t O_FIN = O_HD + (size_t)2 * RG * EI * 2;
constexpr size_t O_GAT = O_FIN + (size_t)RG * EI * 2;
constexpr size_t SZ_ST = (size_t)NSEQ * TOKB * 4;
constexpr size_t O_BL = O_GAT, O_IG = O_BL + SZ_ST, O_WIN = O_IG + SZ_ST, O_FLO = O_WIN + SZ_ST, O_DEN = O_FLO + SZ_ST, O_WSS = O_DEN + SZ_ST;
constexpr size_t O_GC = O_WSS + SZ_ST;
constexpr size_t O_REND_ML = O_GC + (size_t)3 * NSEQ * NCH * 4 + 256;
constexpr size_t O_ACT = O_R;
constexpr size_t O_AKR = O_R + (size_t)MROWS * 3072 * 2;
constexpr size_t O_AVT = O_AKR + (size_t)NB * 4 * TOKB * 64 * 2;
constexpr size_t O_REND_AT = O_AVT + (size_t)NB * 4 * TOKB * 64 * 2;
constexpr size_t O_BAR = (O_REND_ML > O_REND_AT ? O_REND_ML : O_REND_AT);
constexpr size_t WS_END = O_BAR + 3456 * 4 + 256;

struct Params {
  const float* in[25];
  float* out;
  char* ws;
  int nph; int pad0;
  unsigned prog[126];
};

#define GAS __attribute__((address_space(1)))
#define IN(k) ((const float*)(const GAS float*)p.in[(k) + cx.z])
struct Ctx { int tid, bid, nb, z; char* ws; float* out; };
extern __shared__ __attribute__((aligned(16))) char lds_raw[];

__device__ __forceinline__ unsigned pk2(float lo, float hi) { unsigned r; asm volatile("v_cvt_pk_bf16_f32 %0, %1, %2" : "=v"(r) : "v"(lo), "v"(hi)); return r; }
__device__ __forceinline__ float bf2f(unsigned short v) { return __uint_as_float(((unsigned)v) << 16); }
__device__ __forceinline__ float bflo(unsigned v) { return __uint_as_float(v << 16); }
__device__ __forceinline__ float bfhi(unsigned v) { return __uint_as_float(v & 0xffff0000u); }
__device__ __forceinline__ float silu_f(float x) { return x * __builtin_amdgcn_rcpf(1.f + __expf(-x)); }
__device__ __forceinline__ float sigm_f(float x) { return __builtin_amdgcn_rcpf(1.f + __expf(-x)); }
__device__ __forceinline__ float shi(float v, int srclane) { return __int_as_float(__builtin_amdgcn_ds_bpermute(srclane << 2, __float_as_int(v))); }
__device__ __forceinline__ float shx(float v, int m, int lane) { return shi(v, lane ^ m); }
__device__ __forceinline__ float wave_sum(float v, int lane) {
#pragma unroll
  for (int o = 1; o < 64; o <<= 1) v += shx(v, o, lane);
  return v;
}
__device__ __forceinline__ bf16x8 mk8(u32x4 v) { union { u32x4 u; bf16x8 b; } x; x.u = v; return x.b; }
__device__ __forceinline__ bf16x8 mk8(u32x2 a, u32x2 b) { union { u32x4 u; bf16x8 b; } x; x.u = (u32x4){a.x, a.y, b.x, b.y}; return x.b; }
__device__ __forceinline__ float* hrow(const Ctx& cx, int row) { return row < NLAT ? cx.out + (size_t)row * D : (float*)(cx.ws + O_HCTX) + (size_t)(row - NLAT) * D; }
#define MFMA16(a, b, c) __builtin_amdgcn_mfma_f32_16x16x32_bf16(a, b, c, 0, 0, 0)

constexpr int BM = 256, BK = 64, HALF = 128, HT = HALF * BK, NXCD = 8, WGM = 8;
__device__ __forceinline__ int lds_byte(int r, int c) {
  int st = (r >> 4) * 2 + (c >> 5), rr = r & 15, cc = c & 31, ob = rr * 64 + cc * 2;
  return st * 1024 + (ob ^ (((ob >> 9) & 1) << 5));
}
__device__ __forceinline__ void stage_rc(int b, int& R, int& C) {
  int st = b / 1024, sb = b % 1024, swz = sb ^ (((sb >> 9) & 1) << 5);
  R = (st >> 1) * 16 + swz / 64; C = (st & 1) * 32 + (swz % 64) / 2;
}
struct RowMap { int lat0, ctx0, nlat; __device__ __forceinline__ int row0(int pm) const { return pm < nlat ? lat0 + pm * 256 : ctx0 + (pm - nlat) * 256; } };

typedef f32x4 Acc[2][2][4][2];

struct Epi {
  int kind; bf16_t* O; int ldc; const float* modl; int slot; float wgt;
};
__device__ __forceinline__ void run_epi(const Ctx& cx, const Epi& E, const Acc& acc, int r0, int pn, int wr, int wc, int fr, int fq) {
  if (E.kind == 0) {
#pragma unroll
    for (int ai = 0; ai < 2; ++ai)
#pragma unroll
      for (int m = 0; m < 4; ++m) {
        bf16_t* rp = E.O + (size_t)(r0 + ai * HALF + wr * 64 + m * 16 + fr) * E.ldc + pn * 256 + wc * 32 + 4 * fq;
#pragma unroll
        for (int bj = 0; bj < 2; ++bj)
#pragma unroll
          for (int n = 0; n < 2; ++n) {
            f32x4 v = acc[ai][bj][m][n];
            u32x2 o; o.x = pk2(v[0], v[1]); o.y = pk2(v[2], v[3]);
            *(u32x2*)(rp + bj * HALF + n * 16) = o;
          }
      }
  } else if (E.kind == 1) {
#pragma unroll
    for (int ai = 0; ai < 2; ++ai)
#pragma unroll
      for (int m = 0; m < 4; ++m) {
        bf16_t* rp = E.O + (size_t)(r0 + ai * HALF + wr * 64 + m * 16 + fr) * FF + pn * 128 + wc * 16 + 4 * fq;
#pragma unroll
        for (int bj = 0; bj < 2; ++bj) {
          f32x4 g = acc[ai][bj][m][0], v = acc[ai][bj][m][1];
          u32x2 o; o.x = pk2(silu_f(g[0]) * v[0], silu_f(g[1]) * v[1]); o.y = pk2(silu_f(g[2]) * v[2], silu_f(g[3]) * v[3]);
          *(u32x2*)(rp + bj * 64) = o;
        }
      }
  } else {
    const int midx = r0 < NLAT ? (r0 >> 12) : 8;
    const float* gp = E.modl + (size_t)midx * 9216 + (3 * E.slot + 2) * D + pn * 256 + wc * 32 + 4 * fq;
    f32x4 gv[2][2];
#pragma unroll
    for (int bj = 0; bj < 2; ++bj)
#pragma unroll
      for (int n = 0; n < 2; ++n) gv[bj][n] = *(const f32x4*)(gp + bj * HALF + n * 16) * E.wgt;
#pragma unroll
    for (int ai = 0; ai < 2; ++ai)
#pragma unroll
      for (int m = 0; m < 4; ++m) {
        float* rp = hrow(cx, r0 + ai * HALF + wr * 64 + m * 16 + fr) + pn * 256 + wc * 32 + 4 * fq;
        f32x4 h[2][2];
#pragma unroll
        for (int bj = 0; bj < 2; ++bj)
#pragma unroll
          for (int n = 0; n < 2; ++n) h[bj][n] = *(const f32x4*)(rp + bj * HALF + n * 16);
#pragma unroll
        for (int bj = 0; bj < 2; ++bj)
#pragma unroll
          for (int n = 0; n < 2; ++n) *(f32x4*)(rp + bj * HALF + n * 16) = h[bj][n] * ALPHA + gv[bj][n] * acc[ai][bj][m][n];
        __builtin_amdgcn_sched_barrier(0);
      }
  }
}

#define LAS __attribute__((address_space(3)))
__device__ __forceinline__ void gemm_phase(const Ctx& cx, const bf16_t* __restrict__ A, RowMap am, const bf16_t* __restrict__ Bt, int K, int nM, int nN, RowMap cm, const Epi& epi) {
  LAS unsigned char* lds = (LAS unsigned char*)lds_raw;
  constexpr int HTB = HT * 2;
  const int tid = cx.tid, wid = tid >> 6, lane = tid & 63, wr = wid >> 2, wc = wid & 3, fr = lane & 15, fq = lane >> 4;
  unsigned voff[2];
#pragma unroll
  for (int i = 0; i < 2; ++i) { int R, C; stage_rc(tid * 16 + i * 8192, R, C); voff[i] = (unsigned)(R * K + C) * 2u; }
  const size_t kstep = (size_t)(BK * 2), hstep = (size_t)HALF * K * 2;
  const unsigned ldsw = (unsigned)wid * 1024u;
  const int aoff = lds_byte(wr * 64 + fr, fq * 8), boff = lds_byte(wc * 32 + fr, fq * 8);
#define G_SA(b, h) (((b) * 2 + (h)) * HTB)
#define G_SB(b, h) ((4 + (b) * 2 + (h)) * HTB)
#define STAGE(bufoff, gbase) do { _Pragma("unroll") for (int _i = 0; _i < 2; ++_i) \
    __builtin_amdgcn_global_load_lds((const unsigned*)((const char*)(gbase) + voff[_i]), (LAS unsigned*)(lds + (bufoff) + ldsw + _i * 8192), 16, 0, 0); } while (0)
#define LDA(dst, b, h) do { _Pragma("unroll") for (int m = 0; m < 4; ++m) _Pragma("unroll") for (int k = 0; k < 2; ++k) dst[m][k] = *(const LAS bf16x8*)(lds + G_SA(b, h) + aoff + m * 2048 + k * 1024); } while (0)
#define LDB(dst, b, h) do { _Pragma("unroll") for (int n = 0; n < 2; ++n) _Pragma("unroll") for (int k = 0; k < 2; ++k) dst[n][k] = *(const LAS bf16x8*)(lds + G_SB(b, h) + boff + n * 2048 + k * 1024); } while (0)
#define MMA(ai, bj, At, Bt_) do { __builtin_amdgcn_s_setprio(1); _Pragma("unroll") for (int m = 0; m < 4; ++m) _Pragma("unroll") for (int n = 0; n < 2; ++n) _Pragma("unroll") for (int k = 0; k < 2; ++k) \
      acc[ai][bj][m][n] = MFMA16(Bt_[n][k], At[m][k], acc[ai][bj][m][n]); \
    __builtin_amdgcn_s_setprio(0); } while (0)
#define WAIT_V(n) asm volatile("s_waitcnt vmcnt(" #n ")" ::: "memory")
#define WAIT_L(n) asm volatile("s_waitcnt lgkmcnt(" #n ")" ::: "memory")
#define BAR __builtin_amdgcn_s_barrier()
#define SCHED __builtin_amdgcn_sched_barrier(0)
  const int nwg = nM * nN;
  const int nt = K / BK;
  const int wid_s = __builtin_amdgcn_readfirstlane(wid);
#define DECODE(L_, pm_, pn_) do { int wgid = (L_); \
    { int q = nwg / NXCD, r = nwg % NXCD, xcd = wgid % NXCD, off = wgid / NXCD; wgid = (xcd < r ? xcd * (q + 1) : r * (q + 1) + (xcd - r) * q) + off; } \
    const int nig = WGM * nN, gid = wgid / nig, fm = gid * WGM, gsz = min(nM - fm, WGM); \
    pm_ = fm + ((wgid % nig) % gsz); pn_ = (wgid % nig) / gsz; } while (0)
  int L = cx.bid;
  if (L < nwg) {
    int pm, pn;
    DECODE(L, pm, pn);
    const char* cA = (const char*)A + (size_t)am.row0(pm) * K * 2; const char* cB = (const char*)Bt + (size_t)pn * BM * K * 2;
    Acc acc;
#pragma unroll
    for (int a = 0; a < 2; ++a)
#pragma unroll
      for (int b = 0; b < 2; ++b)
#pragma unroll
        for (int m = 0; m < 4; ++m)
#pragma unroll
          for (int n = 0; n < 2; ++n) acc[a][b][m][n] = (f32x4){0.f, 0.f, 0.f, 0.f};
    bf16x8 At[4][2], B0[2][2], B1[2][2];
    STAGE(G_SB(0, 0), cB); STAGE(G_SA(0, 0), cA); STAGE(G_SB(0, 1), cB + hstep); STAGE(G_SA(0, 1), cA + hstep);
    if (wr == 1) BAR;
    WAIT_V(4); BAR;
    STAGE(G_SB(1, 0), cB + kstep); STAGE(G_SA(1, 0), cA + kstep); STAGE(G_SB(1, 1), cB + hstep + kstep);
    WAIT_V(6); BAR;
    for (;;) {
      const int Ln = L + cx.nb;
      const bool has_next = Ln < nwg;
      int pmn = pm, pnn = pn;
      if (has_next) DECODE(Ln, pmn, pnn);
      const char* nA = has_next ? (const char*)A + (size_t)am.row0(pmn) * K * 2 : cA; const char* nB = has_next ? (const char*)Bt + (size_t)pnn * BM * K * 2 : cB;
      for (int t = 0; t < nt; t += 2) {
        const bool last = (t == nt - 2);
        const char* a1 = cA + (size_t)(t + 1) * kstep;
        const char* a2 = last ? nA : cA + (size_t)(t + 2) * kstep; const char* b2 = last ? nB : cB + (size_t)(t + 2) * kstep;
        const char* a3 = a2 + kstep; const char* b3 = b2 + kstep;
        LDB(B0, 0, 0); SCHED; LDA(At, 0, 0); STAGE(G_SA(1, 1), a1 + hstep);
        WAIT_L(8); BAR; WAIT_L(0); MMA(0, 0, At, B0); BAR; SCHED;
        LDB(B1, 0, 1); STAGE(G_SB(0, 0), b2);
        BAR; WAIT_L(0); MMA(0, 1, At, B1); BAR;
        LDA(At, 0, 1); STAGE(G_SA(0, 0), a2);
        BAR; WAIT_L(0); MMA(1, 0, At, B0); BAR; SCHED;
        STAGE(G_SB(0, 1), b2 + hstep);
        WAIT_V(6); BAR; MMA(1, 1, At, B1); BAR;
        LDB(B0, 1, 0); SCHED; LDA(At, 1, 0); STAGE(G_SA(0, 1), a2 + hstep);
        WAIT_L(8); BAR; WAIT_L(0); MMA(0, 0, At, B0); BAR; SCHED;
        LDB(B1, 1, 1); STAGE(G_SB(1, 0), b3);
        BAR; WAIT_L(0); MMA(0, 1, At, B1); BAR;
        LDA(At, 1, 1); STAGE(G_SA(1, 0), a3);
        BAR; WAIT_L(0); MMA(1, 0, At, B0); BAR; SCHED;
        STAGE(G_SB(1, 1), b3 + hstep);
        WAIT_V(6); BAR; MMA(1, 1, At, B1); BAR;
      }
      { int t2 = wid_s * 64 + (int)__builtin_amdgcn_mbcnt_hi(~0u, __builtin_amdgcn_mbcnt_lo(~0u, (unsigned)cx.z)); asm volatile("" : "+v"(t2));
        const int w2 = t2 >> 6, l2 = t2 & 63;
        run_epi(cx, epi, acc, cm.row0(pm), pn, w2 >> 2, w2 & 3, l2 & 15, l2 >> 4); }
      if (!has_next) break;
#pragma unroll
      for (int a = 0; a < 2; ++a)
#pragma unroll
        for (int b = 0; b < 2; ++b)
#pragma unroll
          for (int m = 0; m < 4; ++m)
#pragma unroll
            for (int n = 0; n < 2; ++n) acc[a][b][m][n] = (f32x4){0.f, 0.f, 0.f, 0.f};
      pm = pmn; pn = pnn; cA = nA; cB = nB; L = Ln;
    }
    WAIT_V(0);
    if (wr == 0) BAR;
    BAR;
  }
  __syncthreads();
}

template <int MODE>
__device__ __forceinline__ int wrow(int c) {
  if (MODE == 0) return c;
  const int isv = c >= FF ? 1 : 0, f = c - isv * FF;
  return (f >> 7) * 256 + ((f >> 6) & 1) * 128 + ((f >> 4) & 3) * 32 + isv * 16 + (f & 15);
}
template <int MODE>
__device__ __forceinline__ void transpose_item(const float* __restrict__ W, int K, int N, bf16_t* __restrict__ WT, float* scr, int item, int lane) {
  const int nblk = N / 32, kb = item / nblk, nb = item % nblk, k0 = 64 * kb, n0 = 32 * nb;
#pragma unroll 8
  for (int i = 0; i < 32; ++i) { const int kk = 2 * i + (lane >> 5); scr[kk * 33 + (lane & 31)] = W[(size_t)(k0 + kk) * N + n0 + (lane & 31)]; }
  __builtin_amdgcn_wave_barrier(); asm volatile("s_waitcnt lgkmcnt(0)" ::: "memory");
  const int c = lane & 7;
#pragma unroll
  for (int j = 0; j < 4; ++j) {
    const int n = (lane >> 3) + 8 * j; const float* s = scr + (8 * c) * 33 + n;
    u32x4 o; o.x = pk2(s[0 * 33], s[1 * 33]); o.y = pk2(s[2 * 33], s[3 * 33]); o.z = pk2(s[4 * 33], s[5 * 33]); o.w = pk2(s[6 * 33], s[7 * 33]);
    *(u32x4*)(WT + (size_t)wrow<MODE>(n0 + n) * K + k0 + 8 * c) = o;
  }
  asm volatile("s_waitcnt lgkmcnt(0)" ::: "memory"); __builtin_amdgcn_wave_barrier();
}

__device__ __forceinline__ void prologue(const Params& p, const Ctx& cx) {
  const int tid = cx.tid, lane = tid & 63, wave = tid >> 6;
  char* ws = cx.ws;
  {
    float* cond = (float*)lds_raw;
    float* red = (float*)(lds_raw + 9 * 1024 * 4);
    for (int i = tid; i < 9 * 1024; i += 512) { const int j = i >> 10, k = i & 1023; cond[i] = silu_f(j < 8 ? IN(1)[j * 1024 + k] : IN(3)[k]); }
    __syncthreads();
    for (int u = cx.bid; u < 4 * 36; u += cx.nb) {
      const int layer = u / 36, ct = u % 36, c0 = ct * 256 + 4 * lane;
      const float* wp = IN(4) + (size_t)layer * D * 9216 + c0;
      f32x4 a[9];
#pragma unroll
      for (int j = 0; j < 9; ++j) a[j] = (f32x4){0.f, 0.f, 0.f, 0.f};
#pragma unroll 4
      for (int k = wave * 128; k < wave * 128 + 128; ++k) {
        const f32x4 w = *(const f32x4*)(wp + (size_t)k * 9216);
#pragma unroll
        for (int j = 0; j < 9; ++j) a[j] += w * cond[j * 1024 + k];
      }
#pragma unroll
      for (int j = 0; j < 9; ++j) *(f32x4*)(red + (wave * 9 + j) * 256 + 4 * lane) = a[j];
      __syncthreads();
      float* mt = (float*)(ws + O_MODT) + (size_t)layer * 9 * 9216;
      for (int i = tid; i < 9 * 256; i += 512) {
        const int j = i >> 8, c = i & 255; float s = 0.f;
#pragma unroll
        for (int w = 0; w < 8; ++w) s += red[(w * 9 + j) * 256 + c];
        mt[(size_t)j * 9216 + ct * 256 + c] = s + IN(5)[layer * 9216 + ct * 256 + c];
      }
      __syncthreads();
    }
    __syncthreads();
  }
  {
    float* scr = (float*)lds_raw + wave * (64 * 33);
    const int gw = cx.bid * 8 + wave, NGW = cx.nb * 8;
    constexpr int I_FI = 16 * 176, I_FO = 44 * 32, I_UP = 16 * 128, I_DN = 32 * 32, I_AQ = 16 * 48, I_AO = 16 * 32, I_SI = 16 * 96, I_SO = 16 * 32;
    constexpr int NITEMS = 8 * I_FI + 8 * I_FO + 2 * I_UP + 2 * I_DN + I_AQ + I_AO + I_SI + I_SO;
    for (int it = gw; it < NITEMS; it += NGW) {
      int r = it;
      if (r < 8 * I_FI) { const int mi = r / I_FI; transpose_item<1>(IN(8) + (size_t)mi * 1024 * 5632, 1024, 5632, (bf16_t*)(ws + O_WFI) + (size_t)mi * 5632 * 1024, scr, r % I_FI, lane); continue; } r -= 8 * I_FI;
      if (r < 8 * I_FO) { const int mi = r / I_FO; transpose_item<0>(IN(9) + (size_t)mi * 2816 * 1024, 2816, 1024, (bf16_t*)(ws + O_WFO) + (size_t)mi * 1024 * 2816, scr, r % I_FO, lane); continue; } r -= 8 * I_FO;
      if (r < 2 * I_UP) { const int mi = r / I_UP; transpose_item<0>(IN(10) + (size_t)mi * 1024 * 4096, 1024, 4096, (bf16_t*)(ws + O_WUP) + (size_t)mi * 4096 * 1024, scr, r % I_UP, lane); continue; } r -= 2 * I_UP;
      if (r < 2 * I_DN) { const int mi = r / I_DN; transpose_item<0>(IN(18) + (size_t)mi * 2048 * 1024, 2048, 1024, (bf16_t*)(ws + O_WDN) + (size_t)mi * 1024 * 2048, scr, r % I_DN, lane); continue; } r -= 2 * I_DN;
      if (r < I_AQ) { transpose_item<0>(IN(19), 1024, 1536, (bf16_t*)(ws + O_WAQ), scr, r, lane); continue; } r -= I_AQ;
      if (r < I_AO) { transpose_item<0>(IN(21), 1024, 1024, (bf16_t*)(ws + O_WAO), scr, r, lane); continue; } r -= I_AO;
      if (r < I_SI) { transpose_item<0>(IN(22), 1024, 3072, (bf16_t*)(ws + O_WSI), scr, r, lane); continue; } r -= I_SI;
      transpose_item<0>(IN(24), 1024, 1024, (bf16_t*)(ws + O_WSO), scr, r, lane);
    }
  }
  {
    const int gt = cx.bid * 512 + tid, gs = cx.nb * 512;
    bf16_t* wg = (bf16_t*)(ws + O_WG);
    for (int i = gt; i < 2 * 16 * 6144; i += gs) {
      const int j = i / (16 * 6144), xg = (i / 6144) & 15, k = i % 6144, x = xg >> 3, g = xg & 7;
      const float* wif = IN(14) + (size_t)(j * 2 + x) * 6144 * 8;
      float v;
      const int knat = (k & ~31) + 16 * ((k >> 2) & 1) + 4 * ((k >> 3) & 3) + (k & 3);
      if (k < 2048) v = wif[(size_t)knat * 8 + g];
      else if (k < 4096) v = wif[(size_t)knat * 8 + g] * 22.627416997969522f;
      else {
        const int c = k - 4096, blk = c >> 2, cc = c & 3;
        const float* wv = IN(13) + ((size_t)(j * 3 + 2) * 512 + blk) * 16 + cc * 4;
        v = 0.f;
        for (int d2 = 0; d2 < 4; ++d2) v += wv[d2] * wif[(size_t)(4096 + 4 * blk + d2) * 8 + g];
      }
      wg[i] = (bf16_t)(pk2(v, 0.f) & 0xffff);
    }
    float* rc = (float*)(ws + O_ROPE); float* rs = rc + 4096 * 32;
    for (int i = gt; i < 4096 * 32; i += gs) {
      const int pos = i >> 5, pp = i & 31, jf = pp & 15;
      const float fr_ = __builtin_amdgcn_exp2f(-(float)jf * (13.287712379549449f / 16.f));
      float rev = (float)(pp < 16 ? (pos >> 6) : (pos & 63)) * fr_ * 0.15915494309189535f;
      rev -= rintf(rev);
      rc[i] = __builtin_amdgcn_cosf(rev); rs[i] = __builtin_amdgcn_sinf(rev);
    }
  }
}

template <int MODE>
__device__ __forceinline__ void lnmod_phase(const Params& p, const Ctx& cx, int lnidx  , int layer, int slot) {
  const int lane = cx.tid & 63, gw = cx.bid * 8 + (cx.tid >> 6), NGW = cx.nb * 8;
  const int nrows = MODE == 2 ? NLAT : MROWS;
  const float* lg = IN(6) + (size_t)lnidx * D; const float* lb = IN(7) + (size_t)lnidx * D;
  const float* modl = (const float*)(cx.ws + O_MODT) + (size_t)layer * 9 * 9216;
  bf16_t* U = (bf16_t*)(cx.ws + O_U);
  for (int row = gw; row < nrows; row += NGW) {
    float* hp = hrow(cx, row);
    const float* src = MODE == 0 ? (row < NLAT ? IN(0) + (size_t)row * D : IN(2) + (size_t)(row - NLAT) * D) : hp;
    f32x4 v[4];
#pragma unroll
    for (int j = 0; j < 4; ++j) v[j] = *(const f32x4*)(src + 4 * lane + 256 * j);
    if (MODE != 0) {
      float s = 0.f;
#pragma unroll
      for (int j = 0; j < 4; ++j) s += (v[j][0] + v[j][1]) + (v[j][2] + v[j][3]);
      const float mean = wave_sum(s, lane) * (1.f / D); float s2 = 0.f;
#pragma unroll
      for (int j = 0; j < 4; ++j) { v[j] = v[j] - mean; s2 += (v[j][0] * v[j][0] + v[j][1] * v[j][1]) + (v[j][2] * v[j][2] + v[j][3] * v[j][3]); }
      const float rstd = __builtin_amdgcn_rsqf(wave_sum(s2, lane) * (1.f / D) + LN_EPS);
#pragma unroll
      for (int j = 0; j < 4; ++j) v[j] = v[j] * rstd * *(const f32x4*)(lg + 4 * lane + 256 * j) + *(const f32x4*)(lb + 4 * lane + 256 * j);
    }
#pragma unroll
    for (int j = 0; j < 4; ++j) *(f32x4*)(hp + 4 * lane + 256 * j) = v[j];
    if (MODE != 2) {
      const int midx = row < NLAT ? (row >> 12) : 8;
      const float* sh = modl + (size_t)midx * 9216 + (3 * slot) * D; const float* sc = sh + D;
#pragma unroll
      for (int j = 0; j < 4; ++j) {
        const f32x4 u = v[j] * (*(const f32x4*)(sc + 4 * lane + 256 * j) + 1.f) + *(const f32x4*)(sh + 4 * lane + 256 * j);
        u32x2 o; o.x = pk2(u[0], u[1]); o.y = pk2(u[2], u[3]);
        *(u32x2*)(U + (size_t)row * D + 4 * lane + 256 * j) = o;
      }
    }
  }
}

__device__ __forceinline__ int ml_lrow(int bl, int tok) { return tok < LC ? GB * SEQ + bl * LC + tok : bl * SEQ + (tok - LC); }
__device__ __forceinline__ int ml_nchunk(int x, int st) { return x == 0 ? st : (st < 4 ? 3 - st : 71 - st); }

__device__ __forceinline__ void ml_m0(const Params& p, const Ctx& cx, int j) {
  const int tid = cx.tid;
  char* ws = cx.ws;
  const bf16_t* XZ = (const bf16_t*)(ws + O_XZ);
  bf16_t* QK = (bf16_t*)(ws + O_QK); bf16_t* KT = (bf16_t*)(ws + O_KT); bf16_t* VT = (bf16_t*)(ws + O_VT);
  bf16_t* lk = (bf16_t*)lds_raw;
  bf16_t* lv = lk + 256 * 72;
  const int blk_l = tid & 63, tq = tid >> 6;
  for (int u = cx.bid; u < GB * NCH * 8; u += cx.nb) {
    const int slab = u & 7, ch = (u >> 3) % NCH, bl = u / (8 * NCH);
    const int f0 = slab * 256 + blk_l * 4, blk = f0 >> 2;
    float cw[3][4], cb[4], wq[16], wk[16], wv[16];
#pragma unroll
    for (int k = 0; k < 3; ++k)
#pragma unroll
      for (int c = 0; c < 4; ++c) cw[k][c] = IN(11)[(size_t)(j * 3 + k) * EI + f0 + c];
#pragma unroll
    for (int c = 0; c < 4; ++c) cb[c] = IN(12)[(size_t)j * EI + f0 + c];
#pragma unroll
    for (int i = 0; i < 16; ++i) {
      wq[i] = IN(13)[((size_t)(j * 3 + 0) * 512 + blk) * 16 + i];
      wk[i] = IN(13)[((size_t)(j * 3 + 1) * 512 + blk) * 16 + i] * 0.04419417382415922f;
      wv[i] = IN(13)[((size_t)(j * 3 + 2) * 512 + blk) * 16 + i];
    }
    const int tok0 = ch * 64, seg_lo = tok0 < LC ? 0 : LC, seg_hi = tok0 < LC ? LC : TOKB;
    for (int tt = 0; tt < 8; ++tt) {
      const int tl = tq + 8 * tt, tok = tok0 + tl;
      float xm[3][4];
#pragma unroll
      for (int k = 0; k < 3; ++k) {
        const int t2 = tok + k - 1;
        if (t2 >= seg_lo && t2 < seg_hi) {
          const u32x2 r = *(const u32x2*)(XZ + (size_t)ml_lrow(bl, t2) * 4096 + f0);
          xm[k][0] = bflo(r.x); xm[k][1] = bfhi(r.x); xm[k][2] = bflo(r.y); xm[k][3] = bfhi(r.y);
        } else { xm[k][0] = xm[k][1] = xm[k][2] = xm[k][3] = 0.f; }
      }
      float xc[4], q[4], kk[4], vv[4];
#pragma unroll
      for (int c = 0; c < 4; ++c) xc[c] = silu_f(cw[0][c] * xm[0][c] + cw[1][c] * xm[1][c] + cw[2][c] * xm[2][c] + cb[c]);
#pragma unroll
      for (int d2 = 0; d2 < 4; ++d2) {
        q[d2] = xc[0] * wq[d2] + xc[1] * wq[4 + d2] + xc[2] * wq[8 + d2] + xc[3] * wq[12 + d2];
        kk[d2] = xc[0] * wk[d2] + xc[1] * wk[4 + d2] + xc[2] * wk[8 + d2] + xc[3] * wk[12 + d2];
        vv[d2] = xm[1][0] * wv[d2] + xm[1][1] * wv[4 + d2] + xm[1][2] * wv[8 + d2] + xm[1][3] * wv[12 + d2];
      }
      const size_t lr = ml_lrow(bl, tok);
      u32x2 oq, ok, ov; oq.x = pk2(q[0], q[1]); oq.y = pk2(q[2], q[3]); ok.x = pk2(kk[0], kk[1]); ok.y = pk2(kk[2], kk[3]); ov.x = pk2(vv[0], vv[1]); ov.y = pk2(vv[2], vv[3]);
      const int fp = (f0 & ~31) + 8 * ((f0 >> 2) & 3) + 4 * ((f0 >> 4) & 1);
      *(u32x2*)(QK + lr * 4096 + fp) = oq;
      *(u32x2*)(QK + lr * 4096 + 2048 + fp) = ok;
      const int fl = blk_l * 4;
      lk[(fl + 0) * 72 + tl] = (bf16_t)(ok.x & 0xffff); lk[(fl + 1) * 72 + tl] = (bf16_t)(ok.x >> 16); lk[(fl + 2) * 72 + tl] = (bf16_t)(ok.y & 0xffff); lk[(fl + 3) * 72 + tl] = (bf16_t)(ok.y >> 16);
      lv[(fl + 0) * 72 + tl] = (bf16_t)(ov.x & 0xffff); lv[(fl + 1) * 72 + tl] = (bf16_t)(ov.x >> 16); lv[(fl + 2) * 72 + tl] = (bf16_t)(ov.y & 0xffff); lv[(fl + 3) * 72 + tl] = (bf16_t)(ov.y >> 16);
    }
    __syncthreads();
    {
      const int arr = tid >> 8, fr_ = tid & 255;
      const bf16_t* src = (arr ? lv : lk) + fr_ * 72;
      const int feat = slab * 256 + fr_;
      bf16_t* dst = (arr ? VT : KT) + (((size_t)bl * NCH + ch) * (EI / 16) + (feat >> 4)) * 1024 + (feat & 15) * 32;
#pragma unroll
      for (int i = 0; i < 8; ++i) *(u32x4*)(dst + (i >> 2) * 512 + (i & 3) * 8) = *(const u32x4*)(src + 8 * i);
    }
    __syncthreads();
  }
}

__device__ __forceinline__ void ml_gates(const Params& p, const Ctx& cx, int j) {
  const int tid = cx.tid, lane = tid & 63, wave = tid >> 6, fr = lane & 15, fq = lane >> 4;
  char* ws = cx.ws;
  const bf16_t* XZ = (const bf16_t*)(ws + O_XZ); const bf16_t* QK = (const bf16_t*)(ws + O_QK);
  const bf16_t* WG = (const bf16_t*)(ws + O_WG) + (size_t)j * 16 * 6144;
  float* BL = (float*)(ws + O_BL); float* IG = (float*)(ws + O_IG);
  float* GC = (float*)(ws + O_GC); float* AC = GC + NSEQ * NCH;
  float* part = (float*)lds_raw;
  float* gl = part + 8 * 64 * 16;
  for (int u = cx.bid; u < GB * NCH; u += cx.nb) {
    const int bl = u / NCH, nc = u % NCH, tok0 = nc * 64;
    f32x4 acc[4];
#pragma unroll
    for (int m = 0; m < 4; ++m) acc[m] = (f32x4){0.f, 0.f, 0.f, 0.f};
    size_t lr[4];
#pragma unroll
    for (int m = 0; m < 4; ++m) lr[m] = ml_lrow(bl, tok0 + m * 16 + fr);
#pragma unroll 4
    for (int ks = wave * 24; ks < wave * 24 + 24; ++ks) {
      const int k = ks * 32 + fq * 8;
      const bf16x8 bfr = *(const bf16x8*)(WG + (size_t)fr * 6144 + k);
#pragma unroll
      for (int m = 0; m < 4; ++m) {
        const bf16_t* ap = k < 4096 ? QK + lr[m] * 4096 + k : XZ + lr[m] * 4096 + (k - 4096);
        const bf16x8 afr = *(const bf16x8*)ap;
        acc[m] = MFMA16(afr, bfr, acc[m]);
      }
    }
#pragma unroll
    for (int m = 0; m < 4; ++m)
#pragma unroll
      for (int jj = 0; jj < 4; ++jj) part[(wave * 64 + m * 16 + 4 * fq + jj) * 16 + fr] = acc[m][jj];
    __syncthreads();
    for (int i = tid; i < 1024; i += 512) {
      float s = IN(15)[(size_t)j * 16 + (i & 15)];
#pragma unroll
      for (int w = 0; w < 8; ++w) s += part[w * 1024 + i];
      gl[(i >> 4) * 17 + (i & 15)] = s;
    }
    __syncthreads();
    {
      const int x = wave >> 2, h = wave & 3, seq = (bl * 2 + x) * 4 + h;
      const int tl = x == 0 ? lane : 63 - lane;
      const float ig = gl[tl * 17 + x * 8 + h], fg = gl[tl * 17 + x * 8 + 4 + h];
      float b = fg > 0.f ? -__logf(1.f + __expf(-fg)) : fg - __logf(1.f + __expf(fg));
#pragma unroll
      for (int o = 1; o < 64; o <<= 1) { const float t2 = shi(b, lane - o); if (lane >= o) b += t2; }
      BL[(size_t)seq * TOKB + tok0 + tl] = b; IG[(size_t)seq * TOKB + tok0 + tl] = ig;
      float mx = ig - b;
#pragma unroll
      for (int o = 1; o < 64; o <<= 1) mx = fmaxf(mx, shx(mx, o, lane));
      const float g = shi(b, 63);
      if (lane == 0) { GC[seq * NCH + nc] = g; AC[seq * NCH + nc] = g + mx; }
    }
    __syncthreads();
  }
}

__device__ __forceinline__ void ml_s(const Params& p, const Ctx& cx) {
  const int tid = cx.tid, lane = tid & 63, wave = tid >> 6, fr = lane & 15, fq = lane >> 4;
  char* ws = cx.ws;
  const bf16_t* QK = (const bf16_t*)(ws + O_QK);
  bf16_t* SP = (bf16_t*)(ws + O_SP);
  const float* BL = (const float*)(ws + O_BL); const float* IG = (const float*)(ws + O_IG);
  float* WIN = (float*)(ws + O_WIN); float* FLO = (float*)(ws + O_FLO); float* DEN = (float*)(ws + O_DEN); float* WSS = (float*)(ws + O_WSS);
  const float* GC = (const float*)(ws + O_GC); const float* AC = GC + NSEQ * NCH; float* DEC = (float*)(ws + O_GC) + 2 * NSEQ * NCH;
  float* sb_ = (float*)lds_raw + wave * 256; float* si_ = sb_ + 64; float* smt = si_ + 64;
  const int gw = cx.bid * 8 + wave, NGW = cx.nb * 8;
  for (int u = gw; u < NSEQ * NCH; u += NGW) {
    const int seq = u / NCH, st = u % NCH, x = (seq >> 2) & 1, h = seq & 3, bl = seq >> 3;
    const int nc = ml_nchunk(x, st), tok0 = nc * 64;
    const int nl0 = ml_nchunk(x, lane), nl1 = ml_nchunk(x, 64 + (lane & 3));
    const float g0 = GC[seq * NCH + nl0], a0 = AC[seq * NCH + nl0], g1 = GC[seq * NCH + nl1], a1 = AC[seq * NCH + nl1];
    const int tl = x == 0 ? lane : 63 - lane;
    const float b = BL[(size_t)seq * TOKB + tok0 + tl], ig = IG[(size_t)seq * TOKB + tok0 + tl];
    float mc = 0.f;
    for (int s2 = 0; s2 < st; ++s2) {
      const float gg = __int_as_float(__builtin_amdgcn_readlane(__float_as_int(s2 < 64 ? g0 : g1), s2 & 63));
      const float aa = __int_as_float(__builtin_amdgcn_readlane(__float_as_int(s2 < 64 ? a0 : a1), s2 & 63));
      mc = fmaxf(gg + mc, aa);
    }
    const float gc = __int_as_float(__builtin_amdgcn_readlane(__float_as_int(st < 64 ? g0 : g1), st & 63));
    const float ac = __int_as_float(__builtin_amdgcn_readlane(__float_as_int(st < 64 ? a0 : a1), st & 63));
    const float mnew = fmaxf(gc + mc, ac);
    float cm = ig - b;
#pragma unroll
    for (int o = 1; o < 64; o <<= 1) { const float t2 = shi(cm, lane - o); if (lane >= o) cm = fmaxf(cm, t2); }
    const float mt = b + fmaxf(mc, cm);
    sb_[tl] = b; si_[tl] = ig; smt[tl] = mt;
    WIN[(size_t)seq * TOKB + tok0 + tl] = __expf(b + mc - mt);
    FLO[(size_t)seq * TOKB + tok0 + tl] = __expf(-mt);
    WSS[(size_t)seq * TOKB + tok0 + tl] = __expf(gc - b + ig - mnew);
    if (lane == 0) DEC[seq * NCH + nc] = __expf(gc + mc - mnew);
    f32x4 acc[4][4];
#pragma unroll
    for (int a = 0; a < 4; ++a)
#pragma unroll
      for (int c2 = 0; c2 < 4; ++c2) acc[a][c2] = (f32x4){0.f, 0.f, 0.f, 0.f};
    const bf16_t* rowp[4];
#pragma unroll
    for (int a = 0; a < 4; ++a) rowp[a] = QK + (size_t)ml_lrow(bl, tok0 + a * 16 + fr) * 4096 + h * DH + fq * 8;
#pragma unroll 2
    for (int ks = 0; ks < 16; ++ks) {
      bf16x8 kf[4], qf[4];
#pragma unroll
      for (int a = 0; a < 4; ++a) { kf[a] = *(const bf16x8*)(rowp[a] + 2048 + ks * 32); qf[a] = *(const bf16x8*)(rowp[a] + ks * 32); }
#pragma unroll
      for (int a = 0; a < 4; ++a)
#pragma unroll
        for (int c2 = 0; c2 < 4; ++c2) acc[a][c2] = MFMA16(kf[a], qf[c2], acc[a][c2]);
    }
    __builtin_amdgcn_wave_barrier(); asm volatile("s_waitcnt lgkmcnt(0)" ::: "memory");
    bf16_t* spu = SP + (size_t)(seq * NCH + nc) * 4096;
#pragma unroll
    for (int tb = 0; tb < 4; ++tb) {
      const int t = tb * 16 + fr;
      const float bt = sb_[t], mtt = smt[t];
      float dsum = 0.f;
#pragma unroll
      for (int sbk = 0; sbk < 4; ++sbk) {
        float vals[4];
#pragma unroll
        for (int jj = 0; jj < 4; ++jj) {
          const int s = sbk * 16 + 4 * fq + jj;
          const bool ok = x == 0 ? (s <= t) : (s >= t);
          vals[jj] = ok ? acc[sbk][tb][jj] * __expf(bt - sb_[s] + si_[s] - mtt) : 0.f;
        }
        u32x2 o; o.x = pk2(vals[0], vals[1]); o.y = pk2(vals[2], vals[3]);
        *(u32x2*)(spu + t * 64 + sbk * 16 + 4 * fq) = o;
        dsum += (bflo(o.x) + bfhi(o.x)) + (bflo(o.y) + bfhi(o.y));
      }
      dsum += shx(dsum, 16, lane); dsum += shx(dsum, 32, lane);
      if (fq == 0) DEN[(size_t)seq * TOKB + tok0 + t] = dsum;
    }
    __builtin_amdgcn_wave_barrier(); asm volatile("s_waitcnt lgkmcnt(0)" ::: "memory");
  }
}

constexpr int NEB = 2, NSL = 512 / (16 * NEB);
__device__ __forceinline__ void ml_m2(const Params& p, const Ctx& cx) {
  const int tid = cx.tid, lane = tid & 63, wave = tid >> 6, fr = lane & 15, fq = lane >> 4;
  char* ws = cx.ws;
  const bf16_t* QK = (const bf16_t*)(ws + O_QK); const bf16_t* KT = (const bf16_t*)(ws + O_KT); const bf16_t* VT = (const bf16_t*)(ws + O_VT);
  const bf16_t* SP = (const bf16_t*)(ws + O_SP);
  bf16_t* HD = (bf16_t*)(ws + O_HD);
  const float* WIN = (const float*)(ws + O_WIN); const float* FLO = (const float*)(ws + O_FLO); const float* DEN = (const float*)(ws + O_DEN); const float* WSS = (const float*)(ws + O_WSS);
  const float* DEC = (const float*)(ws + O_GC) + 2 * NSEQ * NCH;
  f32x4* red = (f32x4*)lds_raw;
  f32x4* rn = (f32x4*)(lds_raw + 131072);
  for (int idx = cx.bid >> 3; idx < 2 * NSL; idx += cx.nb >> 3) {
    const int seq = (cx.bid & 7) * 2 + idx / NSL, es = idx % NSL, x = (seq >> 2) & 1, h = seq & 3, bl = seq >> 3;
    const int d0 = wave * 64, e0 = es * 16 * NEB;
    f32x4 C[4][NEB + 1];
#pragma unroll
    for (int a = 0; a < 4; ++a)
#pragma unroll
      for (int b = 0; b < NEB + 1; ++b) C[a][b] = (f32x4){0.f, 0.f, 0.f, 0.f};
    const int tbo = wave >> 1, ebo = __builtin_amdgcn_readfirstlane(wave & 1);
    bf16x8 qc[4][2], kf[4][2], sf0, sf1;
    u32x4 vr[NEB][2];
    f32x4 wv[2][2];
#define M2_LOAD_Q(ST) do { const int _t0 = ml_nchunk(x, (ST)) * 64; _Pragma("unroll") for (int tb = 0; tb < 4; ++tb) { \
        const bf16_t* qp = QK + (size_t)ml_lrow(bl, _t0 + tb * 16 + fr) * 4096 + h * DH + d0 + 8 * fq; \
        qc[tb][0] = *(const bf16x8*)qp; qc[tb][1] = *(const bf16x8*)(qp + 32); } } while (0)
#define M2_LOAD_KV(ST) do { const int _nc = ml_nchunk(x, (ST)), _t0 = _nc * 64; \
        _Pragma("unroll") for (int db = 0; db < 4; ++db) { const bf16_t* kp = KT + (((size_t)bl * NCH + _nc) * (EI / 16) + ((h * DH + d0) >> 4) + db) * 1024 + fr * 32 + 8 * fq; \
          kf[db][0] = *(const bf16x8*)kp; kf[db][1] = *(const bf16x8*)(kp + 512); } \
        _Pragma("unroll") for (int eb = 0; eb < NEB; ++eb) { const bf16_t* vp = VT + (((size_t)bl * NCH + _nc) * (EI / 16) + ((h * DH + e0) >> 4) + eb) * 1024 + fr * 32 + 8 * fq; \
          vr[eb][0] = *(const u32x4*)vp; vr[eb][1] = *(const u32x4*)(vp + 512); } \
        _Pragma("unroll") for (int ks = 0; ks < 2; ++ks) { const float* wp = WSS + (size_t)seq * TOKB + _t0 + 32 * ks + 8 * fq; \
          wv[ks][0] = *(const f32x4*)wp; wv[ks][1] = *(const f32x4*)(wp + 4); } \
        const bf16_t* sp = SP + (size_t)(seq * NCH + _nc) * 4096 + (tbo * 16 + fr) * 64 + 8 * fq; \
        sf0 = *(const bf16x8*)sp; sf1 = *(const bf16x8*)(sp + 32); } while (0)
    M2_LOAD_Q(0); M2_LOAD_KV(0);
    for (int st = 0; st < NCH; ++st) {
      const int nc = ml_nchunk(x, st), tok0 = nc * 64, stn = st + 1 < NCH ? st + 1 : st;
      const size_t tix = (size_t)seq * TOKB + tok0 + tbo * 16 + 4 * fq;
      const f32x4 win = *(const f32x4*)(WIN + tix), flo = *(const f32x4*)(FLO + tix), deni = *(const f32x4*)(DEN + tix);
      const float decay = DEC[seq * NCH + nc];
#pragma unroll
      for (int eb = 0; eb < NEB + 1; ++eb) {
        bf16x8 cb0, cb1;
        { const f32x4 lo = C[0][eb], hi = C[1][eb]; cb0 = mk8((u32x4){pk2(lo[0], lo[1]), pk2(lo[2], lo[3]), pk2(hi[0], hi[1]), pk2(hi[2], hi[3])}); }
        { const f32x4 lo = C[2][eb], hi = C[3][eb]; cb1 = mk8((u32x4){pk2(lo[0], lo[1]), pk2(lo[2], lo[3]), pk2(hi[0], hi[1]), pk2(hi[2], hi[3])}); }
        f32x4 pa[4];
#pragma unroll
        for (int tb = 0; tb < 4; ++tb) pa[tb] = MFMA16(qc[tb][0], cb0, ((f32x4){0.f, 0.f, 0.f, 0.f}));
#pragma unroll
        for (int tb = 0; tb < 4; ++tb) pa[tb] = MFMA16(qc[tb][1], cb1, pa[tb]);
#pragma unroll
        for (int tb = 0; tb < 4; ++tb) {
          if (eb < NEB) red[((wave * 4 + tb) * NEB + eb) * 64 + lane] = pa[tb];
          else if (fr == 0) rn[(wave * 4 + tb) * 4 + fq] = pa[tb];
        }
      }
      M2_LOAD_Q(stn);
      f32x4 oi = {0.f, 0.f, 0.f, 0.f};
#pragma unroll
      for (int eb = 0; eb < NEB + 1; ++eb) {
        bf16x8 vw0, vw1;
        if (eb < NEB) {
          const u32x4 r0 = vr[eb][0], r1 = vr[eb][1];
          if (eb == ebo) { oi = MFMA16(sf0, mk8(r0), oi); oi = MFMA16(sf1, mk8(r1), oi); }
          vw0 = mk8((u32x4){pk2(bflo(r0.x) * wv[0][0][0], bfhi(r0.x) * wv[0][0][1]), pk2(bflo(r0.y) * wv[0][0][2], bfhi(r0.y) * wv[0][0][3]),
                            pk2(bflo(r0.z) * wv[0][1][0], bfhi(r0.z) * wv[0][1][1]), pk2(bflo(r0.w) * wv[0][1][2], bfhi(r0.w) * wv[0][1][3])});
          vw1 = mk8((u32x4){pk2(bflo(r1.x) * wv[1][0][0], bfhi(r1.x) * wv[1][0][1]), pk2(bflo(r1.y) * wv[1][0][2], bfhi(r1.y) * wv[1][0][3]),
                            pk2(bflo(r1.z) * wv[1][1][0], bfhi(r1.z) * wv[1][1][1]), pk2(bflo(r1.w) * wv[1][1][2], bfhi(r1.w) * wv[1][1][3])});
        } else {
          vw0 = mk8((u32x4){pk2(wv[0][0][0], wv[0][0][1]), pk2(wv[0][0][2], wv[0][0][3]), pk2(wv[0][1][0], wv[0][1][1]), pk2(wv[0][1][2], wv[0][1][3])});
          vw1 = mk8((u32x4){pk2(wv[1][0][0], wv[1][0][1]), pk2(wv[1][0][2], wv[1][0][3]), pk2(wv[1][1][0], wv[1][1][1]), pk2(wv[1][1][2], wv[1][1][3])});
        }
#pragma unroll
        for (int db = 0; db < 4; ++db) {
          f32x4 c = C[db][eb] * decay;
          c = MFMA16(kf[db][0], vw0, c); c = MFMA16(kf[db][1], vw1, c);
          C[db][eb] = c;
        }
      }
      asm volatile("s_waitcnt lgkmcnt(0)" ::: "memory");
      __builtin_amdgcn_s_barrier();
      asm volatile("" ::: "memory");
      f32x4 rdn[8], rd0[8];
#pragma unroll
      for (int w = 0; w < 8; ++w) { rdn[w] = rn[(w * 4 + tbo) * 4 + fq]; rd0[w] = red[((w * 4 + tbo) * NEB + ebo) * 64 + lane]; }
      const f32x4 pn = ((rdn[0] + rdn[1]) + (rdn[2] + rdn[3])) + ((rdn[4] + rdn[5]) + (rdn[6] + rdn[7]));
      const f32x4 pi = ((rd0[0] + rd0[1]) + (rd0[2] + rd0[3])) + ((rd0[4] + rd0[5]) + (rd0[6] + rd0[7]));
#pragma unroll
      for (int jj = 0; jj < 4; ++jj) {
        const float num = oi[jj] + win[jj] * pi[jj], den = deni[jj] + win[jj] * pn[jj];
        const float hv = num * __builtin_amdgcn_rcpf(fmaxf(fabsf(den), flo[jj]));
        HD[((size_t)x * RG + ml_lrow(bl, tok0 + tbo * 16 + 4 * fq + jj)) * EI + h * DH + e0 + ebo * 16 + fr] = (bf16_t)(pk2(hv, 0.f) & 0xffff);
      }
      M2_LOAD_KV(stn);
      asm volatile("s_waitcnt lgkmcnt(0)" ::: "memory");
      __builtin_amdgcn_s_barrier();
      asm volatile("" ::: "memory");
    }
    __syncthreads();
#undef M2_LOAD_Q
#undef M2_LOAD_KV
  }
}

__device__ __forceinline__ void ml_fin(const Params& p, const Ctx& cx, int j) {
  const int lane = cx.tid & 63, gw = cx.bid * 8 + (cx.tid >> 6), NGW = cx.nb * 8;
  char* ws = cx.ws;
  const bf16_t* XZ = (const bf16_t*)(ws + O_XZ); const bf16_t* HD = (const bf16_t*)(ws + O_HD);
  bf16_t* FIN = (bf16_t*)(ws + O_FIN);
  for (int u = gw; u < RG * 4; u += NGW) {
    const int lr = u >> 2, h = u & 3, f0 = h * DH + lane * 8;
    int pos, seglen;
    if (lr < GB * SEQ) { pos = lr & (SEQ - 1); seglen = SEQ; } else { pos = (lr - GB * SEQ) & (LC - 1); seglen = LC; }
    const u32x4 hf = *(const u32x4*)(HD + (size_t)lr * EI + f0), hb = *(const u32x4*)(HD + ((size_t)RG + lr) * EI + f0);
    const u32x4 zz = *(const u32x4*)(XZ + (size_t)lr * 4096 + 2048 + f0);
    const u32x4 x1 = *(const u32x4*)(XZ + (size_t)lr * 4096 + f0);
    u32x4 x0 = {0u, 0u, 0u, 0u}, x2 = {0u, 0u, 0u, 0u};
    if (pos > 0) x0 = *(const u32x4*)(XZ + (size_t)(lr - 1) * 4096 + f0);
    if (pos < seglen - 1) x2 = *(const u32x4*)(XZ + (size_t)(lr + 1) * 4096 + f0);
    float hv[8], xm0[8], xm1[8], xm2[8];
    const unsigned hfu[4] = {hf.x, hf.y, hf.z, hf.w}, hbu[4] = {hb.x, hb.y, hb.z, hb.w}, zu[4] = {zz.x, zz.y, zz.z, zz.w};
    const unsigned x0u[4] = {x0.x, x0.y, x0.z, x0.w}, x1u[4] = {x1.x, x1.y, x1.z, x1.w}, x2u[4] = {x2.x, x2.y, x2.z, x2.w};
    float s = 0.f;
#pragma unroll
    for (int i = 0; i < 4; ++i) {
      hv[2 * i] = (bflo(hfu[i]) + bflo(hbu[i])) * sigm_f(bflo(zu[i]));
      hv[2 * i + 1] = (bfhi(hfu[i]) + bfhi(hbu[i])) * sigm_f(bfhi(zu[i]));
      xm0[2 * i] = bflo(x0u[i]); xm0[2 * i + 1] = bfhi(x0u[i]); xm1[2 * i] = bflo(x1u[i]); xm1[2 * i + 1] = bfhi(x1u[i]); xm2[2 * i] = bflo(x2u[i]); xm2[2 * i + 1] = bfhi(x2u[i]);
      s += hv[2 * i] + hv[2 * i + 1];
    }
    const float mean = wave_sum(s, lane) * (1.f / DH); float s2 = 0.f;
#pragma unroll
    for (int i = 0; i < 8; ++i) { hv[i] -= mean; s2 += hv[i] * hv[i]; }
    const float rstd = __builtin_amdgcn_rsqf(wave_sum(s2, lane) * (1.f / DH) + LN_EPS);
    float o[8];
#pragma unroll
    for (int i = 0; i < 8; ++i) {
      const int f = f0 + i;
      const float xc = silu_f(IN(11)[(size_t)(j * 3 + 0) * EI + f] * xm0[i] + IN(11)[(size_t)(j * 3 + 1) * EI + f] * xm1[i] + IN(11)[(size_t)(j * 3 + 2) * EI + f] * xm2[i] + IN(12)[(size_t)j * EI + f]);
      o[i] = hv[i] * rstd * IN(17)[(size_t)j * EI + f] + IN(16)[(size_t)j * EI + f] * xc;
    }
    u32x4 ov; ov.x = pk2(o[0], o[1]); ov.y = pk2(o[2], o[3]); ov.z = pk2(o[4], o[5]); ov.w = pk2(o[6], o[7]);
    *(u32x4*)(FIN + (size_t)lr * EI + f0) = ov;
  }
}

__device__ __forceinline__ void at_prep(const Params& p, const Ctx& cx) {
  const int lane = cx.tid & 63, gw = cx.bid * 8 + (cx.tid >> 6), NGW = cx.nb * 8;
  char* ws = cx.ws;
  bf16_t* ACT = (bf16_t*)(ws + O_ACT); bf16_t* KR = (bf16_t*)(ws + O_AKR); bf16_t* VT = (bf16_t*)(ws + O_AVT);
  const float* rc = (const float*)(ws + O_ROPE); const float* rs = rc + 4096 * 32;
  for (int row = gw; row < MROWS; row += NGW) {
    const bool lat = row < NLAT;
    const int b = lat ? row >> 12 : (row - NLAT) >> 8, pos = lat ? row & 4095 : (row - NLAT) & 255, tok = lat ? LC + pos : pos;
    bf16_t* rp = ACT + (size_t)row * 1536;
    {
      const u32x4 a = *(const u32x4*)(rp + 16 * lane), b2 = *(const u32x4*)(rp + 16 * lane + 8);
      const unsigned w[8] = {a.x, a.y, a.z, a.w, b2.x, b2.y, b2.z, b2.w};
      unsigned o[8];
      const int pp0 = (lane & 3) * 8;
#pragma unroll
      for (int i = 0; i < 8; ++i) {
        float x1 = bflo(w[i]) * 0.125f, x2 = bfhi(w[i]) * 0.125f;
        if (lat) { const float c = rc[pos * 32 + pp0 + i], s = rs[pos * 32 + pp0 + i]; const float y1 = x1 * c - x2 * s, y2 = x1 * s + x2 * c; x1 = y1; x2 = y2; }
        o[i] = pk2(x1, x2);
      }
      *(u32x4*)(rp + 16 * lane) = (u32x4){o[0], o[1], o[2], o[3]}; *(u32x4*)(rp + 16 * lane + 8) = (u32x4){o[4], o[5], o[6], o[7]};
    }
    {
      const u32x2 a = *(const u32x2*)(rp + 1024 + 4 * lane);
      const unsigned w[2] = {a.x, a.y}; unsigned o[2];
      const int g = lane >> 4, dd = (lane & 15) * 4, pp0 = dd >> 1;
#pragma unroll
      for (int i = 0; i < 2; ++i) {
        float x1 = bflo(w[i]), x2 = bfhi(w[i]);
        if (lat) { const float c = rc[pos * 32 + pp0 + i], s = rs[pos * 32 + pp0 + i]; const float y1 = x1 * c - x2 * s, y2 = x1 * s + x2 * c; x1 = y1; x2 = y2; }
        o[i] = pk2(x1, x2);
      }
      *(u32x2*)(KR + (((size_t)b * 4 + g) * TOKB + tok) * 64 + dd) = (u32x2){o[0], o[1]};
      const u32x2 v = *(const u32x2*)(rp + 1280 + 4 * lane);
      bf16_t* vp = VT + (((size_t)b * 4 + g) * 64 + dd) * TOKB + tok;
      vp[0] = (bf16_t)(v.x & 0xffff); vp[TOKB] = (bf16_t)(v.x >> 16); vp[2 * TOKB] = (bf16_t)(v.y & 0xffff); vp[3 * TOKB] = (bf16_t)(v.y >> 16);
    }
  }
}

__device__ __forceinline__ void at_core(const Params& p, const Ctx& cx) {
  const int lane = cx.tid & 63, gw = cx.bid * 8 + (cx.tid >> 6), NGW = cx.nb * 8, fr = lane & 15, fq = lane >> 4;
  char* ws = cx.ws;
  const bf16_t* ACT = (const bf16_t*)(ws + O_ACT); const bf16_t* KR = (const bf16_t*)(ws + O_AKR); const bf16_t* VT = (const bf16_t*)(ws + O_AVT);
  bf16_t* O = (bf16_t*)(ws + O_U);
  for (int u = gw; u < (MROWS / 16) * 4; u += NGW) {
    const int g = u & 3, qb = u >> 2, row0 = qb * 16;
    const bool lat = row0 < NLAT;
    const int b = lat ? row0 >> 12 : (row0 - NLAT) >> 8, q0 = lat ? row0 & 4095 : 0;
    bf16x8 qf[4][2];
    float mrun[4], lrun[4], sink[4];
    f32x4 oacc[4][4];
#pragma unroll
    for (int hh = 0; hh < 4; ++hh) {
      const bf16_t* qp = ACT + (size_t)(row0 + fr) * 1536 + (g * 4 + hh) * 64 + 8 * fq;
      qf[hh][0] = *(const bf16x8*)qp; qf[hh][1] = *(const bf16x8*)(qp + 32);
      sink[hh] = IN(20)[g * 4 + hh]; mrun[hh] = sink[hh]; lrun[hh] = 0.f;
#pragma unroll
      for (int d2 = 0; d2 < 4; ++d2) oacc[hh][d2] = (f32x4){0.f, 0.f, 0.f, 0.f};
    }
    const bf16_t* kbase = KR + ((size_t)b * 4 + g) * TOKB * 64;
    const bf16_t* vbase = VT + ((size_t)b * 4 + g) * 64 * TOKB;
    int wlo = 0, whi = -1;
    if (lat) { wlo = max(0, q0 - 128) & ~31; whi = min(SEQ - 1, q0 + 143); }
    const int nwin = lat ? (whi - wlo) / 32 + 1 : 0;
    for (int ti = 0; ti < 8 + nwin; ++ti) {
      const bool isw = ti >= 8;
      const int kpos0 = isw ? wlo + (ti - 8) * 32 : 0;
      const int tk0 = isw ? LC + kpos0 : ti * 32;
      const bf16_t* kp = kbase + (size_t)(tk0 + fr) * 64 + 8 * fq;
      const bf16x8 k00 = *(const bf16x8*)kp, k01 = *(const bf16x8*)(kp + 32), k10 = *(const bf16x8*)(kp + 16 * 64), k11 = *(const bf16x8*)(kp + 16 * 64 + 32);
      bf16x8 vfr[4];
#pragma unroll
      for (int d2 = 0; d2 < 4; ++d2) {
        const bf16_t* vp = vbase + (size_t)(d2 * 16 + fr) * TOKB + tk0 + 4 * fq;
        vfr[d2] = mk8(*(const u32x2*)vp, *(const u32x2*)(vp + 16));
      }
      bool okm[8];
#pragma unroll
      for (int i = 0; i < 8; ++i) {
        const int kpos = kpos0 + (i >> 2) * 16 + 4 * fq + (i & 3), dlt = (q0 + fr) - kpos;
        okm[i] = !isw || (dlt <= 128 && dlt >= -128);
      }
#pragma unroll
      for (int hh = 0; hh < 4; ++hh) {
        f32x4 s0 = {0.f, 0.f, 0.f, 0.f}, s1 = {0.f, 0.f, 0.f, 0.f};
        s0 = MFMA16(k00, qf[hh][0], s0); s0 = MFMA16(k01, qf[hh][1], s0);
        s1 = MFMA16(k10, qf[hh][0], s1); s1 = MFMA16(k11, qf[hh][1], s1);
        float sv[8]; float tmax = -3.0e38f;
#pragma unroll
        for (int i = 0; i < 8; ++i) { sv[i] = okm[i] ? (i < 4 ? s0[i] : s1[i - 4]) : -3.0e38f; tmax = fmaxf(tmax, sv[i]); }
        tmax = fmaxf(tmax, shx(tmax, 16, lane)); tmax = fmaxf(tmax, shx(tmax, 32, lane));
        const float mnew = fmaxf(mrun[hh], tmax), scale = __expf(mrun[hh] - mnew);
        mrun[hh] = mnew;
        float pv[8];
#pragma unroll
        for (int i = 0; i < 8; ++i) pv[i] = okm[i] ? __expf(sv[i] - mnew) : 0.f;
        const u32x4 pu = {pk2(pv[0], pv[1]), pk2(pv[2], pv[3]), pk2(pv[4], pv[5]), pk2(pv[6], pv[7])};
        const float ps = ((bflo(pu.x) + bfhi(pu.x)) + (bflo(pu.y) + bfhi(pu.y))) + ((bflo(pu.z) + bfhi(pu.z)) + (bflo(pu.w) + bfhi(pu.w)));
        lrun[hh] = lrun[hh] * scale + ps;
        const bf16x8 pf = mk8(pu);
        float scq[4];
#pragma unroll
        for (int jj = 0; jj < 4; ++jj) scq[jj] = shi(scale, 4 * fq + jj);
#pragma unroll
        for (int d2 = 0; d2 < 4; ++d2) {
          f32x4 o = oacc[hh][d2];
          o[0] *= scq[0]; o[1] *= scq[1]; o[2] *= scq[2]; o[3] *= scq[3];
          oacc[hh][d2] = MFMA16(pf, vfr[d2], o);
        }
      }
    }
#pragma unroll
    for (int hh = 0; hh < 4; ++hh) {
      float l = lrun[hh];
      l += shx(l, 16, lane); l += shx(l, 32, lane);
      l += __expf(sink[hh] - mrun[hh]);
      const float inv = __builtin_amdgcn_rcpf(l);
      float iq[4];
#pragma unroll
      for (int jj = 0; jj < 4; ++jj) iq[jj] = shi(inv, 4 * fq + jj);
#pragma unroll
      for (int d2 = 0; d2 < 4; ++d2)
#pragma unroll
        for (int jj = 0; jj < 4; ++jj)
          O[(size_t)(row0 + 4 * fq + jj) * D + (g * 4 + hh) * 64 + d2 * 16 + fr] = (bf16_t)(pk2(oacc[hh][d2][jj] * iq[jj], 0.f) & 0xffff);
    }
  }
}

__device__ __forceinline__ void sc_conv(const Params& p, const Ctx& cx) {
  const int gt = cx.bid * 512 + cx.tid, gs = cx.nb * 512;
  const bf16_t* ACT = (const bf16_t*)(cx.ws + O_ACT); bf16_t* O = (bf16_t*)(cx.ws + O_U);
  const float* cw = IN(23);
  for (int i = gt; i < MROWS * 128; i += gs) {
    const int row = i >> 7, c0 = (i & 127) * 8;
    int pos, seglen;
    if (row < NLAT) { pos = row & (SEQ - 1); seglen = SEQ; } else { pos = (row - NLAT) & (LC - 1); seglen = LC; }
    float accv[8];
#pragma unroll
    for (int e = 0; e < 8; ++e) accv[e] = 0.f;
#pragma unroll
    for (int k = 0; k < 3; ++k) {
      const int pp = pos + k - 1;
      if (pp < 0 || pp >= seglen) continue;
      const bf16_t* rp = ACT + (size_t)(row + k - 1) * 3072;
      const u32x4 cgv = *(const u32x4*)(rp + 1024 + c0), xtv = *(const u32x4*)(rp + 2048 + c0);
      const unsigned cu[4] = {cgv.x, cgv.y, cgv.z, cgv.w}, xu[4] = {xtv.x, xtv.y, xtv.z, xtv.w};
#pragma unroll
      for (int e = 0; e < 4; ++e) {
        accv[2 * e] += cw[k * D + c0 + 2 * e] * (bflo(cu[e]) * bflo(xu[e]));
        accv[2 * e + 1] += cw[k * D + c0 + 2 * e + 1] * (bfhi(cu[e]) * bfhi(xu[e]));
      }
    }
    const u32x4 bgv = *(const u32x4*)(ACT + (size_t)row * 3072 + c0);
    const unsigned bu[4] = {bgv.x, bgv.y, bgv.z, bgv.w};
    u32x4 o;
    o.x = pk2(bflo(bu[0]) * accv[0], bfhi(bu[0]) * accv[1]); o.y = pk2(bflo(bu[1]) * accv[2], bfhi(bu[1]) * accv[3]);
    o.z = pk2(bflo(bu[2]) * accv[4], bfhi(bu[2]) * accv[5]); o.w = pk2(bflo(bu[3]) * accv[6], bfhi(bu[3]) * accv[7]);
    *(u32x4*)(O + (size_t)row * D + c0) = o;
  }
}

#define XB_TMO      128
#define XB_XCNT(j)  (256  + 64 * (j))
#define XB_XSUB(j)  (1280 + 64 * (j))
#define XB_XGEN(j)  (2304 + 64 * (j))
#define XB_TOP      3328
#define XB_TOPGEN   3392
#define XCD_BAR_WORDS 3456
#define XB_SPIN_CAP (1u << 18)
__device__ __forceinline__ unsigned xb_ld(unsigned* p)              { return __hip_atomic_load(p, __ATOMIC_RELAXED, __HIP_MEMORY_SCOPE_AGENT); }
__device__ __forceinline__ unsigned xb_add(unsigned* p, unsigned v) { return __hip_atomic_fetch_add(p, v, __ATOMIC_RELAXED, __HIP_MEMORY_SCOPE_AGENT); }
__device__ __forceinline__ unsigned xb_xcc_id() { return (unsigned)__builtin_amdgcn_s_getreg((3 << 11) | 20) & 0xFu; }
#define XB_SPIN(cond, bar) do { unsigned _sp = 0; while (cond) { __builtin_amdgcn_s_sleep(1); \
    if ((++_sp & 255u) == 0u) { if (xb_ld(&(bar)[XB_TMO])) break; if (_sp > XB_SPIN_CAP) { atomicAdd(&(bar)[XB_TMO], 1u); break; } } } } while (0)
__device__ __forceinline__ void xcd_barrier_complete(unsigned* bar, unsigned x, unsigned& nloc, unsigned& nx) {
  const unsigned G = gridDim.x;
  unsigned sum, cnt, mine, sp = 0u;
  for (;;) {
    sum = 0u; cnt = 0u; mine = 0u;
#pragma unroll
    for (unsigned j = 0; j < 16; ++j) { const unsigned c = xb_ld(&bar[XB_XCNT(j)]); sum += c; cnt += (c > 0u) ? 1u : 0u; mine = (j == x) ? c : mine; }
    if (sum == G) break;
    __builtin_amdgcn_s_sleep(1);
    if ((++sp & 255u) == 0u) { if (xb_ld(&bar[XB_TMO])) break; if (sp > XB_SPIN_CAP) { atomicAdd(&bar[XB_TMO], 1u); break; } }
  }
  nloc = mine > 0u ? mine : 1u; nx = cnt > 0u ? cnt : 1u;
}
__device__ __forceinline__ void xcd_barrier(unsigned* bar, unsigned x, volatile LAS unsigned* st) {
  asm volatile("s_waitcnt vmcnt(0)" ::: "memory");
  __syncthreads();
  if (threadIdx.x == 0) {
    __builtin_amdgcn_s_waitcnt(0);
    unsigned nloc = st[0], nx = st[1];
    if (nloc == 0u) { xcd_barrier_complete(bar, x, nloc, nx); st[0] = nloc; st[1] = nx; }
    const unsigned old = xb_add(&bar[XB_XSUB(x)], 1u);
    const unsigned gen = old / nloc;
    if (old + 1u == (gen + 1u) * nloc) {
      __builtin_amdgcn_fence(__ATOMIC_RELEASE, "agent");
      asm volatile("s_waitcnt vmcnt(0)" ::: "memory");
      const unsigned og = xb_add(&bar[XB_TOP], 1u);
      const unsigned tg = og / nx;
      if (og + 1u == (tg + 1u) * nx) xb_add(&bar[XB_TOPGEN], 1u);
      else XB_SPIN(xb_ld(&bar[XB_TOPGEN]) == tg, bar);
      __builtin_amdgcn_fence(__ATOMIC_ACQUIRE, "agent");
      xb_add(&bar[XB_XGEN(x)], 1u);
      asm volatile("s_waitcnt vmcnt(0)" ::: "memory");
    } else {
      XB_SPIN(xb_ld(&bar[XB_XGEN(x)]) == gen, bar);
      __builtin_amdgcn_fence(__ATOMIC_ACQUIRE, "agent");
      asm volatile("s_waitcnt vmcnt(0)" ::: "memory");
    }
  }
  __syncthreads();
}

#ifndef ENMASK
#define ENMASK 0xffff
#endif
#define EN(i) ((ENMASK >> (i)) & 1)
enum { OP_PRO = 0, OP_LN0, OP_LN1, OP_LNF, OP_FFI, OP_FFO, OP_UP, OP_M0, OP_GAT, OP_S, OP_M2, OP_FIN, OP_DN, OP_AQ, OP_APREP, OP_ACORE, OP_AO, OP_SI, OP_SCONV, OP_SO, OP_DNUP };
__global__ void __launch_bounds__(512) fwd_megakernel(Params p) {
  cg::grid_group grid = cg::this_grid();
  const int wave_s = __builtin_amdgcn_readfirstlane((int)threadIdx.x >> 6);
  volatile LAS unsigned* xst = (volatile LAS unsigned*)((LAS unsigned char*)lds_raw + (LDS_BYTES - 16));
  if (threadIdx.x == 0) { xst[0] = 0u; xst[1] = 0u; }
  __syncthreads();
  unsigned* xbar = (unsigned*)(p.ws + O_BAR);
  const unsigned xcc = xb_xcc_id();
  if (threadIdx.x == 0) (void)xb_add(&xbar[XB_XCNT(xcc)], 1u);
#ifdef DUP_OP
  int rep = 0;
#endif
  for (int ph = 0; ph < p.nph; ++ph) {
    const unsigned w = p.prog[ph];
    const int op = w & 255, a = (w >> 8) & 255, b = (w >> 16) & 255, c = (w >> 24) & 255;
#define MKCTX int z; asm volatile("s_mov_b32 %0, 0" : "=s"(z)); \
    GAS char* wsq = (GAS char*)p.ws; GAS float* outq = (GAS float*)p.out; int bidq = (int)blockIdx.x, nbq = (int)gridDim.x; \
    asm volatile("" : "+s"(wsq), "+s"(outq), "+s"(bidq), "+s"(nbq)); \
    const Ctx cx{wave_s * 64 + (int)__builtin_amdgcn_mbcnt_hi(~0u, __builtin_amdgcn_mbcnt_lo(~0u, (unsigned)z)), bidq, nbq, z, (char*)wsq, (float*)outq};
    if (EN(0) && op == OP_PRO) { MKCTX prologue(p, cx); }
    else if (EN(1) && op == OP_LN0) { MKCTX lnmod_phase<0>(p, cx, 0, 0, 0); }
    else if (EN(1) && op == OP_LN1) { MKCTX lnmod_phase<1>(p, cx, a, b, c); }
    else if (EN(1) && op == OP_LNF) { MKCTX lnmod_phase<2>(p, cx, a, 0, 0); }
    else if (EN(2) && op == OP_M0) { MKCTX ml_m0(p, cx, a); }
    else if (EN(3) && op == OP_GAT) { MKCTX ml_gates(p, cx, a); }
    else if (EN(4) && op == OP_S) { MKCTX ml_s(p, cx); }
    else if (EN(5) && op == OP_M2) { MKCTX ml_m2(p, cx); }
    else if (EN(6) && op == OP_FIN) { MKCTX ml_fin(p, cx, a); }
    else if (EN(7) && op == OP_APREP) { MKCTX at_prep(p, cx); }
    else if (EN(8) && op == OP_ACORE) { MKCTX at_core(p, cx); }
    else if (EN(9) && op == OP_SCONV) { MKCTX sc_conv(p, cx); }
    else if (EN(10)) {
      MKCTX
      char* ws = cx.ws;
      const RowMap idm{0, 0, 1 << 30};
      bf16_t* U = (bf16_t*)(ws + O_U); bf16_t* ACT = (bf16_t*)(ws + O_ACT);
      const float* MODT = (const float*)(ws + O_MODT);
      const int nrep = op == OP_DNUP ? 2 : 1;
      for (int rep = 0; rep < nrep; ++rep) {
        const int op2 = op == OP_DNUP ? (rep == 0 ? (int)OP_UP : (int)OP_DN) : op;
        const int c2 = (op == OP_DNUP && rep == 0) ? c + 1 : c;
        Ctx cg_ = cx;
        if (op == OP_DNUP && rep == 1) cg_.bid = (cx.bid + cx.nb - 32) % cx.nb;
        const bf16_t* A = U; const bf16_t* Bt; int K = 1024, nM = MROWS / 256, nN; RowMap am = idm, cm = idm;
        Epi E; E.kind = 2; E.O = ACT; E.ldc = 0; E.modl = MODT + (size_t)b * 9 * 9216; E.slot = 1; E.wgt = 1.0f;
        if (op2 == OP_FFI) { Bt = (const bf16_t*)(ws + O_WFI) + (size_t)a * 5632 * 1024; nN = 22; E.kind = 1; if (c) nM = NLAT / 256; }
        else if (op2 == OP_FFO) { A = ACT; Bt = (const bf16_t*)(ws + O_WFO) + (size_t)a * 1024 * 2816; K = 2816; nN = 4; E.slot = c & 3; E.wgt = 0.5f; if (c & 4) nM = NLAT / 256; }
        else if (op2 == OP_UP) { Bt = (const bf16_t*)(ws + O_WUP) + (size_t)a * 4096 * 1024; nM = RG / 256; nN = 16; am = RowMap{c2 * GB * SEQ, NLAT + c2 * GB * LC, GB * SEQ / 256}; E.kind = 0; E.O = (bf16_t*)(ws + O_XZ); E.ldc = 4096; }
        else if (op2 == OP_DN) { A = (const bf16_t*)(ws + O_FIN); Bt = (const bf16_t*)(ws + O_WDN) + (size_t)a * 1024 * 2048; K = 2048; nM = RG / 256; nN = 4; cm = RowMap{c2 * GB * SEQ, NLAT + c2 * GB * LC, GB * SEQ / 256}; }
        else if (op2 == OP_AQ) { Bt = (const bf16_t*)(ws + O_WAQ); nN = 6; E.kind = 0; E.ldc = 1536; }
        else if (op2 == OP_AO) { Bt = (const bf16_t*)(ws + O_WAO); nN = 4; }
        else if (op2 == OP_SI) { Bt = (const bf16_t*)(ws + O_WSI); nN = 12; E.kind = 0; E.ldc = 3072; }
        else { Bt = (const bf16_t*)(ws + O_WSO); nN = 4; }
        gemm_phase(cg_, A, am, Bt, K, nM, nN, cm, E);
      }
    }
    if (ph == 0) grid.sync(); else xcd_barrier(xbar, xcc, xst);
#ifdef DUP_OP
    if (op == DUP_OP && rep + 1 < DUP_N) { ++rep; --ph; } else rep = 0;
#endif
  }
}

static int build_program(unsigned* prog) {
  int n = 0;
  auto W = [&](int op, int a, int b, int c) { prog[n++] = (unsigned)op | ((unsigned)a << 8) | ((unsigned)b << 16) | ((unsigned)c << 24); };
  W(OP_PRO, 0, 0, 0);
  W(OP_LN0, 0, 0, 0);
  for (int layer = 0; layer < DEPTH; ++layer) {
    const int kind = layer % 3, j = layer / 3;
    W(OP_FFI, layer * 2, layer, 0); W(OP_FFO, layer * 2, layer, 0);
    W(OP_LN1, layer * 3 + 0, layer, 1);
    if (kind == 0) {
      for (int g = 0; g < NG; ++g) { if (g == 0) W(OP_UP, j, layer, g); W(OP_M0, j, 0, 0); W(OP_GAT, j, 0, 0); W(OP_S, 0, 0, 0); W(OP_M2, 0, 0, 0); W(OP_FIN, j, 0, 0); W(g + 1 < NG ? OP_DNUP : OP_DN, j, layer, g); }
    } else if (kind == 1) { W(OP_AQ, 0, layer, 0); W(OP_APREP, 0, 0, 0); W(OP_ACORE, 0, 0, 0); W(OP_AO, 0, layer, 0); }
    else { W(OP_SI, 0, layer, 0); W(OP_SCONV, 0, 0, 0); W(OP_SO, 0, layer, 0); }
    W(OP_LN1, layer * 3 + 1, layer, 2);
    const int lo = (layer + 1 == DEPTH) ? 1 : 0;
    W(OP_FFI, layer * 2 + 1, layer, lo); W(OP_FFO, layer * 2 + 1, layer, 2 | (lo << 2));
    if (layer + 1 < DEPTH) W(OP_LN1, layer * 3 + 2, layer + 1, 0); else W(OP_LNF, layer * 3 + 2, 0, 0);
  }
  return n;
}

extern "C" void kernel_launch(void* const* d_in, const int* in_sizes, int n_in, void* d_out, int out_size, void* d_ws, size_t ws_size, hipStream_t stream) {
  static int grid_blocks = 0;
  if (!grid_blocks) {
    int dev = 0, cus = 0, per_cu = 0;
    (void)hipGetDevice(&dev);
    (void)hipDeviceGetAttribute(&cus, hipDeviceAttributeMultiprocessorCount, dev);
    (void)hipFuncSetAttribute((const void*)fwd_megakernel, hipFuncAttributeMaxDynamicSharedMemorySize, LDS_BYTES);
    (void)hipOccupancyMaxActiveBlocksPerMultiprocessor(&per_cu, fwd_megakernel, 512, LDS_BYTES);
    if (cus <= 0) cus = 256;
    grid_blocks = cus;
    if (ws_size < WS_END || n_in != 25) fprintf(stderr, "kernel_launch: workspace %zu < %zu or n_in %d != 25\n", ws_size, (size_t)WS_END, n_in);
    if (per_cu < 1) fprintf(stderr, "kernel_launch: occupancy query says %d blocks per CU\n", per_cu);
  }
  Params p{};
  for (int i = 0; i < 25; ++i) p.in[i] = (const float*)d_in[i];
  p.out = (float*)d_out; p.ws = (char*)d_ws;
  p.nph = build_program(p.prog);
  (void)hipMemsetAsync((char*)d_ws + O_BAR, 0, XCD_BAR_WORDS * 4, stream);
  void* args[] = {&p};
  hipError_t e = hipLaunchCooperativeKernel((void*)fwd_megakernel, dim3(grid_blocks), dim3(512), args, LDS_BYTES, stream);
  if (e != hipSuccess) fprintf(stderr, "cooperative launch failed: %s (grid %d)\n", hipGetErrorString(e), grid_blocks);
}
```

```cpp
#include <hip/hip_runtime.h>
#include <hip/hip_cooperative_groups.h>
#include <cstdio>
#include <cstdint>
namespace cg = cooperative_groups;

typedef unsigned short bf16_t;
typedef short bf16x8 __attribute__((ext_vector_type(8)));
typedef short bf16x4 __attribute__((ext_vector_type(4)));
typedef float f32x4 __attribute__((ext_vector_type(4)));
typedef unsigned u32x2 __attribute__((ext_vector_type(2)));
typedef unsigned u32x4 __attribute__((ext_vector_type(4)));

constexpr int D = 1024, NB = 8, SEQ = 4096, LC = 256, DEPTH = 4, FF = 2816, EI = 2048, DH = 512;
constexpr int NLAT = NB * SEQ, NCTX = NB * LC, MROWS = NLAT + NCTX;
constexpr int TOKB = LC + SEQ;
constexpr int NCH = TOKB / 64;
constexpr int GB = 2, NG = NB / GB, RG = GB * TOKB;
constexpr int NSEQ = GB * 8;
constexpr float ALPHA = 1.681792830507429f, LN_EPS = 1e-5f;
constexpr int LDS_BYTES = 144 * 1024;

constexpr size_t al256(size_t x) { return (x + 255) & ~(size_t)255; }
constexpr size_t O_WFI = 0;
constexpr size_t O_WFO = O_WFI + (size_t)8 * 5632 * 1024 * 2;
constexpr size_t O_WUP = O_WFO + (size_t)8 * 1024 * 2816 * 2;
constexpr size_t O_WDN = O_WUP + (size_t)2 * 4096 * 1024 * 2;
constexpr size_t O_WAQ = O_WDN + (size_t)2 * 1024 * 2048 * 2;
constexpr size_t O_WAO = O_WAQ + (size_t)1536 * 1024 * 2;
constexpr size_t O_WSI = O_WAO + (size_t)1024 * 1024 * 2;
constexpr size_t O_WSO = O_WSI + (size_t)3072 * 1024 * 2;
constexpr size_t O_WG = O_WSO + (size_t)1024 * 1024 * 2;
constexpr size_t O_MODT = O_WG + (size_t)2 * 16 * 6144 * 2;
constexpr size_t O_ROPE = O_MODT + (size_t)4 * 9 * 9216 * 4;
constexpr size_t O_HCTX = O_ROPE + (size_t)2 * 4096 * 32 * 4;
constexpr size_t O_U = O_HCTX + (size_t)NCTX * D * 4;
constexpr size_t O_R = O_U + (size_t)MROWS * D * 2;
constexpr size_t O_XZ = O_R;
constexpr size_t O_QK = O_XZ + (size_t)RG * 4096 * 2;
constexpr size_t O_KT = O_QK + (size_t)RG * 4096 * 2;
constexpr size_t O_VT = O_KT + (size_t)GB * EI * TOKB * 2;
constexpr size_t O_SP = O_VT + (size_t)GB * EI * TOKB * 2;
constexpr size_t O_HD = O_SP + (size_t)NSEQ * NCH * 4096 * 2;
constexpr size_t O_FIN = O_HD + (size_t)2 * RG * EI * 2;
constexpr size_t O_GAT = O_FIN + (size_t)RG * EI * 2;
constexpr size_t SZ_ST = (size_t)NSEQ * TOKB * 4;
constexpr size_t O_BL = O_GAT, O_IG = O_BL + SZ_ST, O_WIN = O_IG + SZ_ST, O_FLO = O_WIN + SZ_ST, O_DEN = O_FLO + SZ_ST, O_WSS = O_DEN + SZ_ST;
constexpr size_t O_GC = O_WSS + SZ_ST;
constexpr size_t O_QF = O_GC + (size_t)3 * NSEQ * NCH * 4 + 256;
constexpr size_t O_REND_ML = O_QF + (size_t)GB * EI * TOKB * 2;
constexpr size_t O_ACT = O_R;
constexpr size_t O_AKR = O_R + (size_t)MROWS * 3072 * 2;
constexpr size_t O_AVT = O_AKR + (size_t)NB * 4 * TOKB * 64 * 2;
constexpr size_t O_REND_AT = O_AVT + (size_t)NB * 4 * TOKB * 64 * 2;
constexpr size_t O_BAR = (O_REND_ML > O_REND_AT ? O_REND_ML : O_REND_AT);
constexpr size_t O_STATS = O_BAR + 3456 * 4 + 256;
constexpr size_t O_LNT = O_STATS + (size_t)MROWS * 8 + 256;
constexpr size_t WS_END = O_LNT + (size_t)12 * 2 * D * 4 + 256;

struct Params {
  const float* in[25];
  float* out;
  char* ws;
  int nph; int pad0;
  unsigned prog[126];
};

#define GAS __attribute__((address_space(1)))
#define IN(k) ((const float*)(const GAS float*)p.in[(k) + cx.z])
struct Ctx { int tid, bid, nb, z; char* ws; float* out; };
extern __shared__ __attribute__((aligned(16))) char lds_raw[];

__device__ __forceinline__ unsigned pk2(float lo, float hi) { unsigned r; asm volatile("v_cvt_pk_bf16_f32 %0, %1, %2" : "=v"(r) : "v"(lo), "v"(hi)); return r; }
__device__ __forceinline__ float bf2f(unsigned short v) { return __uint_as_float(((unsigned)v) << 16); }
__device__ __forceinline__ float bflo(unsigned v) { return __uint_as_float(v << 16); }
__device__ __forceinline__ float bfhi(unsigned v) { return __uint_as_float(v & 0xffff0000u); }
__device__ __forceinline__ float silu_f(float x) { return x * __builtin_amdgcn_rcpf(1.f + __expf(-x)); }
__device__ __forceinline__ float sigm_f(float x) { return __builtin_amdgcn_rcpf(1.f + __expf(-x)); }
__device__ __forceinline__ float shi(float v, int srclane) { return __int_as_float(__builtin_amdgcn_ds_bpermute(srclane << 2, __float_as_int(v))); }
__device__ __forceinline__ float shx(float v, int m, int lane) { return shi(v, lane ^ m); }
__device__ __forceinline__ float wave_sum(float v, int lane) {
#pragma unroll
  for (int o = 1; o < 64; o <<= 1) v += shx(v, o, lane);
  return v;
}
__device__ __forceinline__ bf16x8 mk8(u32x4 v) { union { u32x4 u; bf16x8 b; } x; x.u = v; return x.b; }
__device__ __forceinline__ bf16x8 mk8(u32x2 a, u32x2 b) { union { u32x4 u; bf16x8 b; } x; x.u = (u32x4){a.x, a.y, b.x, b.y}; return x.b; }
__device__ __forceinline__ float* hrow(const Ctx& cx, int row) { return row < NLAT ? cx.out + (size_t)row * D : (float*)(cx.ws + O_HCTX) + (size_t)(row - NLAT) * D; }
#define MFMA16(a, b, c) __builtin_amdgcn_mfma_f32_16x16x32_bf16(a, b, c, 0, 0, 0)

constexpr int BM = 256, BK = 64, HALF = 128, HT = HALF * BK, NXCD = 8, WGM = 8;
__device__ __forceinline__ int lds_byte(int r, int c) {
  int st = (r >> 4) * 2 + (c >> 5), rr = r & 15, cc = c & 31, ob = rr * 64 + cc * 2;
  return st * 1024 + (ob ^ (((ob >> 9) & 1) << 5));
}
__device__ __forceinline__ void stage_rc(int b, int& R, int& C) {
  int st = b / 1024, sb = b % 1024, swz = sb ^ (((sb >> 9) & 1) << 5);
  R = (st >> 1) * 16 + swz / 64; C = (st & 1) * 32 + (swz % 64) / 2;
}
struct RowMap { int lat0, ctx0, nlat; __device__ __forceinline__ int row0(int pm) const { return pm < nlat ? lat0 + pm * 256 : ctx0 + (pm - nlat) * 256; } };

typedef f32x4 Acc[2][2][4][2];

struct Epi {
  int kind; bf16_t* O; int ldc; const float* modl; int slot; float wgt;
  int ln;
};
__device__ __forceinline__ void run_epi(const Ctx& cx, const Epi E, const Acc& acc, int r0, int pn, int wr, int wc, int fr, int fq) {
  if (E.kind == 0) {
#pragma unroll
    for (int ai = 0; ai < 2; ++ai)
#pragma unroll
      for (int m = 0; m < 4; ++m) {
        bf16_t* rp = E.O + (size_t)(r0 + ai * HALF + wr * 64 + m * 16 + fr) * E.ldc + pn * 256 + wc * 32 + 4 * fq;
#pragma unroll
        for (int bj = 0; bj < 2; ++bj)
#pragma unroll
          for (int n = 0; n < 2; ++n) {
            f32x4 v = acc[ai][bj][m][n];
            u32x2 o; o.x = pk2(v[0], v[1]); o.y = pk2(v[2], v[3]);
            *(u32x2*)(rp + bj * HALF + n * 16) = o;
          }
      }
  } else if (E.kind == 1) {
#pragma unroll
    for (int ai = 0; ai < 2; ++ai)
#pragma unroll
      for (int m = 0; m < 4; ++m) {
        bf16_t* rp = E.O + (size_t)(r0 + ai * HALF + wr * 64 + m * 16 + fr) * FF + pn * 128 + wc * 16 + 4 * fq;
#pragma unroll
        for (int bj = 0; bj < 2; ++bj) {
          f32x4 g = acc[ai][bj][m][0], v = acc[ai][bj][m][1];
          u32x2 o; o.x = pk2(silu_f(g[0]) * v[0], silu_f(g[1]) * v[1]); o.y = pk2(silu_f(g[2]) * v[2], silu_f(g[3]) * v[3]);
          *(u32x2*)(rp + bj * 64) = o;
        }
      }
  } else {
    const int midx = r0 < NLAT ? (r0 >> 12) : 8;
    const int cb = pn * 256 + wc * 32 + 4 * fq;
    const float* gp = E.modl + (size_t)midx * 9216 + (3 * E.slot + 2) * D + cb;
    f32x4 gv[2][2], lg[2][2], lb[2][2];
#pragma unroll
    for (int bj = 0; bj < 2; ++bj)
#pragma unroll
      for (int n = 0; n < 2; ++n) {
        gv[bj][n] = *(const f32x4*)(gp + bj * HALF + n * 16) * E.wgt;
        if (E.ln >= 0) { const float* lt = (const float*)(cx.ws + O_LNT) + (size_t)E.ln * 2 * D + cb + bj * HALF + n * 16; lg[bj][n] = *(const f32x4*)lt; lb[bj][n] = *(const f32x4*)(lt + D); }
        else { lg[bj][n] = (f32x4){1.f, 1.f, 1.f, 1.f}; lb[bj][n] = (f32x4){0.f, 0.f, 0.f, 0.f}; }
      }
#pragma unroll
    for (int ai = 0; ai < 2; ++ai)
#pragma unroll
      for (int m = 0; m < 4; ++m) {
        const int row = r0 + ai * HALF + wr * 64 + m * 16 + fr;
        float* rp = hrow(cx, row) + cb;
        float mean = 0.f, rstd = 1.f;
        if (E.ln >= 0) { const float2 st = *(const float2*)((const float*)(cx.ws + O_STATS) + (size_t)row * 2); mean = st.x; rstd = st.y; }
        f32x4 h[2][2];
#pragma unroll
        for (int bj = 0; bj < 2; ++bj)
#pragma unroll
          for (int n = 0; n < 2; ++n) h[bj][n] = *(const f32x4*)(rp + bj * HALF + n * 16);
#pragma unroll
        for (int bj = 0; bj < 2; ++bj)
#pragma unroll
          for (int n = 0; n < 2; ++n) *(f32x4*)(rp + bj * HALF + n * 16) = ((h[bj][n] - mean) * rstd) * lg[bj][n] + lb[bj][n] + gv[bj][n] * acc[ai][bj][m][n];
        __builtin_amdgcn_sched_barrier(0);
      }
  }
}

#define LAS __attribute__((address_space(3)))
__device__ __forceinline__ void gemm_phase(const Ctx& cx, const bf16_t* __restrict__ A, RowMap am, const bf16_t* __restrict__ Bt, int K, int nM, int nN, RowMap cm, const Epi epi) {
  LAS unsigned char* lds = (LAS unsigned char*)lds_raw;
  constexpr int HTB = HT * 2;
  const int tid = cx.tid, wid = tid >> 6, lane = tid & 63, wr = wid >> 2, wc = wid & 3, fr = lane & 15, fq = lane >> 4;
  unsigned voff[2];
#pragma unroll
  for (int i = 0; i < 2; ++i) { int R, C; stage_rc(tid * 16 + i * 8192, R, C); voff[i] = (unsigned)(R * K + C) * 2u; }
  const size_t kstep = (size_t)(BK * 2), hstep = (size_t)HALF * K * 2;
  const unsigned ldsw = (unsigned)wid * 1024u;
  const int aoff = lds_byte(wr * 64 + fr, fq * 8), boff = lds_byte(wc * 32 + fr, fq * 8);
#define G_SA(b, h) (((b) * 2 + (h)) * HTB)
#define G_SB(b, h) ((4 + (b) * 2 + (h)) * HTB)
#define STAGE(bufoff, gbase) do { _Pragma("unroll") for (int _i = 0; _i < 2; ++_i) \
    __builtin_amdgcn_global_load_lds((const unsigned*)((const char*)(gbase) + voff[_i]), (LAS unsigned*)(lds + (bufoff) + ldsw + _i * 8192), 16, 0, 0); } while (0)
#define LDA(dst, b, h) do { _Pragma("unroll") for (int m = 0; m < 4; ++m) _Pragma("unroll") for (int k = 0; k < 2; ++k) dst[m][k] = *(const LAS bf16x8*)(lds + G_SA(b, h) + aoff + m * 2048 + k * 1024); } while (0)
#define LDB(dst, b, h) do { _Pragma("unroll") for (int n = 0; n < 2; ++n) _Pragma("unroll") for (int k = 0; k < 2; ++k) dst[n][k] = *(const LAS bf16x8*)(lds + G_SB(b, h) + boff + n * 2048 + k * 1024); } while (0)
#define MMA(ai, bj, At, Bt_) do { __builtin_amdgcn_s_setprio(1); _Pragma("unroll") for (int m = 0; m < 4; ++m) _Pragma("unroll") for (int n = 0; n < 2; ++n) _Pragma("unroll") for (int k = 0; k < 2; ++k) \
      acc[ai][bj][m][n] = MFMA16(Bt_[n][k], At[m][k], acc[ai][bj][m][n]); \
    __builtin_amdgcn_s_setprio(0); } while (0)
#define WAIT_V(n) asm volatile("s_waitcnt vmcnt(" #n ")" ::: "memory")
#define WAIT_L(n) asm volatile("s_waitcnt lgkmcnt(" #n ")" ::: "memory")
#define BAR __builtin_amdgcn_s_barrier()
#define SCHED __builtin_amdgcn_sched_barrier(0)
  const int nwg = nM * nN;
  const int nt = K / BK;
  const int wid_s = __builtin_amdgcn_readfirstlane(wid);
#define DECODE(L_, pm_, pn_) do { int wgid = (L_); \
    { int q = nwg / NXCD, r = nwg % NXCD, xcd = wgid % NXCD, off = wgid / NXCD; wgid = (xcd < r ? xcd * (q + 1) : r * (q + 1) + (xcd - r) * q) + off; } \
    const int nig = WGM * nN, gid = wgid / nig, fm = gid * WGM, gsz = min(nM - fm, WGM); \
    pm_ = fm + ((wgid % nig) % gsz); pn_ = (wgid % nig) / gsz; } while (0)
  int L = cx.bid;
  if (L < nwg) {
    int pm, pn;
    DECODE(L, pm, pn);
    const char* cA = (const char*)A + (size_t)am.row0(pm) * K * 2; const char* cB = (const char*)Bt + (size_t)pn * BM * K * 2;
    Acc acc;
#pragma unroll
    for (int a = 0; a < 2; ++a)
#pragma unroll
      for (int b = 0; b < 2; ++b)
#pragma unroll
        for (int m = 0; m < 4; ++m)
#pragma unroll
          for (int n = 0; n < 2; ++n) acc[a][b][m][n] = (f32x4){0.f, 0.f, 0.f, 0.f};
    bf16x8 At[4][2], B0[2][2], B1[2][2];
    STAGE(G_SB(0, 0), cB); STAGE(G_SA(0, 0), cA); STAGE(G_SB(0, 1), cB + hstep); STAGE(G_SA(0, 1), cA + hstep);
    if (wr == 1) BAR;
    WAIT_V(4); BAR;
    STAGE(G_SB(1, 0), cB + kstep); STAGE(G_SA(1, 0), cA + kstep); STAGE(G_SB(1, 1), cB + hstep + kstep);
    WAIT_V(6); BAR;
    for (;;) {
      const int Ln = L + cx.nb;
      const bool has_next = Ln < nwg;
      int pmn = pm, pnn = pn;
      if (has_next) DECODE(Ln, pmn, pnn);
      const char* nA = has_next ? (const char*)A + (size_t)am.row0(pmn) * K * 2 : cA; const char* nB = has_next ? (const char*)Bt + (size_t)pnn * BM * K * 2 : cB;
      for (int t = 0; t < nt; t += 2) {
        const bool last = (t == nt - 2);
        const char* a1 = cA + (size_t)(t + 1) * kstep;
        const char* a2 = last ? nA : cA + (size_t)(t + 2) * kstep; const char* b2 = last ? nB : cB + (size_t)(t + 2) * kstep;
        const char* a3 = a2 + kstep; const char* b3 = b2 + kstep;
        LDB(B0, 0, 0); SCHED; LDA(At, 0, 0); STAGE(G_SA(1, 1), a1 + hstep);
        WAIT_L(8); BAR; WAIT_L(0); MMA(0, 0, At, B0); BAR; SCHED;
        LDB(B1, 0, 1); STAGE(G_SB(0, 0), b2);
        BAR; WAIT_L(0); MMA(0, 1, At, B1); BAR;
        LDA(At, 0, 1); STAGE(G_SA(0, 0), a2);
        BAR; WAIT_L(0); MMA(1, 0, At, B0); BAR; SCHED;
        STAGE(G_SB(0, 1), b2 + hstep);
        WAIT_V(6); BAR; MMA(1, 1, At, B1); BAR;
        LDB(B0, 1, 0); SCHED; LDA(At, 1, 0); STAGE(G_SA(0, 1), a2 + hstep);
        WAIT_L(8); BAR; WAIT_L(0); MMA(0, 0, At, B0); BAR; SCHED;
        LDB(B1, 1, 1); STAGE(G_SB(1, 0), b3);
        BAR; WAIT_L(0); MMA(0, 1, At, B1); BAR;
        LDA(At, 1, 1); STAGE(G_SA(1, 0), a3);
        BAR; WAIT_L(0); MMA(1, 0, At, B0); BAR; SCHED;
        STAGE(G_SB(1, 1), b3 + hstep);
        WAIT_V(6); BAR; MMA(1, 1, At, B1); BAR;
      }
      { int t2 = wid_s * 64 + (int)__builtin_amdgcn_mbcnt_hi(~0u, __builtin_amdgcn_mbcnt_lo(~0u, (unsigned)cx.z)); asm volatile("" : "+v"(t2));
        const int w2 = t2 >> 6, l2 = t2 & 63;
        run_epi(cx, epi, acc, cm.row0(pm), pn, w2 >> 2, w2 & 3, l2 & 15, l2 >> 4); }
      if (!has_next) break;
#pragma unroll
      for (int a = 0; a < 2; ++a)
#pragma unroll
        for (int b = 0; b < 2; ++b)
#pragma unroll
          for (int m = 0; m < 4; ++m)
#pragma unroll
            for (int n = 0; n < 2; ++n) acc[a][b][m][n] = (f32x4){0.f, 0.f, 0.f, 0.f};
      pm = pmn; pn = pnn; cA = nA; cB = nB; L = Ln;
    }
    WAIT_V(0);
    if (wr == 0) BAR;
    BAR;
  }
  __syncthreads();
}

template <int MODE>
__device__ __forceinline__ int wrow(int c) {
  if (MODE == 0) return c;
  const int isv = c >= FF ? 1 : 0, f = c - isv * FF;
  return (f >> 7) * 256 + ((f >> 6) & 1) * 128 + ((f >> 4) & 3) * 32 + isv * 16 + (f & 15);
}
template <int MODE>
__device__ __forceinline__ void transpose_item(const float* __restrict__ W, int K, int N, bf16_t* __restrict__ WT, float* scr, int item, int lane) {
  const int nblk = N / 32, kb = item / nblk, nb = item % nblk, k0 = 64 * kb, n0 = 32 * nb;
#pragma unroll 8
  for (int i = 0; i < 32; ++i) { const int kk = 2 * i + (lane >> 5); scr[kk * 33 + (lane & 31)] = W[(size_t)(k0 + kk) * N + n0 + (lane & 31)]; }
  __builtin_amdgcn_wave_barrier(); asm volatile("s_waitcnt lgkmcnt(0)" ::: "memory");
  const int c = lane & 7;
#pragma unroll
  for (int j = 0; j < 4; ++j) {
    const int n = (lane >> 3) + 8 * j; const float* s = scr + (8 * c) * 33 + n;
    u32x4 o; o.x = pk2(s[0 * 33], s[1 * 33]); o.y = pk2(s[2 * 33], s[3 * 33]); o.z = pk2(s[4 * 33], s[5 * 33]); o.w = pk2(s[6 * 33], s[7 * 33]);
    *(u32x4*)(WT + (size_t)wrow<MODE>(n0 + n) * K + k0 + 8 * c) = o;
  }
  asm volatile("s_waitcnt lgkmcnt(0)" ::: "memory"); __builtin_amdgcn_wave_barrier();
}

__device__ __forceinline__ void prologue(const Params& p, const Ctx& cx) {
  const int tid = cx.tid, lane = tid & 63, wave = tid >> 6;
  char* ws = cx.ws;
  {
    float* cond = (float*)lds_raw;
    float* red = (float*)(lds_raw + 9 * 1024 * 4);
    for (int i = tid; i < 9 * 1024; i += 512) { const int j = i >> 10, k = i & 1023; cond[i] = silu_f(j < 8 ? IN(1)[j * 1024 + k] : IN(3)[k]); }
    __syncthreads();
    for (int u = cx.bid; u < 4 * 36; u += cx.nb) {
      const int layer = u / 36, ct = u % 36, c0 = ct * 256 + 4 * lane;
      const float* wp = IN(4) + (size_t)layer * D * 9216 + c0;
      f32x4 a[9];
#pragma unroll
      for (int j = 0; j < 9; ++j) a[j] = (f32x4){0.f, 0.f, 0.f, 0.f};
#pragma unroll 4
      for (int k = wave * 128; k < wave * 128 + 128; ++k) {
        const f32x4 w = *(const f32x4*)(wp + (size_t)k * 9216);
#pragma unroll
        for (int j = 0; j < 9; ++j) a[j] += w * cond[j * 1024 + k];
      }
#pragma unroll
      for (int j = 0; j < 9; ++j) *(f32x4*)(red + (wave * 9 + j) * 256 + 4 * lane) = a[j];
      __syncthreads();
      float* mt = (float*)(ws + O_MODT) + (size_t)layer * 9 * 9216;
      for (int i = tid; i < 9 * 256; i += 512) {
        const int j = i >> 8, c = i & 255; float s = 0.f;
#pragma unroll
        for (int w = 0; w < 8; ++w) s += red[(w * 9 + j) * 256 + c];
        mt[(size_t)j * 9216 + ct * 256 + c] = s + IN(5)[layer * 9216 + ct * 256 + c];
      }
      __syncthreads();
    }
    __syncthreads();
  }
  {
    float* scr = (float*)lds_raw + wave * (64 * 33);
    const int gw = cx.bid * 8 + wave, NGW = cx.nb * 8;
    constexpr int I_FI = 16 * 176, I_FO = 44 * 32, I_UP = 16 * 128, I_DN = 32 * 32, I_AQ = 16 * 48, I_AO = 16 * 32, I_SI = 16 * 96, I_SO = 16 * 32;
    constexpr int NITEMS = 8 * I_FI + 8 * I_FO + 2 * I_UP + 2 * I_DN + I_AQ + I_AO + I_SI + I_SO;
    for (int it = gw; it < NITEMS; it += NGW) {
      int r = it;
      if (r < 8 * I_FI) { const int mi = r / I_FI; transpose_item<1>(IN(8) + (size_t)mi * 1024 * 5632, 1024, 5632, (bf16_t*)(ws + O_WFI) + (size_t)mi * 5632 * 1024, scr, r % I_FI, lane); continue; } r -= 8 * I_FI;
      if (r < 8 * I_FO) { const int mi = r / I_FO; transpose_item<0>(IN(9) + (size_t)mi * 2816 * 1024, 2816, 1024, (bf16_t*)(ws + O_WFO) + (size_t)mi * 1024 * 2816, scr, r % I_FO, lane); continue; } r -= 8 * I_FO;
      if (r < 2 * I_UP) { const int mi = r / I_UP; transpose_item<0>(IN(10) + (size_t)mi * 1024 * 4096, 1024, 4096, (bf16_t*)(ws + O_WUP) + (size_t)mi * 4096 * 1024, scr, r % I_UP, lane); continue; } r -= 2 * I_UP;
      if (r < 2 * I_DN) { const int mi = r / I_DN; transpose_item<0>(IN(18) + (size_t)mi * 2048 * 1024, 2048, 1024, (bf16_t*)(ws + O_WDN) + (size_t)mi * 1024 * 2048, scr, r % I_DN, lane); continue; } r -= 2 * I_DN;
      if (r < I_AQ) { transpose_item<0>(IN(19), 1024, 1536, (bf16_t*)(ws + O_WAQ), scr, r, lane); continue; } r -= I_AQ;
      if (r < I_AO) { transpose_item<0>(IN(21), 1024, 1024, (bf16_t*)(ws + O_WAO), scr, r, lane); continue; } r -= I_AO;
      if (r < I_SI) { transpose_item<0>(IN(22), 1024, 3072, (bf16_t*)(ws + O_WSI), scr, r, lane); continue; } r -= I_SI;
      transpose_item<0>(IN(24), 1024, 1024, (bf16_t*)(ws + O_WSO), scr, r, lane);
    }
  }
  {
    const int gt = cx.bid * 512 + tid, gs = cx.nb * 512;
    bf16_t* wg = (bf16_t*)(ws + O_WG);
    for (int i = gt; i < 2 * 16 * 6144; i += gs) {
      const int j = i / (16 * 6144), xg = (i / 6144) & 15, k = i % 6144, x = xg >> 3, g = xg & 7;
      const float* wif = IN(14) + (size_t)(j * 2 + x) * 6144 * 8;
      float v;
      const int knat = (k & ~31) + 16 * ((k >> 2) & 1) + 4 * ((k >> 3) & 3) + (k & 3);
      if (k < 2048) v = wif[(size_t)knat * 8 + g];
      else if (k < 4096) v = wif[(size_t)knat * 8 + g] * 22.627416997969522f;
      else {
        const int c = k - 4096, blk = c >> 2, cc = c & 3;
        const float* wv = IN(13) + ((size_t)(j * 3 + 2) * 512 + blk) * 16 + cc * 4;
        v = 0.f;
        for (int d2 = 0; d2 < 4; ++d2) v += wv[d2] * wif[(size_t)(4096 + 4 * blk + d2) * 8 + g];
      }
      wg[i] = (bf16_t)(pk2(v, 0.f) & 0xffff);
    }
    { float* lnt = (float*)(ws + O_LNT); for (int i = gt; i < 12 * D; i += gs) { const int l = i / D, c2 = i % D; lnt[(size_t)l * 2 * D + c2] = IN(6)[i] * ALPHA; lnt[(size_t)l * 2 * D + D + c2] = IN(7)[i] * ALPHA; } }
    float* rc = (float*)(ws + O_ROPE); float* rs = rc + 4096 * 32;
    for (int i = gt; i < 4096 * 32; i += gs) {
      const int pos = i >> 5, pp = i & 31, jf = pp & 15;
      const float fr_ = __builtin_amdgcn_exp2f(-(float)jf * (13.287712379549449f / 16.f));
      float rev = (float)(pp < 16 ? (pos >> 6) : (pos & 63)) * fr_ * 0.15915494309189535f;
      rev -= rintf(rev);
      rc[i] = __builtin_amdgcn_cosf(rev); rs[i] = __builtin_amdgcn_sinf(rev);
    }
  }
}

template <int MODE>
__device__ __forceinline__ void lnmod_phase(const Params& p, const Ctx& cx, int lnidx  , int layer, int slot) {
  const int lane = cx.tid & 63, gw = cx.bid * 8 + (cx.tid >> 6), NGW = cx.nb * 8;
  const int nrows = MODE == 2 ? NLAT : MROWS;
  const float* lg = IN(6) + (size_t)lnidx * D; const float* lb = IN(7) + (size_t)lnidx * D;
  const float* modl = (const float*)(cx.ws + O_MODT) + (size_t)layer * 9 * 9216;
  bf16_t* U = (bf16_t*)(cx.ws + O_U);
  for (int row = gw; row < nrows; row += NGW) {
    float* hp = hrow(cx, row);
    const float* src = MODE == 0 ? (row < NLAT ? IN(0) + (size_t)row * D : IN(2) + (size_t)(row - NLAT) * D) : hp;
    f32x4 v[4];
#pragma unroll
    for (int j = 0; j < 4; ++j) v[j] = *(const f32x4*)(src + 4 * lane + 256 * j);
    if (MODE != 0) {
      float s = 0.f;
#pragma unroll
      for (int j = 0; j < 4; ++j) s += (v[j][0] + v[j][1]) + (v[j][2] + v[j][3]);
      const float mean = wave_sum(s, lane) * (1.f / D); float s2 = 0.f;
#pragma unroll
      for (int j = 0; j < 4; ++j) { v[j] = v[j] - mean; s2 += (v[j][0] * v[j][0] + v[j][1] * v[j][1]) + (v[j][2] * v[j][2] + v[j][3] * v[j][3]); }
      const float rstd = __builtin_amdgcn_rsqf(wave_sum(s2, lane) * (1.f / D) + LN_EPS);
      if (MODE == 1 && lane == 0) *(float2*)((float*)(cx.ws + O_STATS) + (size_t)row * 2) = make_float2(mean, rstd);
#pragma unroll
      for (int j = 0; j < 4; ++j) v[j] = v[j] * rstd * *(const f32x4*)(lg + 4 * lane + 256 * j) + *(const f32x4*)(lb + 4 * lane + 256 * j);
    }
    if (MODE != 1) {
#pragma unroll
      for (int j = 0; j < 4; ++j) *(f32x4*)(hp + 4 * lane + 256 * j) = MODE == 0 ? v[j] * ALPHA : v[j];
    }
    if (MODE != 2) {
      const int midx = row < NLAT ? (row >> 12) : 8;
      const float* sh = modl + (size_t)midx * 9216 + (3 * slot) * D; const float* sc = sh + D;
#pragma unroll
      for (int j = 0; j < 4; ++j) {
        const f32x4 u = v[j] * (*(const f32x4*)(sc + 4 * lane + 256 * j) + 1.f) + *(const f32x4*)(sh + 4 * lane + 256 * j);
        u32x2 o; o.x = pk2(u[0], u[1]); o.y = pk2(u[2], u[3]);
        *(u32x2*)(U + (size_t)row * D + 4 * lane + 256 * j) = o;
      }
    }
  }
}

__device__ __forceinline__ int ml_lrow(int bl, int tok) { return tok < LC ? GB * SEQ + bl * LC + tok : bl * SEQ + (tok - LC); }
__device__ __forceinline__ int ml_nchunk(int x, int st) { return x == 0 ? st : (st < 4 ? 3 - st : 71 - st); }

__device__ __forceinline__ void ml_m0(const Params& p, const Ctx& cx, int j) {
  const int tid = cx.tid;
  char* ws = cx.ws;
  const bf16_t* XZ = (const bf16_t*)(ws + O_XZ);
  bf16_t* QK = (bf16_t*)(ws + O_QK); bf16_t* KT = (bf16_t*)(ws + O_KT); bf16_t* VT = (bf16_t*)(ws + O_VT); bf16_t* QF = (bf16_t*)(ws + O_QF);
  bf16_t* lk = (bf16_t*)lds_raw;
  bf16_t* lv = lk + 256 * 72;
  const int blk_l = tid & 63, tq = tid >> 6;
  for (int u = cx.bid; u < GB * NCH * 8; u += cx.nb) {
    const int slab = u & 7, ch = (u >> 3) % NCH, bl = u / (8 * NCH);
    const int f0 = slab * 256 + blk_l * 4, blk = f0 >> 2;
    float cw[3][4], cb[4], wq[16], wk[16], wv[16];
#pragma unroll
    for (int k = 0; k < 3; ++k)
#pragma unroll
      for (int c = 0; c < 4; ++c) cw[k][c] = IN(11)[(size_t)(j * 3 + k) * EI + f0 + c];
#pragma unroll
    for (int c = 0; c < 4; ++c) cb[c] = IN(12)[(size_t)j * EI + f0 + c];
#pragma unroll
    for (int i = 0; i < 16; ++i) {
      wq[i] = IN(13)[((size_t)(j * 3 + 0) * 512 + blk) * 16 + i];
      wk[i] = IN(13)[((size_t)(j * 3 + 1) * 512 + blk) * 16 + i] * 0.04419417382415922f;
      wv[i] = IN(13)[((size_t)(j * 3 + 2) * 512 + blk) * 16 + i];
    }
    const int tok0 = ch * 64, seg_lo = tok0 < LC ? 0 : LC, seg_hi = tok0 < LC ? LC : TOKB;
    for (int tt = 0; tt < 8; ++tt) {
      const int tl = tq + 8 * tt, tok = tok0 + tl;
      float xm[3][4];
#pragma unroll
      for (int k = 0; k < 3; ++k) {
        const int t2 = tok + k - 1;
        if (t2 >= seg_lo && t2 < seg_hi) {
          const u32x2 r = *(const u32x2*)(XZ + (size_t)ml_lrow(bl, t2) * 4096 + f0);
          xm[k][0] = bflo(r.x); xm[k][1] = bfhi(r.x); xm[k][2] = bflo(r.y); xm[k][3] = bfhi(r.y);
        } else { xm[k][0] = xm[k][1] = xm[k][2] = xm[k][3] = 0.f; }
      }
      float xc[4], q[4], kk[4], vv[4];
#pragma unroll
      for (int c = 0; c < 4; ++c) xc[c] = silu_f(cw[0][c] * xm[0][c] + cw[1][c] * xm[1][c] + cw[2][c] * xm[2][c] + cb[c]);
#pragma unroll
      for (int d2 = 0; d2 < 4; ++d2) {
        q[d2] = xc[0] * wq[d2] + xc[1] * wq[4 + d2] + xc[2] * wq[8 + d2] + xc[3] * wq[12 + d2];
        kk[d2] = xc[0] * wk[d2] + xc[1] * wk[4 + d2] + xc[2] * wk[8 + d2] + xc[3] * wk[12 + d2];
        vv[d2] = xm[1][0] * wv[d2] + xm[1][1] * wv[4 + d2] + xm[1][2] * wv[8 + d2] + xm[1][3] * wv[12 + d2];
      }
      const size_t lr = ml_lrow(bl, tok);
      u32x2 oq, ok, ov; oq.x = pk2(q[0], q[1]); oq.y = pk2(q[2], q[3]); ok.x = pk2(kk[0], kk[1]); ok.y = pk2(kk[2], kk[3]); ov.x = pk2(vv[0], vv[1]); ov.y = pk2(vv[2], vv[3]);
      const int fp = (f0 & ~31) + 8 * ((f0 >> 2) & 3) + 4 * ((f0 >> 4) & 1);
      *(u32x2*)(QK + lr * 4096 + fp) = oq;
      *(u32x2*)(QF + ((((((size_t)bl * NCH + ch) * 4 + (f0 >> 9)) * 8 + ((f0 >> 6) & 7)) * 4 + (tl >> 4)) * 2 + ((f0 >> 5) & 1)) * 512 + (tl & 15) * 32 + 8 * ((f0 >> 2) & 3) + 4 * ((f0 >> 4) & 1)) = oq;
      *(u32x2*)(QK + lr * 4096 + 2048 + fp) = ok;
      const int fl = blk_l * 4;
      lk[(fl + 0) * 72 + tl] = (bf16_t)(ok.x & 0xffff); lk[(fl + 1) * 72 + tl] = (bf16_t)(ok.x >> 16); lk[(fl + 2) * 72 + tl] = (bf16_t)(ok.y & 0xffff); lk[(fl + 3) * 72 + tl] = (bf16_t)(ok.y >> 16);
      lv[(fl + 0) * 72 + tl] = (bf16_t)(ov.x & 0xffff); lv[(fl + 1) * 72 + tl] = (bf16_t)(ov.x >> 16); lv[(fl + 2) * 72 + tl] = (bf16_t)(ov.y & 0xffff); lv[(fl + 3) * 72 + tl] = (bf16_t)(ov.y >> 16);
    }
    __syncthreads();
    {
      const int arr = tid >> 8, fr_ = tid & 255;
      const bf16_t* src = (arr ? lv : lk) + fr_ * 72;
      const int feat = slab * 256 + fr_;
      bf16_t* dst = (arr ? VT : KT) + (((size_t)bl * NCH + ch) * (EI / 16) + (feat >> 4)) * 1024 + (feat & 15) * 32;
#pragma unroll
      for (int i = 0; i < 8; ++i) *(u32x4*)(dst + (i >> 2) * 512 + (i & 3) * 8) = *(const u32x4*)(src + 8 * i);
    }
    __syncthreads();
  }
}

__device__ __forceinline__ void ml_gates(const Params& p, const Ctx& cx, int j) {
  const int tid = cx.tid, lane = tid & 63, wave = tid >> 6, fr = lane & 15, fq = lane >> 4;
  char* ws = cx.ws;
  const bf16_t* XZ = (const bf16_t*)(ws + O_XZ); const bf16_t* QK = (const bf16_t*)(ws + O_QK);
  const bf16_t* WG = (const bf16_t*)(ws + O_WG) + (size_t)j * 16 * 6144;
  float* BL = (float*)(ws + O_BL); float* IG = (float*)(ws + O_IG);
  float* GC = (float*)(ws + O_GC); float* AC = GC + NSEQ * NCH;
  float* part = (float*)lds_raw;
  float* gl = part + 8 * 64 * 16;
  for (int u = cx.bid; u < GB * NCH; u += cx.nb) {
    const int bl = u / NCH, nc = u % NCH, tok0 = nc * 64;
    f32x4 acc[4];
#pragma unroll
    for (int m = 0; m < 4; ++m) acc[m] = (f32x4){0.f, 0.f, 0.f, 0.f};
    size_t lr[4];
#pragma unroll
    for (int m = 0; m < 4; ++m) lr[m] = ml_lrow(bl, tok0 + m * 16 + fr);
#pragma unroll 4
    for (int ks = wave * 24; ks < wave * 24 + 24; ++ks) {
      const int k = ks * 32 + fq * 8;
      const bf16x8 bfr = *(const bf16x8*)(WG + (size_t)fr * 6144 + k);
#pragma unroll
      for (int m = 0; m < 4; ++m) {
        const bf16_t* ap = k < 4096 ? QK + lr[m] * 4096 + k : XZ + lr[m] * 4096 + (k - 4096);
        const bf16x8 afr = *(const bf16x8*)ap;
        acc[m] = MFMA16(afr, bfr, acc[m]);
      }
    }
#pragma unroll
    for (int m = 0; m < 4; ++m)
#pragma unroll
      for (int jj = 0; jj < 4; ++jj) part[(wave * 64 + m * 16 + 4 * fq + jj) * 16 + fr] = acc[m][jj];
    __syncthreads();
    for (int i = tid; i < 1024; i += 512) {
      float s = IN(15)[(size_t)j * 16 + (i & 15)];
#pragma unroll
      for (int w = 0; w < 8; ++w) s += part[w * 1024 + i];
      gl[(i >> 4) * 17 + (i & 15)] = s;
    }
    __syncthreads();
    {
      const int x = wave >> 2, h = wave & 3, seq = (bl * 2 + x) * 4 + h;
      const int tl = x == 0 ? lane : 63 - lane;
      const float ig = gl[tl * 17 + x * 8 + h], fg = gl[tl * 17 + x * 8 + 4 + h];
      float b = fg > 0.f ? -__logf(1.f + __expf(-fg)) : fg - __logf(1.f + __expf(fg));
#pragma unroll
      for (int o = 1; o < 64; o <<= 1) { const float t2 = shi(b, lane - o); if (lane >= o) b += t2; }
      BL[(size_t)seq * TOKB + tok0 + tl] = b; IG[(size_t)seq * TOKB + tok0 + tl] = ig;
      float mx = ig - b;
#pragma unroll
      for (int o = 1; o < 64; o <<= 1) mx = fmaxf(mx, shx(mx, o, lane));
      const float g = shi(b, 63);
      if (lane == 0) { GC[seq * NCH + nc] = g; AC[seq * NCH + nc] = g + mx; }
    }
    __syncthreads();
  }
}

__device__ __forceinline__ void ml_s(const Params& p, const Ctx& cx) {
  const int tid = cx.tid, lane = tid & 63, wave = tid >> 6, fr = lane & 15, fq = lane >> 4;
  char* ws = cx.ws;
  const bf16_t* QK = (const bf16_t*)(ws + O_QK);
  bf16_t* SP = (bf16_t*)(ws + O_SP);
  const float* BL = (const float*)(ws + O_BL); const float* IG = (const float*)(ws + O_IG);
  float* WIN = (float*)(ws + O_WIN); float* FLO = (float*)(ws + O_FLO); float* DEN = (float*)(ws + O_DEN); float* WSS = (float*)(ws + O_WSS);
  const float* GC = (const float*)(ws + O_GC); const float* AC = GC + NSEQ * NCH; float* DEC = (float*)(ws + O_GC) + 2 * NSEQ * NCH;
  float* sb_ = (float*)lds_raw + wave * 256; float* si_ = sb_ + 64; float* smt = si_ + 64;
  const int gw = cx.bid * 8 + wave, NGW = cx.nb * 8;
  for (int u = gw; u < NSEQ * NCH; u += NGW) {
    const int seq = u / NCH, st = u % NCH, x = (seq >> 2) & 1, h = seq & 3, bl = seq >> 3;
    const int nc = ml_nchunk(x, st), tok0 = nc * 64;
    const int nl0 = ml_nchunk(x, lane), nl1 = ml_nchunk(x, 64 + (lane & 3));
    const float g0 = GC[seq * NCH + nl0], a0 = AC[seq * NCH + nl0], g1 = GC[seq * NCH + nl1], a1 = AC[seq * NCH + nl1];
    const int tl = x == 0 ? lane : 63 - lane;
    const float b = BL[(size_t)seq * TOKB + tok0 + tl], ig = IG[(size_t)seq * TOKB + tok0 + tl];
    float mc = 0.f;
    for (int s2 = 0; s2 < st; ++s2) {
      const float gg = __int_as_float(__builtin_amdgcn_readlane(__float_as_int(s2 < 64 ? g0 : g1), s2 & 63));
      const float aa = __int_as_float(__builtin_amdgcn_readlane(__float_as_int(s2 < 64 ? a0 : a1), s2 & 63));
      mc = fmaxf(gg + mc, aa);
    }
    const float gc = __int_as_float(__builtin_amdgcn_readlane(__float_as_int(st < 64 ? g0 : g1), st & 63));
    const float ac = __int_as_float(__builtin_amdgcn_readlane(__float_as_int(st < 64 ? a0 : a1), st & 63));
    const float mnew = fmaxf(gc + mc, ac);
    float cm = ig - b;
#pragma unroll
    for (int o = 1; o < 64; o <<= 1) { const float t2 = shi(cm, lane - o); if (lane >= o) cm = fmaxf(cm, t2); }
    const float mt = b + fmaxf(mc, cm);
    sb_[tl] = b; si_[tl] = ig; smt[tl] = mt;
    WIN[(size_t)seq * TOKB + tok0 + tl] = __expf(b + mc - mt);
    FLO[(size_t)seq * TOKB + tok0 + tl] = __expf(-mt);
    WSS[(size_t)seq * TOKB + tok0 + tl] = __expf(gc - b + ig - mnew);
    if (lane == 0) DEC[seq * NCH + nc] = __expf(gc + mc - mnew);
    f32x4 acc[4][4];
#pragma unroll
    for (int a = 0; a < 4; ++a)
#pragma unroll
      for (int c2 = 0; c2 < 4; ++c2) acc[a][c2] = (f32x4){0.f, 0.f, 0.f, 0.f};
    const bf16_t* rowp[4];
#pragma unroll
    for (int a = 0; a < 4; ++a) rowp[a] = QK + (size_t)ml_lrow(bl, tok0 + a * 16 + fr) * 4096 + h * DH + fq * 8;
#pragma unroll 2
    for (int ks = 0; ks < 16; ++ks) {
      bf16x8 kf[4], qf[4];
#pragma unroll
      for (int a = 0; a < 4; ++a) { kf[a] = *(const bf16x8*)(rowp[a] + 2048 + ks * 32); qf[a] = *(const bf16x8*)(rowp[a] + ks * 32); }
#pragma unroll
      for (int a = 0; a < 4; ++a)
#pragma unroll
        for (int c2 = 0; c2 < 4; ++c2) acc[a][c2] = MFMA16(kf[a], qf[c2], acc[a][c2]);
    }
    __builtin_amdgcn_wave_barrier(); asm volatile("s_waitcnt lgkmcnt(0)" ::: "memory");
    bf16_t* spu = SP + (size_t)(seq * NCH + nc) * 4096;
#pragma unroll
    for (int tb = 0; tb < 4; ++tb) {
      const int t = tb * 16 + fr;
      const float bt = sb_[t], mtt = smt[t];
      float dsum = 0.f;
#pragma unroll
      for (int sbk = 0; sbk < 4; ++sbk) {
        float vals[4];
#pragma unroll
        for (int jj = 0; jj < 4; ++jj) {
          const int s = sbk * 16 + 4 * fq + jj;
          const bool ok = x == 0 ? (s <= t) : (s >= t);
          vals[jj] = ok ? acc[sbk][tb][jj] * __expf(bt - sb_[s] + si_[s] - mtt) : 0.f;
        }
        u32x2 o; o.x = pk2(vals[0], vals[1]); o.y = pk2(vals[2], vals[3]);
        *(u32x2*)(spu + tb * 1024 + ((sbk * 16 + 4 * fq) >> 5) * 512 + fr * 32 + ((sbk * 16 + 4 * fq) & 31)) = o;
        dsum += (bflo(o.x) + bfhi(o.x)) + (bflo(o.y) + bfhi(o.y));
      }
      dsum += shx(dsum, 16, lane); dsum += shx(dsum, 32, lane);
      if (fq == 0) DEN[(size_t)seq * TOKB + tok0 + t] = dsum;
    }
    __builtin_amdgcn_wave_barrier(); asm volatile("s_waitcnt lgkmcnt(0)" ::: "memory");
  }
}

constexpr int NEB = 2, NSL = 512 / (16 * NEB);
__device__ __forceinline__ void ml_m2(const Params& p, const Ctx& cx) {
  const int tid = cx.tid, lane = tid & 63, wave = tid >> 6, fr = lane & 15, fq = lane >> 4;
  char* ws = cx.ws;
  const bf16_t* QK = (const bf16_t*)(ws + O_QK); const bf16_t* KT = (const bf16_t*)(ws + O_KT); const bf16_t* VT = (const bf16_t*)(ws + O_VT);
  const bf16_t* SP = (const bf16_t*)(ws + O_SP); const bf16_t* QF = (const bf16_t*)(ws + O_QF);
  bf16_t* HD = (bf16_t*)(ws + O_HD);
  const float* WIN = (const float*)(ws + O_WIN); const float* FLO = (const float*)(ws + O_FLO); const float* DEN = (const float*)(ws + O_DEN); const float* WSS = (const float*)(ws + O_WSS);
  const float* DEC = (const float*)(ws + O_GC) + 2 * NSEQ * NCH;
  f32x4* red = (f32x4*)lds_raw;
  f32x4* rn = (f32x4*)(lds_raw + 131072);
  for (int idx = cx.bid >> 3; idx < 2 * NSL; idx += cx.nb >> 3) {
    const int seq = (cx.bid & 7) * 2 + idx / NSL, es = idx % NSL, x = (seq >> 2) & 1, h = seq & 3, bl = seq >> 3;
    const int d0 = wave * 64, e0 = es * 16 * NEB;
    f32x4 C[4][NEB + 1];
#pragma unroll
    for (int a = 0; a < 4; ++a)
#pragma unroll
      for (int b = 0; b < NEB + 1; ++b) C[a][b] = (f32x4){0.f, 0.f, 0.f, 0.f};
    const int tbo = wave >> 1, ebo = __builtin_amdgcn_readfirstlane(wave & 1);
    bf16x8 qc[4][2], kf[4][2], sf0, sf1;
    u32x4 vr[NEB][2];
    f32x4 wv[2][2];
#define M2_LOAD_Q(ST) do { const int _nq = ml_nchunk(x, (ST)); _Pragma("unroll") for (int tb = 0; tb < 4; ++tb) { \
        const bf16_t* qp = QF + ((((((size_t)bl * NCH + _nq) * 4 + h) * 8 + wave) * 4 + tb) * 2) * 512 + fr * 32 + 8 * fq; \
        qc[tb][0] = *(const bf16x8*)qp; qc[tb][1] = *(const bf16x8*)(qp + 512); } } while (0)
#define M2_LOAD_KV(ST) do { const int _nc = ml_nchunk(x, (ST)), _t0 = _nc * 64; \
        _Pragma("unroll") for (int db = 0; db < 4; ++db) { const bf16_t* kp = KT + (((size_t)bl * NCH + _nc) * (EI / 16) + ((h * DH + d0) >> 4) + db) * 1024 + fr * 32 + 8 * fq; \
          kf[db][0] = *(const bf16x8*)kp; kf[db][1] = *(const bf16x8*)(kp + 512); } \
        _Pragma("unroll") for (int eb = 0; eb < NEB; ++eb) { const bf16_t* vp = VT + (((size_t)bl * NCH + _nc) * (EI / 16) + ((h * DH + e0) >> 4) + eb) * 1024 + fr * 32 + 8 * fq; \
          vr[eb][0] = *(const u32x4*)vp; vr[eb][1] = *(const u32x4*)(vp + 512); } \
        _Pragma("unroll") for (int ks = 0; ks < 2; ++ks) { const float* wp = WSS + (size_t)seq * TOKB + _t0 + 32 * ks + 8 * fq; \
          wv[ks][0] = *(const f32x4*)wp; wv[ks][1] = *(const f32x4*)(wp + 4); } \
        const bf16_t* sp = SP + (size_t)(seq * NCH + _nc) * 4096 + tbo * 1024 + fr * 32 + 8 * fq; \
        sf0 = *(const bf16x8*)sp; sf1 = *(const bf16x8*)(sp + 512); } while (0)
    M2_LOAD_Q(0); M2_LOAD_KV(0);
    for (int st = 0; st < NCH; ++st) {
      const int nc = ml_nchunk(x, st), tok0 = nc * 64, stn = st + 1 < NCH ? st + 1 : st;
      const size_t tix = (size_t)seq * TOKB + tok0 + tbo * 16 + 4 * fq;
      const f32x4 win = *(const f32x4*)(WIN + tix), flo = *(const f32x4*)(FLO + tix), deni = *(const f32x4*)(DEN + tix);
      const float decay = DEC[seq * NCH + nc];
#pragma unroll
      for (int eb = 0; eb < NEB + 1; ++eb) {
        bf16x8 cb0, cb1;
        { const f32x4 lo = C[0][eb], hi = C[1][eb]; cb0 = mk8((u32x4){pk2(lo[0], lo[1]), pk2(lo[2], lo[3]), pk2(hi[0], hi[1]), pk2(hi[2], hi[3])}); }
        { const f32x4 lo = C[2][eb], hi = C[3][eb]; cb1 = mk8((u32x4){pk2(lo[0], lo[1]), pk2(lo[2], lo[3]), pk2(hi[0], hi[1]), pk2(hi[2], hi[3])}); }
        f32x4 pa[4];
#pragma unroll
        for (int tb = 0; tb < 4; ++tb) pa[tb] = MFMA16(qc[tb][0], cb0, ((f32x4){0.f, 0.f, 0.f, 0.f}));
#pragma unroll
        for (int tb = 0; tb < 4; ++tb) pa[tb] = MFMA16(qc[tb][1], cb1, pa[tb]);
#pragma unroll
        for (int tb = 0; tb < 4; ++tb) {
          if (eb < NEB) red[((wave * 4 + tb) * NEB + eb) * 64 + lane] = pa[tb];
          else if (fr == 0) rn[(wave * 4 + tb) * 4 + fq] = pa[tb];
        }
      }
      M2_LOAD_Q(stn);
      f32x4 oi = {0.f, 0.f, 0.f, 0.f};
#pragma unroll
      for (int eb = 0; eb < NEB + 1; ++eb) {
        bf16x8 vw0, vw1;
        if (eb < NEB) {
          const u32x4 r0 = vr[eb][0], r1 = vr[eb][1];
          if (eb == ebo) { oi = MFMA16(sf0, mk8(r0), oi); oi = MFMA16(sf1, mk8(r1), oi); }
          vw0 = mk8((u32x4){pk2(bflo(r0.x) * wv[0][0][0], bfhi(r0.x) * wv[0][0][1]), pk2(bflo(r0.y) * wv[0][0][2], bfhi(r0.y) * wv[0][0][3]),
                            pk2(bflo(r0.z) * wv[0][1][0], bfhi(r0.z) * wv[0][1][1]), pk2(bflo(r0.w) * wv[0][1][2], bfhi(r0.w) * wv[0][1][3])});
          vw1 = mk8((u32x4){pk2(bflo(r1.x) * wv[1][0][0], bfhi(r1.x) * wv[1][0][1]), pk2(bflo(r1.y) * wv[1][0][2], bfhi(r1.y) * wv[1][0][3]),
                            pk2(bflo(r1.z) * wv[1][1][0], bfhi(r1.z) * wv[1][1][1]), pk2(bflo(r1.w) * wv[1][1][2], bfhi(r1.w) * wv[1][1][3])});
        } else {
          vw0 = mk8((u32x4){pk2(wv[0][0][0], wv[0][0][1]), pk2(wv[0][0][2], wv[0][0][3]), pk2(wv[0][1][0], wv[0][1][1]), pk2(wv[0][1][2], wv[0][1][3])});
          vw1 = mk8((u32x4){pk2(wv[1][0][0], wv[1][0][1]), pk2(wv[1][0][2], wv[1][0][3]), pk2(wv[1][1][0], wv[1][1][1]), pk2(wv[1][1][2], wv[1][1][3])});
        }
#pragma unroll
        for (int db = 0; db < 4; ++db) {
          f32x4 c = C[db][eb] * decay;
          c = MFMA16(kf[db][0], vw0, c); c = MFMA16(kf[db][1], vw1, c);
          C[db][eb] = c;
        }
      }
      asm volatile("s_waitcnt lgkmcnt(0)" ::: "memory");
      __builtin_amdgcn_s_barrier();
      asm volatile("" ::: "memory");
      f32x4 rdn[8], rd0[8];
#pragma unroll
      for (int w = 0; w < 8; ++w) { rdn[w] = rn[(w * 4 + tbo) * 4 + fq]; rd0[w] = red[((w * 4 + tbo) * NEB + ebo) * 64 + lane]; }
      const f32x4 pn = ((rdn[0] + rdn[1]) + (rdn[2] + rdn[3])) + ((rdn[4] + rdn[5]) + (rdn[6] + rdn[7]));
      const f32x4 pi = ((rd0[0] + rd0[1]) + (rd0[2] + rd0[3])) + ((rd0[4] + rd0[5]) + (rd0[6] + rd0[7]));
#pragma unroll
      for (int jj = 0; jj < 4; ++jj) {
        const float num = oi[jj] + win[jj] * pi[jj], den = deni[jj] + win[jj] * pn[jj];
        const float hv = num * __builtin_amdgcn_rcpf(fmaxf(fabsf(den), flo[jj]));
        HD[((size_t)x * RG + ml_lrow(bl, tok0 + tbo * 16 + 4 * fq + jj)) * EI + h * DH + e0 + ebo * 16 + fr] = (bf16_t)(pk2(hv, 0.f) & 0xffff);
      }
      M2_LOAD_KV(stn);
      asm volatile("s_waitcnt lgkmcnt(0)" ::: "memory");
      __builtin_amdgcn_s_barrier();
      asm volatile("" ::: "memory");
    }
    __syncthreads();
#undef M2_LOAD_Q
#undef M2_LOAD_KV
  }
}

__device__ __forceinline__ void ml_fin(const Params& p, const Ctx& cx, int j) {
  const int lane = cx.tid & 63, gw = cx.bid * 8 + (cx.tid >> 6), NGW = cx.nb * 8;
  char* ws = cx.ws;
  const bf16_t* XZ = (const bf16_t*)(ws + O_XZ); const bf16_t* HD = (const bf16_t*)(ws + O_HD);
  bf16_t* FIN = (bf16_t*)(ws + O_FIN);
  for (int u = gw; u < RG * 4; u += NGW) {
    const int lr = u >> 2, h = u & 3, f0 = h * DH + lane * 8;
    int pos, seglen;
    if (lr < GB * SEQ) { pos = lr & (SEQ - 1); seglen = SEQ; } else { pos = (lr - GB * SEQ) & (LC - 1); seglen = LC; }
    const u32x4 hf = *(const u32x4*)(HD + (size_t)lr * EI + f0), hb = *(const u32x4*)(HD + ((size_t)RG + lr) * EI + f0);
    const u32x4 zz = *(const u32x4*)(XZ + (size_t)lr * 4096 + 2048 + f0);
    const u32x4 x1 = *(const u32x4*)(XZ + (size_t)lr * 4096 + f0);
    u32x4 x0 = {0u, 0u, 0u, 0u}, x2 = {0u, 0u, 0u, 0u};
    if (pos > 0) x0 = *(const u32x4*)(XZ + (size_t)(lr - 1) * 4096 + f0);
    if (pos < seglen - 1) x2 = *(const u32x4*)(XZ + (size_t)(lr + 1) * 4096 + f0);
    float hv[8], xm0[8], xm1[8], xm2[8];
    const unsigned hfu[4] = {hf.x, hf.y, hf.z, hf.w}, hbu[4] = {hb.x, hb.y, hb.z, hb.w}, zu[4] = {zz.x, zz.y, zz.z, zz.w};
    const unsigned x0u[4] = {x0.x, x0.y, x0.z, x0.w}, x1u[4] = {x1.x, x1.y, x1.z, x1.w}, x2u[4] = {x2.x, x2.y, x2.z, x2.w};
    float s = 0.f;
#pragma unroll
    for (int i = 0; i < 4; ++i) {
      hv[2 * i] = (bflo(hfu[i]) + bflo(hbu[i])) * sigm_f(bflo(zu[i]));
      hv[2 * i + 1] = (bfhi(hfu[i]) + bfhi(hbu[i])) * sigm_f(bfhi(zu[i]));
      xm0[2 * i] = bflo(x0u[i]); xm0[2 * i + 1] = bfhi(x0u[i]); xm1[2 * i] = bflo(x1u[i]); xm1[2 * i + 1] = bfhi(x1u[i]); xm2[2 * i] = bflo(x2u[i]); xm2[2 * i + 1] = bfhi(x2u[i]);
      s += hv[2 * i] + hv[2 * i + 1];
    }
    const float mean = wave_sum(s, lane) * (1.f / DH); float s2 = 0.f;
#pragma unroll
    for (int i = 0; i < 8; ++i) { hv[i] -= mean; s2 += hv[i] * hv[i]; }
    const float rstd = __builtin_amdgcn_rsqf(wave_sum(s2, lane) * (1.f / DH) + LN_EPS);
    float o[8];
#pragma unroll
    for (int i = 0; i < 8; ++i) {
      const int f = f0 + i;
      const float xc = silu_f(IN(11)[(size_t)(j * 3 + 0) * EI + f] * xm0[i] + IN(11)[(size_t)(j * 3 + 1) * EI + f] * xm1[i] + IN(11)[(size_t)(j * 3 + 2) * EI + f] * xm2[i] + IN(12)[(size_t)j * EI + f]);
      o[i] = hv[i] * rstd * IN(17)[(size_t)j * EI + f] + IN(16)[(size_t)j * EI + f] * xc;
    }
    u32x4 ov; ov.x = pk2(o[0], o[1]); ov.y = pk2(o[2], o[3]); ov.z = pk2(o[4], o[5]); ov.w = pk2(o[6], o[7]);
    *(u32x4*)(FIN + (size_t)lr * EI + f0) = ov;
  }
}

__device__ __forceinline__ void at_prep(const Params& p, const Ctx& cx) {
  const int lane = cx.tid & 63, gw = cx.bid * 8 + (cx.tid >> 6), NGW = cx.nb * 8;
  char* ws = cx.ws;
  bf16_t* ACT = (bf16_t*)(ws + O_ACT); bf16_t* KR = (bf16_t*)(ws + O_AKR); bf16_t* VT = (bf16_t*)(ws + O_AVT);
  const float* rc = (const float*)(ws + O_ROPE); const float* rs = rc + 4096 * 32;
  for (int row = gw; row < MROWS; row += NGW) {
    const bool lat = row < NLAT;
    const int b = lat ? row >> 12 : (row - NLAT) >> 8, pos = lat ? row & 4095 : (row - NLAT) & 255, tok = lat ? LC + pos : pos;
    bf16_t* rp = ACT + (size_t)row * 1536;
    {
      const u32x4 a = *(const u32x4*)(rp + 16 * lane), b2 = *(const u32x4*)(rp + 16 * lane + 8);
      const unsigned w[8] = {a.x, a.y, a.z, a.w, b2.x, b2.y, b2.z, b2.w};
      unsigned o[8];
      const int pp0 = (lane & 3) * 8;
#pragma unroll
      for (int i = 0; i < 8; ++i) {
        float x1 = bflo(w[i]) * 0.125f, x2 = bfhi(w[i]) * 0.125f;
        if (lat) { const float c = rc[pos * 32 + pp0 + i], s = rs[pos * 32 + pp0 + i]; const float y1 = x1 * c - x2 * s, y2 = x1 * s + x2 * c; x1 = y1; x2 = y2; }
        o[i] = pk2(x1, x2);
      }
      *(u32x4*)(rp + 16 * lane) = (u32x4){o[0], o[1], o[2], o[3]}; *(u32x4*)(rp + 16 * lane + 8) = (u32x4){o[4], o[5], o[6], o[7]};
    }
    {
      const u32x2 a = *(const u32x2*)(rp + 1024 + 4 * lane);
      const unsigned w[2] = {a.x, a.y}; unsigned o[2];
      const int g = lane >> 4, dd = (lane & 15) * 4, pp0 = dd >> 1;
#pragma unroll
      for (int i = 0; i < 2; ++i) {
        float x1 = bflo(w[i]), x2 = bfhi(w[i]);
        if (lat) { const float c = rc[pos * 32 + pp0 + i], s = rs[pos * 32 + pp0 + i]; const float y1 = x1 * c - x2 * s, y2 = x1 * s + x2 * c; x1 = y1; x2 = y2; }
        o[i] = pk2(x1, x2);
      }
      *(u32x2*)(KR + (((size_t)b * 4 + g) * TOKB + tok) * 64 + dd) = (u32x2){o[0], o[1]};
      const u32x2 v = *(const u32x2*)(rp + 1280 + 4 * lane);
      bf16_t* vp = VT + (((size_t)b * 4 + g) * 64 + dd) * TOKB + tok;
      vp[0] = (bf16_t)(v.x & 0xffff); vp[TOKB] = (bf16_t)(v.x >> 16); vp[2 * TOKB] = (bf16_t)(v.y & 0xffff); vp[3 * TOKB] = (bf16_t)(v.y >> 16);
    }
  }
}

__device__ __forceinline__ void at_core(const Params& p, const Ctx& cx) {
  const int lane = cx.tid & 63, gw = cx.bid * 8 + (cx.tid >> 6), NGW = cx.nb * 8, fr = lane & 15, fq = lane >> 4;
  char* ws = cx.ws;
  const bf16_t* ACT = (const bf16_t*)(ws + O_ACT); const bf16_t* KR = (const bf16_t*)(ws + O_AKR); const bf16_t* VT = (const bf16_t*)(ws + O_AVT);
  bf16_t* O = (bf16_t*)(ws + O_U);
  for (int u = gw; u < (MROWS / 16) * 4; u += NGW) {
    const int g = u & 3, qb = u >> 2, row0 = qb * 16;
    const bool lat = row0 < NLAT;
    const int b = lat ? row0 >> 12 : (row0 - NLAT) >> 8, q0 = lat ? row0 & 4095 : 0;
    bf16x8 qf[4][2];
    float mrun[4], lrun[4], sink[4];
    f32x4 oacc[4][4];
#pragma unroll
    for (int hh = 0; hh < 4; ++hh) {
      const bf16_t* qp = ACT + (size_t)(row0 + fr) * 1536 + (g * 4 + hh) * 64 + 8 * fq;
      qf[hh][0] = *(const bf16x8*)qp; qf[hh][1] = *(const bf16x8*)(qp + 32);
      sink[hh] = IN(20)[g * 4 + hh]; mrun[hh] = sink[hh]; lrun[hh] = 0.f;
#pragma unroll
      for (int d2 = 0; d2 < 4; ++d2) oacc[hh][d2] = (f32x4){0.f, 0.f, 0.f, 0.f};
    }
    const bf16_t* kbase = KR + ((size_t)b * 4 + g) * TOKB * 64;
    const bf16_t* vbase = VT + ((size_t)b * 4 + g) * 64 * TOKB;
    int wlo = 0, whi = -1;
    if (lat) { wlo = max(0, q0 - 128) & ~31; whi = min(SEQ - 1, q0 + 143); }
    const int nwin = lat ? (whi - wlo) / 32 + 1 : 0;
    for (int ti = 0; ti < 8 + nwin; ++ti) {
      const bool isw = ti >= 8;
      const int kpos0 = isw ? wlo + (ti - 8) * 32 : 0;
      const int tk0 = isw ? LC + kpos0 : ti * 32;
      const bf16_t* kp = kbase + (size_t)(tk0 + fr) * 64 + 8 * fq;
      const bf16x8 k00 = *(const bf16x8*)kp, k01 = *(const bf16x8*)(kp + 32), k10 = *(const bf16x8*)(kp + 16 * 64), k11 = *(const bf16x8*)(kp + 16 * 64 + 32);
      bf16x8 vfr[4];
#pragma unroll
      for (int d2 = 0; d2 < 4; ++d2) {
        const bf16_t* vp = vbase + (size_t)(d2 * 16 + fr) * TOKB + tk0 + 4 * fq;
        vfr[d2] = mk8(*(const u32x2*)vp, *(const u32x2*)(vp + 16));
      }
      bool okm[8];
#pragma unroll
      for (int i = 0; i < 8; ++i) {
        const int kpos = kpos0 + (i >> 2) * 16 + 4 * fq + (i & 3), dlt = (q0 + fr) - kpos;
        okm[i] = !isw || (dlt <= 128 && dlt >= -128);
      }
#pragma unroll
      for (int hh = 0; hh < 4; ++hh) {
        f32x4 s0 = {0.f, 0.f, 0.f, 0.f}, s1 = {0.f, 0.f, 0.f, 0.f};
        s0 = MFMA16(k00, qf[hh][0], s0); s0 = MFMA16(k01, qf[hh][1], s0);
        s1 = MFMA16(k10, qf[hh][0], s1); s1 = MFMA16(k11, qf[hh][1], s1);
        float sv[8]; float tmax = -3.0e38f;
#pragma unroll
        for (int i = 0; i < 8; ++i) { sv[i] = okm[i] ? (i < 4 ? s0[i] : s1[i - 4]) : -3.0e38f; tmax = fmaxf(tmax, sv[i]); }
        tmax = fmaxf(tmax, shx(tmax, 16, lane)); tmax = fmaxf(tmax, shx(tmax, 32, lane));
        const float mnew = fmaxf(mrun[hh], tmax), scale = __expf(mrun[hh] - mnew);
        mrun[hh] = mnew;
        float pv[8];
#pragma unroll
        for (int i = 0; i < 8; ++i) pv[i] = okm[i] ? __expf(sv[i] - mnew) : 0.f;
        const u32x4 pu = {pk2(pv[0], pv[1]), pk2(pv[2], pv[3]), pk2(pv[4], pv[5]), pk2(pv[6], pv[7])};
        const float ps = ((bflo(pu.x) + bfhi(pu.x)) + (bflo(pu.y) + bfhi(pu.y))) + ((bflo(pu.z) + bfhi(pu.z)) + (bflo(pu.w) + bfhi(pu.w)));
        lrun[hh] = lrun[hh] * scale + ps;
        const bf16x8 pf = mk8(pu);
        float scq[4];
#pragma unroll
        for (int jj = 0; jj < 4; ++jj) scq[jj] = shi(scale, 4 * fq + jj);
#pragma unroll
        for (int d2 = 0; d2 < 4; ++d2) {
          f32x4 o = oacc[hh][d2];
          o[0] *= scq[0]; o[1] *= scq[1]; o[2] *= scq[2]; o[3] *= scq[3];
          oacc[hh][d2] = MFMA16(pf, vfr[d2], o);
        }
      }
    }
#pragma unroll
    for (int hh = 0; hh < 4; ++hh) {
      float l = lrun[hh];
      l += shx(l, 16, lane); l += shx(l, 32, lane);
      l += __expf(sink[hh] - mrun[hh]);
      const float inv = __builtin_amdgcn_rcpf(l);
      float iq[4];
#pragma unroll
      for (int jj = 0; jj < 4; ++jj) iq[jj] = shi(inv, 4 * fq + jj);
#pragma unroll
      for (int d2 = 0; d2 < 4; ++d2)
#pragma unroll
        for (int jj = 0; jj < 4; ++jj)
          O[(size_t)(row0 + 4 * fq + jj) * D + (g * 4 + hh) * 64 + d2 * 16 + fr] = (bf16_t)(pk2(oacc[hh][d2][jj] * iq[jj], 0.f) & 0xffff);
    }
  }
}

__device__ __forceinline__ void sc_conv(const Params& p, const Ctx& cx) {
  const int gt = cx.bid * 512 + cx.tid, gs = cx.nb * 512;
  const bf16_t* ACT = (const bf16_t*)(cx.ws + O_ACT); bf16_t* O = (bf16_t*)(cx.ws + O_U);
  const float* cw = IN(23);
  for (int i = gt; i < MROWS * 128; i += gs) {
    const int row = i >> 7, c0 = (i & 127) * 8;
    int pos, seglen;
    if (row < NLAT) { pos = row & (SEQ - 1); seglen = SEQ; } else { pos = (row - NLAT) & (LC - 1); seglen = LC; }
    float accv[8];
#pragma unroll
    for (int e = 0; e < 8; ++e) accv[e] = 0.f;
#pragma unroll
    for (int k = 0; k < 3; ++k) {
      const int pp = pos + k - 1;
      if (pp < 0 || pp >= seglen) continue;
      const bf16_t* rp = ACT + (size_t)(row + k - 1) * 3072;
      const u32x4 cgv = *(const u32x4*)(rp + 1024 + c0), xtv = *(const u32x4*)(rp + 2048 + c0);
      const unsigned cu[4] = {cgv.x, cgv.y, cgv.z, cgv.w}, xu[4] = {xtv.x, xtv.y, xtv.z, xtv.w};
#pragma unroll
      for (int e = 0; e < 4; ++e) {
        accv[2 * e] += cw[k * D + c0 + 2 * e] * (bflo(cu[e]) * bflo(xu[e]));
        accv[2 * e + 1] += cw[k * D + c0 + 2 * e + 1] * (bfhi(cu[e]) * bfhi(xu[e]));
      }
    }
    const u32x4 bgv = *(const u32x4*)(ACT + (size_t)row * 3072 + c0);
    const unsigned bu[4] = {bgv.x, bgv.y, bgv.z, bgv.w};
    u32x4 o;
    o.x = pk2(bflo(bu[0]) * accv[0], bfhi(bu[0]) * accv[1]); o.y = pk2(bflo(bu[1]) * accv[2], bfhi(bu[1]) * accv[3]);
    o.z = pk2(bflo(bu[2]) * accv[4], bfhi(bu[2]) * accv[5]); o.w = pk2(bflo(bu[3]) * accv[6], bfhi(bu[3]) * accv[7]);
    *(u32x4*)(O + (size_t)row * D + c0) = o;
  }
}

#define XB_TMO      128
#define XB_XCNT(j)  (256  + 64 * (j))
#define XB_XSUB(j)  (1280 + 64 * (j))
#define XB_XGEN(j)  (2304 + 64 * (j))
#define XB_TOP      3328
#define XB_TOPGEN   3392
#define XCD_BAR_WORDS 3456
#define XB_SPIN_CAP (1u << 18)
__device__ __forceinline__ unsigned xb_ld(unsigned* p)              { return __hip_atomic_load(p, __ATOMIC_RELAXED, __HIP_MEMORY_SCOPE_AGENT); }
__device__ __forceinline__ unsigned xb_add(unsigned* p, unsigned v) { return __hip_atomic_fetch_add(p, v, __ATOMIC_RELAXED, __HIP_MEMORY_SCOPE_AGENT); }
__device__ __forceinline__ unsigned xb_xcc_id() { return (unsigned)__builtin_amdgcn_s_getreg((3 << 11) | 20) & 0xFu; }
#define XB_SPIN(cond, bar) do { unsigned _sp = 0; while (cond) { __builtin_amdgcn_s_sleep(1); \
    if ((++_sp & 255u) == 0u) { if (xb_ld(&(bar)[XB_TMO])) break; if (_sp > XB_SPIN_CAP) { atomicAdd(&(bar)[XB_TMO], 1u); break; } } } } while (0)
__device__ __forceinline__ void xcd_barrier_complete(unsigned* bar, unsigned x, unsigned& nloc, unsigned& nx) {
  const unsigned G = gridDim.x;
  unsigned sum, cnt, mine, sp = 0u;
  for (;;) {
    sum = 0u; cnt = 0u; mine = 0u;
#pragma unroll
    for (unsigned j = 0; j < 16; ++j) { const unsigned c = xb_ld(&bar[XB_XCNT(j)]); sum += c; cnt += (c > 0u) ? 1u : 0u; mine = (j == x) ? c : mine; }
    if (sum == G) break;
    __builtin_amdgcn_s_sleep(1);
    if ((++sp & 255u) == 0u) { if (xb_ld(&bar[XB_TMO])) break; if (sp > XB_SPIN_CAP) { atomicAdd(&bar[XB_TMO], 1u); break; } }
  }
  nloc = mine > 0u ? mine : 1u; nx = cnt > 0u ? cnt : 1u;
}
__device__ __forceinline__ void xcd_barrier(unsigned* bar, unsigned x, volatile LAS unsigned* st) {
  asm volatile("s_waitcnt vmcnt(0)" ::: "memory");
  __syncthreads();
  if (threadIdx.x == 0) {
    __builtin_amdgcn_s_waitcnt(0);
    unsigned nloc = st[0], nx = st[1];
    if (nloc == 0u) { xcd_barrier_complete(bar, x, nloc, nx); st[0] = nloc; st[1] = nx; }
    const unsigned old = xb_add(&bar[XB_XSUB(x)], 1u);
    const unsigned gen = old / nloc;
    if (old + 1u == (gen + 1u) * nloc) {
      __builtin_amdgcn_fence(__ATOMIC_RELEASE, "agent");
      asm volatile("s_waitcnt vmcnt(0)" ::: "memory");
      const unsigned og = xb_add(&bar[XB_TOP], 1u);
      const unsigned tg = og / nx;
      if (og + 1u == (tg + 1u) * nx) xb_add(&bar[XB_TOPGEN], 1u);
      else XB_SPIN(xb_ld(&bar[XB_TOPGEN]) == tg, bar);
      __builtin_amdgcn_fence(__ATOMIC_ACQUIRE, "agent");
      xb_add(&bar[XB_XGEN(x)], 1u);
      asm volatile("s_waitcnt vmcnt(0)" ::: "memory");
    } else {
      XB_SPIN(xb_ld(&bar[XB_XGEN(x)]) == gen, bar);
      __builtin_amdgcn_fence(__ATOMIC_ACQUIRE, "agent");
      asm volatile("s_waitcnt vmcnt(0)" ::: "memory");
    }
  }
  __syncthreads();
}

#ifndef ENMASK
#define ENMASK 0xffff
#endif
#define EN(i) ((ENMASK >> (i)) & 1)
enum { OP_PRO = 0, OP_LN0, OP_LN1, OP_LNF, OP_FFI, OP_FFO, OP_UP, OP_M0, OP_GAT, OP_S, OP_M2, OP_FIN, OP_DN, OP_AQ, OP_APREP, OP_ACORE, OP_AO, OP_SI, OP_SCONV, OP_SO, OP_DNUP };
__global__ void __launch_bounds__(512) fwd_megakernel(Params p) {
  cg::grid_group grid = cg::this_grid();
  const int wave_s = __builtin_amdgcn_readfirstlane((int)threadIdx.x >> 6);
  volatile LAS unsigned* xst = (volatile LAS unsigned*)((LAS unsigned char*)lds_raw + (LDS_BYTES - 16));
  if (threadIdx.x == 0) { xst[0] = 0u; xst[1] = 0u; }
  __syncthreads();
  unsigned* xbar = (unsigned*)(p.ws + O_BAR);
  const unsigned xcc = xb_xcc_id();
  if (threadIdx.x == 0) (void)xb_add(&xbar[XB_XCNT(xcc)], 1u);
#ifdef DUP_OP
  int rep = 0;
#endif
  for (int ph = 0; ph < p.nph; ++ph) {
    const unsigned w = p.prog[ph];
    const int op = w & 255, a = (w >> 8) & 255, b = (w >> 16) & 255, c = (w >> 24) & 255;
#define MKCTX int z; asm volatile("s_mov_b32 %0, 0" : "=s"(z)); \
    GAS char* wsq = (GAS char*)p.ws; GAS float* outq = (GAS float*)p.out; int bidq = (int)blockIdx.x, nbq = (int)gridDim.x; \
    asm volatile("" : "+s"(wsq), "+s"(outq), "+s"(bidq), "+s"(nbq)); \
    const Ctx cx{wave_s * 64 + (int)__builtin_amdgcn_mbcnt_hi(~0u, __builtin_amdgcn_mbcnt_lo(~0u, (unsigned)z)), bidq, nbq, z, (char*)wsq, (float*)outq};
    if (EN(0) && op == OP_PRO) { MKCTX prologue(p, cx); }
    else if (EN(1) && op == OP_LN0) { MKCTX lnmod_phase<0>(p, cx, 0, 0, 0); }
    else if (EN(1) && op == OP_LN1) { MKCTX lnmod_phase<1>(p, cx, a, b, c); }
    else if (EN(1) && op == OP_LNF) { MKCTX lnmod_phase<2>(p, cx, a, 0, 0); }
    else if (EN(2) && op == OP_M0) { MKCTX ml_m0(p, cx, a); }
    else if (EN(3) && op == OP_GAT) { MKCTX ml_gates(p, cx, a); }
    else if (EN(4) && op == OP_S) { MKCTX ml_s(p, cx); }
    else if (EN(5) && op == OP_M2) { MKCTX ml_m2(p, cx); }
    else if (EN(6) && op == OP_FIN) { MKCTX ml_fin(p, cx, a); }
    else if (EN(7) && op == OP_APREP) { MKCTX at_prep(p, cx); }
    else if (EN(8) && op == OP_ACORE) { MKCTX at_core(p, cx); }
    else if (EN(9) && op == OP_SCONV) { MKCTX sc_conv(p, cx); }
    else if (EN(10)) {
      MKCTX
      char* ws = cx.ws;
      const RowMap idm{0, 0, 1 << 30};
      bf16_t* U = (bf16_t*)(ws + O_U); bf16_t* ACT = (bf16_t*)(ws + O_ACT);
      const float* MODT = (const float*)(ws + O_MODT);
      const int nrep = op == OP_DNUP ? 2 : 1;
      for (int rep = 0; rep < nrep; ++rep) {
        const int op2 = op == OP_DNUP ? (rep == 0 ? (int)OP_UP : (int)OP_DN) : op;
        const int c2 = (op == OP_DNUP && rep == 0) ? c + 1 : c;
        Ctx cg_ = cx;
        if (op == OP_DNUP && rep == 1) cg_.bid = (cx.bid + cx.nb - 32) % cx.nb;
        const bf16_t* A = U; const bf16_t* Bt; int K = 1024, nM = MROWS / 256, nN; RowMap am = idm, cm = idm;
        Epi E; E.kind = 2; E.O = ACT; E.ldc = 0; E.modl = MODT + (size_t)b * 9 * 9216; E.slot = 1; E.wgt = 1.0f;
        E.ln = b * 3 + 1 - 1;
        if (op2 == OP_FFI) { Bt = (const bf16_t*)(ws + O_WFI) + (size_t)a * 5632 * 1024; nN = 22; E.kind = 1; if (c) nM = NLAT / 256; }
        else if (op2 == OP_FFO) { A = ACT; Bt = (const bf16_t*)(ws + O_WFO) + (size_t)a * 1024 * 2816; K = 2816; nN = 4; E.slot = c & 3; E.wgt = 0.5f; E.ln = b * 3 + (c & 3) - 1; if (c & 4) nM = NLAT / 256; }
        else if (op2 == OP_UP) { Bt = (const bf16_t*)(ws + O_WUP) + (size_t)a * 4096 * 1024; nM = RG / 256; nN = 16; am = RowMap{c2 * GB * SEQ, NLAT + c2 * GB * LC, GB * SEQ / 256}; E.kind = 0; E.O = (bf16_t*)(ws + O_XZ); E.ldc = 4096; }
        else if (op2 == OP_DN) { A = (const bf16_t*)(ws + O_FIN); Bt = (const bf16_t*)(ws + O_WDN) + (size_t)a * 1024 * 2048; K = 2048; nM = RG / 256; nN = 4; cm = RowMap{c2 * GB * SEQ, NLAT + c2 * GB * LC, GB * SEQ / 256}; }
        else if (op2 == OP_AQ) { Bt = (const bf16_t*)(ws + O_WAQ); nN = 6; E.kind = 0; E.ldc = 1536; }
        else if (op2 == OP_AO) { Bt = (const bf16_t*)(ws + O_WAO); nN = 4; }
        else if (op2 == OP_SI) { Bt = (const bf16_t*)(ws + O_WSI); nN = 12; E.kind = 0; E.ldc = 3072; }
        else { Bt = (const bf16_t*)(ws + O_WSO); nN = 4; }
        gemm_phase(cg_, A, am, Bt, K, nM, nN, cm, E);
      }
    }
    if (ph == 0) grid.sync(); else xcd_barrier(xbar, xcc, xst);
#ifdef DUP_OP
    if (op == DUP_OP && rep + 1 < DUP_N) { ++rep; --ph; } else rep = 0;
#endif
  }
}

static int build_program(unsigned* prog) {
  int n = 0;
  auto W = [&](int op, int a, int b, int c) { prog[n++] = (unsigned)op | ((unsigned)a << 8) | ((unsigned)b << 16) | ((unsigned)c << 24); };
  W(OP_PRO, 0, 0, 0);
  W(OP_LN0, 0, 0, 0);
  for (int layer = 0; layer < DEPTH; ++layer) {
    const int kind = layer % 3, j = layer / 3;
    W(OP_FFI, layer * 2, layer, 0); W(OP_FFO, layer * 2, layer, 0);
    W(OP_LN1, layer * 3 + 0, layer, 1);
    if (kind == 0) {
      for (int g = 0; g < NG; ++g) { if (g == 0) W(OP_UP, j, layer, g); W(OP_M0, j, 0, 0); W(OP_GAT, j, 0, 0); W(OP_S, 0, 0, 0); W(OP_M2, 0, 0, 0); W(OP_FIN, j, 0, 0); W(g + 1 < NG ? OP_DNUP : OP_DN, j, layer, g); }
    } else if (kind == 1) { W(OP_AQ, 0, layer, 0); W(OP_APREP, 0, 0, 0); W(OP_ACORE, 0, 0, 0); W(OP_AO, 0, layer, 0); }
    else { W(OP_SI, 0, layer, 0); W(OP_SCONV, 0, 0, 0); W(OP_SO, 0, layer, 0); }
    W(OP_LN1, layer * 3 + 1, layer, 2);
    const int lo = (layer + 1 == DEPTH) ? 1 : 0;
    W(OP_FFI, layer * 2 + 1, layer, lo); W(OP_FFO, layer * 2 + 1, layer, 2 | (lo << 2));
    if (layer + 1 < DEPTH) W(OP_LN1, layer * 3 + 2, layer + 1, 0); else W(OP_LNF, layer * 3 + 2, 0, 0);
  }
  return n;
}

extern "C" void kernel_launch(void* const* d_in, const int* in_sizes, int n_in, void* d_out, int out_size, void* d_ws, size_t ws_size, hipStream_t stream) {
  static int grid_blocks = 0;
  if (!grid_blocks) {
    int dev = 0, cus = 0, per_cu = 0;
    (void)hipGetDevice(&dev);
    (void)hipDeviceGetAttribute(&cus, hipDeviceAttributeMultiprocessorCount, dev);
    (void)hipFuncSetAttribute((const void*)fwd_megakernel, hipFuncAttributeMaxDynamicSharedMemorySize, LDS_BYTES);
    (void)hipOccupancyMaxActiveBlocksPerMultiprocessor(&per_cu, fwd_megakernel, 512, LDS_BYTES);
    if (cus <= 0) cus = 256;
    grid_blocks = cus;
    if (ws_size < WS_END || n_in != 25) fprintf(stderr, "kernel_launch: workspace %zu < %zu or n_in %d != 25\n", ws_size, (size_t)WS_END, n_in);
    if (per_cu < 1) fprintf(stderr, "kernel_launch: occupancy query says %d blocks per CU\n", per_cu);
  }
  Params p{};
  for (int i = 0; i < 25; ++i) p.in[i] = (const float*)d_in[i];
  p.out = (float*)d_out; p.ws = (char*)d_ws;
  p.nph = build_program(p.prog);
  (void)hipMemsetAsync((char*)d_ws + O_BAR, 0, XCD_BAR_WORDS * 4, stream);
  void* args[] = {&p};
  hipError_t e = hipLaunchCooperativeKernel((void*)fwd_megakernel, dim3(grid_blocks), dim3(512), args, LDS_BYTES, stream);
  if (e != hipSuccess) fprintf(stderr, "cooperative launch failed: %s (grid %d)\n", hipGetErrorString(e), grid_blocks);
}
```

```cpp
#include <hip/hip_runtime.h>
#include <hip/hip_cooperative_groups.h>
#include <cstdio>
#include <cstdint>
namespace cg = cooperative_groups;

typedef unsigned short bf16_t;
typedef short bf16x8 __attribute__((ext_vector_type(8)));
typedef short bf16x4 __attribute__((ext_vector_type(4)));
typedef float f32x4 __attribute__((ext_vector_type(4)));
typedef unsigned u32x2 __attribute__((ext_vector_type(2)));
typedef unsigned u32x4 __attribute__((ext_vector_type(4)));

constexpr int D = 1024, NB = 8, SEQ = 4096, LC = 256, DEPTH = 4, FF = 2816, EI = 2048, DH = 512;
constexpr int NLAT = NB * SEQ, NCTX = NB * LC, MROWS = NLAT + NCTX;
constexpr int TOKB = LC + SEQ;
constexpr int NCH = TOKB / 64;
constexpr int GB = 2, NG = NB / GB, RG = GB * TOKB;
constexpr int NSEQ = GB * 8;
constexpr float ALPHA = 1.681792830507429f, LN_EPS = 1e-5f;
constexpr int LDS_BYTES = 144 * 1024;

constexpr size_t al256(size_t x) { return (x + 255) & ~(size_t)255; }
constexpr size_t O_WFI = 0;
constexpr size_t O_WFO = O_WFI + (size_t)8 * 5632 * 1024 * 2;
constexpr size_t O_WUP = O_WFO + (size_t)8 * 1024 * 2816 * 2;
constexpr size_t O_WDN = O_WUP + (size_t)2 * 4096 * 1024 * 2;
constexpr size_t O_WAQ = O_WDN + (size_t)2 * 1024 * 2048 * 2;
constexpr size_t O_WAO = O_WAQ + (size_t)1536 * 1024 * 2;
constexpr size_t O_WSI = O_WAO + (size_t)1024 * 1024 * 2;
constexpr size_t O_WSO = O_WSI + (size_t)3072 * 1024 * 2;
constexpr size_t O_WG = O_WSO + (size_t)1024 * 1024 * 2;
constexpr size_t O_MODT = O_WG + (size_t)2 * 16 * 6144 * 2;
constexpr size_t O_ROPE = O_MODT + (size_t)4 * 9 * 9216 * 4;
constexpr size_t O_HCTX = O_ROPE + (size_t)2 * 4096 * 32 * 4;
constexpr size_t O_U = O_HCTX + (size_t)NCTX * D * 4;
constexpr size_t O_R = O_U + (size_t)MROWS * D * 2;
constexpr size_t O_XZ = O_R;
constexpr size_t O_QK = O_XZ + (size_t)RG * 4096 * 2;
constexpr size_t O_KT = O_QK + (size_t)RG * 4096 * 2;
constexpr size_t O_VT = O_KT + (size_t)GB * EI * TOKB * 2;
constexpr size_t O_SP = O_VT + (size_t)GB * EI * TOKB * 2;
constexpr size_t O_HD = O_SP + (size_t)NSEQ * NCH * 4096 * 2;
constexpr size_t O_FIN = O_HD + (size_t)2 * RG * EI * 2;
constexpr size_t O_GAT = O_FIN + (size_t)RG * EI * 2;
constexpr size_t SZ_ST = (size_t)NSEQ * TOKB * 4;
constexpr size_t O_BL = O_GAT, O_IG = O_BL + SZ_ST, O_WIN = O_IG + SZ_ST, O_FLO = O_WIN + SZ_ST, O_DEN = O_FLO + SZ_ST, O_WSS = O_DEN + SZ_ST;
constexpr size_t O_GC = O_WSS + SZ_ST;
constexpr size_t O_QF = O_GC + (size_t)3 * NSEQ * NCH * 4 + 256;
constexpr size_t O_REND_ML = O_QF + (size_t)GB * EI * TOKB * 2;
constexpr size_t O_ACT = O_R;
constexpr size_t O_AKR = O_R + (size_t)MROWS * 3072 * 2;
constexpr size_t O_AVT = O_AKR + (size_t)NB * 4 * TOKB * 64 * 2;
constexpr size_t O_REND_AT = O_AVT + (size_t)NB * 4 * TOKB * 64 * 2;
constexpr size_t O_BAR = (O_REND_ML > O_REND_AT ? O_REND_ML : O_REND_AT);
constexpr size_t O_STATS = O_BAR + 3456 * 4 + 256;
constexpr size_t O_LNT = O_STATS + (size_t)MROWS * 8 + 256;
constexpr size_t WS_END = O_LNT + (size_t)12 * 2 * D * 4 + 256;

struct Params {
  const float* in[25];
  float* out;
  char* ws;
  int nph; int pad0;
  unsigned prog[126];
};

#define GAS __attribute__((address_space(1)))
#define IN(k) ((const float*)(const GAS float*)p.in[(k) + cx.z])
struct Ctx { int tid, bid, nb, z; char* ws; float* out; };
extern __shared__ __attribute__((aligned(16))) char lds_raw[];

__device__ __forceinline__ unsigned pk2(float lo, float hi) { unsigned r; asm volatile("v_cvt_pk_bf16_f32 %0, %1, %2" : "=v"(r) : "v"(lo), "v"(hi)); return r; }
__device__ __forceinline__ float bf2f(unsigned short v) { return __uint_as_float(((unsigned)v) << 16); }
__device__ __forceinline__ float bflo(unsigned v) { return __uint_as_float(v << 16); }
__device__ __forceinline__ float bfhi(unsigned v) { return __uint_as_float(v & 0xffff0000u); }
__device__ __forceinline__ float silu_f(float x) { return x * __builtin_amdgcn_rcpf(1.f + __expf(-x)); }
__device__ __forceinline__ float sigm_f(float x) { return __builtin_amdgcn_rcpf(1.f + __expf(-x)); }
__device__ __forceinline__ float shi(float v, int srclane) { return __int_as_float(__builtin_amdgcn_ds_bpermute(srclane << 2, __float_as_int(v))); }
__device__ __forceinline__ float shx(float v, int m, int lane) { return shi(v, lane ^ m); }
__device__ __forceinline__ float wave_sum(float v, int lane) {
#pragma unroll
  for (int o = 1; o < 64; o <<= 1) v += shx(v, o, lane);
  return v;
}
__device__ __forceinline__ bf16x8 mk8(u32x4 v) { union { u32x4 u; bf16x8 b; } x; x.u = v; return x.b; }
__device__ __forceinline__ bf16x8 mk8(u32x2 a, u32x2 b) { union { u32x4 u; bf16x8 b; } x; x.u = (u32x4){a.x, a.y, b.x, b.y}; return x.b; }
__device__ __forceinline__ float* hrow(const Ctx& cx, int row) { return row < NLAT ? cx.out + (size_t)row * D : (float*)(cx.ws + O_HCTX) + (size_t)(row - NLAT) * D; }
#define MFMA16(a, b, c) __builtin_amdgcn_mfma_f32_16x16x32_bf16(a, b, c, 0, 0, 0)

constexpr int BM = 256, BK = 64, HALF = 128, HT = HALF * BK, NXCD = 8, WGM = 8;
__device__ __forceinline__ int lds_byte(int r, int c) {
  int st = (r >> 4) * 2 + (c >> 5), rr = r & 15, cc = c & 31, ob = rr * 64 + cc * 2;
  return st * 1024 + (ob ^ (((ob >> 9) & 1) << 5));
}
__device__ __forceinline__ void stage_rc(int b, int& R, int& C) {
  int st = b / 1024, sb = b % 1024, swz = sb ^ (((sb >> 9) & 1) << 5);
  R = (st >> 1) * 16 + swz / 64; C = (st & 1) * 32 + (swz % 64) / 2;
}
struct RowMap { int lat0, ctx0, nlat; __device__ __forceinline__ int row0(int pm) const { return pm < nlat ? lat0 + pm * 256 : ctx0 + (pm - nlat) * 256; } };

typedef f32x4 Acc[2][2][4][2];

struct Epi {
  int kind; bf16_t* O; int ldc; const float* modl; int slot; float wgt;
  int ln;
};
__device__ __forceinline__ void run_epi(const Ctx& cx, const Epi E, const Acc& acc, int r0, int pn, int wr, int wc, int fr, int fq) {
  if (E.kind == 0) {
#pragma unroll
    for (int ai = 0; ai < 2; ++ai)
#pragma unroll
      for (int m = 0; m < 4; ++m) {
        bf16_t* rp = E.O + (size_t)(r0 + ai * HALF + wr * 64 + m * 16 + fr) * E.ldc + pn * 256 + wc * 32 + 4 * fq;
#pragma unroll
        for (int bj = 0; bj < 2; ++bj)
#pragma unroll
          for (int n = 0; n < 2; ++n) {
            f32x4 v = acc[ai][bj][m][n];
            u32x2 o; o.x = pk2(v[0], v[1]); o.y = pk2(v[2], v[3]);
            *(u32x2*)(rp + bj * HALF + n * 16) = o;
          }
      }
  } else if (E.kind == 1) {
#pragma unroll
    for (int ai = 0; ai < 2; ++ai)
#pragma unroll
      for (int m = 0; m < 4; ++m) {
        bf16_t* rp = E.O + (size_t)(r0 + ai * HALF + wr * 64 + m * 16 + fr) * FF + pn * 128 + wc * 16 + 4 * fq;
#pragma unroll
        for (int bj = 0; bj < 2; ++bj) {
          f32x4 g = acc[ai][bj][m][0], v = acc[ai][bj][m][1];
          u32x2 o; o.x = pk2(silu_f(g[0]) * v[0], silu_f(g[1]) * v[1]); o.y = pk2(silu_f(g[2]) * v[2], silu_f(g[3]) * v[3]);
          *(u32x2*)(rp + bj * 64) = o;
        }
      }
  } else {
    const int midx = r0 < NLAT ? (r0 >> 12) : 8;
    const int cb = pn * 256 + wc * 32 + 4 * fq;
    const float* gp = E.modl + (size_t)midx * 9216 + (3 * E.slot + 2) * D + cb;
    f32x4 gv[2][2], lg[2][2], lb[2][2];
#pragma unroll
    for (int bj = 0; bj < 2; ++bj)
#pragma unroll
      for (int n = 0; n < 2; ++n) {
        gv[bj][n] = *(const f32x4*)(gp + bj * HALF + n * 16) * E.wgt;
        if (E.ln >= 0) { const float* lt = (const float*)(cx.ws + O_LNT) + (size_t)E.ln * 2 * D + cb + bj * HALF + n * 16; lg[bj][n] = *(const f32x4*)lt; lb[bj][n] = *(const f32x4*)(lt + D); }
        else { lg[bj][n] = (f32x4){1.f, 1.f, 1.f, 1.f}; lb[bj][n] = (f32x4){0.f, 0.f, 0.f, 0.f}; }
      }
#pragma unroll
    for (int ai = 0; ai < 2; ++ai)
#pragma unroll
      for (int m = 0; m < 4; ++m) {
        const int row = r0 + ai * HALF + wr * 64 + m * 16 + fr;
        float* rp = hrow(cx, row) + cb;
        float mean = 0.f, rstd = 1.f;
        if (E.ln >= 0) { const float2 st = *(const float2*)((const float*)(cx.ws + O_STATS) + (size_t)row * 2); mean = st.x; rstd = st.y; }
        f32x4 h[2][2];
#pragma unroll
        for (int bj = 0; bj < 2; ++bj)
#pragma unroll
          for (int n = 0; n < 2; ++n) h[bj][n] = *(const f32x4*)(rp + bj * HALF + n * 16);
#pragma unroll
        for (int bj = 0; bj < 2; ++bj)
#pragma unroll
          for (int n = 0; n < 2; ++n) *(f32x4*)(rp + bj * HALF + n * 16) = ((h[bj][n] - mean) * rstd) * lg[bj][n] + lb[bj][n] + gv[bj][n] * acc[ai][bj][m][n];
        __builtin_amdgcn_sched_barrier(0);
      }
  }
}

#define LAS __attribute__((address_space(3)))
__device__ __forceinline__ void gemm_phase(const Ctx& cx, const bf16_t* __restrict__ A, RowMap am, const bf16_t* __restrict__ Bt, int K, int nM, int nN, RowMap cm, const Epi epi) {
  LAS unsigned char* lds = (LAS unsigned char*)lds_raw;
  constexpr int HTB = HT * 2;
  const int tid = cx.tid, wid = tid >> 6, lane = tid & 63, wr = wid >> 2, wc = wid & 3, fr = lane & 15, fq = lane >> 4;
  unsigned voff[2];
#pragma unroll
  for (int i = 0; i < 2; ++i) { int R, C; stage_rc(tid * 16 + i * 8192, R, C); voff[i] = (unsigned)(R * K + C) * 2u; }
  const size_t kstep = (size_t)(BK * 2), hstep = (size_t)HALF * K * 2;
  const unsigned ldsw = (unsigned)wid * 1024u;
  const int aoff = lds_byte(wr * 64 + fr, fq * 8), boff = lds_byte(wc * 32 + fr, fq * 8);
#define G_SA(b, h) (((b) * 2 + (h)) * HTB)
#define G_SB(b, h) ((4 + (b) * 2 + (h)) * HTB)
#define STAGE(bufoff, gbase) do { _Pragma("unroll") for (int _i = 0; _i < 2; ++_i) \
    __builtin_amdgcn_global_load_lds((const unsigned*)((const char*)(gbase) + voff[_i]), (LAS unsigned*)(lds + (bufoff) + ldsw + _i * 8192), 16, 0, 0); } while (0)
#define LDA(dst, b, h) do { _Pragma("unroll") for (int m = 0; m < 4; ++m) _Pragma("unroll") for (int k = 0; k < 2; ++k) dst[m][k] = *(const LAS bf16x8*)(lds + G_SA(b, h) + aoff + m * 2048 + k * 1024); } while (0)
#define LDB(dst, b, h) do { _Pragma("unroll") for (int n = 0; n < 2; ++n) _Pragma("unroll") for (int k = 0; k < 2; ++k) dst[n][k] = *(const LAS bf16x8*)(lds + G_SB(b, h) + boff + n * 2048 + k * 1024); } while (0)
#define MMA(ai, bj, At, Bt_) do { __builtin_amdgcn_s_setprio(1); _Pragma("unroll") for (int m = 0; m < 4; ++m) _Pragma("unroll") for (int n = 0; n < 2; ++n) _Pragma("unroll") for (int k = 0; k < 2; ++k) \
      acc[ai][bj][m][n] = MFMA16(Bt_[n][k], At[m][k], acc[ai][bj][m][n]); \
    __builtin_amdgcn_s_setprio(0); } while (0)
#define WAIT_V(n) asm volatile("s_waitcnt vmcnt(" #n ")" ::: "memory")
#define WAIT_L(n) asm volatile("s_waitcnt lgkmcnt(" #n ")" ::: "memory")
#define BAR __builtin_amdgcn_s_barrier()
#define SCHED __builtin_amdgcn_sched_barrier(0)
  const int nwg = nM * nN;
  const int nt = K / BK;
  const int wid_s = __builtin_amdgcn_readfirstlane(wid);
#define DECODE(L_, pm_, pn_) do { int wgid = (L_); \
    { int q = nwg / NXCD, r = nwg % NXCD, xcd = wgid % NXCD, off = wgid / NXCD; wgid = (xcd < r ? xcd * (q + 1) : r * (q + 1) + (xcd - r) * q) + off; } \
    const int nig = WGM * nN, gid = wgid / nig, fm = gid * WGM, gsz = min(nM - fm, WGM); \
    pm_ = fm + ((wgid % nig) % gsz); pn_ = (wgid % nig) / gsz; } while (0)
  int L = cx.bid;
  if (L < nwg) {
    int pm, pn;
    DECODE(L, pm, pn);
    const char* cA = (const char*)A + (size_t)am.row0(pm) * K * 2; const char* cB = (const char*)Bt + (size_t)pn * BM * K * 2;
    Acc acc;
#pragma unroll
    for (int a = 0; a < 2; ++a)
#pragma unroll
      for (int b = 0; b < 2; ++b)
#pragma unroll
        for (int m = 0; m < 4; ++m)
#pragma unroll
          for (int n = 0; n < 2; ++n) acc[a][b][m][n] = (f32x4){0.f, 0.f, 0.f, 0.f};
    bf16x8 At[4][2], B0[2][2], B1[2][2];
    STAGE(G_SB(0, 0), cB); STAGE(G_SA(0, 0), cA); STAGE(G_SB(0, 1), cB + hstep); STAGE(G_SA(0, 1), cA + hstep);
    if (wr == 1) BAR;
    WAIT_V(4); BAR;
    STAGE(G_SB(1, 0), cB + kstep); STAGE(G_SA(1, 0), cA + kstep); STAGE(G_SB(1, 1), cB + hstep + kstep);
    WAIT_V(6); BAR;
    for (;;) {
      const int Ln = L + cx.nb;
      const bool has_next = Ln < nwg;
      int pmn = pm, pnn = pn;
      if (has_next) DECODE(Ln, pmn, pnn);
      const char* nA = has_next ? (const char*)A + (size_t)am.row0(pmn) * K * 2 : cA; const char* nB = has_next ? (const char*)Bt + (size_t)pnn * BM * K * 2 : cB;
      for (int t = 0; t < nt; t += 2) {
        const bool last = (t == nt - 2);
        const char* a1 = cA + (size_t)(t + 1) * kstep;
        const char* a2 = last ? nA : cA + (size_t)(t + 2) * kstep; const char* b2 = last ? nB : cB + (size_t)(t + 2) * kstep;
        const char* a3 = a2 + kstep; const char* b3 = b2 + kstep;
        LDB(B0, 0, 0); SCHED; LDA(At, 0, 0); STAGE(G_SA(1, 1), a1 + hstep);
        WAIT_L(8); BAR; WAIT_L(0); MMA(0, 0, At, B0); BAR; SCHED;
        LDB(B1, 0, 1); STAGE(G_SB(0, 0), b2);
        BAR; WAIT_L(0); MMA(0, 1, At, B1); BAR;
        LDA(At, 0, 1); STAGE(G_SA(0, 0), a2);
        BAR; WAIT_L(0); MMA(1, 0, At, B0); BAR; SCHED;
        STAGE(G_SB(0, 1), b2 + hstep);
        WAIT_V(6); BAR; MMA(1, 1, At, B1); BAR;
        LDB(B0, 1, 0); SCHED; LDA(At, 1, 0); STAGE(G_SA(0, 1), a2 + hstep);
        WAIT_L(8); BAR; WAIT_L(0); MMA(0, 0, At, B0); BAR; SCHED;
        LDB(B1, 1, 1); STAGE(G_SB(1, 0), b3);
        BAR; WAIT_L(0); MMA(0, 1, At, B1); BAR;
        LDA(At, 1, 1); STAGE(G_SA(1, 0), a3);
        BAR; WAIT_L(0); MMA(1, 0, At, B0); BAR; SCHED;
        STAGE(G_SB(1, 1), b3 + hstep);
        WAIT_V(6); BAR; MMA(1, 1, At, B1); BAR;
      }
      { int t2 = wid_s * 64 + (int)__builtin_amdgcn_mbcnt_hi(~0u, __builtin_amdgcn_mbcnt_lo(~0u, (unsigned)cx.z)); asm volatile("" : "+v"(t2));
        const int w2 = t2 >> 6, l2 = t2 & 63;
        run_epi(cx, epi, acc, cm.row0(pm), pn, w2 >> 2, w2 & 3, l2 & 15, l2 >> 4); }
      if (!has_next) break;
#pragma unroll
      for (int a = 0; a < 2; ++a)
#pragma unroll
        for (int b = 0; b < 2; ++b)
#pragma unroll
          for (int m = 0; m < 4; ++m)
#pragma unroll
            for (int n = 0; n < 2; ++n) acc[a][b][m][n] = (f32x4){0.f, 0.f, 0.f, 0.f};
      pm = pmn; pn = pnn; cA = nA; cB = nB; L = Ln;
    }
    WAIT_V(0);
    if (wr == 0) BAR;
    BAR;
  }
  __syncthreads();
}

template <int MODE>
__device__ __forceinline__ int wrow(int c) {
  if (MODE == 0) return c;
  const int isv = c >= FF ? 1 : 0, f = c - isv * FF;
  return (f >> 7) * 256 + ((f >> 6) & 1) * 128 + ((f >> 4) & 3) * 32 + isv * 16 + (f & 15);
}
template <int MODE>
__device__ __forceinline__ void transpose_item(const float* __restrict__ W, int K, int N, bf16_t* __restrict__ WT, float* scr, int item, int lane) {
  const int nblk = N / 32, kb = item / nblk, nb = item % nblk, k0 = 64 * kb, n0 = 32 * nb;
#pragma unroll 8
  for (int i = 0; i < 32; ++i) { const int kk = 2 * i + (lane >> 5); scr[kk * 33 + (lane & 31)] = W[(size_t)(k0 + kk) * N + n0 + (lane & 31)]; }
  __builtin_amdgcn_wave_barrier(); asm volatile("s_waitcnt lgkmcnt(0)" ::: "memory");
  const int c = lane & 7;
#pragma unroll
  for (int j = 0; j < 4; ++j) {
    const int n = (lane >> 3) + 8 * j; const float* s = scr + (8 * c) * 33 + n;
    u32x4 o; o.x = pk2(s[0 * 33], s[1 * 33]); o.y = pk2(s[2 * 33], s[3 * 33]); o.z = pk2(s[4 * 33], s[5 * 33]); o.w = pk2(s[6 * 33], s[7 * 33]);
    *(u32x4*)(WT + (size_t)wrow<MODE>(n0 + n) * K + k0 + 8 * c) = o;
  }
  asm volatile("s_waitcnt lgkmcnt(0)" ::: "memory"); __builtin_amdgcn_wave_barrier();
}

__device__ __forceinline__ void prologue(const Params& p, const Ctx& cx) {
  const int tid = cx.tid, lane = tid & 63, wave = tid >> 6;
  char* ws = cx.ws;
  {
    float* cond = (float*)lds_raw;
    float* red = (float*)(lds_raw + 9 * 1024 * 4);
    for (int i = tid; i < 9 * 1024; i += 512) { const int j = i >> 10, k = i & 1023; cond[i] = silu_f(j < 8 ? IN(1)[j * 1024 + k] : IN(3)[k]); }
    __syncthreads();
    for (int u = cx.bid; u < 4 * 36; u += cx.nb) {
      const int layer = u / 36, ct = u % 36, c0 = ct * 256 + 4 * lane;
      const float* wp = IN(4) + (size_t)layer * D * 9216 + c0;
      f32x4 a[9];
#pragma unroll
      for (int j = 0; j < 9; ++j) a[j] = (f32x4){0.f, 0.f, 0.f, 0.f};
#pragma unroll 4
      for (int k = wave * 128; k < wave * 128 + 128; ++k) {
        const f32x4 w = *(const f32x4*)(wp + (size_t)k * 9216);
#pragma unroll
        for (int j = 0; j < 9; ++j) a[j] += w * cond[j * 1024 + k];
      }
#pragma unroll
      for (int j = 0; j < 9; ++j) *(f32x4*)(red + (wave * 9 + j) * 256 + 4 * lane) = a[j];
      __syncthreads();
      float* mt = (float*)(ws + O_MODT) + (size_t)layer * 9 * 9216;
      for (int i = tid; i < 9 * 256; i += 512) {
        const int j = i >> 8, c = i & 255; float s = 0.f;
#pragma unroll
        for (int w = 0; w < 8; ++w) s += red[(w * 9 + j) * 256 + c];
        mt[(size_t)j * 9216 + ct * 256 + c] = s + IN(5)[layer * 9216 + ct * 256 + c];
      }
      __syncthreads();
    }
    __syncthreads();
  }
  {
    float* scr = (float*)lds_raw + wave * (64 * 33);
    const int gw = cx.bid * 8 + wave, NGW = cx.nb * 8;
    constexpr int I_FI = 16 * 176, I_FO = 44 * 32, I_UP = 16 * 128, I_DN = 32 * 32, I_AQ = 16 * 48, I_AO = 16 * 32, I_SI = 16 * 96, I_SO = 16 * 32;
    constexpr int NITEMS = 8 * I_FI + 8 * I_FO + 2 * I_UP + 2 * I_DN + I_AQ + I_AO + I_SI + I_SO;
    for (int it = gw; it < NITEMS; it += NGW) {
      int r = it;
      if (r < 8 * I_FI) { const int mi = r / I_FI; transpose_item<1>(IN(8) + (size_t)mi * 1024 * 5632, 1024, 5632, (bf16_t*)(ws + O_WFI) + (size_t)mi * 5632 * 1024, scr, r % I_FI, lane); continue; } r -= 8 * I_FI;
      if (r < 8 * I_FO) { const int mi = r / I_FO; transpose_item<0>(IN(9) + (size_t)mi * 2816 * 1024, 2816, 1024, (bf16_t*)(ws + O_WFO) + (size_t)mi * 1024 * 2816, scr, r % I_FO, lane); continue; } r -= 8 * I_FO;
      if (r < 2 * I_UP) { const int mi = r / I_UP; transpose_item<0>(IN(10) + (size_t)mi * 1024 * 4096, 1024, 4096, (bf16_t*)(ws + O_WUP) + (size_t)mi * 4096 * 1024, scr, r % I_UP, lane); continue; } r -= 2 * I_UP;
      if (r < 2 * I_DN) { const int mi = r / I_DN; transpose_item<0>(IN(18) + (size_t)mi * 2048 * 1024, 2048, 1024, (bf16_t*)(ws + O_WDN) + (size_t)mi * 1024 * 2048, scr, r % I_DN, lane); continue; } r -= 2 * I_DN;
      if (r < I_AQ) { transpose_item<0>(IN(19), 1024, 1536, (bf16_t*)(ws + O_WAQ), scr, r, lane); continue; } r -= I_AQ;
      if (r < I_AO) { transpose_item<0>(IN(21), 1024, 1024, (bf16_t*)(ws + O_WAO), scr, r, lane); continue; } r -= I_AO;
      if (r < I_SI) { transpose_item<0>(IN(22), 1024, 3072, (bf16_t*)(ws + O_WSI), scr, r, lane); continue; } r -= I_SI;
      transpose_item<0>(IN(24), 1024, 1024, (bf16_t*)(ws + O_WSO), scr, r, lane);
    }
  }
  {
    const int gt = cx.bid * 512 + tid, gs = cx.nb * 512;
    bf16_t* wg = (bf16_t*)(ws + O_WG);
    for (int i = gt; i < 2 * 16 * 6144; i += gs) {
      const int j = i / (16 * 6144), xg = (i / 6144) & 15, k = i % 6144, x = xg >> 3, g = xg & 7;
      const float* wif = IN(14) + (size_t)(j * 2 + x) * 6144 * 8;
      float v;
      const int knat = (k & ~31) + 16 * ((k >> 2) & 1) + 4 * ((k >> 3) & 3) + (k & 3);
      if (k < 2048) v = wif[(size_t)knat * 8 + g];
      else if (k < 4096) v = wif[(size_t)knat * 8 + g] * 22.627416997969522f;
      else {
        const int c = k - 4096, blk = c >> 2, cc = c & 3;
        const float* wv = IN(13) + ((size_t)(j * 3 + 2) * 512 + blk) * 16 + cc * 4;
        v = 0.f;
        for (int d2 = 0; d2 < 4; ++d2) v += wv[d2] * wif[(size_t)(4096 + 4 * blk + d2) * 8 + g];
      }
      wg[i] = (bf16_t)(pk2(v, 0.f) & 0xffff);
    }
    { float* lnt = (float*)(ws + O_LNT); for (int i = gt; i < 12 * D; i += gs) { const int l = i / D, c2 = i % D; lnt[(size_t)l * 2 * D + c2] = IN(6)[i] * ALPHA; lnt[(size_t)l * 2 * D + D + c2] = IN(7)[i] * ALPHA; } }
    float* rc = (float*)(ws + O_ROPE); float* rs = rc + 4096 * 32;
    for (int i = gt; i < 4096 * 32; i += gs) {
      const int pos = i >> 5, pp = i & 31, jf = pp & 15;
      const float fr_ = __builtin_amdgcn_exp2f(-(float)jf * (13.287712379549449f / 16.f));
      float rev = (float)(pp < 16 ? (pos >> 6) : (pos & 63)) * fr_ * 0.15915494309189535f;
      rev -= rintf(rev);
      rc[i] = __builtin_amdgcn_cosf(rev); rs[i] = __builtin_amdgcn_sinf(rev);
    }
  }
}

template <int MODE>
__device__ __forceinline__ void lnmod_phase(const Params& p, const Ctx& cx, int lnidx  , int layer, int slot) {
  const int lane = cx.tid & 63, gw = cx.bid * 8 + (cx.tid >> 6), NGW = cx.nb * 8;
  const int nrows = MODE == 2 ? NLAT : MROWS;
  const float* lg = IN(6) + (size_t)lnidx * D; const float* lb = IN(7) + (size_t)lnidx * D;
  const float* modl = (const float*)(cx.ws + O_MODT) + (size_t)layer * 9 * 9216;
  bf16_t* U = (bf16_t*)(cx.ws + O_U);
  for (int row = gw; row < nrows; row += NGW) {
    float* hp = hrow(cx, row);
    const float* src = MODE == 0 ? (row < NLAT ? IN(0) + (size_t)row * D : IN(2) + (size_t)(row - NLAT) * D) : hp;
    f32x4 v[4];
#pragma unroll
    for (int j = 0; j < 4; ++j) v[j] = *(const f32x4*)(src + 4 * lane + 256 * j);
    if (MODE != 0) {
      float s = 0.f;
#pragma unroll
      for (int j = 0; j < 4; ++j) s += (v[j][0] + v[j][1]) + (v[j][2] + v[j][3]);
      const float mean = wave_sum(s, lane) * (1.f / D); float s2 = 0.f;
#pragma unroll
      for (int j = 0; j < 4; ++j) { v[j] = v[j] - mean; s2 += (v[j][0] * v[j][0] + v[j][1] * v[j][1]) + (v[j][2] * v[j][2] + v[j][3] * v[j][3]); }
      const float rstd = __builtin_amdgcn_rsqf(wave_sum(s2, lane) * (1.f / D) + LN_EPS);
      if (MODE == 1 && lane == 0) *(float2*)((float*)(cx.ws + O_STATS) + (size_t)row * 2) = make_float2(mean, rstd);
#pragma unroll
      for (int j = 0; j < 4; ++j) v[j] = v[j] * rstd * *(const f32x4*)(lg + 4 * lane + 256 * j) + *(const f32x4*)(lb + 4 * lane + 256 * j);
    }
    if (MODE != 1) {
#pragma unroll
      for (int j = 0; j < 4; ++j) *(f32x4*)(hp + 4 * lane + 256 * j) = MODE == 0 ? v[j] * ALPHA : v[j];
    }
    if (MODE != 2) {
      const int midx = row < NLAT ? (row >> 12) : 8;
      const float* sh = modl + (size_t)midx * 9216 + (3 * slot) * D; const float* sc = sh + D;
#pragma unroll
      for (int j = 0; j < 4; ++j) {
        const f32x4 u = v[j] * (*(const f32x4*)(sc + 4 * lane + 256 * j) + 1.f) + *(const f32x4*)(sh + 4 * lane + 256 * j);
        u32x2 o; o.x = pk2(u[0], u[1]); o.y = pk2(u[2], u[3]);
        *(u32x2*)(U + (size_t)row * D + 4 * lane + 256 * j) = o;
      }
    }
  }
}

__device__ __forceinline__ int ml_lrow(int bl, int tok) { return tok < LC ? GB * SEQ + bl * LC + tok : bl * SEQ + (tok - LC); }
__device__ __forceinline__ int ml_nchunk(int x, int st) { return x == 0 ? st : (st < 4 ? 3 - st : 71 - st); }

__device__ __forceinline__ void ml_m0(const Params& p, const Ctx& cx, int j) {
  const int tid = cx.tid;
  char* ws = cx.ws;
  const bf16_t* XZ = (const bf16_t*)(ws + O_XZ);
  bf16_t* QK = (bf16_t*)(ws + O_QK); bf16_t* KT = (bf16_t*)(ws + O_KT); bf16_t* VT = (bf16_t*)(ws + O_VT); bf16_t* QF = (bf16_t*)(ws + O_QF);
  const int blk_l = tid & 63, tq = tid >> 6;
  for (int u = cx.bid; u < GB * NCH * 8; u += cx.nb) {
    const int slab = u & 7, ch = (u >> 3) % NCH, bl = u / (8 * NCH);
    const int f0 = slab * 256 + blk_l * 4, blk = f0 >> 2;
    float cw[3][4], cb[4], wq[16], wk[16], wv[16];
#pragma unroll
    for (int k = 0; k < 3; ++k)
#pragma unroll
      for (int c = 0; c < 4; ++c) cw[k][c] = IN(11)[(size_t)(j * 3 + k) * EI + f0 + c];
#pragma unroll
    for (int c = 0; c < 4; ++c) cb[c] = IN(12)[(size_t)j * EI + f0 + c];
#pragma unroll
    for (int i = 0; i < 16; ++i) {
      wq[i] = IN(13)[((size_t)(j * 3 + 0) * 512 + blk) * 16 + i];
      wk[i] = IN(13)[((size_t)(j * 3 + 1) * 512 + blk) * 16 + i] * 0.04419417382415922f;
      wv[i] = IN(13)[((size_t)(j * 3 + 2) * 512 + blk) * 16 + i];
    }
    const int tok0 = ch * 64, seg_lo = tok0 < LC ? 0 : LC, seg_hi = tok0 < LC ? LC : TOKB;
    const int tl0 = tq * 8;
    float xmp[4], xmc[4], xmn[4];
    {
      const int t2 = tok0 + tl0 - 1;
      if (t2 >= seg_lo) { const u32x2 r = *(const u32x2*)(XZ + (size_t)ml_lrow(bl, t2) * 4096 + f0); xmp[0] = bflo(r.x); xmp[1] = bfhi(r.x); xmp[2] = bflo(r.y); xmp[3] = bfhi(r.y); }
      else { xmp[0] = xmp[1] = xmp[2] = xmp[3] = 0.f; }
      const u32x2 r = *(const u32x2*)(XZ + (size_t)ml_lrow(bl, tok0 + tl0) * 4096 + f0); xmc[0] = bflo(r.x); xmc[1] = bfhi(r.x); xmc[2] = bflo(r.y); xmc[3] = bfhi(r.y);
    }
    unsigned kpk[4][4], vpk[4][4];
    float kprev[4], vprev[4];
    const int fp = (f0 & ~31) + 8 * ((f0 >> 2) & 3) + 4 * ((f0 >> 4) & 1);
#pragma unroll
    for (int tt = 0; tt < 8; ++tt) {
      const int tl = tl0 + tt, tok = tok0 + tl;
      if (tok + 1 < seg_hi) { const u32x2 r = *(const u32x2*)(XZ + (size_t)ml_lrow(bl, tok + 1) * 4096 + f0); xmn[0] = bflo(r.x); xmn[1] = bfhi(r.x); xmn[2] = bflo(r.y); xmn[3] = bfhi(r.y); }
      else { xmn[0] = xmn[1] = xmn[2] = xmn[3] = 0.f; }
      float xc[4], q[4], kk[4], vv[4];
#pragma unroll
      for (int c = 0; c < 4; ++c) xc[c] = silu_f(cw[0][c] * xmp[c] + cw[1][c] * xmc[c] + cw[2][c] * xmn[c] + cb[c]);
#pragma unroll
      for (int d2 = 0; d2 < 4; ++d2) {
        q[d2] = xc[0] * wq[d2] + xc[1] * wq[4 + d2] + xc[2] * wq[8 + d2] + xc[3] * wq[12 + d2];
        kk[d2] = xc[0] * wk[d2] + xc[1] * wk[4 + d2] + xc[2] * wk[8 + d2] + xc[3] * wk[12 + d2];
        vv[d2] = xmc[0] * wv[d2] + xmc[1] * wv[4 + d2] + xmc[2] * wv[8 + d2] + xmc[3] * wv[12 + d2];
      }
      const size_t lr = ml_lrow(bl, tok);
      u32x2 oq, ok; oq.x = pk2(q[0], q[1]); oq.y = pk2(q[2], q[3]); ok.x = pk2(kk[0], kk[1]); ok.y = pk2(kk[2], kk[3]);
      *(u32x2*)(QK + lr * 4096 + fp) = oq;
      *(u32x2*)(QF + ((((((size_t)bl * NCH + ch) * 4 + (f0 >> 9)) * 8 + ((f0 >> 6) & 7)) * 4 + (tl >> 4)) * 2 + ((f0 >> 5) & 1)) * 512 + (tl & 15) * 32 + 8 * ((f0 >> 2) & 3) + 4 * ((f0 >> 4) & 1)) = oq;
      *(u32x2*)(QK + lr * 4096 + 2048 + fp) = ok;
      if (tt & 1) {
#pragma unroll
        for (int c = 0; c < 4; ++c) { kpk[c][tt >> 1] = pk2(kprev[c], kk[c]); vpk[c][tt >> 1] = pk2(vprev[c], vv[c]); }
      } else {
#pragma unroll
        for (int c = 0; c < 4; ++c) { kprev[c] = kk[c]; vprev[c] = vv[c]; }
      }
#pragma unroll
      for (int c = 0; c < 4; ++c) { xmp[c] = xmc[c]; xmc[c] = xmn[c]; }
    }
#pragma unroll
    for (int c = 0; c < 4; ++c) {
      const int feat = f0 + c;
      const size_t off = (((size_t)bl * NCH + ch) * (EI / 16) + (feat >> 4)) * 1024 + (tq >> 2) * 512 + (feat & 15) * 32 + (tq & 3) * 8;
      *(u32x4*)(KT + off) = (u32x4){kpk[c][0], kpk[c][1], kpk[c][2], kpk[c][3]};
      *(u32x4*)(VT + off) = (u32x4){vpk[c][0], vpk[c][1], vpk[c][2], vpk[c][3]};
    }
  }
}

__device__ __forceinline__ void ml_gates(const Params& p, const Ctx& cx, int j) {
  const int tid = cx.tid, lane = tid & 63, wave = tid >> 6, fr = lane & 15, fq = lane >> 4;
  char* ws = cx.ws;
  const bf16_t* XZ = (const bf16_t*)(ws + O_XZ); const bf16_t* QK = (const bf16_t*)(ws + O_QK);
  const bf16_t* WG = (const bf16_t*)(ws + O_WG) + (size_t)j * 16 * 6144;
  float* BL = (float*)(ws + O_BL); float* IG = (float*)(ws + O_IG);
  float* GC = (float*)(ws + O_GC); float* AC = GC + NSEQ * NCH;
  float* part = (float*)lds_raw;
  float* gl = part + 8 * 64 * 16;
  for (int u = cx.bid; u < GB * NCH; u += cx.nb) {
    const int bl = u / NCH, nc = u % NCH, tok0 = nc * 64;
    f32x4 acc[4];
#pragma unroll
    for (int m = 0; m < 4; ++m) acc[m] = (f32x4){0.f, 0.f, 0.f, 0.f};
    size_t lr[4];
#pragma unroll
    for (int m = 0; m < 4; ++m) lr[m] = ml_lrow(bl, tok0 + m * 16 + fr);
#pragma unroll 4
    for (int ks = wave * 24; ks < wave * 24 + 24; ++ks) {
      const int k = ks * 32 + fq * 8;
      const bf16x8 bfr = *(const bf16x8*)(WG + (size_t)fr * 6144 + k);
#pragma unroll
      for (int m = 0; m < 4; ++m) {
        const bf16_t* ap = k < 4096 ? QK + lr[m] * 4096 + k : XZ + lr[m] * 4096 + (k - 4096);
        const bf16x8 afr = *(const bf16x8*)ap;
        acc[m] = MFMA16(afr, bfr, acc[m]);
      }
    }
#pragma unroll
    for (int m = 0; m < 4; ++m)
#pragma unroll
      for (int jj = 0; jj < 4; ++jj) part[(wave * 64 + m * 16 + 4 * fq + jj) * 16 + fr] = acc[m][jj];
    __syncthreads();
    for (int i = tid; i < 1024; i += 512) {
      float s = IN(15)[(size_t)j * 16 + (i & 15)];
#pragma unroll
      for (int w = 0; w < 8; ++w) s += part[w * 1024 + i];
      gl[(i >> 4) * 17 + (i & 15)] = s;
    }
    __syncthreads();
    {
      const int x = wave >> 2, h = wave & 3, seq = (bl * 2 + x) * 4 + h;
      const int tl = x == 0 ? lane : 63 - lane;
      const float ig = gl[tl * 17 + x * 8 + h], fg = gl[tl * 17 + x * 8 + 4 + h];
      float b = fg > 0.f ? -__logf(1.f + __expf(-fg)) : fg - __logf(1.f + __expf(fg));
#pragma unroll
      for (int o = 1; o < 64; o <<= 1) { const float t2 = shi(b, lane - o); if (lane >= o) b += t2; }
      BL[(size_t)seq * TOKB + tok0 + tl] = b; IG[(size_t)seq * TOKB + tok0 + tl] = ig;
      float mx = ig - b;
#pragma unroll
      for (int o = 1; o < 64; o <<= 1) mx = fmaxf(mx, shx(mx, o, lane));
      const float g = shi(b, 63);
      if (lane == 0) { GC[seq * NCH + nc] = g; AC[seq * NCH + nc] = g + mx; }
    }
    __syncthreads();
  }
}

__device__ __forceinline__ void ml_s(const Params& p, const Ctx& cx) {
  const int tid = cx.tid, lane = tid & 63, wave = tid >> 6, fr = lane & 15, fq = lane >> 4;
  char* ws = cx.ws;
  const bf16_t* QK = (const bf16_t*)(ws + O_QK);
  bf16_t* SP = (bf16_t*)(ws + O_SP);
  const float* BL = (const float*)(ws + O_BL); const float* IG = (const float*)(ws + O_IG);
  float* WIN = (float*)(ws + O_WIN); float* FLO = (float*)(ws + O_FLO); float* DEN = (float*)(ws + O_DEN); float* WSS = (float*)(ws + O_WSS);
  const float* GC = (const float*)(ws + O_GC); const float* AC = GC + NSEQ * NCH; float* DEC = (float*)(ws + O_GC) + 2 * NSEQ * NCH;
  float* sb_ = (float*)lds_raw + wave * 256; float* si_ = sb_ + 64; float* smt = si_ + 64;
  const int gw = cx.bid * 8 + wave, NGW = cx.nb * 8;
  for (int u = gw; u < NSEQ * NCH; u += NGW) {
    const int seq = u / NCH, st = u % NCH, x = (seq >> 2) & 1, h = seq & 3, bl = seq >> 3;
    const int nc = ml_nchunk(x, st), tok0 = nc * 64;
    const int nl0 = ml_nchunk(x, lane), nl1 = ml_nchunk(x, 64 + (lane & 3));
    const float g0 = GC[seq * NCH + nl0], a0 = AC[seq * NCH + nl0], g1 = GC[seq * NCH + nl1], a1 = AC[seq * NCH + nl1];
    const int tl = x == 0 ? lane : 63 - lane;
    const float b = BL[(size_t)seq * TOKB + tok0 + tl], ig = IG[(size_t)seq * TOKB + tok0 + tl];
    float mc = 0.f;
    for (int s2 = 0; s2 < st; ++s2) {
      const float gg = __int_as_float(__builtin_amdgcn_readlane(__float_as_int(s2 < 64 ? g0 : g1), s2 & 63));
      const float aa = __int_as_float(__builtin_amdgcn_readlane(__float_as_int(s2 < 64 ? a0 : a1), s2 & 63));
      mc = fmaxf(gg + mc, aa);
    }
    const float gc = __int_as_float(__builtin_amdgcn_readlane(__float_as_int(st < 64 ? g0 : g1), st & 63));
    const float ac = __int_as_float(__builtin_amdgcn_readlane(__float_as_int(st < 64 ? a0 : a1), st & 63));
    const float mnew = fmaxf(gc + mc, ac);
    float cm = ig - b;
#pragma unroll
    for (int o = 1; o < 64; o <<= 1) { const float t2 = shi(cm, lane - o); if (lane >= o) cm = fmaxf(cm, t2); }
    const float mt = b + fmaxf(mc, cm);
    sb_[tl] = b; si_[tl] = ig; smt[tl] = mt;
    WIN[(size_t)seq * TOKB + tok0 + tl] = __expf(b + mc - mt);
    FLO[(size_t)seq * TOKB + tok0 + tl] = __expf(-mt);
    WSS[(size_t)seq * TOKB + tok0 + tl] = __expf(gc - b + ig - mnew);
    if (lane == 0) DEC[seq * NCH + nc] = __expf(gc + mc - mnew);
    f32x4 acc[4][4];
#pragma unroll
    for (int a = 0; a < 4; ++a)
#pragma unroll
      for (int c2 = 0; c2 < 4; ++c2) acc[a][c2] = (f32x4){0.f, 0.f, 0.f, 0.f};
    const bf16_t* rowp[4];
#pragma unroll
    for (int a = 0; a < 4; ++a) rowp[a] = QK + (size_t)ml_lrow(bl, tok0 + a * 16 + fr) * 4096 + h * DH + fq * 8;
#pragma unroll 2
    for (int ks = 0; ks < 16; ++ks) {
      bf16x8 kf[4], qf[4];
#pragma unroll
      for (int a = 0; a < 4; ++a) { kf[a] = *(const bf16x8*)(rowp[a] + 2048 + ks * 32); qf[a] = *(const bf16x8*)(rowp[a] + ks * 32); }
#pragma unroll
      for (int a = 0; a < 4; ++a)
#pragma unroll
        for (int c2 = 0; c2 < 4; ++c2) acc[a][c2] = MFMA16(kf[a], qf[c2], acc[a][c2]);
    }
    __builtin_amdgcn_wave_barrier(); asm volatile("s_waitcnt lgkmcnt(0)" ::: "memory");
    bf16_t* spu = SP + (size_t)(seq * NCH + nc) * 4096;
#pragma unroll
    for (int tb = 0; tb < 4; ++tb) {
      const int t = tb * 16 + fr;
      const float bt = sb_[t], mtt = smt[t];
      float dsum = 0.f;
#pragma unroll
      for (int sbk = 0; sbk < 4; ++sbk) {
        float vals[4];
#pragma unroll
        for (int jj = 0; jj < 4; ++jj) {
          const int s = sbk * 16 + 4 * fq + jj;
          const bool ok = x == 0 ? (s <= t) : (s >= t);
          vals[jj] = ok ? acc[sbk][tb][jj] * __expf(bt - sb_[s] + si_[s] - mtt) : 0.f;
        }
        u32x2 o; o.x = pk2(vals[0], vals[1]); o.y = pk2(vals[2], vals[3]);
        *(u32x2*)(spu + tb * 1024 + ((sbk * 16 + 4 * fq) >> 5) * 512 + fr * 32 + ((sbk * 16 + 4 * fq) & 31)) = o;
        dsum += (bflo(o.x) + bfhi(o.x)) + (bflo(o.y) + bfhi(o.y));
      }
      dsum += shx(dsum, 16, lane); dsum += shx(dsum, 32, lane);
      if (fq == 0) DEN[(size_t)seq * TOKB + tok0 + t] = dsum;
    }
    __builtin_amdgcn_wave_barrier(); asm volatile("s_waitcnt lgkmcnt(0)" ::: "memory");
  }
}

constexpr int NEB = 2, NSL = 512 / (16 * NEB);
__device__ __forceinline__ void ml_m2(const Params& p, const Ctx& cx) {
  const int tid = cx.tid, lane = tid & 63, wave = tid >> 6, fr = lane & 15, fq = lane >> 4;
  char* ws = cx.ws;
  const bf16_t* QK = (const bf16_t*)(ws + O_QK); const bf16_t* KT = (const bf16_t*)(ws + O_KT); const bf16_t* VT = (const bf16_t*)(ws + O_VT);
  const bf16_t* SP = (const bf16_t*)(ws + O_SP); const bf16_t* QF = (const bf16_t*)(ws + O_QF);
  bf16_t* HD = (bf16_t*)(ws + O_HD);
  const float* WIN = (const float*)(ws + O_WIN); const float* FLO = (const float*)(ws + O_FLO); const float* DEN = (const float*)(ws + O_DEN); const float* WSS = (const float*)(ws + O_WSS);
  const float* DEC = (const float*)(ws + O_GC) + 2 * NSEQ * NCH;
  f32x4* red = (f32x4*)lds_raw;
  f32x4* rn = (f32x4*)(lds_raw + 131072);
  for (int idx = cx.bid >> 3; idx < 2 * NSL; idx += cx.nb >> 3) {
    const int seq = (cx.bid & 7) * 2 + idx / NSL, es = idx % NSL, x = (seq >> 2) & 1, h = seq & 3, bl = seq >> 3;
    const int d0 = wave * 64, e0 = es * 16 * NEB;
    f32x4 C[4][NEB + 1];
#pragma unroll
    for (int a = 0; a < 4; ++a)
#pragma unroll
      for (int b = 0; b < NEB + 1; ++b) C[a][b] = (f32x4){0.f, 0.f, 0.f, 0.f};
    const int tbo = wave >> 1, ebo = __builtin_amdgcn_readfirstlane(wave & 1);
    bf16x8 qc[4][2], kf[4][2], sf0, sf1;
    u32x4 vr[NEB][2];
    f32x4 wv[2][2];
#define M2_LOAD_Q(ST) do { const int _nq = ml_nchunk(x, (ST)); _Pragma("unroll") for (int tb = 0; tb < 4; ++tb) { \
        const bf16_t* qp = QF + ((((((size_t)bl * NCH + _nq) * 4 + h) * 8 + wave) * 4 + tb) * 2) * 512 + fr * 32 + 8 * fq; \
        qc[tb][0] = *(const bf16x8*)qp; qc[tb][1] = *(const bf16x8*)(qp + 512); } } while (0)
#define M2_LOAD_KV(ST) do { const int _nc = ml_nchunk(x, (ST)), _t0 = _nc * 64; \
        _Pragma("unroll") for (int db = 0; db < 4; ++db) { const bf16_t* kp = KT + (((size_t)bl * NCH + _nc) * (EI / 16) + ((h * DH + d0) >> 4) + db) * 1024 + fr * 32 + 8 * fq; \
          kf[db][0] = *(const bf16x8*)kp; kf[db][1] = *(const bf16x8*)(kp + 512); } \
        _Pragma("unroll") for (int eb = 0; eb < NEB; ++eb) { const bf16_t* vp = VT + (((size_t)bl * NCH + _nc) * (EI / 16) + ((h * DH + e0) >> 4) + eb) * 1024 + fr * 32 + 8 * fq; \
          vr[eb][0] = *(const u32x4*)vp; vr[eb][1] = *(const u32x4*)(vp + 512); } \
        _Pragma("unroll") for (int ks = 0; ks < 2; ++ks) { const float* wp = WSS + (size_t)seq * TOKB + _t0 + 32 * ks + 8 * fq; \
          wv[ks][0] = *(const f32x4*)wp; wv[ks][1] = *(const f32x4*)(wp + 4); } \
        const bf16_t* sp = SP + (size_t)(seq * NCH + _nc) * 4096 + tbo * 1024 + fr * 32 + 8 * fq; \
        sf0 = *(const bf16x8*)sp; sf1 = *(const bf16x8*)(sp + 512); } while (0)
    M2_LOAD_Q(0); M2_LOAD_KV(0);
    for (int st = 0; st < NCH; ++st) {
      const int nc = ml_nchunk(x, st), tok0 = nc * 64, stn = st + 1 < NCH ? st + 1 : st;
      const size_t tix = (size_t)seq * TOKB + tok0 + tbo * 16 + 4 * fq;
      const f32x4 win = *(const f32x4*)(WIN + tix), flo = *(const f32x4*)(FLO + tix), deni = *(const f32x4*)(DEN + tix);
      const float decay = DEC[seq * NCH + nc];
#pragma unroll
      for (int eb = 0; eb < NEB + 1; ++eb) {
        bf16x8 cb0, cb1;
        { const f32x4 lo = C[0][eb], hi = C[1][eb]; cb0 = mk8((u32x4){pk2(lo[0], lo[1]), pk2(lo[2], lo[3]), pk2(hi[0], hi[1]), pk2(hi[2], hi[3])}); }
        { const f32x4 lo = C[2][eb], hi = C[3][eb]; cb1 = mk8((u32x4){pk2(lo[0], lo[1]), pk2(lo[2], lo[3]), pk2(hi[0], hi[1]), pk2(hi[2], hi[3])}); }
        f32x4 pa[4];
#pragma unroll
        for (int tb = 0; tb < 4; ++tb) pa[tb] = MFMA16(qc[tb][0], cb0, ((f32x4){0.f, 0.f, 0.f, 0.f}));
#pragma unroll
        for (int tb = 0; tb < 4; ++tb) pa[tb] = MFMA16(qc[tb][1], cb1, pa[tb]);
#pragma unroll
        for (int tb = 0; tb < 4; ++tb) {
          if (eb < NEB) red[((wave * 4 + tb) * NEB + eb) * 64 + lane] = pa[tb];
          else if (fr == 0) rn[(wave * 4 + tb) * 4 + fq] = pa[tb];
        }
      }
      M2_LOAD_Q(stn);
      f32x4 oi = {0.f, 0.f, 0.f, 0.f};
#pragma unroll
      for (int eb = 0; eb < NEB + 1; ++eb) {
        bf16x8 vw0, vw1;
        if (eb < NEB) {
          const u32x4 r0 = vr[eb][0], r1 = vr[eb][1];
          if (eb == ebo) { oi = MFMA16(sf0, mk8(r0), oi); oi = MFMA16(sf1, mk8(r1), oi); }
          vw0 = mk8((u32x4){pk2(bflo(r0.x) * wv[0][0][0], bfhi(r0.x) * wv[0][0][1]), pk2(bflo(r0.y) * wv[0][0][2], bfhi(r0.y) * wv[0][0][3]),
                            pk2(bflo(r0.z) * wv[0][1][0], bfhi(r0.z) * wv[0][1][1]), pk2(bflo(r0.w) * wv[0][1][2], bfhi(r0.w) * wv[0][1][3])});
          vw1 = mk8((u32x4){pk2(bflo(r1.x) * wv[1][0][0], bfhi(r1.x) * wv[1][0][1]), pk2(bflo(r1.y) * wv[1][0][2], bfhi(r1.y) * wv[1][0][3]),
                            pk2(bflo(r1.z) * wv[1][1][0], bfhi(r1.z) * wv[1][1][1]), pk2(bflo(r1.w) * wv[1][1][2], bfhi(r1.w) * wv[1][1][3])});
        } else {
          vw0 = mk8((u32x4){pk2(wv[0][0][0], wv[0][0][1]), pk2(wv[0][0][2], wv[0][0][3]), pk2(wv[0][1][0], wv[0][1][1]), pk2(wv[0][1][2], wv[0][1][3])});
          vw1 = mk8((u32x4){pk2(wv[1][0][0], wv[1][0][1]), pk2(wv[1][0][2], wv[1][0][3]), pk2(wv[1][1][0], wv[1][1][1]), pk2(wv[1][1][2], wv[1][1][3])});
        }
#pragma unroll
        for (int db = 0; db < 4; ++db) {
          f32x4 c = C[db][eb] * decay;
          c = MFMA16(kf[db][0], vw0, c); c = MFMA16(kf[db][1], vw1, c);
          C[db][eb] = c;
        }
      }
      asm volatile("s_waitcnt lgkmcnt(0)" ::: "memory");
      __builtin_amdgcn_s_barrier();
      asm volatile("" ::: "memory");
      f32x4 rdn[8], rd0[8];
#pragma unroll
      for (int w = 0; w < 8; ++w) { rdn[w] = rn[(w * 4 + tbo) * 4 + fq]; rd0[w] = red[((w * 4 + tbo) * NEB + ebo) * 64 + lane]; }
      const f32x4 pn = ((rdn[0] + rdn[1]) + (rdn[2] + rdn[3])) + ((rdn[4] + rdn[5]) + (rdn[6] + rdn[7]));
      const f32x4 pi = ((rd0[0] + rd0[1]) + (rd0[2] + rd0[3])) + ((rd0[4] + rd0[5]) + (rd0[6] + rd0[7]));
#pragma unroll
      for (int jj = 0; jj < 4; ++jj) {
        const float num = oi[jj] + win[jj] * pi[jj], den = deni[jj] + win[jj] * pn[jj];
        const float hv = num * __builtin_amdgcn_rcpf(fmaxf(fabsf(den), flo[jj]));
        HD[((size_t)x * RG + ml_lrow(bl, tok0 + tbo * 16 + 4 * fq + jj)) * EI + h * DH + e0 + ebo * 16 + fr] = (bf16_t)(pk2(hv, 0.f) & 0xffff);
      }
      M2_LOAD_KV(stn);
      asm volatile("s_waitcnt lgkmcnt(0)" ::: "memory");
      __builtin_amdgcn_s_barrier();
      asm volatile("" ::: "memory");
    }
    __syncthreads();
#undef M2_LOAD_Q
#undef M2_LOAD_KV
  }
}

__device__ __forceinline__ void ml_fin(const Params& p, const Ctx& cx, int j) {
  const int lane = cx.tid & 63, gw = cx.bid * 8 + (cx.tid >> 6), NGW = cx.nb * 8;
  char* ws = cx.ws;
  const bf16_t* XZ = (const bf16_t*)(ws + O_XZ); const bf16_t* HD = (const bf16_t*)(ws + O_HD);
  bf16_t* FIN = (bf16_t*)(ws + O_FIN);
  for (int u = gw; u < RG * 4; u += NGW) {
    const int lr = u >> 2, h = u & 3, f0 = h * DH + lane * 8;
    int pos, seglen;
    if (lr < GB * SEQ) { pos = lr & (SEQ - 1); seglen = SEQ; } else { pos = (lr - GB * SEQ) & (LC - 1); seglen = LC; }
    const u32x4 hf = *(const u32x4*)(HD + (size_t)lr * EI + f0), hb = *(const u32x4*)(HD + ((size_t)RG + lr) * EI + f0);
    const u32x4 zz = *(const u32x4*)(XZ + (size_t)lr * 4096 + 2048 + f0);
    const u32x4 x1 = *(const u32x4*)(XZ + (size_t)lr * 4096 + f0);
    u32x4 x0 = {0u, 0u, 0u, 0u}, x2 = {0u, 0u, 0u, 0u};
    if (pos > 0) x0 = *(const u32x4*)(XZ + (size_t)(lr - 1) * 4096 + f0);
    if (pos < seglen - 1) x2 = *(const u32x4*)(XZ + (size_t)(lr + 1) * 4096 + f0);
    float hv[8], xm0[8], xm1[8], xm2[8];
    const unsigned hfu[4] = {hf.x, hf.y, hf.z, hf.w}, hbu[4] = {hb.x, hb.y, hb.z, hb.w}, zu[4] = {zz.x, zz.y, zz.z, zz.w};
    const unsigned x0u[4] = {x0.x, x0.y, x0.z, x0.w}, x1u[4] = {x1.x, x1.y, x1.z, x1.w}, x2u[4] = {x2.x, x2.y, x2.z, x2.w};
    float s = 0.f;
#pragma unroll
    for (int i = 0; i < 4; ++i) {
      hv[2 * i] = (bflo(hfu[i]) + bflo(hbu[i])) * sigm_f(bflo(zu[i]));
      hv[2 * i + 1] = (bfhi(hfu[i]) + bfhi(hbu[i])) * sigm_f(bfhi(zu[i]));
      xm0[2 * i] = bflo(x0u[i]); xm0[2 * i + 1] = bfhi(x0u[i]); xm1[2 * i] = bflo(x1u[i]); xm1[2 * i + 1] = bfhi(x1u[i]); xm2[2 * i] = bflo(x2u[i]); xm2[2 * i + 1] = bfhi(x2u[i]);
      s += hv[2 * i] + hv[2 * i + 1];
    }
    const float mean = wave_sum(s, lane) * (1.f / DH); float s2 = 0.f;
#pragma unroll
    for (int i = 0; i < 8; ++i) { hv[i] -= mean; s2 += hv[i] * hv[i]; }
    const float rstd = __builtin_amdgcn_rsqf(wave_sum(s2, lane) * (1.f / DH) + LN_EPS);
    float o[8];
#pragma unroll
    for (int i = 0; i < 8; ++i) {
      const int f = f0 + i;
      const float xc = silu_f(IN(11)[(size_t)(j * 3 + 0) * EI + f] * xm0[i] + IN(11)[(size_t)(j * 3 + 1) * EI + f] * xm1[i] + IN(11)[(size_t)(j * 3 + 2) * EI + f] * xm2[i] + IN(12)[(size_t)j * EI + f]);
      o[i] = hv[i] * rstd * IN(17)[(size_t)j * EI + f] + IN(16)[(size_t)j * EI + f] * xc;
    }
    u32x4 ov; ov.x = pk2(o[0], o[1]); ov.y = pk2(o[2], o[3]); ov.z = pk2(o[4], o[5]); ov.w = pk2(o[6], o[7]);
    *(u32x4*)(FIN + (size_t)lr * EI + f0) = ov;
  }
}

__device__ __forceinline__ void at_prep(const Params& p, const Ctx& cx) {
  const int lane = cx.tid & 63, gw = cx.bid * 8 + (cx.tid >> 6), NGW = cx.nb * 8;
  char* ws = cx.ws;
  bf16_t* ACT = (bf16_t*)(ws + O_ACT); bf16_t* KR = (bf16_t*)(ws + O_AKR); bf16_t* VT = (bf16_t*)(ws + O_AVT);
  const float* rc = (const float*)(ws + O_ROPE); const float* rs = rc + 4096 * 32;
  for (int row = gw; row < MROWS; row += NGW) {
    const bool lat = row < NLAT;
    const int b = lat ? row >> 12 : (row - NLAT) >> 8, pos = lat ? row & 4095 : (row - NLAT) & 255, tok = lat ? LC + pos : pos;
    bf16_t* rp = ACT + (size_t)row * 1536;
    {
      const u32x4 a = *(const u32x4*)(rp + 16 * lane), b2 = *(const u32x4*)(rp + 16 * lane + 8);
      const unsigned w[8] = {a.x, a.y, a.z, a.w, b2.x, b2.y, b2.z, b2.w};
      unsigned o[8];
      const int pp0 = (lane & 3) * 8;
#pragma unroll
      for (int i = 0; i < 8; ++i) {
        float x1 = bflo(w[i]) * 0.125f, x2 = bfhi(w[i]) * 0.125f;
        if (lat) { const float c = rc[pos * 32 + pp0 + i], s = rs[pos * 32 + pp0 + i]; const float y1 = x1 * c - x2 * s, y2 = x1 * s + x2 * c; x1 = y1; x2 = y2; }
        o[i] = pk2(x1, x2);
      }
      *(u32x4*)(rp + 16 * lane) = (u32x4){o[0], o[1], o[2], o[3]}; *(u32x4*)(rp + 16 * lane + 8) = (u32x4){o[4], o[5], o[6], o[7]};
    }
    {
      const u32x2 a = *(const u32x2*)(rp + 1024 + 4 * lane);
      const unsigned w[2] = {a.x, a.y}; unsigned o[2];
      const int g = lane >> 4, dd = (lane & 15) * 4, pp0 = dd >> 1;
#pragma unroll
      for (int i = 0; i < 2; ++i) {
        float x1 = bflo(w[i]), x2 = bfhi(w[i]);
        if (lat) { const float c = rc[pos * 32 + pp0 + i], s = rs[pos * 32 + pp0 + i]; const float y1 = x1 * c - x2 * s, y2 = x1 * s + x2 * c; x1 = y1; x2 = y2; }
        o[i] = pk2(x1, x2);
      }
      *(u32x2*)(KR + (((size_t)b * 4 + g) * TOKB + tok) * 64 + dd) = (u32x2){o[0], o[1]};
      const u32x2 v = *(const u32x2*)(rp + 1280 + 4 * lane);
      bf16_t* vp = VT + (((size_t)b * 4 + g) * 64 + dd) * TOKB + tok;
      vp[0] = (bf16_t)(v.x & 0xffff); vp[TOKB] = (bf16_t)(v.x >> 16); vp[2 * TOKB] = (bf16_t)(v.y & 0xffff); vp[3 * TOKB] = (bf16_t)(v.y >> 16);
    }
  }
}

__device__ __forceinline__ void at_core(const Params& p, const Ctx& cx) {
  const int lane = cx.tid & 63, gw = cx.bid * 8 + (cx.tid >> 6), NGW = cx.nb * 8, fr = lane & 15, fq = lane >> 4;
  char* ws = cx.ws;
  const bf16_t* ACT = (const bf16_t*)(ws + O_ACT); const bf16_t* KR = (const bf16_t*)(ws + O_AKR); const bf16_t* VT = (const bf16_t*)(ws + O_AVT);
  bf16_t* O = (bf16_t*)(ws + O_U);
  for (int u = gw; u < (MROWS / 16) * 4; u += NGW) {
    const int g = u & 3, qb = u >> 2, row0 = qb * 16;
    const bool lat = row0 < NLAT;
    const int b = lat ? row0 >> 12 : (row0 - NLAT) >> 8, q0 = lat ? row0 & 4095 : 0;
    bf16x8 qf[4][2];
    float mrun[4], lrun[4], sink[4];
    f32x4 oacc[4][4];
#pragma unroll
    for (int hh = 0; hh < 4; ++hh) {
      const bf16_t* qp = ACT + (size_t)(row0 + fr) * 1536 + (g * 4 + hh) * 64 + 8 * fq;
      qf[hh][0] = *(const bf16x8*)qp; qf[hh][1] = *(const bf16x8*)(qp + 32);
      sink[hh] = IN(20)[g * 4 + hh]; mrun[hh] = sink[hh]; lrun[hh] = 0.f;
#pragma unroll
      for (int d2 = 0; d2 < 4; ++d2) oacc[hh][d2] = (f32x4){0.f, 0.f, 0.f, 0.f};
    }
    const bf16_t* kbase = KR + ((size_t)b * 4 + g) * TOKB * 64;
    const bf16_t* vbase = VT + ((size_t)b * 4 + g) * 64 * TOKB;
    int wlo = 0, whi = -1;
    if (lat) { wlo = max(0, q0 - 128) & ~31; whi = min(SEQ - 1, q0 + 143); }
    const int nwin = lat ? (whi - wlo) / 32 + 1 : 0;
    for (int ti = 0; ti < 8 + nwin; ++ti) {
      const bool isw = ti >= 8;
      const int kpos0 = isw ? wlo + (ti - 8) * 32 : 0;
      const int tk0 = isw ? LC + kpos0 : ti * 32;
      const bf16_t* kp = kbase + (size_t)(tk0 + fr) * 64 + 8 * fq;
      const bf16x8 k00 = *(const bf16x8*)kp, k01 = *(const bf16x8*)(kp + 32), k10 = *(const bf16x8*)(kp + 16 * 64), k11 = *(const bf16x8*)(kp + 16 * 64 + 32);
      bf16x8 vfr[4];
#pragma unroll
      for (int d2 = 0; d2 < 4; ++d2) {
        const bf16_t* vp = vbase + (size_t)(d2 * 16 + fr) * TOKB + tk0 + 4 * fq;
        vfr[d2] = mk8(*(const u32x2*)vp, *(const u32x2*)(vp + 16));
      }
      bool okm[8];
#pragma unroll
      for (int i = 0; i < 8; ++i) {
        const int kpos = kpos0 + (i >> 2) * 16 + 4 * fq + (i & 3), dlt = (q0 + fr) - kpos;
        okm[i] = !isw || (dlt <= 128 && dlt >= -128);
      }
#pragma unroll
      for (int hh = 0; hh < 4; ++hh) {
        f32x4 s0 = {0.f, 0.f, 0.f, 0.f}, s1 = {0.f, 0.f, 0.f, 0.f};
        s0 = MFMA16(k00, qf[hh][0], s0); s0 = MFMA16(k01, qf[hh][1], s0);
        s1 = MFMA16(k10, qf[hh][0], s1); s1 = MFMA16(k11, qf[hh][1], s1);
        float sv[8]; float tmax = -3.0e38f;
#pragma unroll
        for (int i = 0; i < 8; ++i) { sv[i] = okm[i] ? (i < 4 ? s0[i] : s1[i - 4]) : -3.0e38f; tmax = fmaxf(tmax, sv[i]); }
        tmax = fmaxf(tmax, shx(tmax, 16, lane)); tmax = fmaxf(tmax, shx(tmax, 32, lane));
        const float mnew = fmaxf(mrun[hh], tmax), scale = __expf(mrun[hh] - mnew);
        mrun[hh] = mnew;
        float pv[8];
#pragma unroll
        for (int i = 0; i < 8; ++i) pv[i] = okm[i] ? __expf(sv[i] - mnew) : 0.f;
        const u32x4 pu = {pk2(pv[0], pv[1]), pk2(pv[2], pv[3]), pk2(pv[4], pv[5]), pk2(pv[6], pv[7])};
        const float ps = ((bflo(pu.x) + bfhi(pu.x)) + (bflo(pu.y) + bfhi(pu.y))) + ((bflo(pu.z) + bfhi(pu.z)) + (bflo(pu.w) + bfhi(pu.w)));
        lrun[hh] = lrun[hh] * scale + ps;
        const bf16x8 pf = mk8(pu);
        float scq[4];
#pragma unroll
        for (int jj = 0; jj < 4; ++jj) scq[jj] = shi(scale, 4 * fq + jj);
#pragma unroll
        for (int d2 = 0; d2 < 4; ++d2) {
          f32x4 o = oacc[hh][d2];
          o[0] *= scq[0]; o[1] *= scq[1]; o[2] *= scq[2]; o[3] *= scq[3];
          oacc[hh][d2] = MFMA16(pf, vfr[d2], o);
        }
      }
    }
#pragma unroll
    for (int hh = 0; hh < 4; ++hh) {
      float l = lrun[hh];
      l += shx(l, 16, lane); l += shx(l, 32, lane);
      l += __expf(sink[hh] - mrun[hh]);
      const float inv = __builtin_amdgcn_rcpf(l);
      float iq[4];
#pragma unroll
      for (int jj = 0; jj < 4; ++jj) iq[jj] = shi(inv, 4 * fq + jj);
#pragma unroll
      for (int d2 = 0; d2 < 4; ++d2)
#pragma unroll
        for (int jj = 0; jj < 4; ++jj)
          O[(size_t)(row0 + 4 * fq + jj) * D + (g * 4 + hh) * 64 + d2 * 16 + fr] = (bf16_t)(pk2(oacc[hh][d2][jj] * iq[jj], 0.f) & 0xffff);
    }
  }
}

__device__ __forceinline__ void sc_conv(const Params& p, const Ctx& cx) {
  const int gt = cx.bid * 512 + cx.tid, gs = cx.nb * 512;
  const bf16_t* ACT = (const bf16_t*)(cx.ws + O_ACT); bf16_t* O = (bf16_t*)(cx.ws + O_U);
  const float* cw = IN(23);
  for (int i = gt; i < MROWS * 128; i += gs) {
    const int row = i >> 7, c0 = (i & 127) * 8;
    int pos, seglen;
    if (row < NLAT) { pos = row & (SEQ - 1); seglen = SEQ; } else { pos = (row - NLAT) & (LC - 1); seglen = LC; }
    float accv[8];
#pragma unroll
    for (int e = 0; e < 8; ++e) accv[e] = 0.f;
#pragma unroll
    for (int k = 0; k < 3; ++k) {
      const int pp = pos + k - 1;
      if (pp < 0 || pp >= seglen) continue;
      const bf16_t* rp = ACT + (size_t)(row + k - 1) * 3072;
      const u32x4 cgv = *(const u32x4*)(rp + 1024 + c0), xtv = *(const u32x4*)(rp + 2048 + c0);
      const unsigned cu[4] = {cgv.x, cgv.y, cgv.z, cgv.w}, xu[4] = {xtv.x, xtv.y, xtv.z, xtv.w};
#pragma unroll
      for (int e = 0; e < 4; ++e) {
        accv[2 * e] += cw[k * D + c0 + 2 * e] * (bflo(cu[e]) * bflo(xu[e]));
        accv[2 * e + 1] += cw[k * D + c0 + 2 * e + 1] * (bfhi(cu[e]) * bfhi(xu[e]));
      }
    }
    const u32x4 bgv = *(const u32x4*)(ACT + (size_t)row * 3072 + c0);
    const unsigned bu[4] = {bgv.x, bgv.y, bgv.z, bgv.w};
    u32x4 o;
    o.x = pk2(bflo(bu[0]) * accv[0], bfhi(bu[0]) * accv[1]); o.y = pk2(bflo(bu[1]) * accv[2], bfhi(bu[1]) * accv[3]);
    o.z = pk2(bflo(bu[2]) * accv[4], bfhi(bu[2]) * accv[5]); o.w = pk2(bflo(bu[3]) * accv[6], bfhi(bu[3]) * accv[7]);
    *(u32x4*)(O + (size_t)row * D + c0) = o;
  }
}

#define XB_TMO      128
#define XB_XCNT(j)  (256  + 64 * (j))
#define XB_XSUB(j)  (1280 + 64 * (j))
#define XB_XGEN(j)  (2304 + 64 * (j))
#define XB_TOP      3328
#define XB_TOPGEN   3392
#define XCD_BAR_WORDS 3456
#define XB_SPIN_CAP (1u << 18)
__device__ __forceinline__ unsigned xb_ld(unsigned* p)              { return __hip_atomic_load(p, __ATOMIC_RELAXED, __HIP_MEMORY_SCOPE_AGENT); }
__device__ __forceinline__ unsigned xb_add(unsigned* p, unsigned v) { return __hip_atomic_fetch_add(p, v, __ATOMIC_RELAXED, __HIP_MEMORY_SCOPE_AGENT); }
__device__ __forceinline__ unsigned xb_xcc_id() { return (unsigned)__builtin_amdgcn_s_getreg((3 << 11) | 20) & 0xFu; }
#define XB_SPIN(cond, bar) do { unsigned _sp = 0; while (cond) { __builtin_amdgcn_s_sleep(1); \
    if ((++_sp & 255u) == 0u) { if (xb_ld(&(bar)[XB_TMO])) break; if (_sp > XB_SPIN_CAP) { atomicAdd(&(bar)[XB_TMO], 1u); break; } } } } while (0)
__device__ __forceinline__ void xcd_barrier_complete(unsigned* bar, unsigned x, unsigned& nloc, unsigned& nx) {
  const unsigned G = gridDim.x;
  unsigned sum, cnt, mine, sp = 0u;
  for (;;) {
    sum = 0u; cnt = 0u; mine = 0u;
#pragma unroll
    for (unsigned j = 0; j < 16; ++j) { const unsigned c = xb_ld(&bar[XB_XCNT(j)]); sum += c; cnt += (c > 0u) ? 1u : 0u; mine = (j == x) ? c : mine; }
    if (sum == G) break;
    __builtin_amdgcn_s_sleep(1);
    if ((++sp & 255u) == 0u) { if (xb_ld(&bar[XB_TMO])) break; if (sp > XB_SPIN_CAP) { atomicAdd(&bar[XB_TMO], 1u); break; } }
  }
  nloc = mine > 0u ? mine : 1u; nx = cnt > 0u ? cnt : 1u;
}
__device__ __forceinline__ void xcd_barrier(unsigned* bar, unsigned x, volatile LAS unsigned* st) {
  asm volatile("s_waitcnt vmcnt(0)" ::: "memory");
  __syncthreads();
  if (threadIdx.x == 0) {
    __builtin_amdgcn_s_waitcnt(0);
    unsigned nloc = st[0], nx = st[1];
    if (nloc == 0u) { xcd_barrier_complete(bar, x, nloc, nx); st[0] = nloc; st[1] = nx; }
    const unsigned old = xb_add(&bar[XB_XSUB(x)], 1u);
    const unsigned gen = old / nloc;
    if (old + 1u == (gen + 1u) * nloc) {
      __builtin_amdgcn_fence(__ATOMIC_RELEASE, "agent");
      asm volatile("s_waitcnt vmcnt(0)" ::: "memory");
      const unsigned og = xb_add(&bar[XB_TOP], 1u);
      const unsigned tg = og / nx;
      if (og + 1u == (tg + 1u) * nx) xb_add(&bar[XB_TOPGEN], 1u);
      else XB_SPIN(xb_ld(&bar[XB_TOPGEN]) == tg, bar);
      __builtin_amdgcn_fence(__ATOMIC_ACQUIRE, "agent");
      xb_add(&bar[XB_XGEN(x)], 1u);
      asm volatile("s_waitcnt vmcnt(0)" ::: "memory");
    } else {
      XB_SPIN(xb_ld(&bar[XB_XGEN(x)]) == gen, bar);
      __builtin_amdgcn_fence(__ATOMIC_ACQUIRE, "agent");
      asm volatile("s_waitcnt vmcnt(0)" ::: "memory");
    }
  }
  __syncthreads();
}

#ifndef ENMASK
#define ENMASK 0xffff
#endif
#define EN(i) ((ENMASK >> (i)) & 1)
enum { OP_PRO = 0, OP_LN0, OP_LN1, OP_LNF, OP_FFI, OP_FFO, OP_UP, OP_M0, OP_GAT, OP_S, OP_M2, OP_FIN, OP_DN, OP_AQ, OP_APREP, OP_ACORE, OP_AO, OP_SI, OP_SCONV, OP_SO, OP_DNUP };
__global__ void __launch_bounds__(512) fwd_megakernel(Params p) {
  cg::grid_group grid = cg::this_grid();
  const int wave_s = __builtin_amdgcn_readfirstlane((int)threadIdx.x >> 6);
  volatile LAS unsigned* xst = (volatile LAS unsigned*)((LAS unsigned char*)lds_raw + (LDS_BYTES - 16));
  if (threadIdx.x == 0) { xst[0] = 0u; xst[1] = 0u; }
  __syncthreads();
  unsigned* xbar = (unsigned*)(p.ws + O_BAR);
  const unsigned xcc = xb_xcc_id();
  if (threadIdx.x == 0) (void)xb_add(&xbar[XB_XCNT(xcc)], 1u);
#ifdef DUP_OP
  int rep = 0;
#endif
  for (int ph = 0; ph < p.nph; ++ph) {
    const unsigned w = p.prog[ph];
    const int op = w & 255, a = (w >> 8) & 255, b = (w >> 16) & 255, c = (w >> 24) & 255;
#define MKCTX int z; asm volatile("s_mov_b32 %0, 0" : "=s"(z)); \
    GAS char* wsq = (GAS char*)p.ws; GAS float* outq = (GAS float*)p.out; int bidq = (int)blockIdx.x, nbq = (int)gridDim.x; \
    asm volatile("" : "+s"(wsq), "+s"(outq), "+s"(bidq), "+s"(nbq)); \
    const Ctx cx{wave_s * 64 + (int)__builtin_amdgcn_mbcnt_hi(~0u, __builtin_amdgcn_mbcnt_lo(~0u, (unsigned)z)), bidq, nbq, z, (char*)wsq, (float*)outq};
    if (EN(0) && op == OP_PRO) { MKCTX prologue(p, cx); }
    else if (EN(1) && op == OP_LN0) { MKCTX lnmod_phase<0>(p, cx, 0, 0, 0); }
    else if (EN(1) && op == OP_LN1) { MKCTX lnmod_phase<1>(p, cx, a, b, c); }
    else if (EN(1) && op == OP_LNF) { MKCTX lnmod_phase<2>(p, cx, a, 0, 0); }
    else if (EN(2) && op == OP_M0) { MKCTX ml_m0(p, cx, a); }
    else if (EN(3) && op == OP_GAT) { MKCTX ml_gates(p, cx, a); }
    else if (EN(4) && op == OP_S) { MKCTX ml_s(p, cx); }
    else if (EN(5) && op == OP_M2) { MKCTX ml_m2(p, cx); }
    else if (EN(6) && op == OP_FIN) { MKCTX ml_fin(p, cx, a); }
    else if (EN(7) && op == OP_APREP) { MKCTX at_prep(p, cx); }
    else if (EN(8) && op == OP_ACORE) { MKCTX at_core(p, cx); }
    else if (EN(9) && op == OP_SCONV) { MKCTX sc_conv(p, cx); }
    else if (EN(10)) {
      MKCTX
      char* ws = cx.ws;
      const RowMap idm{0, 0, 1 << 30};
      bf16_t* U = (bf16_t*)(ws + O_U); bf16_t* ACT = (bf16_t*)(ws + O_ACT);
      const float* MODT = (const float*)(ws + O_MODT);
      const int nrep = op == OP_DNUP ? 2 : 1;
      for (int rep = 0; rep < nrep; ++rep) {
        const int op2 = op == OP_DNUP ? (rep == 0 ? (int)OP_UP : (int)OP_DN) : op;
        const int c2 = (op == OP_DNUP && rep == 0) ? c + 1 : c;
        Ctx cg_ = cx;
        if (op == OP_DNUP && rep == 1) cg_.bid = (cx.bid + cx.nb - 32) % cx.nb;
        const bf16_t* A = U; const bf16_t* Bt; int K = 1024, nM = MROWS / 256, nN; RowMap am = idm, cm = idm;
        Epi E; E.kind = 2; E.O = ACT; E.ldc = 0; E.modl = MODT + (size_t)b * 9 * 9216; E.slot = 1; E.wgt = 1.0f;
        E.ln = b * 3 + 1 - 1;
        if (op2 == OP_FFI) { Bt = (const bf16_t*)(ws + O_WFI) + (size_t)a * 5632 * 1024; nN = 22; E.kind = 1; if (c) nM = NLAT / 256; }
        else if (op2 == OP_FFO) { A = ACT; Bt = (const bf16_t*)(ws + O_WFO) + (size_t)a * 1024 * 2816; K = 2816; nN = 4; E.slot = c & 3; E.wgt = 0.5f; E.ln = b * 3 + (c & 3) - 1; if (c & 4) nM = NLAT / 256; }
        else if (op2 == OP_UP) { Bt = (const bf16_t*)(ws + O_WUP) + (size_t)a * 4096 * 1024; nM = RG / 256; nN = 16; am = RowMap{c2 * GB * SEQ, NLAT + c2 * GB * LC, GB * SEQ / 256}; E.kind = 0; E.O = (bf16_t*)(ws + O_XZ); E.ldc = 4096; }
        else if (op2 == OP_DN) { A = (const bf16_t*)(ws + O_FIN); Bt = (const bf16_t*)(ws + O_WDN) + (size_t)a * 1024 * 2048; K = 2048; nM = RG / 256; nN = 4; cm = RowMap{c2 * GB * SEQ, NLAT + c2 * GB * LC, GB * SEQ / 256}; }
        else if (op2 == OP_AQ) { Bt = (const bf16_t*)(ws + O_WAQ); nN = 6; E.kind = 0; E.ldc = 1536; }
        else if (op2 == OP_AO) { Bt = (const bf16_t*)(ws + O_WAO); nN = 4; }
        else if (op2 == OP_SI) { Bt = (const bf16_t*)(ws + O_WSI); nN = 12; E.kind = 0; E.ldc = 3072; }
        else { Bt = (const bf16_t*)(ws + O_WSO); nN = 4; }
        gemm_phase(cg_, A, am, Bt, K, nM, nN, cm, E);
      }
    }
    if (ph == 0) grid.sync(); else xcd_barrier(xbar, xcc, xst);
#ifdef DUP_OP
    if (op == DUP_OP && rep + 1 < DUP_N) { ++rep; --ph; } else rep = 0;
#endif
  }
}

static int build_program(unsigned* prog) {
  int n = 0;
  auto W = [&](int op, int a, int b, int c) { prog[n++] = (unsigned)op | ((unsigned)a << 8) | ((unsigned)b << 16) | ((unsigned)c << 24); };
  W(OP_PRO, 0, 0, 0);
  W(OP_LN0, 0, 0, 0);
  for (int layer = 0; layer < DEPTH; ++layer) {
    const int kind = layer % 3, j = layer / 3;
    W(OP_FFI, layer * 2, layer, 0); W(OP_FFO, layer * 2, layer, 0);
    W(OP_LN1, layer * 3 + 0, layer, 1);
    if (kind == 0) {
      for (int g = 0; g < NG; ++g) { if (g == 0) W(OP_UP, j, layer, g); W(OP_M0, j, 0, 0); W(OP_GAT, j, 0, 0); W(OP_S, 0, 0, 0); W(OP_M2, 0, 0, 0); W(OP_FIN, j, 0, 0); W(g + 1 < NG ? OP_DNUP : OP_DN, j, layer, g); }
    } else if (kind == 1) { W(OP_AQ, 0, layer, 0); W(OP_APREP, 0, 0, 0); W(OP_ACORE, 0, 0, 0); W(OP_AO, 0, layer, 0); }
    else { W(OP_SI, 0, layer, 0); W(OP_SCONV, 0, 0, 0); W(OP_SO, 0, layer, 0); }
    W(OP_LN1, layer * 3 + 1, layer, 2);
    const int lo = (layer + 1 == DEPTH) ? 1 : 0;
    W(OP_FFI, layer * 2 + 1, layer, lo); W(OP_FFO, layer * 2 + 1, layer, 2 | (lo << 2));
    if (layer + 1 < DEPTH) W(OP_LN1, layer * 3 + 2, layer + 1, 0); else W(OP_LNF, layer * 3 + 2, 0, 0);
  }
  return n;
}

extern "C" void kernel_launch(void* const* d_in, const int* in_sizes, int n_in, void* d_out, int out_size, void* d_ws, size_t ws_size, hipStream_t stream) {
  static int grid_blocks = 0;
  if (!grid_blocks) {
    int dev = 0, cus = 0, per_cu = 0;
    (void)hipGetDevice(&dev);
    (void)hipDeviceGetAttribute(&cus, hipDeviceAttributeMultiprocessorCount, dev);
    (void)hipFuncSetAttribute((const void*)fwd_megakernel, hipFuncAttributeMaxDynamicSharedMemorySize, LDS_BYTES);
    (void)hipOccupancyMaxActiveBlocksPerMultiprocessor(&per_cu, fwd_megakernel, 512, LDS_BYTES);
    if (cus <= 0) cus = 256;
    grid_blocks = cus;
    if (ws_size < WS_END || n_in != 25) fprintf(stderr, "kernel_launch: workspace %zu < %zu or n_in %d != 25\n", ws_size, (size_t)WS_END, n_in);
    if (per_cu < 1) fprintf(stderr, "kernel_launch: occupancy query says %d blocks per CU\n", per_cu);
  }
  Params p{};
  for (int i = 0; i < 25; ++i) p.in[i] = (const float*)d_in[i];
  p.out = (float*)d_out; p.ws = (char*)d_ws;
  p.nph = build_program(p.prog);
  (void)hipMemsetAsync((char*)d_ws + O_BAR, 0, XCD_BAR_WORDS * 4, stream);
  void* args[] = {&p};
  hipError_t e = hipLaunchCooperativeKernel((void*)fwd_megakernel, dim3(grid_blocks), dim3(512), args, LDS_BYTES, stream);
  if (e != hipSuccess) fprintf(stderr, "cooperative launch failed: %s (grid %d)\n", hipGetErrorString(e), grid_blocks);
}
```

```cpp
#include <hip/hip_runtime.h>
#include <hip/hip_cooperative_groups.h>
#include <cstdio>
#include <cstdint>
namespace cg = cooperative_groups;

typedef unsigned short bf16_t;
typedef short bf16x8 __attribute__((ext_vector_type(8)));
typedef short bf16x4 __attribute__((ext_vector_type(4)));
typedef float f32x4 __attribute__((ext_vector_type(4)));
typedef unsigned u32x2 __attribute__((ext_vector_type(2)));
typedef unsigned u32x4 __attribute__((ext_vector_type(4)));

constexpr int D = 1024, NB = 8, SEQ = 4096, LC = 256, DEPTH = 4, FF = 2816, EI = 2048, DH = 512;
constexpr int NLAT = NB * SEQ, NCTX = NB * LC, MROWS = NLAT + NCTX;
constexpr int TOKB = LC + SEQ;
constexpr int NCH = TOKB / 64;
constexpr int GB = 2, NG = NB / GB, RG = GB * TOKB;
constexpr int NSEQ = GB * 8;
constexpr float ALPHA = 1.681792830507429f, LN_EPS = 1e-5f;
constexpr int LDS_BYTES = 144 * 1024;

constexpr size_t al256(size_t x) { return (x + 255) & ~(size_t)255; }
constexpr size_t O_WFI = 0;
constexpr size_t O_WFO = O_WFI + (size_t)8 * 5632 * 1024 * 2;
constexpr size_t O_WUP = O_WFO + (size_t)8 * 1024 * 2816 * 2;
constexpr size_t O_WDN = O_WUP + (size_t)2 * 4096 * 1024 * 2;
constexpr size_t O_WAQ = O_WDN + (size_t)2 * 1024 * 2048 * 2;
constexpr size_t O_WAO = O_WAQ + (size_t)1536 * 1024 * 2;
constexpr size_t O_WSI = O_WAO + (size_t)1024 * 1024 * 2;
constexpr size_t O_WSO = O_WSI + (size_t)3072 * 1024 * 2;
constexpr size_t O_WG = O_WSO + (size_t)1024 * 1024 * 2;
constexpr size_t O_MODT = O_WG + (size_t)2 * 16 * 6144 * 2;
constexpr size_t O_ROPE = O_MODT + (size_t)4 * 9 * 9216 * 4;
constexpr size_t O_HCTX = O_ROPE + (size_t)2 * 4096 * 32 * 4;
constexpr size_t O_U = O_HCTX + (size_t)NCTX * D * 4;
constexpr size_t O_R = O_U + (size_t)MROWS * D * 2;
constexpr size_t O_XZ = O_R;
constexpr size_t O_QK = O_XZ + (size_t)RG * 4096 * 2;
constexpr size_t O_KT = O_QK + (size_t)RG * 4096 * 2;
constexpr size_t O_VT = O_KT + (size_t)GB * EI * TOKB * 2;
constexpr size_t O_SP = O_VT + (size_t)GB * EI * TOKB * 2;
constexpr size_t O_HD = O_SP + (size_t)NSEQ * NCH * 4096 * 2;
constexpr size_t O_FIN = O_HD + (size_t)2 * RG * EI * 2;
constexpr size_t O_GAT = O_FIN + (size_t)RG * EI * 2;
constexpr size_t SZ_ST = (size_t)NSEQ * TOKB * 4;
constexpr size_t O_BL = O_GAT, O_IG = O_BL + SZ_ST, O_WIN = O_IG + SZ_ST, O_FLO = O_WIN + SZ_ST, O_DEN = O_FLO + SZ_ST, O_WSS = O_DEN + SZ_ST;
constexpr size_t O_GC = O_WSS + SZ_ST;
constexpr size_t O_QF = O_GC + (size_t)3 * NSEQ * NCH * 4 + 256;
constexpr size_t O_REND_ML = O_QF + (size_t)GB * EI * TOKB * 2;
constexpr size_t O_ACT = O_R;
constexpr size_t O_AKR = O_R + (size_t)MROWS * 3072 * 2;
constexpr size_t O_AVT = O_AKR + (size_t)NB * 4 * TOKB * 64 * 2;
constexpr size_t O_REND_AT = O_AVT + (size_t)NB * 4 * TOKB * 64 * 2;
constexpr size_t O_BAR = (O_REND_ML > O_REND_AT ? O_REND_ML : O_REND_AT);
constexpr size_t O_STATS = O_BAR + 3456 * 4 + 256;
constexpr size_t O_LNT = O_STATS + (size_t)MROWS * 8 + 256;
constexpr size_t WS_END = O_LNT + (size_t)12 * 2 * D * 4 + 256;

struct Params {
  const float* in[25];
  float* out;
  char* ws;
  int nph; int pad0;
  unsigned prog[126];
};

#define GAS __attribute__((address_space(1)))
#define IN(k) ((const float*)(const GAS float*)p.in[(k) + cx.z])
struct Ctx { int tid, bid, nb, z; char* ws; float* out; };
extern __shared__ __attribute__((aligned(16))) char lds_raw[];

__device__ __forceinline__ unsigned pk2(float lo, float hi) { unsigned r; asm volatile("v_cvt_pk_bf16_f32 %0, %1, %2" : "=v"(r) : "v"(lo), "v"(hi)); return r; }
__device__ __forceinline__ float bf2f(unsigned short v) { return __uint_as_float(((unsigned)v) << 16); }
__device__ __forceinline__ float bflo(unsigned v) { return __uint_as_float(v << 16); }
__device__ __forceinline__ float bfhi(unsigned v) { return __uint_as_float(v & 0xffff0000u); }
__device__ __forceinline__ float silu_f(float x) { return x * __builtin_amdgcn_rcpf(1.f + __expf(-x)); }
__device__ __forceinline__ float sigm_f(float x) { return __builtin_amdgcn_rcpf(1.f + __expf(-x)); }
__device__ __forceinline__ float shi(float v, int srclane) { return __int_as_float(__builtin_amdgcn_ds_bpermute(srclane << 2, __float_as_int(v))); }
__device__ __forceinline__ float shx(float v, int m, int lane) { return shi(v, lane ^ m); }
__device__ __forceinline__ float wave_sum(float v, int lane) {
#pragma unroll
  for (int o = 1; o < 64; o <<= 1) v += shx(v, o, lane);
  return v;
}
__device__ __forceinline__ bf16x8 mk8(u32x4 v) { union { u32x4 u; bf16x8 b; } x; x.u = v; return x.b; }
__device__ __forceinline__ bf16x8 mk8(u32x2 a, u32x2 b) { union { u32x4 u; bf16x8 b; } x; x.u = (u32x4){a.x, a.y, b.x, b.y}; return x.b; }
__device__ __forceinline__ float* hrow(const Ctx& cx, int row) { return row < NLAT ? cx.out + (size_t)row * D : (float*)(cx.ws + O_HCTX) + (size_t)(row - NLAT) * D; }
#define MFMA16(a, b, c) __builtin_amdgcn_mfma_f32_16x16x32_bf16(a, b, c, 0, 0, 0)
__device__ __forceinline__ size_t nat(int r, int c, int K) { return ((size_t)(r >> 4) * (K >> 5) + (c >> 5)) * 512 + (r & 15) * 32 + (c & 31); }

constexpr int BM = 256, BK = 64, HALF = 128, HT = HALF * BK, NXCD = 8, WGM = 8;
__device__ __forceinline__ int lds_byte(int r, int c) {
  int st = (r >> 4) * 2 + (c >> 5), rr = r & 15, cc = c & 31, ob = rr * 64 + cc * 2;
  return st * 1024 + (ob ^ (((ob >> 9) & 1) << 5));
}
__device__ __forceinline__ void stage_rc(int b, int& R, int& C) {
  int st = b / 1024, sb = b % 1024, swz = sb ^ (((sb >> 9) & 1) << 5);
  R = (st >> 1) * 16 + swz / 64; C = (st & 1) * 32 + (swz % 64) / 2;
}
struct RowMap { int lat0, ctx0, nlat; __device__ __forceinline__ int row0(int pm) const { return pm < nlat ? lat0 + pm * 256 : ctx0 + (pm - nlat) * 256; } };

typedef f32x4 Acc[2][2][4][2];

struct Epi {
  int kind; bf16_t* O; int ldc; const float* modl; int slot; float wgt;
  int ln;
};
__device__ __forceinline__ void run_epi(const Ctx& cx, const Epi E, const Acc& acc, int r0, int pn, int wr, int wc, int fr, int fq) {
  if (E.kind == 0) {
#pragma unroll
    for (int ai = 0; ai < 2; ++ai)
#pragma unroll
      for (int m = 0; m < 4; ++m) {
        bf16_t* rp = E.O + (size_t)(r0 + ai * HALF + wr * 64 + m * 16 + fr) * E.ldc + pn * 256 + wc * 32 + 4 * fq;
#pragma unroll
        for (int bj = 0; bj < 2; ++bj)
#pragma unroll
          for (int n = 0; n < 2; ++n) {
            f32x4 v = acc[ai][bj][m][n];
            u32x2 o; o.x = pk2(v[0], v[1]); o.y = pk2(v[2], v[3]);
            *(u32x2*)(rp + bj * HALF + n * 16) = o;
          }
      }
  } else if (E.kind == 1) {
#pragma unroll
    for (int ai = 0; ai < 2; ++ai)
#pragma unroll
      for (int m = 0; m < 4; ++m) {
        const int rrow = r0 + ai * HALF + wr * 64 + m * 16 + fr, fcol = pn * 128 + wc * 16 + 4 * fq;
#pragma unroll
        for (int bj = 0; bj < 2; ++bj) {
          f32x4 g = acc[ai][bj][m][0], v = acc[ai][bj][m][1];
          u32x2 o; o.x = pk2(silu_f(g[0]) * v[0], silu_f(g[1]) * v[1]); o.y = pk2(silu_f(g[2]) * v[2], silu_f(g[3]) * v[3]);
          *(u32x2*)(E.O + nat(rrow, fcol + bj * 64, FF)) = o;
        }
      }
  } else {
    const int midx = r0 < NLAT ? (r0 >> 12) : 8;
    const int cb = pn * 256 + wc * 32 + 4 * fq;
    const float* gp = E.modl + (size_t)midx * 9216 + (3 * E.slot + 2) * D + cb;
    f32x4 gv[2][2], lg[2][2], lb[2][2];
#pragma unroll
    for (int bj = 0; bj < 2; ++bj)
#pragma unroll
      for (int n = 0; n < 2; ++n) {
        gv[bj][n] = *(const f32x4*)(gp + bj * HALF + n * 16) * E.wgt;
        if (E.ln >= 0) { const float* lt = (const float*)(cx.ws + O_LNT) + (size_t)E.ln * 2 * D + cb + bj * HALF + n * 16; lg[bj][n] = *(const f32x4*)lt; lb[bj][n] = *(const f32x4*)(lt + D); }
        else { lg[bj][n] = (f32x4){1.f, 1.f, 1.f, 1.f}; lb[bj][n] = (f32x4){0.f, 0.f, 0.f, 0.f}; }
      }
#pragma unroll
    for (int ai = 0; ai < 2; ++ai)
#pragma unroll
      for (int m = 0; m < 4; ++m) {
        const int row = r0 + ai * HALF + wr * 64 + m * 16 + fr;
        float* rp = hrow(cx, row) + cb;
        float mean = 0.f, rstd = 1.f;
        if (E.ln >= 0) { const float2 st = *(const float2*)((const float*)(cx.ws + O_STATS) + (size_t)row * 2); mean = st.x; rstd = st.y; }
        f32x4 h[2][2];
#pragma unroll
        for (int bj = 0; bj < 2; ++bj)
#pragma unroll
          for (int n = 0; n < 2; ++n) h[bj][n] = *(const f32x4*)(rp + bj * HALF + n * 16);
#pragma unroll
        for (int bj = 0; bj < 2; ++bj)
#pragma unroll
          for (int n = 0; n < 2; ++n) *(f32x4*)(rp + bj * HALF + n * 16) = ((h[bj][n] - mean) * rstd) * lg[bj][n] + lb[bj][n] + gv[bj][n] * acc[ai][bj][m][n];
        __builtin_amdgcn_sched_barrier(0);
      }
  }
}

#define LAS __attribute__((address_space(3)))
__device__ __forceinline__ void gemm_phase(const Ctx& cx, const bf16_t* __restrict__ A, RowMap am, const bf16_t* __restrict__ Bt, int K, int nM, int nN, RowMap cm, const Epi epi) {
  LAS unsigned char* lds = (LAS unsigned char*)lds_raw;
  constexpr int HTB = HT * 2;
  const int tid = cx.tid, wid = tid >> 6, lane = tid & 63, wr = wid >> 2, wc = wid & 3, fr = lane & 15, fq = lane >> 4;
  unsigned voff[2];
#pragma unroll
  for (int i = 0; i < 2; ++i) { const int st = wid + 8 * i, sb = lane * 16; voff[i] = (unsigned)(((st >> 1) * (K >> 5) + (st & 1)) * 1024 + (sb ^ (((sb >> 9) & 1) << 5))); }
  const size_t kstep = 2048, hstep = (size_t)8 * (K >> 5) * 1024;
  const unsigned ldsw = (unsigned)wid * 1024u;
  const int aoff = lds_byte(wr * 64 + fr, fq * 8), boff = lds_byte(wc * 32 + fr, fq * 8);
#define G_SA(b, h) (((b) * 2 + (h)) * HTB)
#define G_SB(b, h) ((4 + (b) * 2 + (h)) * HTB)
#define STAGE(bufoff, gbase) do { _Pragma("unroll") for (int _i = 0; _i < 2; ++_i) \
    __builtin_amdgcn_global_load_lds((const unsigned*)((const char*)(gbase) + voff[_i]), (LAS unsigned*)(lds + (bufoff) + ldsw + _i * 8192), 16, 0, 0); } while (0)
#define LDA(dst, b, h) do { _Pragma("unroll") for (int m = 0; m < 4; ++m) _Pragma("unroll") for (int k = 0; k < 2; ++k) dst[m][k] = *(const LAS bf16x8*)(lds + G_SA(b, h) + aoff + m * 2048 + k * 1024); } while (0)
#define LDB(dst, b, h) do { _Pragma("unroll") for (int n = 0; n < 2; ++n) _Pragma("unroll") for (int k = 0; k < 2; ++k) dst[n][k] = *(const LAS bf16x8*)(lds + G_SB(b, h) + boff + n * 2048 + k * 1024); } while (0)
#define MMA(ai, bj, At, Bt_) do { __builtin_amdgcn_s_setprio(1); _Pragma("unroll") for (int m = 0; m < 4; ++m) _Pragma("unroll") for (int n = 0; n < 2; ++n) _Pragma("unroll") for (int k = 0; k < 2; ++k) \
      acc[ai][bj][m][n] = MFMA16(Bt_[n][k], At[m][k], acc[ai][bj][m][n]); \
    __builtin_amdgcn_s_setprio(0); } while (0)
#define WAIT_V(n) asm volatile("s_waitcnt vmcnt(" #n ")" ::: "memory")
#define WAIT_L(n) asm volatile("s_waitcnt lgkmcnt(" #n ")" ::: "memory")
#define BAR __builtin_amdgcn_s_barrier()
#define SCHED __builtin_amdgcn_sched_barrier(0)
  const int nwg = nM * nN;
  const int nt = K / BK;
  const int wid_s = __builtin_amdgcn_readfirstlane(wid);
#define DECODE(L_, pm_, pn_) do { int wgid = (L_); \
    { int q = nwg / NXCD, r = nwg % NXCD, xcd = wgid % NXCD, off = wgid / NXCD; wgid = (xcd < r ? xcd * (q + 1) : r * (q + 1) + (xcd - r) * q) + off; } \
    const int nig = WGM * nN, gid = wgid / nig, fm = gid * WGM, gsz = min(nM - fm, WGM); \
    pm_ = fm + ((wgid % nig) % gsz); pn_ = (wgid % nig) / gsz; } while (0)
  int L = cx.bid;
  if (L < nwg) {
    int pm, pn;
    DECODE(L, pm, pn);
    const char* cA = (const char*)A + (size_t)(am.row0(pm) >> 4) * (K >> 5) * 1024; const char* cB = (const char*)Bt + (size_t)(pn * BM >> 4) * (K >> 5) * 1024;
    Acc acc;
#pragma unroll
    for (int a = 0; a < 2; ++a)
#pragma unroll
      for (int b = 0; b < 2; ++b)
#pragma unroll
        for (int m = 0; m < 4; ++m)
#pragma unroll
          for (int n = 0; n < 2; ++n) acc[a][b][m][n] = (f32x4){0.f, 0.f, 0.f, 0.f};
    bf16x8 At[4][2], B0[2][2], B1[2][2];
    STAGE(G_SB(0, 0), cB); STAGE(G_SA(0, 0), cA); STAGE(G_SB(0, 1), cB + hstep); STAGE(G_SA(0, 1), cA + hstep);
    if (wr == 1) BAR;
    WAIT_V(4); BAR;
    STAGE(G_SB(1, 0), cB + kstep); STAGE(G_SA(1, 0), cA + kstep); STAGE(G_SB(1, 1), cB + hstep + kstep);
    WAIT_V(6); BAR;
    for (;;) {
      const int Ln = L + cx.nb;
      const bool has_next = Ln < nwg;
      int pmn = pm, pnn = pn;
      if (has_next) DECODE(Ln, pmn, pnn);
      const char* nA = has_next ? (const char*)A + (size_t)(am.row0(pmn) >> 4) * (K >> 5) * 1024 : cA; const char* nB = has_next ? (const char*)Bt + (size_t)(pnn * BM >> 4) * (K >> 5) * 1024 : cB;
      for (int t = 0; t < nt; t += 2) {
        const bool last = (t == nt - 2);
        const char* a1 = cA + (size_t)(t + 1) * kstep;
        const char* a2 = last ? nA : cA + (size_t)(t + 2) * kstep; const char* b2 = last ? nB : cB + (size_t)(t + 2) * kstep;
        const char* a3 = a2 + kstep; const char* b3 = b2 + kstep;
        LDB(B0, 0, 0); SCHED; LDA(At, 0, 0); STAGE(G_SA(1, 1), a1 + hstep);
        WAIT_L(8); BAR; WAIT_L(0); MMA(0, 0, At, B0); BAR; SCHED;
        LDB(B1, 0, 1); STAGE(G_SB(0, 0), b2);
        BAR; WAIT_L(0); MMA(0, 1, At, B1); BAR;
        LDA(At, 0, 1); STAGE(G_SA(0, 0), a2);
        BAR; WAIT_L(0); MMA(1, 0, At, B0); BAR; SCHED;
        STAGE(G_SB(0, 1), b2 + hstep);
        WAIT_V(6); BAR; MMA(1, 1, At, B1); BAR;
        LDB(B0, 1, 0); SCHED; LDA(At, 1, 0); STAGE(G_SA(0, 1), a2 + hstep);
        WAIT_L(8); BAR; WAIT_L(0); MMA(0, 0, At, B0); BAR; SCHED;
        LDB(B1, 1, 1); STAGE(G_SB(1, 0), b3);
        BAR; WAIT_L(0); MMA(0, 1, At, B1); BAR;
        LDA(At, 1, 1); STAGE(G_SA(1, 0), a3);
        BAR; WAIT_L(0); MMA(1, 0, At, B0); BAR; SCHED;
        STAGE(G_SB(1, 1), b3 + hstep);
        WAIT_V(6); BAR; MMA(1, 1, At, B1); BAR;
      }
      { int t2 = wid_s * 64 + (int)__builtin_amdgcn_mbcnt_hi(~0u, __builtin_amdgcn_mbcnt_lo(~0u, (unsigned)cx.z)); asm volatile("" : "+v"(t2));
        const int w2 = t2 >> 6, l2 = t2 & 63;
        run_epi(cx, epi, acc, cm.row0(pm), pn, w2 >> 2, w2 & 3, l2 & 15, l2 >> 4); }
      if (!has_next) break;
#pragma unroll
      for (int a = 0; a < 2; ++a)
#pragma unroll
        for (int b = 0; b < 2; ++b)
#pragma unroll
          for (int m = 0; m < 4; ++m)
#pragma unroll
            for (int n = 0; n < 2; ++n) acc[a][b][m][n] = (f32x4){0.f, 0.f, 0.f, 0.f};
      pm = pmn; pn = pnn; cA = nA; cB = nB; L = Ln;
    }
    WAIT_V(0);
    if (wr == 0) BAR;
    BAR;
  }
  __syncthreads();
}

template <int MODE>
__device__ __forceinline__ int wrow(int c) {
  if (MODE == 0) return c;
  const int isv = c >= FF ? 1 : 0, f = c - isv * FF;
  return (f >> 7) * 256 + ((f >> 6) & 1) * 128 + ((f >> 4) & 3) * 32 + isv * 16 + (f & 15);
}
template <int MODE>
__device__ __forceinline__ void transpose_item(const float* __restrict__ W, int K, int N, bf16_t* __restrict__ WT, float* scr, int item, int lane) {
  const int nblk = N / 32, kb = item / nblk, nb = item % nblk, k0 = 64 * kb, n0 = 32 * nb;
#pragma unroll 8
  for (int i = 0; i < 32; ++i) { const int kk = 2 * i + (lane >> 5); scr[kk * 33 + (lane & 31)] = W[(size_t)(k0 + kk) * N + n0 + (lane & 31)]; }
  __builtin_amdgcn_wave_barrier(); asm volatile("s_waitcnt lgkmcnt(0)" ::: "memory");
  const int c = lane & 7;
#pragma unroll
  for (int j = 0; j < 4; ++j) {
    const int n = (lane >> 3) + 8 * j; const float* s = scr + (8 * c) * 33 + n;
    u32x4 o; o.x = pk2(s[0 * 33], s[1 * 33]); o.y = pk2(s[2 * 33], s[3 * 33]); o.z = pk2(s[4 * 33], s[5 * 33]); o.w = pk2(s[6 * 33], s[7 * 33]);
    *(u32x4*)(WT + nat(wrow<MODE>(n0 + n), k0 + 8 * c, K)) = o;
  }
  asm volatile("s_waitcnt lgkmcnt(0)" ::: "memory"); __builtin_amdgcn_wave_barrier();
}

__device__ __forceinline__ void prologue(const Params& p, const Ctx& cx) {
  const int tid = cx.tid, lane = tid & 63, wave = tid >> 6;
  char* ws = cx.ws;
  {
    float* cond = (float*)lds_raw;
    float* red = (float*)(lds_raw + 9 * 1024 * 4);
    for (int i = tid; i < 9 * 1024; i += 512) { const int j = i >> 10, k = i & 1023; cond[i] = silu_f(j < 8 ? IN(1)[j * 1024 + k] : IN(3)[k]); }
    __syncthreads();
    for (int u = cx.bid; u < 4 * 36; u += cx.nb) {
      const int layer = u / 36, ct = u % 36, c0 = ct * 256 + 4 * lane;
      const float* wp = IN(4) + (size_t)layer * D * 9216 + c0;
      f32x4 a[9];
#pragma unroll
      for (int j = 0; j < 9; ++j) a[j] = (f32x4){0.f, 0.f, 0.f, 0.f};
#pragma unroll 4
      for (int k = wave * 128; k < wave * 128 + 128; ++k) {
        const f32x4 w = *(const f32x4*)(wp + (size_t)k * 9216);
#pragma unroll
        for (int j = 0; j < 9; ++j) a[j] += w * cond[j * 1024 + k];
      }
#pragma unroll
      for (int j = 0; j < 9; ++j) *(f32x4*)(red + (wave * 9 + j) * 256 + 4 * lane) = a[j];
      __syncthreads();
      float* mt = (float*)(ws + O_MODT) + (size_t)layer * 9 * 9216;
      for (int i = tid; i < 9 * 256; i += 512) {
        const int j = i >> 8, c = i & 255; float s = 0.f;
#pragma unroll
        for (int w = 0; w < 8; ++w) s += red[(w * 9 + j) * 256 + c];
        mt[(size_t)j * 9216 + ct * 256 + c] = s + IN(5)[layer * 9216 + ct * 256 + c];
      }
      __syncthreads();
    }
    __syncthreads();
  }
  {
    float* scr = (float*)lds_raw + wave * (64 * 33);
    const int gw = cx.bid * 8 + wave, NGW = cx.nb * 8;
    constexpr int I_FI = 16 * 176, I_FO = 44 * 32, I_UP = 16 * 128, I_DN = 32 * 32, I_AQ = 16 * 48, I_AO = 16 * 32, I_SI = 16 * 96, I_SO = 16 * 32;
    constexpr int NITEMS = 8 * I_FI + 8 * I_FO + 2 * I_UP + 2 * I_DN + I_AQ + I_AO + I_SI + I_SO;
    for (int it = gw; it < NITEMS; it += NGW) {
      int r = it;
      if (r < 8 * I_FI) { const int mi = r / I_FI; transpose_item<1>(IN(8) + (size_t)mi * 1024 * 5632, 1024, 5632, (bf16_t*)(ws + O_WFI) + (size_t)mi * 5632 * 1024, scr, r % I_FI, lane); continue; } r -= 8 * I_FI;
      if (r < 8 * I_FO) { const int mi = r / I_FO; transpose_item<0>(IN(9) + (size_t)mi * 2816 * 1024, 2816, 1024, (bf16_t*)(ws + O_WFO) + (size_t)mi * 1024 * 2816, scr, r % I_FO, lane); continue; } r -= 8 * I_FO;
      if (r < 2 * I_UP) { const int mi = r / I_UP; transpose_item<0>(IN(10) + (size_t)mi * 1024 * 4096, 1024, 4096, (bf16_t*)(ws + O_WUP) + (size_t)mi * 4096 * 1024, scr, r % I_UP, lane); continue; } r -= 2 * I_UP;
      if (r < 2 * I_DN) { const int mi = r / I_DN; transpose_item<0>(IN(18) + (size_t)mi * 2048 * 1024, 2048, 1024, (bf16_t*)(ws + O_WDN) + (size_t)mi * 1024 * 2048, scr, r % I_DN, lane); continue; } r -= 2 * I_DN;
      if (r < I_AQ) { transpose_item<0>(IN(19), 1024, 1536, (bf16_t*)(ws + O_WAQ), scr, r, lane); continue; } r -= I_AQ;
      if (r < I_AO) { transpose_item<0>(IN(21), 1024, 1024, (bf16_t*)(ws + O_WAO), scr, r, lane); continue; } r -= I_AO;
      if (r < I_SI) { transpose_item<0>(IN(22), 1024, 3072, (bf16_t*)(ws + O_WSI), scr, r, lane); continue; } r -= I_SI;
      transpose_item<0>(IN(24), 1024, 1024, (bf16_t*)(ws + O_WSO), scr, r, lane);
    }
  }
  {
    const int gt = cx.bid * 512 + tid, gs = cx.nb * 512;
    bf16_t* wg = (bf16_t*)(ws + O_WG);
    for (int i = gt; i < 2 * 16 * 6144; i += gs) {
      const int j = i / (16 * 6144), xg = (i / 6144) & 15, k = i % 6144, x = xg >> 3, g = xg & 7;
      const float* wif = IN(14) + (size_t)(j * 2 + x) * 6144 * 8;
      float v;
      const int knat = (k & ~31) + 16 * ((k >> 2) & 1) + 4 * ((k >> 3) & 3) + (k & 3);
      if (k < 2048) v = wif[(size_t)knat * 8 + g];
      else if (k < 4096) v = wif[(size_t)knat * 8 + g] * 22.627416997969522f;
      else {
        const int c = k - 4096, blk = c >> 2, cc = c & 3;
        const float* wv = IN(13) + ((size_t)(j * 3 + 2) * 512 + blk) * 16 + cc * 4;
        v = 0.f;
        for (int d2 = 0; d2 < 4; ++d2) v += wv[d2] * wif[(size_t)(4096 + 4 * blk + d2) * 8 + g];
      }
      wg[i] = (bf16_t)(pk2(v, 0.f) & 0xffff);
    }
    { float* lnt = (float*)(ws + O_LNT); for (int i = gt; i < 12 * D; i += gs) { const int l = i / D, c2 = i % D; lnt[(size_t)l * 2 * D + c2] = IN(6)[i] * ALPHA; lnt[(size_t)l * 2 * D + D + c2] = IN(7)[i] * ALPHA; } }
    float* rc = (float*)(ws + O_ROPE); float* rs = rc + 4096 * 32;
    for (int i = gt; i < 4096 * 32; i += gs) {
      const int pos = i >> 5, pp = i & 31, jf = pp & 15;
      const float fr_ = __builtin_amdgcn_exp2f(-(float)jf * (13.287712379549449f / 16.f));
      float rev = (float)(pp < 16 ? (pos >> 6) : (pos & 63)) * fr_ * 0.15915494309189535f;
      rev -= rintf(rev);
      rc[i] = __builtin_amdgcn_cosf(rev); rs[i] = __builtin_amdgcn_sinf(rev);
    }
  }
}

template <int MODE>
__device__ __forceinline__ void lnmod_phase(const Params& p, const Ctx& cx, int lnidx  , int layer, int slot) {
  const int lane = cx.tid & 63, gw = cx.bid * 8 + (cx.tid >> 6), NGW = cx.nb * 8;
  const int nrows = MODE == 2 ? NLAT : MROWS;
  const float* lg = IN(6) + (size_t)lnidx * D; const float* lb = IN(7) + (size_t)lnidx * D;
  const float* modl = (const float*)(cx.ws + O_MODT) + (size_t)layer * 9 * 9216;
  bf16_t* U = (bf16_t*)(cx.ws + O_U);
  for (int row = gw; row < nrows; row += NGW) {
    float* hp = hrow(cx, row);
    const float* src = MODE == 0 ? (row < NLAT ? IN(0) + (size_t)row * D : IN(2) + (size_t)(row - NLAT) * D) : hp;
    f32x4 v[4];
#pragma unroll
    for (int j = 0; j < 4; ++j) v[j] = *(const f32x4*)(src + 4 * lane + 256 * j);
    if (MODE != 0) {
      float s = 0.f;
#pragma unroll
      for (int j = 0; j < 4; ++j) s += (v[j][0] + v[j][1]) + (v[j][2] + v[j][3]);
      const float mean = wave_sum(s, lane) * (1.f / D); float s2 = 0.f;
#pragma unroll
      for (int j = 0; j < 4; ++j) { v[j] = v[j] - mean; s2 += (v[j][0] * v[j][0] + v[j][1] * v[j][1]) + (v[j][2] * v[j][2] + v[j][3] * v[j][3]); }
      const float rstd = __builtin_amdgcn_rsqf(wave_sum(s2, lane) * (1.f / D) + LN_EPS);
      if (MODE == 1 && lane == 0) *(float2*)((float*)(cx.ws + O_STATS) + (size_t)row * 2) = make_float2(mean, rstd);
#pragma unroll
      for (int j = 0; j < 4; ++j) v[j] = v[j] * rstd * *(const f32x4*)(lg + 4 * lane + 256 * j) + *(const f32x4*)(lb + 4 * lane + 256 * j);
    }
    if (MODE != 1) {
#pragma unroll
      for (int j = 0; j < 4; ++j) *(f32x4*)(hp + 4 * lane + 256 * j) = MODE == 0 ? v[j] * ALPHA : v[j];
    }
    if (MODE != 2) {
      const int midx = row < NLAT ? (row >> 12) : 8;
      const float* sh = modl + (size_t)midx * 9216 + (3 * slot) * D; const float* sc = sh + D;
#pragma unroll
      for (int j = 0; j < 4; ++j) {
        const f32x4 u = v[j] * (*(const f32x4*)(sc + 4 * lane + 256 * j) + 1.f) + *(const f32x4*)(sh + 4 * lane + 256 * j);
        u32x2 o; o.x = pk2(u[0], u[1]); o.y = pk2(u[2], u[3]);
        *(u32x2*)(U + nat(row, 4 * lane + 256 * j, D)) = o;
      }
    }
  }
}

__device__ __forceinline__ int ml_lrow(int bl, int tok) { return tok < LC ? GB * SEQ + bl * LC + tok : bl * SEQ + (tok - LC); }
__device__ __forceinline__ int ml_nchunk(int x, int st) { return x == 0 ? st : (st < 4 ? 3 - st : 71 - st); }

__device__ __forceinline__ void ml_m0(const Params& p, const Ctx& cx, int j) {
  const int tid = cx.tid;
  char* ws = cx.ws;
  const bf16_t* XZ = (const bf16_t*)(ws + O_XZ);
  bf16_t* QK = (bf16_t*)(ws + O_QK); bf16_t* KT = (bf16_t*)(ws + O_KT); bf16_t* VT = (bf16_t*)(ws + O_VT); bf16_t* QF = (bf16_t*)(ws + O_QF);
  const int blk_l = tid & 63, tq = tid >> 6;
  for (int u = cx.bid; u < GB * NCH * 8; u += cx.nb) {
    const int slab = u & 7, ch = (u >> 3) % NCH, bl = u / (8 * NCH);
    const int f0 = slab * 256 + blk_l * 4, blk = f0 >> 2;
    float cw[3][4], cb[4], wq[16], wk[16], wv[16];
#pragma unroll
    for (int k = 0; k < 3; ++k)
#pragma unroll
      for (int c = 0; c < 4; ++c) cw[k][c] = IN(11)[(size_t)(j * 3 + k) * EI + f0 + c];
#pragma unroll
    for (int c = 0; c < 4; ++c) cb[c] = IN(12)[(size_t)j * EI + f0 + c];
#pragma unroll
    for (int i = 0; i < 16; ++i) {
      wq[i] = IN(13)[((size_t)(j * 3 + 0) * 512 + blk) * 16 + i];
      wk[i] = IN(13)[((size_t)(j * 3 + 1) * 512 + blk) * 16 + i] * 0.04419417382415922f;
      wv[i] = IN(13)[((size_t)(j * 3 + 2) * 512 + blk) * 16 + i];
    }
    const int tok0 = ch * 64, seg_lo = tok0 < LC ? 0 : LC, seg_hi = tok0 < LC ? LC : TOKB;
    const int tl0 = tq * 8;
    float xmp[4], xmc[4], xmn[4];
    {
      const int t2 = tok0 + tl0 - 1;
      if (t2 >= seg_lo) { const u32x2 r = *(const u32x2*)(XZ + (size_t)ml_lrow(bl, t2) * 4096 + f0); xmp[0] = bflo(r.x); xmp[1] = bfhi(r.x); xmp[2] = bflo(r.y); xmp[3] = bfhi(r.y); }
      else { xmp[0] = xmp[1] = xmp[2] = xmp[3] = 0.f; }
      const u32x2 r = *(const u32x2*)(XZ + (size_t)ml_lrow(bl, tok0 + tl0) * 4096 + f0); xmc[0] = bflo(r.x); xmc[1] = bfhi(r.x); xmc[2] = bflo(r.y); xmc[3] = bfhi(r.y);
    }
    unsigned kpk[4][4], vpk[4][4];
    float kprev[4], vprev[4];
    const int fp = (f0 & ~31) + 8 * ((f0 >> 2) & 3) + 4 * ((f0 >> 4) & 1);
#pragma unroll
    for (int tt = 0; tt < 8; ++tt) {
      const int tl = tl0 + tt, tok = tok0 + tl;
      if (tok + 1 < seg_hi) { const u32x2 r = *(const u32x2*)(XZ + (size_t)ml_lrow(bl, tok + 1) * 4096 + f0); xmn[0] = bflo(r.x); xmn[1] = bfhi(r.x); xmn[2] = bflo(r.y); xmn[3] = bfhi(r.y); }
      else { xmn[0] = xmn[1] = xmn[2] = xmn[3] = 0.f; }
      float xc[4], q[4], kk[4], vv[4];
#pragma unroll
      for (int c = 0; c < 4; ++c) xc[c] = silu_f(cw[0][c] * xmp[c] + cw[1][c] * xmc[c] + cw[2][c] * xmn[c] + cb[c]);
#pragma unroll
      for (int d2 = 0; d2 < 4; ++d2) {
        q[d2] = xc[0] * wq[d2] + xc[1] * wq[4 + d2] + xc[2] * wq[8 + d2] + xc[3] * wq[12 + d2];
        kk[d2] = xc[0] * wk[d2] + xc[1] * wk[4 + d2] + xc[2] * wk[8 + d2] + xc[3] * wk[12 + d2];
        vv[d2] = xmc[0] * wv[d2] + xmc[1] * wv[4 + d2] + xmc[2] * wv[8 + d2] + xmc[3] * wv[12 + d2];
      }
      const size_t lr = ml_lrow(bl, tok);
      u32x2 oq, ok; oq.x = pk2(q[0], q[1]); oq.y = pk2(q[2], q[3]); ok.x = pk2(kk[0], kk[1]); ok.y = pk2(kk[2], kk[3]);
      *(u32x2*)(QK + lr * 4096 + fp) = oq;
      *(u32x2*)(QF + ((((((size_t)bl * NCH + ch) * 4 + (f0 >> 9)) * 8 + ((f0 >> 6) & 7)) * 4 + (tl >> 4)) * 2 + ((f0 >> 5) & 1)) * 512 + (tl & 15) * 32 + 8 * ((f0 >> 2) & 3) + 4 * ((f0 >> 4) & 1)) = oq;
      *(u32x2*)(QK + lr * 4096 + 2048 + fp) = ok;
      if (tt & 1) {
#pragma unroll
        for (int c = 0; c < 4; ++c) { kpk[c][tt >> 1] = pk2(kprev[c], kk[c]); vpk[c][tt >> 1] = pk2(vprev[c], vv[c]); }
      } else {
#pragma unroll
        for (int c = 0; c < 4; ++c) { kprev[c] = kk[c]; vprev[c] = vv[c]; }
      }
#pragma unroll
      for (int c = 0; c < 4; ++c) { xmp[c] = xmc[c]; xmc[c] = xmn[c]; }
    }
#pragma unroll
    for (int c = 0; c < 4; ++c) {
      const int feat = f0 + c;
      const size_t off = (((size_t)bl * NCH + ch) * (EI / 16) + (feat >> 4)) * 1024 + (tq >> 2) * 512 + (feat & 15) * 32 + (tq & 3) * 8;
      *(u32x4*)(KT + off) = (u32x4){kpk[c][0], kpk[c][1], kpk[c][2], kpk[c][3]};
      *(u32x4*)(VT + off) = (u32x4){vpk[c][0], vpk[c][1], vpk[c][2], vpk[c][3]};
    }
  }
}

__device__ __forceinline__ void ml_gates(const Params& p, const Ctx& cx, int j) {
  const int tid = cx.tid, lane = tid & 63, wave = tid >> 6, fr = lane & 15, fq = lane >> 4;
  char* ws = cx.ws;
  const bf16_t* XZ = (const bf16_t*)(ws + O_XZ); const bf16_t* QK = (const bf16_t*)(ws + O_QK);
  const bf16_t* WG = (const bf16_t*)(ws + O_WG) + (size_t)j * 16 * 6144;
  float* BL = (float*)(ws + O_BL); float* IG = (float*)(ws + O_IG);
  float* GC = (float*)(ws + O_GC); float* AC = GC + NSEQ * NCH;
  float* part = (float*)lds_raw;
  float* gl = part + 8 * 64 * 16;
  for (int u = cx.bid; u < GB * NCH; u += cx.nb) {
    const int bl = u / NCH, nc = u % NCH, tok0 = nc * 64;
    f32x4 acc[4];
#pragma unroll
    for (int m = 0; m < 4; ++m) acc[m] = (f32x4){0.f, 0.f, 0.f, 0.f};
    size_t lr[4];
#pragma unroll
    for (int m = 0; m < 4; ++m) lr[m] = ml_lrow(bl, tok0 + m * 16 + fr);
#pragma unroll 4
    for (int ks = wave * 24; ks < wave * 24 + 24; ++ks) {
      const int k = ks * 32 + fq * 8;
      const bf16x8 bfr = *(const bf16x8*)(WG + (size_t)fr * 6144 + k);
#pragma unroll
      for (int m = 0; m < 4; ++m) {
        const bf16_t* ap = k < 4096 ? QK + lr[m] * 4096 + k : XZ + lr[m] * 4096 + (k - 4096);
        const bf16x8 afr = *(const bf16x8*)ap;
        acc[m] = MFMA16(afr, bfr, acc[m]);
      }
    }
#pragma unroll
    for (int m = 0; m < 4; ++m)
#pragma unroll
      for (int jj = 0; jj < 4; ++jj) part[(wave * 64 + m * 16 + 4 * fq + jj) * 16 + fr] = acc[m][jj];
    __syncthreads();
    for (int i = tid; i < 1024; i += 512) {
      float s = IN(15)[(size_t)j * 16 + (i & 15)];
#pragma unroll
      for (int w = 0; w < 8; ++w) s += part[w * 1024 + i];
      gl[(i >> 4) * 17 + (i & 15)] = s;
    }
    __syncthreads();
    {
      const int x = wave >> 2, h = wave & 3, seq = (bl * 2 + x) * 4 + h;
      const int tl = x == 0 ? lane : 63 - lane;
      const float ig = gl[tl * 17 + x * 8 + h], fg = gl[tl * 17 + x * 8 + 4 + h];
      float b = fg > 0.f ? -__logf(1.f + __expf(-fg)) : fg - __logf(1.f + __expf(fg));
#pragma unroll
      for (int o = 1; o < 64; o <<= 1) { const float t2 = shi(b, lane - o); if (lane >= o) b += t2; }
      BL[(size_t)seq * TOKB + tok0 + tl] = b; IG[(size_t)seq * TOKB + tok0 + tl] = ig;
      float mx = ig - b;
#pragma unroll
      for (int o = 1; o < 64; o <<= 1) mx = fmaxf(mx, shx(mx, o, lane));
      const float g = shi(b, 63);
      if (lane == 0) { GC[seq * NCH + nc] = g; AC[seq * NCH + nc] = g + mx; }
    }
    __syncthreads();
  }
}

__device__ __forceinline__ void ml_s(const Params& p, const Ctx& cx) {
  const int tid = cx.tid, lane = tid & 63, wave = tid >> 6, fr = lane & 15, fq = lane >> 4;
  char* ws = cx.ws;
  const bf16_t* QK = (const bf16_t*)(ws + O_QK);
  bf16_t* SP = (bf16_t*)(ws + O_SP);
  const float* BL = (const float*)(ws + O_BL); const float* IG = (const float*)(ws + O_IG);
  float* WIN = (float*)(ws + O_WIN); float* FLO = (float*)(ws + O_FLO); float* DEN = (float*)(ws + O_DEN); float* WSS = (float*)(ws + O_WSS);
  const float* GC = (const float*)(ws + O_GC); const float* AC = GC + NSEQ * NCH; float* DEC = (float*)(ws + O_GC) + 2 * NSEQ * NCH;
  float* sb_ = (float*)lds_raw + wave * 256; float* si_ = sb_ + 64; float* smt = si_ + 64;
  const int gw = cx.bid * 8 + wave, NGW = cx.nb * 8;
  for (int u = gw; u < NSEQ * NCH; u += NGW) {
    const int seq = u / NCH, st = u % NCH, x = (seq >> 2) & 1, h = seq & 3, bl = seq >> 3;
    const int nc = ml_nchunk(x, st), tok0 = nc * 64;
    const int nl0 = ml_nchunk(x, lane), nl1 = ml_nchunk(x, 64 + (lane & 3));
    const float g0 = GC[seq * NCH + nl0], a0 = AC[seq * NCH + nl0], g1 = GC[seq * NCH + nl1], a1 = AC[seq * NCH + nl1];
    const int tl = x == 0 ? lane : 63 - lane;
    const float b = BL[(size_t)seq * TOKB + tok0 + tl], ig = IG[(size_t)seq * TOKB + tok0 + tl];
    float mc = 0.f;
    for (int s2 = 0; s2 < st; ++s2) {
      const float gg = __int_as_float(__builtin_amdgcn_readlane(__float_as_int(s2 < 64 ? g0 : g1), s2 & 63));
      const float aa = __int_as_float(__builtin_amdgcn_readlane(__float_as_int(s2 < 64 ? a0 : a1), s2 & 63));
      mc = fmaxf(gg + mc, aa);
    }
    const float gc = __int_as_float(__builtin_amdgcn_readlane(__float_as_int(st < 64 ? g0 : g1), st & 63));
    const float ac = __int_as_float(__builtin_amdgcn_readlane(__float_as_int(st < 64 ? a0 : a1), st & 63));
    const float mnew = fmaxf(gc + mc, ac);
    float cm = ig - b;
#pragma unroll
    for (int o = 1; o < 64; o <<= 1) { const float t2 = shi(cm, lane - o); if (lane >= o) cm = fmaxf(cm, t2); }
    const float mt = b + fmaxf(mc, cm);
    sb_[tl] = b; si_[tl] = ig; smt[tl] = mt;
    WIN[(size_t)seq * TOKB + tok0 + tl] = __expf(b + mc - mt);
    FLO[(size_t)seq * TOKB + tok0 + tl] = __expf(-mt);
    WSS[(size_t)seq * TOKB + tok0 + tl] = __expf(gc - b + ig - mnew);
    if (lane == 0) DEC[seq * NCH + nc] = __expf(gc + mc - mnew);
    f32x4 acc[4][4];
#pragma unroll
    for (int a = 0; a < 4; ++a)
#pragma unroll
      for (int c2 = 0; c2 < 4; ++c2) acc[a][c2] = (f32x4){0.f, 0.f, 0.f, 0.f};
    const bf16_t* rowp[4];
#pragma unroll
    for (int a = 0; a < 4; ++a) rowp[a] = QK + (size_t)ml_lrow(bl, tok0 + a * 16 + fr) * 4096 + h * DH + fq * 8;
#pragma unroll 2
    for (int ks = 0; ks < 16; ++ks) {
      bf16x8 kf[4], qf[4];
#pragma unroll
      for (int a = 0; a < 4; ++a) { kf[a] = *(const bf16x8*)(rowp[a] + 2048 + ks * 32); qf[a] = *(const bf16x8*)(rowp[a] + ks * 32); }
#pragma unroll
      for (int a = 0; a < 4; ++a)
#pragma unroll
        for (int c2 = 0; c2 < 4; ++c2) acc[a][c2] = MFMA16(kf[a], qf[c2], acc[a][c2]);
    }
    __builtin_amdgcn_wave_barrier(); asm volatile("s_waitcnt lgkmcnt(0)" ::: "memory");
    bf16_t* spu = SP + (size_t)(seq * NCH + nc) * 4096;
#pragma unroll
    for (int tb = 0; tb < 4; ++tb) {
      const int t = tb * 16 + fr;
      const float bt = sb_[t], mtt = smt[t];
      float dsum = 0.f;
#pragma unroll
      for (int sbk = 0; sbk < 4; ++sbk) {
        float vals[4];
#pragma unroll
        for (int jj = 0; jj < 4; ++jj) {
          const int s = sbk * 16 + 4 * fq + jj;
          const bool ok = x == 0 ? (s <= t) : (s >= t);
          vals[jj] = ok ? acc[sbk][tb][jj] * __expf(bt - sb_[s] + si_[s] - mtt) : 0.f;
        }
        u32x2 o; o.x = pk2(vals[0], vals[1]); o.y = pk2(vals[2], vals[3]);
        *(u32x2*)(spu + tb * 1024 + ((sbk * 16 + 4 * fq) >> 5) * 512 + fr * 32 + ((sbk * 16 + 4 * fq) & 31)) = o;
        dsum += (bflo(o.x) + bfhi(o.x)) + (bflo(o.y) + bfhi(o.y));
      }
      dsum += shx(dsum, 16, lane); dsum += shx(dsum, 32, lane);
      if (fq == 0) DEN[(size_t)seq * TOKB + tok0 + t] = dsum;
    }
    __builtin_amdgcn_wave_barrier(); asm volatile("s_waitcnt lgkmcnt(0)" ::: "memory");
  }
}

constexpr int NEB = 2, NSL = 512 / (16 * NEB);
__device__ __forceinline__ void ml_m2(const Params& p, const Ctx& cx) {
  const int tid = cx.tid, lane = tid & 63, wave = tid >> 6, fr = lane & 15, fq = lane >> 4;
  char* ws = cx.ws;
  const bf16_t* QK = (const bf16_t*)(ws + O_QK); const bf16_t* KT = (const bf16_t*)(ws + O_KT); const bf16_t* VT = (const bf16_t*)(ws + O_VT);
  const bf16_t* SP = (const bf16_t*)(ws + O_SP); const bf16_t* QF = (const bf16_t*)(ws + O_QF);
  bf16_t* HD = (bf16_t*)(ws + O_HD);
  const float* WIN = (const float*)(ws + O_WIN); const float* FLO = (const float*)(ws + O_FLO); const float* DEN = (const float*)(ws + O_DEN); const float* WSS = (const float*)(ws + O_WSS);
  const float* DEC = (const float*)(ws + O_GC) + 2 * NSEQ * NCH;
  f32x4* red = (f32x4*)lds_raw;
  f32x4* rn = (f32x4*)(lds_raw + 131072);
  for (int idx = cx.bid >> 3; idx < 2 * NSL; idx += cx.nb >> 3) {
    const int seq = (cx.bid & 7) * 2 + idx / NSL, es = idx % NSL, x = (seq >> 2) & 1, h = seq & 3, bl = seq >> 3;
    const int d0 = wave * 64, e0 = es * 16 * NEB;
    f32x4 C[4][NEB + 1];
#pragma unroll
    for (int a = 0; a < 4; ++a)
#pragma unroll
      for (int b = 0; b < NEB + 1; ++b) C[a][b] = (f32x4){0.f, 0.f, 0.f, 0.f};
    const int tbo = wave >> 1, ebo = __builtin_amdgcn_readfirstlane(wave & 1);
    bf16x8 qc[4][2], kf[4][2], sf0, sf1;
    u32x4 vr[NEB][2];
    f32x4 wv[2][2];
#define M2_LOAD_Q(ST) do { const int _nq = ml_nchunk(x, (ST)); _Pragma("unroll") for (int tb = 0; tb < 4; ++tb) { \
        const bf16_t* qp = QF + ((((((size_t)bl * NCH + _nq) * 4 + h) * 8 + wave) * 4 + tb) * 2) * 512 + fr * 32 + 8 * fq; \
        qc[tb][0] = *(const bf16x8*)qp; qc[tb][1] = *(const bf16x8*)(qp + 512); } } while (0)
#define M2_LOAD_KV(ST) do { const int _nc = ml_nchunk(x, (ST)), _t0 = _nc * 64; \
        _Pragma("unroll") for (int db = 0; db < 4; ++db) { const bf16_t* kp = KT + (((size_t)bl * NCH + _nc) * (EI / 16) + ((h * DH + d0) >> 4) + db) * 1024 + fr * 32 + 8 * fq; \
          kf[db][0] = *(const bf16x8*)kp; kf[db][1] = *(const bf16x8*)(kp + 512); } \
        _Pragma("unroll") for (int eb = 0; eb < NEB; ++eb) { const bf16_t* vp = VT + (((size_t)bl * NCH + _nc) * (EI / 16) + ((h * DH + e0) >> 4) + eb) * 1024 + fr * 32 + 8 * fq; \
          vr[eb][0] = *(const u32x4*)vp; vr[eb][1] = *(const u32x4*)(vp + 512); } \
        _Pragma("unroll") for (int ks = 0; ks < 2; ++ks) { const float* wp = WSS + (size_t)seq * TOKB + _t0 + 32 * ks + 8 * fq; \
          wv[ks][0] = *(const f32x4*)wp; wv[ks][1] = *(const f32x4*)(wp + 4); } \
        const bf16_t* sp = SP + (size_t)(seq * NCH + _nc) * 4096 + tbo * 1024 + fr * 32 + 8 * fq; \
        sf0 = *(const bf16x8*)sp; sf1 = *(const bf16x8*)(sp + 512); } while (0)
    M2_LOAD_Q(0); M2_LOAD_KV(0);
    for (int st = 0; st < NCH; ++st) {
      const int nc = ml_nchunk(x, st), tok0 = nc * 64, stn = st + 1 < NCH ? st + 1 : st;
      const size_t tix = (size_t)seq * TOKB + tok0 + tbo * 16 + 4 * fq;
      const f32x4 win = *(const f32x4*)(WIN + tix), flo = *(const f32x4*)(FLO + tix), deni = *(const f32x4*)(DEN + tix);
      const float decay = DEC[seq * NCH + nc];
#pragma unroll
      for (int eb = 0; eb < NEB + 1; ++eb) {
        bf16x8 cb0, cb1;
        { const f32x4 lo = C[0][eb], hi = C[1][eb]; cb0 = mk8((u32x4){pk2(lo[0], lo[1]), pk2(lo[2], lo[3]), pk2(hi[0], hi[1]), pk2(hi[2], hi[3])}); }
        { const f32x4 lo = C[2][eb], hi = C[3][eb]; cb1 = mk8((u32x4){pk2(lo[0], lo[1]), pk2(lo[2], lo[3]), pk2(hi[0], hi[1]), pk2(hi[2], hi[3])}); }
        f32x4 pa[4];
#pragma unroll
        for (int tb = 0; tb < 4; ++tb) pa[tb] = MFMA16(qc[tb][0], cb0, ((f32x4){0.f, 0.f, 0.f, 0.f}));
#pragma unroll
        for (int tb = 0; tb < 4; ++tb) pa[tb] = MFMA16(qc[tb][1], cb1, pa[tb]);
#pragma unroll
        for (int tb = 0; tb < 4; ++tb) {
          if (eb < NEB) red[((wave * 4 + tb) * NEB + eb) * 64 + lane] = pa[tb];
          else if (fr == 0) rn[(wave * 4 + tb) * 4 + fq] = pa[tb];
        }
      }
      M2_LOAD_Q(stn);
      f32x4 oi = {0.f, 0.f, 0.f, 0.f};
#pragma unroll
      for (int eb = 0; eb < NEB + 1; ++eb) {
        bf16x8 vw0, vw1;
        if (eb < NEB) {
          const u32x4 r0 = vr[eb][0], r1 = vr[eb][1];
          if (eb == ebo) { oi = MFMA16(sf0, mk8(r0), oi); oi = MFMA16(sf1, mk8(r1), oi); }
          vw0 = mk8((u32x4){pk2(bflo(r0.x) * wv[0][0][0], bfhi(r0.x) * wv[0][0][1]), pk2(bflo(r0.y) * wv[0][0][2], bfhi(r0.y) * wv[0][0][3]),
                            pk2(bflo(r0.z) * wv[0][1][0], bfhi(r0.z) * wv[0][1][1]), pk2(bflo(r0.w) * wv[0][1][2], bfhi(r0.w) * wv[0][1][3])});
          vw1 = mk8((u32x4){pk2(bflo(r1.x) * wv[1][0][0], bfhi(r1.x) * wv[1][0][1]), pk2(bflo(r1.y) * wv[1][0][2], bfhi(r1.y) * wv[1][0][3]),
                            pk2(bflo(r1.z) * wv[1][1][0], bfhi(r1.z) * wv[1][1][1]), pk2(bflo(r1.w) * wv[1][1][2], bfhi(r1.w) * wv[1][1][3])});
        } else {
          vw0 = mk8((u32x4){pk2(wv[0][0][0], wv[0][0][1]), pk2(wv[0][0][2], wv[0][0][3]), pk2(wv[0][1][0], wv[0][1][1]), pk2(wv[0][1][2], wv[0][1][3])});
          vw1 = mk8((u32x4){pk2(wv[1][0][0], wv[1][0][1]), pk2(wv[1][0][2], wv[1][0][3]), pk2(wv[1][1][0], wv[1][1][1]), pk2(wv[1][1][2], wv[1][1][3])});
        }
#pragma unroll
        for (int db = 0; db < 4; ++db) {
          f32x4 c = C[db][eb] * decay;
          c = MFMA16(kf[db][0], vw0, c); c = MFMA16(kf[db][1], vw1, c);
          C[db][eb] = c;
        }
      }
      asm volatile("s_waitcnt lgkmcnt(0)" ::: "memory");
      __builtin_amdgcn_s_barrier();
      asm volatile("" ::: "memory");
      f32x4 rdn[8], rd0[8];
#pragma unroll
      for (int w = 0; w < 8; ++w) { rdn[w] = rn[(w * 4 + tbo) * 4 + fq]; rd0[w] = red[((w * 4 + tbo) * NEB + ebo) * 64 + lane]; }
      const f32x4 pn = ((rdn[0] + rdn[1]) + (rdn[2] + rdn[3])) + ((rdn[4] + rdn[5]) + (rdn[6] + rdn[7]));
      const f32x4 pi = ((rd0[0] + rd0[1]) + (rd0[2] + rd0[3])) + ((rd0[4] + rd0[5]) + (rd0[6] + rd0[7]));
#pragma unroll
      for (int jj = 0; jj < 4; ++jj) {
        const float num = oi[jj] + win[jj] * pi[jj], den = deni[jj] + win[jj] * pn[jj];
        const float hv = num * __builtin_amdgcn_rcpf(fmaxf(fabsf(den), flo[jj]));
        HD[((size_t)x * RG + ml_lrow(bl, tok0 + tbo * 16 + 4 * fq + jj)) * EI + h * DH + e0 + ebo * 16 + fr] = (bf16_t)(pk2(hv, 0.f) & 0xffff);
      }
      M2_LOAD_KV(stn);
      asm volatile("s_waitcnt lgkmcnt(0)" ::: "memory");
      __builtin_amdgcn_s_barrier();
      asm volatile("" ::: "memory");
    }
    __syncthreads();
#undef M2_LOAD_Q
#undef M2_LOAD_KV
  }
}

__device__ __forceinline__ void ml_fin(const Params& p, const Ctx& cx, int j) {
  const int lane = cx.tid & 63, gw = cx.bid * 8 + (cx.tid >> 6), NGW = cx.nb * 8;
  char* ws = cx.ws;
  const bf16_t* XZ = (const bf16_t*)(ws + O_XZ); const bf16_t* HD = (const bf16_t*)(ws + O_HD);
  bf16_t* FIN = (bf16_t*)(ws + O_FIN);
  for (int u = gw; u < RG * 4; u += NGW) {
    const int lr = u >> 2, h = u & 3, f0 = h * DH + lane * 8;
    int pos, seglen;
    if (lr < GB * SEQ) { pos = lr & (SEQ - 1); seglen = SEQ; } else { pos = (lr - GB * SEQ) & (LC - 1); seglen = LC; }
    const u32x4 hf = *(const u32x4*)(HD + (size_t)lr * EI + f0), hb = *(const u32x4*)(HD + ((size_t)RG + lr) * EI + f0);
    const u32x4 zz = *(const u32x4*)(XZ + (size_t)lr * 4096 + 2048 + f0);
    const u32x4 x1 = *(const u32x4*)(XZ + (size_t)lr * 4096 + f0);
    u32x4 x0 = {0u, 0u, 0u, 0u}, x2 = {0u, 0u, 0u, 0u};
    if (pos > 0) x0 = *(const u32x4*)(XZ + (size_t)(lr - 1) * 4096 + f0);
    if (pos < seglen - 1) x2 = *(const u32x4*)(XZ + (size_t)(lr + 1) * 4096 + f0);
    float hv[8], xm0[8], xm1[8], xm2[8];
    const unsigned hfu[4] = {hf.x, hf.y, hf.z, hf.w}, hbu[4] = {hb.x, hb.y, hb.z, hb.w}, zu[4] = {zz.x, zz.y, zz.z, zz.w};
    const unsigned x0u[4] = {x0.x, x0.y, x0.z, x0.w}, x1u[4] = {x1.x, x1.y, x1.z, x1.w}, x2u[4] = {x2.x, x2.y, x2.z, x2.w};
    float s = 0.f;
#pragma unroll
    for (int i = 0; i < 4; ++i) {
      hv[2 * i] = (bflo(hfu[i]) + bflo(hbu[i])) * sigm_f(bflo(zu[i]));
      hv[2 * i + 1] = (bfhi(hfu[i]) + bfhi(hbu[i])) * sigm_f(bfhi(zu[i]));
      xm0[2 * i] = bflo(x0u[i]); xm0[2 * i + 1] = bfhi(x0u[i]); xm1[2 * i] = bflo(x1u[i]); xm1[2 * i + 1] = bfhi(x1u[i]); xm2[2 * i] = bflo(x2u[i]); xm2[2 * i + 1] = bfhi(x2u[i]);
      s += hv[2 * i] + hv[2 * i + 1];
    }
    const float mean = wave_sum(s, lane) * (1.f / DH); float s2 = 0.f;
#pragma unroll
    for (int i = 0; i < 8; ++i) { hv[i] -= mean; s2 += hv[i] * hv[i]; }
    const float rstd = __builtin_amdgcn_rsqf(wave_sum(s2, lane) * (1.f / DH) + LN_EPS);
    float o[8];
#pragma unroll
    for (int i = 0; i < 8; ++i) {
      const int f = f0 + i;
      const float xc = silu_f(IN(11)[(size_t)(j * 3 + 0) * EI + f] * xm0[i] + IN(11)[(size_t)(j * 3 + 1) * EI + f] * xm1[i] + IN(11)[(size_t)(j * 3 + 2) * EI + f] * xm2[i] + IN(12)[(size_t)j * EI + f]);
      o[i] = hv[i] * rstd * IN(17)[(size_t)j * EI + f] + IN(16)[(size_t)j * EI + f] * xc;
    }
    u32x4 ov; ov.x = pk2(o[0], o[1]); ov.y = pk2(o[2], o[3]); ov.z = pk2(o[4], o[5]); ov.w = pk2(o[6], o[7]);
    *(u32x4*)(FIN + nat(lr, f0, EI)) = ov;
  }
}

__device__ __forceinline__ void at_prep(const Params& p, const Ctx& cx) {
  const int lane = cx.tid & 63, gw = cx.bid * 8 + (cx.tid >> 6), NGW = cx.nb * 8;
  char* ws = cx.ws;
  bf16_t* ACT = (bf16_t*)(ws + O_ACT); bf16_t* KR = (bf16_t*)(ws + O_AKR); bf16_t* VT = (bf16_t*)(ws + O_AVT);
  const float* rc = (const float*)(ws + O_ROPE); const float* rs = rc + 4096 * 32;
  for (int row = gw; row < MROWS; row += NGW) {
    const bool lat = row < NLAT;
    const int b = lat ? row >> 12 : (row - NLAT) >> 8, pos = lat ? row & 4095 : (row - NLAT) & 255, tok = lat ? LC + pos : pos;
    bf16_t* rp = ACT + (size_t)row * 1536;
    {
      const u32x4 a = *(const u32x4*)(rp + 16 * lane), b2 = *(const u32x4*)(rp + 16 * lane + 8);
      const unsigned w[8] = {a.x, a.y, a.z, a.w, b2.x, b2.y, b2.z, b2.w};
      unsigned o[8];
      const int pp0 = (lane & 3) * 8;
#pragma unroll
      for (int i = 0; i < 8; ++i) {
        float x1 = bflo(w[i]) * 0.125f, x2 = bfhi(w[i]) * 0.125f;
        if (lat) { const float c = rc[pos * 32 + pp0 + i], s = rs[pos * 32 + pp0 + i]; const float y1 = x1 * c - x2 * s, y2 = x1 * s + x2 * c; x1 = y1; x2 = y2; }
        o[i] = pk2(x1, x2);
      }
      *(u32x4*)(rp + 16 * lane) = (u32x4){o[0], o[1], o[2], o[3]}; *(u32x4*)(rp + 16 * lane + 8) = (u32x4){o[4], o[5], o[6], o[7]};
    }
    {
      const u32x2 a = *(const u32x2*)(rp + 1024 + 4 * lane);
      const unsigned w[2] = {a.x, a.y}; unsigned o[2];
      const int g = lane >> 4, dd = (lane & 15) * 4, pp0 = dd >> 1;
#pragma unroll
      for (int i = 0; i < 2; ++i) {
        float x1 = bflo(w[i]), x2 = bfhi(w[i]);
        if (lat) { const float c = rc[pos * 32 + pp0 + i], s = rs[pos * 32 + pp0 + i]; const float y1 = x1 * c - x2 * s, y2 = x1 * s + x2 * c; x1 = y1; x2 = y2; }
        o[i] = pk2(x1, x2);
      }
      *(u32x2*)(KR + (((size_t)b * 4 + g) * TOKB + tok) * 64 + dd) = (u32x2){o[0], o[1]};
      const u32x2 v = *(const u32x2*)(rp + 1280 + 4 * lane);
      bf16_t* vp = VT + (((size_t)b * 4 + g) * 64 + dd) * TOKB + tok;
      vp[0] = (bf16_t)(v.x & 0xffff); vp[TOKB] = (bf16_t)(v.x >> 16); vp[2 * TOKB] = (bf16_t)(v.y & 0xffff); vp[3 * TOKB] = (bf16_t)(v.y >> 16);
    }
  }
}

__device__ __forceinline__ void at_core(const Params& p, const Ctx& cx) {
  const int lane = cx.tid & 63, gw = cx.bid * 8 + (cx.tid >> 6), NGW = cx.nb * 8, fr = lane & 15, fq = lane >> 4;
  char* ws = cx.ws;
  const bf16_t* ACT = (const bf16_t*)(ws + O_ACT); const bf16_t* KR = (const bf16_t*)(ws + O_AKR); const bf16_t* VT = (const bf16_t*)(ws + O_AVT);
  bf16_t* O = (bf16_t*)(ws + O_U);
  for (int u = gw; u < (MROWS / 16) * 4; u += NGW) {
    const int g = u & 3, qb = u >> 2, row0 = qb * 16;
    const bool lat = row0 < NLAT;
    const int b = lat ? row0 >> 12 : (row0 - NLAT) >> 8, q0 = lat ? row0 & 4095 : 0;
    bf16x8 qf[4][2];
    float mrun[4], lrun[4], sink[4];
    f32x4 oacc[4][4];
#pragma unroll
    for (int hh = 0; hh < 4; ++hh) {
      const bf16_t* qp = ACT + (size_t)(row0 + fr) * 1536 + (g * 4 + hh) * 64 + 8 * fq;
      qf[hh][0] = *(const bf16x8*)qp; qf[hh][1] = *(const bf16x8*)(qp + 32);
      sink[hh] = IN(20)[g * 4 + hh]; mrun[hh] = sink[hh]; lrun[hh] = 0.f;
#pragma unroll
      for (int d2 = 0; d2 < 4; ++d2) oacc[hh][d2] = (f32x4){0.f, 0.f, 0.f, 0.f};
    }
    const bf16_t* kbase = KR + ((size_t)b * 4 + g) * TOKB * 64;
    const bf16_t* vbase = VT + ((size_t)b * 4 + g) * 64 * TOKB;
    int wlo = 0, whi = -1;
    if (lat) { wlo = max(0, q0 - 128) & ~31; whi = min(SEQ - 1, q0 + 143); }
    const int nwin = lat ? (whi - wlo) / 32 + 1 : 0;
    for (int ti = 0; ti < 8 + nwin; ++ti) {
      const bool isw = ti >= 8;
      const int kpos0 = isw ? wlo + (ti - 8) * 32 : 0;
      const int tk0 = isw ? LC + kpos0 : ti * 32;
      const bf16_t* kp = kbase + (size_t)(tk0 + fr) * 64 + 8 * fq;
      const bf16x8 k00 = *(const bf16x8*)kp, k01 = *(const bf16x8*)(kp + 32), k10 = *(const bf16x8*)(kp + 16 * 64), k11 = *(const bf16x8*)(kp + 16 * 64 + 32);
      bf16x8 vfr[4];
#pragma unroll
      for (int d2 = 0; d2 < 4; ++d2) {
        const bf16_t* vp = vbase + (size_t)(d2 * 16 + fr) * TOKB + tk0 + 4 * fq;
        vfr[d2] = mk8(*(const u32x2*)vp, *(const u32x2*)(vp + 16));
      }
      bool okm[8];
#pragma unroll
      for (int i = 0; i < 8; ++i) {
        const int kpos = kpos0 + (i >> 2) * 16 + 4 * fq + (i & 3), dlt = (q0 + fr) - kpos;
        okm[i] = !isw || (dlt <= 128 && dlt >= -128);
      }
#pragma unroll
      for (int hh = 0; hh < 4; ++hh) {
        f32x4 s0 = {0.f, 0.f, 0.f, 0.f}, s1 = {0.f, 0.f, 0.f, 0.f};
        s0 = MFMA16(k00, qf[hh][0], s0); s0 = MFMA16(k01, qf[hh][1], s0);
        s1 = MFMA16(k10, qf[hh][0], s1); s1 = MFMA16(k11, qf[hh][1], s1);
        float sv[8]; float tmax = -3.0e38f;
#pragma unroll
        for (int i = 0; i < 8; ++i) { sv[i] = okm[i] ? (i < 4 ? s0[i] : s1[i - 4]) : -3.0e38f; tmax = fmaxf(tmax, sv[i]); }
        tmax = fmaxf(tmax, shx(tmax, 16, lane)); tmax = fmaxf(tmax, shx(tmax, 32, lane));
        const float mnew = fmaxf(mrun[hh], tmax), scale = __expf(mrun[hh] - mnew);
        mrun[hh] = mnew;
        float pv[8];
#pragma unroll
        for (int i = 0; i < 8; ++i) pv[i] = okm[i] ? __expf(sv[i] - mnew) : 0.f;
        const u32x4 pu = {pk2(pv[0], pv[1]), pk2(pv[2], pv[3]), pk2(pv[4], pv[5]), pk2(pv[6], pv[7])};
        const float ps = ((bflo(pu.x) + bfhi(pu.x)) + (bflo(pu.y) + bfhi(pu.y))) + ((bflo(pu.z) + bfhi(pu.z)) + (bflo(pu.w) + bfhi(pu.w)));
        lrun[hh] = lrun[hh] * scale + ps;
        const bf16x8 pf = mk8(pu);
        float scq[4];
#pragma unroll
        for (int jj = 0; jj < 4; ++jj) scq[jj] = shi(scale, 4 * fq + jj);
#pragma unroll
        for (int d2 = 0; d2 < 4; ++d2) {
          f32x4 o = oacc[hh][d2];
          o[0] *= scq[0]; o[1] *= scq[1]; o[2] *= scq[2]; o[3] *= scq[3];
          oacc[hh][d2] = MFMA16(pf, vfr[d2], o);
        }
      }
    }
#pragma unroll
    for (int hh = 0; hh < 4; ++hh) {
      float l = lrun[hh];
      l += shx(l, 16, lane); l += shx(l, 32, lane);
      l += __expf(sink[hh] - mrun[hh]);
      const float inv = __builtin_amdgcn_rcpf(l);
      float iq[4];
#pragma unroll
      for (int jj = 0; jj < 4; ++jj) iq[jj] = shi(inv, 4 * fq + jj);
#pragma unroll
      for (int d2 = 0; d2 < 4; ++d2)
#pragma unroll
        for (int jj = 0; jj < 4; ++jj)
          O[nat(row0 + 4 * fq + jj, (g * 4 + hh) * 64 + d2 * 16 + fr, D)] = (bf16_t)(pk2(oacc[hh][d2][jj] * iq[jj], 0.f) & 0xffff);
    }
  }
}

__device__ __forceinline__ void sc_conv(const Params& p, const Ctx& cx) {
  const int gt = cx.bid * 512 + cx.tid, gs = cx.nb * 512;
  const bf16_t* ACT = (const bf16_t*)(cx.ws + O_ACT); bf16_t* O = (bf16_t*)(cx.ws + O_U);
  const float* cw = IN(23);
  for (int i = gt; i < MROWS * 128; i += gs) {
    const int row = i >> 7, c0 = (i & 127) * 8;
    int pos, seglen;
    if (row < NLAT) { pos = row & (SEQ - 1); seglen = SEQ; } else { pos = (row - NLAT) & (LC - 1); seglen = LC; }
    float accv[8];
#pragma unroll
    for (int e = 0; e < 8; ++e) accv[e] = 0.f;
#pragma unroll
    for (int k = 0; k < 3; ++k) {
      const int pp = pos + k - 1;
      if (pp < 0 || pp >= seglen) continue;
      const bf16_t* rp = ACT + (size_t)(row + k - 1) * 3072;
      const u32x4 cgv = *(const u32x4*)(rp + 1024 + c0), xtv = *(const u32x4*)(rp + 2048 + c0);
      const unsigned cu[4] = {cgv.x, cgv.y, cgv.z, cgv.w}, xu[4] = {xtv.x, xtv.y, xtv.z, xtv.w};
#pragma unroll
      for (int e = 0; e < 4; ++e) {
        accv[2 * e] += cw[k * D + c0 + 2 * e] * (bflo(cu[e]) * bflo(xu[e]));
        accv[2 * e + 1] += cw[k * D + c0 + 2 * e + 1] * (bfhi(cu[e]) * bfhi(xu[e]));
      }
    }
    const u32x4 bgv = *(const u32x4*)(ACT + (size_t)row * 3072 + c0);
    const unsigned bu[4] = {bgv.x, bgv.y, bgv.z, bgv.w};
    u32x4 o;
    o.x = pk2(bflo(bu[0]) * accv[0], bfhi(bu[0]) * accv[1]); o.y = pk2(bflo(bu[1]) * accv[2], bfhi(bu[1]) * accv[3]);
    o.z = pk2(bflo(bu[2]) * accv[4], bfhi(bu[2]) * accv[5]); o.w = pk2(bflo(bu[3]) * accv[6], bfhi(bu[3]) * accv[7]);
    *(u32x4*)(O + nat(row, c0, D)) = o;
  }
}

#define XB_TMO      128
#define XB_XCNT(j)  (256  + 64 * (j))
#define XB_XSUB(j)  (1280 + 64 * (j))
#define XB_XGEN(j)  (2304 + 64 * (j))
#define XB_TOP      3328
#define XB_TOPGEN   3392
#define XCD_BAR_WORDS 3456
#define XB_SPIN_CAP (1u << 18)
__device__ __forceinline__ unsigned xb_ld(unsigned* p)              { return __hip_atomic_load(p, __ATOMIC_RELAXED, __HIP_MEMORY_SCOPE_AGENT); }
__device__ __forceinline__ unsigned xb_add(unsigned* p, unsigned v) { return __hip_atomic_fetch_add(p, v, __ATOMIC_RELAXED, __HIP_MEMORY_SCOPE_AGENT); }
__device__ __forceinline__ unsigned xb_xcc_id() { return (unsigned)__builtin_amdgcn_s_getreg((3 << 11) | 20) & 0xFu; }
#define XB_SPIN(cond, bar) do { unsigned _sp = 0; while (cond) { __builtin_amdgcn_s_sleep(1); \
    if ((++_sp & 255u) == 0u) { if (xb_ld(&(bar)[XB_TMO])) break; if (_sp > XB_SPIN_CAP) { atomicAdd(&(bar)[XB_TMO], 1u); break; } } } } while (0)
__device__ __forceinline__ void xcd_barrier_complete(unsigned* bar, unsigned x, unsigned& nloc, unsigned& nx) {
  const unsigned G = gridDim.x;
  unsigned sum, cnt, mine, sp = 0u;
  for (;;) {
    sum = 0u; cnt = 0u; mine = 0u;
#pragma unroll
    for (unsigned j = 0; j < 16; ++j) { const unsigned c = xb_ld(&bar[XB_XCNT(j)]); sum += c; cnt += (c > 0u) ? 1u : 0u; mine = (j == x) ? c : mine; }
    if (sum == G) break;
    __builtin_amdgcn_s_sleep(1);
    if ((++sp & 255u) == 0u) { if (xb_ld(&bar[XB_TMO])) break; if (sp > XB_SPIN_CAP) { atomicAdd(&bar[XB_TMO], 1u); break; } }
  }
  nloc = mine > 0u ? mine : 1u; nx = cnt > 0u ? cnt : 1u;
}
__device__ __forceinline__ void xcd_barrier(unsigned* bar, unsigned x, volatile LAS unsigned* st) {
  asm volatile("s_waitcnt vmcnt(0)" ::: "memory");
  __syncthreads();
  if (threadIdx.x == 0) {
    __builtin_amdgcn_s_waitcnt(0);
    unsigned nloc = st[0], nx = st[1];
    if (nloc == 0u) { xcd_barrier_complete(bar, x, nloc, nx); st[0] = nloc; st[1] = nx; }
    const unsigned old = xb_add(&bar[XB_XSUB(x)], 1u);
    const unsigned gen = old / nloc;
    if (old + 1u == (gen + 1u) * nloc) {
      __builtin_amdgcn_fence(__ATOMIC_RELEASE, "agent");
      asm volatile("s_waitcnt vmcnt(0)" ::: "memory");
      const unsigned og = xb_add(&bar[XB_TOP], 1u);
      const unsigned tg = og / nx;
      if (og + 1u == (tg + 1u) * nx) xb_add(&bar[XB_TOPGEN], 1u);
      else XB_SPIN(xb_ld(&bar[XB_TOPGEN]) == tg, bar);
      __builtin_amdgcn_fence(__ATOMIC_ACQUIRE, "agent");
      xb_add(&bar[XB_XGEN(x)], 1u);
      asm volatile("s_waitcnt vmcnt(0)" ::: "memory");
    } else {
      XB_SPIN(xb_ld(&bar[XB_XGEN(x)]) == gen, bar);
      __builtin_amdgcn_fence(__ATOMIC_ACQUIRE, "agent");
      asm volatile("s_waitcnt vmcnt(0)" ::: "memory");
    }
  }
  __syncthreads();
}

#ifndef ENMASK
#define ENMASK 0xffff
#endif
#define EN(i) ((ENMASK >> (i)) & 1)
enum { OP_PRO = 0, OP_LN0, OP_LN1, OP_LNF, OP_FFI, OP_FFO, OP_UP, OP_M0, OP_GAT, OP_S, OP_M2, OP_FIN, OP_DN, OP_AQ, OP_APREP, OP_ACORE, OP_AO, OP_SI, OP_SCONV, OP_SO, OP_DNUP };
__global__ void __launch_bounds__(512) fwd_megakernel(Params p) {
  cg::grid_group grid = cg::this_grid();
  const int wave_s = __builtin_amdgcn_readfirstlane((int)threadIdx.x >> 6);
  volatile LAS unsigned* xst = (volatile LAS unsigned*)((LAS unsigned char*)lds_raw + (LDS_BYTES - 16));
  if (threadIdx.x == 0) { xst[0] = 0u; xst[1] = 0u; }
  __syncthreads();
  unsigned* xbar = (unsigned*)(p.ws + O_BAR);
  const unsigned xcc = xb_xcc_id();
  if (threadIdx.x == 0) (void)xb_add(&xbar[XB_XCNT(xcc)], 1u);
#ifdef DUP_OP
  int rep = 0;
#endif
  for (int ph = 0; ph < p.nph; ++ph) {
    const unsigned w = p.prog[ph];
    const int op = w & 255, a = (w >> 8) & 255, b = (w >> 16) & 255, c = (w >> 24) & 255;
#define MKCTX int z; asm volatile("s_mov_b32 %0, 0" : "=s"(z)); \
    GAS char* wsq = (GAS char*)p.ws; GAS float* outq = (GAS float*)p.out; int bidq = (int)blockIdx.x, nbq = (int)gridDim.x; \
    asm volatile("" : "+s"(wsq), "+s"(outq), "+s"(bidq), "+s"(nbq)); \
    const Ctx cx{wave_s * 64 + (int)__builtin_amdgcn_mbcnt_hi(~0u, __builtin_amdgcn_mbcnt_lo(~0u, (unsigned)z)), bidq, nbq, z, (char*)wsq, (float*)outq};
    if (EN(0) && op == OP_PRO) { MKCTX prologue(p, cx); }
    else if (EN(1) && op == OP_LN0) { MKCTX lnmod_phase<0>(p, cx, 0, 0, 0); }
    else if (EN(1) && op == OP_LN1) { MKCTX lnmod_phase<1>(p, cx, a, b, c); }
    else if (EN(1) && op == OP_LNF) { MKCTX lnmod_phase<2>(p, cx, a, 0, 0); }
    else if (EN(2) && op == OP_M0) { MKCTX ml_m0(p, cx, a); }
    else if (EN(3) && op == OP_GAT) { MKCTX ml_gates(p, cx, a); }
    else if (EN(4) && op == OP_S) { MKCTX ml_s(p, cx); }
    else if (EN(5) && op == OP_M2) { MKCTX ml_m2(p, cx); }
    else if (EN(6) && op == OP_FIN) { MKCTX ml_fin(p, cx, a); }
    else if (EN(7) && op == OP_APREP) { MKCTX at_prep(p, cx); }
    else if (EN(8) && op == OP_ACORE) { MKCTX at_core(p, cx); }
    else if (EN(9) && op == OP_SCONV) { MKCTX sc_conv(p, cx); }
    else if (EN(10)) {
      MKCTX
      char* ws = cx.ws;
      const RowMap idm{0, 0, 1 << 30};
      bf16_t* U = (bf16_t*)(ws + O_U); bf16_t* ACT = (bf16_t*)(ws + O_ACT);
      const float* MODT = (const float*)(ws + O_MODT);
      const int nrep = op == OP_DNUP ? 2 : 1;
      for (int rep = 0; rep < nrep; ++rep) {
        const int op2 = op == OP_DNUP ? (rep == 0 ? (int)OP_UP : (int)OP_DN) : op;
        const int c2 = (op == OP_DNUP && rep == 0) ? c + 1 : c;
        Ctx cg_ = cx;
        if (op == OP_DNUP && rep == 1) cg_.bid = (cx.bid + cx.nb - 32) % cx.nb;
        const bf16_t* A = U; const bf16_t* Bt; int K = 1024, nM = MROWS / 256, nN; RowMap am = idm, cm = idm;
        Epi E; E.kind = 2; E.O = ACT; E.ldc = 0; E.modl = MODT + (size_t)b * 9 * 9216; E.slot = 1; E.wgt = 1.0f;
        E.ln = b * 3 + 1 - 1;
        if (op2 == OP_FFI) { Bt = (const bf16_t*)(ws + O_WFI) + (size_t)a * 5632 * 1024; nN = 22; E.kind = 1; if (c) nM = NLAT / 256; }
        else if (op2 == OP_FFO) { A = ACT; Bt = (const bf16_t*)(ws + O_WFO) + (size_t)a * 1024 * 2816; K = 2816; nN = 4; E.slot = c & 3; E.wgt = 0.5f; E.ln = b * 3 + (c & 3) - 1; if (c & 4) nM = NLAT / 256; }
        else if (op2 == OP_UP) { Bt = (const bf16_t*)(ws + O_WUP) + (size_t)a * 4096 * 1024; nM = RG / 256; nN = 16; am = RowMap{c2 * GB * SEQ, NLAT + c2 * GB * LC, GB * SEQ / 256}; E.kind = 0; E.O = (bf16_t*)(ws + O_XZ); E.ldc = 4096; }
        else if (op2 == OP_DN) { A = (const bf16_t*)(ws + O_FIN); Bt = (const bf16_t*)(ws + O_WDN) + (size_t)a * 1024 * 2048; K = 2048; nM = RG / 256; nN = 4; cm = RowMap{c2 * GB * SEQ, NLAT + c2 * GB * LC, GB * SEQ / 256}; }
        else if (op2 == OP_AQ) { Bt = (const bf16_t*)(ws + O_WAQ); nN = 6; E.kind = 0; E.ldc = 1536; }
        else if (op2 == OP_AO) { Bt = (const bf16_t*)(ws + O_WAO); nN = 4; }
        else if (op2 == OP_SI) { Bt = (const bf16_t*)(ws + O_WSI); nN = 12; E.kind = 0; E.ldc = 3072; }
        else { Bt = (const bf16_t*)(ws + O_WSO); nN = 4; }
        gemm_phase(cg_, A, am, Bt, K, nM, nN, cm, E);
      }
    }
    if (ph == 0) grid.sync(); else xcd_barrier(xbar, xcc, xst);
#ifdef DUP_OP
    if (op == DUP_OP && rep + 1 < DUP_N) { ++rep; --ph; } else rep = 0;
#endif
  }
}

static int build_program(unsigned* prog) {
  int n = 0;
  auto W = [&](int op, int a, int b, int c) { prog[n++] = (unsigned)op | ((unsigned)a << 8) | ((unsigned)b << 16) | ((unsigned)c << 24); };
  W(OP_PRO, 0, 0, 0);
  W(OP_LN0, 0, 0, 0);
  for (int layer = 0; layer < DEPTH; ++layer) {
    const int kind = layer % 3, j = layer / 3;
    W(OP_FFI, layer * 2, layer, 0); W(OP_FFO, layer * 2, layer, 0);
    W(OP_LN1, layer * 3 + 0, layer, 1);
    if (kind == 0) {
      for (int g = 0; g < NG; ++g) { if (g == 0) W(OP_UP, j, layer, g); W(OP_M0, j, 0, 0); W(OP_GAT, j, 0, 0); W(OP_S, 0, 0, 0); W(OP_M2, 0, 0, 0); W(OP_FIN, j, 0, 0); W(g + 1 < NG ? OP_DNUP : OP_DN, j, layer, g); }
    } else if (kind == 1) { W(OP_AQ, 0, layer, 0); W(OP_APREP, 0, 0, 0); W(OP_ACORE, 0, 0, 0); W(OP_AO, 0, layer, 0); }
    else { W(OP_SI, 0, layer, 0); W(OP_SCONV, 0, 0, 0); W(OP_SO, 0, layer, 0); }
    W(OP_LN1, layer * 3 + 1, layer, 2);
    const int lo = (layer + 1 == DEPTH) ? 1 : 0;
    W(OP_FFI, layer * 2 + 1, layer, lo); W(OP_FFO, layer * 2 + 1, layer, 2 | (lo << 2));
    if (layer + 1 < DEPTH) W(OP_LN1, layer * 3 + 2, layer + 1, 0); else W(OP_LNF, layer * 3 + 2, 0, 0);
  }
  return n;
}

extern "C" void kernel_launch(void* const* d_in, const int* in_sizes, int n_in, void* d_out, int out_size, void* d_ws, size_t ws_size, hipStream_t stream) {
  static int grid_blocks = 0;
  if (!grid_blocks) {
    int dev = 0, cus = 0, per_cu = 0;
    (void)hipGetDevice(&dev);
    (void)hipDeviceGetAttribute(&cus, hipDeviceAttributeMultiprocessorCount, dev);
    (void)hipFuncSetAttribute((const void*)fwd_megakernel, hipFuncAttributeMaxDynamicSharedMemorySize, LDS_BYTES);
    (void)hipOccupancyMaxActiveBlocksPerMultiprocessor(&per_cu, fwd_megakernel, 512, LDS_BYTES);
    if (cus <= 0) cus = 256;
    grid_blocks = cus;
    if (ws_size < WS_END || n_in != 25) fprintf(stderr, "kernel_launch: workspace %zu < %zu or n_in %d != 25\n", ws_size, (size_t)WS_END, n_in);
    if (per_cu < 1) fprintf(stderr, "kernel_launch: occupancy query says %d blocks per CU\n", per_cu);
  }
  Params p{};
  for (int i = 0; i < 25; ++i) p.in[i] = (const float*)d_in[i];
  p.out = (float*)d_out; p.ws = (char*)d_ws;
  p.nph = build_program(p.prog);
  (void)hipMemsetAsync((char*)d_ws + O_BAR, 0, XCD_BAR_WORDS * 4, stream);
  void* args[] = {&p};
  hipError_t e = hipLaunchCooperativeKernel((void*)fwd_megakernel, dim3(grid_blocks), dim3(512), args, LDS_BYTES, stream);
  if (e != hipSuccess) fprintf(stderr, "cooperative launch failed: %s (grid %d)\n", hipGetErrorString(e), grid_blocks);
}
```

```cpp
#include <hip/hip_runtime.h>
#include <hip/hip_cooperative_groups.h>
#include <cstdio>
#include <cstdint>
namespace cg = cooperative_groups;

typedef unsigned short bf16_t;
typedef short bf16x8 __attribute__((ext_vector_type(8)));
typedef short bf16x4 __attribute__((ext_vector_type(4)));
typedef float f32x4 __attribute__((ext_vector_type(4)));
typedef unsigned u32x2 __attribute__((ext_vector_type(2)));
typedef unsigned u32x4 __attribute__((ext_vector_type(4)));

constexpr int D = 1024, NB = 8, SEQ = 4096, LC = 256, DEPTH = 4, FF = 2816, EI = 2048, DH = 512;
constexpr int NLAT = NB * SEQ, NCTX = NB * LC, MROWS = NLAT + NCTX;
constexpr int TOKB = LC + SEQ;
constexpr int NCH = TOKB / 64;
constexpr int GB = 2, NG = NB / GB, RG = GB * TOKB;
constexpr int NSEQ = GB * 8;
constexpr float ALPHA = 1.681792830507429f, LN_EPS = 1e-5f;
constexpr int LDS_BYTES = 144 * 1024;

constexpr size_t al256(size_t x) { return (x + 255) & ~(size_t)255; }
constexpr size_t O_WFI = 0;
constexpr size_t O_WFO = O_WFI + (size_t)8 * 5632 * 1024 * 2;
constexpr size_t O_WUP = O_WFO + (size_t)8 * 1024 * 2816 * 2;
constexpr size_t O_WDN = O_WUP + (size_t)2 * 4096 * 1024 * 2;
constexpr size_t O_WAQ = O_WDN + (size_t)2 * 1024 * 2048 * 2;
constexpr size_t O_WAO = O_WAQ + (size_t)1536 * 1024 * 2;
constexpr size_t O_WSI = O_WAO + (size_t)1024 * 1024 * 2;
constexpr size_t O_WSO = O_WSI + (size_t)3072 * 1024 * 2;
constexpr size_t O_WG = O_WSO + (size_t)1024 * 1024 * 2;
constexpr size_t O_MODT = O_WG + (size_t)2 * 16 * 6144 * 2;
constexpr size_t O_ROPE = O_MODT + (size_t)4 * 9 * 9216 * 4;
constexpr size_t O_HCTX = O_ROPE + (size_t)2 * 4096 * 32 * 4;
constexpr size_t O_U = O_HCTX + (size_t)NCTX * D * 4;
constexpr size_t O_R = O_U + (size_t)MROWS * D * 2;
constexpr size_t O_XZ = O_R;
constexpr size_t O_QK = O_XZ + (size_t)RG * 4096 * 2;
constexpr size_t O_KT = O_QK + (size_t)RG * 4096 * 2;
constexpr size_t O_VT = O_KT + (size_t)GB * EI * TOKB * 2;
constexpr size_t O_SP = O_VT + (size_t)GB * EI * TOKB * 2;
constexpr size_t O_HD = O_SP + (size_t)NSEQ * NCH * 4096 * 2;
constexpr size_t O_FIN = O_HD + (size_t)2 * RG * EI * 2;
constexpr size_t O_GAT = O_FIN + (size_t)RG * EI * 2;
constexpr size_t SZ_ST = (size_t)NSEQ * TOKB * 4;
constexpr size_t O_BL = O_GAT, O_IG = O_BL + SZ_ST, O_WIN = O_IG + SZ_ST, O_FLO = O_WIN + SZ_ST, O_DEN = O_FLO + SZ_ST, O_WSS = O_DEN + SZ_ST;
constexpr size_t O_GC = O_WSS + SZ_ST;
constexpr size_t O_QF = O_GC + (size_t)3 * NSEQ * NCH * 4 + 256;
constexpr size_t O_REND_ML = O_QF + (size_t)GB * EI * TOKB * 2;
constexpr size_t O_ACT = O_R;
constexpr size_t O_AKR = O_R + (size_t)MROWS * 3072 * 2;
constexpr size_t O_AVT = O_AKR + (size_t)NB * 4 * TOKB * 64 * 2;
constexpr size_t O_REND_AT = O_AVT + (size_t)NB * 4 * TOKB * 64 * 2;
constexpr size_t O_BAR = (O_REND_ML > O_REND_AT ? O_REND_ML : O_REND_AT);
constexpr size_t O_STATS = O_BAR + 3456 * 4 + 256;
constexpr size_t O_LNT = O_STATS + (size_t)MROWS * 8 + 256;
constexpr size_t WS_END = O_LNT + (size_t)12 * 2 * D * 4 + 256;

struct Params {
  const float* in[25];
  float* out;
  char* ws;
  int nph; int pad0;
  unsigned prog[126];
};

#define GAS __attribute__((address_space(1)))
#define IN(k) ((const float*)(const GAS float*)p.in[(k) + cx.z])
struct Ctx { int tid, bid, nb, z; char* ws; float* out; };
extern __shared__ __attribute__((aligned(16))) char lds_raw[];

__device__ __forceinline__ unsigned pk2(float lo, float hi) { unsigned r; asm volatile("v_cvt_pk_bf16_f32 %0, %1, %2" : "=v"(r) : "v"(lo), "v"(hi)); return r; }
__device__ __forceinline__ float bf2f(unsigned short v) { return __uint_as_float(((unsigned)v) << 16); }
__device__ __forceinline__ float bflo(unsigned v) { return __uint_as_float(v << 16); }
__device__ __forceinline__ float bfhi(unsigned v) { return __uint_as_float(v & 0xffff0000u); }
__device__ __forceinline__ float silu_f(float x) { return x * __builtin_amdgcn_rcpf(1.f + __expf(-x)); }
__device__ __forceinline__ float sigm_f(float x) { return __builtin_amdgcn_rcpf(1.f + __expf(-x)); }
__device__ __forceinline__ float shi(float v, int srclane) { return __int_as_float(__builtin_amdgcn_ds_bpermute(srclane << 2, __float_as_int(v))); }
__device__ __forceinline__ float shx(float v, int m, int lane) { return shi(v, lane ^ m); }
__device__ __forceinline__ float wave_sum(float v, int lane) {
#pragma unroll
  for (int o = 1; o < 64; o <<= 1) v += shx(v, o, lane);
  return v;
}
__device__ __forceinline__ bf16x8 mk8(u32x4 v) { union { u32x4 u; bf16x8 b; } x; x.u = v; return x.b; }
__device__ __forceinline__ bf16x8 mk8(u32x2 a, u32x2 b) { union { u32x4 u; bf16x8 b; } x; x.u = (u32x4){a.x, a.y, b.x, b.y}; return x.b; }
__device__ __forceinline__ float* hrow(const Ctx& cx, int row) { return row < NLAT ? cx.out + (size_t)row * D : (float*)(cx.ws + O_HCTX) + (size_t)(row - NLAT) * D; }
#define MFMA16(a, b, c) __builtin_amdgcn_mfma_f32_16x16x32_bf16(a, b, c, 0, 0, 0)
__device__ __forceinline__ size_t nat(int r, int c, int K) { return ((size_t)(r >> 4) * (K >> 5) + (c >> 5)) * 512 + (r & 15) * 32 + (c & 31); }

constexpr int BM = 256, BK = 64, HALF = 128, HT = HALF * BK, NXCD = 8, WGM = 4;
__device__ __forceinline__ int lds_byte(int r, int c) {
  int st = (r >> 4) * 2 + (c >> 5), rr = r & 15, cc = c & 31, ob = rr * 64 + cc * 2;
  return st * 1024 + (ob ^ (((ob >> 9) & 1) << 5));
}
__device__ __forceinline__ void stage_rc(int b, int& R, int& C) {
  int st = b / 1024, sb = b % 1024, swz = sb ^ (((sb >> 9) & 1) << 5);
  R = (st >> 1) * 16 + swz / 64; C = (st & 1) * 32 + (swz % 64) / 2;
}
struct RowMap { int lat0, ctx0, nlat; __device__ __forceinline__ int row0(int pm) const { return pm < nlat ? lat0 + pm * 256 : ctx0 + (pm - nlat) * 256; } };

typedef f32x4 Acc[2][2][4][2];

struct Epi {
  int kind; bf16_t* O; int ldc; const float* modl; int slot; float wgt;
  int ln;
};
__device__ __forceinline__ void run_epi(const Ctx& cx, const Epi E, const Acc& acc, int r0, int pn, int wr, int wc, int fr, int fq) {
  if (E.kind == 0) {
#pragma unroll
    for (int ai = 0; ai < 2; ++ai)
#pragma unroll
      for (int m = 0; m < 4; ++m) {
        bf16_t* rp = E.O + (size_t)(r0 + ai * HALF + wr * 64 + m * 16 + fr) * E.ldc + pn * 256 + wc * 32 + 4 * fq;
#pragma unroll
        for (int bj = 0; bj < 2; ++bj)
#pragma unroll
          for (int n = 0; n < 2; ++n) {
            f32x4 v = acc[ai][bj][m][n];
            u32x2 o; o.x = pk2(v[0], v[1]); o.y = pk2(v[2], v[3]);
            *(u32x2*)(rp + bj * HALF + n * 16) = o;
          }
      }
  } else if (E.kind == 1) {
#pragma unroll
    for (int ai = 0; ai < 2; ++ai)
#pragma unroll
      for (int m = 0; m < 4; ++m) {
        const int rrow = r0 + ai * HALF + wr * 64 + m * 16 + fr, fcol = pn * 128 + wc * 16 + 4 * fq;
#pragma unroll
        for (int bj = 0; bj < 2; ++bj) {
          f32x4 g = acc[ai][bj][m][0], v = acc[ai][bj][m][1];
          u32x2 o; o.x = pk2(silu_f(g[0]) * v[0], silu_f(g[1]) * v[1]); o.y = pk2(silu_f(g[2]) * v[2], silu_f(g[3]) * v[3]);
          *(u32x2*)(E.O + nat(rrow, fcol + bj * 64, FF)) = o;
        }
      }
  } else {
    const int midx = r0 < NLAT ? (r0 >> 12) : 8;
    const int cb = pn * 256 + wc * 32 + 4 * fq;
    const float* gp = E.modl + (size_t)midx * 9216 + (3 * E.slot + 2) * D + cb;
    f32x4 gv[2][2], lg[2][2], lb[2][2];
#pragma unroll
    for (int bj = 0; bj < 2; ++bj)
#pragma unroll
      for (int n = 0; n < 2; ++n) {
        gv[bj][n] = *(const f32x4*)(gp + bj * HALF + n * 16) * E.wgt;
        if (E.ln >= 0) { const float* lt = (const float*)(cx.ws + O_LNT) + (size_t)E.ln * 2 * D + cb + bj * HALF + n * 16; lg[bj][n] = *(const f32x4*)lt; lb[bj][n] = *(const f32x4*)(lt + D); }
        else { lg[bj][n] = (f32x4){1.f, 1.f, 1.f, 1.f}; lb[bj][n] = (f32x4){0.f, 0.f, 0.f, 0.f}; }
      }
#pragma unroll
    for (int ai = 0; ai < 2; ++ai)
#pragma unroll
      for (int m = 0; m < 4; ++m) {
        const int row = r0 + ai * HALF + wr * 64 + m * 16 + fr;
        float* rp = hrow(cx, row) + cb;
        float mean = 0.f, rstd = 1.f;
        if (E.ln >= 0) { const float2 st = *(const float2*)((const float*)(cx.ws + O_STATS) + (size_t)row * 2); mean = st.x; rstd = st.y; }
        f32x4 h[2][2];
#pragma unroll
        for (int bj = 0; bj < 2; ++bj)
#pragma unroll
          for (int n = 0; n < 2; ++n) h[bj][n] = *(const f32x4*)(rp + bj * HALF + n * 16);
#pragma unroll
        for (int bj = 0; bj < 2; ++bj)
#pragma unroll
          for (int n = 0; n < 2; ++n) *(f32x4*)(rp + bj * HALF + n * 16) = ((h[bj][n] - mean) * rstd) * lg[bj][n] + lb[bj][n] + gv[bj][n] * acc[ai][bj][m][n];
        __builtin_amdgcn_sched_barrier(0);
      }
  }
}

#define LAS __attribute__((address_space(3)))
__device__ __forceinline__ void gemm_phase(const Ctx& cx, const bf16_t* __restrict__ A, RowMap am, const bf16_t* __restrict__ Bt, int K, int nM, int nN, RowMap cm, const Epi epi) {
  LAS unsigned char* lds = (LAS unsigned char*)lds_raw;
  constexpr int HTB = HT * 2;
  const int tid = cx.tid, wid = tid >> 6, lane = tid & 63, wr = wid >> 2, wc = wid & 3, fr = lane & 15, fq = lane >> 4;
  unsigned voff[2];
#pragma unroll
  for (int i = 0; i < 2; ++i) { const int st = wid + 8 * i, sb = lane * 16; voff[i] = (unsigned)(((st >> 1) * (K >> 5) + (st & 1)) * 1024 + (sb ^ (((sb >> 9) & 1) << 5))); }
  const size_t kstep = 2048, hstep = (size_t)8 * (K >> 5) * 1024;
  const unsigned ldsw = (unsigned)wid * 1024u;
  const int aoff = lds_byte(wr * 64 + fr, fq * 8), boff = lds_byte(wc * 32 + fr, fq * 8);
#define G_SA(b, h) (((b) * 2 + (h)) * HTB)
#define G_SB(b, h) ((4 + (b) * 2 + (h)) * HTB)
#define STAGE(bufoff, gbase) do { _Pragma("unroll") for (int _i = 0; _i < 2; ++_i) \
    __builtin_amdgcn_global_load_lds((const unsigned*)((const char*)(gbase) + voff[_i]), (LAS unsigned*)(lds + (bufoff) + ldsw + _i * 8192), 16, 0, 0); } while (0)
#define LDA(dst, b, h) do { _Pragma("unroll") for (int m = 0; m < 4; ++m) _Pragma("unroll") for (int k = 0; k < 2; ++k) dst[m][k] = *(const LAS bf16x8*)(lds + G_SA(b, h) + aoff + m * 2048 + k * 1024); } while (0)
#define LDB(dst, b, h) do { _Pragma("unroll") for (int n = 0; n < 2; ++n) _Pragma("unroll") for (int k = 0; k < 2; ++k) dst[n][k] = *(const LAS bf16x8*)(lds + G_SB(b, h) + boff + n * 2048 + k * 1024); } while (0)
#define MMA(ai, bj, At, Bt_) do { __builtin_amdgcn_s_setprio(1); _Pragma("unroll") for (int m = 0; m < 4; ++m) _Pragma("unroll") for (int n = 0; n < 2; ++n) _Pragma("unroll") for (int k = 0; k < 2; ++k) \
      acc[ai][bj][m][n] = MFMA16(Bt_[n][k], At[m][k], acc[ai][bj][m][n]); \
    __builtin_amdgcn_s_setprio(0); } while (0)
#define WAIT_V(n) asm volatile("s_waitcnt vmcnt(" #n ")" ::: "memory")
#define WAIT_L(n) asm volatile("s_waitcnt lgkmcnt(" #n ")" ::: "memory")
#define BAR __builtin_amdgcn_s_barrier()
#define SCHED __builtin_amdgcn_sched_barrier(0)
  const int nwg = nM * nN;
  const int nt = K / BK;
  const int wid_s = __builtin_amdgcn_readfirstlane(wid);
#define DECODE(L_, pm_, pn_) do { int wgid = (L_); \
    { int q = nwg / NXCD, r = nwg % NXCD, xcd = wgid % NXCD, off = wgid / NXCD; wgid = (xcd < r ? xcd * (q + 1) : r * (q + 1) + (xcd - r) * q) + off; } \
    const int nig = WGM * nN, gid = wgid / nig, fm = gid * WGM, gsz = min(nM - fm, WGM); \
    pm_ = fm + ((wgid % nig) % gsz); pn_ = (wgid % nig) / gsz; } while (0)
  int L = cx.bid;
  if (L < nwg) {
    int pm, pn;
    DECODE(L, pm, pn);
    const char* cA = (const char*)A + (size_t)(am.row0(pm) >> 4) * (K >> 5) * 1024; const char* cB = (const char*)Bt + (size_t)(pn * BM >> 4) * (K >> 5) * 1024;
    Acc acc;
#pragma unroll
    for (int a = 0; a < 2; ++a)
#pragma unroll
      for (int b = 0; b < 2; ++b)
#pragma unroll
        for (int m = 0; m < 4; ++m)
#pragma unroll
          for (int n = 0; n < 2; ++n) acc[a][b][m][n] = (f32x4){0.f, 0.f, 0.f, 0.f};
    bf16x8 At[4][2], B0[2][2], B1[2][2];
    STAGE(G_SB(0, 0), cB); STAGE(G_SA(0, 0), cA); STAGE(G_SB(0, 1), cB + hstep); STAGE(G_SA(0, 1), cA + hstep);
    if (wr == 1) BAR;
    WAIT_V(4); BAR;
    STAGE(G_SB(1, 0), cB + kstep); STAGE(G_SA(1, 0), cA + kstep); STAGE(G_SB(1, 1), cB + hstep + kstep);
    WAIT_V(6); BAR;
    for (;;) {
      const int Ln = L + cx.nb;
      const bool has_next = Ln < nwg;
      int pmn = pm, pnn = pn;
      if (has_next) DECODE(Ln, pmn, pnn);
      const char* nA = has_next ? (const char*)A + (size_t)(am.row0(pmn) >> 4) * (K >> 5) * 1024 : cA; const char* nB = has_next ? (const char*)Bt + (size_t)(pnn * BM >> 4) * (K >> 5) * 1024 : cB;
      for (int t = 0; t < nt; t += 2) {
        const bool last = (t == nt - 2);
        const char* a1 = cA + (size_t)(t + 1) * kstep;
        const char* a2 = last ? nA : cA + (size_t)(t + 2) * kstep; const char* b2 = last ? nB : cB + (size_t)(t + 2) * kstep;
        const char* a3 = a2 + kstep; const char* b3 = b2 + kstep;
        LDB(B0, 0, 0); SCHED; LDA(At, 0, 0); STAGE(G_SA(1, 1), a1 + hstep);
        WAIT_L(8); BAR; WAIT_L(0); MMA(0, 0, At, B0); BAR; SCHED;
        LDB(B1, 0, 1); STAGE(G_SB(0, 0), b2);
        BAR; WAIT_L(0); MMA(0, 1, At, B1); BAR;
        LDA(At, 0, 1); STAGE(G_SA(0, 0), a2);
        BAR; WAIT_L(0); MMA(1, 0, At, B0); BAR; SCHED;
        STAGE(G_SB(0, 1), b2 + hstep);
        WAIT_V(6); BAR; MMA(1, 1, At, B1); BAR;
        LDB(B0, 1, 0); SCHED; LDA(At, 1, 0); STAGE(G_SA(0, 1), a2 + hstep);
        WAIT_L(8); BAR; WAIT_L(0); MMA(0, 0, At, B0); BAR; SCHED;
        LDB(B1, 1, 1); STAGE(G_SB(1, 0), b3);
        BAR; WAIT_L(0); MMA(0, 1, At, B1); BAR;
        LDA(At, 1, 1); STAGE(G_SA(1, 0), a3);
        BAR; WAIT_L(0); MMA(1, 0, At, B0); BAR; SCHED;
        STAGE(G_SB(1, 1), b3 + hstep);
        WAIT_V(6); BAR; MMA(1, 1, At, B1); BAR;
      }
      { int t2 = wid_s * 64 + (int)__builtin_amdgcn_mbcnt_hi(~0u, __builtin_amdgcn_mbcnt_lo(~0u, (unsigned)cx.z)); asm volatile("" : "+v"(t2));
        const int w2 = t2 >> 6, l2 = t2 & 63;
        run_epi(cx, epi, acc, cm.row0(pm), pn, w2 >> 2, w2 & 3, l2 & 15, l2 >> 4); }
      if (!has_next) break;
#pragma unroll
      for (int a = 0; a < 2; ++a)
#pragma unroll
        for (int b = 0; b < 2; ++b)
#pragma unroll
          for (int m = 0; m < 4; ++m)
#pragma unroll
            for (int n = 0; n < 2; ++n) acc[a][b][m][n] = (f32x4){0.f, 0.f, 0.f, 0.f};
      pm = pmn; pn = pnn; cA = nA; cB = nB; L = Ln;
    }
    WAIT_V(0);
    if (wr == 0) BAR;
    BAR;
  }
  __syncthreads();
}

template <int MODE>
__device__ __forceinline__ int wrow(int c) {
  if (MODE == 0) return c;
  const int isv = c >= FF ? 1 : 0, f = c - isv * FF;
  return (f >> 7) * 256 + ((f >> 6) & 1) * 128 + ((f >> 4) & 3) * 32 + isv * 16 + (f & 15);
}
template <int MODE>
__device__ __forceinline__ void transpose_item(const float* __restrict__ W, int K, int N, bf16_t* __restrict__ WT, float* scr, int item, int lane) {
  const int nblk = N / 32, kb = item / nblk, nb = item % nblk, k0 = 64 * kb, n0 = 32 * nb;
#pragma unroll 8
  for (int i = 0; i < 32; ++i) { const int kk = 2 * i + (lane >> 5); scr[kk * 33 + (lane & 31)] = W[(size_t)(k0 + kk) * N + n0 + (lane & 31)]; }
  __builtin_amdgcn_wave_barrier(); asm volatile("s_waitcnt lgkmcnt(0)" ::: "memory");
  const int c = lane & 7;
#pragma unroll
  for (int j = 0; j < 4; ++j) {
    const int n = (lane >> 3) + 8 * j; const float* s = scr + (8 * c) * 33 + n;
    u32x4 o; o.x = pk2(s[0 * 33], s[1 * 33]); o.y = pk2(s[2 * 33], s[3 * 33]); o.z = pk2(s[4 * 33], s[5 * 33]); o.w = pk2(s[6 * 33], s[7 * 33]);
    *(u32x4*)(WT + nat(wrow<MODE>(n0 + n), k0 + 8 * c, K)) = o;
  }
  asm volatile("s_waitcnt lgkmcnt(0)" ::: "memory"); __builtin_amdgcn_wave_barrier();
}

__device__ __forceinline__ void prologue(const Params& p, const Ctx& cx) {
  const int tid = cx.tid, lane = tid & 63, wave = tid >> 6;
  char* ws = cx.ws;
  {
    float* cond = (float*)lds_raw;
    float* red = (float*)(lds_raw + 9 * 1024 * 4);
    for (int i = tid; i < 9 * 1024; i += 512) { const int j = i >> 10, k = i & 1023; cond[i] = silu_f(j < 8 ? IN(1)[j * 1024 + k] : IN(3)[k]); }
    __syncthreads();
    for (int u = cx.bid; u < 4 * 36; u += cx.nb) {
      const int layer = u / 36, ct = u % 36, c0 = ct * 256 + 4 * lane;
      const float* wp = IN(4) + (size_t)layer * D * 9216 + c0;
      f32x4 a[9];
#pragma unroll
      for (int j = 0; j < 9; ++j) a[j] = (f32x4){0.f, 0.f, 0.f, 0.f};
#pragma unroll 4
      for (int k = wave * 128; k < wave * 128 + 128; ++k) {
        const f32x4 w = *(const f32x4*)(wp + (size_t)k * 9216);
#pragma unroll
        for (int j = 0; j < 9; ++j) a[j] += w * cond[j * 1024 + k];
      }
#pragma unroll
      for (int j = 0; j < 9; ++j) *(f32x4*)(red + (wave * 9 + j) * 256 + 4 * lane) = a[j];
      __syncthreads();
      float* mt = (float*)(ws + O_MODT) + (size_t)layer * 9 * 9216;
      for (int i = tid; i < 9 * 256; i += 512) {
        const int j = i >> 8, c = i & 255; float s = 0.f;
#pragma unroll
        for (int w = 0; w < 8; ++w) s += red[(w * 9 + j) * 256 + c];
        mt[(size_t)j * 9216 + ct * 256 + c] = s + IN(5)[layer * 9216 + ct * 256 + c];
      }
      __syncthreads();
    }
    __syncthreads();
  }
  {
    float* scr = (float*)lds_raw + wave * (64 * 33);
    const int gw = cx.bid * 8 + wave, NGW = cx.nb * 8;
    constexpr int I_FI = 16 * 176, I_FO = 44 * 32, I_UP = 16 * 128, I_DN = 32 * 32, I_AQ = 16 * 48, I_AO = 16 * 32, I_SI = 16 * 96, I_SO = 16 * 32;
    constexpr int NITEMS = 8 * I_FI + 8 * I_FO + 2 * I_UP + 2 * I_DN + I_AQ + I_AO + I_SI + I_SO;
    for (int it = gw; it < NITEMS; it += NGW) {
      int r = it;
      if (r < 8 * I_FI) { const int mi = r / I_FI; transpose_item<1>(IN(8) + (size_t)mi * 1024 * 5632, 1024, 5632, (bf16_t*)(ws + O_WFI) + (size_t)mi * 5632 * 1024, scr, r % I_FI, lane); continue; } r -= 8 * I_FI;
      if (r < 8 * I_FO) { const int mi = r / I_FO; transpose_item<0>(IN(9) + (size_t)mi * 2816 * 1024, 2816, 1024, (bf16_t*)(ws + O_WFO) + (size_t)mi * 1024 * 2816, scr, r % I_FO, lane); continue; } r -= 8 * I_FO;
      if (r < 2 * I_UP) { const int mi = r / I_UP; transpose_item<0>(IN(10) + (size_t)mi * 1024 * 4096, 1024, 4096, (bf16_t*)(ws + O_WUP) + (size_t)mi * 4096 * 1024, scr, r % I_UP, lane); continue; } r -= 2 * I_UP;
      if (r < 2 * I_DN) { const int mi = r / I_DN; transpose_item<0>(IN(18) + (size_t)mi * 2048 * 1024, 2048, 1024, (bf16_t*)(ws + O_WDN) + (size_t)mi * 1024 * 2048, scr, r % I_DN, lane); continue; } r -= 2 * I_DN;
      if (r < I_AQ) { transpose_item<0>(IN(19), 1024, 1536, (bf16_t*)(ws + O_WAQ), scr, r, lane); continue; } r -= I_AQ;
      if (r < I_AO) { transpose_item<0>(IN(21), 1024, 1024, (bf16_t*)(ws + O_WAO), scr, r, lane); continue; } r -= I_AO;
      if (r < I_SI) { transpose_item<0>(IN(22), 1024, 3072, (bf16_t*)(ws + O_WSI), scr, r, lane); continue; } r -= I_SI;
      transpose_item<0>(IN(24), 1024, 1024, (bf16_t*)(ws + O_WSO), scr, r, lane);
    }
  }
  {
    const int gt = cx.bid * 512 + tid, gs = cx.nb * 512;
    bf16_t* wg = (bf16_t*)(ws + O_WG);
    for (int i = gt; i < 2 * 16 * 6144; i += gs) {
      const int j = i / (16 * 6144), xg = (i / 6144) & 15, k = i % 6144, x = xg >> 3, g = xg & 7;
      const float* wif = IN(14) + (size_t)(j * 2 + x) * 6144 * 8;
      float v;
      const int knat = (k & ~31) + 16 * ((k >> 2) & 1) + 4 * ((k >> 3) & 3) + (k & 3);
      if (k < 2048) v = wif[(size_t)knat * 8 + g];
      else if (k < 4096) v = wif[(size_t)knat * 8 + g] * 22.627416997969522f;
      else {
        const int c = k - 4096, blk = c >> 2, cc = c & 3;
        const float* wv = IN(13) + ((size_t)(j * 3 + 2) * 512 + blk) * 16 + cc * 4;
        v = 0.f;
        for (int d2 = 0; d2 < 4; ++d2) v += wv[d2] * wif[(size_t)(4096 + 4 * blk + d2) * 8 + g];
      }
      wg[i] = (bf16_t)(pk2(v, 0.f) & 0xffff);
    }
    { float* lnt = (float*)(ws + O_LNT); for (int i = gt; i < 12 * D; i += gs) { const int l = i / D, c2 = i % D; lnt[(size_t)l * 2 * D + c2] = IN(6)[i] * ALPHA; lnt[(size_t)l * 2 * D + D + c2] = IN(7)[i] * ALPHA; } }
    float* rc = (float*)(ws + O_ROPE); float* rs = rc + 4096 * 32;
    for (int i = gt; i < 4096 * 32; i += gs) {
      const int pos = i >> 5, pp = i & 31, jf = pp & 15;
      const float fr_ = __builtin_amdgcn_exp2f(-(float)jf * (13.287712379549449f / 16.f));
      float rev = (float)(pp < 16 ? (pos >> 6) : (pos & 63)) * fr_ * 0.15915494309189535f;
      rev -= rintf(rev);
      rc[i] = __builtin_amdgcn_cosf(rev); rs[i] = __builtin_amdgcn_sinf(rev);
    }
  }
}

template <int MODE>
__device__ __forceinline__ void lnmod_phase(const Params& p, const Ctx& cx, int lnidx  , int layer, int slot) {
  const int lane = cx.tid & 63, gw = cx.bid * 8 + (cx.tid >> 6), NGW = cx.nb * 8;
  const int nrows = MODE == 2 ? NLAT : MROWS;
  const float* lg = IN(6) + (size_t)lnidx * D; const float* lb = IN(7) + (size_t)lnidx * D;
  const float* modl = (const float*)(cx.ws + O_MODT) + (size_t)layer * 9 * 9216;
  bf16_t* U = (bf16_t*)(cx.ws + O_U);
  for (int row = gw; row < nrows; row += NGW) {
    float* hp = hrow(cx, row);
    const float* src = MODE == 0 ? (row < NLAT ? IN(0) + (size_t)row * D : IN(2) + (size_t)(row - NLAT) * D) : hp;
    f32x4 v[4];
#pragma unroll
    for (int j = 0; j < 4; ++j) v[j] = *(const f32x4*)(src + 4 * lane + 256 * j);
    if (MODE != 0) {
      float s = 0.f;
#pragma unroll
      for (int j = 0; j < 4; ++j) s += (v[j][0] + v[j][1]) + (v[j][2] + v[j][3]);
      const float mean = wave_sum(s, lane) * (1.f / D); float s2 = 0.f;
#pragma unroll
      for (int j = 0; j < 4; ++j) { v[j] = v[j] - mean; s2 += (v[j][0] * v[j][0] + v[j][1] * v[j][1]) + (v[j][2] * v[j][2] + v[j][3] * v[j][3]); }
      const float rstd = __builtin_amdgcn_rsqf(wave_sum(s2, lane) * (1.f / D) + LN_EPS);
      if (MODE == 1 && lane == 0) *(float2*)((float*)(cx.ws + O_STATS) + (size_t)row * 2) = make_float2(mean, rstd);
#pragma unroll
      for (int j = 0; j < 4; ++j) v[j] = v[j] * rstd * *(const f32x4*)(lg + 4 * lane + 256 * j) + *(const f32x4*)(lb + 4 * lane + 256 * j);
    }
    if (MODE != 1) {
#pragma unroll
      for (int j = 0; j < 4; ++j) *(f32x4*)(hp + 4 * lane + 256 * j) = MODE == 0 ? v[j] * ALPHA : v[j];
    }
    if (MODE != 2) {
      const int midx = row < NLAT ? (row >> 12) : 8;
      const float* sh = modl + (size_t)midx * 9216 + (3 * slot) * D; const float* sc = sh + D;
#pragma unroll
      for (int j = 0; j < 4; ++j) {
        const f32x4 u = v[j] * (*(const f32x4*)(sc + 4 * lane + 256 * j) + 1.f) + *(const f32x4*)(sh + 4 * lane + 256 * j);
        u32x2 o; o.x = pk2(u[0], u[1]); o.y = pk2(u[2], u[3]);
        *(u32x2*)(U + nat(row, 4 * lane + 256 * j, D)) = o;
      }
    }
  }
}

__device__ __forceinline__ int ml_lrow(int bl, int tok) { return tok < LC ? GB * SEQ + bl * LC + tok : bl * SEQ + (tok - LC); }
__device__ __forceinline__ int ml_nchunk(int x, int st) { return x == 0 ? st : (st < 4 ? 3 - st : 71 - st); }

__device__ __forceinline__ void ml_m0(const Params& p, const Ctx& cx, int j) {
  const int tid = cx.tid;
  char* ws = cx.ws;
  const bf16_t* XZ = (const bf16_t*)(ws + O_XZ);
  bf16_t* QK = (bf16_t*)(ws + O_QK); bf16_t* KT = (bf16_t*)(ws + O_KT); bf16_t* VT = (bf16_t*)(ws + O_VT); bf16_t* QF = (bf16_t*)(ws + O_QF);
  const int blk_l = tid & 63, tq = tid >> 6;
  for (int u = cx.bid; u < GB * NCH * 8; u += cx.nb) {
    const int slab = u & 7, ch = (u >> 3) % NCH, bl = u / (8 * NCH);
    const int f0 = slab * 256 + blk_l * 4, blk = f0 >> 2;
    float cw[3][4], cb[4], wq[16], wk[16], wv[16];
#pragma unroll
    for (int k = 0; k < 3; ++k)
#pragma unroll
      for (int c = 0; c < 4; ++c) cw[k][c] = IN(11)[(size_t)(j * 3 + k) * EI + f0 + c];
#pragma unroll
    for (int c = 0; c < 4; ++c) cb[c] = IN(12)[(size_t)j * EI + f0 + c];
#pragma unroll
    for (int i = 0; i < 16; ++i) {
      wq[i] = IN(13)[((size_t)(j * 3 + 0) * 512 + blk) * 16 + i];
      wk[i] = IN(13)[((size_t)(j * 3 + 1) * 512 + blk) * 16 + i] * 0.04419417382415922f;
      wv[i] = IN(13)[((size_t)(j * 3 + 2) * 512 + blk) * 16 + i];
    }
    const int tok0 = ch * 64, seg_lo = tok0 < LC ? 0 : LC, seg_hi = tok0 < LC ? LC : TOKB;
    const int tl0 = tq * 8;
    float xmp[4], xmc[4], xmn[4];
    {
      const int t2 = tok0 + tl0 - 1;
      if (t2 >= seg_lo) { const u32x2 r = *(const u32x2*)(XZ + (size_t)ml_lrow(bl, t2) * 4096 + f0); xmp[0] = bflo(r.x); xmp[1] = bfhi(r.x); xmp[2] = bflo(r.y); xmp[3] = bfhi(r.y); }
      else { xmp[0] = xmp[1] = xmp[2] = xmp[3] = 0.f; }
      const u32x2 r = *(const u32x2*)(XZ + (size_t)ml_lrow(bl, tok0 + tl0) * 4096 + f0); xmc[0] = bflo(r.x); xmc[1] = bfhi(r.x); xmc[2] = bflo(r.y); xmc[3] = bfhi(r.y);
    }
    unsigned kpk[4][4], vpk[4][4];
    float kprev[4], vprev[4];
    const int fp = (f0 & ~31) + 8 * ((f0 >> 2) & 3) + 4 * ((f0 >> 4) & 1);
#pragma unroll
    for (int tt = 0; tt < 8; ++tt) {
      const int tl = tl0 + tt, tok = tok0 + tl;
      if (tok + 1 < seg_hi) { const u32x2 r = *(const u32x2*)(XZ + (size_t)ml_lrow(bl, tok + 1) * 4096 + f0); xmn[0] = bflo(r.x); xmn[1] = bfhi(r.x); xmn[2] = bflo(r.y); xmn[3] = bfhi(r.y); }
      else { xmn[0] = xmn[1] = xmn[2] = xmn[3] = 0.f; }
      float xc[4], q[4], kk[4], vv[4];
#pragma unroll
      for (int c = 0; c < 4; ++c) xc[c] = silu_f(cw[0][c] * xmp[c] + cw[1][c] * xmc[c] + cw[2][c] * xmn[c] + cb[c]);
#pragma unroll
      for (int d2 = 0; d2 < 4; ++d2) {
        q[d2] = xc[0] * wq[d2] + xc[1] * wq[4 + d2] + xc[2] * wq[8 + d2] + xc[3] * wq[12 + d2];
        kk[d2] = xc[0] * wk[d2] + xc[1] * wk[4 + d2] + xc[2] * wk[8 + d2] + xc[3] * wk[12 + d2];
        vv[d2] = xmc[0] * wv[d2] + xmc[1] * wv[4 + d2] + xmc[2] * wv[8 + d2] + xmc[3] * wv[12 + d2];
      }
      const size_t lr = ml_lrow(bl, tok);
      u32x2 oq, ok; oq.x = pk2(q[0], q[1]); oq.y = pk2(q[2], q[3]); ok.x = pk2(kk[0], kk[1]); ok.y = pk2(kk[2], kk[3]);
      *(u32x2*)(QK + lr * 4096 + fp) = oq;
      *(u32x2*)(QF + ((((((size_t)bl * NCH + ch) * 4 + (f0 >> 9)) * 8 + ((f0 >> 6) & 7)) * 4 + (tl >> 4)) * 2 + ((f0 >> 5) & 1)) * 512 + (tl & 15) * 32 + 8 * ((f0 >> 2) & 3) + 4 * ((f0 >> 4) & 1)) = oq;
      *(u32x2*)(QK + lr * 4096 + 2048 + fp) = ok;
      if (tt & 1) {
#pragma unroll
        for (int c = 0; c < 4; ++c) { kpk[c][tt >> 1] = pk2(kprev[c], kk[c]); vpk[c][tt >> 1] = pk2(vprev[c], vv[c]); }
      } else {
#pragma unroll
        for (int c = 0; c < 4; ++c) { kprev[c] = kk[c]; vprev[c] = vv[c]; }
      }
#pragma unroll
      for (int c = 0; c < 4; ++c) { xmp[c] = xmc[c]; xmc[c] = xmn[c]; }
    }
#pragma unroll
    for (int c = 0; c < 4; ++c) {
      const int feat = f0 + c;
      const size_t off = (((size_t)bl * NCH + ch) * (EI / 16) + (feat >> 4)) * 1024 + (tq >> 2) * 512 + (feat & 15) * 32 + (tq & 3) * 8;
      *(u32x4*)(KT + off) = (u32x4){kpk[c][0], kpk[c][1], kpk[c][2], kpk[c][3]};
      *(u32x4*)(VT + off) = (u32x4){vpk[c][0], vpk[c][1], vpk[c][2], vpk[c][3]};
    }
  }
}

__device__ __forceinline__ void ml_gates(const Params& p, const Ctx& cx, int j) {
  const int tid = cx.tid, lane = tid & 63, wave = tid >> 6, fr = lane & 15, fq = lane >> 4;
  char* ws = cx.ws;
  const bf16_t* XZ = (const bf16_t*)(ws + O_XZ); const bf16_t* QK = (const bf16_t*)(ws + O_QK);
  const bf16_t* WG = (const bf16_t*)(ws + O_WG) + (size_t)j * 16 * 6144;
  float* BL = (float*)(ws + O_BL); float* IG = (float*)(ws + O_IG);
  float* GC = (float*)(ws + O_GC); float* AC = GC + NSEQ * NCH;
  float* part = (float*)lds_raw;
  float* gl = part + 8 * 64 * 16;
  for (int u = cx.bid; u < GB * NCH; u += cx.nb) {
    const int bl = u / NCH, nc = u % NCH, tok0 = nc * 64;
    f32x4 acc[4];
#pragma unroll
    for (int m = 0; m < 4; ++m) acc[m] = (f32x4){0.f, 0.f, 0.f, 0.f};
    size_t lr[4];
#pragma unroll
    for (int m = 0; m < 4; ++m) lr[m] = ml_lrow(bl, tok0 + m * 16 + fr);
#pragma unroll 4
    for (int ks = wave * 24; ks < wave * 24 + 24; ++ks) {
      const int k = ks * 32 + fq * 8;
      const bf16x8 bfr = *(const bf16x8*)(WG + (size_t)fr * 6144 + k);
#pragma unroll
      for (int m = 0; m < 4; ++m) {
        const bf16_t* ap = k < 4096 ? QK + lr[m] * 4096 + k : XZ + lr[m] * 4096 + (k - 4096);
        const bf16x8 afr = *(const bf16x8*)ap;
        acc[m] = MFMA16(afr, bfr, acc[m]);
      }
    }
#pragma unroll
    for (int m = 0; m < 4; ++m)
#pragma unroll
      for (int jj = 0; jj < 4; ++jj) part[(wave * 64 + m * 16 + 4 * fq + jj) * 16 + fr] = acc[m][jj];
    __syncthreads();
    for (int i = tid; i < 1024; i += 512) {
      float s = IN(15)[(size_t)j * 16 + (i & 15)];
#pragma unroll
      for (int w = 0; w < 8; ++w) s += part[w * 1024 + i];
      gl[(i >> 4) * 17 + (i & 15)] = s;
    }
    __syncthreads();
    {
      const int x = wave >> 2, h = wave & 3, seq = (bl * 2 + x) * 4 + h;
      const int tl = x == 0 ? lane : 63 - lane;
      const float ig = gl[tl * 17 + x * 8 + h], fg = gl[tl * 17 + x * 8 + 4 + h];
      float b = fg > 0.f ? -__logf(1.f + __expf(-fg)) : fg - __logf(1.f + __expf(fg));
#pragma unroll
      for (int o = 1; o < 64; o <<= 1) { const float t2 = shi(b, lane - o); if (lane >= o) b += t2; }
      BL[(size_t)seq * TOKB + tok0 + tl] = b; IG[(size_t)seq * TOKB + tok0 + tl] = ig;
      float mx = ig - b;
#pragma unroll
      for (int o = 1; o < 64; o <<= 1) mx = fmaxf(mx, shx(mx, o, lane));
      const float g = shi(b, 63);
      if (lane == 0) { GC[seq * NCH + nc] = g; AC[seq * NCH + nc] = g + mx; }
    }
    __syncthreads();
  }
}

__device__ __forceinline__ void ml_s(const Params& p, const Ctx& cx) {
  const int tid = cx.tid, lane = tid & 63, wave = tid >> 6, fr = lane & 15, fq = lane >> 4;
  char* ws = cx.ws;
  const bf16_t* QK = (const bf16_t*)(ws + O_QK);
  bf16_t* SP = (bf16_t*)(ws + O_SP);
  const float* BL = (const float*)(ws + O_BL); const float* IG = (const float*)(ws + O_IG);
  float* WIN = (float*)(ws + O_WIN); float* FLO = (float*)(ws + O_FLO); float* DEN = (float*)(ws + O_DEN); float* WSS = (float*)(ws + O_WSS);
  const float* GC = (const float*)(ws + O_GC); const float* AC = GC + NSEQ * NCH; float* DEC = (float*)(ws + O_GC) + 2 * NSEQ * NCH;
  float* sb_ = (float*)lds_raw + wave * 256; float* si_ = sb_ + 64; float* smt = si_ + 64;
  const int gw = cx.bid * 8 + wave, NGW = cx.nb * 8;
  for (int u = gw; u < NSEQ * NCH; u += NGW) {
    const int seq = u / NCH, st = u % NCH, x = (seq >> 2) & 1, h = seq & 3, bl = seq >> 3;
    const int nc = ml_nchunk(x, st), tok0 = nc * 64;
    const int nl0 = ml_nchunk(x, lane), nl1 = ml_nchunk(x, 64 + (lane & 3));
    const float g0 = GC[seq * NCH + nl0], a0 = AC[seq * NCH + nl0], g1 = GC[seq * NCH + nl1], a1 = AC[seq * NCH + nl1];
    const int tl = x == 0 ? lane : 63 - lane;
    const float b = BL[(size_t)seq * TOKB + tok0 + tl], ig = IG[(size_t)seq * TOKB + tok0 + tl];
    float mc = 0.f;
    for (int s2 = 0; s2 < st; ++s2) {
      const float gg = __int_as_float(__builtin_amdgcn_readlane(__float_as_int(s2 < 64 ? g0 : g1), s2 & 63));
      const float aa = __int_as_float(__builtin_amdgcn_readlane(__float_as_int(s2 < 64 ? a0 : a1), s2 & 63));
      mc = fmaxf(gg + mc, aa);
    }
    const float gc = __int_as_float(__builtin_amdgcn_readlane(__float_as_int(st < 64 ? g0 : g1), st & 63));
    const float ac = __int_as_float(__builtin_amdgcn_readlane(__float_as_int(st < 64 ? a0 : a1), st & 63));
    const float mnew = fmaxf(gc + mc, ac);
    float cm = ig - b;
#pragma unroll
    for (int o = 1; o < 64; o <<= 1) { const float t2 = shi(cm, lane - o); if (lane >= o) cm = fmaxf(cm, t2); }
    const float mt = b + fmaxf(mc, cm);
    sb_[tl] = b; si_[tl] = ig; smt[tl] = mt;
    WIN[(size_t)seq * TOKB + tok0 + tl] = __expf(b + mc - mt);
    FLO[(size_t)seq * TOKB + tok0 + tl] = __expf(-mt);
    WSS[(size_t)seq * TOKB + tok0 + tl] = __expf(gc - b + ig - mnew);
    if (lane == 0) DEC[seq * NCH + nc] = __expf(gc + mc - mnew);
    f32x4 acc[4][4];
#pragma unroll
    for (int a = 0; a < 4; ++a)
#pragma unroll
      for (int c2 = 0; c2 < 4; ++c2) acc[a][c2] = (f32x4){0.f, 0.f, 0.f, 0.f};
    const bf16_t* rowp[4];
#pragma unroll
    for (int a = 0; a < 4; ++a) rowp[a] = QK + (size_t)ml_lrow(bl, tok0 + a * 16 + fr) * 4096 + h * DH + fq * 8;
#pragma unroll 2
    for (int ks = 0; ks < 16; ++ks) {
      bf16x8 kf[4], qf[4];
#pragma unroll
      for (int a = 0; a < 4; ++a) { kf[a] = *(const bf16x8*)(rowp[a] + 2048 + ks * 32); qf[a] = *(const bf16x8*)(rowp[a] + ks * 32); }
#pragma unroll
      for (int a = 0; a < 4; ++a)
#pragma unroll
        for (int c2 = 0; c2 < 4; ++c2) acc[a][c2] = MFMA16(kf[a], qf[c2], acc[a][c2]);
    }
    __builtin_amdgcn_wave_barrier(); asm volatile("s_waitcnt lgkmcnt(0)" ::: "memory");
    bf16_t* spu = SP + (size_t)(seq * NCH + nc) * 4096;
#pragma unroll
    for (int tb = 0; tb < 4; ++tb) {
      const int t = tb * 16 + fr;
      const float bt = sb_[t], mtt = smt[t];
      float dsum = 0.f;
#pragma unroll
      for (int sbk = 0; sbk < 4; ++sbk) {
        float vals[4];
#pragma unroll
        for (int jj = 0; jj < 4; ++jj) {
          const int s = sbk * 16 + 4 * fq + jj;
          const bool ok = x == 0 ? (s <= t) : (s >= t);
          vals[jj] = ok ? acc[sbk][tb][jj] * __expf(bt - sb_[s] + si_[s] - mtt) : 0.f;
        }
        u32x2 o; o.x = pk2(vals[0], vals[1]); o.y = pk2(vals[2], vals[3]);
        *(u32x2*)(spu + tb * 1024 + ((sbk * 16 + 4 * fq) >> 5) * 512 + fr * 32 + ((sbk * 16 + 4 * fq) & 31)) = o;
        dsum += (bflo(o.x) + bfhi(o.x)) + (bflo(o.y) + bfhi(o.y));
      }
      dsum += shx(dsum, 16, lane); dsum += shx(dsum, 32, lane);
      if (fq == 0) DEN[(size_t)seq * TOKB + tok0 + t] = dsum;
    }
    __builtin_amdgcn_wave_barrier(); asm volatile("s_waitcnt lgkmcnt(0)" ::: "memory");
  }
}

constexpr int NEB = 2, NSL = 512 / (16 * NEB);
__device__ __forceinline__ void ml_m2(const Params& p, const Ctx& cx) {
  const int tid = cx.tid, lane = tid & 63, wave = tid >> 6, fr = lane & 15, fq = lane >> 4;
  char* ws = cx.ws;
  const bf16_t* QK = (const bf16_t*)(ws + O_QK); const bf16_t* KT = (const bf16_t*)(ws + O_KT); const bf16_t* VT = (const bf16_t*)(ws + O_VT);
  const bf16_t* SP = (const bf16_t*)(ws + O_SP); const bf16_t* QF = (const bf16_t*)(ws + O_QF);
  bf16_t* HD = (bf16_t*)(ws + O_HD);
  const float* WIN = (const float*)(ws + O_WIN); const float* FLO = (const float*)(ws + O_FLO); const float* DEN = (const float*)(ws + O_DEN); const float* WSS = (const float*)(ws + O_WSS);
  const float* DEC = (const float*)(ws + O_GC) + 2 * NSEQ * NCH;
  f32x4* red = (f32x4*)lds_raw;
  f32x4* rn = (f32x4*)(lds_raw + 131072);
  for (int idx = cx.bid >> 3; idx < 2 * NSL; idx += cx.nb >> 3) {
    const int seq = (cx.bid & 7) * 2 + idx / NSL, es = idx % NSL, x = (seq >> 2) & 1, h = seq & 3, bl = seq >> 3;
    const int d0 = wave * 64, e0 = es * 16 * NEB;
    f32x4 C[4][NEB + 1];
#pragma unroll
    for (int a = 0; a < 4; ++a)
#pragma unroll
      for (int b = 0; b < NEB + 1; ++b) C[a][b] = (f32x4){0.f, 0.f, 0.f, 0.f};
    const int tbo = wave >> 1, ebo = __builtin_amdgcn_readfirstlane(wave & 1);
    bf16x8 qc[4][2], kf[4][2], sf0, sf1;
    u32x4 vr[NEB][2];
    f32x4 wv[2][2];
#define M2_LOAD_Q(ST) do { const int _nq = ml_nchunk(x, (ST)); _Pragma("unroll") for (int tb = 0; tb < 4; ++tb) { \
        const bf16_t* qp = QF + ((((((size_t)bl * NCH + _nq) * 4 + h) * 8 + wave) * 4 + tb) * 2) * 512 + fr * 32 + 8 * fq; \
        qc[tb][0] = *(const bf16x8*)qp; qc[tb][1] = *(const bf16x8*)(qp + 512); } } while (0)
#define M2_LOAD_KV(ST) do { const int _nc = ml_nchunk(x, (ST)), _t0 = _nc * 64; \
        _Pragma("unroll") for (int db = 0; db < 4; ++db) { const bf16_t* kp = KT + (((size_t)bl * NCH + _nc) * (EI / 16) + ((h * DH + d0) >> 4) + db) * 1024 + fr * 32 + 8 * fq; \
          kf[db][0] = *(const bf16x8*)kp; kf[db][1] = *(const bf16x8*)(kp + 512); } \
        _Pragma("unroll") for (int eb = 0; eb < NEB; ++eb) { const bf16_t* vp = VT + (((size_t)bl * NCH + _nc) * (EI / 16) + ((h * DH + e0) >> 4) + eb) * 1024 + fr * 32 + 8 * fq; \
          vr[eb][0] = *(const u32x4*)vp; vr[eb][1] = *(const u32x4*)(vp + 512); } \
        _Pragma("unroll") for (int ks = 0; ks < 2; ++ks) { const float* wp = WSS + (size_t)seq * TOKB + _t0 + 32 * ks + 8 * fq; \
          wv[ks][0] = *(const f32x4*)wp; wv[ks][1] = *(const f32x4*)(wp + 4); } \
        const bf16_t* sp = SP + (size_t)(seq * NCH + _nc) * 4096 + tbo * 1024 + fr * 32 + 8 * fq; \
        sf0 = *(const bf16x8*)sp; sf1 = *(const bf16x8*)(sp + 512); } while (0)
    M2_LOAD_Q(0); M2_LOAD_KV(0);
    for (int st = 0; st < NCH; ++st) {
      const int nc = ml_nchunk(x, st), tok0 = nc * 64, stn = st + 1 < NCH ? st + 1 : st;
      const size_t tix = (size_t)seq * TOKB + tok0 + tbo * 16 + 4 * fq;
      const f32x4 win = *(const f32x4*)(WIN + tix), flo = *(const f32x4*)(FLO + tix), deni = *(const f32x4*)(DEN + tix);
      const float decay = DEC[seq * NCH + nc];
#pragma unroll
      for (int eb = 0; eb < NEB + 1; ++eb) {
        bf16x8 cb0, cb1;
        { const f32x4 lo = C[0][eb], hi = C[1][eb]; cb0 = mk8((u32x4){pk2(lo[0], lo[1]), pk2(lo[2], lo[3]), pk2(hi[0], hi[1]), pk2(hi[2], hi[3])}); }
        { const f32x4 lo = C[2][eb], hi = C[3][eb]; cb1 = mk8((u32x4){pk2(lo[0], lo[1]), pk2(lo[2], lo[3]), pk2(hi[0], hi[1]), pk2(hi[2], hi[3])}); }
        f32x4 pa[4];
#pragma unroll
        for (int tb = 0; tb < 4; ++tb) pa[tb] = MFMA16(qc[tb][0], cb0, ((f32x4){0.f, 0.f, 0.f, 0.f}));
#pragma unroll
        for (int tb = 0; tb < 4; ++tb) pa[tb] = MFMA16(qc[tb][1], cb1, pa[tb]);
#pragma unroll
        for (int tb = 0; tb < 4; ++tb) {
          if (eb < NEB) red[((wave * 4 + tb) * NEB + eb) * 64 + lane] = pa[tb];
          else if (fr == 0) rn[(wave * 4 + tb) * 4 + fq] = pa[tb];
        }
      }
      M2_LOAD_Q(stn);
      f32x4 oi = {0.f, 0.f, 0.f, 0.f};
#pragma unroll
      for (int eb = 0; eb < NEB + 1; ++eb) {
        bf16x8 vw0, vw1;
        if (eb < NEB) {
          const u32x4 r0 = vr[eb][0], r1 = vr[eb][1];
          if (eb == ebo) { oi = MFMA16(sf0, mk8(r0), oi); oi = MFMA16(sf1, mk8(r1), oi); }
          vw0 = mk8((u32x4){pk2(bflo(r0.x) * wv[0][0][0], bfhi(r0.x) * wv[0][0][1]), pk2(bflo(r0.y) * wv[0][0][2], bfhi(r0.y) * wv[0][0][3]),
                            pk2(bflo(r0.z) * wv[0][1][0], bfhi(r0.z) * wv[0][1][1]), pk2(bflo(r0.w) * wv[0][1][2], bfhi(r0.w) * wv[0][1][3])});
          vw1 = mk8((u32x4){pk2(bflo(r1.x) * wv[1][0][0], bfhi(r1.x) * wv[1][0][1]), pk2(bflo(r1.y) * wv[1][0][2], bfhi(r1.y) * wv[1][0][3]),
                            pk2(bflo(r1.z) * wv[1][1][0], bfhi(r1.z) * wv[1][1][1]), pk2(bflo(r1.w) * wv[1][1][2], bfhi(r1.w) * wv[1][1][3])});
        } else {
          vw0 = mk8((u32x4){pk2(wv[0][0][0], wv[0][0][1]), pk2(wv[0][0][2], wv[0][0][3]), pk2(wv[0][1][0], wv[0][1][1]), pk2(wv[0][1][2], wv[0][1][3])});
          vw1 = mk8((u32x4){pk2(wv[1][0][0], wv[1][0][1]), pk2(wv[1][0][2], wv[1][0][3]), pk2(wv[1][1][0], wv[1][1][1]), pk2(wv[1][1][2], wv[1][1][3])});
        }
#pragma unroll
        for (int db = 0; db < 4; ++db) {
          f32x4 c = C[db][eb] * decay;
          c = MFMA16(kf[db][0], vw0, c); c = MFMA16(kf[db][1], vw1, c);
          C[db][eb] = c;
        }
      }
      asm volatile("s_waitcnt lgkmcnt(0)" ::: "memory");
      __builtin_amdgcn_s_barrier();
      asm volatile("" ::: "memory");
      f32x4 rdn[8], rd0[8];
#pragma unroll
      for (int w = 0; w < 8; ++w) { rdn[w] = rn[(w * 4 + tbo) * 4 + fq]; rd0[w] = red[((w * 4 + tbo) * NEB + ebo) * 64 + lane]; }
      const f32x4 pn = ((rdn[0] + rdn[1]) + (rdn[2] + rdn[3])) + ((rdn[4] + rdn[5]) + (rdn[6] + rdn[7]));
      const f32x4 pi = ((rd0[0] + rd0[1]) + (rd0[2] + rd0[3])) + ((rd0[4] + rd0[5]) + (rd0[6] + rd0[7]));
#pragma unroll
      for (int jj = 0; jj < 4; ++jj) {
        const float num = oi[jj] + win[jj] * pi[jj], den = deni[jj] + win[jj] * pn[jj];
        const float hv = num * __builtin_amdgcn_rcpf(fmaxf(fabsf(den), flo[jj]));
        HD[((size_t)x * RG + ml_lrow(bl, tok0 + tbo * 16 + 4 * fq + jj)) * EI + h * DH + e0 + ebo * 16 + fr] = (bf16_t)(pk2(hv, 0.f) & 0xffff);
      }
      M2_LOAD_KV(stn);
      asm volatile("s_waitcnt lgkmcnt(0)" ::: "memory");
      __builtin_amdgcn_s_barrier();
      asm volatile("" ::: "memory");
    }
    __syncthreads();
#undef M2_LOAD_Q
#undef M2_LOAD_KV
  }
}

__device__ __forceinline__ void ml_fin(const Params& p, const Ctx& cx, int j) {
  const int lane = cx.tid & 63, gw = cx.bid * 8 + (cx.tid >> 6), NGW = cx.nb * 8;
  char* ws = cx.ws;
  const bf16_t* XZ = (const bf16_t*)(ws + O_XZ); const bf16_t* HD = (const bf16_t*)(ws + O_HD);
  bf16_t* FIN = (bf16_t*)(ws + O_FIN);
  for (int u = gw; u < RG * 4; u += NGW) {
    const int lr = u >> 2, h = u & 3, f0 = h * DH + lane * 8;
    int pos, seglen;
    if (lr < GB * SEQ) { pos = lr & (SEQ - 1); seglen = SEQ; } else { pos = (lr - GB * SEQ) & (LC - 1); seglen = LC; }
    const u32x4 hf = *(const u32x4*)(HD + (size_t)lr * EI + f0), hb = *(const u32x4*)(HD + ((size_t)RG + lr) * EI + f0);
    const u32x4 zz = *(const u32x4*)(XZ + (size_t)lr * 4096 + 2048 + f0);
    const u32x4 x1 = *(const u32x4*)(XZ + (size_t)lr * 4096 + f0);
    u32x4 x0 = {0u, 0u, 0u, 0u}, x2 = {0u, 0u, 0u, 0u};
    if (pos > 0) x0 = *(const u32x4*)(XZ + (size_t)(lr - 1) * 4096 + f0);
    if (pos < seglen - 1) x2 = *(const u32x4*)(XZ + (size_t)(lr + 1) * 4096 + f0);
    float hv[8], xm0[8], xm1[8], xm2[8];
    const unsigned hfu[4] = {hf.x, hf.y, hf.z, hf.w}, hbu[4] = {hb.x, hb.y, hb.z, hb.w}, zu[4] = {zz.x, zz.y, zz.z, zz.w};
    const unsigned x0u[4] = {x0.x, x0.y, x0.z, x0.w}, x1u[4] = {x1.x, x1.y, x1.z, x1.w}, x2u[4] = {x2.x, x2.y, x2.z, x2.w};
    float s = 0.f;
#pragma unroll
    for (int i = 0; i < 4; ++i) {
      hv[2 * i] = (bflo(hfu[i]) + bflo(hbu[i])) * sigm_f(bflo(zu[i]));
      hv[2 * i + 1] = (bfhi(hfu[i]) + bfhi(hbu[i])) * sigm_f(bfhi(zu[i]));
      xm0[2 * i] = bflo(x0u[i]); xm0[2 * i + 1] = bfhi(x0u[i]); xm1[2 * i] = bflo(x1u[i]); xm1[2 * i + 1] = bfhi(x1u[i]); xm2[2 * i] = bflo(x2u[i]); xm2[2 * i + 1] = bfhi(x2u[i]);
      s += hv[2 * i] + hv[2 * i + 1];
    }
    const float mean = wave_sum(s, lane) * (1.f / DH); float s2 = 0.f;
#pragma unroll
    for (int i = 0; i < 8; ++i) { hv[i] -= mean; s2 += hv[i] * hv[i]; }
    const float rstd = __builtin_amdgcn_rsqf(wave_sum(s2, lane) * (1.f / DH) + LN_EPS);
    float o[8];
#pragma unroll
    for (int i = 0; i < 8; ++i) {
      const int f = f0 + i;
      const float xc = silu_f(IN(11)[(size_t)(j * 3 + 0) * EI + f] * xm0[i] + IN(11)[(size_t)(j * 3 + 1) * EI + f] * xm1[i] + IN(11)[(size_t)(j * 3 + 2) * EI + f] * xm2[i] + IN(12)[(size_t)j * EI + f]);
      o[i] = hv[i] * rstd * IN(17)[(size_t)j * EI + f] + IN(16)[(size_t)j * EI + f] * xc;
    }
    u32x4 ov; ov.x = pk2(o[0], o[1]); ov.y = pk2(o[2], o[3]); ov.z = pk2(o[4], o[5]); ov.w = pk2(o[6], o[7]);
    *(u32x4*)(FIN + nat(lr, f0, EI)) = ov;
  }
}

__device__ __forceinline__ void at_prep(const Params& p, const Ctx& cx) {
  const int lane = cx.tid & 63, gw = cx.bid * 8 + (cx.tid >> 6), NGW = cx.nb * 8;
  char* ws = cx.ws;
  bf16_t* ACT = (bf16_t*)(ws + O_ACT); bf16_t* KR = (bf16_t*)(ws + O_AKR); bf16_t* VT = (bf16_t*)(ws + O_AVT);
  const float* rc = (const float*)(ws + O_ROPE); const float* rs = rc + 4096 * 32;
  for (int row = gw; row < MROWS; row += NGW) {
    const bool lat = row < NLAT;
    const int b = lat ? row >> 12 : (row - NLAT) >> 8, pos = lat ? row & 4095 : (row - NLAT) & 255, tok = lat ? LC + pos : pos;
    bf16_t* rp = ACT + (size_t)row * 1536;
    {
      const u32x4 a = *(const u32x4*)(rp + 16 * lane), b2 = *(const u32x4*)(rp + 16 * lane + 8);
      const unsigned w[8] = {a.x, a.y, a.z, a.w, b2.x, b2.y, b2.z, b2.w};
      unsigned o[8];
      const int pp0 = (lane & 3) * 8;
#pragma unroll
      for (int i = 0; i < 8; ++i) {
        float x1 = bflo(w[i]) * 0.125f, x2 = bfhi(w[i]) * 0.125f;
        if (lat) { const float c = rc[pos * 32 + pp0 + i], s = rs[pos * 32 + pp0 + i]; const float y1 = x1 * c - x2 * s, y2 = x1 * s + x2 * c; x1 = y1; x2 = y2; }
        o[i] = pk2(x1, x2);
      }
      *(u32x4*)(rp + 16 * lane) = (u32x4){o[0], o[1], o[2], o[3]}; *(u32x4*)(rp + 16 * lane + 8) = (u32x4){o[4], o[5], o[6], o[7]};
    }
    {
      const u32x2 a = *(const u32x2*)(rp + 1024 + 4 * lane);
      const unsigned w[2] = {a.x, a.y}; unsigned o[2];
      const int g = lane >> 4, dd = (lane & 15) * 4, pp0 = dd >> 1;
#pragma unroll
      for (int i = 0; i < 2; ++i) {
        float x1 = bflo(w[i]), x2 = bfhi(w[i]);
        if (lat) { const float c = rc[pos * 32 + pp0 + i], s = rs[pos * 32 + pp0 + i]; const float y1 = x1 * c - x2 * s, y2 = x1 * s + x2 * c; x1 = y1; x2 = y2; }
        o[i] = pk2(x1, x2);
      }
      *(u32x2*)(KR + (((size_t)b * 4 + g) * TOKB + tok) * 64 + dd) = (u32x2){o[0], o[1]};
      const u32x2 v = *(const u32x2*)(rp + 1280 + 4 * lane);
      bf16_t* vp = VT + (((size_t)b * 4 + g) * 64 + dd) * TOKB + tok;
      vp[0] = (bf16_t)(v.x & 0xffff); vp[TOKB] = (bf16_t)(v.x >> 16); vp[2 * TOKB] = (bf16_t)(v.y & 0xffff); vp[3 * TOKB] = (bf16_t)(v.y >> 16);
    }
  }
}

__device__ __forceinline__ void at_core(const Params& p, const Ctx& cx) {
  const int lane = cx.tid & 63, gw = cx.bid * 8 + (cx.tid >> 6), NGW = cx.nb * 8, fr = lane & 15, fq = lane >> 4;
  char* ws = cx.ws;
  const bf16_t* ACT = (const bf16_t*)(ws + O_ACT); const bf16_t* KR = (const bf16_t*)(ws + O_AKR); const bf16_t* VT = (const bf16_t*)(ws + O_AVT);
  bf16_t* O = (bf16_t*)(ws + O_U);
  for (int u = gw; u < (MROWS / 16) * 4; u += NGW) {
    const int g = u & 3, qb = u >> 2, row0 = qb * 16;
    const bool lat = row0 < NLAT;
    const int b = lat ? row0 >> 12 : (row0 - NLAT) >> 8, q0 = lat ? row0 & 4095 : 0;
    bf16x8 qf[4][2];
    float mrun[4], lrun[4], sink[4];
    f32x4 oacc[4][4];
#pragma unroll
    for (int hh = 0; hh < 4; ++hh) {
      const bf16_t* qp = ACT + (size_t)(row0 + fr) * 1536 + (g * 4 + hh) * 64 + 8 * fq;
      qf[hh][0] = *(const bf16x8*)qp; qf[hh][1] = *(const bf16x8*)(qp + 32);
      sink[hh] = IN(20)[g * 4 + hh]; mrun[hh] = sink[hh]; lrun[hh] = 0.f;
#pragma unroll
      for (int d2 = 0; d2 < 4; ++d2) oacc[hh][d2] = (f32x4){0.f, 0.f, 0.f, 0.f};
    }
    const bf16_t* kbase = KR + ((size_t)b * 4 + g) * TOKB * 64;
    const bf16_t* vbase = VT + ((size_t)b * 4 + g) * 64 * TOKB;
    int wlo = 0, whi = -1;
    if (lat) { wlo = max(0, q0 - 128) & ~31; whi = min(SEQ - 1, q0 + 143); }
    const int nwin = lat ? (whi - wlo) / 32 + 1 : 0;
    for (int ti = 0; ti < 8 + nwin; ++ti) {
      const bool isw = ti >= 8;
      const int kpos0 = isw ? wlo + (ti - 8) * 32 : 0;
      const int tk0 = isw ? LC + kpos0 : ti * 32;
      const bf16_t* kp = kbase + (size_t)(tk0 + fr) * 64 + 8 * fq;
      const bf16x8 k00 = *(const bf16x8*)kp, k01 = *(const bf16x8*)(kp + 32), k10 = *(const bf16x8*)(kp + 16 * 64), k11 = *(const bf16x8*)(kp + 16 * 64 + 32);
      bf16x8 vfr[4];
#pragma unroll
      for (int d2 = 0; d2 < 4; ++d2) {
        const bf16_t* vp = vbase + (size_t)(d2 * 16 + fr) * TOKB + tk0 + 4 * fq;
        vfr[d2] = mk8(*(const u32x2*)vp, *(const u32x2*)(vp + 16));
      }
      bool okm[8];
#pragma unroll
      for (int i = 0; i < 8; ++i) {
        const int kpos = kpos0 + (i >> 2) * 16 + 4 * fq + (i & 3), dlt = (q0 + fr) - kpos;
        okm[i] = !isw || (dlt <= 128 && dlt >= -128);
      }
#pragma unroll
      for (int hh = 0; hh < 4; ++hh) {
        f32x4 s0 = {0.f, 0.f, 0.f, 0.f}, s1 = {0.f, 0.f, 0.f, 0.f};
        s0 = MFMA16(k00, qf[hh][0], s0); s0 = MFMA16(k01, qf[hh][1], s0);
        s1 = MFMA16(k10, qf[hh][0], s1); s1 = MFMA16(k11, qf[hh][1], s1);
        float sv[8]; float tmax = -3.0e38f;
#pragma unroll
        for (int i = 0; i < 8; ++i) { sv[i] = okm[i] ? (i < 4 ? s0[i] : s1[i - 4]) : -3.0e38f; tmax = fmaxf(tmax, sv[i]); }
        tmax = fmaxf(tmax, shx(tmax, 16, lane)); tmax = fmaxf(tmax, shx(tmax, 32, lane));
        const float mnew = fmaxf(mrun[hh], tmax), scale = __expf(mrun[hh] - mnew);
        mrun[hh] = mnew;
        float pv[8];
#pragma unroll
        for (int i = 0; i < 8; ++i) pv[i] = okm[i] ? __expf(sv[i] - mnew) : 0.f;
        const u32x4 pu = {pk2(pv[0], pv[1]), pk2(pv[2], pv[3]), pk2(pv[4], pv[5]), pk2(pv[6], pv[7])};
        const float ps = ((bflo(pu.x) + bfhi(pu.x)) + (bflo(pu.y) + bfhi(pu.y))) + ((bflo(pu.z) + bfhi(pu.z)) + (bflo(pu.w) + bfhi(pu.w)));
        lrun[hh] = lrun[hh] * scale + ps;
        const bf16x8 pf = mk8(pu);
        float scq[4];
#pragma unroll
        for (int jj = 0; jj < 4; ++jj) scq[jj] = shi(scale, 4 * fq + jj);
#pragma unroll
        for (int d2 = 0; d2 < 4; ++d2) {
          f32x4 o = oacc[hh][d2];
          o[0] *= scq[0]; o[1] *= scq[1]; o[2] *= scq[2]; o[3] *= scq[3];
          oacc[hh][d2] = MFMA16(pf, vfr[d2], o);
        }
      }
    }
#pragma unroll
    for (int hh = 0; hh < 4; ++hh) {
      float l = lrun[hh];
      l += shx(l, 16, lane); l += shx(l, 32, lane);
      l += __expf(sink[hh] - mrun[hh]);
      const float inv = __builtin_amdgcn_rcpf(l);
      float iq[4];
#pragma unroll
      for (int jj = 0; jj < 4; ++jj) iq[jj] = shi(inv, 4 * fq + jj);
#pragma unroll
      for (int d2 = 0; d2 < 4; ++d2)
#pragma unroll
        for (int jj = 0; jj < 4; ++jj)
          O[nat(row0 + 4 * fq + jj, (g * 4 + hh) * 64 + d2 * 16 + fr, D)] = (bf16_t)(pk2(oacc[hh][d2][jj] * iq[jj], 0.f) & 0xffff);
    }
  }
}

__device__ __forceinline__ void sc_conv(const Params& p, const Ctx& cx) {
  const int gt = cx.bid * 512 + cx.tid, gs = cx.nb * 512;
  const bf16_t* ACT = (const bf16_t*)(cx.ws + O_ACT); bf16_t* O = (bf16_t*)(cx.ws + O_U);
  const float* cw = IN(23);
  for (int i = gt; i < MROWS * 128; i += gs) {
    const int row = i >> 7, c0 = (i & 127) * 8;
    int pos, seglen;
    if (row < NLAT) { pos = row & (SEQ - 1); seglen = SEQ; } else { pos = (row - NLAT) & (LC - 1); seglen = LC; }
    float accv[8];
#pragma unroll
    for (int e = 0; e < 8; ++e) accv[e] = 0.f;
#pragma unroll
    for (int k = 0; k < 3; ++k) {
      const int pp = pos + k - 1;
      if (pp < 0 || pp >= seglen) continue;
      const bf16_t* rp = ACT + (size_t)(row + k - 1) * 3072;
      const u32x4 cgv = *(const u32x4*)(rp + 1024 + c0), xtv = *(const u32x4*)(rp + 2048 + c0);
      const unsigned cu[4] = {cgv.x, cgv.y, cgv.z, cgv.w}, xu[4] = {xtv.x, xtv.y, xtv.z, xtv.w};
#pragma unroll
      for (int e = 0; e < 4; ++e) {
        accv[2 * e] += cw[k * D + c0 + 2 * e] * (bflo(cu[e]) * bflo(xu[e]));
        accv[2 * e + 1] += cw[k * D + c0 + 2 * e + 1] * (bfhi(cu[e]) * bfhi(xu[e]));
      }
    }
    const u32x4 bgv = *(const u32x4*)(ACT + (size_t)row * 3072 + c0);
    const unsigned bu[4] = {bgv.x, bgv.y, bgv.z, bgv.w};
    u32x4 o;
    o.x = pk2(bflo(bu[0]) * accv[0], bfhi(bu[0]) * accv[1]); o.y = pk2(bflo(bu[1]) * accv[2], bfhi(bu[1]) * accv[3]);
    o.z = pk2(bflo(bu[2]) * accv[4], bfhi(bu[2]) * accv[5]); o.w = pk2(bflo(bu[3]) * accv[6], bfhi(bu[3]) * accv[7]);
    *(u32x4*)(O + nat(row, c0, D)) = o;
  }
}

#define XB_TMO      128
#define XB_XCNT(j)  (256  + 64 * (j))
#define XB_XSUB(j)  (1280 + 64 * (j))
#define XB_XGEN(j)  (2304 + 64 * (j))
#define XB_TOP      3328
#define XB_TOPGEN   3392
#define XCD_BAR_WORDS 3456
#define XB_SPIN_CAP (1u << 18)
__device__ __forceinline__ unsigned xb_ld(unsigned* p)              { return __hip_atomic_load(p, __ATOMIC_RELAXED, __HIP_MEMORY_SCOPE_AGENT); }
__device__ __forceinline__ unsigned xb_add(unsigned* p, unsigned v) { return __hip_atomic_fetch_add(p, v, __ATOMIC_RELAXED, __HIP_MEMORY_SCOPE_AGENT); }
__device__ __forceinline__ unsigned xb_xcc_id() { return (unsigned)__builtin_amdgcn_s_getreg((3 << 11) | 20) & 0xFu; }
#define XB_SPIN(cond, bar) do { unsigned _sp = 0; while (cond) { __builtin_amdgcn_s_sleep(1); \
    if ((++_sp & 255u) == 0u) { if (xb_ld(&(bar)[XB_TMO])) break; if (_sp > XB_SPIN_CAP) { atomicAdd(&(bar)[XB_TMO], 1u); break; } } } } while (0)
__device__ __forceinline__ void xcd_barrier_complete(unsigned* bar, unsigned x, unsigned& nloc, unsigned& nx) {
  const unsigned G = gridDim.x;
  unsigned sum, cnt, mine, sp = 0u;
  for (;;) {
    sum = 0u; cnt = 0u; mine = 0u;
#pragma unroll
    for (unsigned j = 0; j < 16; ++j) { const unsigned c = xb_ld(&bar[XB_XCNT(j)]); sum += c; cnt += (c > 0u) ? 1u : 0u; mine = (j == x) ? c : mine; }
    if (sum == G) break;
    __builtin_amdgcn_s_sleep(1);
    if ((++sp & 255u) == 0u) { if (xb_ld(&bar[XB_TMO])) break; if (sp > XB_SPIN_CAP) { atomicAdd(&bar[XB_TMO], 1u); break; } }
  }
  nloc = mine > 0u ? mine : 1u; nx = cnt > 0u ? cnt : 1u;
}
__device__ __forceinline__ void xcd_barrier(unsigned* bar, unsigned x, volatile LAS unsigned* st) {
  asm volatile("s_waitcnt vmcnt(0)" ::: "memory");
  __syncthreads();
  if (threadIdx.x == 0) {
    __builtin_amdgcn_s_waitcnt(0);
    unsigned nloc = st[0], nx = st[1];
    if (nloc == 0u) { xcd_barrier_complete(bar, x, nloc, nx); st[0] = nloc; st[1] = nx; }
    const unsigned old = xb_add(&bar[XB_XSUB(x)], 1u);
    const unsigned gen = old / nloc;
    if (old + 1u == (gen + 1u) * nloc) {
      __builtin_amdgcn_fence(__ATOMIC_RELEASE, "agent");
      asm volatile("s_waitcnt vmcnt(0)" ::: "memory");
      const unsigned og = xb_add(&bar[XB_TOP], 1u);
      const unsigned tg = og / nx;
      if (og + 1u == (tg + 1u) * nx) xb_add(&bar[XB_TOPGEN], 1u);
      else XB_SPIN(xb_ld(&bar[XB_TOPGEN]) == tg, bar);
      __builtin_amdgcn_fence(__ATOMIC_ACQUIRE, "agent");
      xb_add(&bar[XB_XGEN(x)], 1u);
      asm volatile("s_waitcnt vmcnt(0)" ::: "memory");
    } else {
      XB_SPIN(xb_ld(&bar[XB_XGEN(x)]) == gen, bar);
      __builtin_amdgcn_fence(__ATOMIC_ACQUIRE, "agent");
      asm volatile("s_waitcnt vmcnt(0)" ::: "memory");
    }
  }
  __syncthreads();
}

#ifndef ENMASK
#define ENMASK 0xffff
#endif
#define EN(i) ((ENMASK >> (i)) & 1)
enum { OP_PRO = 0, OP_LN0, OP_LN1, OP_LNF, OP_FFI, OP_FFO, OP_UP, OP_M0, OP_GAT, OP_S, OP_M2, OP_FIN, OP_DN, OP_AQ, OP_APREP, OP_ACORE, OP_AO, OP_SI, OP_SCONV, OP_SO, OP_DNUP };
__global__ void __launch_bounds__(512) fwd_megakernel(Params p) {
  cg::grid_group grid = cg::this_grid();
  const int wave_s = __builtin_amdgcn_readfirstlane((int)threadIdx.x >> 6);
  volatile LAS unsigned* xst = (volatile LAS unsigned*)((LAS unsigned char*)lds_raw + (LDS_BYTES - 16));
  if (threadIdx.x == 0) { xst[0] = 0u; xst[1] = 0u; }
  __syncthreads();
  unsigned* xbar = (unsigned*)(p.ws + O_BAR);
  const unsigned xcc = xb_xcc_id();
  if (threadIdx.x == 0) (void)xb_add(&xbar[XB_XCNT(xcc)], 1u);
#ifdef DUP_OP
  int rep = 0;
#endif
  for (int ph = 0; ph < p.nph; ++ph) {
    const unsigned w = p.prog[ph];
    const int op = w & 255, a = (w >> 8) & 255, b = (w >> 16) & 255, c = (w >> 24) & 255;
#define MKCTX int z; asm volatile("s_mov_b32 %0, 0" : "=s"(z)); \
    GAS char* wsq = (GAS char*)p.ws; GAS float* outq = (GAS float*)p.out; int bidq = (int)blockIdx.x, nbq = (int)gridDim.x; \
    asm volatile("" : "+s"(wsq), "+s"(outq), "+s"(bidq), "+s"(nbq)); \
    const Ctx cx{wave_s * 64 + (int)__builtin_amdgcn_mbcnt_hi(~0u, __builtin_amdgcn_mbcnt_lo(~0u, (unsigned)z)), bidq, nbq, z, (char*)wsq, (float*)outq};
    if (EN(0) && op == OP_PRO) { MKCTX prologue(p, cx); }
    else if (EN(1) && op == OP_LN0) { MKCTX lnmod_phase<0>(p, cx, 0, 0, 0); }
    else if (EN(1) && op == OP_LN1) { MKCTX lnmod_phase<1>(p, cx, a, b, c); }
    else if (EN(1) && op == OP_LNF) { MKCTX lnmod_phase<2>(p, cx, a, 0, 0); }
    else if (EN(2) && op == OP_M0) { MKCTX ml_m0(p, cx, a); }
    else if (EN(3) && op == OP_GAT) { MKCTX ml_gates(p, cx, a); }
    else if (EN(4) && op == OP_S) { MKCTX ml_s(p, cx); }
    else if (EN(5) && op == OP_M2) { MKCTX ml_m2(p, cx); }
    else if (EN(6) && op == OP_FIN) { MKCTX ml_fin(p, cx, a); }
    else if (EN(7) && op == OP_APREP) { MKCTX at_prep(p, cx); }
    else if (EN(8) && op == OP_ACORE) { MKCTX at_core(p, cx); }
    else if (EN(9) && op == OP_SCONV) { MKCTX sc_conv(p, cx); }
    else if (EN(10)) {
      MKCTX
      char* ws = cx.ws;
      const RowMap idm{0, 0, 1 << 30};
      bf16_t* U = (bf16_t*)(ws + O_U); bf16_t* ACT = (bf16_t*)(ws + O_ACT);
      const float* MODT = (const float*)(ws + O_MODT);
      const int nrep = op == OP_DNUP ? 2 : 1;
      for (int rep = 0; rep < nrep; ++rep) {
        const int op2 = op == OP_DNUP ? (rep == 0 ? (int)OP_UP : (int)OP_DN) : op;
        const int c2 = (op == OP_DNUP && rep == 0) ? c + 1 : c;
        Ctx cg_ = cx;
        if (op == OP_DNUP && rep == 1) cg_.bid = (cx.bid + cx.nb - 32) % cx.nb;
        const bf16_t* A = U; const bf16_t* Bt; int K = 1024, nM = MROWS / 256, nN; RowMap am = idm, cm = idm;
        Epi E; E.kind = 2; E.O = ACT; E.ldc = 0; E.modl = MODT + (size_t)b * 9 * 9216; E.slot = 1; E.wgt = 1.0f;
        E.ln = b * 3 + 1 - 1;
        if (op2 == OP_FFI) { Bt = (const bf16_t*)(ws + O_WFI) + (size_t)a * 5632 * 1024; nN = 22; E.kind = 1; if (c) nM = NLAT / 256; }
        else if (op2 == OP_FFO) { A = ACT; Bt = (const bf16_t*)(ws + O_WFO) + (size_t)a * 1024 * 2816; K = 2816; nN = 4; E.slot = c & 3; E.wgt = 0.5f; E.ln = b * 3 + (c & 3) - 1; if (c & 4) nM = NLAT / 256; }
        else if (op2 == OP_UP) { Bt = (const bf16_t*)(ws + O_WUP) + (size_t)a * 4096 * 1024; nM = RG / 256; nN = 16; am = RowMap{c2 * GB * SEQ, NLAT + c2 * GB * LC, GB * SEQ / 256}; E.kind = 0; E.O = (bf16_t*)(ws + O_XZ); E.ldc = 4096; }
        else if (op2 == OP_DN) { A = (const bf16_t*)(ws + O_FIN); Bt = (const bf16_t*)(ws + O_WDN) + (size_t)a * 1024 * 2048; K = 2048; nM = RG / 256; nN = 4; cm = RowMap{c2 * GB * SEQ, NLAT + c2 * GB * LC, GB * SEQ / 256}; }
        else if (op2 == OP_AQ) { Bt = (const bf16_t*)(ws + O_WAQ); nN = 6; E.kind = 0; E.ldc = 1536; }
        else if (op2 == OP_AO) { Bt = (const bf16_t*)(ws + O_WAO); nN = 4; }
        else if (op2 == OP_SI) { Bt = (const bf16_t*)(ws + O_WSI); nN = 12; E.kind = 0; E.ldc = 3072; }
        else { Bt = (const bf16_t*)(ws + O_WSO); nN = 4; }
        gemm_phase(cg_, A, am, Bt, K, nM, nN, cm, E);
      }
    }
    if (ph == 0) grid.sync(); else xcd_barrier(xbar, xcc, xst);
#ifdef DUP_OP
    if (op == DUP_OP && rep + 1 < DUP_N) { ++rep; --ph; } else rep = 0;
#endif
  }
}

static int build_program(unsigned* prog) {
  int n = 0;
  auto W = [&](int op, int a, int b, int c) { prog[n++] = (unsigned)op | ((unsigned)a << 8) | ((unsigned)b << 16) | ((unsigned)c << 24); };
  W(OP_PRO, 0, 0, 0);
  W(OP_LN0, 0, 0, 0);
  for (int layer = 0; layer < DEPTH; ++layer) {
    const int kind = layer % 3, j = layer / 3;
    W(OP_FFI, layer * 2, layer, 0); W(OP_FFO, layer * 2, layer, 0);
    W(OP_LN1, layer * 3 + 0, layer, 1);
    if (kind == 0) {
      for (int g = 0; g < NG; ++g) { if (g == 0) W(OP_UP, j, layer, g); W(OP_M0, j, 0, 0); W(OP_GAT, j, 0, 0); W(OP_S, 0, 0, 0); W(OP_M2, 0, 0, 0); W(OP_FIN, j, 0, 0); W(g + 1 < NG ? OP_DNUP : OP_DN, j, layer, g); }
    } else if (kind == 1) { W(OP_AQ, 0, layer, 0); W(OP_APREP, 0, 0, 0); W(OP_ACORE, 0, 0, 0); W(OP_AO, 0, layer, 0); }
    else { W(OP_SI, 0, layer, 0); W(OP_SCONV, 0, 0, 0); W(OP_SO, 0, layer, 0); }
    W(OP_LN1, layer * 3 + 1, layer, 2);
    const int lo = (layer + 1 == DEPTH) ? 1 : 0;
    W(OP_FFI, layer * 2 + 1, layer, lo); W(OP_FFO, layer * 2 + 1, layer, 2 | (lo << 2));
    if (layer + 1 < DEPTH) W(OP_LN1, layer * 3 + 2, layer + 1, 0); else W(OP_LNF, layer * 3 + 2, 0, 0);
  }
  return n;
}

extern "C" void kernel_launch(void* const* d_in, const int* in_sizes, int n_in, void* d_out, int out_size, void* d_ws, size_t ws_size, hipStream_t stream) {
  static int grid_blocks = 0;
  if (!grid_blocks) {
    int dev = 0, cus = 0, per_cu = 0;
    (void)hipGetDevice(&dev);
    (void)hipDeviceGetAttribute(&cus, hipDeviceAttributeMultiprocessorCount, dev);
    (void)hipFuncSetAttribute((const void*)fwd_megakernel, hipFuncAttributeMaxDynamicSharedMemorySize, LDS_BYTES);
    (void)hipOccupancyMaxActiveBlocksPerMultiprocessor(&per_cu, fwd_megakernel, 512, LDS_BYTES);
    if (cus <= 0) cus = 256;
    grid_blocks = cus;
    if (ws_size < WS_END || n_in != 25) fprintf(stderr, "kernel_launch: workspace %zu < %zu or n_in %d != 25\n", ws_size, (size_t)WS_END, n_in);
    if (per_cu < 1) fprintf(stderr, "kernel_launch: occupancy query says %d blocks per CU\n", per_cu);
  }
  Params p{};
  for (int i = 0; i < 25; ++i) p.in[i] = (const float*)d_in[i];
  p.out = (float*)d_out; p.ws = (char*)d_ws;
  p.nph = build_program(p.prog);
  (void)hipMemsetAsync((char*)d_ws + O_BAR, 0, XCD_BAR_WORDS * 4, stream);
  void* args[] = {&p};
  hipError_t e = hipLaunchCooperativeKernel((void*)fwd_megakernel, dim3(grid_blocks), dim3(512), args, LDS_BYTES, stream);
  if (e != hipSuccess) fprintf(stderr, "cooperative launch failed: %s (grid %d)\n", hipGetErrorString(e), grid_blocks);
}
```

```cpp
#include <hip/hip_runtime.h>
#include <hip/hip_cooperative_groups.h>
#include <cstdio>
#include <cstdint>
namespace cg = cooperative_groups;

typedef unsigned short bf16_t;
typedef short bf16x8 __attribute__((ext_vector_type(8)));
typedef short bf16x4 __attribute__((ext_vector_type(4)));
typedef float f32x4 __attribute__((ext_vector_type(4)));
typedef unsigned u32x2 __attribute__((ext_vector_type(2)));
typedef unsigned u32x4 __attribute__((ext_vector_type(4)));

constexpr int D = 1024, NB = 8, SEQ = 4096, LC = 256, DEPTH = 4, FF = 2816, EI = 2048, DH = 512;
constexpr int NLAT = NB * SEQ, NCTX = NB * LC, MROWS = NLAT + NCTX;
constexpr int TOKB = LC + SEQ;
constexpr int NCH = TOKB / 64;
constexpr int GB = 2, NG = NB / GB, RG = GB * TOKB;
constexpr int NSEQ = GB * 8;
constexpr float ALPHA = 1.681792830507429f, LN_EPS = 1e-5f;
constexpr int LDS_BYTES = 144 * 1024;

constexpr size_t al256(size_t x) { return (x + 255) & ~(size_t)255; }
constexpr size_t O_WFI = 0;
constexpr size_t O_WFO = O_WFI + (size_t)8 * 5632 * 1024 * 2;
constexpr size_t O_WUP = O_WFO + (size_t)8 * 1024 * 2816 * 2;
constexpr size_t O_WDN = O_WUP + (size_t)2 * 4096 * 1024 * 2;
constexpr size_t O_WAQ = O_WDN + (size_t)2 * 1024 * 2048 * 2;
constexpr size_t O_WAO = O_WAQ + (size_t)1536 * 1024 * 2;
constexpr size_t O_WSI = O_WAO + (size_t)1024 * 1024 * 2;
constexpr size_t O_WSO = O_WSI + (size_t)3072 * 1024 * 2;
constexpr size_t O_WG = O_WSO + (size_t)1024 * 1024 * 2;
constexpr size_t O_MODT = O_WG + (size_t)2 * 16 * 6144 * 2;
constexpr size_t O_ROPE = O_MODT + (size_t)4 * 9 * 9216 * 4;
constexpr size_t O_HCTX = O_ROPE + (size_t)2 * 4096 * 32 * 4;
constexpr size_t O_U = O_HCTX + (size_t)NCTX * D * 4;
constexpr size_t O_R = O_U + (size_t)MROWS * D * 2;
constexpr size_t O_XZ = O_R;
constexpr size_t O_QK = O_XZ + (size_t)RG * 4096 * 2;
constexpr size_t O_KT = O_QK + (size_t)RG * 4096 * 2;
constexpr size_t O_VT = O_KT + (size_t)GB * EI * TOKB * 2;
constexpr size_t O_SP = O_VT + (size_t)GB * EI * TOKB * 2;
constexpr size_t O_HD = O_SP + (size_t)NSEQ * NCH * 4096 * 2;
constexpr size_t O_FIN = O_HD + (size_t)2 * RG * EI * 2;
constexpr size_t O_GAT = O_FIN + (size_t)RG * EI * 2;
constexpr size_t SZ_ST = (size_t)NSEQ * TOKB * 4;
constexpr size_t O_BL = O_GAT, O_IG = O_BL + SZ_ST, O_WIN = O_IG + SZ_ST, O_FLO = O_WIN + SZ_ST, O_DEN = O_FLO + SZ_ST, O_WSS = O_DEN + SZ_ST;
constexpr size_t O_GC = O_WSS + SZ_ST;
constexpr size_t O_QF = O_GC + (size_t)3 * NSEQ * NCH * 4 + 256;
constexpr size_t O_REND_ML = O_QF + (size_t)GB * EI * TOKB * 2;
constexpr size_t O_ACT = O_R;
constexpr size_t O_AKR = O_R + (size_t)MROWS * 3072 * 2;
constexpr size_t O_AVT = O_AKR + (size_t)NB * 4 * TOKB * 64 * 2;
constexpr size_t O_REND_AT = O_AVT + (size_t)NB * 4 * TOKB * 64 * 2;
constexpr size_t O_BAR = (O_REND_ML > O_REND_AT ? O_REND_ML : O_REND_AT);
constexpr size_t O_STATS = O_BAR + 3456 * 4 + 256;
constexpr size_t O_LNT = O_STATS + (size_t)MROWS * 8 + 256;
constexpr size_t WS_END = O_LNT + (size_t)12 * 2 * D * 4 + 256;

struct Params {
  const float* in[25];
  float* out;
  char* ws;
  int nph; int pad0;
  unsigned prog[126];
};

#define GAS __attribute__((address_space(1)))
#define IN(k) ((const float*)(const GAS float*)p.in[(k) + cx.z])
struct Ctx { int tid, bid, nb, z; char* ws; float* out; };
extern __shared__ __attribute__((aligned(16))) char lds_raw[];

__device__ __forceinline__ unsigned pk2(float lo, float hi) { unsigned r; asm volatile("v_cvt_pk_bf16_f32 %0, %1, %2" : "=v"(r) : "v"(lo), "v"(hi)); return r; }
__device__ __forceinline__ float bf2f(unsigned short v) { return __uint_as_float(((unsigned)v) << 16); }
__device__ __forceinline__ float bflo(unsigned v) { return __uint_as_float(v << 16); }
__device__ __forceinline__ float bfhi(unsigned v) { return __uint_as_float(v & 0xffff0000u); }
__device__ __forceinline__ float silu_f(float x) { return x * __builtin_amdgcn_rcpf(1.f + __expf(-x)); }
__device__ __forceinline__ float sigm_f(float x) { return __builtin_amdgcn_rcpf(1.f + __expf(-x)); }
__device__ __forceinline__ float shi(float v, int srclane) { return __int_as_float(__builtin_amdgcn_ds_bpermute(srclane << 2, __float_as_int(v))); }
__device__ __forceinline__ float shx(float v, int m, int lane) { return shi(v, lane ^ m); }
__device__ __forceinline__ float wave_sum(float v, int lane) {
#pragma unroll
  for (int o = 1; o < 64; o <<= 1) v += shx(v, o, lane);
  return v;
}
__device__ __forceinline__ bf16x8 mk8(u32x4 v) { union { u32x4 u; bf16x8 b; } x; x.u = v; return x.b; }
__device__ __forceinline__ bf16x8 mk8(u32x2 a, u32x2 b) { union { u32x4 u; bf16x8 b; } x; x.u = (u32x4){a.x, a.y, b.x, b.y}; return x.b; }
__device__ __forceinline__ float* hrow(const Ctx& cx, int row) { return row < NLAT ? cx.out + (size_t)row * D : (float*)(cx.ws + O_HCTX) + (size_t)(row - NLAT) * D; }
#define MFMA16(a, b, c) __builtin_amdgcn_mfma_f32_16x16x32_bf16(a, b, c, 0, 0, 0)
__device__ __forceinline__ size_t nat(int r, int c, int K) { return ((size_t)(r >> 4) * (K >> 5) + (c >> 5)) * 512 + (r & 15) * 32 + (c & 31); }

constexpr int BM = 256, BK = 64, HALF = 128, HT = HALF * BK, NXCD = 8, WGM = 4;
__device__ __forceinline__ int lds_byte(int r, int c) {
  int st = (r >> 4) * 2 + (c >> 5), rr = r & 15, cc = c & 31, ob = rr * 64 + cc * 2;
  return st * 1024 + (ob ^ (((ob >> 9) & 1) << 5));
}
__device__ __forceinline__ void stage_rc(int b, int& R, int& C) {
  int st = b / 1024, sb = b % 1024, swz = sb ^ (((sb >> 9) & 1) << 5);
  R = (st >> 1) * 16 + swz / 64; C = (st & 1) * 32 + (swz % 64) / 2;
}
struct RowMap { int lat0, ctx0, nlat; __device__ __forceinline__ int row0(int pm) const { return pm < nlat ? lat0 + pm * 256 : ctx0 + (pm - nlat) * 256; } };

typedef f32x4 Acc[2][2][4][2];

struct Epi {
  int kind; bf16_t* O; int ldc; const float* modl; int slot; float wgt;
  int ln;
};
__device__ __forceinline__ void run_epi(const Ctx& cx, const Epi E, const Acc& acc, int r0, int pn, int wr, int wc, int fr, int fq) {
  if (E.kind == 0) {
#pragma unroll
    for (int ai = 0; ai < 2; ++ai)
#pragma unroll
      for (int m = 0; m < 4; ++m) {
        bf16_t* rp = E.O + (size_t)(r0 + ai * HALF + wr * 64 + m * 16 + fr) * E.ldc + pn * 256 + wc * 32 + 4 * fq;
#pragma unroll
        for (int bj = 0; bj < 2; ++bj)
#pragma unroll
          for (int n = 0; n < 2; ++n) {
            f32x4 v = acc[ai][bj][m][n];
            u32x2 o; o.x = pk2(v[0], v[1]); o.y = pk2(v[2], v[3]);
            *(u32x2*)(rp + bj * HALF + n * 16) = o;
          }
      }
  } else if (E.kind == 1) {
#pragma unroll
    for (int ai = 0; ai < 2; ++ai)
#pragma unroll
      for (int m = 0; m < 4; ++m) {
        const int rrow = r0 + ai * HALF + wr * 64 + m * 16 + fr, fcol = pn * 128 + wc * 16 + 4 * fq;
#pragma unroll
        for (int bj = 0; bj < 2; ++bj) {
          f32x4 g = acc[ai][bj][m][0], v = acc[ai][bj][m][1];
          u32x2 o; o.x = pk2(silu_f(g[0]) * v[0], silu_f(g[1]) * v[1]); o.y = pk2(silu_f(g[2]) * v[2], silu_f(g[3]) * v[3]);
          *(u32x2*)(E.O + nat(rrow, fcol + bj * 64, FF)) = o;
        }
      }
  } else {
    const int midx = r0 < NLAT ? (r0 >> 12) : 8;
    const int cb = pn * 256 + wc * 32 + 4 * fq;
    const float* gp = E.modl + (size_t)midx * 9216 + (3 * E.slot + 2) * D + cb;
    f32x4 gv[2][2], lg[2][2], lb[2][2];
#pragma unroll
    for (int bj = 0; bj < 2; ++bj)
#pragma unroll
      for (int n = 0; n < 2; ++n) {
        gv[bj][n] = *(const f32x4*)(gp + bj * HALF + n * 16) * E.wgt;
        if (E.ln >= 0) { const float* lt = (const float*)(cx.ws + O_LNT) + (size_t)E.ln * 2 * D + cb + bj * HALF + n * 16; lg[bj][n] = *(const f32x4*)lt; lb[bj][n] = *(const f32x4*)(lt + D); }
        else { lg[bj][n] = (f32x4){1.f, 1.f, 1.f, 1.f}; lb[bj][n] = (f32x4){0.f, 0.f, 0.f, 0.f}; }
      }
#pragma unroll
    for (int ai = 0; ai < 2; ++ai)
#pragma unroll
      for (int m = 0; m < 4; ++m) {
        const int row = r0 + ai * HALF + wr * 64 + m * 16 + fr;
        float* rp = hrow(cx, row) + cb;
        float mean = 0.f, rstd = 1.f;
        if (E.ln >= 0) { const float2 st = *(const float2*)((const float*)(cx.ws + O_STATS) + (size_t)row * 2); mean = st.x; rstd = st.y; }
        f32x4 h[2][2];
#pragma unroll
        for (int bj = 0; bj < 2; ++bj)
#pragma unroll
          for (int n = 0; n < 2; ++n) h[bj][n] = *(const f32x4*)(rp + bj * HALF + n * 16);
#pragma unroll
        for (int bj = 0; bj < 2; ++bj)
#pragma unroll
          for (int n = 0; n < 2; ++n) *(f32x4*)(rp + bj * HALF + n * 16) = ((h[bj][n] - mean) * rstd) * lg[bj][n] + lb[bj][n] + gv[bj][n] * acc[ai][bj][m][n];
        __builtin_amdgcn_sched_barrier(0);
      }
  }
}

#define LAS __attribute__((address_space(3)))
__device__ __forceinline__ void gemm_phase(const Ctx& cx, const bf16_t* __restrict__ A, RowMap am, const bf16_t* __restrict__ Bt, int K, int nM, int nN, RowMap cm, const Epi epi) {
  LAS unsigned char* lds = (LAS unsigned char*)lds_raw;
  constexpr int HTB = HT * 2;
  const int tid = cx.tid, wid = tid >> 6, lane = tid & 63, wr = wid >> 2, wc = wid & 3, fr = lane & 15, fq = lane >> 4;
  unsigned voff[2];
#pragma unroll
  for (int i = 0; i < 2; ++i) { const int st = wid + 8 * i, sb = lane * 16; voff[i] = (unsigned)(((st >> 1) * (K >> 5) + (st & 1)) * 1024 + (sb ^ (((sb >> 9) & 1) << 5))); }
  const size_t kstep = 2048, hstep = (size_t)8 * (K >> 5) * 1024;
  const unsigned ldsw = (unsigned)wid * 1024u;
  const int aoff = lds_byte(wr * 64 + fr, fq * 8), boff = lds_byte(wc * 32 + fr, fq * 8);
#define G_SA(b, h) (((b) * 2 + (h)) * HTB)
#define G_SB(b, h) ((4 + (b) * 2 + (h)) * HTB)
#define STAGE(bufoff, gbase) do { _Pragma("unroll") for (int _i = 0; _i < 2; ++_i) \
    __builtin_amdgcn_global_load_lds((const unsigned*)((const char*)(gbase) + voff[_i]), (LAS unsigned*)(lds + (bufoff) + ldsw + _i * 8192), 16, 0, 0); } while (0)
#define LDA(dst, b, h) do { _Pragma("unroll") for (int m = 0; m < 4; ++m) _Pragma("unroll") for (int k = 0; k < 2; ++k) dst[m][k] = *(const LAS bf16x8*)(lds + G_SA(b, h) + aoff + m * 2048 + k * 1024); } while (0)
#define LDB(dst, b, h) do { _Pragma("unroll") for (int n = 0; n < 2; ++n) _Pragma("unroll") for (int k = 0; k < 2; ++k) dst[n][k] = *(const LAS bf16x8*)(lds + G_SB(b, h) + boff + n * 2048 + k * 1024); } while (0)
#define MMA(ai, bj, At, Bt_) do { __builtin_amdgcn_s_setprio(1); _Pragma("unroll") for (int m = 0; m < 4; ++m) _Pragma("unroll") for (int n = 0; n < 2; ++n) _Pragma("unroll") for (int k = 0; k < 2; ++k) \
      acc[ai][bj][m][n] = MFMA16(Bt_[n][k], At[m][k], acc[ai][bj][m][n]); \
    __builtin_amdgcn_s_setprio(0); } while (0)
#define WAIT_V(n) asm volatile("s_waitcnt vmcnt(" #n ")" ::: "memory")
#define WAIT_L(n) asm volatile("s_waitcnt lgkmcnt(" #n ")" ::: "memory")
#define BAR __builtin_amdgcn_s_barrier()
#define SCHED __builtin_amdgcn_sched_barrier(0)
  const int nwg = nM * nN;
  const int nt = K / BK;
  const int wid_s = __builtin_amdgcn_readfirstlane(wid);
#define DECODE(L_, pm_, pn_) do { int wgid = (L_); \
    { int q = nwg / NXCD, r = nwg % NXCD, xcd = wgid % NXCD, off = wgid / NXCD; wgid = (xcd < r ? xcd * (q + 1) : r * (q + 1) + (xcd - r) * q) + off; } \
    const int nig = WGM * nN, gid = wgid / nig, fm = gid * WGM, gsz = min(nM - fm, WGM); \
    pm_ = fm + ((wgid % nig) % gsz); pn_ = (wgid % nig) / gsz; } while (0)
  int L = cx.bid;
  if (L < nwg) {
    int pm, pn;
    DECODE(L, pm, pn);
    const char* cA = (const char*)A + (size_t)(am.row0(pm) >> 4) * (K >> 5) * 1024; const char* cB = (const char*)Bt + (size_t)(pn * BM >> 4) * (K >> 5) * 1024;
    Acc acc;
#pragma unroll
    for (int a = 0; a < 2; ++a)
#pragma unroll
      for (int b = 0; b < 2; ++b)
#pragma unroll
        for (int m = 0; m < 4; ++m)
#pragma unroll
          for (int n = 0; n < 2; ++n) acc[a][b][m][n] = (f32x4){0.f, 0.f, 0.f, 0.f};
    bf16x8 At[4][2], B0[2][2], B1[2][2];
    STAGE(G_SB(0, 0), cB); STAGE(G_SA(0, 0), cA); STAGE(G_SB(0, 1), cB + hstep); STAGE(G_SA(0, 1), cA + hstep);
    if (wr == 1) BAR;
    WAIT_V(4); BAR;
    STAGE(G_SB(1, 0), cB + kstep); STAGE(G_SA(1, 0), cA + kstep); STAGE(G_SB(1, 1), cB + hstep + kstep);
    WAIT_V(6); BAR;
    for (;;) {
      const int Ln = L + cx.nb;
      const bool has_next = Ln < nwg;
      int pmn = pm, pnn = pn;
      if (has_next) DECODE(Ln, pmn, pnn);
      const char* nA = has_next ? (const char*)A + (size_t)(am.row0(pmn) >> 4) * (K >> 5) * 1024 : cA; const char* nB = has_next ? (const char*)Bt + (size_t)(pnn * BM >> 4) * (K >> 5) * 1024 : cB;
      for (int t = 0; t < nt; t += 2) {
        const bool last = (t == nt - 2);
        const char* a1 = cA + (size_t)(t + 1) * kstep;
        const char* a2 = last ? nA : cA + (size_t)(t + 2) * kstep; const char* b2 = last ? nB : cB + (size_t)(t + 2) * kstep;
        const char* a3 = a2 + kstep; const char* b3 = b2 + kstep;
        LDB(B0, 0, 0); SCHED; LDA(At, 0, 0); STAGE(G_SA(1, 1), a1 + hstep);
        WAIT_L(8); BAR; WAIT_L(0); MMA(0, 0, At, B0); BAR; SCHED;
        LDB(B1, 0, 1); STAGE(G_SB(0, 0), b2);
        BAR; WAIT_L(0); MMA(0, 1, At, B1); BAR;
        LDA(At, 0, 1); STAGE(G_SA(0, 0), a2);
        BAR; WAIT_L(0); MMA(1, 0, At, B0); BAR; SCHED;
        STAGE(G_SB(0, 1), b2 + hstep);
        WAIT_V(6); BAR; MMA(1, 1, At, B1); BAR;
        LDB(B0, 1, 0); SCHED; LDA(At, 1, 0); STAGE(G_SA(0, 1), a2 + hstep);
        WAIT_L(8); BAR; WAIT_L(0); MMA(0, 0, At, B0); BAR; SCHED;
        LDB(B1, 1, 1); STAGE(G_SB(1, 0), b3);
        BAR; WAIT_L(0); MMA(0, 1, At, B1); BAR;
        LDA(At, 1, 1); STAGE(G_SA(1, 0), a3);
        BAR; WAIT_L(0); MMA(1, 0, At, B0); BAR; SCHED;
        STAGE(G_SB(1, 1), b3 + hstep);
        WAIT_V(6); BAR; MMA(1, 1, At, B1); BAR;
      }
      { int t2 = wid_s * 64 + (int)__builtin_amdgcn_mbcnt_hi(~0u, __builtin_amdgcn_mbcnt_lo(~0u, (unsigned)cx.z)); asm volatile("" : "+v"(t2));
        const int w2 = t2 >> 6, l2 = t2 & 63;
        run_epi(cx, epi, acc, cm.row0(pm), pn, w2 >> 2, w2 & 3, l2 & 15, l2 >> 4); }
      if (!has_next) break;
#pragma unroll
      for (int a = 0; a < 2; ++a)
#pragma unroll
        for (int b = 0; b < 2; ++b)
#pragma unroll
          for (int m = 0; m < 4; ++m)
#pragma unroll
            for (int n = 0; n < 2; ++n) acc[a][b][m][n] = (f32x4){0.f, 0.f, 0.f, 0.f};
      pm = pmn; pn = pnn; cA = nA; cB = nB; L = Ln;
    }
    WAIT_V(0);
    if (wr == 0) BAR;
    BAR;
  }
  __syncthreads();
}

template <int MODE>
__device__ __forceinline__ int wrow(int c) {
  if (MODE == 0) return c;
  const int isv = c >= FF ? 1 : 0, f = c - isv * FF;
  return (f >> 7) * 256 + ((f >> 6) & 1) * 128 + ((f >> 4) & 3) * 32 + isv * 16 + (f & 15);
}
template <int MODE>
__device__ __forceinline__ void transpose_item(const float* __restrict__ W, int K, int N, bf16_t* __restrict__ WT, float* scr, int item, int lane) {
  const int nblk = N / 32, kb = item / nblk, nb = item % nblk, k0 = 64 * kb, n0 = 32 * nb;
#pragma unroll 8
  for (int i = 0; i < 32; ++i) { const int kk = 2 * i + (lane >> 5); scr[kk * 33 + (lane & 31)] = W[(size_t)(k0 + kk) * N + n0 + (lane & 31)]; }
  __builtin_amdgcn_wave_barrier(); asm volatile("s_waitcnt lgkmcnt(0)" ::: "memory");
  const int c = lane & 7;
#pragma unroll
  for (int j = 0; j < 4; ++j) {
    const int n = (lane >> 3) + 8 * j; const float* s = scr + (8 * c) * 33 + n;
    u32x4 o; o.x = pk2(s[0 * 33], s[1 * 33]); o.y = pk2(s[2 * 33], s[3 * 33]); o.z = pk2(s[4 * 33], s[5 * 33]); o.w = pk2(s[6 * 33], s[7 * 33]);
    *(u32x4*)(WT + nat(wrow<MODE>(n0 + n), k0 + 8 * c, K)) = o;
  }
  asm volatile("s_waitcnt lgkmcnt(0)" ::: "memory"); __builtin_amdgcn_wave_barrier();
}

__device__ __forceinline__ void prologue(const Params& p, const Ctx& cx) {
  const int tid = cx.tid, lane = tid & 63, wave = tid >> 6;
  char* ws = cx.ws;
  {
    float* cond = (float*)lds_raw;
    float* red = (float*)(lds_raw + 9 * 1024 * 4);
    for (int i = tid; i < 9 * 1024; i += 512) { const int j = i >> 10, k = i & 1023; cond[i] = silu_f(j < 8 ? IN(1)[j * 1024 + k] : IN(3)[k]); }
    __syncthreads();
    for (int u = cx.bid; u < 4 * 36; u += cx.nb) {
      const int layer = u / 36, ct = u % 36, c0 = ct * 256 + 4 * lane;
      const float* wp = IN(4) + (size_t)layer * D * 9216 + c0;
      f32x4 a[9];
#pragma unroll
      for (int j = 0; j < 9; ++j) a[j] = (f32x4){0.f, 0.f, 0.f, 0.f};
#pragma unroll 4
      for (int k = wave * 128; k < wave * 128 + 128; ++k) {
        const f32x4 w = *(const f32x4*)(wp + (size_t)k * 9216);
#pragma unroll
        for (int j = 0; j < 9; ++j) a[j] += w * cond[j * 1024 + k];
      }
#pragma unroll
      for (int j = 0; j < 9; ++j) *(f32x4*)(red + (wave * 9 + j) * 256 + 4 * lane) = a[j];
      __syncthreads();
      float* mt = (float*)(ws + O_MODT) + (size_t)layer * 9 * 9216;
      for (int i = tid; i < 9 * 256; i += 512) {
        const int j = i >> 8, c = i & 255; float s = 0.f;
#pragma unroll
        for (int w = 0; w < 8; ++w) s += red[(w * 9 + j) * 256 + c];
        mt[(size_t)j * 9216 + ct * 256 + c] = s + IN(5)[layer * 9216 + ct * 256 + c];
      }
      __syncthreads();
    }
    __syncthreads();
  }
  {
    float* scr = (float*)lds_raw + wave * (64 * 33);
    const int gw = cx.bid * 8 + wave, NGW = cx.nb * 8;
    constexpr int I_FI = 16 * 176, I_FO = 44 * 32, I_UP = 16 * 128, I_DN = 32 * 32, I_AQ = 16 * 48, I_AO = 16 * 32, I_SI = 16 * 96, I_SO = 16 * 32;
    constexpr int NITEMS = 8 * I_FI + 8 * I_FO + 2 * I_UP + 2 * I_DN + I_AQ + I_AO + I_SI + I_SO;
    for (int it = gw; it < NITEMS; it += NGW) {
      int r = it;
      if (r < 8 * I_FI) { const int mi = r / I_FI; transpose_item<1>(IN(8) + (size_t)mi * 1024 * 5632, 1024, 5632, (bf16_t*)(ws + O_WFI) + (size_t)mi * 5632 * 1024, scr, r % I_FI, lane); continue; } r -= 8 * I_FI;
      if (r < 8 * I_FO) { const int mi = r / I_FO; transpose_item<0>(IN(9) + (size_t)mi * 2816 * 1024, 2816, 1024, (bf16_t*)(ws + O_WFO) + (size_t)mi * 1024 * 2816, scr, r % I_FO, lane); continue; } r -= 8 * I_FO;
      if (r < 2 * I_UP) { const int mi = r / I_UP; transpose_item<0>(IN(10) + (size_t)mi * 1024 * 4096, 1024, 4096, (bf16_t*)(ws + O_WUP) + (size_t)mi * 4096 * 1024, scr, r % I_UP, lane); continue; } r -= 2 * I_UP;
      if (r < 2 * I_DN) { const int mi = r / I_DN; transpose_item<0>(IN(18) + (size_t)mi * 2048 * 1024, 2048, 1024, (bf16_t*)(ws + O_WDN) + (size_t)mi * 1024 * 2048, scr, r % I_DN, lane); continue; } r -= 2 * I_DN;
      if (r < I_AQ) { transpose_item<0>(IN(19), 1024, 1536, (bf16_t*)(ws + O_WAQ), scr, r, lane); continue; } r -= I_AQ;
      if (r < I_AO) { transpose_item<0>(IN(21), 1024, 1024, (bf16_t*)(ws + O_WAO), scr, r, lane); continue; } r -= I_AO;
      if (r < I_SI) { transpose_item<0>(IN(22), 1024, 3072, (bf16_t*)(ws + O_WSI), scr, r, lane); continue; } r -= I_SI;
      transpose_item<0>(IN(24), 1024, 1024, (bf16_t*)(ws + O_WSO), scr, r, lane);
    }
  }
  {
    const int gt = cx.bid * 512 + tid, gs = cx.nb * 512;
    bf16_t* wg = (bf16_t*)(ws + O_WG);
    for (int i = gt; i < 2 * 16 * 6144; i += gs) {
      const int j = i / (16 * 6144), xg = (i / 6144) & 15, k = i % 6144, x = xg >> 3, g = xg & 7;
      const float* wif = IN(14) + (size_t)(j * 2 + x) * 6144 * 8;
      float v;
      const int knat = (k & ~31) + 16 * ((k >> 2) & 1) + 4 * ((k >> 3) & 3) + (k & 3);
      if (k < 2048) v = wif[(size_t)knat * 8 + g];
      else if (k < 4096) v = wif[(size_t)knat * 8 + g] * 22.627416997969522f;
      else {
        const int c = k - 4096, blk = c >> 2, cc = c & 3;
        const float* wv = IN(13) + ((size_t)(j * 3 + 2) * 512 + blk) * 16 + cc * 4;
        v = 0.f;
        for (int d2 = 0; d2 < 4; ++d2) v += wv[d2] * wif[(size_t)(4096 + 4 * blk + d2) * 8 + g];
      }
      wg[i] = (bf16_t)(pk2(v, 0.f) & 0xffff);
    }
    { float* lnt = (float*)(ws + O_LNT); for (int i = gt; i < 12 * D; i += gs) { const int l = i / D, c2 = i % D; lnt[(size_t)l * 2 * D + c2] = IN(6)[i] * ALPHA; lnt[(size_t)l * 2 * D + D + c2] = IN(7)[i] * ALPHA; } }
    float* rc = (float*)(ws + O_ROPE); float* rs = rc + 4096 * 32;
    for (int i = gt; i < 4096 * 32; i += gs) {
      const int pos = i >> 5, pp = i & 31, jf = pp & 15;
      const float fr_ = __builtin_amdgcn_exp2f(-(float)jf * (13.287712379549449f / 16.f));
      float rev = (float)(pp < 16 ? (pos >> 6) : (pos & 63)) * fr_ * 0.15915494309189535f;
      rev -= rintf(rev);
      rc[i] = __builtin_amdgcn_cosf(rev); rs[i] = __builtin_amdgcn_sinf(rev);
    }
  }
}

template <int MODE>
__device__ __forceinline__ void lnmod_phase(const Params& p, const Ctx& cx, int lnidx  , int layer, int slot) {
  const int lane = cx.tid & 63, gw = cx.bid * 8 + (cx.tid >> 6), NGW = cx.nb * 8;
  const int nrows = MODE == 2 ? NLAT : MROWS;
  const float* lg = IN(6) + (size_t)lnidx * D; const float* lb = IN(7) + (size_t)lnidx * D;
  const float* modl = (const float*)(cx.ws + O_MODT) + (size_t)layer * 9 * 9216;
  bf16_t* U = (bf16_t*)(cx.ws + O_U);
  for (int row = gw; row < nrows; row += NGW) {
    float* hp = hrow(cx, row);
    const float* src = MODE == 0 ? (row < NLAT ? IN(0) + (size_t)row * D : IN(2) + (size_t)(row - NLAT) * D) : hp;
    f32x4 v[4];
#pragma unroll
    for (int j = 0; j < 4; ++j) v[j] = *(const f32x4*)(src + 4 * lane + 256 * j);
    if (MODE != 0) {
      float s = 0.f;
#pragma unroll
      for (int j = 0; j < 4; ++j) s += (v[j][0] + v[j][1]) + (v[j][2] + v[j][3]);
      const float mean = wave_sum(s, lane) * (1.f / D); float s2 = 0.f;
#pragma unroll
      for (int j = 0; j < 4; ++j) { v[j] = v[j] - mean; s2 += (v[j][0] * v[j][0] + v[j][1] * v[j][1]) + (v[j][2] * v[j][2] + v[j][3] * v[j][3]); }
      const float rstd = __builtin_amdgcn_rsqf(wave_sum(s2, lane) * (1.f / D) + LN_EPS);
      if (MODE == 1 && lane == 0) *(float2*)((float*)(cx.ws + O_STATS) + (size_t)row * 2) = make_float2(mean, rstd);
#pragma unroll
      for (int j = 0; j < 4; ++j) v[j] = v[j] * rstd * *(const f32x4*)(lg + 4 * lane + 256 * j) + *(const f32x4*)(lb + 4 * lane + 256 * j);
    }
    if (MODE != 1) {
#pragma unroll
      for (int j = 0; j < 4; ++j) *(f32x4*)(hp + 4 * lane + 256 * j) = MODE == 0 ? v[j] * ALPHA : v[j];
    }
    if (MODE != 2) {
      const int midx = row < NLAT ? (row >> 12) : 8;
      const float* sh = modl + (size_t)midx * 9216 + (3 * slot) * D; const float* sc = sh + D;
#pragma unroll
      for (int j = 0; j < 4; ++j) {
        const f32x4 u = v[j] * (*(const f32x4*)(sc + 4 * lane + 256 * j) + 1.f) + *(const f32x4*)(sh + 4 * lane + 256 * j);
        u32x2 o; o.x = pk2(u[0], u[1]); o.y = pk2(u[2], u[3]);
        *(u32x2*)(U + nat(row, 4 * lane + 256 * j, D)) = o;
      }
    }
  }
}

__device__ __forceinline__ int ml_lrow(int bl, int tok) { return tok < LC ? GB * SEQ + bl * LC + tok : bl * SEQ + (tok - LC); }
__device__ __forceinline__ int ml_nchunk(int x, int st) { return x == 0 ? st : (st < 4 ? 3 - st : 71 - st); }

__device__ __forceinline__ void ml_m0(const Params& p, const Ctx& cx, int j) {
  const int tid = cx.tid;
  char* ws = cx.ws;
  const bf16_t* XZ = (const bf16_t*)(ws + O_XZ);
  bf16_t* QK = (bf16_t*)(ws + O_QK); bf16_t* KT = (bf16_t*)(ws + O_KT); bf16_t* VT = (bf16_t*)(ws + O_VT); bf16_t* QF = (bf16_t*)(ws + O_QF);
  const int blk_l = tid & 63, tq = tid >> 6;
  for (int u = cx.bid; u < GB * NCH * 8; u += cx.nb) {
    const int slab = u & 7, ch = (u >> 3) % NCH, bl = u / (8 * NCH);
    const int f0 = slab * 256 + blk_l * 4, blk = f0 >> 2;
    float cw[3][4], cb[4], wq[16], wk[16], wv[16];
#pragma unroll
    for (int k = 0; k < 3; ++k)
#pragma unroll
      for (int c = 0; c < 4; ++c) cw[k][c] = IN(11)[(size_t)(j * 3 + k) * EI + f0 + c];
#pragma unroll
    for (int c = 0; c < 4; ++c) cb[c] = IN(12)[(size_t)j * EI + f0 + c];
#pragma unroll
    for (int i = 0; i < 16; ++i) {
      wq[i] = IN(13)[((size_t)(j * 3 + 0) * 512 + blk) * 16 + i];
      wk[i] = IN(13)[((size_t)(j * 3 + 1) * 512 + blk) * 16 + i] * 0.04419417382415922f;
      wv[i] = IN(13)[((size_t)(j * 3 + 2) * 512 + blk) * 16 + i];
    }
    const int tok0 = ch * 64, seg_lo = tok0 < LC ? 0 : LC, seg_hi = tok0 < LC ? LC : TOKB;
    const int tl0 = tq * 8;
    float xmp[4], xmc[4], xmn[4];
    {
      const int t2 = tok0 + tl0 - 1;
      if (t2 >= seg_lo) { const u32x2 r = *(const u32x2*)(XZ + (size_t)ml_lrow(bl, t2) * 4096 + f0); xmp[0] = bflo(r.x); xmp[1] = bfhi(r.x); xmp[2] = bflo(r.y); xmp[3] = bfhi(r.y); }
      else { xmp[0] = xmp[1] = xmp[2] = xmp[3] = 0.f; }
      const u32x2 r = *(const u32x2*)(XZ + (size_t)ml_lrow(bl, tok0 + tl0) * 4096 + f0); xmc[0] = bflo(r.x); xmc[1] = bfhi(r.x); xmc[2] = bflo(r.y); xmc[3] = bfhi(r.y);
    }
    unsigned kpk[4][4], vpk[4][4];
    float kprev[4], vprev[4];
    const int fp = (f0 & ~31) + 8 * ((f0 >> 2) & 3) + 4 * ((f0 >> 4) & 1);
#pragma unroll
    for (int tt = 0; tt < 8; ++tt) {
      const int tl = tl0 + tt, tok = tok0 + tl;
      if (tok + 1 < seg_hi) { const u32x2 r = *(const u32x2*)(XZ + (size_t)ml_lrow(bl, tok + 1) * 4096 + f0); xmn[0] = bflo(r.x); xmn[1] = bfhi(r.x); xmn[2] = bflo(r.y); xmn[3] = bfhi(r.y); }
      else { xmn[0] = xmn[1] = xmn[2] = xmn[3] = 0.f; }
      float xc[4], q[4], kk[4], vv[4];
#pragma unroll
      for (int c = 0; c < 4; ++c) xc[c] = silu_f(cw[0][c] * xmp[c] + cw[1][c] * xmc[c] + cw[2][c] * xmn[c] + cb[c]);
#pragma unroll
      for (int d2 = 0; d2 < 4; ++d2) {
        q[d2] = xc[0] * wq[d2] + xc[1] * wq[4 + d2] + xc[2] * wq[8 + d2] + xc[3] * wq[12 + d2];
        kk[d2] = xc[0] * wk[d2] + xc[1] * wk[4 + d2] + xc[2] * wk[8 + d2] + xc[3] * wk[12 + d2];
        vv[d2] = xmc[0] * wv[d2] + xmc[1] * wv[4 + d2] + xmc[2] * wv[8 + d2] + xmc[3] * wv[12 + d2];
      }
      const size_t lr = ml_lrow(bl, tok);
      u32x2 oq, ok; oq.x = pk2(q[0], q[1]); oq.y = pk2(q[2], q[3]); ok.x = pk2(kk[0], kk[1]); ok.y = pk2(kk[2], kk[3]);
      *(u32x2*)(QF + ((((((size_t)bl * NCH + ch) * 4 + (f0 >> 9)) * 8 + ((f0 >> 6) & 7)) * 4 + (tl >> 4)) * 2 + ((f0 >> 5) & 1)) * 512 + (tl & 15) * 32 + 8 * ((f0 >> 2) & 3) + 4 * ((f0 >> 4) & 1)) = oq;
      *(u32x2*)(QK + lr * 4096 + 2048 + fp) = ok;
      if (tt & 1) {
#pragma unroll
        for (int c = 0; c < 4; ++c) { kpk[c][tt >> 1] = pk2(kprev[c], kk[c]); vpk[c][tt >> 1] = pk2(vprev[c], vv[c]); }
      } else {
#pragma unroll
        for (int c = 0; c < 4; ++c) { kprev[c] = kk[c]; vprev[c] = vv[c]; }
      }
#pragma unroll
      for (int c = 0; c < 4; ++c) { xmp[c] = xmc[c]; xmc[c] = xmn[c]; }
    }
#pragma unroll
    for (int c = 0; c < 4; ++c) {
      const int feat = f0 + c;
      const size_t off = (((size_t)bl * NCH + ch) * (EI / 16) + (feat >> 4)) * 1024 + (tq >> 2) * 512 + (feat & 15) * 32 + (tq & 3) * 8;
      *(u32x4*)(KT + off) = (u32x4){kpk[c][0], kpk[c][1], kpk[c][2], kpk[c][3]};
      *(u32x4*)(VT + off) = (u32x4){vpk[c][0], vpk[c][1], vpk[c][2], vpk[c][3]};
    }
  }
}

__device__ __forceinline__ void ml_gates(const Params& p, const Ctx& cx, int j) {
  const int tid = cx.tid, lane = tid & 63, wave = tid >> 6, fr = lane & 15, fq = lane >> 4;
  char* ws = cx.ws;
  const bf16_t* XZ = (const bf16_t*)(ws + O_XZ); const bf16_t* QK = (const bf16_t*)(ws + O_QK); const bf16_t* QF = (const bf16_t*)(ws + O_QF);
  const bf16_t* WG = (const bf16_t*)(ws + O_WG) + (size_t)j * 16 * 6144;
  float* BL = (float*)(ws + O_BL); float* IG = (float*)(ws + O_IG);
  float* GC = (float*)(ws + O_GC); float* AC = GC + NSEQ * NCH;
  float* part = (float*)lds_raw;
  float* gl = part + 8 * 64 * 16;
  for (int u = cx.bid; u < GB * NCH; u += cx.nb) {
    const int bl = u / NCH, nc = u % NCH, tok0 = nc * 64;
    f32x4 acc[4];
#pragma unroll
    for (int m = 0; m < 4; ++m) acc[m] = (f32x4){0.f, 0.f, 0.f, 0.f};
    size_t lr[4];
#pragma unroll
    for (int m = 0; m < 4; ++m) lr[m] = ml_lrow(bl, tok0 + m * 16 + fr);
#pragma unroll 4
    for (int ks = wave * 24; ks < wave * 24 + 24; ++ks) {
      const int k = ks * 32 + fq * 8;
      const bf16x8 bfr = *(const bf16x8*)(WG + (size_t)fr * 6144 + k);
#pragma unroll
      for (int m = 0; m < 4; ++m) {
        const bf16_t* ap = k < 2048 ? QF + ((((((size_t)bl * NCH + nc) * 4 + (k >> 9)) * 8 + ((k >> 6) & 7)) * 4 + m) * 2 + ((k >> 5) & 1)) * 512 + fr * 32 + 8 * fq
                         : k < 4096 ? QK + lr[m] * 4096 + k : XZ + lr[m] * 4096 + (k - 4096);
        const bf16x8 afr = *(const bf16x8*)ap;
        acc[m] = MFMA16(afr, bfr, acc[m]);
      }
    }
#pragma unroll
    for (int m = 0; m < 4; ++m)
#pragma unroll
      for (int jj = 0; jj < 4; ++jj) part[(wave * 64 + m * 16 + 4 * fq + jj) * 16 + fr] = acc[m][jj];
    __syncthreads();
    for (int i = tid; i < 1024; i += 512) {
      float s = IN(15)[(size_t)j * 16 + (i & 15)];
#pragma unroll
      for (int w = 0; w < 8; ++w) s += part[w * 1024 + i];
      gl[(i >> 4) * 17 + (i & 15)] = s;
    }
    __syncthreads();
    {
      const int x = wave >> 2, h = wave & 3, seq = (bl * 2 + x) * 4 + h;
      const int tl = x == 0 ? lane : 63 - lane;
      const float ig = gl[tl * 17 + x * 8 + h], fg = gl[tl * 17 + x * 8 + 4 + h];
      float b = fg > 0.f ? -__logf(1.f + __expf(-fg)) : fg - __logf(1.f + __expf(fg));
#pragma unroll
      for (int o = 1; o < 64; o <<= 1) { const float t2 = shi(b, lane - o); if (lane >= o) b += t2; }
      BL[(size_t)seq * TOKB + tok0 + tl] = b; IG[(size_t)seq * TOKB + tok0 + tl] = ig;
      float mx = ig - b;
#pragma unroll
      for (int o = 1; o < 64; o <<= 1) mx = fmaxf(mx, shx(mx, o, lane));
      const float g = shi(b, 63);
      if (lane == 0) { GC[seq * NCH + nc] = g; AC[seq * NCH + nc] = g + mx; }
    }
    __syncthreads();
  }
}

__device__ __forceinline__ void ml_s(const Params& p, const Ctx& cx) {
  const int tid = cx.tid, lane = tid & 63, wave = tid >> 6, fr = lane & 15, fq = lane >> 4;
  char* ws = cx.ws;
  const bf16_t* QK = (const bf16_t*)(ws + O_QK);
  bf16_t* SP = (bf16_t*)(ws + O_SP);
  const float* BL = (const float*)(ws + O_BL); const float* IG = (const float*)(ws + O_IG);
  float* WIN = (float*)(ws + O_WIN); float* FLO = (float*)(ws + O_FLO); float* DEN = (float*)(ws + O_DEN); float* WSS = (float*)(ws + O_WSS);
  const float* GC = (const float*)(ws + O_GC); const float* AC = GC + NSEQ * NCH; float* DEC = (float*)(ws + O_GC) + 2 * NSEQ * NCH;
  float* sb_ = (float*)lds_raw + wave * 256; float* si_ = sb_ + 64; float* smt = si_ + 64;
  const int gw = cx.bid * 8 + wave, NGW = cx.nb * 8;
  for (int u = gw; u < NSEQ * NCH; u += NGW) {
    const int seq = u / NCH, st = u % NCH, x = (seq >> 2) & 1, h = seq & 3, bl = seq >> 3;
    const int nc = ml_nchunk(x, st), tok0 = nc * 64;
    const int nl0 = ml_nchunk(x, lane), nl1 = ml_nchunk(x, 64 + (lane & 3));
    const float g0 = GC[seq * NCH + nl0], a0 = AC[seq * NCH + nl0], g1 = GC[seq * NCH + nl1], a1 = AC[seq * NCH + nl1];
    const int tl = x == 0 ? lane : 63 - lane;
    const float b = BL[(size_t)seq * TOKB + tok0 + tl], ig = IG[(size_t)seq * TOKB + tok0 + tl];
    float mc = 0.f;
    for (int s2 = 0; s2 < st; ++s2) {
      const float gg = __int_as_float(__builtin_amdgcn_readlane(__float_as_int(s2 < 64 ? g0 : g1), s2 & 63));
      const float aa = __int_as_float(__builtin_amdgcn_readlane(__float_as_int(s2 < 64 ? a0 : a1), s2 & 63));
      mc = fmaxf(gg + mc, aa);
    }
    const float gc = __int_as_float(__builtin_amdgcn_readlane(__float_as_int(st < 64 ? g0 : g1), st & 63));
    const float ac = __int_as_float(__builtin_amdgcn_readlane(__float_as_int(st < 64 ? a0 : a1), st & 63));
    const float mnew = fmaxf(gc + mc, ac);
    float cm = ig - b;
#pragma unroll
    for (int o = 1; o < 64; o <<= 1) { const float t2 = shi(cm, lane - o); if (lane >= o) cm = fmaxf(cm, t2); }
    const float mt = b + fmaxf(mc, cm);
    sb_[tl] = b; si_[tl] = ig; smt[tl] = mt;
    WIN[(size_t)seq * TOKB + tok0 + tl] = __expf(b + mc - mt);
    FLO[(size_t)seq * TOKB + tok0 + tl] = __expf(-mt);
    WSS[(size_t)seq * TOKB + tok0 + tl] = __expf(gc - b + ig - mnew);
    if (lane == 0) DEC[seq * NCH + nc] = __expf(gc + mc - mnew);
    f32x4 acc[4][4];
#pragma unroll
    for (int a = 0; a < 4; ++a)
#pragma unroll
      for (int c2 = 0; c2 < 4; ++c2) acc[a][c2] = (f32x4){0.f, 0.f, 0.f, 0.f};
    const bf16_t* rowp[4];
#pragma unroll
    for (int a = 0; a < 4; ++a) rowp[a] = QK + (size_t)ml_lrow(bl, tok0 + a * 16 + fr) * 4096 + h * DH + fq * 8;
    const bf16_t* qfb = (const bf16_t*)(ws + O_QF) + ((((size_t)bl * NCH + nc) * 4 + h) * 8) * 4 * 2 * 512 + fr * 32 + 8 * fq;
#pragma unroll 2
    for (int ks = 0; ks < 16; ++ks) {
      bf16x8 kf[4], qf[4];
#pragma unroll
      for (int a = 0; a < 4; ++a) { kf[a] = *(const bf16x8*)(rowp[a] + 2048 + ks * 32); qf[a] = *(const bf16x8*)(qfb + (((size_t)(ks >> 1) * 4 + a) * 2 + (ks & 1)) * 512); }
#pragma unroll
      for (int a = 0; a < 4; ++a)
#pragma unroll
        for (int c2 = 0; c2 < 4; ++c2) acc[a][c2] = MFMA16(kf[a], qf[c2], acc[a][c2]);
    }
    __builtin_amdgcn_wave_barrier(); asm volatile("s_waitcnt lgkmcnt(0)" ::: "memory");
    bf16_t* spu = SP + (size_t)(seq * NCH + nc) * 4096;
#pragma unroll
    for (int tb = 0; tb < 4; ++tb) {
      const int t = tb * 16 + fr;
      const float bt = sb_[t], mtt = smt[t];
      float dsum = 0.f;
#pragma unroll
      for (int sbk = 0; sbk < 4; ++sbk) {
        float vals[4];
#pragma unroll
        for (int jj = 0; jj < 4; ++jj) {
          const int s = sbk * 16 + 4 * fq + jj;
          const bool ok = x == 0 ? (s <= t) : (s >= t);
          vals[jj] = ok ? acc[sbk][tb][jj] * __expf(bt - sb_[s] + si_[s] - mtt) : 0.f;
        }
        u32x2 o; o.x = pk2(vals[0], vals[1]); o.y = pk2(vals[2], vals[3]);
        *(u32x2*)(spu + tb * 1024 + ((sbk * 16 + 4 * fq) >> 5) * 512 + fr * 32 + ((sbk * 16 + 4 * fq) & 31)) = o;
        dsum += (bflo(o.x) + bfhi(o.x)) + (bflo(o.y) + bfhi(o.y));
      }
      dsum += shx(dsum, 16, lane); dsum += shx(dsum, 32, lane);
      if (fq == 0) DEN[(size_t)seq * TOKB + tok0 + t] = dsum;
    }
    __builtin_amdgcn_wave_barrier(); asm volatile("s_waitcnt lgkmcnt(0)" ::: "memory");
  }
}

constexpr int NEB = 2, NSL = 512 / (16 * NEB);
__device__ __forceinline__ void ml_m2(const Params& p, const Ctx& cx) {
  const int tid = cx.tid, lane = tid & 63, wave = tid >> 6, fr = lane & 15, fq = lane >> 4;
  char* ws = cx.ws;
  const bf16_t* QK = (const bf16_t*)(ws + O_QK); const bf16_t* KT = (const bf16_t*)(ws + O_KT); const bf16_t* VT = (const bf16_t*)(ws + O_VT);
  const bf16_t* SP = (const bf16_t*)(ws + O_SP); const bf16_t* QF = (const bf16_t*)(ws + O_QF);
  bf16_t* HD = (bf16_t*)(ws + O_HD);
  const float* WIN = (const float*)(ws + O_WIN); const float* FLO = (const float*)(ws + O_FLO); const float* DEN = (const float*)(ws + O_DEN); const float* WSS = (const float*)(ws + O_WSS);
  const float* DEC = (const float*)(ws + O_GC) + 2 * NSEQ * NCH;
  f32x4* red = (f32x4*)lds_raw;
  f32x4* rn = (f32x4*)(lds_raw + 131072);
  for (int idx = cx.bid >> 3; idx < 2 * NSL; idx += cx.nb >> 3) {
    const int seq = (cx.bid & 7) * 2 + idx / NSL, es = idx % NSL, x = (seq >> 2) & 1, h = seq & 3, bl = seq >> 3;
    const int d0 = wave * 64, e0 = es * 16 * NEB;
    f32x4 C[4][NEB + 1];
#pragma unroll
    for (int a = 0; a < 4; ++a)
#pragma unroll
      for (int b = 0; b < NEB + 1; ++b) C[a][b] = (f32x4){0.f, 0.f, 0.f, 0.f};
    const int tbo = wave >> 1, ebo = __builtin_amdgcn_readfirstlane(wave & 1);
    bf16x8 qc[4][2], kf[4][2], sf0, sf1;
    u32x4 vr[NEB][2];
    f32x4 wv[2][2];
#define M2_LOAD_Q(ST) do { const int _nq = ml_nchunk(x, (ST)); _Pragma("unroll") for (int tb = 0; tb < 4; ++tb) { \
        const bf16_t* qp = QF + ((((((size_t)bl * NCH + _nq) * 4 + h) * 8 + wave) * 4 + tb) * 2) * 512 + fr * 32 + 8 * fq; \
        qc[tb][0] = *(const bf16x8*)qp; qc[tb][1] = *(const bf16x8*)(qp + 512); } } while (0)
#define M2_LOAD_KV(ST) do { const int _nc = ml_nchunk(x, (ST)), _t0 = _nc * 64; \
        _Pragma("unroll") for (int db = 0; db < 4; ++db) { const bf16_t* kp = KT + (((size_t)bl * NCH + _nc) * (EI / 16) + ((h * DH + d0) >> 4) + db) * 1024 + fr * 32 + 8 * fq; \
          kf[db][0] = *(const bf16x8*)kp; kf[db][1] = *(const bf16x8*)(kp + 512); } \
        _Pragma("unroll") for (int eb = 0; eb < NEB; ++eb) { const bf16_t* vp = VT + (((size_t)bl * NCH + _nc) * (EI / 16) + ((h * DH + e0) >> 4) + eb) * 1024 + fr * 32 + 8 * fq; \
          vr[eb][0] = *(const u32x4*)vp; vr[eb][1] = *(const u32x4*)(vp + 512); } \
        _Pragma("unroll") for (int ks = 0; ks < 2; ++ks) { const float* wp = WSS + (size_t)seq * TOKB + _t0 + 32 * ks + 8 * fq; \
          wv[ks][0] = *(const f32x4*)wp; wv[ks][1] = *(const f32x4*)(wp + 4); } \
        const bf16_t* sp = SP + (size_t)(seq * NCH + _nc) * 4096 + tbo * 1024 + fr * 32 + 8 * fq; \
        sf0 = *(const bf16x8*)sp; sf1 = *(const bf16x8*)(sp + 512); } while (0)
    M2_LOAD_Q(0); M2_LOAD_KV(0);
    for (int st = 0; st < NCH; ++st) {
      const int nc = ml_nchunk(x, st), tok0 = nc * 64, stn = st + 1 < NCH ? st + 1 : st;
      const size_t tix = (size_t)seq * TOKB + tok0 + tbo * 16 + 4 * fq;
      const f32x4 win = *(const f32x4*)(WIN + tix), flo = *(const f32x4*)(FLO + tix), deni = *(const f32x4*)(DEN + tix);
      const float decay = DEC[seq * NCH + nc];
#pragma unroll
      for (int eb = 0; eb < NEB + 1; ++eb) {
        bf16x8 cb0, cb1;
        { const f32x4 lo = C[0][eb], hi = C[1][eb]; cb0 = mk8((u32x4){pk2(lo[0], lo[1]), pk2(lo[2], lo[3]), pk2(hi[0], hi[1]), pk2(hi[2], hi[3])}); }
        { const f32x4 lo = C[2][eb], hi = C[3][eb]; cb1 = mk8((u32x4){pk2(lo[0], lo[1]), pk2(lo[2], lo[3]), pk2(hi[0], hi[1]), pk2(hi[2], hi[3])}); }
        f32x4 pa[4];
#pragma unroll
        for (int tb = 0; tb < 4; ++tb) pa[tb] = MFMA16(qc[tb][0], cb0, ((f32x4){0.f, 0.f, 0.f, 0.f}));
#pragma unroll
        for (int tb = 0; tb < 4; ++tb) pa[tb] = MFMA16(qc[tb][1], cb1, pa[tb]);
#pragma unroll
        for (int tb = 0; tb < 4; ++tb) {
          if (eb < NEB) red[((wave * 4 + tb) * NEB + eb) * 64 + lane] = pa[tb];
          else if (fr == 0) rn[(wave * 4 + tb) * 4 + fq] = pa[tb];
        }
      }
      M2_LOAD_Q(stn);
      f32x4 oi = {0.f, 0.f, 0.f, 0.f};
#pragma unroll
      for (int eb = 0; eb < NEB + 1; ++eb) {
        bf16x8 vw0, vw1;
        if (eb < NEB) {
          const u32x4 r0 = vr[eb][0], r1 = vr[eb][1];
          if (eb == ebo) { oi = MFMA16(sf0, mk8(r0), oi); oi = MFMA16(sf1, mk8(r1), oi); }
          vw0 = mk8((u32x4){pk2(bflo(r0.x) * wv[0][0][0], bfhi(r0.x) * wv[0][0][1]), pk2(bflo(r0.y) * wv[0][0][2], bfhi(r0.y) * wv[0][0][3]),
                            pk2(bflo(r0.z) * wv[0][1][0], bfhi(r0.z) * wv[0][1][1]), pk2(bflo(r0.w) * wv[0][1][2], bfhi(r0.w) * wv[0][1][3])});
          vw1 = mk8((u32x4){pk2(bflo(r1.x) * wv[1][0][0], bfhi(r1.x) * wv[1][0][1]), pk2(bflo(r1.y) * wv[1][0][2], bfhi(r1.y) * wv[1][0][3]),
                            pk2(bflo(r1.z) * wv[1][1][0], bfhi(r1.z) * wv[1][1][1]), pk2(bflo(r1.w) * wv[1][1][2], bfhi(r1.w) * wv[1][1][3])});
        } else {
          vw0 = mk8((u32x4){pk2(wv[0][0][0], wv[0][0][1]), pk2(wv[0][0][2], wv[0][0][3]), pk2(wv[0][1][0], wv[0][1][1]), pk2(wv[0][1][2], wv[0][1][3])});
          vw1 = mk8((u32x4){pk2(wv[1][0][0], wv[1][0][1]), pk2(wv[1][0][2], wv[1][0][3]), pk2(wv[1][1][0], wv[1][1][1]), pk2(wv[1][1][2], wv[1][1][3])});
        }
#pragma unroll
        for (int db = 0; db < 4; ++db) {
          f32x4 c = C[db][eb] * decay;
          c = MFMA16(kf[db][0], vw0, c); c = MFMA16(kf[db][1], vw1, c);
          C[db][eb] = c;
        }
      }
      asm volatile("s_waitcnt lgkmcnt(0)" ::: "memory");
      __builtin_amdgcn_s_barrier();
      asm volatile("" ::: "memory");
      f32x4 rdn[8], rd0[8];
#pragma unroll
      for (int w = 0; w < 8; ++w) { rdn[w] = rn[(w * 4 + tbo) * 4 + fq]; rd0[w] = red[((w * 4 + tbo) * NEB + ebo) * 64 + lane]; }
      const f32x4 pn = ((rdn[0] + rdn[1]) + (rdn[2] + rdn[3])) + ((rdn[4] + rdn[5]) + (rdn[6] + rdn[7]));
      const f32x4 pi = ((rd0[0] + rd0[1]) + (rd0[2] + rd0[3])) + ((rd0[4] + rd0[5]) + (rd0[6] + rd0[7]));
#pragma unroll
      for (int jj = 0; jj < 4; ++jj) {
        const float num = oi[jj] + win[jj] * pi[jj], den = deni[jj] + win[jj] * pn[jj];
        const float hv = num * __builtin_amdgcn_rcpf(fmaxf(fabsf(den), flo[jj]));
        HD[((size_t)x * RG + ml_lrow(bl, tok0 + tbo * 16 + 4 * fq + jj)) * EI + h * DH + e0 + ebo * 16 + fr] = (bf16_t)(pk2(hv, 0.f) & 0xffff);
      }
      M2_LOAD_KV(stn);
      asm volatile("s_waitcnt lgkmcnt(0)" ::: "memory");
      __builtin_amdgcn_s_barrier();
      asm volatile("" ::: "memory");
    }
    __syncthreads();
#undef M2_LOAD_Q
#undef M2_LOAD_KV
  }
}

__device__ __forceinline__ void ml_fin(const Params& p, const Ctx& cx, int j) {
  const int lane = cx.tid & 63, gw = cx.bid * 8 + (cx.tid >> 6), NGW = cx.nb * 8;
  char* ws = cx.ws;
  const bf16_t* XZ = (const bf16_t*)(ws + O_XZ); const bf16_t* HD = (const bf16_t*)(ws + O_HD);
  bf16_t* FIN = (bf16_t*)(ws + O_FIN);
  for (int u = gw; u < RG * 4; u += NGW) {
    const int lr = u >> 2, h = u & 3, f0 = h * DH + lane * 8;
    int pos, seglen;
    if (lr < GB * SEQ) { pos = lr & (SEQ - 1); seglen = SEQ; } else { pos = (lr - GB * SEQ) & (LC - 1); seglen = LC; }
    const u32x4 hf = *(const u32x4*)(HD + (size_t)lr * EI + f0), hb = *(const u32x4*)(HD + ((size_t)RG + lr) * EI + f0);
    const u32x4 zz = *(const u32x4*)(XZ + (size_t)lr * 4096 + 2048 + f0);
    const u32x4 x1 = *(const u32x4*)(XZ + (size_t)lr * 4096 + f0);
    u32x4 x0 = {0u, 0u, 0u, 0u}, x2 = {0u, 0u, 0u, 0u};
    if (pos > 0) x0 = *(const u32x4*)(XZ + (size_t)(lr - 1) * 4096 + f0);
    if (pos < seglen - 1) x2 = *(const u32x4*)(XZ + (size_t)(lr + 1) * 4096 + f0);
    float hv[8], xm0[8], xm1[8], xm2[8];
    const unsigned hfu[4] = {hf.x, hf.y, hf.z, hf.w}, hbu[4] = {hb.x, hb.y, hb.z, hb.w}, zu[4] = {zz.x, zz.y, zz.z, zz.w};
    const unsigned x0u[4] = {x0.x, x0.y, x0.z, x0.w}, x1u[4] = {x1.x, x1.y, x1.z, x1.w}, x2u[4] = {x2.x, x2.y, x2.z, x2.w};
    float s = 0.f;
#pragma unroll
    for (int i = 0; i < 4; ++i) {
      hv[2 * i] = (bflo(hfu[i]) + bflo(hbu[i])) * sigm_f(bflo(zu[i]));
      hv[2 * i + 1] = (bfhi(hfu[i]) + bfhi(hbu[i])) * sigm_f(bfhi(zu[i]));
      xm0[2 * i] = bflo(x0u[i]); xm0[2 * i + 1] = bfhi(x0u[i]); xm1[2 * i] = bflo(x1u[i]); xm1[2 * i + 1] = bfhi(x1u[i]); xm2[2 * i] = bflo(x2u[i]); xm2[2 * i + 1] = bfhi(x2u[i]);
      s += hv[2 * i] + hv[2 * i + 1];
    }
    const float mean = wave_sum(s, lane) * (1.f / DH); float s2 = 0.f;
#pragma unroll
    for (int i = 0; i < 8; ++i) { hv[i] -= mean; s2 += hv[i] * hv[i]; }
    const float rstd = __builtin_amdgcn_rsqf(wave_sum(s2, lane) * (1.f / DH) + LN_EPS);
    float o[8];
#pragma unroll
    for (int i = 0; i < 8; ++i) {
      const int f = f0 + i;
      const float xc = silu_f(IN(11)[(size_t)(j * 3 + 0) * EI + f] * xm0[i] + IN(11)[(size_t)(j * 3 + 1) * EI + f] * xm1[i] + IN(11)[(size_t)(j * 3 + 2) * EI + f] * xm2[i] + IN(12)[(size_t)j * EI + f]);
      o[i] = hv[i] * rstd * IN(17)[(size_t)j * EI + f] + IN(16)[(size_t)j * EI + f] * xc;
    }
    u32x4 ov; ov.x = pk2(o[0], o[1]); ov.y = pk2(o[2], o[3]); ov.z = pk2(o[4], o[5]); ov.w = pk2(o[6], o[7]);
    *(u32x4*)(FIN + nat(lr, f0, EI)) = ov;
  }
}

__device__ __forceinline__ void at_prep(const Params& p, const Ctx& cx) {
  const int lane = cx.tid & 63, gw = cx.bid * 8 + (cx.tid >> 6), NGW = cx.nb * 8;
  char* ws = cx.ws;
  bf16_t* ACT = (bf16_t*)(ws + O_ACT); bf16_t* KR = (bf16_t*)(ws + O_AKR); bf16_t* VT = (bf16_t*)(ws + O_AVT);
  const float* rc = (const float*)(ws + O_ROPE); const float* rs = rc + 4096 * 32;
  for (int row = gw; row < MROWS; row += NGW) {
    const bool lat = row < NLAT;
    const int b = lat ? row >> 12 : (row - NLAT) >> 8, pos = lat ? row & 4095 : (row - NLAT) & 255, tok = lat ? LC + pos : pos;
    bf16_t* rp = ACT + (size_t)row * 1536;
    {
      const u32x4 a = *(const u32x4*)(rp + 16 * lane), b2 = *(const u32x4*)(rp + 16 * lane + 8);
      const unsigned w[8] = {a.x, a.y, a.z, a.w, b2.x, b2.y, b2.z, b2.w};
      unsigned o[8];
      const int pp0 = (lane & 3) * 8;
#pragma unroll
      for (int i = 0; i < 8; ++i) {
        float x1 = bflo(w[i]) * 0.125f, x2 = bfhi(w[i]) * 0.125f;
        if (lat) { const float c = rc[pos * 32 + pp0 + i], s = rs[pos * 32 + pp0 + i]; const float y1 = x1 * c - x2 * s, y2 = x1 * s + x2 * c; x1 = y1; x2 = y2; }
        o[i] = pk2(x1, x2);
      }
      *(u32x4*)(rp + 16 * lane) = (u32x4){o[0], o[1], o[2], o[3]}; *(u32x4*)(rp + 16 * lane + 8) = (u32x4){o[4], o[5], o[6], o[7]};
    }
    {
      const u32x2 a = *(const u32x2*)(rp + 1024 + 4 * lane);
      const unsigned w[2] = {a.x, a.y}; unsigned o[2];
      const int g = lane >> 4, dd = (lane & 15) * 4, pp0 = dd >> 1;
#pragma unroll
      for (int i = 0; i < 2; ++i) {
        float x1 = bflo(w[i]), x2 = bfhi(w[i]);
        if (lat) { const float c = rc[pos * 32 + pp0 + i], s = rs[pos * 32 + pp0 + i]; const float y1 = x1 * c - x2 * s, y2 = x1 * s + x2 * c; x1 = y1; x2 = y2; }
        o[i] = pk2(x1, x2);
      }
      *(u32x2*)(KR + (((size_t)b * 4 + g) * TOKB + tok) * 64 + dd) = (u32x2){o[0], o[1]};
      const u32x2 v = *(const u32x2*)(rp + 1280 + 4 * lane);
      bf16_t* vp = VT + (((size_t)b * 4 + g) * 64 + dd) * TOKB + tok;
      vp[0] = (bf16_t)(v.x & 0xffff); vp[TOKB] = (bf16_t)(v.x >> 16); vp[2 * TOKB] = (bf16_t)(v.y & 0xffff); vp[3 * TOKB] = (bf16_t)(v.y >> 16);
    }
  }
}

__device__ __forceinline__ void at_core(const Params& p, const Ctx& cx) {
  const int lane = cx.tid & 63, gw = cx.bid * 8 + (cx.tid >> 6), NGW = cx.nb * 8, fr = lane & 15, fq = lane >> 4;
  char* ws = cx.ws;
  const bf16_t* ACT = (const bf16_t*)(ws + O_ACT); const bf16_t* KR = (const bf16_t*)(ws + O_AKR); const bf16_t* VT = (const bf16_t*)(ws + O_AVT);
  bf16_t* O = (bf16_t*)(ws + O_U);
  for (int u = gw; u < (MROWS / 16) * 4; u += NGW) {
    const int g = u & 3, qb = u >> 2, row0 = qb * 16;
    const bool lat = row0 < NLAT;
    const int b = lat ? row0 >> 12 : (row0 - NLAT) >> 8, q0 = lat ? row0 & 4095 : 0;
    bf16x8 qf[4][2];
    float mrun[4], lrun[4], sink[4];
    f32x4 oacc[4][4];
#pragma unroll
    for (int hh = 0; hh < 4; ++hh) {
      const bf16_t* qp = ACT + (size_t)(row0 + fr) * 1536 + (g * 4 + hh) * 64 + 8 * fq;
      qf[hh][0] = *(const bf16x8*)qp; qf[hh][1] = *(const bf16x8*)(qp + 32);
      sink[hh] = IN(20)[g * 4 + hh]; mrun[hh] = sink[hh]; lrun[hh] = 0.f;
#pragma unroll
      for (int d2 = 0; d2 < 4; ++d2) oacc[hh][d2] = (f32x4){0.f, 0.f, 0.f, 0.f};
    }
    const bf16_t* kbase = KR + ((size_t)b * 4 + g) * TOKB * 64;
    const bf16_t* vbase = VT + ((size_t)b * 4 + g) * 64 * TOKB;
    int wlo = 0, whi = -1;
    if (lat) { wlo = max(0, q0 - 128) & ~31; whi = min(SEQ - 1, q0 + 143); }
    const int nwin = lat ? (whi - wlo) / 32 + 1 : 0;
    for (int ti = 0; ti < 8 + nwin; ++ti) {
      const bool isw = ti >= 8;
      const int kpos0 = isw ? wlo + (ti - 8) * 32 : 0;
      const int tk0 = isw ? LC + kpos0 : ti * 32;
      const bf16_t* kp = kbase + (size_t)(tk0 + fr) * 64 + 8 * fq;
      const bf16x8 k00 = *(const bf16x8*)kp, k01 = *(const bf16x8*)(kp + 32), k10 = *(const bf16x8*)(kp + 16 * 64), k11 = *(const bf16x8*)(kp + 16 * 64 + 32);
      bf16x8 vfr[4];
#pragma unroll
      for (int d2 = 0; d2 < 4; ++d2) {
        const bf16_t* vp = vbase + (size_t)(d2 * 16 + fr) * TOKB + tk0 + 4 * fq;
        vfr[d2] = mk8(*(const u32x2*)vp, *(const u32x2*)(vp + 16));
      }
      bool okm[8];
#pragma unroll
      for (int i = 0; i < 8; ++i) {
        const int kpos = kpos0 + (i >> 2) * 16 + 4 * fq + (i & 3), dlt = (q0 + fr) - kpos;
        okm[i] = !isw || (dlt <= 128 && dlt >= -128);
      }
#pragma unroll
      for (int hh = 0; hh < 4; ++hh) {
        f32x4 s0 = {0.f, 0.f, 0.f, 0.f}, s1 = {0.f, 0.f, 0.f, 0.f};
        s0 = MFMA16(k00, qf[hh][0], s0); s0 = MFMA16(k01, qf[hh][1], s0);
        s1 = MFMA16(k10, qf[hh][0], s1); s1 = MFMA16(k11, qf[hh][1], s1);
        float sv[8]; float tmax = -3.0e38f;
#pragma unroll
        for (int i = 0; i < 8; ++i) { sv[i] = okm[i] ? (i < 4 ? s0[i] : s1[i - 4]) : -3.0e38f; tmax = fmaxf(tmax, sv[i]); }
        tmax = fmaxf(tmax, shx(tmax, 16, lane)); tmax = fmaxf(tmax, shx(tmax, 32, lane));
        const float mnew = fmaxf(mrun[hh], tmax), scale = __expf(mrun[hh] - mnew);
        mrun[hh] = mnew;
        float pv[8];
#pragma unroll
        for (int i = 0; i < 8; ++i) pv[i] = okm[i] ? __expf(sv[i] - mnew) : 0.f;
        const u32x4 pu = {pk2(pv[0], pv[1]), pk2(pv[2], pv[3]), pk2(pv[4], pv[5]), pk2(pv[6], pv[7])};
        const float ps = ((bflo(pu.x) + bfhi(pu.x)) + (bflo(pu.y) + bfhi(pu.y))) + ((bflo(pu.z) + bfhi(pu.z)) + (bflo(pu.w) + bfhi(pu.w)));
        lrun[hh] = lrun[hh] * scale + ps;
        const bf16x8 pf = mk8(pu);
        float scq[4];
#pragma unroll
        for (int jj = 0; jj < 4; ++jj) scq[jj] = shi(scale, 4 * fq + jj);
#pragma unroll
        for (int d2 = 0; d2 < 4; ++d2) {
          f32x4 o = oacc[hh][d2];
          o[0] *= scq[0]; o[1] *= scq[1]; o[2] *= scq[2]; o[3] *= scq[3];
          oacc[hh][d2] = MFMA16(pf, vfr[d2], o);
        }
      }
    }
#pragma unroll
    for (int hh = 0; hh < 4; ++hh) {
      float l = lrun[hh];
      l += shx(l, 16, lane); l += shx(l, 32, lane);
      l += __expf(sink[hh] - mrun[hh]);
      const float inv = __builtin_amdgcn_rcpf(l);
      float iq[4];
#pragma unroll
      for (int jj = 0; jj < 4; ++jj) iq[jj] = shi(inv, 4 * fq + jj);
#pragma unroll
      for (int d2 = 0; d2 < 4; ++d2)
#pragma unroll
        for (int jj = 0; jj < 4; ++jj)
          O[nat(row0 + 4 * fq + jj, (g * 4 + hh) * 64 + d2 * 16 + fr, D)] = (bf16_t)(pk2(oacc[hh][d2][jj] * iq[jj], 0.f) & 0xffff);
    }
  }
}

__device__ __forceinline__ void sc_conv(const Params& p, const Ctx& cx) {
  const int gt = cx.bid * 512 + cx.tid, gs = cx.nb * 512;
  const bf16_t* ACT = (const bf16_t*)(cx.ws + O_ACT); bf16_t* O = (bf16_t*)(cx.ws + O_U);
  const float* cw = IN(23);
  for (int i = gt; i < MROWS * 128; i += gs) {
    const int row = i >> 7, c0 = (i & 127) * 8;
    int pos, seglen;
    if (row < NLAT) { pos = row & (SEQ - 1); seglen = SEQ; } else { pos = (row - NLAT) & (LC - 1); seglen = LC; }
    float accv[8];
#pragma unroll
    for (int e = 0; e < 8; ++e) accv[e] = 0.f;
#pragma unroll
    for (int k = 0; k < 3; ++k) {
      const int pp = pos + k - 1;
      if (pp < 0 || pp >= seglen) continue;
      const bf16_t* rp = ACT + (size_t)(row + k - 1) * 3072;
      const u32x4 cgv = *(const u32x4*)(rp + 1024 + c0), xtv = *(const u32x4*)(rp + 2048 + c0);
      const unsigned cu[4] = {cgv.x, cgv.y, cgv.z, cgv.w}, xu[4] = {xtv.x, xtv.y, xtv.z, xtv.w};
#pragma unroll
      for (int e = 0; e < 4; ++e) {
        accv[2 * e] += cw[k * D + c0 + 2 * e] * (bflo(cu[e]) * bflo(xu[e]));
        accv[2 * e + 1] += cw[k * D + c0 + 2 * e + 1] * (bfhi(cu[e]) * bfhi(xu[e]));
      }
    }
    const u32x4 bgv = *(const u32x4*)(ACT + (size_t)row * 3072 + c0);
    const unsigned bu[4] = {bgv.x, bgv.y, bgv.z, bgv.w};
    u32x4 o;
    o.x = pk2(bflo(bu[0]) * accv[0], bfhi(bu[0]) * accv[1]); o.y = pk2(bflo(bu[1]) * accv[2], bfhi(bu[1]) * accv[3]);
    o.z = pk2(bflo(bu[2]) * accv[4], bfhi(bu[2]) * accv[5]); o.w = pk2(bflo(bu[3]) * accv[6], bfhi(bu[3]) * accv[7]);
    *(u32x4*)(O + nat(row, c0, D)) = o;
  }
}

#define XB_TMO      128
#define XB_XCNT(j)  (256  + 64 * (j))
#define XB_XSUB(j)  (1280 + 64 * (j))
#define XB_XGEN(j)  (2304 + 64 * (j))
#define XB_TOP      3328
#define XB_TOPGEN   3392
#define XCD_BAR_WORDS 3456
#define XB_SPIN_CAP (1u << 18)
__device__ __forceinline__ unsigned xb_ld(unsigned* p)              { return __hip_atomic_load(p, __ATOMIC_RELAXED, __HIP_MEMORY_SCOPE_AGENT); }
__device__ __forceinline__ unsigned xb_add(unsigned* p, unsigned v) { return __hip_atomic_fetch_add(p, v, __ATOMIC_RELAXED, __HIP_MEMORY_SCOPE_AGENT); }
__device__ __forceinline__ unsigned xb_xcc_id() { return (unsigned)__builtin_amdgcn_s_getreg((3 << 11) | 20) & 0xFu; }
#define XB_SPIN(cond, bar) do { unsigned _sp = 0; while (cond) { __builtin_amdgcn_s_sleep(1); \
    if ((++_sp & 255u) == 0u) { if (xb_ld(&(bar)[XB_TMO])) break; if (_sp > XB_SPIN_CAP) { atomicAdd(&(bar)[XB_TMO], 1u); break; } } } } while (0)
__device__ __forceinline__ void xcd_barrier_complete(unsigned* bar, unsigned x, unsigned& nloc, unsigned& nx) {
  const unsigned G = gridDim.x;
  unsigned sum, cnt, mine, sp = 0u;
  for (;;) {
    sum = 0u; cnt = 0u; mine = 0u;
#pragma unroll
    for (unsigned j = 0; j < 16; ++j) { const unsigned c = xb_ld(&bar[XB_XCNT(j)]); sum += c; cnt += (c > 0u) ? 1u : 0u; mine = (j == x) ? c : mine; }
    if (sum == G) break;
    __builtin_amdgcn_s_sleep(1);
    if ((++sp & 255u) == 0u) { if (xb_ld(&bar[XB_TMO])) break; if (sp > XB_SPIN_CAP) { atomicAdd(&bar[XB_TMO], 1u); break; } }
  }
  nloc = mine > 0u ? mine : 1u; nx = cnt > 0u ? cnt : 1u;
}
__device__ __forceinline__ void xcd_barrier(unsigned* bar, unsigned x, volatile LAS unsigned* st) {
  asm volatile("s_waitcnt vmcnt(0)" ::: "memory");
  __syncthreads();
  if (threadIdx.x == 0) {
    __builtin_amdgcn_s_waitcnt(0);
    unsigned nloc = st[0], nx = st[1];
    if (nloc == 0u) { xcd_barrier_complete(bar, x, nloc, nx); st[0] = nloc; st[1] = nx; }
    const unsigned old = xb_add(&bar[XB_XSUB(x)], 1u);
    const unsigned gen = old / nloc;
    if (old + 1u == (gen + 1u) * nloc) {
      __builtin_amdgcn_fence(__ATOMIC_RELEASE, "agent");
      asm volatile("s_waitcnt vmcnt(0)" ::: "memory");
      const unsigned og = xb_add(&bar[XB_TOP], 1u);
      const unsigned tg = og / nx;
      if (og + 1u == (tg + 1u) * nx) xb_add(&bar[XB_TOPGEN], 1u);
      else XB_SPIN(xb_ld(&bar[XB_TOPGEN]) == tg, bar);
      __builtin_amdgcn_fence(__ATOMIC_ACQUIRE, "agent");
      xb_add(&bar[XB_XGEN(x)], 1u);
      asm volatile("s_waitcnt vmcnt(0)" ::: "memory");
    } else {
      XB_SPIN(xb_ld(&bar[XB_XGEN(x)]) == gen, bar);
      __builtin_amdgcn_fence(__ATOMIC_ACQUIRE, "agent");
      asm volatile("s_waitcnt vmcnt(0)" ::: "memory");
    }
  }
  __syncthreads();
}

#ifndef ENMASK
#define ENMASK 0xffff
#endif
#define EN(i) ((ENMASK >> (i)) & 1)
enum { OP_PRO = 0, OP_LN0, OP_LN1, OP_LNF, OP_FFI, OP_FFO, OP_UP, OP_M0, OP_GAT, OP_S, OP_M2, OP_FIN, OP_DN, OP_AQ, OP_APREP, OP_ACORE, OP_AO, OP_SI, OP_SCONV, OP_SO, OP_DNUP };
__global__ void __launch_bounds__(512) fwd_megakernel(Params p) {
  cg::grid_group grid = cg::this_grid();
  const int wave_s = __builtin_amdgcn_readfirstlane((int)threadIdx.x >> 6);
  volatile LAS unsigned* xst = (volatile LAS unsigned*)((LAS unsigned char*)lds_raw + (LDS_BYTES - 16));
  if (threadIdx.x == 0) { xst[0] = 0u; xst[1] = 0u; }
  __syncthreads();
  unsigned* xbar = (unsigned*)(p.ws + O_BAR);
  const unsigned xcc = xb_xcc_id();
  if (threadIdx.x == 0) (void)xb_add(&xbar[XB_XCNT(xcc)], 1u);
#ifdef DUP_OP
  int rep = 0;
#endif
  for (int ph = 0; ph < p.nph; ++ph) {
    const unsigned w = p.prog[ph];
    const int op = w & 255, a = (w >> 8) & 255, b = (w >> 16) & 255, c = (w >> 24) & 255;
#define MKCTX int z; asm volatile("s_mov_b32 %0, 0" : "=s"(z)); \
    GAS char* wsq = (GAS char*)p.ws; GAS float* outq = (GAS float*)p.out; int bidq = (int)blockIdx.x, nbq = (int)gridDim.x; \
    asm volatile("" : "+s"(wsq), "+s"(outq), "+s"(bidq), "+s"(nbq)); \
    const Ctx cx{wave_s * 64 + (int)__builtin_amdgcn_mbcnt_hi(~0u, __builtin_amdgcn_mbcnt_lo(~0u, (unsigned)z)), bidq, nbq, z, (char*)wsq, (float*)outq};
    if (EN(0) && op == OP_PRO) { MKCTX prologue(p, cx); }
    else if (EN(1) && op == OP_LN0) { MKCTX lnmod_phase<0>(p, cx, 0, 0, 0); }
    else if (EN(1) && op == OP_LN1) { MKCTX lnmod_phase<1>(p, cx, a, b, c); }
    else if (EN(1) && op == OP_LNF) { MKCTX lnmod_phase<2>(p, cx, a, 0, 0); }
    else if (EN(2) && op == OP_M0) { MKCTX ml_m0(p, cx, a); }
    else if (EN(3) && op == OP_GAT) { MKCTX ml_gates(p, cx, a); }
    else if (EN(4) && op == OP_S) { MKCTX ml_s(p, cx); }
    else if (EN(5) && op == OP_M2) { MKCTX ml_m2(p, cx); }
    else if (EN(6) && op == OP_FIN) { MKCTX ml_fin(p, cx, a); }
    else if (EN(7) && op == OP_APREP) { MKCTX at_prep(p, cx); }
    else if (EN(8) && op == OP_ACORE) { MKCTX at_core(p, cx); }
    else if (EN(9) && op == OP_SCONV) { MKCTX sc_conv(p, cx); }
    else if (EN(10)) {
      MKCTX
      char* ws = cx.ws;
      const RowMap idm{0, 0, 1 << 30};
      bf16_t* U = (bf16_t*)(ws + O_U); bf16_t* ACT = (bf16_t*)(ws + O_ACT);
      const float* MODT = (const float*)(ws + O_MODT);
      const int nrep = op == OP_DNUP ? 2 : 1;
      for (int rep = 0; rep < nrep; ++rep) {
        const int op2 = op == OP_DNUP ? (rep == 0 ? (int)OP_UP : (int)OP_DN) : op;
        const int c2 = (op == OP_DNUP && rep == 0) ? c + 1 : c;
        Ctx cg_ = cx;
        if (op == OP_DNUP && rep == 1) cg_.bid = (cx.bid + cx.nb - 32) % cx.nb;
        const bf16_t* A = U; const bf16_t* Bt; int K = 1024, nM = MROWS / 256, nN; RowMap am = idm, cm = idm;
        Epi E; E.kind = 2; E.O = ACT; E.ldc = 0; E.modl = MODT + (size_t)b * 9 * 9216; E.slot = 1; E.wgt = 1.0f;
        E.ln = b * 3 + 1 - 1;
        if (op2 == OP_FFI) { Bt = (const bf16_t*)(ws + O_WFI) + (size_t)a * 5632 * 1024; nN = 22; E.kind = 1; if (c) nM = NLAT / 256; }
        else if (op2 == OP_FFO) { A = ACT; Bt = (const bf16_t*)(ws + O_WFO) + (size_t)a * 1024 * 2816; K = 2816; nN = 4; E.slot = c & 3; E.wgt = 0.5f; E.ln = b * 3 + (c & 3) - 1; if (c & 4) nM = NLAT / 256; }
        else if (op2 == OP_UP) { Bt = (const bf16_t*)(ws + O_WUP) + (size_t)a * 4096 * 1024; nM = RG / 256; nN = 16; am = RowMap{c2 * GB * SEQ, NLAT + c2 * GB * LC, GB * SEQ / 256}; E.kind = 0; E.O = (bf16_t*)(ws + O_XZ); E.ldc = 4096; }
        else if (op2 == OP_DN) { A = (const bf16_t*)(ws + O_FIN); Bt = (const bf16_t*)(ws + O_WDN) + (size_t)a * 1024 * 2048; K = 2048; nM = RG / 256; nN = 4; cm = RowMap{c2 * GB * SEQ, NLAT + c2 * GB * LC, GB * SEQ / 256}; }
        else if (op2 == OP_AQ) { Bt = (const bf16_t*)(ws + O_WAQ); nN = 6; E.kind = 0; E.ldc = 1536; }
        else if (op2 == OP_AO) { Bt = (const bf16_t*)(ws + O_WAO); nN = 4; }
        else if (op2 == OP_SI) { Bt = (const bf16_t*)(ws + O_WSI); nN = 12; E.kind = 0; E.ldc = 3072; }
        else { Bt = (const bf16_t*)(ws + O_WSO); nN = 4; }
        gemm_phase(cg_, A, am, Bt, K, nM, nN, cm, E);
      }
    }
    if (ph == 0) grid.sync(); else xcd_barrier(xbar, xcc, xst);
#ifdef DUP_OP
    if (op == DUP_OP && rep + 1 < DUP_N) { ++rep; --ph; } else rep = 0;
#endif
  }
}

static int build_program(unsigned* prog) {
  int n = 0;
  auto W = [&](int op, int a, int b, int c) { prog[n++] = (unsigned)op | ((unsigned)a << 8) | ((unsigned)b << 16) | ((unsigned)c << 24); };
  W(OP_PRO, 0, 0, 0);
  W(OP_LN0, 0, 0, 0);
  for (int layer = 0; layer < DEPTH; ++layer) {
    const int kind = layer % 3, j = layer / 3;
    W(OP_FFI, layer * 2, layer, 0); W(OP_FFO, layer * 2, layer, 0);
    W(OP_LN1, layer * 3 + 0, layer, 1);
    if (kind == 0) {
      for (int g = 0; g < NG; ++g) { if (g == 0) W(OP_UP, j, layer, g); W(OP_M0, j, 0, 0); W(OP_GAT, j, 0, 0); W(OP_S, 0, 0, 0); W(OP_M2, 0, 0, 0); W(OP_FIN, j, 0, 0); W(g + 1 < NG ? OP_DNUP : OP_DN, j, layer, g); }
    } else if (kind == 1) { W(OP_AQ, 0, layer, 0); W(OP_APREP, 0, 0, 0); W(OP_ACORE, 0, 0, 0); W(OP_AO, 0, layer, 0); }
    else { W(OP_SI, 0, layer, 0); W(OP_SCONV, 0, 0, 0); W(OP_SO, 0, layer, 0); }
    W(OP_LN1, layer * 3 + 1, layer, 2);
    const int lo = (layer + 1 == DEPTH) ? 1 : 0;
    W(OP_FFI, layer * 2 + 1, layer, lo); W(OP_FFO, layer * 2 + 1, layer, 2 | (lo << 2));
    if (layer + 1 < DEPTH) W(OP_LN1, layer * 3 + 2, layer + 1, 0); else W(OP_LNF, layer * 3 + 2, 0, 0);
  }
  return n;
}

extern "C" void kernel_launch(void* const* d_in, const int* in_sizes, int n_in, void* d_out, int out_size, void* d_ws, size_t ws_size, hipStream_t stream) {
  static int grid_blocks = 0;
  if (!grid_blocks) {
    int dev = 0, cus = 0, per_cu = 0;
    (void)hipGetDevice(&dev);
    (void)hipDeviceGetAttribute(&cus, hipDeviceAttributeMultiprocessorCount, dev);
    (void)hipFuncSetAttribute((const void*)fwd_megakernel, hipFuncAttributeMaxDynamicSharedMemorySize, LDS_BYTES);
    (void)hipOccupancyMaxActiveBlocksPerMultiprocessor(&per_cu, fwd_megakernel, 512, LDS_BYTES);
    if (cus <= 0) cus = 256;
    grid_blocks = cus;
    if (ws_size < WS_END || n_in != 25) fprintf(stderr, "kernel_launch: workspace %zu < %zu or n_in %d != 25\n", ws_size, (size_t)WS_END, n_in);
    if (per_cu < 1) fprintf(stderr, "kernel_launch: occupancy query says %d blocks per CU\n", per_cu);
  }
  Params p{};
  for (int i = 0; i < 25; ++i) p.in[i] = (const float*)d_in[i];
  p.out = (float*)d_out; p.ws = (char*)d_ws;
  p.nph = build_program(p.prog);
  (void)hipMemsetAsync((char*)d_ws + O_BAR, 0, XCD_BAR_WORDS * 4, stream);
  void* args[] = {&p};
  hipError_t e = hipLaunchCooperativeKernel((void*)fwd_megakernel, dim3(grid_blocks), dim3(512), args, LDS_BYTES, stream);
  if (e != hipSuccess) fprintf(stderr, "cooperative launch failed: %s (grid %d)\n", hipGetErrorString(e), grid_blocks);
}
```

```cpp
#include <hip/hip_runtime.h>
#include <hip/hip_cooperative_groups.h>
#include <cstdio>
#include <cstdint>
namespace cg = cooperative_groups;

typedef unsigned short bf16_t;
typedef short bf16x8 __attribute__((ext_vector_type(8)));
typedef short bf16x4 __attribute__((ext_vector_type(4)));
typedef float f32x4 __attribute__((ext_vector_type(4)));
typedef unsigned u32x2 __attribute__((ext_vector_type(2)));
typedef unsigned u32x4 __attribute__((ext_vector_type(4)));

constexpr int D = 1024, NB = 8, SEQ = 4096, LC = 256, DEPTH = 4, FF = 2816, EI = 2048, DH = 512;
constexpr int NLAT = NB * SEQ, NCTX = NB * LC, MROWS = NLAT + NCTX;
constexpr int TOKB = LC + SEQ;
constexpr int NCH = TOKB / 64;
constexpr int GB = 2, NG = NB / GB, RG = GB * TOKB;
constexpr int NSEQ = GB * 8;
constexpr float ALPHA = 1.681792830507429f, LN_EPS = 1e-5f;
constexpr int LDS_BYTES = 144 * 1024;

constexpr size_t al256(size_t x) { return (x + 255) & ~(size_t)255; }
constexpr size_t O_WFI = 0;
constexpr size_t O_WFO = O_WFI + (size_t)8 * 5632 * 1024 * 2;
constexpr size_t O_WUP = O_WFO + (size_t)8 * 1024 * 2816 * 2;
constexpr size_t O_WDN = O_WUP + (size_t)2 * 4096 * 1024 * 2;
constexpr size_t O_WAQ = O_WDN + (size_t)2 * 1024 * 2048 * 2;
constexpr size_t O_WAO = O_WAQ + (size_t)1536 * 1024 * 2;
constexpr size_t O_WSI = O_WAO + (size_t)1024 * 1024 * 2;
constexpr size_t O_WSO = O_WSI + (size_t)3072 * 1024 * 2;
constexpr size_t O_WG = O_WSO + (size_t)1024 * 1024 * 2;
constexpr size_t O_MODT = O_WG + (size_t)2 * 16 * 6144 * 2;
constexpr size_t O_ROPE = O_MODT + (size_t)4 * 9 * 9216 * 4;
constexpr size_t O_HCTX = O_ROPE + (size_t)2 * 4096 * 32 * 4;
constexpr size_t O_U = O_HCTX + (size_t)NCTX * D * 4;
constexpr size_t O_R = O_U + (size_t)MROWS * D * 2;
constexpr size_t O_XZ = O_R;
constexpr size_t O_QK = O_XZ + (size_t)RG * 4096 * 2;
constexpr size_t O_KT = O_QK + (size_t)RG * 4096 * 2;
constexpr size_t O_VT = O_KT + (size_t)GB * EI * TOKB * 2;
constexpr size_t O_SP = O_VT + (size_t)GB * EI * TOKB * 2;
constexpr size_t O_HD = O_SP + (size_t)NSEQ * NCH * 4096 * 2;
constexpr size_t O_FIN = O_HD + (size_t)2 * RG * EI * 2;
constexpr size_t O_GAT = O_FIN + (size_t)RG * EI * 2;
constexpr size_t SZ_ST = (size_t)NSEQ * TOKB * 4;
constexpr size_t O_BL = O_GAT, O_IG = O_BL + SZ_ST, O_WIN = O_IG + SZ_ST, O_FLO = O_WIN + SZ_ST, O_DEN = O_FLO + SZ_ST, O_WSS = O_DEN + SZ_ST;
constexpr size_t O_GC = O_WSS + SZ_ST;
constexpr size_t O_QF = O_GC + (size_t)3 * NSEQ * NCH * 4 + 256;
constexpr size_t O_REND_ML = O_QF + (size_t)GB * EI * TOKB * 2;
constexpr size_t O_ACT = O_R;
constexpr size_t O_AKR = O_R + (size_t)MROWS * 3072 * 2;
constexpr size_t O_AVT = O_AKR + (size_t)NB * 4 * TOKB * 64 * 2;
constexpr size_t O_REND_AT = O_AVT + (size_t)NB * 4 * TOKB * 64 * 2;
constexpr size_t O_BAR = (O_REND_ML > O_REND_AT ? O_REND_ML : O_REND_AT);
constexpr size_t O_STATS = O_BAR + 3456 * 4 + 256;
constexpr size_t O_LNT = O_STATS + (size_t)MROWS * 8 + 256;
constexpr size_t WS_END = O_LNT + (size_t)12 * 2 * D * 4 + 256;

struct Params {
  const float* in[25];
  float* out;
  char* ws;
  int nph; int pad0;
  unsigned prog[126];
};

#define GAS __attribute__((address_space(1)))
#define IN(k) ((const float*)(const GAS float*)p.in[(k) + cx.z])
struct Ctx { int tid, bid, nb, z; char* ws; float* out; };
extern __shared__ __attribute__((aligned(16))) char lds_raw[];

__device__ __forceinline__ unsigned pk2(float lo, float hi) { unsigned r; asm("v_cvt_pk_bf16_f32 %0, %1, %2" : "=v"(r) : "v"(lo), "v"(hi)); return r; }
__device__ __forceinline__ float bf2f(unsigned short v) { return __uint_as_float(((unsigned)v) << 16); }
__device__ __forceinline__ float bflo(unsigned v) { return __uint_as_float(v << 16); }
__device__ __forceinline__ float bfhi(unsigned v) { return __uint_as_float(v & 0xffff0000u); }
__device__ __forceinline__ float silu_f(float x) { return x * __builtin_amdgcn_rcpf(1.f + __expf(-x)); }
__device__ __forceinline__ float sigm_f(float x) { return __builtin_amdgcn_rcpf(1.f + __expf(-x)); }
__device__ __forceinline__ float shi(float v, int srclane) { return __int_as_float(__builtin_amdgcn_ds_bpermute(srclane << 2, __float_as_int(v))); }
__device__ __forceinline__ float shx(float v, int m, int lane) { return shi(v, lane ^ m); }
__device__ __forceinline__ float wave_sum(float v, int lane) {
#pragma unroll
  for (int o = 1; o < 64; o <<= 1) v += shx(v, o, lane);
  return v;
}
__device__ __forceinline__ bf16x8 mk8(u32x4 v) { union { u32x4 u; bf16x8 b; } x; x.u = v; return x.b; }
__device__ __forceinline__ bf16x8 mk8(u32x2 a, u32x2 b) { union { u32x4 u; bf16x8 b; } x; x.u = (u32x4){a.x, a.y, b.x, b.y}; return x.b; }
__device__ __forceinline__ float* hrow(const Ctx& cx, int row) { return row < NLAT ? cx.out + (size_t)row * D : (float*)(cx.ws + O_HCTX) + (size_t)(row - NLAT) * D; }
#define MFMA16(a, b, c) __builtin_amdgcn_mfma_f32_16x16x32_bf16(a, b, c, 0, 0, 0)
__device__ __forceinline__ size_t nat(int r, int c, int K) { return ((size_t)(r >> 4) * (K >> 5) + (c >> 5)) * 512 + (r & 15) * 32 + (c & 31); }

constexpr int BM = 256, BK = 64, HALF = 128, HT = HALF * BK, NXCD = 8, WGM = 4;
__device__ __forceinline__ int lds_byte(int r, int c) {
  int st = (r >> 4) * 2 + (c >> 5), rr = r & 15, cc = c & 31, ob = rr * 64 + cc * 2;
  return st * 1024 + (ob ^ (((ob >> 9) & 1) << 5));
}
__device__ __forceinline__ void stage_rc(int b, int& R, int& C) {
  int st = b / 1024, sb = b % 1024, swz = sb ^ (((sb >> 9) & 1) << 5);
  R = (st >> 1) * 16 + swz / 64; C = (st & 1) * 32 + (swz % 64) / 2;
}
struct RowMap { int lat0, ctx0, nlat; __device__ __forceinline__ int row0(int pm) const { return pm < nlat ? lat0 + pm * 256 : ctx0 + (pm - nlat) * 256; } };

typedef f32x4 Acc[2][2][4][2];

struct Epi {
  int kind; bf16_t* O; int ldc; const float* modl; int slot; float wgt;
  int ln;
};
__device__ __forceinline__ void run_epi(const Ctx& cx, const Epi E, const Acc& acc, int r0, int pn, int wr, int wc, int fr, int fq) {
  if (E.kind == 0) {
#pragma unroll
    for (int ai = 0; ai < 2; ++ai)
#pragma unroll
      for (int m = 0; m < 4; ++m) {
        bf16_t* rp = E.O + (size_t)(r0 + ai * HALF + wr * 64 + m * 16 + fr) * E.ldc + pn * 256 + wc * 32 + 4 * fq;
#pragma unroll
        for (int bj = 0; bj < 2; ++bj)
#pragma unroll
          for (int n = 0; n < 2; ++n) {
            f32x4 v = acc[ai][bj][m][n];
            u32x2 o; o.x = pk2(v[0], v[1]); o.y = pk2(v[2], v[3]);
            *(u32x2*)(rp + bj * HALF + n * 16) = o;
          }
      }
  } else if (E.kind == 1) {
#pragma unroll
    for (int ai = 0; ai < 2; ++ai)
#pragma unroll
      for (int m = 0; m < 4; ++m) {
        const int rrow = r0 + ai * HALF + wr * 64 + m * 16 + fr, fcol = pn * 128 + wc * 16 + 4 * fq;
#pragma unroll
        for (int bj = 0; bj < 2; ++bj) {
          f32x4 g = acc[ai][bj][m][0], v = acc[ai][bj][m][1];
          u32x2 o; o.x = pk2(silu_f(g[0]) * v[0], silu_f(g[1]) * v[1]); o.y = pk2(silu_f(g[2]) * v[2], silu_f(g[3]) * v[3]);
          *(u32x2*)(E.O + nat(rrow, fcol + bj * 64, FF)) = o;
        }
      }
  } else {
    const int midx = r0 < NLAT ? (r0 >> 12) : 8;
    const int cb = pn * 256 + wc * 32 + 4 * fq;
    const float* gp = E.modl + (size_t)midx * 9216 + (3 * E.slot + 2) * D + cb;
    f32x4 gv[2][2], lg[2][2], lb[2][2];
#pragma unroll
    for (int bj = 0; bj < 2; ++bj)
#pragma unroll
      for (int n = 0; n < 2; ++n) {
        gv[bj][n] = *(const f32x4*)(gp + bj * HALF + n * 16) * E.wgt;
        if (E.ln >= 0) { const float* lt = (const float*)(cx.ws + O_LNT) + (size_t)E.ln * 2 * D + cb + bj * HALF + n * 16; lg[bj][n] = *(const f32x4*)lt; lb[bj][n] = *(const f32x4*)(lt + D); }
        else { lg[bj][n] = (f32x4){1.f, 1.f, 1.f, 1.f}; lb[bj][n] = (f32x4){0.f, 0.f, 0.f, 0.f}; }
      }
#pragma unroll
    for (int ai = 0; ai < 2; ++ai)
#pragma unroll
      for (int m = 0; m < 4; ++m) {
        const int row = r0 + ai * HALF + wr * 64 + m * 16 + fr;
        float* rp = hrow(cx, row) + cb;
        float mean = 0.f, rstd = 1.f;
        if (E.ln >= 0) { const float2 st = *(const float2*)((const float*)(cx.ws + O_STATS) + (size_t)row * 2); mean = st.x; rstd = st.y; }
        f32x4 h[2][2];
#pragma unroll
        for (int bj = 0; bj < 2; ++bj)
#pragma unroll
          for (int n = 0; n < 2; ++n) h[bj][n] = *(const f32x4*)(rp + bj * HALF + n * 16);
#pragma unroll
        for (int bj = 0; bj < 2; ++bj)
#pragma unroll
          for (int n = 0; n < 2; ++n) *(f32x4*)(rp + bj * HALF + n * 16) = ((h[bj][n] - mean) * rstd) * lg[bj][n] + lb[bj][n] + gv[bj][n] * acc[ai][bj][m][n];
        __builtin_amdgcn_sched_barrier(0);
      }
  }
}

#define LAS __attribute__((address_space(3)))
__device__ __forceinline__ void gemm_phase(const Ctx& cx, const bf16_t* __restrict__ A, RowMap am, const bf16_t* __restrict__ Bt, int K, int nM, int nN, RowMap cm, const Epi epi) {
  LAS unsigned char* lds = (LAS unsigned char*)lds_raw;
  constexpr int HTB = HT * 2;
  const int tid = cx.tid, wid = tid >> 6, lane = tid & 63, wr = wid >> 2, wc = wid & 3, fr = lane & 15, fq = lane >> 4;
  unsigned voff[2];
#pragma unroll
  for (int i = 0; i < 2; ++i) { const int st = wid + 8 * i, sb = lane * 16; voff[i] = (unsigned)(((st >> 1) * (K >> 5) + (st & 1)) * 1024 + (sb ^ (((sb >> 9) & 1) << 5))); }
  const size_t kstep = 2048, hstep = (size_t)8 * (K >> 5) * 1024;
  const unsigned ldsw = (unsigned)wid * 1024u;
  const int aoff = lds_byte(wr * 64 + fr, fq * 8), boff = lds_byte(wc * 32 + fr, fq * 8);
#define G_SA(b, h) (((b) * 2 + (h)) * HTB)
#define G_SB(b, h) ((4 + (b) * 2 + (h)) * HTB)
#define STAGE(bufoff, gbase) do { _Pragma("unroll") for (int _i = 0; _i < 2; ++_i) \
    __builtin_amdgcn_global_load_lds((const unsigned*)((const char*)(gbase) + voff[_i]), (LAS unsigned*)(lds + (bufoff) + ldsw + _i * 8192), 16, 0, 0); } while (0)
#define LDA(dst, b, h) do { _Pragma("unroll") for (int m = 0; m < 4; ++m) _Pragma("unroll") for (int k = 0; k < 2; ++k) dst[m][k] = *(const LAS bf16x8*)(lds + G_SA(b, h) + aoff + m * 2048 + k * 1024); } while (0)
#define LDB(dst, b, h) do { _Pragma("unroll") for (int n = 0; n < 2; ++n) _Pragma("unroll") for (int k = 0; k < 2; ++k) dst[n][k] = *(const LAS bf16x8*)(lds + G_SB(b, h) + boff + n * 2048 + k * 1024); } while (0)
#define MMA(ai, bj, At, Bt_) do { __builtin_amdgcn_s_setprio(1); _Pragma("unroll") for (int m = 0; m < 4; ++m) _Pragma("unroll") for (int n = 0; n < 2; ++n) _Pragma("unroll") for (int k = 0; k < 2; ++k) \
      acc[ai][bj][m][n] = MFMA16(Bt_[n][k], At[m][k], acc[ai][bj][m][n]); \
    __builtin_amdgcn_s_setprio(0); } while (0)
#define WAIT_V(n) asm volatile("s_waitcnt vmcnt(" #n ")" ::: "memory")
#define WAIT_L(n) asm volatile("s_waitcnt lgkmcnt(" #n ")" ::: "memory")
#define BAR __builtin_amdgcn_s_barrier()
#define SCHED __builtin_amdgcn_sched_barrier(0)
  const int nwg = nM * nN;
  const int nt = K / BK;
  const int wid_s = __builtin_amdgcn_readfirstlane(wid);
#define DECODE(L_, pm_, pn_) do { int wgid = (L_); \
    { int q = nwg / NXCD, r = nwg % NXCD, xcd = wgid % NXCD, off = wgid / NXCD; wgid = (xcd < r ? xcd * (q + 1) : r * (q + 1) + (xcd - r) * q) + off; } \
    const int nig = WGM * nN, gid = wgid / nig, fm = gid * WGM, gsz = min(nM - fm, WGM); \
    pm_ = fm + ((wgid % nig) % gsz); pn_ = (wgid % nig) / gsz; } while (0)
  int L = cx.bid;
  if (L < nwg) {
    int pm, pn;
    DECODE(L, pm, pn);
    const char* cA = (const char*)A + (size_t)(am.row0(pm) >> 4) * (K >> 5) * 1024; const char* cB = (const char*)Bt + (size_t)(pn * BM >> 4) * (K >> 5) * 1024;
    Acc acc;
#pragma unroll
    for (int a = 0; a < 2; ++a)
#pragma unroll
      for (int b = 0; b < 2; ++b)
#pragma unroll
        for (int m = 0; m < 4; ++m)
#pragma unroll
          for (int n = 0; n < 2; ++n) acc[a][b][m][n] = (f32x4){0.f, 0.f, 0.f, 0.f};
    bf16x8 At[4][2], B0[2][2], B1[2][2];
    STAGE(G_SB(0, 0), cB); STAGE(G_SA(0, 0), cA); STAGE(G_SB(0, 1), cB + hstep); STAGE(G_SA(0, 1), cA + hstep);
    if (wr == 1) BAR;
    WAIT_V(4); BAR;
    STAGE(G_SB(1, 0), cB + kstep); STAGE(G_SA(1, 0), cA + kstep); STAGE(G_SB(1, 1), cB + hstep + kstep);
    WAIT_V(6); BAR;
    for (;;) {
      const int Ln = L + cx.nb;
      const bool has_next = Ln < nwg;
      int pmn = pm, pnn = pn;
      if (has_next) DECODE(Ln, pmn, pnn);
      const char* nA = has_next ? (const char*)A + (size_t)(am.row0(pmn) >> 4) * (K >> 5) * 1024 : cA; const char* nB = has_next ? (const char*)Bt + (size_t)(pnn * BM >> 4) * (K >> 5) * 1024 : cB;
      for (int t = 0; t < nt; t += 2) {
        const bool last = (t == nt - 2);
        const char* a1 = cA + (size_t)(t + 1) * kstep;
        const char* a2 = last ? nA : cA + (size_t)(t + 2) * kstep; const char* b2 = last ? nB : cB + (size_t)(t + 2) * kstep;
        const char* a3 = a2 + kstep; const char* b3 = b2 + kstep;
        LDB(B0, 0, 0); SCHED; LDA(At, 0, 0); STAGE(G_SA(1, 1), a1 + hstep);
        WAIT_L(8); BAR; WAIT_L(0); MMA(0, 0, At, B0); BAR; SCHED;
        LDB(B1, 0, 1); STAGE(G_SB(0, 0), b2);
        BAR; WAIT_L(0); MMA(0, 1, At, B1); BAR;
        LDA(At, 0, 1); STAGE(G_SA(0, 0), a2);
        BAR; WAIT_L(0); MMA(1, 0, At, B0); BAR; SCHED;
        STAGE(G_SB(0, 1), b2 + hstep);
        WAIT_V(6); BAR; MMA(1, 1, At, B1); BAR;
        LDB(B0, 1, 0); SCHED; LDA(At, 1, 0); STAGE(G_SA(0, 1), a2 + hstep);
        WAIT_L(8); BAR; WAIT_L(0); MMA(0, 0, At, B0); BAR; SCHED;
        LDB(B1, 1, 1); STAGE(G_SB(1, 0), b3);
        BAR; WAIT_L(0); MMA(0, 1, At, B1); BAR;
        LDA(At, 1, 1); STAGE(G_SA(1, 0), a3);
        BAR; WAIT_L(0); MMA(1, 0, At, B0); BAR; SCHED;
        STAGE(G_SB(1, 1), b3 + hstep);
        WAIT_V(6); BAR; MMA(1, 1, At, B1); BAR;
      }
      { int t2 = wid_s * 64 + (int)__builtin_amdgcn_mbcnt_hi(~0u, __builtin_amdgcn_mbcnt_lo(~0u, (unsigned)cx.z)); asm volatile("" : "+v"(t2));
        const int w2 = t2 >> 6, l2 = t2 & 63;
        run_epi(cx, epi, acc, cm.row0(pm), pn, w2 >> 2, w2 & 3, l2 & 15, l2 >> 4); }
      if (!has_next) break;
#pragma unroll
      for (int a = 0; a < 2; ++a)
#pragma unroll
        for (int b = 0; b < 2; ++b)
#pragma unroll
          for (int m = 0; m < 4; ++m)
#pragma unroll
            for (int n = 0; n < 2; ++n) acc[a][b][m][n] = (f32x4){0.f, 0.f, 0.f, 0.f};
      pm = pmn; pn = pnn; cA = nA; cB = nB; L = Ln;
    }
    WAIT_V(0);
    if (wr == 0) BAR;
    BAR;
  }
  __syncthreads();
}

template <int MODE>
__device__ __forceinline__ int wrow(int c) {
  if (MODE == 0) return c;
  const int isv = c >= FF ? 1 : 0, f = c - isv * FF;
  return (f >> 7) * 256 + ((f >> 6) & 1) * 128 + ((f >> 4) & 3) * 32 + isv * 16 + (f & 15);
}
template <int MODE>
__device__ __forceinline__ void transpose_item(const float* __restrict__ W, int K, int N, bf16_t* __restrict__ WT, float* scr, int item, int lane) {
  const int nblk = N / 32, kb = item / nblk, nb = item % nblk, k0 = 64 * kb, n0 = 32 * nb;
#pragma unroll 8
  for (int i = 0; i < 32; ++i) { const int kk = 2 * i + (lane >> 5); scr[kk * 33 + (lane & 31)] = W[(size_t)(k0 + kk) * N + n0 + (lane & 31)]; }
  __builtin_amdgcn_wave_barrier(); asm volatile("s_waitcnt lgkmcnt(0)" ::: "memory");
  const int c = lane & 7;
#pragma unroll
  for (int j = 0; j < 4; ++j) {
    const int n = (lane >> 3) + 8 * j; const float* s = scr + (8 * c) * 33 + n;
    u32x4 o; o.x = pk2(s[0 * 33], s[1 * 33]); o.y = pk2(s[2 * 33], s[3 * 33]); o.z = pk2(s[4 * 33], s[5 * 33]); o.w = pk2(s[6 * 33], s[7 * 33]);
    *(u32x4*)(WT + nat(wrow<MODE>(n0 + n), k0 + 8 * c, K)) = o;
  }
  asm volatile("s_waitcnt lgkmcnt(0)" ::: "memory"); __builtin_amdgcn_wave_barrier();
}

__device__ __forceinline__ void prologue(const Params& p, const Ctx& cx) {
  const int tid = cx.tid, lane = tid & 63, wave = tid >> 6;
  char* ws = cx.ws;
  {
    float* cond = (float*)lds_raw;
    float* red = (float*)(lds_raw + 9 * 1024 * 4);
    for (int i = tid; i < 9 * 1024; i += 512) { const int j = i >> 10, k = i & 1023; cond[i] = silu_f(j < 8 ? IN(1)[j * 1024 + k] : IN(3)[k]); }
    __syncthreads();
    for (int u = cx.bid; u < 4 * 36; u += cx.nb) {
      const int layer = u / 36, ct = u % 36, c0 = ct * 256 + 4 * lane;
      const float* wp = IN(4) + (size_t)layer * D * 9216 + c0;
      f32x4 a[9];
#pragma unroll
      for (int j = 0; j < 9; ++j) a[j] = (f32x4){0.f, 0.f, 0.f, 0.f};
#pragma unroll 4
      for (int k = wave * 128; k < wave * 128 + 128; ++k) {
        const f32x4 w = *(const f32x4*)(wp + (size_t)k * 9216);
#pragma unroll
        for (int j = 0; j < 9; ++j) a[j] += w * cond[j * 1024 + k];
      }
#pragma unroll
      for (int j = 0; j < 9; ++j) *(f32x4*)(red + (wave * 9 + j) * 256 + 4 * lane) = a[j];
      __syncthreads();
      float* mt = (float*)(ws + O_MODT) + (size_t)layer * 9 * 9216;
      for (int i = tid; i < 9 * 256; i += 512) {
        const int j = i >> 8, c = i & 255; float s = 0.f;
#pragma unroll
        for (int w = 0; w < 8; ++w) s += red[(w * 9 + j) * 256 + c];
        mt[(size_t)j * 9216 + ct * 256 + c] = s + IN(5)[layer * 9216 + ct * 256 + c];
      }
      __syncthreads();
    }
    __syncthreads();
  }
  {
    float* scr = (float*)lds_raw + wave * (64 * 33);
    const int gw = cx.bid * 8 + wave, NGW = cx.nb * 8;
    constexpr int I_FI = 16 * 176, I_FO = 44 * 32, I_UP = 16 * 128, I_DN = 32 * 32, I_AQ = 16 * 48, I_AO = 16 * 32, I_SI = 16 * 96, I_SO = 16 * 32;
    constexpr int NITEMS = 8 * I_FI + 8 * I_FO + 2 * I_UP + 2 * I_DN + I_AQ + I_AO + I_SI + I_SO;
    for (int it = gw; it < NITEMS; it += NGW) {
      int r = it;
      if (r < 8 * I_FI) { const int mi = r / I_FI; transpose_item<1>(IN(8) + (size_t)mi * 1024 * 5632, 1024, 5632, (bf16_t*)(ws + O_WFI) + (size_t)mi * 5632 * 1024, scr, r % I_FI, lane); continue; } r -= 8 * I_FI;
      if (r < 8 * I_FO) { const int mi = r / I_FO; transpose_item<0>(IN(9) + (size_t)mi * 2816 * 1024, 2816, 1024, (bf16_t*)(ws + O_WFO) + (size_t)mi * 1024 * 2816, scr, r % I_FO, lane); continue; } r -= 8 * I_FO;
      if (r < 2 * I_UP) { const int mi = r / I_UP; transpose_item<0>(IN(10) + (size_t)mi * 1024 * 4096, 1024, 4096, (bf16_t*)(ws + O_WUP) + (size_t)mi * 4096 * 1024, scr, r % I_UP, lane); continue; } r -= 2 * I_UP;
      if (r < 2 * I_DN) { const int mi = r / I_DN; transpose_item<0>(IN(18) + (size_t)mi * 2048 * 1024, 2048, 1024, (bf16_t*)(ws + O_WDN) + (size_t)mi * 1024 * 2048, scr, r % I_DN, lane); continue; } r -= 2 * I_DN;
      if (r < I_AQ) { transpose_item<0>(IN(19), 1024, 1536, (bf16_t*)(ws + O_WAQ), scr, r, lane); continue; } r -= I_AQ;
      if (r < I_AO) { transpose_item<0>(IN(21), 1024, 1024, (bf16_t*)(ws + O_WAO), scr, r, lane); continue; } r -= I_AO;
      if (r < I_SI) { transpose_item<0>(IN(22), 1024, 3072, (bf16_t*)(ws + O_WSI), scr, r, lane); continue; } r -= I_SI;
      transpose_item<0>(IN(24), 1024, 1024, (bf16_t*)(ws + O_WSO), scr, r, lane);
    }
  }
  {
    const int gt = cx.bid * 512 + tid, gs = cx.nb * 512;
    bf16_t* wg = (bf16_t*)(ws + O_WG);
    for (int i = gt; i < 2 * 16 * 6144; i += gs) {
      const int j = i / (16 * 6144), xg = (i / 6144) & 15, k = i % 6144, x = xg >> 3, g = xg & 7;
      const float* wif = IN(14) + (size_t)(j * 2 + x) * 6144 * 8;
      float v;
      const int knat = (k & ~31) + 16 * ((k >> 2) & 1) + 4 * ((k >> 3) & 3) + (k & 3);
      if (k < 2048) v = wif[(size_t)knat * 8 + g];
      else if (k < 4096) v = wif[(size_t)knat * 8 + g] * 22.627416997969522f;
      else {
        const int c = k - 4096, blk = c >> 2, cc = c & 3;
        const float* wv = IN(13) + ((size_t)(j * 3 + 2) * 512 + blk) * 16 + cc * 4;
        v = 0.f;
        for (int d2 = 0; d2 < 4; ++d2) v += wv[d2] * wif[(size_t)(4096 + 4 * blk + d2) * 8 + g];
      }
      wg[i] = (bf16_t)(pk2(v, 0.f) & 0xffff);
    }
    { float* lnt = (float*)(ws + O_LNT); for (int i = gt; i < 12 * D; i += gs) { const int l = i / D, c2 = i % D; lnt[(size_t)l * 2 * D + c2] = IN(6)[i] * ALPHA; lnt[(size_t)l * 2 * D + D + c2] = IN(7)[i] * ALPHA; } }
    float* rc = (float*)(ws + O_ROPE); float* rs = rc + 4096 * 32;
    for (int i = gt; i < 4096 * 32; i += gs) {
      const int pos = i >> 5, pp = i & 31, jf = pp & 15;
      const float fr_ = __builtin_amdgcn_exp2f(-(float)jf * (13.287712379549449f / 16.f));
      float rev = (float)(pp < 16 ? (pos >> 6) : (pos & 63)) * fr_ * 0.15915494309189535f;
      rev -= rintf(rev);
      rc[i] = __builtin_amdgcn_cosf(rev); rs[i] = __builtin_amdgcn_sinf(rev);
    }
  }
}

template <int MODE>
__device__ __forceinline__ void lnmod_phase(const Params& p, const Ctx& cx, int lnidx  , int layer, int slot) {
  const int lane = cx.tid & 63, gw = cx.bid * 8 + (cx.tid >> 6), NGW = cx.nb * 8;
  const int nrows = MODE == 2 ? NLAT : MROWS;
  const float* lg = IN(6) + (size_t)lnidx * D; const float* lb = IN(7) + (size_t)lnidx * D;
  const float* modl = (const float*)(cx.ws + O_MODT) + (size_t)layer * 9 * 9216;
  bf16_t* U = (bf16_t*)(cx.ws + O_U);
  for (int row = gw; row < nrows; row += NGW) {
    float* hp = hrow(cx, row);
    const float* src = MODE == 0 ? (row < NLAT ? IN(0) + (size_t)row * D : IN(2) + (size_t)(row - NLAT) * D) : hp;
    f32x4 v[4];
#pragma unroll
    for (int j = 0; j < 4; ++j) v[j] = *(const f32x4*)(src + 4 * lane + 256 * j);
    if (MODE != 0) {
      float s = 0.f;
#pragma unroll
      for (int j = 0; j < 4; ++j) s += (v[j][0] + v[j][1]) + (v[j][2] + v[j][3]);
      const float mean = wave_sum(s, lane) * (1.f / D); float s2 = 0.f;
#pragma unroll
      for (int j = 0; j < 4; ++j) { v[j] = v[j] - mean; s2 += (v[j][0] * v[j][0] + v[j][1] * v[j][1]) + (v[j][2] * v[j][2] + v[j][3] * v[j][3]); }
      const float rstd = __builtin_amdgcn_rsqf(wave_sum(s2, lane) * (1.f / D) + LN_EPS);
      if (MODE == 1 && lane == 0) *(float2*)((float*)(cx.ws + O_STATS) + (size_t)row * 2) = make_float2(mean, rstd);
#pragma unroll
      for (int j = 0; j < 4; ++j) v[j] = v[j] * rstd * *(const f32x4*)(lg + 4 * lane + 256 * j) + *(const f32x4*)(lb + 4 * lane + 256 * j);
    }
    if (MODE != 1) {
#pragma unroll
      for (int j = 0; j < 4; ++j) *(f32x4*)(hp + 4 * lane + 256 * j) = MODE == 0 ? v[j] * ALPHA : v[j];
    }
    if (MODE != 2) {
      const int midx = row < NLAT ? (row >> 12) : 8;
      const float* sh = modl + (size_t)midx * 9216 + (3 * slot) * D; const float* sc = sh + D;
#pragma unroll
      for (int j = 0; j < 4; ++j) {
        const f32x4 u = v[j] * (*(const f32x4*)(sc + 4 * lane + 256 * j) + 1.f) + *(const f32x4*)(sh + 4 * lane + 256 * j);
        u32x2 o; o.x = pk2(u[0], u[1]); o.y = pk2(u[2], u[3]);
        *(u32x2*)(U + nat(row, 4 * lane + 256 * j, D)) = o;
      }
    }
  }
}

__device__ __forceinline__ int ml_lrow(int bl, int tok) { return tok < LC ? GB * SEQ + bl * LC + tok : bl * SEQ + (tok - LC); }
__device__ __forceinline__ int ml_nchunk(int x, int st) { return x == 0 ? st : (st < 4 ? 3 - st : 71 - st); }

__device__ __forceinline__ void ml_m0(const Params& p, const Ctx& cx, int j) {
  const int tid = cx.tid;
  char* ws = cx.ws;
  const bf16_t* XZ = (const bf16_t*)(ws + O_XZ);
  bf16_t* QK = (bf16_t*)(ws + O_QK); bf16_t* KT = (bf16_t*)(ws + O_KT); bf16_t* VT = (bf16_t*)(ws + O_VT); bf16_t* QF = (bf16_t*)(ws + O_QF);
  const int blk_l = tid & 63, tq = tid >> 6;
  for (int u = cx.bid; u < GB * NCH * 8; u += cx.nb) {
    const int slab = u & 7, ch = (u >> 3) % NCH, bl = u / (8 * NCH);
    const int f0 = slab * 256 + blk_l * 4, blk = f0 >> 2;
    float cw[3][4], cb[4], wq[16], wk[16], wv[16];
#pragma unroll
    for (int k = 0; k < 3; ++k)
#pragma unroll
      for (int c = 0; c < 4; ++c) cw[k][c] = IN(11)[(size_t)(j * 3 + k) * EI + f0 + c];
#pragma unroll
    for (int c = 0; c < 4; ++c) cb[c] = IN(12)[(size_t)j * EI + f0 + c];
#pragma unroll
    for (int i = 0; i < 16; ++i) {
      wq[i] = IN(13)[((size_t)(j * 3 + 0) * 512 + blk) * 16 + i];
      wk[i] = IN(13)[((size_t)(j * 3 + 1) * 512 + blk) * 16 + i] * 0.04419417382415922f;
      wv[i] = IN(13)[((size_t)(j * 3 + 2) * 512 + blk) * 16 + i];
    }
    const int tok0 = ch * 64, seg_lo = tok0 < LC ? 0 : LC, seg_hi = tok0 < LC ? LC : TOKB;
    const int tl0 = tq * 8;
    float xmp[4], xmc[4], xmn[4];
    {
      const int t2 = tok0 + tl0 - 1;
      if (t2 >= seg_lo) { const u32x2 r = *(const u32x2*)(XZ + (size_t)ml_lrow(bl, t2) * 4096 + f0); xmp[0] = bflo(r.x); xmp[1] = bfhi(r.x); xmp[2] = bflo(r.y); xmp[3] = bfhi(r.y); }
      else { xmp[0] = xmp[1] = xmp[2] = xmp[3] = 0.f; }
      const u32x2 r = *(const u32x2*)(XZ + (size_t)ml_lrow(bl, tok0 + tl0) * 4096 + f0); xmc[0] = bflo(r.x); xmc[1] = bfhi(r.x); xmc[2] = bflo(r.y); xmc[3] = bfhi(r.y);
    }
    unsigned kpk[4][4], vpk[4][4];
    float kprev[4], vprev[4];
    const int fp = (f0 & ~31) + 8 * ((f0 >> 2) & 3) + 4 * ((f0 >> 4) & 1);
#pragma unroll
    for (int tt = 0; tt < 8; ++tt) {
      const int tl = tl0 + tt, tok = tok0 + tl;
      if (tok + 1 < seg_hi) { const u32x2 r = *(const u32x2*)(XZ + (size_t)ml_lrow(bl, tok + 1) * 4096 + f0); xmn[0] = bflo(r.x); xmn[1] = bfhi(r.x); xmn[2] = bflo(r.y); xmn[3] = bfhi(r.y); }
      else { xmn[0] = xmn[1] = xmn[2] = xmn[3] = 0.f; }
      float xc[4], q[4], kk[4], vv[4];
#pragma unroll
      for (int c = 0; c < 4; ++c) xc[c] = silu_f(cw[0][c] * xmp[c] + cw[1][c] * xmc[c] + cw[2][c] * xmn[c] + cb[c]);
#pragma unroll
      for (int d2 = 0; d2 < 4; ++d2) {
        q[d2] = xc[0] * wq[d2] + xc[1] * wq[4 + d2] + xc[2] * wq[8 + d2] + xc[3] * wq[12 + d2];
        kk[d2] = xc[0] * wk[d2] + xc[1] * wk[4 + d2] + xc[2] * wk[8 + d2] + xc[3] * wk[12 + d2];
        vv[d2] = xmc[0] * wv[d2] + xmc[1] * wv[4 + d2] + xmc[2] * wv[8 + d2] + xmc[3] * wv[12 + d2];
      }
      const size_t lr = ml_lrow(bl, tok);
      u32x2 oq, ok; oq.x = pk2(q[0], q[1]); oq.y = pk2(q[2], q[3]); ok.x = pk2(kk[0], kk[1]); ok.y = pk2(kk[2], kk[3]);
      *(u32x2*)(QF + ((((((size_t)bl * NCH + ch) * 4 + (f0 >> 9)) * 8 + ((f0 >> 6) & 7)) * 4 + (tl >> 4)) * 2 + ((f0 >> 5) & 1)) * 512 + (tl & 15) * 32 + 8 * ((f0 >> 2) & 3) + 4 * ((f0 >> 4) & 1)) = oq;
      *(u32x2*)(QK + lr * 4096 + 2048 + fp) = ok;
      if (tt & 1) {
#pragma unroll
        for (int c = 0; c < 4; ++c) { kpk[c][tt >> 1] = pk2(kprev[c], kk[c]); vpk[c][tt >> 1] = pk2(vprev[c], vv[c]); }
      } else {
#pragma unroll
        for (int c = 0; c < 4; ++c) { kprev[c] = kk[c]; vprev[c] = vv[c]; }
      }
#pragma unroll
      for (int c = 0; c < 4; ++c) { xmp[c] = xmc[c]; xmc[c] = xmn[c]; }
    }
#pragma unroll
    for (int c = 0; c < 4; ++c) {
      const int feat = f0 + c;
      const size_t off = (((size_t)bl * NCH + ch) * (EI / 16) + (feat >> 4)) * 1024 + (tq >> 2) * 512 + (feat & 15) * 32 + (tq & 3) * 8;
      *(u32x4*)(KT + off) = (u32x4){kpk[c][0], kpk[c][1], kpk[c][2], kpk[c][3]};
      *(u32x4*)(VT + off) = (u32x4){vpk[c][0], vpk[c][1], vpk[c][2], vpk[c][3]};
    }
  }
}

__device__ __forceinline__ void ml_gates(const Params& p, const Ctx& cx, int j) {
  const int tid = cx.tid, lane = tid & 63, wave = tid >> 6, fr = lane & 15, fq = lane >> 4;
  char* ws = cx.ws;
  const bf16_t* XZ = (const bf16_t*)(ws + O_XZ); const bf16_t* QK = (const bf16_t*)(ws + O_QK); const bf16_t* QF = (const bf16_t*)(ws + O_QF);
  const bf16_t* WG = (const bf16_t*)(ws + O_WG) + (size_t)j * 16 * 6144;
  float* BL = (float*)(ws + O_BL); float* IG = (float*)(ws + O_IG);
  float* GC = (float*)(ws + O_GC); float* AC = GC + NSEQ * NCH;
  float* part = (float*)lds_raw;
  float* gl = part + 8 * 64 * 16;
  for (int u = cx.bid; u < GB * NCH; u += cx.nb) {
    const int bl = u / NCH, nc = u % NCH, tok0 = nc * 64;
    f32x4 acc[4];
#pragma unroll
    for (int m = 0; m < 4; ++m) acc[m] = (f32x4){0.f, 0.f, 0.f, 0.f};
    size_t lr[4];
#pragma unroll
    for (int m = 0; m < 4; ++m) lr[m] = ml_lrow(bl, tok0 + m * 16 + fr);
#pragma unroll 4
    for (int ks = wave * 24; ks < wave * 24 + 24; ++ks) {
      const int k = ks * 32 + fq * 8;
      const bf16x8 bfr = *(const bf16x8*)(WG + (size_t)fr * 6144 + k);
#pragma unroll
      for (int m = 0; m < 4; ++m) {
        const bf16_t* ap = k < 2048 ? QF + ((((((size_t)bl * NCH + nc) * 4 + (k >> 9)) * 8 + ((k >> 6) & 7)) * 4 + m) * 2 + ((k >> 5) & 1)) * 512 + fr * 32 + 8 * fq
                         : k < 4096 ? QK + lr[m] * 4096 + k : XZ + lr[m] * 4096 + (k - 4096);
        const bf16x8 afr = *(const bf16x8*)ap;
        acc[m] = MFMA16(afr, bfr, acc[m]);
      }
    }
#pragma unroll
    for (int m = 0; m < 4; ++m)
#pragma unroll
      for (int jj = 0; jj < 4; ++jj) part[(wave * 64 + m * 16 + 4 * fq + jj) * 16 + fr] = acc[m][jj];
    __syncthreads();
    for (int i = tid; i < 1024; i += 512) {
      float s = IN(15)[(size_t)j * 16 + (i & 15)];
#pragma unroll
      for (int w = 0; w < 8; ++w) s += part[w * 1024 + i];
      gl[(i >> 4) * 17 + (i & 15)] = s;
    }
    __syncthreads();
    {
      const int x = wave >> 2, h = wave & 3, seq = (bl * 2 + x) * 4 + h;
      const int tl = x == 0 ? lane : 63 - lane;
      const float ig = gl[tl * 17 + x * 8 + h], fg = gl[tl * 17 + x * 8 + 4 + h];
      float b = fg > 0.f ? -__logf(1.f + __expf(-fg)) : fg - __logf(1.f + __expf(fg));
#pragma unroll
      for (int o = 1; o < 64; o <<= 1) { const float t2 = shi(b, lane - o); if (lane >= o) b += t2; }
      BL[(size_t)seq * TOKB + tok0 + tl] = b; IG[(size_t)seq * TOKB + tok0 + tl] = ig;
      float mx = ig - b;
#pragma unroll
      for (int o = 1; o < 64; o <<= 1) mx = fmaxf(mx, shx(mx, o, lane));
      const float g = shi(b, 63);
      if (lane == 0) { GC[seq * NCH + nc] = g; AC[seq * NCH + nc] = g + mx; }
    }
    __syncthreads();
  }
}

__device__ __forceinline__ void ml_s(const Params& p, const Ctx& cx) {
  const int tid = cx.tid, lane = tid & 63, wave = tid >> 6, fr = lane & 15, fq = lane >> 4;
  char* ws = cx.ws;
  const bf16_t* QK = (const bf16_t*)(ws + O_QK);
  bf16_t* SP = (bf16_t*)(ws + O_SP);
  const float* BL = (const float*)(ws + O_BL); const float* IG = (const float*)(ws + O_IG);
  float* WIN = (float*)(ws + O_WIN); float* FLO = (float*)(ws + O_FLO); float* DEN = (float*)(ws + O_DEN); float* WSS = (float*)(ws + O_WSS);
  const float* GC = (const float*)(ws + O_GC); const float* AC = GC + NSEQ * NCH; float* DEC = (float*)(ws + O_GC) + 2 * NSEQ * NCH;
  float* sb_ = (float*)lds_raw + wave * 256; float* si_ = sb_ + 64; float* smt = si_ + 64;
  const int gw = cx.bid * 8 + wave, NGW = cx.nb * 8;
  for (int u = gw; u < NSEQ * NCH; u += NGW) {
    const int seq = u / NCH, st = u % NCH, x = (seq >> 2) & 1, h = seq & 3, bl = seq >> 3;
    const int nc = ml_nchunk(x, st), tok0 = nc * 64;
    const int nl0 = ml_nchunk(x, lane), nl1 = ml_nchunk(x, 64 + (lane & 3));
    const float g0 = GC[seq * NCH + nl0], a0 = AC[seq * NCH + nl0], g1 = GC[seq * NCH + nl1], a1 = AC[seq * NCH + nl1];
    const int tl = x == 0 ? lane : 63 - lane;
    const float b = BL[(size_t)seq * TOKB + tok0 + tl], ig = IG[(size_t)seq * TOKB + tok0 + tl];
    float mc = 0.f;
    for (int s2 = 0; s2 < st; ++s2) {
      const float gg = __int_as_float(__builtin_amdgcn_readlane(__float_as_int(s2 < 64 ? g0 : g1), s2 & 63));
      const float aa = __int_as_float(__builtin_amdgcn_readlane(__float_as_int(s2 < 64 ? a0 : a1), s2 & 63));
      mc = fmaxf(gg + mc, aa);
    }
    const float gc = __int_as_float(__builtin_amdgcn_readlane(__float_as_int(st < 64 ? g0 : g1), st & 63));
    const float ac = __int_as_float(__builtin_amdgcn_readlane(__float_as_int(st < 64 ? a0 : a1), st & 63));
    const float mnew = fmaxf(gc + mc, ac);
    float cm = ig - b;
#pragma unroll
    for (int o = 1; o < 64; o <<= 1) { const float t2 = shi(cm, lane - o); if (lane >= o) cm = fmaxf(cm, t2); }
    const float mt = b + fmaxf(mc, cm);
    sb_[tl] = b; si_[tl] = ig; smt[tl] = mt;
    WIN[(size_t)seq * TOKB + tok0 + tl] = __expf(b + mc - mt);
    FLO[(size_t)seq * TOKB + tok0 + tl] = __expf(-mt);
    WSS[(size_t)seq * TOKB + tok0 + tl] = __expf(gc - b + ig - mnew);
    if (lane == 0) DEC[seq * NCH + nc] = __expf(gc + mc - mnew);
    f32x4 acc[4][4];
#pragma unroll
    for (int a = 0; a < 4; ++a)
#pragma unroll
      for (int c2 = 0; c2 < 4; ++c2) acc[a][c2] = (f32x4){0.f, 0.f, 0.f, 0.f};
    const bf16_t* rowp[4];
#pragma unroll
    for (int a = 0; a < 4; ++a) rowp[a] = QK + (size_t)ml_lrow(bl, tok0 + a * 16 + fr) * 4096 + h * DH + fq * 8;
    const bf16_t* qfb = (const bf16_t*)(ws + O_QF) + ((((size_t)bl * NCH + nc) * 4 + h) * 8) * 4 * 2 * 512 + fr * 32 + 8 * fq;
#pragma unroll 2
    for (int ks = 0; ks < 16; ++ks) {
      bf16x8 kf[4], qf[4];
#pragma unroll
      for (int a = 0; a < 4; ++a) { kf[a] = *(const bf16x8*)(rowp[a] + 2048 + ks * 32); qf[a] = *(const bf16x8*)(qfb + (((size_t)(ks >> 1) * 4 + a) * 2 + (ks & 1)) * 512); }
#pragma unroll
      for (int a = 0; a < 4; ++a)
#pragma unroll
        for (int c2 = 0; c2 < 4; ++c2) acc[a][c2] = MFMA16(kf[a], qf[c2], acc[a][c2]);
    }
    __builtin_amdgcn_wave_barrier(); asm volatile("s_waitcnt lgkmcnt(0)" ::: "memory");
    bf16_t* spu = SP + (size_t)(seq * NCH + nc) * 4096;
#pragma unroll
    for (int tb = 0; tb < 4; ++tb) {
      const int t = tb * 16 + fr;
      const float bt = sb_[t], mtt = smt[t];
      float dsum = 0.f;
#pragma unroll
      for (int sbk = 0; sbk < 4; ++sbk) {
        float vals[4];
#pragma unroll
        for (int jj = 0; jj < 4; ++jj) {
          const int s = sbk * 16 + 4 * fq + jj;
          const bool ok = x == 0 ? (s <= t) : (s >= t);
          vals[jj] = ok ? acc[sbk][tb][jj] * __expf(bt - sb_[s] + si_[s] - mtt) : 0.f;
        }
        u32x2 o; o.x = pk2(vals[0], vals[1]); o.y = pk2(vals[2], vals[3]);
        *(u32x2*)(spu + tb * 1024 + ((sbk * 16 + 4 * fq) >> 5) * 512 + fr * 32 + ((sbk * 16 + 4 * fq) & 31)) = o;
        dsum += (bflo(o.x) + bfhi(o.x)) + (bflo(o.y) + bfhi(o.y));
      }
      dsum += shx(dsum, 16, lane); dsum += shx(dsum, 32, lane);
      if (fq == 0) DEN[(size_t)seq * TOKB + tok0 + t] = dsum;
    }
    __builtin_amdgcn_wave_barrier(); asm volatile("s_waitcnt lgkmcnt(0)" ::: "memory");
  }
}

constexpr int NEB = 2, NSL = 512 / (16 * NEB);
__device__ __forceinline__ void ml_m2(const Params& p, const Ctx& cx) {
  const int tid = cx.tid, lane = tid & 63, wave = tid >> 6, fr = lane & 15, fq = lane >> 4;
  char* ws = cx.ws;
  const bf16_t* QK = (const bf16_t*)(ws + O_QK); const bf16_t* KT = (const bf16_t*)(ws + O_KT); const bf16_t* VT = (const bf16_t*)(ws + O_VT);
  const bf16_t* SP = (const bf16_t*)(ws + O_SP); const bf16_t* QF = (const bf16_t*)(ws + O_QF);
  bf16_t* HD = (bf16_t*)(ws + O_HD);
  const float* WIN = (const float*)(ws + O_WIN); const float* FLO = (const float*)(ws + O_FLO); const float* DEN = (const float*)(ws + O_DEN); const float* WSS = (const float*)(ws + O_WSS);
  const float* DEC = (const float*)(ws + O_GC) + 2 * NSEQ * NCH;
  f32x4* red = (f32x4*)lds_raw;
  f32x4* rn = (f32x4*)(lds_raw + 131072);
  for (int idx = cx.bid >> 3; idx < 2 * NSL; idx += cx.nb >> 3) {
    const int seq = (cx.bid & 7) * 2 + idx / NSL, es = idx % NSL, x = (seq >> 2) & 1, h = seq & 3, bl = seq >> 3;
    const int d0 = wave * 64, e0 = es * 16 * NEB;
    f32x4 C[4][NEB + 1];
#pragma unroll
    for (int a = 0; a < 4; ++a)
#pragma unroll
      for (int b = 0; b < NEB + 1; ++b) C[a][b] = (f32x4){0.f, 0.f, 0.f, 0.f};
    const int tbo = wave >> 1, ebo = __builtin_amdgcn_readfirstlane(wave & 1);
    bf16x8 qc[4][2], kf[4][2], sf0, sf1;
    u32x4 vr[NEB][2];
    f32x4 wv[2][2];
#define M2_LOAD_Q(ST) do { const int _nq = ml_nchunk(x, (ST)); _Pragma("unroll") for (int tb = 0; tb < 4; ++tb) { \
        const bf16_t* qp = QF + ((((((size_t)bl * NCH + _nq) * 4 + h) * 8 + wave) * 4 + tb) * 2) * 512 + fr * 32 + 8 * fq; \
        qc[tb][0] = *(const bf16x8*)qp; qc[tb][1] = *(const bf16x8*)(qp + 512); } } while (0)
#define M2_LOAD_KV(ST) do { const int _nc = ml_nchunk(x, (ST)), _t0 = _nc * 64; \
        _Pragma("unroll") for (int db = 0; db < 4; ++db) { const bf16_t* kp = KT + (((size_t)bl * NCH + _nc) * (EI / 16) + ((h * DH + d0) >> 4) + db) * 1024 + fr * 32 + 8 * fq; \
          kf[db][0] = *(const bf16x8*)kp; kf[db][1] = *(const bf16x8*)(kp + 512); } \
        _Pragma("unroll") for (int eb = 0; eb < NEB; ++eb) { const bf16_t* vp = VT + (((size_t)bl * NCH + _nc) * (EI / 16) + ((h * DH + e0) >> 4) + eb) * 1024 + fr * 32 + 8 * fq; \
          vr[eb][0] = *(const u32x4*)vp; vr[eb][1] = *(const u32x4*)(vp + 512); } \
        _Pragma("unroll") for (int ks = 0; ks < 2; ++ks) { const float* wp = WSS + (size_t)seq * TOKB + _t0 + 32 * ks + 8 * fq; \
          wv[ks][0] = *(const f32x4*)wp; wv[ks][1] = *(const f32x4*)(wp + 4); } \
        const bf16_t* sp = SP + (size_t)(seq * NCH + _nc) * 4096 + tbo * 1024 + fr * 32 + 8 * fq; \
        sf0 = *(const bf16x8*)sp; sf1 = *(const bf16x8*)(sp + 512); } while (0)
    M2_LOAD_Q(0); M2_LOAD_KV(0);
    for (int st = 0; st < NCH; ++st) {
      const int nc = ml_nchunk(x, st), tok0 = nc * 64, stn = st + 1 < NCH ? st + 1 : st;
      const size_t tix = (size_t)seq * TOKB + tok0 + tbo * 16 + 4 * fq;
      const f32x4 win = *(const f32x4*)(WIN + tix), flo = *(const f32x4*)(FLO + tix), deni = *(const f32x4*)(DEN + tix);
      const float decay = DEC[seq * NCH + nc];
#pragma unroll
      for (int eb = 0; eb < NEB + 1; ++eb) {
        bf16x8 cb0, cb1;
        { const f32x4 lo = C[0][eb], hi = C[1][eb]; cb0 = mk8((u32x4){pk2(lo[0], lo[1]), pk2(lo[2], lo[3]), pk2(hi[0], hi[1]), pk2(hi[2], hi[3])}); }
        { const f32x4 lo = C[2][eb], hi = C[3][eb]; cb1 = mk8((u32x4){pk2(lo[0], lo[1]), pk2(lo[2], lo[3]), pk2(hi[0], hi[1]), pk2(hi[2], hi[3])}); }
        f32x4 pa[4];
#pragma unroll
        for (int tb = 0; tb < 4; ++tb) pa[tb] = MFMA16(qc[tb][0], cb0, ((f32x4){0.f, 0.f, 0.f, 0.f}));
#pragma unroll
        for (int tb = 0; tb < 4; ++tb) pa[tb] = MFMA16(qc[tb][1], cb1, pa[tb]);
#pragma unroll
        for (int tb = 0; tb < 4; ++tb) {
          if (eb < NEB) red[((wave * 4 + tb) * NEB + eb) * 64 + lane] = pa[tb];
          else if (fr == 0) rn[(wave * 4 + tb) * 4 + fq] = pa[tb];
        }
      }
      M2_LOAD_Q(stn);
      f32x4 oi = {0.f, 0.f, 0.f, 0.f};
#pragma unroll
      for (int eb = 0; eb < NEB + 1; ++eb) {
        bf16x8 vw0, vw1;
        if (eb < NEB) {
          const u32x4 r0 = vr[eb][0], r1 = vr[eb][1];
          if (eb == ebo) { oi = MFMA16(sf0, mk8(r0), oi); oi = MFMA16(sf1, mk8(r1), oi); }
          vw0 = mk8((u32x4){pk2(bflo(r0.x) * wv[0][0][0], bfhi(r0.x) * wv[0][0][1]), pk2(bflo(r0.y) * wv[0][0][2], bfhi(r0.y) * wv[0][0][3]),
                            pk2(bflo(r0.z) * wv[0][1][0], bfhi(r0.z) * wv[0][1][1]), pk2(bflo(r0.w) * wv[0][1][2], bfhi(r0.w) * wv[0][1][3])});
          vw1 = mk8((u32x4){pk2(bflo(r1.x) * wv[1][0][0], bfhi(r1.x) * wv[1][0][1]), pk2(bflo(r1.y) * wv[1][0][2], bfhi(r1.y) * wv[1][0][3]),
                            pk2(bflo(r1.z) * wv[1][1][0], bfhi(r1.z) * wv[1][1][1]), pk2(bflo(r1.w) * wv[1][1][2], bfhi(r1.w) * wv[1][1][3])});
        } else {
          vw0 = mk8((u32x4){pk2(wv[0][0][0], wv[0][0][1]), pk2(wv[0][0][2], wv[0][0][3]), pk2(wv[0][1][0], wv[0][1][1]), pk2(wv[0][1][2], wv[0][1][3])});
          vw1 = mk8((u32x4){pk2(wv[1][0][0], wv[1][0][1]), pk2(wv[1][0][2], wv[1][0][3]), pk2(wv[1][1][0], wv[1][1][1]), pk2(wv[1][1][2], wv[1][1][3])});
        }
#pragma unroll
        for (int db = 0; db < 4; ++db) {
          f32x4 c = C[db][eb] * decay;
          c = MFMA16(kf[db][0], vw0, c); c = MFMA16(kf[db][1], vw1, c);
          C[db][eb] = c;
        }
      }
      asm volatile("s_waitcnt lgkmcnt(0)" ::: "memory");
      __builtin_amdgcn_s_barrier();
      asm volatile("" ::: "memory");
      f32x4 rdn[8], rd0[8];
#pragma unroll
      for (int w = 0; w < 8; ++w) { rdn[w] = rn[(w * 4 + tbo) * 4 + fq]; rd0[w] = red[((w * 4 + tbo) * NEB + ebo) * 64 + lane]; }
      const f32x4 pn = ((rdn[0] + rdn[1]) + (rdn[2] + rdn[3])) + ((rdn[4] + rdn[5]) + (rdn[6] + rdn[7]));
      const f32x4 pi = ((rd0[0] + rd0[1]) + (rd0[2] + rd0[3])) + ((rd0[4] + rd0[5]) + (rd0[6] + rd0[7]));
#pragma unroll
      for (int jj = 0; jj < 4; ++jj) {
        const float num = oi[jj] + win[jj] * pi[jj], den = deni[jj] + win[jj] * pn[jj];
        const float hv = num * __builtin_amdgcn_rcpf(fmaxf(fabsf(den), flo[jj]));
        HD[((size_t)x * RG + ml_lrow(bl, tok0 + tbo * 16 + 4 * fq + jj)) * EI + h * DH + e0 + ebo * 16 + fr] = (bf16_t)(pk2(hv, 0.f) & 0xffff);
      }
      M2_LOAD_KV(stn);
      asm volatile("s_waitcnt lgkmcnt(0)" ::: "memory");
      __builtin_amdgcn_s_barrier();
      asm volatile("" ::: "memory");
    }
    __syncthreads();
#undef M2_LOAD_Q
#undef M2_LOAD_KV
  }
}

__device__ __forceinline__ void ml_fin(const Params& p, const Ctx& cx, int j) {
  const int lane = cx.tid & 63, gw = cx.bid * 8 + (cx.tid >> 6), NGW = cx.nb * 8;
  char* ws = cx.ws;
  const bf16_t* XZ = (const bf16_t*)(ws + O_XZ); const bf16_t* HD = (const bf16_t*)(ws + O_HD);
  bf16_t* FIN = (bf16_t*)(ws + O_FIN);
  for (int u = gw; u < RG * 4; u += NGW) {
    const int lr = u >> 2, h = u & 3, f0 = h * DH + lane * 8;
    int pos, seglen;
    if (lr < GB * SEQ) { pos = lr & (SEQ - 1); seglen = SEQ; } else { pos = (lr - GB * SEQ) & (LC - 1); seglen = LC; }
    const u32x4 hf = *(const u32x4*)(HD + (size_t)lr * EI + f0), hb = *(const u32x4*)(HD + ((size_t)RG + lr) * EI + f0);
    const u32x4 zz = *(const u32x4*)(XZ + (size_t)lr * 4096 + 2048 + f0);
    const u32x4 x1 = *(const u32x4*)(XZ + (size_t)lr * 4096 + f0);
    u32x4 x0 = {0u, 0u, 0u, 0u}, x2 = {0u, 0u, 0u, 0u};
    if (pos > 0) x0 = *(const u32x4*)(XZ + (size_t)(lr - 1) * 4096 + f0);
    if (pos < seglen - 1) x2 = *(const u32x4*)(XZ + (size_t)(lr + 1) * 4096 + f0);
    float hv[8], xm0[8], xm1[8], xm2[8];
    const unsigned hfu[4] = {hf.x, hf.y, hf.z, hf.w}, hbu[4] = {hb.x, hb.y, hb.z, hb.w}, zu[4] = {zz.x, zz.y, zz.z, zz.w};
    const unsigned x0u[4] = {x0.x, x0.y, x0.z, x0.w}, x1u[4] = {x1.x, x1.y, x1.z, x1.w}, x2u[4] = {x2.x, x2.y, x2.z, x2.w};
    float s = 0.f;
#pragma unroll
    for (int i = 0; i < 4; ++i) {
      hv[2 * i] = (bflo(hfu[i]) + bflo(hbu[i])) * sigm_f(bflo(zu[i]));
      hv[2 * i + 1] = (bfhi(hfu[i]) + bfhi(hbu[i])) * sigm_f(bfhi(zu[i]));
      xm0[2 * i] = bflo(x0u[i]); xm0[2 * i + 1] = bfhi(x0u[i]); xm1[2 * i] = bflo(x1u[i]); xm1[2 * i + 1] = bfhi(x1u[i]); xm2[2 * i] = bflo(x2u[i]); xm2[2 * i + 1] = bfhi(x2u[i]);
      s += hv[2 * i] + hv[2 * i + 1];
    }
    const float mean = wave_sum(s, lane) * (1.f / DH); float s2 = 0.f;
#pragma unroll
    for (int i = 0; i < 8; ++i) { hv[i] -= mean; s2 += hv[i] * hv[i]; }
    const float rstd = __builtin_amdgcn_rsqf(wave_sum(s2, lane) * (1.f / DH) + LN_EPS);
    float o[8];
#pragma unroll
    for (int i = 0; i < 8; ++i) {
      const int f = f0 + i;
      const float xc = silu_f(IN(11)[(size_t)(j * 3 + 0) * EI + f] * xm0[i] + IN(11)[(size_t)(j * 3 + 1) * EI + f] * xm1[i] + IN(11)[(size_t)(j * 3 + 2) * EI + f] * xm2[i] + IN(12)[(size_t)j * EI + f]);
      o[i] = hv[i] * rstd * IN(17)[(size_t)j * EI + f] + IN(16)[(size_t)j * EI + f] * xc;
    }
    u32x4 ov; ov.x = pk2(o[0], o[1]); ov.y = pk2(o[2], o[3]); ov.z = pk2(o[4], o[5]); ov.w = pk2(o[6], o[7]);
    *(u32x4*)(FIN + nat(lr, f0, EI)) = ov;
  }
}

__device__ __forceinline__ void at_prep(const Params& p, const Ctx& cx) {
  const int lane = cx.tid & 63, gw = cx.bid * 8 + (cx.tid >> 6), NGW = cx.nb * 8;
  char* ws = cx.ws;
  bf16_t* ACT = (bf16_t*)(ws + O_ACT); bf16_t* KR = (bf16_t*)(ws + O_AKR); bf16_t* VT = (bf16_t*)(ws + O_AVT);
  const float* rc = (const float*)(ws + O_ROPE); const float* rs = rc + 4096 * 32;
  for (int row = gw; row < MROWS; row += NGW) {
    const bool lat = row < NLAT;
    const int b = lat ? row >> 12 : (row - NLAT) >> 8, pos = lat ? row & 4095 : (row - NLAT) & 255, tok = lat ? LC + pos : pos;
    bf16_t* rp = ACT + (size_t)row * 1536;
    {
      const u32x4 a = *(const u32x4*)(rp + 16 * lane), b2 = *(const u32x4*)(rp + 16 * lane + 8);
      const unsigned w[8] = {a.x, a.y, a.z, a.w, b2.x, b2.y, b2.z, b2.w};
      unsigned o[8];
      const int pp0 = (lane & 3) * 8;
#pragma unroll
      for (int i = 0; i < 8; ++i) {
        float x1 = bflo(w[i]) * 0.125f, x2 = bfhi(w[i]) * 0.125f;
        if (lat) { const float c = rc[pos * 32 + pp0 + i], s = rs[pos * 32 + pp0 + i]; const float y1 = x1 * c - x2 * s, y2 = x1 * s + x2 * c; x1 = y1; x2 = y2; }
        o[i] = pk2(x1, x2);
      }
      *(u32x4*)(rp + 16 * lane) = (u32x4){o[0], o[1], o[2], o[3]}; *(u32x4*)(rp + 16 * lane + 8) = (u32x4){o[4], o[5], o[6], o[7]};
    }
    {
      const u32x2 a = *(const u32x2*)(rp + 1024 + 4 * lane);
      const unsigned w[2] = {a.x, a.y}; unsigned o[2];
      const int g = lane >> 4, dd = (lane & 15) * 4, pp0 = dd >> 1;
#pragma unroll
      for (int i = 0; i < 2; ++i) {
        float x1 = bflo(w[i]), x2 = bfhi(w[i]);
        if (lat) { const float c = rc[pos * 32 + pp0 + i], s = rs[pos * 32 + pp0 + i]; const float y1 = x1 * c - x2 * s, y2 = x1 * s + x2 * c; x1 = y1; x2 = y2; }
        o[i] = pk2(x1, x2);
      }
      *(u32x2*)(KR + (((size_t)b * 4 + g) * TOKB + tok) * 64 + dd) = (u32x2){o[0], o[1]};
      const u32x2 v = *(const u32x2*)(rp + 1280 + 4 * lane);
      bf16_t* vp = VT + (((size_t)b * 4 + g) * 64 + dd) * TOKB + tok;
      vp[0] = (bf16_t)(v.x & 0xffff); vp[TOKB] = (bf16_t)(v.x >> 16); vp[2 * TOKB] = (bf16_t)(v.y & 0xffff); vp[3 * TOKB] = (bf16_t)(v.y >> 16);
    }
  }
}

__device__ __forceinline__ void at_core(const Params& p, const Ctx& cx) {
  const int lane = cx.tid & 63, gw = cx.bid * 8 + (cx.tid >> 6), NGW = cx.nb * 8, fr = lane & 15, fq = lane >> 4;
  char* ws = cx.ws;
  const bf16_t* ACT = (const bf16_t*)(ws + O_ACT); const bf16_t* KR = (const bf16_t*)(ws + O_AKR); const bf16_t* VT = (const bf16_t*)(ws + O_AVT);
  bf16_t* O = (bf16_t*)(ws + O_U);
  for (int u = gw; u < (MROWS / 16) * 4; u += NGW) {
    const int g = u & 3, qb = u >> 2, row0 = qb * 16;
    const bool lat = row0 < NLAT;
    const int b = lat ? row0 >> 12 : (row0 - NLAT) >> 8, q0 = lat ? row0 & 4095 : 0;
    bf16x8 qf[4][2];
    float mrun[4], lrun[4], sink[4];
    f32x4 oacc[4][4];
#pragma unroll
    for (int hh = 0; hh < 4; ++hh) {
      const bf16_t* qp = ACT + (size_t)(row0 + fr) * 1536 + (g * 4 + hh) * 64 + 8 * fq;
      qf[hh][0] = *(const bf16x8*)qp; qf[hh][1] = *(const bf16x8*)(qp + 32);
      sink[hh] = IN(20)[g * 4 + hh]; mrun[hh] = sink[hh]; lrun[hh] = 0.f;
#pragma unroll
      for (int d2 = 0; d2 < 4; ++d2) oacc[hh][d2] = (f32x4){0.f, 0.f, 0.f, 0.f};
    }
    const bf16_t* kbase = KR + ((size_t)b * 4 + g) * TOKB * 64;
    const bf16_t* vbase = VT + ((size_t)b * 4 + g) * 64 * TOKB;
    int wlo = 0, whi = -1;
    if (lat) { wlo = max(0, q0 - 128) & ~31; whi = min(SEQ - 1, q0 + 143); }
    const int nwin = lat ? (whi - wlo) / 32 + 1 : 0;
    for (int ti = 0; ti < 8 + nwin; ++ti) {
      const bool isw = ti >= 8;
      const int kpos0 = isw ? wlo + (ti - 8) * 32 : 0;
      const int tk0 = isw ? LC + kpos0 : ti * 32;
      const bf16_t* kp = kbase + (size_t)(tk0 + fr) * 64 + 8 * fq;
      const bf16x8 k00 = *(const bf16x8*)kp, k01 = *(const bf16x8*)(kp + 32), k10 = *(const bf16x8*)(kp + 16 * 64), k11 = *(const bf16x8*)(kp + 16 * 64 + 32);
      bf16x8 vfr[4];
#pragma unroll
      for (int d2 = 0; d2 < 4; ++d2) {
        const bf16_t* vp = vbase + (size_t)(d2 * 16 + fr) * TOKB + tk0 + 4 * fq;
        vfr[d2] = mk8(*(const u32x2*)vp, *(const u32x2*)(vp + 16));
      }
      bool okm[8];
#pragma unroll
      for (int i = 0; i < 8; ++i) {
        const int kpos = kpos0 + (i >> 2) * 16 + 4 * fq + (i & 3), dlt = (q0 + fr) - kpos;
        okm[i] = !isw || (dlt <= 128 && dlt >= -128);
      }
#pragma unroll
      for (int hh = 0; hh < 4; ++hh) {
        f32x4 s0 = {0.f, 0.f, 0.f, 0.f}, s1 = {0.f, 0.f, 0.f, 0.f};
        s0 = MFMA16(k00, qf[hh][0], s0); s0 = MFMA16(k01, qf[hh][1], s0);
        s1 = MFMA16(k10, qf[hh][0], s1); s1 = MFMA16(k11, qf[hh][1], s1);
        float sv[8]; float tmax = -3.0e38f;
#pragma unroll
        for (int i = 0; i < 8; ++i) { sv[i] = okm[i] ? (i < 4 ? s0[i] : s1[i - 4]) : -3.0e38f; tmax = fmaxf(tmax, sv[i]); }
        tmax = fmaxf(tmax, shx(tmax, 16, lane)); tmax = fmaxf(tmax, shx(tmax, 32, lane));
        const float mnew = fmaxf(mrun[hh], tmax), scale = __expf(mrun[hh] - mnew);
        mrun[hh] = mnew;
        float pv[8];
#pragma unroll
        for (int i = 0; i < 8; ++i) pv[i] = okm[i] ? __expf(sv[i] - mnew) : 0.f;
        const u32x4 pu = {pk2(pv[0], pv[1]), pk2(pv[2], pv[3]), pk2(pv[4], pv[5]), pk2(pv[6], pv[7])};
        const float ps = ((bflo(pu.x) + bfhi(pu.x)) + (bflo(pu.y) + bfhi(pu.y))) + ((bflo(pu.z) + bfhi(pu.z)) + (bflo(pu.w) + bfhi(pu.w)));
        lrun[hh] = lrun[hh] * scale + ps;
        const bf16x8 pf = mk8(pu);
        float scq[4];
#pragma unroll
        for (int jj = 0; jj < 4; ++jj) scq[jj] = shi(scale, 4 * fq + jj);
#pragma unroll
        for (int d2 = 0; d2 < 4; ++d2) {
          f32x4 o = oacc[hh][d2];
          o[0] *= scq[0]; o[1] *= scq[1]; o[2] *= scq[2]; o[3] *= scq[3];
          oacc[hh][d2] = MFMA16(pf, vfr[d2], o);
        }
      }
    }
#pragma unroll
    for (int hh = 0; hh < 4; ++hh) {
      float l = lrun[hh];
      l += shx(l, 16, lane); l += shx(l, 32, lane);
      l += __expf(sink[hh] - mrun[hh]);
      const float inv = __builtin_amdgcn_rcpf(l);
      float iq[4];
#pragma unroll
      for (int jj = 0; jj < 4; ++jj) iq[jj] = shi(inv, 4 * fq + jj);
#pragma unroll
      for (int d2 = 0; d2 < 4; ++d2)
#pragma unroll
        for (int jj = 0; jj < 4; ++jj)
          O[nat(row0 + 4 * fq + jj, (g * 4 + hh) * 64 + d2 * 16 + fr, D)] = (bf16_t)(pk2(oacc[hh][d2][jj] * iq[jj], 0.f) & 0xffff);
    }
  }
}

__device__ __forceinline__ void sc_conv(const Params& p, const Ctx& cx) {
  const int gt = cx.bid * 512 + cx.tid, gs = cx.nb * 512;
  const bf16_t* ACT = (const bf16_t*)(cx.ws + O_ACT); bf16_t* O = (bf16_t*)(cx.ws + O_U);
  const float* cw = IN(23);
  for (int i = gt; i < MROWS * 128; i += gs) {
    const int row = i >> 7, c0 = (i & 127) * 8;
    int pos, seglen;
    if (row < NLAT) { pos = row & (SEQ - 1); seglen = SEQ; } else { pos = (row - NLAT) & (LC - 1); seglen = LC; }
    float accv[8];
#pragma unroll
    for (int e = 0; e < 8; ++e) accv[e] = 0.f;
#pragma unroll
    for (int k = 0; k < 3; ++k) {
      const int pp = pos + k - 1;
      if (pp < 0 || pp >= seglen) continue;
      const bf16_t* rp = ACT + (size_t)(row + k - 1) * 3072;
      const u32x4 cgv = *(const u32x4*)(rp + 1024 + c0), xtv = *(const u32x4*)(rp + 2048 + c0);
      const unsigned cu[4] = {cgv.x, cgv.y, cgv.z, cgv.w}, xu[4] = {xtv.x, xtv.y, xtv.z, xtv.w};
#pragma unroll
      for (int e = 0; e < 4; ++e) {
        accv[2 * e] += cw[k * D + c0 + 2 * e] * (bflo(cu[e]) * bflo(xu[e]));
        accv[2 * e + 1] += cw[k * D + c0 + 2 * e + 1] * (bfhi(cu[e]) * bfhi(xu[e]));
      }
    }
    const u32x4 bgv = *(const u32x4*)(ACT + (size_t)row * 3072 + c0);
    const unsigned bu[4] = {bgv.x, bgv.y, bgv.z, bgv.w};
    u32x4 o;
    o.x = pk2(bflo(bu[0]) * accv[0], bfhi(bu[0]) * accv[1]); o.y = pk2(bflo(bu[1]) * accv[2], bfhi(bu[1]) * accv[3]);
    o.z = pk2(bflo(bu[2]) * accv[4], bfhi(bu[2]) * accv[5]); o.w = pk2(bflo(bu[3]) * accv[6], bfhi(bu[3]) * accv[7]);
    *(u32x4*)(O + nat(row, c0, D)) = o;
  }
}

#define XB_TMO      128
#define XB_XCNT(j)  (256  + 64 * (j))
#define XB_XSUB(j)  (1280 + 64 * (j))
#define XB_XGEN(j)  (2304 + 64 * (j))
#define XB_TOP      3328
#define XB_TOPGEN   3392
#define XCD_BAR_WORDS 3456
#define XB_SPIN_CAP (1u << 18)
__device__ __forceinline__ unsigned xb_ld(unsigned* p)              { return __hip_atomic_load(p, __ATOMIC_RELAXED, __HIP_MEMORY_SCOPE_AGENT); }
__device__ __forceinline__ unsigned xb_add(unsigned* p, unsigned v) { return __hip_atomic_fetch_add(p, v, __ATOMIC_RELAXED, __HIP_MEMORY_SCOPE_AGENT); }
__device__ __forceinline__ unsigned xb_xcc_id() { return (unsigned)__builtin_amdgcn_s_getreg((3 << 11) | 20) & 0xFu; }
#define XB_SPIN(cond, bar) do { unsigned _sp = 0; while (cond) { __builtin_amdgcn_s_sleep(1); \
    if ((++_sp & 255u) == 0u) { if (xb_ld(&(bar)[XB_TMO])) break; if (_sp > XB_SPIN_CAP) { atomicAdd(&(bar)[XB_TMO], 1u); break; } } } } while (0)
__device__ __forceinline__ void xcd_barrier_complete(unsigned* bar, unsigned x, unsigned& nloc, unsigned& nx) {
  const unsigned G = gridDim.x;
  unsigned sum, cnt, mine, sp = 0u;
  for (;;) {
    sum = 0u; cnt = 0u; mine = 0u;
#pragma unroll
    for (unsigned j = 0; j < 16; ++j) { const unsigned c = xb_ld(&bar[XB_XCNT(j)]); sum += c; cnt += (c > 0u) ? 1u : 0u; mine = (j == x) ? c : mine; }
    if (sum == G) break;
    __builtin_amdgcn_s_sleep(1);
    if ((++sp & 255u) == 0u) { if (xb_ld(&bar[XB_TMO])) break; if (sp > XB_SPIN_CAP) { atomicAdd(&bar[XB_TMO], 1u); break; } }
  }
  nloc = mine > 0u ? mine : 1u; nx = cnt > 0u ? cnt : 1u;
}
__device__ __forceinline__ void xcd_barrier(unsigned* bar, unsigned x, volatile LAS unsigned* st) {
  asm volatile("s_waitcnt vmcnt(0)" ::: "memory");
  __syncthreads();
  if (threadIdx.x == 0) {
    __builtin_amdgcn_s_waitcnt(0);
    unsigned nloc = st[0], nx = st[1];
    if (nloc == 0u) { xcd_barrier_complete(bar, x, nloc, nx); st[0] = nloc; st[1] = nx; }
    const unsigned old = xb_add(&bar[XB_XSUB(x)], 1u);
    const unsigned gen = old / nloc;
    if (old + 1u == (gen + 1u) * nloc) {
      __builtin_amdgcn_fence(__ATOMIC_RELEASE, "agent");
      asm volatile("s_waitcnt vmcnt(0)" ::: "memory");
      const unsigned og = xb_add(&bar[XB_TOP], 1u);
      const unsigned tg = og / nx;
      if (og + 1u == (tg + 1u) * nx) xb_add(&bar[XB_TOPGEN], 1u);
      else XB_SPIN(xb_ld(&bar[XB_TOPGEN]) == tg, bar);
      __builtin_amdgcn_fence(__ATOMIC_ACQUIRE, "agent");
      xb_add(&bar[XB_XGEN(x)], 1u);
      asm volatile("s_waitcnt vmcnt(0)" ::: "memory");
    } else {
      XB_SPIN(xb_ld(&bar[XB_XGEN(x)]) == gen, bar);
      __builtin_amdgcn_fence(__ATOMIC_ACQUIRE, "agent");
      asm volatile("s_waitcnt vmcnt(0)" ::: "memory");
    }
  }
  __syncthreads();
}

#ifndef ENMASK
#define ENMASK 0xffff
#endif
#define EN(i) ((ENMASK >> (i)) & 1)
enum { OP_PRO = 0, OP_LN0, OP_LN1, OP_LNF, OP_FFI, OP_FFO, OP_UP, OP_M0, OP_GAT, OP_S, OP_M2, OP_FIN, OP_DN, OP_AQ, OP_APREP, OP_ACORE, OP_AO, OP_SI, OP_SCONV, OP_SO, OP_DNUP };
__global__ void __launch_bounds__(512) fwd_megakernel(Params p) {
  cg::grid_group grid = cg::this_grid();
  const int wave_s = __builtin_amdgcn_readfirstlane((int)threadIdx.x >> 6);
  volatile LAS unsigned* xst = (volatile LAS unsigned*)((LAS unsigned char*)lds_raw + (LDS_BYTES - 16));
  if (threadIdx.x == 0) { xst[0] = 0u; xst[1] = 0u; }
  __syncthreads();
  unsigned* xbar = (unsigned*)(p.ws + O_BAR);
  const unsigned xcc = xb_xcc_id();
  if (threadIdx.x == 0) (void)xb_add(&xbar[XB_XCNT(xcc)], 1u);
#ifdef DUP_OP
  int rep = 0;
#endif
  for (int ph = 0; ph < p.nph; ++ph) {
    const unsigned w = p.prog[ph];
    const int op = w & 255, a = (w >> 8) & 255, b = (w >> 16) & 255, c = (w >> 24) & 255;
#define MKCTX int z; asm volatile("s_mov_b32 %0, 0" : "=s"(z)); \
    GAS char* wsq = (GAS char*)p.ws; GAS float* outq = (GAS float*)p.out; int bidq = (int)blockIdx.x, nbq = (int)gridDim.x; \
    asm volatile("" : "+s"(wsq), "+s"(outq), "+s"(bidq), "+s"(nbq)); \
    const Ctx cx{wave_s * 64 + (int)__builtin_amdgcn_mbcnt_hi(~0u, __builtin_amdgcn_mbcnt_lo(~0u, (unsigned)z)), bidq, nbq, z, (char*)wsq, (float*)outq};
    if (EN(0) && op == OP_PRO) { MKCTX prologue(p, cx); }
    else if (EN(1) && op == OP_LN0) { MKCTX lnmod_phase<0>(p, cx, 0, 0, 0); }
    else if (EN(1) && op == OP_LN1) { MKCTX lnmod_phase<1>(p, cx, a, b, c); }
    else if (EN(1) && op == OP_LNF) { MKCTX lnmod_phase<2>(p, cx, a, 0, 0); }
    else if (EN(2) && op == OP_M0) { MKCTX ml_m0(p, cx, a); }
    else if (EN(3) && op == OP_GAT) { MKCTX ml_gates(p, cx, a); }
    else if (EN(4) && op == OP_S) { MKCTX ml_s(p, cx); }
    else if (EN(5) && op == OP_M2) { MKCTX ml_m2(p, cx); }
    else if (EN(6) && op == OP_FIN) { MKCTX ml_fin(p, cx, a); }
    else if (EN(7) && op == OP_APREP) { MKCTX at_prep(p, cx); }
    else if (EN(8) && op == OP_ACORE) { MKCTX at_core(p, cx); }
    else if (EN(9) && op == OP_SCONV) { MKCTX sc_conv(p, cx); }
    else if (EN(10)) {
      MKCTX
      char* ws = cx.ws;
      const RowMap idm{0, 0, 1 << 30};
      bf16_t* U = (bf16_t*)(ws + O_U); bf16_t* ACT = (bf16_t*)(ws + O_ACT);
      const float* MODT = (const float*)(ws + O_MODT);
      const int nrep = op == OP_DNUP ? 2 : 1;
      for (int rep = 0; rep < nrep; ++rep) {
        const int op2 = op == OP_DNUP ? (rep == 0 ? (int)OP_UP : (int)OP_DN) : op;
        const int c2 = (op == OP_DNUP && rep == 0) ? c + 1 : c;
        Ctx cg_ = cx;
        if (op == OP_DNUP && rep == 1) cg_.bid = (cx.bid + cx.nb - 32) % cx.nb;
        const bf16_t* A = U; const bf16_t* Bt; int K = 1024, nM = MROWS / 256, nN; RowMap am = idm, cm = idm;
        Epi E; E.kind = 2; E.O = ACT; E.ldc = 0; E.modl = MODT + (size_t)b * 9 * 9216; E.slot = 1; E.wgt = 1.0f;
        E.ln = b * 3 + 1 - 1;
        if (op2 == OP_FFI) { Bt = (const bf16_t*)(ws + O_WFI) + (size_t)a * 5632 * 1024; nN = 22; E.kind = 1; if (c) nM = NLAT / 256; }
        else if (op2 == OP_FFO) { A = ACT; Bt = (const bf16_t*)(ws + O_WFO) + (size_t)a * 1024 * 2816; K = 2816; nN = 4; E.slot = c & 3; E.wgt = 0.5f; E.ln = b * 3 + (c & 3) - 1; if (c & 4) nM = NLAT / 256; }
        else if (op2 == OP_UP) { Bt = (const bf16_t*)(ws + O_WUP) + (size_t)a * 4096 * 1024; nM = RG / 256; nN = 16; am = RowMap{c2 * GB * SEQ, NLAT + c2 * GB * LC, GB * SEQ / 256}; E.kind = 0; E.O = (bf16_t*)(ws + O_XZ); E.ldc = 4096; }
        else if (op2 == OP_DN) { A = (const bf16_t*)(ws + O_FIN); Bt = (const bf16_t*)(ws + O_WDN) + (size_t)a * 1024 * 2048; K = 2048; nM = RG / 256; nN = 4; cm = RowMap{c2 * GB * SEQ, NLAT + c2 * GB * LC, GB * SEQ / 256}; }
        else if (op2 == OP_AQ) { Bt = (const bf16_t*)(ws + O_WAQ); nN = 6; E.kind = 0; E.ldc = 1536; }
        else if (op2 == OP_AO) { Bt = (const bf16_t*)(ws + O_WAO); nN = 4; }
        else if (op2 == OP_SI) { Bt = (const bf16_t*)(ws + O_WSI); nN = 12; E.kind = 0; E.ldc = 3072; }
        else { Bt = (const bf16_t*)(ws + O_WSO); nN = 4; }
        gemm_phase(cg_, A, am, Bt, K, nM, nN, cm, E);
      }
    }
    if (ph == 0) grid.sync(); else xcd_barrier(xbar, xcc, xst);
#ifdef DUP_OP
    if (op == DUP_OP && rep + 1 < DUP_N) { ++rep; --ph; } else rep = 0;
#endif
  }
}

static int build_program(unsigned* prog) {
  int n = 0;
  auto W = [&](int op, int a, int b, int c) { prog[n++] = (unsigned)op | ((unsigned)a << 8) | ((unsigned)b << 16) | ((unsigned)c << 24); };
  W(OP_PRO, 0, 0, 0);
  W(OP_LN0, 0, 0, 0);
  for (int layer = 0; layer < DEPTH; ++layer) {
    const int kind = layer % 3, j = layer / 3;
    W(OP_FFI, layer * 2, layer, 0); W(OP_FFO, layer * 2, layer, 0);
    W(OP_LN1, layer * 3 + 0, layer, 1);
    if (kind == 0) {
      for (int g = 0; g < NG; ++g) { if (g == 0) W(OP_UP, j, layer, g); W(OP_M0, j, 0, 0); W(OP_GAT, j, 0, 0); W(OP_S, 0, 0, 0); W(OP_M2, 0, 0, 0); W(OP_FIN, j, 0, 0); W(g + 1 < NG ? OP_DNUP : OP_DN, j, layer, g); }
    } else if (kind == 1) { W(OP_AQ, 0, layer, 0); W(OP_APREP, 0, 0, 0); W(OP_ACORE, 0, 0, 0); W(OP_AO, 0, layer, 0); }
    else { W(OP_SI, 0, layer, 0); W(OP_SCONV, 0, 0, 0); W(OP_SO, 0, layer, 0); }
    W(OP_LN1, layer * 3 + 1, layer, 2);
    const int lo = (layer + 1 == DEPTH) ? 1 : 0;
    W(OP_FFI, layer * 2 + 1, layer, lo); W(OP_FFO, layer * 2 + 1, layer, 2 | (lo << 2));
    if (layer + 1 < DEPTH) W(OP_LN1, layer * 3 + 2, layer + 1, 0); else W(OP_LNF, layer * 3 + 2, 0, 0);
  }
  return n;
}

extern "C" void kernel_launch(void* const* d_in, const int* in_sizes, int n_in, void* d_out, int out_size, void* d_ws, size_t ws_size, hipStream_t stream) {
  static int grid_blocks = 0;
  if (!grid_blocks) {
    int dev = 0, cus = 0, per_cu = 0;
    (void)hipGetDevice(&dev);
    (void)hipDeviceGetAttribute(&cus, hipDeviceAttributeMultiprocessorCount, dev);
    (void)hipFuncSetAttribute((const void*)fwd_megakernel, hipFuncAttributeMaxDynamicSharedMemorySize, LDS_BYTES);
    (void)hipOccupancyMaxActiveBlocksPerMultiprocessor(&per_cu, fwd_megakernel, 512, LDS_BYTES);
    if (cus <= 0) cus = 256;
    grid_blocks = cus;
    if (ws_size < WS_END || n_in != 25) fprintf(stderr, "kernel_launch: workspace %zu < %zu or n_in %d != 25\n", ws_size, (size_t)WS_END, n_in);
    if (per_cu < 1) fprintf(stderr, "kernel_launch: occupancy query says %d blocks per CU\n", per_cu);
  }
  Params p{};
  for (int i = 0; i < 25; ++i) p.in[i] = (const float*)d_in[i];
  p.out = (float*)d_out; p.ws = (char*)d_ws;
  p.nph = build_program(p.prog);
  (void)hipMemsetAsync((char*)d_ws + O_BAR, 0, XCD_BAR_WORDS * 4, stream);
  void* args[] = {&p};
  hipError_t e = hipLaunchCooperativeKernel((void*)fwd_megakernel, dim3(grid_blocks), dim3(512), args, LDS_BYTES, stream);
  if (e != hipSuccess) fprintf(stderr, "cooperative launch failed: %s (grid %d)\n", hipGetErrorString(e), grid_blocks);
}
```

```cpp
#include <hip/hip_runtime.h>
#include <hip/hip_cooperative_groups.h>
#include <cstdio>
#include <cstdint>
namespace cg = cooperative_groups;

typedef unsigned short bf16_t;
typedef short bf16x8 __attribute__((ext_vector_type(8)));
typedef short bf16x4 __attribute__((ext_vector_type(4)));
typedef float f32x4 __attribute__((ext_vector_type(4)));
typedef unsigned u32x2 __attribute__((ext_vector_type(2)));
typedef unsigned u32x4 __attribute__((ext_vector_type(4)));

constexpr int D = 1024, NB = 8, SEQ = 4096, LC = 256, DEPTH = 4, FF = 2816, EI = 2048, DH = 512;
constexpr int NLAT = NB * SEQ, NCTX = NB * LC, MROWS = NLAT + NCTX;
constexpr int TOKB = LC + SEQ;
constexpr int NCH = TOKB / 64;
constexpr int GB = 2, NG = NB / GB, RG = GB * TOKB;
constexpr int NSEQ = GB * 8;
constexpr float ALPHA = 1.681792830507429f, LN_EPS = 1e-5f;
constexpr int LDS_BYTES = 144 * 1024;

constexpr size_t al256(size_t x) { return (x + 255) & ~(size_t)255; }
constexpr size_t O_WFI = 0;
constexpr size_t O_WFO = O_WFI + (size_t)8 * 5632 * 1024 * 2;
constexpr size_t O_WUP = O_WFO + (size_t)8 * 1024 * 2816 * 2;
constexpr size_t O_WDN = O_WUP + (size_t)2 * 4096 * 1024 * 2;
constexpr size_t O_WAQ = O_WDN + (size_t)2 * 1024 * 2048 * 2;
constexpr size_t O_WAO = O_WAQ + (size_t)1536 * 1024 * 2;
constexpr size_t O_WSI = O_WAO + (size_t)1024 * 1024 * 2;
constexpr size_t O_WSO = O_WSI + (size_t)3072 * 1024 * 2;
constexpr size_t O_WG = O_WSO + (size_t)1024 * 1024 * 2;
constexpr size_t O_MODT = O_WG + (size_t)2 * 16 * 6144 * 2;
constexpr size_t O_ROPE = O_MODT + (size_t)4 * 9 * 9216 * 4;
constexpr size_t O_HCTX = O_ROPE + (size_t)2 * 4096 * 32 * 4;
constexpr size_t O_U = O_HCTX + (size_t)NCTX * D * 4;
constexpr size_t O_R = O_U + (size_t)MROWS * D * 2;
constexpr size_t O_XZ = O_R;
constexpr size_t O_QK = O_XZ + (size_t)RG * 4096 * 2;
constexpr size_t O_KT = O_QK + (size_t)RG * 4096 * 2;
constexpr size_t O_VT = O_KT + (size_t)GB * EI * TOKB * 2;
constexpr size_t O_SP = O_VT + (size_t)GB * EI * TOKB * 2;
constexpr size_t O_HD = O_SP + (size_t)NSEQ * NCH * 4096 * 2;
constexpr size_t O_FIN = O_HD + (size_t)2 * RG * EI * 2;
constexpr size_t O_GAT = O_FIN + (size_t)RG * EI * 2;
constexpr size_t SZ_ST = (size_t)NSEQ * TOKB * 4;
constexpr size_t O_BL = O_GAT, O_IG = O_BL + SZ_ST, O_WIN = O_IG + SZ_ST, O_FLO = O_WIN + SZ_ST, O_DEN = O_FLO + SZ_ST, O_WSS = O_DEN + SZ_ST;
constexpr size_t O_GC = O_WSS + SZ_ST;
constexpr size_t O_QF = O_GC + (size_t)3 * NSEQ * NCH * 4 + 256;
constexpr size_t O_REND_ML = O_QF + (size_t)GB * EI * TOKB * 2;
constexpr size_t O_ACT = O_R;
constexpr size_t O_AKR = O_R + (size_t)MROWS * 3072 * 2;
constexpr size_t O_AVT = O_AKR + (size_t)NB * 4 * TOKB * 64 * 2;
constexpr size_t O_REND_AT = O_AVT + (size_t)NB * 4 * TOKB * 64 * 2;
constexpr size_t O_BAR = (O_REND_ML > O_REND_AT ? O_REND_ML : O_REND_AT);
constexpr size_t O_STATS = O_BAR + 3456 * 4 + 256;
constexpr size_t O_LNT = O_STATS + (size_t)MROWS * 8 + 256;
constexpr size_t WS_END = O_LNT + (size_t)12 * 2 * D * 4 + 256;

struct Params {
  const float* in[25];
  float* out;
  char* ws;
  int nph; int pad0;
  unsigned prog[126];
};

#define GAS __attribute__((address_space(1)))
#define IN(k) ((const float*)(const GAS float*)p.in[(k) + cx.z])
struct Ctx { int tid, bid, nb, z; char* ws; float* out; };
extern __shared__ __attribute__((aligned(16))) char lds_raw[];

__device__ __forceinline__ unsigned pk2(float lo, float hi) { unsigned r; asm("v_cvt_pk_bf16_f32 %0, %1, %2" : "=v"(r) : "v"(lo), "v"(hi)); return r; }
__device__ __forceinline__ float bf2f(unsigned short v) { return __uint_as_float(((unsigned)v) << 16); }
__device__ __forceinline__ float bflo(unsigned v) { return __uint_as_float(v << 16); }
__device__ __forceinline__ float bfhi(unsigned v) { return __uint_as_float(v & 0xffff0000u); }
__device__ __forceinline__ float silu_f(float x) { return x * __builtin_amdgcn_rcpf(1.f + __expf(-x)); }
__device__ __forceinline__ float sigm_f(float x) { return __builtin_amdgcn_rcpf(1.f + __expf(-x)); }
__device__ __forceinline__ float shi(float v, int srclane) { return __int_as_float(__builtin_amdgcn_ds_bpermute(srclane << 2, __float_as_int(v))); }
__device__ __forceinline__ float shx(float v, int m, int lane) { return shi(v, lane ^ m); }
__device__ __forceinline__ float wave_sum(float v, int lane) {
#pragma unroll
  for (int o = 1; o < 64; o <<= 1) v += shx(v, o, lane);
  return v;
}
__device__ __forceinline__ bf16x8 mk8(u32x4 v) { union { u32x4 u; bf16x8 b; } x; x.u = v; return x.b; }
__device__ __forceinline__ bf16x8 mk8(u32x2 a, u32x2 b) { union { u32x4 u; bf16x8 b; } x; x.u = (u32x4){a.x, a.y, b.x, b.y}; return x.b; }
__device__ __forceinline__ float* hrow(const Ctx& cx, int row) { return row < NLAT ? cx.out + (size_t)row * D : (float*)(cx.ws + O_HCTX) + (size_t)(row - NLAT) * D; }
#define MFMA16(a, b, c) __builtin_amdgcn_mfma_f32_16x16x32_bf16(a, b, c, 0, 0, 0)
__device__ __forceinline__ size_t nat(int r, int c, int K) { return ((size_t)(r >> 4) * (K >> 5) + (c >> 5)) * 512 + (r & 15) * 32 + (c & 31); }

constexpr int BM = 256, BK = 64, HALF = 128, HT = HALF * BK, NXCD = 8, WGM = 4;
__device__ __forceinline__ int lds_byte(int r, int c) {
  int st = (r >> 4) * 2 + (c >> 5), rr = r & 15, cc = c & 31, ob = rr * 64 + cc * 2;
  return st * 1024 + (ob ^ (((ob >> 9) & 1) << 5));
}
__device__ __forceinline__ void stage_rc(int b, int& R, int& C) {
  int st = b / 1024, sb = b % 1024, swz = sb ^ (((sb >> 9) & 1) << 5);
  R = (st >> 1) * 16 + swz / 64; C = (st & 1) * 32 + (swz % 64) / 2;
}
struct RowMap { int lat0, ctx0, nlat; __device__ __forceinline__ int row0(int pm) const { return pm < nlat ? lat0 + pm * 256 : ctx0 + (pm - nlat) * 256; } };

typedef f32x4 Acc[2][2][4][2];

struct Epi {
  int kind; bf16_t* O; int ldc; const float* modl; int slot; float wgt;
  int ln;
};
__device__ __forceinline__ void run_epi(const Ctx& cx, const Epi E, const Acc& acc, int r0, int pn, int wr, int wc, int fr, int fq) {
  if (E.kind == 0) {
#pragma unroll
    for (int ai = 0; ai < 2; ++ai)
#pragma unroll
      for (int m = 0; m < 4; ++m) {
        bf16_t* rp = E.O + (size_t)(r0 + ai * HALF + wr * 64 + m * 16 + fr) * E.ldc + pn * 256 + wc * 32 + 4 * fq;
#pragma unroll
        for (int bj = 0; bj < 2; ++bj)
#pragma unroll
          for (int n = 0; n < 2; ++n) {
            f32x4 v = acc[ai][bj][m][n];
            u32x2 o; o.x = pk2(v[0], v[1]); o.y = pk2(v[2], v[3]);
            *(u32x2*)(rp + bj * HALF + n * 16) = o;
          }
      }
  } else if (E.kind == 1) {
#pragma unroll
    for (int ai = 0; ai < 2; ++ai)
#pragma unroll
      for (int m = 0; m < 4; ++m) {
        const int rrow = r0 + ai * HALF + wr * 64 + m * 16 + fr, fcol = pn * 128 + wc * 16 + 4 * fq;
#pragma unroll
        for (int bj = 0; bj < 2; ++bj) {
          f32x4 g = acc[ai][bj][m][0], v = acc[ai][bj][m][1];
          u32x2 o; o.x = pk2(silu_f(g[0]) * v[0], silu_f(g[1]) * v[1]); o.y = pk2(silu_f(g[2]) * v[2], silu_f(g[3]) * v[3]);
          *(u32x2*)(E.O + nat(rrow, fcol + bj * 64, FF)) = o;
        }
      }
  } else {
    const int midx = r0 < NLAT ? (r0 >> 12) : 8;
    const int cb = pn * 256 + wc * 32 + 4 * fq;
    const float* gp = E.modl + (size_t)midx * 9216 + (3 * E.slot + 2) * D + cb;
    f32x4 gv[2][2], lg[2][2], lb[2][2];
#pragma unroll
    for (int bj = 0; bj < 2; ++bj)
#pragma unroll
      for (int n = 0; n < 2; ++n) {
        gv[bj][n] = *(const f32x4*)(gp + bj * HALF + n * 16) * E.wgt;
        if (E.ln >= 0) { const float* lt = (const float*)(cx.ws + O_LNT) + (size_t)E.ln * 2 * D + cb + bj * HALF + n * 16; lg[bj][n] = *(const f32x4*)lt; lb[bj][n] = *(const f32x4*)(lt + D); }
        else { lg[bj][n] = (f32x4){1.f, 1.f, 1.f, 1.f}; lb[bj][n] = (f32x4){0.f, 0.f, 0.f, 0.f}; }
      }
#pragma unroll
    for (int ai = 0; ai < 2; ++ai)
#pragma unroll
      for (int m = 0; m < 4; ++m) {
        const int row = r0 + ai * HALF + wr * 64 + m * 16 + fr;
        float* rp = hrow(cx, row) + cb;
        float mean = 0.f, rstd = 1.f;
        if (E.ln >= 0) { const float2 st = *(const float2*)((const float*)(cx.ws + O_STATS) + (size_t)row * 2); mean = st.x; rstd = st.y; }
        f32x4 h[2][2];
#pragma unroll
        for (int bj = 0; bj < 2; ++bj)
#pragma unroll
          for (int n = 0; n < 2; ++n) h[bj][n] = *(const f32x4*)(rp + bj * HALF + n * 16);
#pragma unroll
        for (int bj = 0; bj < 2; ++bj)
#pragma unroll
          for (int n = 0; n < 2; ++n) *(f32x4*)(rp + bj * HALF + n * 16) = ((h[bj][n] - mean) * rstd) * lg[bj][n] + lb[bj][n] + gv[bj][n] * acc[ai][bj][m][n];
        __builtin_amdgcn_sched_barrier(0);
      }
  }
}

#define LAS __attribute__((address_space(3)))
__device__ __forceinline__ void gemm_phase(const Ctx& cx, const bf16_t* __restrict__ A, RowMap am, const bf16_t* __restrict__ Bt, int K, int nM, int nN, RowMap cm, const Epi epi) {
  LAS unsigned char* lds = (LAS unsigned char*)lds_raw;
  constexpr int HTB = HT * 2;
  const int tid = cx.tid, wid = tid >> 6, lane = tid & 63, wr = wid >> 2, wc = wid & 3, fr = lane & 15, fq = lane >> 4;
  unsigned voff[2];
#pragma unroll
  for (int i = 0; i < 2; ++i) { const int st = wid + 8 * i, sb = lane * 16; voff[i] = (unsigned)(((st >> 1) * (K >> 5) + (st & 1)) * 1024 + (sb ^ (((sb >> 9) & 1) << 5))); }
  const size_t kstep = 2048, hstep = (size_t)8 * (K >> 5) * 1024;
  const unsigned ldsw = (unsigned)wid * 1024u;
  const int aoff = lds_byte(wr * 64 + fr, fq * 8), boff = lds_byte(wc * 32 + fr, fq * 8);
#define G_SA(b, h) (((b) * 2 + (h)) * HTB)
#define G_SB(b, h) ((4 + (b) * 2 + (h)) * HTB)
#define STAGE(bufoff, gbase) do { _Pragma("unroll") for (int _i = 0; _i < 2; ++_i) \
    __builtin_amdgcn_global_load_lds((const unsigned*)((const char*)(gbase) + voff[_i]), (LAS unsigned*)(lds + (bufoff) + ldsw + _i * 8192), 16, 0, 0); } while (0)
#define LDA(dst, b, h) do { _Pragma("unroll") for (int m = 0; m < 4; ++m) _Pragma("unroll") for (int k = 0; k < 2; ++k) dst[m][k] = *(const LAS bf16x8*)(lds + G_SA(b, h) + aoff + m * 2048 + k * 1024); } while (0)
#define LDB(dst, b, h) do { _Pragma("unroll") for (int n = 0; n < 2; ++n) _Pragma("unroll") for (int k = 0; k < 2; ++k) dst[n][k] = *(const LAS bf16x8*)(lds + G_SB(b, h) + boff + n * 2048 + k * 1024); } while (0)
#define MMA(ai, bj, At, Bt_) do { __builtin_amdgcn_s_setprio(1); _Pragma("unroll") for (int m = 0; m < 4; ++m) _Pragma("unroll") for (int n = 0; n < 2; ++n) _Pragma("unroll") for (int k = 0; k < 2; ++k) \
      acc[ai][bj][m][n] = MFMA16(Bt_[n][k], At[m][k], acc[ai][bj][m][n]); \
    __builtin_amdgcn_s_setprio(0); } while (0)
#define WAIT_V(n) asm volatile("s_waitcnt vmcnt(" #n ")" ::: "memory")
#define WAIT_L(n) asm volatile("s_waitcnt lgkmcnt(" #n ")" ::: "memory")
#define BAR __builtin_amdgcn_s_barrier()
#define SCHED __builtin_amdgcn_sched_barrier(0)
  const int nwg = nM * nN;
  const int nt = K / BK;
  const int wid_s = __builtin_amdgcn_readfirstlane(wid);
#define DECODE(L_, pm_, pn_) do { int wgid = (L_); \
    { int q = nwg / NXCD, r = nwg % NXCD, xcd = wgid % NXCD, off = wgid / NXCD; wgid = (xcd < r ? xcd * (q + 1) : r * (q + 1) + (xcd - r) * q) + off; } \
    const int nig = WGM * nN, gid = wgid / nig, fm = gid * WGM, gsz = min(nM - fm, WGM); \
    pm_ = fm + ((wgid % nig) % gsz); pn_ = (wgid % nig) / gsz; } while (0)
  int L = cx.bid;
  if (L < nwg) {
    int pm, pn;
    DECODE(L, pm, pn);
    const char* cA = (const char*)A + (size_t)(am.row0(pm) >> 4) * (K >> 5) * 1024; const char* cB = (const char*)Bt + (size_t)(pn * BM >> 4) * (K >> 5) * 1024;
    Acc acc;
#pragma unroll
    for (int a = 0; a < 2; ++a)
#pragma unroll
      for (int b = 0; b < 2; ++b)
#pragma unroll
        for (int m = 0; m < 4; ++m)
#pragma unroll
          for (int n = 0; n < 2; ++n) acc[a][b][m][n] = (f32x4){0.f, 0.f, 0.f, 0.f};
    bf16x8 At[4][2], B0[2][2], B1[2][2];
    STAGE(G_SB(0, 0), cB); STAGE(G_SA(0, 0), cA); STAGE(G_SB(0, 1), cB + hstep); STAGE(G_SA(0, 1), cA + hstep);
    if (wr == 1) BAR;
    WAIT_V(4); BAR;
    STAGE(G_SB(1, 0), cB + kstep); STAGE(G_SA(1, 0), cA + kstep); STAGE(G_SB(1, 1), cB + hstep + kstep);
    WAIT_V(6); BAR;
    for (;;) {
      const int Ln = L + cx.nb;
      const bool has_next = Ln < nwg;
      int pmn = pm, pnn = pn;
      if (has_next) DECODE(Ln, pmn, pnn);
      const char* nA = has_next ? (const char*)A + (size_t)(am.row0(pmn) >> 4) * (K >> 5) * 1024 : cA; const char* nB = has_next ? (const char*)Bt + (size_t)(pnn * BM >> 4) * (K >> 5) * 1024 : cB;
      for (int t = 0; t < nt; t += 2) {
        const bool last = (t == nt - 2);
        const char* a1 = cA + (size_t)(t + 1) * kstep;
        const char* a2 = last ? nA : cA + (size_t)(t + 2) * kstep; const char* b2 = last ? nB : cB + (size_t)(t + 2) * kstep;
        const char* a3 = a2 + kstep; const char* b3 = b2 + kstep;
        LDB(B0, 0, 0); SCHED; LDA(At, 0, 0); STAGE(G_SA(1, 1), a1 + hstep);
        WAIT_L(8); BAR; WAIT_L(0); MMA(0, 0, At, B0); BAR; SCHED;
        LDB(B1, 0, 1); STAGE(G_SB(0, 0), b2);
        BAR; WAIT_L(0); MMA(0, 1, At, B1); BAR;
        LDA(At, 0, 1); STAGE(G_SA(0, 0), a2);
        BAR; WAIT_L(0); MMA(1, 0, At, B0); BAR; SCHED;
        STAGE(G_SB(0, 1), b2 + hstep);
        WAIT_V(6); BAR; MMA(1, 1, At, B1); BAR;
        LDB(B0, 1, 0); SCHED; LDA(At, 1, 0); STAGE(G_SA(0, 1), a2 + hstep);
        WAIT_L(8); BAR; WAIT_L(0); MMA(0, 0, At, B0); BAR; SCHED;
        LDB(B1, 1, 1); STAGE(G_SB(1, 0), b3);
        BAR; WAIT_L(0); MMA(0, 1, At, B1); BAR;
        LDA(At, 1, 1); STAGE(G_SA(1, 0), a3);
        BAR; WAIT_L(0); MMA(1, 0, At, B0); BAR; SCHED;
        STAGE(G_SB(1, 1), b3 + hstep);
        WAIT_V(6); BAR; MMA(1, 1, At, B1); BAR;
      }
      { int t2 = wid_s * 64 + (int)__builtin_amdgcn_mbcnt_hi(~0u, __builtin_amdgcn_mbcnt_lo(~0u, (unsigned)cx.z)); asm volatile("" : "+v"(t2));
        const int w2 = t2 >> 6, l2 = t2 & 63;
        run_epi(cx, epi, acc, cm.row0(pm), pn, w2 >> 2, w2 & 3, l2 & 15, l2 >> 4); }
      if (!has_next) break;
#pragma unroll
      for (int a = 0; a < 2; ++a)
#pragma unroll
        for (int b = 0; b < 2; ++b)
#pragma unroll
          for (int m = 0; m < 4; ++m)
#pragma unroll
            for (int n = 0; n < 2; ++n) acc[a][b][m][n] = (f32x4){0.f, 0.f, 0.f, 0.f};
      pm = pmn; pn = pnn; cA = nA; cB = nB; L = Ln;
    }
    WAIT_V(0);
    if (wr == 0) BAR;
    BAR;
  }
  __syncthreads();
}

template <int MODE>
__device__ __forceinline__ int wrow(int c) {
  if (MODE == 0) return c;
  const int isv = c >= FF ? 1 : 0, f = c - isv * FF;
  return (f >> 7) * 256 + ((f >> 6) & 1) * 128 + ((f >> 4) & 3) * 32 + isv * 16 + (f & 15);
}
template <int MODE>
__device__ __forceinline__ void transpose_item(const float* __restrict__ W, int K, int N, bf16_t* __restrict__ WT, float* scr, int item, int lane) {
  const int nblk = N / 32, kb = item / nblk, nb = item % nblk, k0 = 64 * kb, n0 = 32 * nb;
#pragma unroll 8
  for (int i = 0; i < 32; ++i) { const int kk = 2 * i + (lane >> 5); scr[kk * 33 + (lane & 31)] = W[(size_t)(k0 + kk) * N + n0 + (lane & 31)]; }
  __builtin_amdgcn_wave_barrier(); asm volatile("s_waitcnt lgkmcnt(0)" ::: "memory");
  const int c = lane & 7;
#pragma unroll
  for (int j = 0; j < 4; ++j) {
    const int n = (lane >> 3) + 8 * j; const float* s = scr + (8 * c) * 33 + n;
    u32x4 o; o.x = pk2(s[0 * 33], s[1 * 33]); o.y = pk2(s[2 * 33], s[3 * 33]); o.z = pk2(s[4 * 33], s[5 * 33]); o.w = pk2(s[6 * 33], s[7 * 33]);
    *(u32x4*)(WT + nat(wrow<MODE>(n0 + n), k0 + 8 * c, K)) = o;
  }
  asm volatile("s_waitcnt lgkmcnt(0)" ::: "memory"); __builtin_amdgcn_wave_barrier();
}

__device__ __forceinline__ void prologue(const Params& p, const Ctx& cx) {
  const int tid = cx.tid, lane = tid & 63, wave = tid >> 6;
  char* ws = cx.ws;
  {
    float* cond = (float*)lds_raw;
    float* red = (float*)(lds_raw + 9 * 1024 * 4);
    for (int i = tid; i < 9 * 1024; i += 512) { const int j = i >> 10, k = i & 1023; cond[i] = silu_f(j < 8 ? IN(1)[j * 1024 + k] : IN(3)[k]); }
    __syncthreads();
    for (int u = cx.bid; u < 4 * 36; u += cx.nb) {
      const int layer = u / 36, ct = u % 36, c0 = ct * 256 + 4 * lane;
      const float* wp = IN(4) + (size_t)layer * D * 9216 + c0;
      f32x4 a[9];
#pragma unroll
      for (int j = 0; j < 9; ++j) a[j] = (f32x4){0.f, 0.f, 0.f, 0.f};
#pragma unroll 4
      for (int k = wave * 128; k < wave * 128 + 128; ++k) {
        const f32x4 w = *(const f32x4*)(wp + (size_t)k * 9216);
#pragma unroll
        for (int j = 0; j < 9; ++j) a[j] += w * cond[j * 1024 + k];
      }
#pragma unroll
      for (int j = 0; j < 9; ++j) *(f32x4*)(red + (wave * 9 + j) * 256 + 4 * lane) = a[j];
      __syncthreads();
      float* mt = (float*)(ws + O_MODT) + (size_t)layer * 9 * 9216;
      for (int i = tid; i < 9 * 256; i += 512) {
        const int j = i >> 8, c = i & 255; float s = 0.f;
#pragma unroll
        for (int w = 0; w < 8; ++w) s += red[(w * 9 + j) * 256 + c];
        mt[(size_t)j * 9216 + ct * 256 + c] = s + IN(5)[layer * 9216 + ct * 256 + c];
      }
      __syncthreads();
    }
    __syncthreads();
  }
  {
    float* scr = (float*)lds_raw + wave * (64 * 33);
    const int gw = cx.bid * 8 + wave, NGW = cx.nb * 8;
    constexpr int I_FI = 16 * 176, I_FO = 44 * 32, I_UP = 16 * 128, I_DN = 32 * 32, I_AQ = 16 * 48, I_AO = 16 * 32, I_SI = 16 * 96, I_SO = 16 * 32;
    constexpr int NITEMS = 8 * I_FI + 8 * I_FO + 2 * I_UP + 2 * I_DN + I_AQ + I_AO + I_SI + I_SO;
    for (int it = gw; it < NITEMS; it += NGW) {
      int r = it;
      if (r < 8 * I_FI) { const int mi = r / I_FI; transpose_item<1>(IN(8) + (size_t)mi * 1024 * 5632, 1024, 5632, (bf16_t*)(ws + O_WFI) + (size_t)mi * 5632 * 1024, scr, r % I_FI, lane); continue; } r -= 8 * I_FI;
      if (r < 8 * I_FO) { const int mi = r / I_FO; transpose_item<0>(IN(9) + (size_t)mi * 2816 * 1024, 2816, 1024, (bf16_t*)(ws + O_WFO) + (size_t)mi * 1024 * 2816, scr, r % I_FO, lane); continue; } r -= 8 * I_FO;
      if (r < 2 * I_UP) { const int mi = r / I_UP; transpose_item<0>(IN(10) + (size_t)mi * 1024 * 4096, 1024, 4096, (bf16_t*)(ws + O_WUP) + (size_t)mi * 4096 * 1024, scr, r % I_UP, lane); continue; } r -= 2 * I_UP;
      if (r < 2 * I_DN) { const int mi = r / I_DN; transpose_item<0>(IN(18) + (size_t)mi * 2048 * 1024, 2048, 1024, (bf16_t*)(ws + O_WDN) + (size_t)mi * 1024 * 2048, scr, r % I_DN, lane); continue; } r -= 2 * I_DN;
      if (r < I_AQ) { transpose_item<0>(IN(19), 1024, 1536, (bf16_t*)(ws + O_WAQ), scr, r, lane); continue; } r -= I_AQ;
      if (r < I_AO) { transpose_item<0>(IN(21), 1024, 1024, (bf16_t*)(ws + O_WAO), scr, r, lane); continue; } r -= I_AO;
      if (r < I_SI) { transpose_item<0>(IN(22), 1024, 3072, (bf16_t*)(ws + O_WSI), scr, r, lane); continue; } r -= I_SI;
      transpose_item<0>(IN(24), 1024, 1024, (bf16_t*)(ws + O_WSO), scr, r, lane);
    }
  }
  {
    const int gt = cx.bid * 512 + tid, gs = cx.nb * 512;
    bf16_t* wg = (bf16_t*)(ws + O_WG);
    for (int i = gt; i < 2 * 16 * 6144; i += gs) {
      const int j = i / (16 * 6144), xg = (i / 6144) & 15, k = i % 6144, x = xg >> 3, g = xg & 7;
      const float* wif = IN(14) + (size_t)(j * 2 + x) * 6144 * 8;
      float v;
      const int knat = (k & ~31) + 16 * ((k >> 2) & 1) + 4 * ((k >> 3) & 3) + (k & 3);
      if (k < 2048) v = wif[(size_t)knat * 8 + g];
      else if (k < 4096) v = wif[(size_t)knat * 8 + g] * 22.627416997969522f;
      else {
        const int c = k - 4096, blk = c >> 2, cc = c & 3;
        const float* wv = IN(13) + ((size_t)(j * 3 + 2) * 512 + blk) * 16 + cc * 4;
        v = 0.f;
        for (int d2 = 0; d2 < 4; ++d2) v += wv[d2] * wif[(size_t)(4096 + 4 * blk + d2) * 8 + g];
      }
      wg[i] = (bf16_t)(pk2(v, 0.f) & 0xffff);
    }
    { float* lnt = (float*)(ws + O_LNT); for (int i = gt; i < 12 * D; i += gs) { const int l = i / D, c2 = i % D; lnt[(size_t)l * 2 * D + c2] = IN(6)[i] * ALPHA; lnt[(size_t)l * 2 * D + D + c2] = IN(7)[i] * ALPHA; } }
    float* rc = (float*)(ws + O_ROPE); float* rs = rc + 4096 * 32;
    for (int i = gt; i < 4096 * 32; i += gs) {
      const int pos = i >> 5, pp = i & 31, jf = pp & 15;
      const float fr_ = __builtin_amdgcn_exp2f(-(float)jf * (13.287712379549449f / 16.f));
      float rev = (float)(pp < 16 ? (pos >> 6) : (pos & 63)) * fr_ * 0.15915494309189535f;
      rev -= rintf(rev);
      rc[i] = __builtin_amdgcn_cosf(rev); rs[i] = __builtin_amdgcn_sinf(rev);
    }
  }
}

template <int MODE>
__device__ __forceinline__ void lnmod_phase(const Params& p, const Ctx& cx, int lnidx  , int layer, int slot) {
  const int lane = cx.tid & 63, gw = cx.bid * 8 + (cx.tid >> 6), NGW = cx.nb * 8;
  const int nrows = MODE == 2 ? NLAT : MROWS;
  const float* lg = IN(6) + (size_t)lnidx * D; const float* lb = IN(7) + (size_t)lnidx * D;
  const float* modl = (const float*)(cx.ws + O_MODT) + (size_t)layer * 9 * 9216;
  bf16_t* U = (bf16_t*)(cx.ws + O_U);
  for (int row = gw; row < nrows; row += NGW) {
    float* hp = hrow(cx, row);
    const float* src = MODE == 0 ? (row < NLAT ? IN(0) + (size_t)row * D : IN(2) + (size_t)(row - NLAT) * D) : hp;
    f32x4 v[4];
#pragma unroll
    for (int j = 0; j < 4; ++j) v[j] = *(const f32x4*)(src + 4 * lane + 256 * j);
    if (MODE != 0) {
      float s = 0.f;
#pragma unroll
      for (int j = 0; j < 4; ++j) s += (v[j][0] + v[j][1]) + (v[j][2] + v[j][3]);
      const float mean = wave_sum(s, lane) * (1.f / D); float s2 = 0.f;
#pragma unroll
      for (int j = 0; j < 4; ++j) { v[j] = v[j] - mean; s2 += (v[j][0] * v[j][0] + v[j][1] * v[j][1]) + (v[j][2] * v[j][2] + v[j][3] * v[j][3]); }
      const float rstd = __builtin_amdgcn_rsqf(wave_sum(s2, lane) * (1.f / D) + LN_EPS);
      if (MODE == 1 && lane == 0) *(float2*)((float*)(cx.ws + O_STATS) + (size_t)row * 2) = make_float2(mean, rstd);
#pragma unroll
      for (int j = 0; j < 4; ++j) v[j] = v[j] * rstd * *(const f32x4*)(lg + 4 * lane + 256 * j) + *(const f32x4*)(lb + 4 * lane + 256 * j);
    }
    if (MODE != 1) {
#pragma unroll
      for (int j = 0; j < 4; ++j) *(f32x4*)(hp + 4 * lane + 256 * j) = MODE == 0 ? v[j] * ALPHA : v[j];
    }
    if (MODE != 2) {
      const int midx = row < NLAT ? (row >> 12) : 8;
      const float* sh = modl + (size_t)midx * 9216 + (3 * slot) * D; const float* sc = sh + D;
#pragma unroll
      for (int j = 0; j < 4; ++j) {
        const f32x4 u = v[j] * (*(const f32x4*)(sc + 4 * lane + 256 * j) + 1.f) + *(const f32x4*)(sh + 4 * lane + 256 * j);
        u32x2 o; o.x = pk2(u[0], u[1]); o.y = pk2(u[2], u[3]);
        *(u32x2*)(U + nat(row, 4 * lane + 256 * j, D)) = o;
      }
    }
  }
}

__device__ __forceinline__ int ml_lrow(int bl, int tok) { return tok < LC ? GB * SEQ + bl * LC + tok : bl * SEQ + (tok - LC); }
__device__ __forceinline__ int ml_nchunk(int x, int st) { return x == 0 ? st : (st < 4 ? 3 - st : 71 - st); }

__device__ __forceinline__ void ml_m0(const Params& p, const Ctx& cx, int j) {
  const int tid = cx.tid;
  char* ws = cx.ws;
  const bf16_t* XZ = (const bf16_t*)(ws + O_XZ);
  bf16_t* QK = (bf16_t*)(ws + O_QK); bf16_t* KT = (bf16_t*)(ws + O_KT); bf16_t* VT = (bf16_t*)(ws + O_VT); bf16_t* QF = (bf16_t*)(ws + O_QF);
  const int blk_l = tid & 63, tq = tid >> 6;
  for (int u = cx.bid; u < GB * NCH * 8; u += cx.nb) {
    const int slab = u & 7, ch = (u >> 3) % NCH, bl = u / (8 * NCH);
    const int f0 = slab * 256 + blk_l * 4, blk = f0 >> 2;
    float cw[3][4], cb[4], wq[16], wk[16], wv[16];
#pragma unroll
    for (int k = 0; k < 3; ++k)
#pragma unroll
      for (int c = 0; c < 4; ++c) cw[k][c] = IN(11)[(size_t)(j * 3 + k) * EI + f0 + c];
#pragma unroll
    for (int c = 0; c < 4; ++c) cb[c] = IN(12)[(size_t)j * EI + f0 + c];
#pragma unroll
    for (int i = 0; i < 16; ++i) {
      wq[i] = IN(13)[((size_t)(j * 3 + 0) * 512 + blk) * 16 + i];
      wk[i] = IN(13)[((size_t)(j * 3 + 1) * 512 + blk) * 16 + i] * 0.04419417382415922f;
      wv[i] = IN(13)[((size_t)(j * 3 + 2) * 512 + blk) * 16 + i];
    }
    const int tok0 = ch * 64, seg_lo = tok0 < LC ? 0 : LC, seg_hi = tok0 < LC ? LC : TOKB;
    const int tl0 = tq * 8;
    float xmp[4], xmc[4], xmn[4];
    {
      const int t2 = tok0 + tl0 - 1;
      if (t2 >= seg_lo) { const u32x2 r = *(const u32x2*)(XZ + (size_t)ml_lrow(bl, t2) * 4096 + f0); xmp[0] = bflo(r.x); xmp[1] = bfhi(r.x); xmp[2] = bflo(r.y); xmp[3] = bfhi(r.y); }
      else { xmp[0] = xmp[1] = xmp[2] = xmp[3] = 0.f; }
      const u32x2 r = *(const u32x2*)(XZ + (size_t)ml_lrow(bl, tok0 + tl0) * 4096 + f0); xmc[0] = bflo(r.x); xmc[1] = bfhi(r.x); xmc[2] = bflo(r.y); xmc[3] = bfhi(r.y);
    }
    unsigned kpk[4][4], vpk[4][4];
    float kprev[4], vprev[4];
    const int fp = (f0 & ~31) + 8 * ((f0 >> 2) & 3) + 4 * ((f0 >> 4) & 1);
#pragma unroll
    for (int tt = 0; tt < 8; ++tt) {
      const int tl = tl0 + tt, tok = tok0 + tl;
      if (tok + 1 < seg_hi) { const u32x2 r = *(const u32x2*)(XZ + (size_t)ml_lrow(bl, tok + 1) * 4096 + f0); xmn[0] = bflo(r.x); xmn[1] = bfhi(r.x); xmn[2] = bflo(r.y); xmn[3] = bfhi(r.y); }
      else { xmn[0] = xmn[1] = xmn[2] = xmn[3] = 0.f; }
      float xc[4], q[4], kk[4], vv[4];
#pragma unroll
      for (int c = 0; c < 4; ++c) xc[c] = silu_f(cw[0][c] * xmp[c] + cw[1][c] * xmc[c] + cw[2][c] * xmn[c] + cb[c]);
#pragma unroll
      for (int d2 = 0; d2 < 4; ++d2) {
        q[d2] = xc[0] * wq[d2] + xc[1] * wq[4 + d2] + xc[2] * wq[8 + d2] + xc[3] * wq[12 + d2];
        kk[d2] = xc[0] * wk[d2] + xc[1] * wk[4 + d2] + xc[2] * wk[8 + d2] + xc[3] * wk[12 + d2];
        vv[d2] = xmc[0] * wv[d2] + xmc[1] * wv[4 + d2] + xmc[2] * wv[8 + d2] + xmc[3] * wv[12 + d2];
      }
      const size_t lr = ml_lrow(bl, tok);
      u32x2 oq, ok; oq.x = pk2(q[0], q[1]); oq.y = pk2(q[2], q[3]); ok.x = pk2(kk[0], kk[1]); ok.y = pk2(kk[2], kk[3]);
      *(u32x2*)(QF + ((((((size_t)bl * NCH + ch) * 4 + (f0 >> 9)) * 8 + ((f0 >> 6) & 7)) * 4 + (tl >> 4)) * 2 + ((f0 >> 5) & 1)) * 512 + (tl & 15) * 32 + 8 * ((f0 >> 2) & 3) + 4 * ((f0 >> 4) & 1)) = oq;
      *(u32x2*)(QK + lr * 4096 + 2048 + fp) = ok;
      if (tt & 1) {
#pragma unroll
        for (int c = 0; c < 4; ++c) { kpk[c][tt >> 1] = pk2(kprev[c], kk[c]); vpk[c][tt >> 1] = pk2(vprev[c], vv[c]); }
      } else {
#pragma unroll
        for (int c = 0; c < 4; ++c) { kprev[c] = kk[c]; vprev[c] = vv[c]; }
      }
#pragma unroll
      for (int c = 0; c < 4; ++c) { xmp[c] = xmc[c]; xmc[c] = xmn[c]; }
    }
#pragma unroll
    for (int c = 0; c < 4; ++c) {
      const int feat = f0 + c;
      const size_t off = (((size_t)bl * NCH + ch) * (EI / 16) + (feat >> 4)) * 1024 + (tq >> 2) * 512 + (feat & 15) * 32 + (tq & 3) * 8;
      *(u32x4*)(KT + off) = (u32x4){kpk[c][0], kpk[c][1], kpk[c][2], kpk[c][3]};
      *(u32x4*)(VT + off) = (u32x4){vpk[c][0], vpk[c][1], vpk[c][2], vpk[c][3]};
    }
  }
}

__device__ __forceinline__ void ml_gates(const Params& p, const Ctx& cx, int j) {
  const int tid = cx.tid, lane = tid & 63, wave = tid >> 6, fr = lane & 15, fq = lane >> 4;
  char* ws = cx.ws;
  const bf16_t* XZ = (const bf16_t*)(ws + O_XZ); const bf16_t* QK = (const bf16_t*)(ws + O_QK); const bf16_t* QF = (const bf16_t*)(ws + O_QF);
  const bf16_t* WG = (const bf16_t*)(ws + O_WG) + (size_t)j * 16 * 6144;
  float* BL = (float*)(ws + O_BL); float* IG = (float*)(ws + O_IG);
  float* GC = (float*)(ws + O_GC); float* AC = GC + NSEQ * NCH;
  float* part = (float*)lds_raw;
  float* gl = part + 8 * 64 * 16;
  for (int u = cx.bid; u < GB * NCH; u += cx.nb) {
    const int bl = u / NCH, nc = u % NCH, tok0 = nc * 64;
    f32x4 acc[4];
#pragma unroll
    for (int m = 0; m < 4; ++m) acc[m] = (f32x4){0.f, 0.f, 0.f, 0.f};
    size_t lr[4];
#pragma unroll
    for (int m = 0; m < 4; ++m) lr[m] = ml_lrow(bl, tok0 + m * 16 + fr);
#pragma unroll 4
    for (int ks = wave * 24; ks < wave * 24 + 24; ++ks) {
      const int k = ks * 32 + fq * 8;
      const bf16x8 bfr = *(const bf16x8*)(WG + (size_t)fr * 6144 + k);
#pragma unroll
      for (int m = 0; m < 4; ++m) {
        const bf16_t* ap = k < 2048 ? QF + ((((((size_t)bl * NCH + nc) * 4 + (k >> 9)) * 8 + ((k >> 6) & 7)) * 4 + m) * 2 + ((k >> 5) & 1)) * 512 + fr * 32 + 8 * fq
                         : k < 4096 ? QK + lr[m] * 4096 + k : XZ + lr[m] * 4096 + (k - 4096);
        const bf16x8 afr = *(const bf16x8*)ap;
        acc[m] = MFMA16(afr, bfr, acc[m]);
      }
    }
#pragma unroll
    for (int m = 0; m < 4; ++m)
#pragma unroll
      for (int jj = 0; jj < 4; ++jj) part[(wave * 64 + m * 16 + 4 * fq + jj) * 16 + fr] = acc[m][jj];
    __syncthreads();
    for (int i = tid; i < 1024; i += 512) {
      float s = IN(15)[(size_t)j * 16 + (i & 15)];
#pragma unroll
      for (int w = 0; w < 8; ++w) s += part[w * 1024 + i];
      gl[(i >> 4) * 17 + (i & 15)] = s;
    }
    __syncthreads();
    {
      const int x = wave >> 2, h = wave & 3, seq = (bl * 2 + x) * 4 + h;
      const int tl = x == 0 ? lane : 63 - lane;
      const float ig = gl[tl * 17 + x * 8 + h], fg = gl[tl * 17 + x * 8 + 4 + h];
      float b = fg > 0.f ? -__logf(1.f + __expf(-fg)) : fg - __logf(1.f + __expf(fg));
#pragma unroll
      for (int o = 1; o < 64; o <<= 1) { const float t2 = shi(b, lane - o); if (lane >= o) b += t2; }
      BL[(size_t)seq * TOKB + tok0 + tl] = b; IG[(size_t)seq * TOKB + tok0 + tl] = ig;
      float mx = ig - b;
#pragma unroll
      for (int o = 1; o < 64; o <<= 1) mx = fmaxf(mx, shx(mx, o, lane));
      const float g = shi(b, 63);
      if (lane == 0) { GC[seq * NCH + nc] = g; AC[seq * NCH + nc] = g + mx; }
    }
    __syncthreads();
  }
}

__device__ __forceinline__ void ml_s(const Params& p, const Ctx& cx) {
  const int tid = cx.tid, lane = tid & 63, wave = tid >> 6, fr = lane & 15, fq = lane >> 4;
  char* ws = cx.ws;
  const bf16_t* QK = (const bf16_t*)(ws + O_QK);
  bf16_t* SP = (bf16_t*)(ws + O_SP);
  const float* BL = (const float*)(ws + O_BL); const float* IG = (const float*)(ws + O_IG);
  float* WIN = (float*)(ws + O_WIN); float* FLO = (float*)(ws + O_FLO); float* DEN = (float*)(ws + O_DEN); float* WSS = (float*)(ws + O_WSS);
  const float* GC = (const float*)(ws + O_GC); const float* AC = GC + NSEQ * NCH; float* DEC = (float*)(ws + O_GC) + 2 * NSEQ * NCH;
  float* sb_ = (float*)lds_raw + wave * 256; float* si_ = sb_ + 64; float* smt = si_ + 64;
  const int gw = cx.bid * 8 + wave, NGW = cx.nb * 8;
  for (int u = gw; u < NSEQ * NCH; u += NGW) {
    const int seq = u / NCH, st = u % NCH, x = (seq >> 2) & 1, h = seq & 3, bl = seq >> 3;
    const int nc = ml_nchunk(x, st), tok0 = nc * 64;
    const int nl0 = ml_nchunk(x, lane), nl1 = ml_nchunk(x, 64 + (lane & 3));
    const float g0 = GC[seq * NCH + nl0], a0 = AC[seq * NCH + nl0], g1 = GC[seq * NCH + nl1], a1 = AC[seq * NCH + nl1];
    const int tl = x == 0 ? lane : 63 - lane;
    const float b = BL[(size_t)seq * TOKB + tok0 + tl], ig = IG[(size_t)seq * TOKB + tok0 + tl];
    float mc = 0.f;
    for (int s2 = 0; s2 < st; ++s2) {
      const float gg = __int_as_float(__builtin_amdgcn_readlane(__float_as_int(s2 < 64 ? g0 : g1), s2 & 63));
      const float aa = __int_as_float(__builtin_amdgcn_readlane(__float_as_int(s2 < 64 ? a0 : a1), s2 & 63));
      mc = fmaxf(gg + mc, aa);
    }
    const float gc = __int_as_float(__builtin_amdgcn_readlane(__float_as_int(st < 64 ? g0 : g1), st & 63));
    const float ac = __int_as_float(__builtin_amdgcn_readlane(__float_as_int(st < 64 ? a0 : a1), st & 63));
    const float mnew = fmaxf(gc + mc, ac);
    float cm = ig - b;
#pragma unroll
    for (int o = 1; o < 64; o <<= 1) { const float t2 = shi(cm, lane - o); if (lane >= o) cm = fmaxf(cm, t2); }
    const float mt = b + fmaxf(mc, cm);
    sb_[tl] = b; si_[tl] = ig; smt[tl] = mt;
    WIN[(size_t)seq * TOKB + tok0 + tl] = __expf(b + mc - mt);
    FLO[(size_t)seq * TOKB + tok0 + tl] = __expf(-mt);
    WSS[(size_t)seq * TOKB + tok0 + tl] = __expf(gc - b + ig - mnew);
    if (lane == 0) DEC[seq * NCH + nc] = __expf(gc + mc - mnew);
    f32x4 acc[4][4];
#pragma unroll
    for (int a = 0; a < 4; ++a)
#pragma unroll
      for (int c2 = 0; c2 < 4; ++c2) acc[a][c2] = (f32x4){0.f, 0.f, 0.f, 0.f};
    const bf16_t* rowp[4];
#pragma unroll
    for (int a = 0; a < 4; ++a) rowp[a] = QK + (size_t)ml_lrow(bl, tok0 + a * 16 + fr) * 4096 + h * DH + fq * 8;
    const bf16_t* qfb = (const bf16_t*)(ws + O_QF) + ((((size_t)bl * NCH + nc) * 4 + h) * 8) * 4 * 2 * 512 + fr * 32 + 8 * fq;
#pragma unroll 2
    for (int ks = 0; ks < 16; ++ks) {
      bf16x8 kf[4], qf[4];
#pragma unroll
      for (int a = 0; a < 4; ++a) { kf[a] = *(const bf16x8*)(rowp[a] + 2048 + ks * 32); qf[a] = *(const bf16x8*)(qfb + (((size_t)(ks >> 1) * 4 + a) * 2 + (ks & 1)) * 512); }
#pragma unroll
      for (int a = 0; a < 4; ++a)
#pragma unroll
        for (int c2 = 0; c2 < 4; ++c2) acc[a][c2] = MFMA16(kf[a], qf[c2], acc[a][c2]);
    }
    __builtin_amdgcn_wave_barrier(); asm volatile("s_waitcnt lgkmcnt(0)" ::: "memory");
    bf16_t* spu = SP + (size_t)(seq * NCH + nc) * 4096;
#pragma unroll
    for (int tb = 0; tb < 4; ++tb) {
      const int t = tb * 16 + fr;
      const float bt = sb_[t], mtt = smt[t];
      float dsum = 0.f;
#pragma unroll
      for (int sbk = 0; sbk < 4; ++sbk) {
        float vals[4];
#pragma unroll
        for (int jj = 0; jj < 4; ++jj) {
          const int s = sbk * 16 + 4 * fq + jj;
          const bool ok = x == 0 ? (s <= t) : (s >= t);
          vals[jj] = ok ? acc[sbk][tb][jj] * __expf(bt - sb_[s] + si_[s] - mtt) : 0.f;
        }
        u32x2 o; o.x = pk2(vals[0], vals[1]); o.y = pk2(vals[2], vals[3]);
        *(u32x2*)(spu + tb * 1024 + ((sbk * 16 + 4 * fq) >> 5) * 512 + fr * 32 + ((sbk * 16 + 4 * fq) & 31)) = o;
        dsum += (bflo(o.x) + bfhi(o.x)) + (bflo(o.y) + bfhi(o.y));
      }
      dsum += shx(dsum, 16, lane); dsum += shx(dsum, 32, lane);
      if (fq == 0) DEN[(size_t)seq * TOKB + tok0 + t] = dsum;
    }
    __builtin_amdgcn_wave_barrier(); asm volatile("s_waitcnt lgkmcnt(0)" ::: "memory");
  }
}

constexpr int NEB = 2, NSL = 512 / (16 * NEB);
__device__ __forceinline__ void ml_m2(const Params& p, const Ctx& cx) {
  const int tid = cx.tid, lane = tid & 63, wave = tid >> 6, fr = lane & 15, fq = lane >> 4;
  char* ws = cx.ws;
  const bf16_t* QK = (const bf16_t*)(ws + O_QK); const bf16_t* KT = (const bf16_t*)(ws + O_KT); const bf16_t* VT = (const bf16_t*)(ws + O_VT);
  const bf16_t* SP = (const bf16_t*)(ws + O_SP); const bf16_t* QF = (const bf16_t*)(ws + O_QF);
  bf16_t* HD = (bf16_t*)(ws + O_HD);
  const float* WIN = (const float*)(ws + O_WIN); const float* FLO = (const float*)(ws + O_FLO); const float* DEN = (const float*)(ws + O_DEN); const float* WSS = (const float*)(ws + O_WSS);
  const float* DEC = (const float*)(ws + O_GC) + 2 * NSEQ * NCH;
  f32x4* red = (f32x4*)lds_raw;
  f32x4* rn = (f32x4*)(lds_raw + 131072);
  for (int idx = cx.bid >> 3; idx < 2 * NSL; idx += cx.nb >> 3) {
    const int seq = (cx.bid & 7) * 2 + idx / NSL, es = idx % NSL, x = (seq >> 2) & 1, h = seq & 3, bl = seq >> 3;
    const int d0 = wave * 64, e0 = es * 16 * NEB;
    f32x4 C[4][NEB + 1];
#pragma unroll
    for (int a = 0; a < 4; ++a)
#pragma unroll
      for (int b = 0; b < NEB + 1; ++b) C[a][b] = (f32x4){0.f, 0.f, 0.f, 0.f};
    const int tbo = wave >> 1, ebo = __builtin_amdgcn_readfirstlane(wave & 1);
    bf16x8 qc[4][2], kf[4][2], sf0, sf1;
    u32x4 vr[NEB][2];
    f32x4 wv[2][2];
#define M2_LOAD_Q(ST) do { const int _nq = ml_nchunk(x, (ST)); _Pragma("unroll") for (int tb = 0; tb < 4; ++tb) { \
        const bf16_t* qp = QF + ((((((size_t)bl * NCH + _nq) * 4 + h) * 8 + wave) * 4 + tb) * 2) * 512 + fr * 32 + 8 * fq; \
        qc[tb][0] = *(const bf16x8*)qp; qc[tb][1] = *(const bf16x8*)(qp + 512); } } while (0)
#define M2_LOAD_KV(ST) do { const int _nc = ml_nchunk(x, (ST)), _t0 = _nc * 64; \
        _Pragma("unroll") for (int db = 0; db < 4; ++db) { const bf16_t* kp = KT + (((size_t)bl * NCH + _nc) * (EI / 16) + ((h * DH + d0) >> 4) + db) * 1024 + fr * 32 + 8 * fq; \
          kf[db][0] = *(const bf16x8*)kp; kf[db][1] = *(const bf16x8*)(kp + 512); } \
        _Pragma("unroll") for (int eb = 0; eb < NEB; ++eb) { const bf16_t* vp = VT + (((size_t)bl * NCH + _nc) * (EI / 16) + ((h * DH + e0) >> 4) + eb) * 1024 + fr * 32 + 8 * fq; \
          vr[eb][0] = *(const u32x4*)vp; vr[eb][1] = *(const u32x4*)(vp + 512); } \
        _Pragma("unroll") for (int ks = 0; ks < 2; ++ks) { const float* wp = WSS + (size_t)seq * TOKB + _t0 + 32 * ks + 8 * fq; \
          wv[ks][0] = *(const f32x4*)wp; wv[ks][1] = *(const f32x4*)(wp + 4); } \
        const bf16_t* sp = SP + (size_t)(seq * NCH + _nc) * 4096 + tbo * 1024 + fr * 32 + 8 * fq; \
        sf0 = *(const bf16x8*)sp; sf1 = *(const bf16x8*)(sp + 512); } while (0)
    const int hd_lane = (tbo * 16 + 4 * fq) * EI + h * DH + e0 + ebo * 16 + fr;
    M2_LOAD_Q(0); M2_LOAD_KV(0);
    for (int st = 0; st < NCH; ++st) {
      const int nc = ml_nchunk(x, st), tok0 = nc * 64, stn = st + 1 < NCH ? st + 1 : st;
      const size_t tix = (size_t)seq * TOKB + tok0 + tbo * 16 + 4 * fq;
      const f32x4 win = *(const f32x4*)(WIN + tix), flo = *(const f32x4*)(FLO + tix), deni = *(const f32x4*)(DEN + tix);
      const float decay = DEC[seq * NCH + nc];
#pragma unroll
      for (int eb = 0; eb < NEB + 1; ++eb) {
        bf16x8 cb0, cb1;
        { const f32x4 lo = C[0][eb], hi = C[1][eb]; cb0 = mk8((u32x4){pk2(lo[0], lo[1]), pk2(lo[2], lo[3]), pk2(hi[0], hi[1]), pk2(hi[2], hi[3])}); }
        { const f32x4 lo = C[2][eb], hi = C[3][eb]; cb1 = mk8((u32x4){pk2(lo[0], lo[1]), pk2(lo[2], lo[3]), pk2(hi[0], hi[1]), pk2(hi[2], hi[3])}); }
        f32x4 pa[4];
#pragma unroll
        for (int tb = 0; tb < 4; ++tb) pa[tb] = MFMA16(qc[tb][0], cb0, ((f32x4){0.f, 0.f, 0.f, 0.f}));
#pragma unroll
        for (int tb = 0; tb < 4; ++tb) pa[tb] = MFMA16(qc[tb][1], cb1, pa[tb]);
#pragma unroll
        for (int tb = 0; tb < 4; ++tb) {
          if (eb < NEB) red[((wave * 4 + tb) * NEB + eb) * 64 + lane] = pa[tb];
          else if (fr == 0) rn[(wave * 4 + tb) * 4 + fq] = pa[tb];
        }
      }
      M2_LOAD_Q(stn);
      f32x4 oi = {0.f, 0.f, 0.f, 0.f};
#pragma unroll
      for (int eb = 0; eb < NEB + 1; ++eb) {
        bf16x8 vw0, vw1;
        if (eb < NEB) {
          const u32x4 r0 = vr[eb][0], r1 = vr[eb][1];
          if (eb == ebo) { oi = MFMA16(sf0, mk8(r0), oi); oi = MFMA16(sf1, mk8(r1), oi); }
          vw0 = mk8((u32x4){pk2(bflo(r0.x) * wv[0][0][0], bfhi(r0.x) * wv[0][0][1]), pk2(bflo(r0.y) * wv[0][0][2], bfhi(r0.y) * wv[0][0][3]),
                            pk2(bflo(r0.z) * wv[0][1][0], bfhi(r0.z) * wv[0][1][1]), pk2(bflo(r0.w) * wv[0][1][2], bfhi(r0.w) * wv[0][1][3])});
          vw1 = mk8((u32x4){pk2(bflo(r1.x) * wv[1][0][0], bfhi(r1.x) * wv[1][0][1]), pk2(bflo(r1.y) * wv[1][0][2], bfhi(r1.y) * wv[1][0][3]),
                            pk2(bflo(r1.z) * wv[1][1][0], bfhi(r1.z) * wv[1][1][1]), pk2(bflo(r1.w) * wv[1][1][2], bfhi(r1.w) * wv[1][1][3])});
        } else {
          vw0 = mk8((u32x4){pk2(wv[0][0][0], wv[0][0][1]), pk2(wv[0][0][2], wv[0][0][3]), pk2(wv[0][1][0], wv[0][1][1]), pk2(wv[0][1][2], wv[0][1][3])});
          vw1 = mk8((u32x4){pk2(wv[1][0][0], wv[1][0][1]), pk2(wv[1][0][2], wv[1][0][3]), pk2(wv[1][1][0], wv[1][1][1]), pk2(wv[1][1][2], wv[1][1][3])});
        }
#pragma unroll
        for (int db = 0; db < 4; ++db) {
          f32x4 c = C[db][eb] * decay;
          c = MFMA16(kf[db][0], vw0, c); c = MFMA16(kf[db][1], vw1, c);
          C[db][eb] = c;
        }
      }
      asm volatile("s_waitcnt lgkmcnt(0)" ::: "memory");
      __builtin_amdgcn_s_barrier();
      asm volatile("" ::: "memory");
      bf16_t* hdp = HD + ((size_t)x * RG + ml_lrow(bl, tok0)) * EI + hd_lane;
      f32x4 rdn[8], rd0[8];
#pragma unroll
      for (int w = 0; w < 8; ++w) { rdn[w] = rn[(w * 4 + tbo) * 4 + fq]; rd0[w] = red[((w * 4 + tbo) * NEB + ebo) * 64 + lane]; }
      const f32x4 pn = ((rdn[0] + rdn[1]) + (rdn[2] + rdn[3])) + ((rdn[4] + rdn[5]) + (rdn[6] + rdn[7]));
      const f32x4 pi = ((rd0[0] + rd0[1]) + (rd0[2] + rd0[3])) + ((rd0[4] + rd0[5]) + (rd0[6] + rd0[7]));
#pragma unroll
      for (int jj = 0; jj < 4; ++jj) {
        const float num = oi[jj] + win[jj] * pi[jj], den = deni[jj] + win[jj] * pn[jj];
        const float hv = num * __builtin_amdgcn_rcpf(fmaxf(fabsf(den), flo[jj]));
        hdp[(size_t)jj * EI] = (bf16_t)(pk2(hv, 0.f) & 0xffff);
      }
      M2_LOAD_KV(stn);
      asm volatile("s_waitcnt lgkmcnt(0)" ::: "memory");
      __builtin_amdgcn_s_barrier();
      asm volatile("" ::: "memory");
    }
    __syncthreads();
#undef M2_LOAD_Q
#undef M2_LOAD_KV
  }
}

__device__ __forceinline__ void ml_fin(const Params& p, const Ctx& cx, int j) {
  const int lane = cx.tid & 63, gw = cx.bid * 8 + (cx.tid >> 6), NGW = cx.nb * 8;
  char* ws = cx.ws;
  const bf16_t* XZ = (const bf16_t*)(ws + O_XZ); const bf16_t* HD = (const bf16_t*)(ws + O_HD);
  bf16_t* FIN = (bf16_t*)(ws + O_FIN);
  for (int u = gw; u < RG * 4; u += NGW) {
    const int lr = u >> 2, h = u & 3, f0 = h * DH + lane * 8;
    int pos, seglen;
    if (lr < GB * SEQ) { pos = lr & (SEQ - 1); seglen = SEQ; } else { pos = (lr - GB * SEQ) & (LC - 1); seglen = LC; }
    const u32x4 hf = *(const u32x4*)(HD + (size_t)lr * EI + f0), hb = *(const u32x4*)(HD + ((size_t)RG + lr) * EI + f0);
    const u32x4 zz = *(const u32x4*)(XZ + (size_t)lr * 4096 + 2048 + f0);
    const u32x4 x1 = *(const u32x4*)(XZ + (size_t)lr * 4096 + f0);
    u32x4 x0 = {0u, 0u, 0u, 0u}, x2 = {0u, 0u, 0u, 0u};
    if (pos > 0) x0 = *(const u32x4*)(XZ + (size_t)(lr - 1) * 4096 + f0);
    if (pos < seglen - 1) x2 = *(const u32x4*)(XZ + (size_t)(lr + 1) * 4096 + f0);
    float hv[8], xm0[8], xm1[8], xm2[8];
    const unsigned hfu[4] = {hf.x, hf.y, hf.z, hf.w}, hbu[4] = {hb.x, hb.y, hb.z, hb.w}, zu[4] = {zz.x, zz.y, zz.z, zz.w};
    const unsigned x0u[4] = {x0.x, x0.y, x0.z, x0.w}, x1u[4] = {x1.x, x1.y, x1.z, x1.w}, x2u[4] = {x2.x, x2.y, x2.z, x2.w};
    float s = 0.f;
#pragma unroll
    for (int i = 0; i < 4; ++i) {
      hv[2 * i] = (bflo(hfu[i]) + bflo(hbu[i])) * sigm_f(bflo(zu[i]));
      hv[2 * i + 1] = (bfhi(hfu[i]) + bfhi(hbu[i])) * sigm_f(bfhi(zu[i]));
      xm0[2 * i] = bflo(x0u[i]); xm0[2 * i + 1] = bfhi(x0u[i]); xm1[2 * i] = bflo(x1u[i]); xm1[2 * i + 1] = bfhi(x1u[i]); xm2[2 * i] = bflo(x2u[i]); xm2[2 * i + 1] = bfhi(x2u[i]);
      s += hv[2 * i] + hv[2 * i + 1];
    }
    const float mean = wave_sum(s, lane) * (1.f / DH); float s2 = 0.f;
#pragma unroll
    for (int i = 0; i < 8; ++i) { hv[i] -= mean; s2 += hv[i] * hv[i]; }
    const float rstd = __builtin_amdgcn_rsqf(wave_sum(s2, lane) * (1.f / DH) + LN_EPS);
    float o[8];
#pragma unroll
    for (int i = 0; i < 8; ++i) {
      const int f = f0 + i;
      const float xc = silu_f(IN(11)[(size_t)(j * 3 + 0) * EI + f] * xm0[i] + IN(11)[(size_t)(j * 3 + 1) * EI + f] * xm1[i] + IN(11)[(size_t)(j * 3 + 2) * EI + f] * xm2[i] + IN(12)[(size_t)j * EI + f]);
      o[i] = hv[i] * rstd * IN(17)[(size_t)j * EI + f] + IN(16)[(size_t)j * EI + f] * xc;
    }
    u32x4 ov; ov.x = pk2(o[0], o[1]); ov.y = pk2(o[2], o[3]); ov.z = pk2(o[4], o[5]); ov.w = pk2(o[6], o[7]);
    *(u32x4*)(FIN + nat(lr, f0, EI)) = ov;
  }
}

__device__ __forceinline__ void at_prep(const Params& p, const Ctx& cx) {
  const int lane = cx.tid & 63, gw = cx.bid * 8 + (cx.tid >> 6), NGW = cx.nb * 8;
  char* ws = cx.ws;
  bf16_t* ACT = (bf16_t*)(ws + O_ACT); bf16_t* KR = (bf16_t*)(ws + O_AKR); bf16_t* VT = (bf16_t*)(ws + O_AVT);
  const float* rc = (const float*)(ws + O_ROPE); const float* rs = rc + 4096 * 32;
  for (int row = gw; row < MROWS; row += NGW) {
    const bool lat = row < NLAT;
    const int b = lat ? row >> 12 : (row - NLAT) >> 8, pos = lat ? row & 4095 : (row - NLAT) & 255, tok = lat ? LC + pos : pos;
    bf16_t* rp = ACT + (size_t)row * 1536;
    {
      const u32x4 a = *(const u32x4*)(rp + 16 * lane), b2 = *(const u32x4*)(rp + 16 * lane + 8);
      const unsigned w[8] = {a.x, a.y, a.z, a.w, b2.x, b2.y, b2.z, b2.w};
      unsigned o[8];
      const int pp0 = (lane & 3) * 8;
#pragma unroll
      for (int i = 0; i < 8; ++i) {
        float x1 = bflo(w[i]) * 0.125f, x2 = bfhi(w[i]) * 0.125f;
        if (lat) { const float c = rc[pos * 32 + pp0 + i], s = rs[pos * 32 + pp0 + i]; const float y1 = x1 * c - x2 * s, y2 = x1 * s + x2 * c; x1 = y1; x2 = y2; }
        o[i] = pk2(x1, x2);
      }
      *(u32x4*)(rp + 16 * lane) = (u32x4){o[0], o[1], o[2], o[3]}; *(u32x4*)(rp + 16 * lane + 8) = (u32x4){o[4], o[5], o[6], o[7]};
    }
    {
      const u32x2 a = *(const u32x2*)(rp + 1024 + 4 * lane);
      const unsigned w[2] = {a.x, a.y}; unsigned o[2];
      const int g = lane >> 4, dd = (lane & 15) * 4, pp0 = dd >> 1;
#pragma unroll
      for (int i = 0; i < 2; ++i) {
        float x1 = bflo(w[i]), x2 = bfhi(w[i]);
        if (lat) { const float c = rc[pos * 32 + pp0 + i], s = rs[pos * 32 + pp0 + i]; const float y1 = x1 * c - x2 * s, y2 = x1 * s + x2 * c; x1 = y1; x2 = y2; }
        o[i] = pk2(x1, x2);
      }
      *(u32x2*)(KR + (((size_t)b * 4 + g) * TOKB + tok) * 64 + dd) = (u32x2){o[0], o[1]};
      const u32x2 v = *(const u32x2*)(rp + 1280 + 4 * lane);
      bf16_t* vp = VT + (((size_t)b * 4 + g) * 64 + dd) * TOKB + tok;
      vp[0] = (bf16_t)(v.x & 0xffff); vp[TOKB] = (bf16_t)(v.x >> 16); vp[2 * TOKB] = (bf16_t)(v.y & 0xffff); vp[3 * TOKB] = (bf16_t)(v.y >> 16);
    }
  }
}

__device__ __forceinline__ void at_core(const Params& p, const Ctx& cx) {
  const int lane = cx.tid & 63, gw = cx.bid * 8 + (cx.tid >> 6), NGW = cx.nb * 8, fr = lane & 15, fq = lane >> 4;
  char* ws = cx.ws;
  const bf16_t* ACT = (const bf16_t*)(ws + O_ACT); const bf16_t* KR = (const bf16_t*)(ws + O_AKR); const bf16_t* VT = (const bf16_t*)(ws + O_AVT);
  bf16_t* O = (bf16_t*)(ws + O_U);
  for (int u = gw; u < (MROWS / 16) * 4; u += NGW) {
    const int g = u & 3, qb = u >> 2, row0 = qb * 16;
    const bool lat = row0 < NLAT;
    const int b = lat ? row0 >> 12 : (row0 - NLAT) >> 8, q0 = lat ? row0 & 4095 : 0;
    bf16x8 qf[4][2];
    float mrun[4], lrun[4], sink[4];
    f32x4 oacc[4][4];
#pragma unroll
    for (int hh = 0; hh < 4; ++hh) {
      const bf16_t* qp = ACT + (size_t)(row0 + fr) * 1536 + (g * 4 + hh) * 64 + 8 * fq;
      qf[hh][0] = *(const bf16x8*)qp; qf[hh][1] = *(const bf16x8*)(qp + 32);
      sink[hh] = IN(20)[g * 4 + hh]; mrun[hh] = sink[hh]; lrun[hh] = 0.f;
#pragma unroll
      for (int d2 = 0; d2 < 4; ++d2) oacc[hh][d2] = (f32x4){0.f, 0.f, 0.f, 0.f};
    }
    const bf16_t* kbase = KR + ((size_t)b * 4 + g) * TOKB * 64;
    const bf16_t* vbase = VT + ((size_t)b * 4 + g) * 64 * TOKB;
    int wlo = 0, whi = -1;
    if (lat) { wlo = max(0, q0 - 128) & ~31; whi = min(SEQ - 1, q0 + 143); }
    const int nwin = lat ? (whi - wlo) / 32 + 1 : 0;
    for (int ti = 0; ti < 8 + nwin; ++ti) {
      const bool isw = ti >= 8;
      const int kpos0 = isw ? wlo + (ti - 8) * 32 : 0;
      const int tk0 = isw ? LC + kpos0 : ti * 32;
      const bf16_t* kp = kbase + (size_t)(tk0 + fr) * 64 + 8 * fq;
      const bf16x8 k00 = *(const bf16x8*)kp, k01 = *(const bf16x8*)(kp + 32), k10 = *(const bf16x8*)(kp + 16 * 64), k11 = *(const bf16x8*)(kp + 16 * 64 + 32);
      bf16x8 vfr[4];
#pragma unroll
      for (int d2 = 0; d2 < 4; ++d2) {
        const bf16_t* vp = vbase + (size_t)(d2 * 16 + fr) * TOKB + tk0 + 4 * fq;
        vfr[d2] = mk8(*(const u32x2*)vp, *(const u32x2*)(vp + 16));
      }
      bool okm[8];
#pragma unroll
      for (int i = 0; i < 8; ++i) {
        const int kpos = kpos0 + (i >> 2) * 16 + 4 * fq + (i & 3), dlt = (q0 + fr) - kpos;
        okm[i] = !isw || (dlt <= 128 && dlt >= -128);
      }
#pragma unroll
      for (int hh = 0; hh < 4; ++hh) {
        f32x4 s0 = {0.f, 0.f, 0.f, 0.f}, s1 = {0.f, 0.f, 0.f, 0.f};
        s0 = MFMA16(k00, qf[hh][0], s0); s0 = MFMA16(k01, qf[hh][1], s0);
        s1 = MFMA16(k10, qf[hh][0], s1); s1 = MFMA16(k11, qf[hh][1], s1);
        float sv[8]; float tmax = -3.0e38f;
#pragma unroll
        for (int i = 0; i < 8; ++i) { sv[i] = okm[i] ? (i < 4 ? s0[i] : s1[i - 4]) : -3.0e38f; tmax = fmaxf(tmax, sv[i]); }
        tmax = fmaxf(tmax, shx(tmax, 16, lane)); tmax = fmaxf(tmax, shx(tmax, 32, lane));
        const float mnew = fmaxf(mrun[hh], tmax), scale = __expf(mrun[hh] - mnew);
        mrun[hh] = mnew;
        float pv[8];
#pragma unroll
        for (int i = 0; i < 8; ++i) pv[i] = okm[i] ? __expf(sv[i] - mnew) : 0.f;
        const u32x4 pu = {pk2(pv[0], pv[1]), pk2(pv[2], pv[3]), pk2(pv[4], pv[5]), pk2(pv[6], pv[7])};
        const float ps = ((bflo(pu.x) + bfhi(pu.x)) + (bflo(pu.y) + bfhi(pu.y))) + ((bflo(pu.z) + bfhi(pu.z)) + (bflo(pu.w) + bfhi(pu.w)));
        lrun[hh] = lrun[hh] * scale + ps;
        const bf16x8 pf = mk8(pu);
        float scq[4];
#pragma unroll
        for (int jj = 0; jj < 4; ++jj) scq[jj] = shi(scale, 4 * fq + jj);
#pragma unroll
        for (int d2 = 0; d2 < 4; ++d2) {
          f32x4 o = oacc[hh][d2];
          o[0] *= scq[0]; o[1] *= scq[1]; o[2] *= scq[2]; o[3] *= scq[3];
          oacc[hh][d2] = MFMA16(pf, vfr[d2], o);
        }
      }
    }
#pragma unroll
    for (int hh = 0; hh < 4; ++hh) {
      float l = lrun[hh];
      l += shx(l, 16, lane); l += shx(l, 32, lane);
      l += __expf(sink[hh] - mrun[hh]);
      const float inv = __builtin_amdgcn_rcpf(l);
      float iq[4];
#pragma unroll
      for (int jj = 0; jj < 4; ++jj) iq[jj] = shi(inv, 4 * fq + jj);
#pragma unroll
      for (int d2 = 0; d2 < 4; ++d2)
#pragma unroll
        for (int jj = 0; jj < 4; ++jj)
          O[nat(row0 + 4 * fq + jj, (g * 4 + hh) * 64 + d2 * 16 + fr, D)] = (bf16_t)(pk2(oacc[hh][d2][jj] * iq[jj], 0.f) & 0xffff);
    }
  }
}

__device__ __forceinline__ void sc_conv(const Params& p, const Ctx& cx) {
  const int gt = cx.bid * 512 + cx.tid, gs = cx.nb * 512;
  const bf16_t* ACT = (const bf16_t*)(cx.ws + O_ACT); bf16_t* O = (bf16_t*)(cx.ws + O_U);
  const float* cw = IN(23);
  for (int i = gt; i < MROWS * 128; i += gs) {
    const int row = i >> 7, c0 = (i & 127) * 8;
    int pos, seglen;
    if (row < NLAT) { pos = row & (SEQ - 1); seglen = SEQ; } else { pos = (row - NLAT) & (LC - 1); seglen = LC; }
    float accv[8];
#pragma unroll
    for (int e = 0; e < 8; ++e) accv[e] = 0.f;
#pragma unroll
    for (int k = 0; k < 3; ++k) {
      const int pp = pos + k - 1;
      if (pp < 0 || pp >= seglen) continue;
      const bf16_t* rp = ACT + (size_t)(row + k - 1) * 3072;
      const u32x4 cgv = *(const u32x4*)(rp + 1024 + c0), xtv = *(const u32x4*)(rp + 2048 + c0);
      const unsigned cu[4] = {cgv.x, cgv.y, cgv.z, cgv.w}, xu[4] = {xtv.x, xtv.y, xtv.z, xtv.w};
#pragma unroll
      for (int e = 0; e < 4; ++e) {
        accv[2 * e] += cw[k * D + c0 + 2 * e] * (bflo(cu[e]) * bflo(xu[e]));
        accv[2 * e + 1] += cw[k * D + c0 + 2 * e + 1] * (bfhi(cu[e]) * bfhi(xu[e]));
      }
    }
    const u32x4 bgv = *(const u32x4*)(ACT + (size_t)row * 3072 + c0);
    const unsigned bu[4] = {bgv.x, bgv.y, bgv.z, bgv.w};
    u32x4 o;
    o.x = pk2(bflo(bu[0]) * accv[0], bfhi(bu[0]) * accv[1]); o.y = pk2(bflo(bu[1]) * accv[2], bfhi(bu[1]) * accv[3]);
    o.z = pk2(bflo(bu[2]) * accv[4], bfhi(bu[2]) * accv[5]); o.w = pk2(bflo(bu[3]) * accv[6], bfhi(bu[3]) * accv[7]);
    *(u32x4*)(O + nat(row, c0, D)) = o;
  }
}

#define XB_TMO      128
#define XB_XCNT(j)  (256  + 64 * (j))
#define XB_XSUB(j)  (1280 + 64 * (j))
#define XB_XGEN(j)  (2304 + 64 * (j))
#define XB_TOP      3328
#define XB_TOPGEN   3392
#define XCD_BAR_WORDS 3456
#define XB_SPIN_CAP (1u << 18)
__device__ __forceinline__ unsigned xb_ld(unsigned* p)              { return __hip_atomic_load(p, __ATOMIC_RELAXED, __HIP_MEMORY_SCOPE_AGENT); }
__device__ __forceinline__ unsigned xb_add(unsigned* p, unsigned v) { return __hip_atomic_fetch_add(p, v, __ATOMIC_RELAXED, __HIP_MEMORY_SCOPE_AGENT); }
__device__ __forceinline__ unsigned xb_xcc_id() { return (unsigned)__builtin_amdgcn_s_getreg((3 << 11) | 20) & 0xFu; }
#define XB_SPIN(cond, bar) do { unsigned _sp = 0; while (cond) { __builtin_amdgcn_s_sleep(1); \
    if ((++_sp & 255u) == 0u) { if (xb_ld(&(bar)[XB_TMO])) break; if (_sp > XB_SPIN_CAP) { atomicAdd(&(bar)[XB_TMO], 1u); break; } } } } while (0)
__device__ __forceinline__ void xcd_barrier_complete(unsigned* bar, unsigned x, unsigned& nloc, unsigned& nx) {
  const unsigned G = gridDim.x;
  unsigned sum, cnt, mine, sp = 0u;
  for (;;) {
    sum = 0u; cnt = 0u; mine = 0u;
#pragma unroll
    for (unsigned j = 0; j < 16; ++j) { const unsigned c = xb_ld(&bar[XB_XCNT(j)]); sum += c; cnt += (c > 0u) ? 1u : 0u; mine = (j == x) ? c : mine; }
    if (sum == G) break;
    __builtin_amdgcn_s_sleep(1);
    if ((++sp & 255u) == 0u) { if (xb_ld(&bar[XB_TMO])) break; if (sp > XB_SPIN_CAP) { atomicAdd(&bar[XB_TMO], 1u); break; } }
  }
  nloc = mine > 0u ? mine : 1u; nx = cnt > 0u ? cnt : 1u;
}
__device__ __forceinline__ void xcd_barrier(unsigned* bar, unsigned x, volatile LAS unsigned* st) {
  asm volatile("s_waitcnt vmcnt(0)" ::: "memory");
  __syncthreads();
  if (threadIdx.x == 0) {
    __builtin_amdgcn_s_waitcnt(0);
    unsigned nloc = st[0], nx = st[1];
    if (nloc == 0u) { xcd_barrier_complete(bar, x, nloc, nx); st[0] = nloc; st[1] = nx; }
    const unsigned old = xb_add(&bar[XB_XSUB(x)], 1u);
    const unsigned gen = old / nloc;
    if (old + 1u == (gen + 1u) * nloc) {
      __builtin_amdgcn_fence(__ATOMIC_RELEASE, "agent");
      asm volatile("s_waitcnt vmcnt(0)" ::: "memory");
      const unsigned og = xb_add(&bar[XB_TOP], 1u);
      const unsigned tg = og / nx;
      if (og + 1u == (tg + 1u) * nx) xb_add(&bar[XB_TOPGEN], 1u);
      else XB_SPIN(xb_ld(&bar[XB_TOPGEN]) == tg, bar);
      __builtin_amdgcn_fence(__ATOMIC_ACQUIRE, "agent");
      xb_add(&bar[XB_XGEN(x)], 1u);
      asm volatile("s_waitcnt vmcnt(0)" ::: "memory");
    } else {
      XB_SPIN(xb_ld(&bar[XB_XGEN(x)]) == gen, bar);
      __builtin_amdgcn_fence(__ATOMIC_ACQUIRE, "agent");
      asm volatile("s_waitcnt vmcnt(0)" ::: "memory");
    }
  }
  __syncthreads();
}

#ifndef ENMASK
#define ENMASK 0xffff
#endif
#define EN(i) ((ENMASK >> (i)) & 1)
enum { OP_PRO = 0, OP_LN0, OP_LN1, OP_LNF, OP_FFI, OP_FFO, OP_UP, OP_M0, OP_GAT, OP_S, OP_M2, OP_FIN, OP_DN, OP_AQ, OP_APREP, OP_ACORE, OP_AO, OP_SI, OP_SCONV, OP_SO, OP_DNUP };
__global__ void __launch_bounds__(512) fwd_megakernel(Params p) {
  cg::grid_group grid = cg::this_grid();
  const int wave_s = __builtin_amdgcn_readfirstlane((int)threadIdx.x >> 6);
  volatile LAS unsigned* xst = (volatile LAS unsigned*)((LAS unsigned char*)lds_raw + (LDS_BYTES - 16));
  if (threadIdx.x == 0) { xst[0] = 0u; xst[1] = 0u; }
  __syncthreads();
  unsigned* xbar = (unsigned*)(p.ws + O_BAR);
  const unsigned xcc = xb_xcc_id();
  if (threadIdx.x == 0) (void)xb_add(&xbar[XB_XCNT(xcc)], 1u);
#ifdef DUP_OP
  int rep = 0;
#endif
  for (int ph = 0; ph < p.nph; ++ph) {
    const unsigned w = p.prog[ph];
    const int op = w & 255, a = (w >> 8) & 255, b = (w >> 16) & 255, c = (w >> 24) & 255;
#define MKCTX int z; asm volatile("s_mov_b32 %0, 0" : "=s"(z)); \
    GAS char* wsq = (GAS char*)p.ws; GAS float* outq = (GAS float*)p.out; int bidq = (int)blockIdx.x, nbq = (int)gridDim.x; \
    asm volatile("" : "+s"(wsq), "+s"(outq), "+s"(bidq), "+s"(nbq)); \
    const Ctx cx{wave_s * 64 + (int)__builtin_amdgcn_mbcnt_hi(~0u, __builtin_amdgcn_mbcnt_lo(~0u, (unsigned)z)), bidq, nbq, z, (char*)wsq, (float*)outq};
    if (EN(0) && op == OP_PRO) { MKCTX prologue(p, cx); }
    else if (EN(1) && op == OP_LN0) { MKCTX lnmod_phase<0>(p, cx, 0, 0, 0); }
    else if (EN(1) && op == OP_LN1) { MKCTX lnmod_phase<1>(p, cx, a, b, c); }
    else if (EN(1) && op == OP_LNF) { MKCTX lnmod_phase<2>(p, cx, a, 0, 0); }
    else if (EN(2) && op == OP_M0) { MKCTX ml_m0(p, cx, a); }
    else if (EN(3) && op == OP_GAT) { MKCTX ml_gates(p, cx, a); }
    else if (EN(4) && op == OP_S) { MKCTX ml_s(p, cx); }
    else if (EN(5) && op == OP_M2) { MKCTX ml_m2(p, cx); }
    else if (EN(6) && op == OP_FIN) { MKCTX ml_fin(p, cx, a); }
    else if (EN(7) && op == OP_APREP) { MKCTX at_prep(p, cx); }
    else if (EN(8) && op == OP_ACORE) { MKCTX at_core(p, cx); }
    else if (EN(9) && op == OP_SCONV) { MKCTX sc_conv(p, cx); }
    else if (EN(10)) {
      MKCTX
      char* ws = cx.ws;
      const RowMap idm{0, 0, 1 << 30};
      bf16_t* U = (bf16_t*)(ws + O_U); bf16_t* ACT = (bf16_t*)(ws + O_ACT);
      const float* MODT = (const float*)(ws + O_MODT);
      const int nrep = op == OP_DNUP ? 2 : 1;
      for (int rep = 0; rep < nrep; ++rep) {
        const int op2 = op == OP_DNUP ? (rep == 0 ? (int)OP_UP : (int)OP_DN) : op;
        const int c2 = (op == OP_DNUP && rep == 0) ? c + 1 : c;
        Ctx cg_ = cx;
        if (op == OP_DNUP && rep == 1) cg_.bid = (cx.bid + cx.nb - 32) % cx.nb;
        const bf16_t* A = U; const bf16_t* Bt; int K = 1024, nM = MROWS / 256, nN; RowMap am = idm, cm = idm;
        Epi E; E.kind = 2; E.O = ACT; E.ldc = 0; E.modl = MODT + (size_t)b * 9 * 9216; E.slot = 1; E.wgt = 1.0f;
        E.ln = b * 3 + 1 - 1;
        if (op2 == OP_FFI) { Bt = (const bf16_t*)(ws + O_WFI) + (size_t)a * 5632 * 1024; nN = 22; E.kind = 1; if (c) nM = NLAT / 256; }
        else if (op2 == OP_FFO) { A = ACT; Bt = (const bf16_t*)(ws + O_WFO) + (size_t)a * 1024 * 2816; K = 2816; nN = 4; E.slot = c & 3; E.wgt = 0.5f; E.ln = b * 3 + (c & 3) - 1; if (c & 4) nM = NLAT / 256; }
        else if (op2 == OP_UP) { Bt = (const bf16_t*)(ws + O_WUP) + (size_t)a * 4096 * 1024; nM = RG / 256; nN = 16; am = RowMap{c2 * GB * SEQ, NLAT + c2 * GB * LC, GB * SEQ / 256}; E.kind = 0; E.O = (bf16_t*)(ws + O_XZ); E.ldc = 4096; }
        else if (op2 == OP_DN) { A = (const bf16_t*)(ws + O_FIN); Bt = (const bf16_t*)(ws + O_WDN) + (size_t)a * 1024 * 2048; K = 2048; nM = RG / 256; nN = 4; cm = RowMap{c2 * GB * SEQ, NLAT + c2 * GB * LC, GB * SEQ / 256}; }
        else if (op2 == OP_AQ) { Bt = (const bf16_t*)(ws + O_WAQ); nN = 6; E.kind = 0; E.ldc = 1536; }
        else if (op2 == OP_AO) { Bt = (const bf16_t*)(ws + O_WAO); nN = 4; }
        else if (op2 == OP_SI) { Bt = (const bf16_t*)(ws + O_WSI); nN = 12; E.kind = 0; E.ldc = 3072; }
        else { Bt = (const bf16_t*)(ws + O_WSO); nN = 4; }
        gemm_phase(cg_, A, am, Bt, K, nM, nN, cm, E);
      }
    }
    if (ph == 0) grid.sync(); else xcd_barrier(xbar, xcc, xst);
#ifdef DUP_OP
    if (op == DUP_OP && rep + 1 < DUP_N) { ++rep; --ph; } else rep = 0;
#endif
  }
}

static int build_program(unsigned* prog) {
  int n = 0;
  auto W = [&](int op, int a, int b, int c) { prog[n++] = (unsigned)op | ((unsigned)a << 8) | ((unsigned)b << 16) | ((unsigned)c << 24); };
  W(OP_PRO, 0, 0, 0);
  W(OP_LN0, 0, 0, 0);
  for (int layer = 0; layer < DEPTH; ++layer) {
    const int kind = layer % 3, j = layer / 3;
    W(OP_FFI, layer * 2, layer, 0); W(OP_FFO, layer * 2, layer, 0);
    W(OP_LN1, layer * 3 + 0, layer, 1);
    if (kind == 0) {
      for (int g = 0; g < NG; ++g) { if (g == 0) W(OP_UP, j, layer, g); W(OP_M0, j, 0, 0); W(OP_GAT, j, 0, 0); W(OP_S, 0, 0, 0); W(OP_M2, 0, 0, 0); W(OP_FIN, j, 0, 0); W(g + 1 < NG ? OP_DNUP : OP_DN, j, layer, g); }
    } else if (kind == 1) { W(OP_AQ, 0, layer, 0); W(OP_APREP, 0, 0, 0); W(OP_ACORE, 0, 0, 0); W(OP_AO, 0, layer, 0); }
    else { W(OP_SI, 0, layer, 0); W(OP_SCONV, 0, 0, 0); W(OP_SO, 0, layer, 0); }
    W(OP_LN1, layer * 3 + 1, layer, 2);
    const int lo = (layer + 1 == DEPTH) ? 1 : 0;
    W(OP_FFI, layer * 2 + 1, layer, lo); W(OP_FFO, layer * 2 + 1, layer, 2 | (lo << 2));
    if (layer + 1 < DEPTH) W(OP_LN1, layer * 3 + 2, layer + 1, 0); else W(OP_LNF, layer * 3 + 2, 0, 0);
  }
  return n;
}

extern "C" void kernel_launch(void* const* d_in, const int* in_sizes, int n_in, void* d_out, int out_size, void* d_ws, size_t ws_size, hipStream_t stream) {
  static int grid_blocks = 0;
  if (!grid_blocks) {
    int dev = 0, cus = 0, per_cu = 0;
    (void)hipGetDevice(&dev);
    (void)hipDeviceGetAttribute(&cus, hipDeviceAttributeMultiprocessorCount, dev);
    (void)hipFuncSetAttribute((const void*)fwd_megakernel, hipFuncAttributeMaxDynamicSharedMemorySize, LDS_BYTES);
    (void)hipOccupancyMaxActiveBlocksPerMultiprocessor(&per_cu, fwd_megakernel, 512, LDS_BYTES);
    if (cus <= 0) cus = 256;
    grid_blocks = cus;
    if (ws_size < WS_END || n_in != 25) fprintf(stderr, "kernel_launch: workspace %zu < %zu or n_in %d != 25\n", ws_size, (size_t)WS_END, n_in);
    if (per_cu < 1) fprintf(stderr, "kernel_launch: occupancy query says %d blocks per CU\n", per_cu);
  }
  Params p{};
  for (int i = 0; i < 25; ++i) p.in[i] = (const float*)d_in[i];
  p.out = (float*)d_out; p.ws = (char*)d_ws;
  p.nph = build_program(p.prog);
  (void)hipMemsetAsync((char*)d_ws + O_BAR, 0, XCD_BAR_WORDS * 4, stream);
  void* args[] = {&p};
  hipError_t e = hipLaunchCooperativeKernel((void*)fwd_megakernel, dim3(grid_blocks), dim3(512), args, LDS_BYTES, stream);
  if (e != hipSuccess) fprintf(stderr, "cooperative launch failed: %s (grid %d)\n", hipGetErrorString(e), grid_blocks);
}
```

```cpp
#include <hip/hip_runtime.h>
#include <hip/hip_cooperative_groups.h>
#include <cstdio>
#include <cstdint>
namespace cg = cooperative_groups;

typedef unsigned short bf16_t;
typedef short bf16x8 __attribute__((ext_vector_type(8)));
typedef short bf16x4 __attribute__((ext_vector_type(4)));
typedef float f32x4 __attribute__((ext_vector_type(4)));
typedef unsigned u32x2 __attribute__((ext_vector_type(2)));
typedef unsigned u32x4 __attribute__((ext_vector_type(4)));

constexpr int D = 1024, NB = 8, SEQ = 4096, LC = 256, DEPTH = 4, FF = 2816, EI = 2048, DH = 512;
constexpr int NLAT = NB * SEQ, NCTX = NB * LC, MROWS = NLAT + NCTX;
constexpr int TOKB = LC + SEQ;
constexpr int NCH = TOKB / 64;
constexpr int GB = 2, NG = NB / GB, RG = GB * TOKB;
constexpr int NSEQ = GB * 8;
constexpr float ALPHA = 1.681792830507429f, LN_EPS = 1e-5f;
constexpr int LDS_BYTES = 144 * 1024;

constexpr size_t al256(size_t x) { return (x + 255) & ~(size_t)255; }
constexpr size_t O_WFI = 0;
constexpr size_t O_WFO = O_WFI + (size_t)8 * 5632 * 1024 * 2;
constexpr size_t O_WUP = O_WFO + (size_t)8 * 1024 * 2816 * 2;
constexpr size_t O_WDN = O_WUP + (size_t)2 * 4096 * 1024 * 2;
constexpr size_t O_WAQ = O_WDN + (size_t)2 * 1024 * 2048 * 2;
constexpr size_t O_WAO = O_WAQ + (size_t)1536 * 1024 * 2;
constexpr size_t O_WSI = O_WAO + (size_t)1024 * 1024 * 2;
constexpr size_t O_WSO = O_WSI + (size_t)3072 * 1024 * 2;
constexpr size_t O_WG = O_WSO + (size_t)1024 * 1024 * 2;
constexpr size_t O_MODT = O_WG + (size_t)2 * 16 * 6144 * 2;
constexpr size_t O_ROPE = O_MODT + (size_t)4 * 9 * 9216 * 4;
constexpr size_t O_HCTX = O_ROPE + (size_t)2 * 4096 * 32 * 4;
constexpr size_t O_U = O_HCTX + (size_t)NCTX * D * 4;
constexpr size_t O_R = O_U + (size_t)MROWS * D * 2;
constexpr size_t O_XZ = O_R;
constexpr size_t O_QK = O_XZ + (size_t)RG * 4096 * 2;
constexpr size_t O_KT = O_QK + (size_t)RG * 4096 * 2;
constexpr size_t O_VT = O_KT + (size_t)GB * EI * TOKB * 2;
constexpr size_t O_SP = O_VT + (size_t)GB * EI * TOKB * 2;
constexpr size_t O_HD = O_SP + (size_t)NSEQ * NCH * 4096 * 2;
constexpr size_t O_FIN = O_HD + (size_t)2 * RG * EI * 2;
constexpr size_t O_GAT = O_FIN + (size_t)RG * EI * 2;
constexpr size_t SZ_ST = (size_t)NSEQ * TOKB * 4;
constexpr size_t O_BL = O_GAT, O_IG = O_BL + SZ_ST, O_WIN = O_IG + SZ_ST, O_FLO = O_WIN + SZ_ST, O_DEN = O_FLO + SZ_ST, O_WSS = O_DEN + SZ_ST;
constexpr size_t O_GC = O_WSS + SZ_ST;
constexpr size_t O_QF = O_GC + (size_t)3 * NSEQ * NCH * 4 + 256;
constexpr size_t O_REND_ML = O_QF + (size_t)GB * EI * TOKB * 2;
constexpr size_t O_ACT = O_R;
constexpr size_t O_AKR = O_R + (size_t)MROWS * 3072 * 2;
constexpr size_t O_AVT = O_AKR + (size_t)NB * 4 * TOKB * 64 * 2;
constexpr size_t O_REND_AT = O_AVT + (size_t)NB * 4 * TOKB * 64 * 2;
constexpr size_t O_BAR = (O_REND_ML > O_REND_AT ? O_REND_ML : O_REND_AT);
constexpr size_t O_STATS = O_BAR + 3456 * 4 + 256;
constexpr size_t O_LNT = O_STATS + (size_t)MROWS * 8 + 256;
constexpr size_t WS_END = O_LNT + (size_t)12 * 2 * D * 4 + 256;

struct Params {
  const float* in[25];
  float* out;
  char* ws;
  int nph; int pad0;
  unsigned prog[126];
};

#define GAS __attribute__((address_space(1)))
#define IN(k) ((const float*)(const GAS float*)p.in[(k) + cx.z])
struct Ctx { int tid, bid, nb, z; char* ws; float* out; };
extern __shared__ __attribute__((aligned(16))) char lds_raw[];

__device__ __forceinline__ unsigned pk2(float lo, float hi) { unsigned r; asm("v_cvt_pk_bf16_f32 %0, %1, %2" : "=v"(r) : "v"(lo), "v"(hi)); return r; }
__device__ __forceinline__ float bf2f(unsigned short v) { return __uint_as_float(((unsigned)v) << 16); }
__device__ __forceinline__ float bflo(unsigned v) { return __uint_as_float(v << 16); }
__device__ __forceinline__ float bfhi(unsigned v) { return __uint_as_float(v & 0xffff0000u); }
__device__ __forceinline__ float silu_f(float x) { return x * __builtin_amdgcn_rcpf(1.f + __expf(-x)); }
__device__ __forceinline__ float sigm_f(float x) { return __builtin_amdgcn_rcpf(1.f + __expf(-x)); }
__device__ __forceinline__ float shi(float v, int srclane) { return __int_as_float(__builtin_amdgcn_ds_bpermute(srclane << 2, __float_as_int(v))); }
__device__ __forceinline__ float shx(float v, int m, int lane) { return shi(v, lane ^ m); }
__device__ __forceinline__ float wave_sum(float v, int lane) {
#pragma unroll
  for (int o = 1; o < 64; o <<= 1) v += shx(v, o, lane);
  return v;
}
__device__ __forceinline__ bf16x8 mk8(u32x4 v) { union { u32x4 u; bf16x8 b; } x; x.u = v; return x.b; }
__device__ __forceinline__ bf16x8 mk8(u32x2 a, u32x2 b) { union { u32x4 u; bf16x8 b; } x; x.u = (u32x4){a.x, a.y, b.x, b.y}; return x.b; }
__device__ __forceinline__ float* hrow(const Ctx& cx, int row) { return row < NLAT ? cx.out + (size_t)row * D : (float*)(cx.ws + O_HCTX) + (size_t)(row - NLAT) * D; }
typedef float f32x2 __attribute__((ext_vector_type(2)));
__device__ __forceinline__ f32x2 pk_add(f32x2 a, f32x2 b) { f32x2 r; asm("v_pk_add_f32 %0, %1, %2" : "=v"(r) : "v"(a), "v"(b)); return r; }
__device__ __forceinline__ f32x2 pk_mul(f32x2 a, f32x2 b) { f32x2 r; asm("v_pk_mul_f32 %0, %1, %2" : "=v"(r) : "v"(a), "v"(b)); return r; }
__device__ __forceinline__ f32x4 add4(f32x4 a, f32x4 b) { const f32x2 lo = pk_add((f32x2){a[0], a[1]}, (f32x2){b[0], b[1]}), hi = pk_add((f32x2){a[2], a[3]}, (f32x2){b[2], b[3]}); return (f32x4){lo[0], lo[1], hi[0], hi[1]}; }
__device__ __forceinline__ unsigned pkmul2(unsigned v, float w0, float w1) { const f32x2 r = pk_mul((f32x2){__uint_as_float(v << 16), __uint_as_float(v & 0xffff0000u)}, (f32x2){w0, w1}); unsigned o; asm("v_cvt_pk_bf16_f32 %0, %1, %2" : "=v"(o) : "v"(r[0]), "v"(r[1])); return o; }
#define MFMA16(a, b, c) __builtin_amdgcn_mfma_f32_16x16x32_bf16(a, b, c, 0, 0, 0)
__device__ __forceinline__ size_t nat(int r, int c, int K) { return ((size_t)(r >> 4) * (K >> 5) + (c >> 5)) * 512 + (r & 15) * 32 + (c & 31); }

constexpr int BM = 256, BK = 64, HALF = 128, HT = HALF * BK, NXCD = 8, WGM = 4;
__device__ __forceinline__ int lds_byte(int r, int c) {
  int st = (r >> 4) * 2 + (c >> 5), rr = r & 15, cc = c & 31, ob = rr * 64 + cc * 2;
  return st * 1024 + (ob ^ (((ob >> 9) & 1) << 5));
}
__device__ __forceinline__ void stage_rc(int b, int& R, int& C) {
  int st = b / 1024, sb = b % 1024, swz = sb ^ (((sb >> 9) & 1) << 5);
  R = (st >> 1) * 16 + swz / 64; C = (st & 1) * 32 + (swz % 64) / 2;
}
struct RowMap { int lat0, ctx0, nlat; __device__ __forceinline__ int row0(int pm) const { return pm < nlat ? lat0 + pm * 256 : ctx0 + (pm - nlat) * 256; } };

typedef f32x4 Acc[2][2][4][2];

struct Epi {
  int kind; bf16_t* O; int ldc; const float* modl; int slot; float wgt;
  int ln;
};
__device__ __forceinline__ void run_epi(const Ctx& cx, const Epi E, const Acc& acc, int r0, int pn, int wr, int wc, int fr, int fq) {
  if (E.kind == 0) {
#pragma unroll
    for (int ai = 0; ai < 2; ++ai)
#pragma unroll
      for (int m = 0; m < 4; ++m) {
        bf16_t* rp = E.O + (size_t)(r0 + ai * HALF + wr * 64 + m * 16 + fr) * E.ldc + pn * 256 + wc * 32 + 4 * fq;
#pragma unroll
        for (int bj = 0; bj < 2; ++bj)
#pragma unroll
          for (int n = 0; n < 2; ++n) {
            f32x4 v = acc[ai][bj][m][n];
            u32x2 o; o.x = pk2(v[0], v[1]); o.y = pk2(v[2], v[3]);
            *(u32x2*)(rp + bj * HALF + n * 16) = o;
          }
      }
  } else if (E.kind == 1) {
#pragma unroll
    for (int ai = 0; ai < 2; ++ai)
#pragma unroll
      for (int m = 0; m < 4; ++m) {
        const int rrow = r0 + ai * HALF + wr * 64 + m * 16 + fr, fcol = pn * 128 + wc * 16 + 4 * fq;
#pragma unroll
        for (int bj = 0; bj < 2; ++bj) {
          f32x4 g = acc[ai][bj][m][0], v = acc[ai][bj][m][1];
          u32x2 o; o.x = pk2(silu_f(g[0]) * v[0], silu_f(g[1]) * v[1]); o.y = pk2(silu_f(g[2]) * v[2], silu_f(g[3]) * v[3]);
          *(u32x2*)(E.O + nat(rrow, fcol + bj * 64, FF)) = o;
        }
      }
  } else {
    const int midx = r0 < NLAT ? (r0 >> 12) : 8;
    const int cb = pn * 256 + wc * 32 + 4 * fq;
    const float* gp = E.modl + (size_t)midx * 9216 + (3 * E.slot + 2) * D + cb;
    f32x4 gv[2][2], lg[2][2], lb[2][2];
#pragma unroll
    for (int bj = 0; bj < 2; ++bj)
#pragma unroll
      for (int n = 0; n < 2; ++n) {
        gv[bj][n] = *(const f32x4*)(gp + bj * HALF + n * 16) * E.wgt;
        if (E.ln >= 0) { const float* lt = (const float*)(cx.ws + O_LNT) + (size_t)E.ln * 2 * D + cb + bj * HALF + n * 16; lg[bj][n] = *(const f32x4*)lt; lb[bj][n] = *(const f32x4*)(lt + D); }
        else { lg[bj][n] = (f32x4){1.f, 1.f, 1.f, 1.f}; lb[bj][n] = (f32x4){0.f, 0.f, 0.f, 0.f}; }
      }
#pragma unroll
    for (int ai = 0; ai < 2; ++ai)
#pragma unroll
      for (int m = 0; m < 4; ++m) {
        const int row = r0 + ai * HALF + wr * 64 + m * 16 + fr;
        float* rp = hrow(cx, row) + cb;
        float mean = 0.f, rstd = 1.f;
        if (E.ln >= 0) { const float2 st = *(const float2*)((const float*)(cx.ws + O_STATS) + (size_t)row * 2); mean = st.x; rstd = st.y; }
        f32x4 h[2][2];
#pragma unroll
        for (int bj = 0; bj < 2; ++bj)
#pragma unroll
          for (int n = 0; n < 2; ++n) h[bj][n] = *(const f32x4*)(rp + bj * HALF + n * 16);
#pragma unroll
        for (int bj = 0; bj < 2; ++bj)
#pragma unroll
          for (int n = 0; n < 2; ++n) *(f32x4*)(rp + bj * HALF + n * 16) = ((h[bj][n] - mean) * rstd) * lg[bj][n] + lb[bj][n] + gv[bj][n] * acc[ai][bj][m][n];
        __builtin_amdgcn_sched_barrier(0);
      }
  }
}

#define LAS __attribute__((address_space(3)))
__device__ __forceinline__ void gemm_phase(const Ctx& cx, const bf16_t* __restrict__ A, RowMap am, const bf16_t* __restrict__ Bt, int K, int nM, int nN, RowMap cm, const Epi epi) {
  LAS unsigned char* lds = (LAS unsigned char*)lds_raw;
  constexpr int HTB = HT * 2;
  const int tid = cx.tid, wid = tid >> 6, lane = tid & 63, wr = wid >> 2, wc = wid & 3, fr = lane & 15, fq = lane >> 4;
  unsigned voff[2];
#pragma unroll
  for (int i = 0; i < 2; ++i) { const int st = wid + 8 * i, sb = lane * 16; voff[i] = (unsigned)(((st >> 1) * (K >> 5) + (st & 1)) * 1024 + (sb ^ (((sb >> 9) & 1) << 5))); }
  const size_t kstep = 2048, hstep = (size_t)8 * (K >> 5) * 1024;
  const unsigned ldsw = (unsigned)wid * 1024u;
  const int aoff = lds_byte(wr * 64 + fr, fq * 8), boff = lds_byte(wc * 32 + fr, fq * 8);
#define G_SA(b, h) (((b) * 2 + (h)) * HTB)
#define G_SB(b, h) ((4 + (b) * 2 + (h)) * HTB)
#define STAGE(bufoff, gbase) do { _Pragma("unroll") for (int _i = 0; _i < 2; ++_i) \
    __builtin_amdgcn_global_load_lds((const unsigned*)((const char*)(gbase) + voff[_i]), (LAS unsigned*)(lds + (bufoff) + ldsw + _i * 8192), 16, 0, 0); } while (0)
#define LDA(dst, b, h) do { _Pragma("unroll") for (int m = 0; m < 4; ++m) _Pragma("unroll") for (int k = 0; k < 2; ++k) dst[m][k] = *(const LAS bf16x8*)(lds + G_SA(b, h) + aoff + m * 2048 + k * 1024); } while (0)
#define LDB(dst, b, h) do { _Pragma("unroll") for (int n = 0; n < 2; ++n) _Pragma("unroll") for (int k = 0; k < 2; ++k) dst[n][k] = *(const LAS bf16x8*)(lds + G_SB(b, h) + boff + n * 2048 + k * 1024); } while (0)
#define MMA(ai, bj, At, Bt_) do { __builtin_amdgcn_s_setprio(1); _Pragma("unroll") for (int m = 0; m < 4; ++m) _Pragma("unroll") for (int n = 0; n < 2; ++n) _Pragma("unroll") for (int k = 0; k < 2; ++k) \
      acc[ai][bj][m][n] = MFMA16(Bt_[n][k], At[m][k], acc[ai][bj][m][n]); \
    __builtin_amdgcn_s_setprio(0); } while (0)
#define WAIT_V(n) asm volatile("s_waitcnt vmcnt(" #n ")" ::: "memory")
#define WAIT_L(n) asm volatile("s_waitcnt lgkmcnt(" #n ")" ::: "memory")
#define BAR __builtin_amdgcn_s_barrier()
#define SCHED __builtin_amdgcn_sched_barrier(0)
  const int nwg = nM * nN;
  const int nt = K / BK;
  const int wid_s = __builtin_amdgcn_readfirstlane(wid);
#define DECODE(L_, pm_, pn_) do { int wgid = (L_); \
    { int q = nwg / NXCD, r = nwg % NXCD, xcd = wgid % NXCD, off = wgid / NXCD; wgid = (xcd < r ? xcd * (q + 1) : r * (q + 1) + (xcd - r) * q) + off; } \
    const int nig = WGM * nN, gid = wgid / nig, fm = gid * WGM, gsz = min(nM - fm, WGM); \
    pm_ = fm + ((wgid % nig) % gsz); pn_ = (wgid % nig) / gsz; } while (0)
  int L = cx.bid;
  if (L < nwg) {
    int pm, pn;
    DECODE(L, pm, pn);
    const char* cA = (const char*)A + (size_t)(am.row0(pm) >> 4) * (K >> 5) * 1024; const char* cB = (const char*)Bt + (size_t)(pn * BM >> 4) * (K >> 5) * 1024;
    Acc acc;
#pragma unroll
    for (int a = 0; a < 2; ++a)
#pragma unroll
      for (int b = 0; b < 2; ++b)
#pragma unroll
        for (int m = 0; m < 4; ++m)
#pragma unroll
          for (int n = 0; n < 2; ++n) acc[a][b][m][n] = (f32x4){0.f, 0.f, 0.f, 0.f};
    bf16x8 At[4][2], B0[2][2], B1[2][2];
    STAGE(G_SB(0, 0), cB); STAGE(G_SA(0, 0), cA); STAGE(G_SB(0, 1), cB + hstep); STAGE(G_SA(0, 1), cA + hstep);
    if (wr == 1) BAR;
    WAIT_V(4); BAR;
    STAGE(G_SB(1, 0), cB + kstep); STAGE(G_SA(1, 0), cA + kstep); STAGE(G_SB(1, 1), cB + hstep + kstep);
    WAIT_V(6); BAR;
    for (;;) {
      const int Ln = L + cx.nb;
      const bool has_next = Ln < nwg;
      int pmn = pm, pnn = pn;
      if (has_next) DECODE(Ln, pmn, pnn);
      const char* nA = has_next ? (const char*)A + (size_t)(am.row0(pmn) >> 4) * (K >> 5) * 1024 : cA; const char* nB = has_next ? (const char*)Bt + (size_t)(pnn * BM >> 4) * (K >> 5) * 1024 : cB;
      for (int t = 0; t < nt; t += 2) {
        const bool last = (t == nt - 2);
        const char* a1 = cA + (size_t)(t + 1) * kstep;
        const char* a2 = last ? nA : cA + (size_t)(t + 2) * kstep; const char* b2 = last ? nB : cB + (size_t)(t + 2) * kstep;
        const char* a3 = a2 + kstep; const char* b3 = b2 + kstep;
        LDB(B0, 0, 0); SCHED; LDA(At, 0, 0); STAGE(G_SA(1, 1), a1 + hstep);
        WAIT_L(8); BAR; WAIT_L(0); MMA(0, 0, At, B0); BAR; SCHED;
        LDB(B1, 0, 1); STAGE(G_SB(0, 0), b2);
        BAR; WAIT_L(0); MMA(0, 1, At, B1); BAR;
        LDA(At, 0, 1); STAGE(G_SA(0, 0), a2);
        BAR; WAIT_L(0); MMA(1, 0, At, B0); BAR; SCHED;
        STAGE(G_SB(0, 1), b2 + hstep);
        WAIT_V(6); BAR; MMA(1, 1, At, B1); BAR;
        LDB(B0, 1, 0); SCHED; LDA(At, 1, 0); STAGE(G_SA(0, 1), a2 + hstep);
        WAIT_L(8); BAR; WAIT_L(0); MMA(0, 0, At, B0); BAR; SCHED;
        LDB(B1, 1, 1); STAGE(G_SB(1, 0), b3);
        BAR; WAIT_L(0); MMA(0, 1, At, B1); BAR;
        LDA(At, 1, 1); STAGE(G_SA(1, 0), a3);
        BAR; WAIT_L(0); MMA(1, 0, At, B0); BAR; SCHED;
        STAGE(G_SB(1, 1), b3 + hstep);
        WAIT_V(6); BAR; MMA(1, 1, At, B1); BAR;
      }
      { int t2 = wid_s * 64 + (int)__builtin_amdgcn_mbcnt_hi(~0u, __builtin_amdgcn_mbcnt_lo(~0u, (unsigned)cx.z)); asm volatile("" : "+v"(t2));
        const int w2 = t2 >> 6, l2 = t2 & 63;
        run_epi(cx, epi, acc, cm.row0(pm), pn, w2 >> 2, w2 & 3, l2 & 15, l2 >> 4); }
      if (!has_next) break;
#pragma unroll
      for (int a = 0; a < 2; ++a)
#pragma unroll
        for (int b = 0; b < 2; ++b)
#pragma unroll
          for (int m = 0; m < 4; ++m)
#pragma unroll
            for (int n = 0; n < 2; ++n) acc[a][b][m][n] = (f32x4){0.f, 0.f, 0.f, 0.f};
      pm = pmn; pn = pnn; cA = nA; cB = nB; L = Ln;
    }
    WAIT_V(0);
    if (wr == 0) BAR;
    BAR;
  }
  __syncthreads();
}

template <int MODE>
__device__ __forceinline__ int wrow(int c) {
  if (MODE == 0) return c;
  const int isv = c >= FF ? 1 : 0, f = c - isv * FF;
  return (f >> 7) * 256 + ((f >> 6) & 1) * 128 + ((f >> 4) & 3) * 32 + isv * 16 + (f & 15);
}
template <int MODE>
__device__ __forceinline__ void transpose_item(const float* __restrict__ W, int K, int N, bf16_t* __restrict__ WT, float* scr, int item, int lane) {
  const int nblk = N / 32, kb = item / nblk, nb = item % nblk, k0 = 64 * kb, n0 = 32 * nb;
#pragma unroll 8
  for (int i = 0; i < 32; ++i) { const int kk = 2 * i + (lane >> 5); scr[kk * 33 + (lane & 31)] = W[(size_t)(k0 + kk) * N + n0 + (lane & 31)]; }
  __builtin_amdgcn_wave_barrier(); asm volatile("s_waitcnt lgkmcnt(0)" ::: "memory");
  const int c = lane & 7;
#pragma unroll
  for (int j = 0; j < 4; ++j) {
    const int n = (lane >> 3) + 8 * j; const float* s = scr + (8 * c) * 33 + n;
    u32x4 o; o.x = pk2(s[0 * 33], s[1 * 33]); o.y = pk2(s[2 * 33], s[3 * 33]); o.z = pk2(s[4 * 33], s[5 * 33]); o.w = pk2(s[6 * 33], s[7 * 33]);
    *(u32x4*)(WT + nat(wrow<MODE>(n0 + n), k0 + 8 * c, K)) = o;
  }
  asm volatile("s_waitcnt lgkmcnt(0)" ::: "memory"); __builtin_amdgcn_wave_barrier();
}

__device__ __forceinline__ void prologue(const Params& p, const Ctx& cx) {
  const int tid = cx.tid, lane = tid & 63, wave = tid >> 6;
  char* ws = cx.ws;
  {
    float* cond = (float*)lds_raw;
    float* red = (float*)(lds_raw + 9 * 1024 * 4);
    for (int i = tid; i < 9 * 1024; i += 512) { const int j = i >> 10, k = i & 1023; cond[i] = silu_f(j < 8 ? IN(1)[j * 1024 + k] : IN(3)[k]); }
    __syncthreads();
    for (int u = cx.bid; u < 4 * 36; u += cx.nb) {
      const int layer = u / 36, ct = u % 36, c0 = ct * 256 + 4 * lane;
      const float* wp = IN(4) + (size_t)layer * D * 9216 + c0;
      f32x4 a[9];
#pragma unroll
      for (int j = 0; j < 9; ++j) a[j] = (f32x4){0.f, 0.f, 0.f, 0.f};
#pragma unroll 4
      for (int k = wave * 128; k < wave * 128 + 128; ++k) {
        const f32x4 w = *(const f32x4*)(wp + (size_t)k * 9216);
#pragma unroll
        for (int j = 0; j < 9; ++j) a[j] += w * cond[j * 1024 + k];
      }
#pragma unroll
      for (int j = 0; j < 9; ++j) *(f32x4*)(red + (wave * 9 + j) * 256 + 4 * lane) = a[j];
      __syncthreads();
      float* mt = (float*)(ws + O_MODT) + (size_t)layer * 9 * 9216;
      for (int i = tid; i < 9 * 256; i += 512) {
        const int j = i >> 8, c = i & 255; float s = 0.f;
#pragma unroll
        for (int w = 0; w < 8; ++w) s += red[(w * 9 + j) * 256 + c];
        mt[(size_t)j * 9216 + ct * 256 + c] = s + IN(5)[layer * 9216 + ct * 256 + c];
      }
      __syncthreads();
    }
    __syncthreads();
  }
  {
    float* scr = (float*)lds_raw + wave * (64 * 33);
    const int gw = cx.bid * 8 + wave, NGW = cx.nb * 8;
    constexpr int I_FI = 16 * 176, I_FO = 44 * 32, I_UP = 16 * 128, I_DN = 32 * 32, I_AQ = 16 * 48, I_AO = 16 * 32, I_SI = 16 * 96, I_SO = 16 * 32;
    constexpr int NITEMS = 8 * I_FI + 8 * I_FO + 2 * I_UP + 2 * I_DN + I_AQ + I_AO + I_SI + I_SO;
    for (int it = gw; it < NITEMS; it += NGW) {
      int r = it;
      if (r < 8 * I_FI) { const int mi = r / I_FI; transpose_item<1>(IN(8) + (size_t)mi * 1024 * 5632, 1024, 5632, (bf16_t*)(ws + O_WFI) + (size_t)mi * 5632 * 1024, scr, r % I_FI, lane); continue; } r -= 8 * I_FI;
      if (r < 8 * I_FO) { const int mi = r / I_FO; transpose_item<0>(IN(9) + (size_t)mi * 2816 * 1024, 2816, 1024, (bf16_t*)(ws + O_WFO) + (size_t)mi * 1024 * 2816, scr, r % I_FO, lane); continue; } r -= 8 * I_FO;
      if (r < 2 * I_UP) { const int mi = r / I_UP; transpose_item<0>(IN(10) + (size_t)mi * 1024 * 4096, 1024, 4096, (bf16_t*)(ws + O_WUP) + (size_t)mi * 4096 * 1024, scr, r % I_UP, lane); continue; } r -= 2 * I_UP;
      if (r < 2 * I_DN) { const int mi = r / I_DN; transpose_item<0>(IN(18) + (size_t)mi * 2048 * 1024, 2048, 1024, (bf16_t*)(ws + O_WDN) + (size_t)mi * 1024 * 2048, scr, r % I_DN, lane); continue; } r -= 2 * I_DN;
      if (r < I_AQ) { transpose_item<0>(IN(19), 1024, 1536, (bf16_t*)(ws + O_WAQ), scr, r, lane); continue; } r -= I_AQ;
      if (r < I_AO) { transpose_item<0>(IN(21), 1024, 1024, (bf16_t*)(ws + O_WAO), scr, r, lane); continue; } r -= I_AO;
      if (r < I_SI) { transpose_item<0>(IN(22), 1024, 3072, (bf16_t*)(ws + O_WSI), scr, r, lane); continue; } r -= I_SI;
      transpose_item<0>(IN(24), 1024, 1024, (bf16_t*)(ws + O_WSO), scr, r, lane);
    }
  }
  {
    const int gt = cx.bid * 512 + tid, gs = cx.nb * 512;
    bf16_t* wg = (bf16_t*)(ws + O_WG);
    for (int i = gt; i < 2 * 16 * 6144; i += gs) {
      const int j = i / (16 * 6144), xg = (i / 6144) & 15, k = i % 6144, x = xg >> 3, g = xg & 7;
      const float* wif = IN(14) + (size_t)(j * 2 + x) * 6144 * 8;
      float v;
      const int knat = (k & ~31) + 16 * ((k >> 2) & 1) + 4 * ((k >> 3) & 3) + (k & 3);
      if (k < 2048) v = wif[(size_t)knat * 8 + g];
      else if (k < 4096) v = wif[(size_t)knat * 8 + g] * 22.627416997969522f;
      else {
        const int c = k - 4096, blk = c >> 2, cc = c & 3;
        const float* wv = IN(13) + ((size_t)(j * 3 + 2) * 512 + blk) * 16 + cc * 4;
        v = 0.f;
        for (int d2 = 0; d2 < 4; ++d2) v += wv[d2] * wif[(size_t)(4096 + 4 * blk + d2) * 8 + g];
      }
      wg[i] = (bf16_t)(pk2(v, 0.f) & 0xffff);
    }
    { float* lnt = (float*)(ws + O_LNT); for (int i = gt; i < 12 * D; i += gs) { const int l = i / D, c2 = i % D; lnt[(size_t)l * 2 * D + c2] = IN(6)[i] * ALPHA; lnt[(size_t)l * 2 * D + D + c2] = IN(7)[i] * ALPHA; } }
    float* rc = (float*)(ws + O_ROPE); float* rs = rc + 4096 * 32;
    for (int i = gt; i < 4096 * 32; i += gs) {
      const int pos = i >> 5, pp = i & 31, jf = pp & 15;
      const float fr_ = __builtin_amdgcn_exp2f(-(float)jf * (13.287712379549449f / 16.f));
      float rev = (float)(pp < 16 ? (pos >> 6) : (pos & 63)) * fr_ * 0.15915494309189535f;
      rev -= rintf(rev);
      rc[i] = __builtin_amdgcn_cosf(rev); rs[i] = __builtin_amdgcn_sinf(rev);
    }
  }
}

template <int MODE>
__device__ __forceinline__ void lnmod_phase(const Params& p, const Ctx& cx, int lnidx  , int layer, int slot) {
  const int lane = cx.tid & 63, gw = cx.bid * 8 + (cx.tid >> 6), NGW = cx.nb * 8;
  const int nrows = MODE == 2 ? NLAT : MROWS;
  const float* lg = IN(6) + (size_t)lnidx * D; const float* lb = IN(7) + (size_t)lnidx * D;
  const float* modl = (const float*)(cx.ws + O_MODT) + (size_t)layer * 9 * 9216;
  bf16_t* U = (bf16_t*)(cx.ws + O_U);
  for (int row = gw; row < nrows; row += NGW) {
    float* hp = hrow(cx, row);
    const float* src = MODE == 0 ? (row < NLAT ? IN(0) + (size_t)row * D : IN(2) + (size_t)(row - NLAT) * D) : hp;
    f32x4 v[4];
#pragma unroll
    for (int j = 0; j < 4; ++j) v[j] = *(const f32x4*)(src + 4 * lane + 256 * j);
    if (MODE != 0) {
      float s = 0.f;
#pragma unroll
      for (int j = 0; j < 4; ++j) s += (v[j][0] + v[j][1]) + (v[j][2] + v[j][3]);
      const float mean = wave_sum(s, lane) * (1.f / D); float s2 = 0.f;
#pragma unroll
      for (int j = 0; j < 4; ++j) { v[j] = v[j] - mean; s2 += (v[j][0] * v[j][0] + v[j][1] * v[j][1]) + (v[j][2] * v[j][2] + v[j][3] * v[j][3]); }
      const float rstd = __builtin_amdgcn_rsqf(wave_sum(s2, lane) * (1.f / D) + LN_EPS);
      if (MODE == 1 && lane == 0) *(float2*)((float*)(cx.ws + O_STATS) + (size_t)row * 2) = make_float2(mean, rstd);
#pragma unroll
      for (int j = 0; j < 4; ++j) v[j] = v[j] * rstd * *(const f32x4*)(lg + 4 * lane + 256 * j) + *(const f32x4*)(lb + 4 * lane + 256 * j);
    }
    if (MODE != 1) {
#pragma unroll
      for (int j = 0; j < 4; ++j) *(f32x4*)(hp + 4 * lane + 256 * j) = MODE == 0 ? v[j] * ALPHA : v[j];
    }
    if (MODE != 2) {
      const int midx = row < NLAT ? (row >> 12) : 8;
      const float* sh = modl + (size_t)midx * 9216 + (3 * slot) * D; const float* sc = sh + D;
#pragma unroll
      for (int j = 0; j < 4; ++j) {
        const f32x4 u = v[j] * (*(const f32x4*)(sc + 4 * lane + 256 * j) + 1.f) + *(const f32x4*)(sh + 4 * lane + 256 * j);
        u32x2 o; o.x = pk2(u[0], u[1]); o.y = pk2(u[2], u[3]);
        *(u32x2*)(U + nat(row, 4 * lane + 256 * j, D)) = o;
      }
    }
  }
}

__device__ __forceinline__ int ml_lrow(int bl, int tok) { return tok < LC ? GB * SEQ + bl * LC + tok : bl * SEQ + (tok - LC); }
__device__ __forceinline__ int ml_nchunk(int x, int st) { return x == 0 ? st : (st < 4 ? 3 - st : 71 - st); }

__device__ __forceinline__ void ml_m0(const Params& p, const Ctx& cx, int j) {
  const int tid = cx.tid;
  char* ws = cx.ws;
  const bf16_t* XZ = (const bf16_t*)(ws + O_XZ);
  bf16_t* QK = (bf16_t*)(ws + O_QK); bf16_t* KT = (bf16_t*)(ws + O_KT); bf16_t* VT = (bf16_t*)(ws + O_VT); bf16_t* QF = (bf16_t*)(ws + O_QF);
  const int blk_l = tid & 63, tq = tid >> 6;
  for (int u = cx.bid; u < GB * NCH * 8; u += cx.nb) {
    const int slab = u & 7, ch = (u >> 3) % NCH, bl = u / (8 * NCH);
    const int f0 = slab * 256 + blk_l * 4, blk = f0 >> 2;
    float cw[3][4], cb[4], wq[16], wk[16], wv[16];
#pragma unroll
    for (int k = 0; k < 3; ++k)
#pragma unroll
      for (int c = 0; c < 4; ++c) cw[k][c] = IN(11)[(size_t)(j * 3 + k) * EI + f0 + c];
#pragma unroll
    for (int c = 0; c < 4; ++c) cb[c] = IN(12)[(size_t)j * EI + f0 + c];
#pragma unroll
    for (int i = 0; i < 16; ++i) {
      wq[i] = IN(13)[((size_t)(j * 3 + 0) * 512 + blk) * 16 + i];
      wk[i] = IN(13)[((size_t)(j * 3 + 1) * 512 + blk) * 16 + i] * 0.04419417382415922f;
      wv[i] = IN(13)[((size_t)(j * 3 + 2) * 512 + blk) * 16 + i];
    }
    const int tok0 = ch * 64, seg_lo = tok0 < LC ? 0 : LC, seg_hi = tok0 < LC ? LC : TOKB;
    const int tl0 = tq * 8;
    float xmp[4], xmc[4], xmn[4];
    {
      const int t2 = tok0 + tl0 - 1;
      if (t2 >= seg_lo) { const u32x2 r = *(const u32x2*)(XZ + (size_t)ml_lrow(bl, t2) * 4096 + f0); xmp[0] = bflo(r.x); xmp[1] = bfhi(r.x); xmp[2] = bflo(r.y); xmp[3] = bfhi(r.y); }
      else { xmp[0] = xmp[1] = xmp[2] = xmp[3] = 0.f; }
      const u32x2 r = *(const u32x2*)(XZ + (size_t)ml_lrow(bl, tok0 + tl0) * 4096 + f0); xmc[0] = bflo(r.x); xmc[1] = bfhi(r.x); xmc[2] = bflo(r.y); xmc[3] = bfhi(r.y);
    }
    unsigned kpk[4][4], vpk[4][4];
    float kprev[4], vprev[4];
    const int fp = (f0 & ~31) + 8 * ((f0 >> 2) & 3) + 4 * ((f0 >> 4) & 1);
#pragma unroll
    for (int tt = 0; tt < 8; ++tt) {
      const int tl = tl0 + tt, tok = tok0 + tl;
      if (tok + 1 < seg_hi) { const u32x2 r = *(const u32x2*)(XZ + (size_t)ml_lrow(bl, tok + 1) * 4096 + f0); xmn[0] = bflo(r.x); xmn[1] = bfhi(r.x); xmn[2] = bflo(r.y); xmn[3] = bfhi(r.y); }
      else { xmn[0] = xmn[1] = xmn[2] = xmn[3] = 0.f; }
      float xc[4], q[4], kk[4], vv[4];
#pragma unroll
      for (int c = 0; c < 4; ++c) xc[c] = silu_f(cw[0][c] * xmp[c] + cw[1][c] * xmc[c] + cw[2][c] * xmn[c] + cb[c]);
#pragma unroll
      for (int d2 = 0; d2 < 4; ++d2) {
        q[d2] = xc[0] * wq[d2] + xc[1] * wq[4 + d2] + xc[2] * wq[8 + d2] + xc[3] * wq[12 + d2];
        kk[d2] = xc[0] * wk[d2] + xc[1] * wk[4 + d2] + xc[2] * wk[8 + d2] + xc[3] * wk[12 + d2];
        vv[d2] = xmc[0] * wv[d2] + xmc[1] * wv[4 + d2] + xmc[2] * wv[8 + d2] + xmc[3] * wv[12 + d2];
      }
      const size_t lr = ml_lrow(bl, tok);
      u32x2 oq, ok; oq.x = pk2(q[0], q[1]); oq.y = pk2(q[2], q[3]); ok.x = pk2(kk[0], kk[1]); ok.y = pk2(kk[2], kk[3]);
      *(u32x2*)(QF + ((((((size_t)bl * NCH + ch) * 4 + (f0 >> 9)) * 8 + ((f0 >> 6) & 7)) * 4 + (tl >> 4)) * 2 + ((f0 >> 5) & 1)) * 512 + (tl & 15) * 32 + 8 * ((f0 >> 2) & 3) + 4 * ((f0 >> 4) & 1)) = oq;
      *(u32x2*)(QK + lr * 4096 + 2048 + fp) = ok;
      if (tt & 1) {
#pragma unroll
        for (int c = 0; c < 4; ++c) { kpk[c][tt >> 1] = pk2(kprev[c], kk[c]); vpk[c][tt >> 1] = pk2(vprev[c], vv[c]); }
      } else {
#pragma unroll
        for (int c = 0; c < 4; ++c) { kprev[c] = kk[c]; vprev[c] = vv[c]; }
      }
#pragma unroll
      for (int c = 0; c < 4; ++c) { xmp[c] = xmc[c]; xmc[c] = xmn[c]; }
    }
#pragma unroll
    for (int c = 0; c < 4; ++c) {
      const int feat = f0 + c;
      const size_t off = (((size_t)bl * NCH + ch) * (EI / 16) + (feat >> 4)) * 1024 + (tq >> 2) * 512 + (feat & 15) * 32 + (tq & 3) * 8;
      *(u32x4*)(KT + off) = (u32x4){kpk[c][0], kpk[c][1], kpk[c][2], kpk[c][3]};
      *(u32x4*)(VT + off) = (u32x4){vpk[c][0], vpk[c][1], vpk[c][2], vpk[c][3]};
    }
  }
}

__device__ __forceinline__ void ml_gates(const Params& p, const Ctx& cx, int j) {
  const int tid = cx.tid, lane = tid & 63, wave = tid >> 6, fr = lane & 15, fq = lane >> 4;
  char* ws = cx.ws;
  const bf16_t* XZ = (const bf16_t*)(ws + O_XZ); const bf16_t* QK = (const bf16_t*)(ws + O_QK); const bf16_t* QF = (const bf16_t*)(ws + O_QF);
  const bf16_t* WG = (const bf16_t*)(ws + O_WG) + (size_t)j * 16 * 6144;
  float* BL = (float*)(ws + O_BL); float* IG = (float*)(ws + O_IG);
  float* GC = (float*)(ws + O_GC); float* AC = GC + NSEQ * NCH;
  float* part = (float*)lds_raw;
  float* gl = part + 8 * 64 * 16;
  for (int u = cx.bid; u < GB * NCH; u += cx.nb) {
    const int bl = u / NCH, nc = u % NCH, tok0 = nc * 64;
    f32x4 acc[4];
#pragma unroll
    for (int m = 0; m < 4; ++m) acc[m] = (f32x4){0.f, 0.f, 0.f, 0.f};
    size_t lr[4];
#pragma unroll
    for (int m = 0; m < 4; ++m) lr[m] = ml_lrow(bl, tok0 + m * 16 + fr);
#pragma unroll 4
    for (int ks = wave * 24; ks < wave * 24 + 24; ++ks) {
      const int k = ks * 32 + fq * 8;
      const bf16x8 bfr = *(const bf16x8*)(WG + (size_t)fr * 6144 + k);
#pragma unroll
      for (int m = 0; m < 4; ++m) {
        const bf16_t* ap = k < 2048 ? QF + ((((((size_t)bl * NCH + nc) * 4 + (k >> 9)) * 8 + ((k >> 6) & 7)) * 4 + m) * 2 + ((k >> 5) & 1)) * 512 + fr * 32 + 8 * fq
                         : k < 4096 ? QK + lr[m] * 4096 + k : XZ + lr[m] * 4096 + (k - 4096);
        const bf16x8 afr = *(const bf16x8*)ap;
        acc[m] = MFMA16(afr, bfr, acc[m]);
      }
    }
#pragma unroll
    for (int m = 0; m < 4; ++m)
#pragma unroll
      for (int jj = 0; jj < 4; ++jj) part[(wave * 64 + m * 16 + 4 * fq + jj) * 16 + fr] = acc[m][jj];
    __syncthreads();
    for (int i = tid; i < 1024; i += 512) {
      float s = IN(15)[(size_t)j * 16 + (i & 15)];
#pragma unroll
      for (int w = 0; w < 8; ++w) s += part[w * 1024 + i];
      gl[(i >> 4) * 17 + (i & 15)] = s;
    }
    __syncthreads();
    {
      const int x = wave >> 2, h = wave & 3, seq = (bl * 2 + x) * 4 + h;
      const int tl = x == 0 ? lane : 63 - lane;
      const float ig = gl[tl * 17 + x * 8 + h], fg = gl[tl * 17 + x * 8 + 4 + h];
      float b = fg > 0.f ? -__logf(1.f + __expf(-fg)) : fg - __logf(1.f + __expf(fg));
#pragma unroll
      for (int o = 1; o < 64; o <<= 1) { const float t2 = shi(b, lane - o); if (lane >= o) b += t2; }
      BL[(size_t)seq * TOKB + tok0 + tl] = b; IG[(size_t)seq * TOKB + tok0 + tl] = ig;
      float mx = ig - b;
#pragma unroll
      for (int o = 1; o < 64; o <<= 1) mx = fmaxf(mx, shx(mx, o, lane));
      const float g = shi(b, 63);
      if (lane == 0) { GC[seq * NCH + nc] = g; AC[seq * NCH + nc] = g + mx; }
    }
    __syncthreads();
  }
}

__device__ __forceinline__ void ml_s(const Params& p, const Ctx& cx) {
  const int tid = cx.tid, lane = tid & 63, wave = tid >> 6, fr = lane & 15, fq = lane >> 4;
  char* ws = cx.ws;
  const bf16_t* QK = (const bf16_t*)(ws + O_QK);
  bf16_t* SP = (bf16_t*)(ws + O_SP);
  const float* BL = (const float*)(ws + O_BL); const float* IG = (const float*)(ws + O_IG);
  float* WIN = (float*)(ws + O_WIN); float* FLO = (float*)(ws + O_FLO); float* DEN = (float*)(ws + O_DEN); float* WSS = (float*)(ws + O_WSS);
  const float* GC = (const float*)(ws + O_GC); const float* AC = GC + NSEQ * NCH; float* DEC = (float*)(ws + O_GC) + 2 * NSEQ * NCH;
  float* sb_ = (float*)lds_raw + wave * 256; float* si_ = sb_ + 64; float* smt = si_ + 64;
  const int gw = cx.bid * 8 + wave, NGW = cx.nb * 8;
  for (int u = gw; u < NSEQ * NCH; u += NGW) {
    const int seq = u / NCH, st = u % NCH, x = (seq >> 2) & 1, h = seq & 3, bl = seq >> 3;
    const int nc = ml_nchunk(x, st), tok0 = nc * 64;
    const int nl0 = ml_nchunk(x, lane), nl1 = ml_nchunk(x, 64 + (lane & 3));
    const float g0 = GC[seq * NCH + nl0], a0 = AC[seq * NCH + nl0], g1 = GC[seq * NCH + nl1], a1 = AC[seq * NCH + nl1];
    const int tl = x == 0 ? lane : 63 - lane;
    const float b = BL[(size_t)seq * TOKB + tok0 + tl], ig = IG[(size_t)seq * TOKB + tok0 + tl];
    float mc = 0.f;
    for (int s2 = 0; s2 < st; ++s2) {
      const float gg = __int_as_float(__builtin_amdgcn_readlane(__float_as_int(s2 < 64 ? g0 : g1), s2 & 63));
      const float aa = __int_as_float(__builtin_amdgcn_readlane(__float_as_int(s2 < 64 ? a0 : a1), s2 & 63));
      mc = fmaxf(gg + mc, aa);
    }
    const float gc = __int_as_float(__builtin_amdgcn_readlane(__float_as_int(st < 64 ? g0 : g1), st & 63));
    const float ac = __int_as_float(__builtin_amdgcn_readlane(__float_as_int(st < 64 ? a0 : a1), st & 63));
    const float mnew = fmaxf(gc + mc, ac);
    float cm = ig - b;
#pragma unroll
    for (int o = 1; o < 64; o <<= 1) { const float t2 = shi(cm, lane - o); if (lane >= o) cm = fmaxf(cm, t2); }
    const float mt = b + fmaxf(mc, cm);
    sb_[tl] = b; si_[tl] = ig; smt[tl] = mt;
    WIN[(size_t)seq * TOKB + tok0 + tl] = __expf(b + mc - mt);
    FLO[(size_t)seq * TOKB + tok0 + tl] = __expf(-mt);
    WSS[(size_t)seq * TOKB + tok0 + tl] = __expf(gc - b + ig - mnew);
    if (lane == 0) DEC[seq * NCH + nc] = __expf(gc + mc - mnew);
    f32x4 acc[4][4];
#pragma unroll
    for (int a = 0; a < 4; ++a)
#pragma unroll
      for (int c2 = 0; c2 < 4; ++c2) acc[a][c2] = (f32x4){0.f, 0.f, 0.f, 0.f};
    const bf16_t* rowp[4];
#pragma unroll
    for (int a = 0; a < 4; ++a) rowp[a] = QK + (size_t)ml_lrow(bl, tok0 + a * 16 + fr) * 4096 + h * DH + fq * 8;
    const bf16_t* qfb = (const bf16_t*)(ws + O_QF) + ((((size_t)bl * NCH + nc) * 4 + h) * 8) * 4 * 2 * 512 + fr * 32 + 8 * fq;
#pragma unroll 2
    for (int ks = 0; ks < 16; ++ks) {
      bf16x8 kf[4], qf[4];
#pragma unroll
      for (int a = 0; a < 4; ++a) { kf[a] = *(const bf16x8*)(rowp[a] + 2048 + ks * 32); qf[a] = *(const bf16x8*)(qfb + (((size_t)(ks >> 1) * 4 + a) * 2 + (ks & 1)) * 512); }
#pragma unroll
      for (int a = 0; a < 4; ++a)
#pragma unroll
        for (int c2 = 0; c2 < 4; ++c2) acc[a][c2] = MFMA16(kf[a], qf[c2], acc[a][c2]);
    }
    __builtin_amdgcn_wave_barrier(); asm volatile("s_waitcnt lgkmcnt(0)" ::: "memory");
    bf16_t* spu = SP + (size_t)(seq * NCH + nc) * 4096;
#pragma unroll
    for (int tb = 0; tb < 4; ++tb) {
      const int t = tb * 16 + fr;
      const float bt = sb_[t], mtt = smt[t];
      float dsum = 0.f;
#pragma unroll
      for (int sbk = 0; sbk < 4; ++sbk) {
        float vals[4];
#pragma unroll
        for (int jj = 0; jj < 4; ++jj) {
          const int s = sbk * 16 + 4 * fq + jj;
          const bool ok = x == 0 ? (s <= t) : (s >= t);
          vals[jj] = ok ? acc[sbk][tb][jj] * __expf(bt - sb_[s] + si_[s] - mtt) : 0.f;
        }
        u32x2 o; o.x = pk2(vals[0], vals[1]); o.y = pk2(vals[2], vals[3]);
        *(u32x2*)(spu + tb * 1024 + ((sbk * 16 + 4 * fq) >> 5) * 512 + fr * 32 + ((sbk * 16 + 4 * fq) & 31)) = o;
        dsum += (bflo(o.x) + bfhi(o.x)) + (bflo(o.y) + bfhi(o.y));
      }
      dsum += shx(dsum, 16, lane); dsum += shx(dsum, 32, lane);
      if (fq == 0) DEN[(size_t)seq * TOKB + tok0 + t] = dsum;
    }
    __builtin_amdgcn_wave_barrier(); asm volatile("s_waitcnt lgkmcnt(0)" ::: "memory");
  }
}

constexpr int NEB = 2, NSL = 512 / (16 * NEB);
__device__ __forceinline__ void ml_m2(const Params& p, const Ctx& cx) {
  const int tid = cx.tid, lane = tid & 63, wave = tid >> 6, fr = lane & 15, fq = lane >> 4;
  char* ws = cx.ws;
  const bf16_t* QK = (const bf16_t*)(ws + O_QK); const bf16_t* KT = (const bf16_t*)(ws + O_KT); const bf16_t* VT = (const bf16_t*)(ws + O_VT);
  const bf16_t* SP = (const bf16_t*)(ws + O_SP); const bf16_t* QF = (const bf16_t*)(ws + O_QF);
  bf16_t* HD = (bf16_t*)(ws + O_HD);
  const float* WIN = (const float*)(ws + O_WIN); const float* FLO = (const float*)(ws + O_FLO); const float* DEN = (const float*)(ws + O_DEN); const float* WSS = (const float*)(ws + O_WSS);
  const float* DEC = (const float*)(ws + O_GC) + 2 * NSEQ * NCH;
  f32x4* red = (f32x4*)lds_raw;
  f32x4* rn = (f32x4*)(lds_raw + 131072);
  for (int idx = cx.bid >> 3; idx < 2 * NSL; idx += cx.nb >> 3) {
    const int seq = (cx.bid & 7) * 2 + idx / NSL, es = idx % NSL, x = (seq >> 2) & 1, h = seq & 3, bl = seq >> 3;
    const int d0 = wave * 64, e0 = es * 16 * NEB;
    f32x4 C[4][NEB + 1];
#pragma unroll
    for (int a = 0; a < 4; ++a)
#pragma unroll
      for (int b = 0; b < NEB + 1; ++b) C[a][b] = (f32x4){0.f, 0.f, 0.f, 0.f};
    const int tbo = wave >> 1, ebo = __builtin_amdgcn_readfirstlane(wave & 1);
    bf16x8 qc[4][2], kf[4][2], sf0, sf1;
    u32x4 vr[NEB][2];
    f32x4 wv[2][2];
#define M2_LOAD_Q(ST) do { const int _nq = ml_nchunk(x, (ST)); _Pragma("unroll") for (int tb = 0; tb < 4; ++tb) { \
        const bf16_t* qp = QF + ((((((size_t)bl * NCH + _nq) * 4 + h) * 8 + wave) * 4 + tb) * 2) * 512 + fr * 32 + 8 * fq; \
        qc[tb][0] = *(const bf16x8*)qp; qc[tb][1] = *(const bf16x8*)(qp + 512); } } while (0)
#define M2_LOAD_KV(ST) do { const int _nc = ml_nchunk(x, (ST)), _t0 = _nc * 64; \
        _Pragma("unroll") for (int db = 0; db < 4; ++db) { const bf16_t* kp = KT + (((size_t)bl * NCH + _nc) * (EI / 16) + ((h * DH + d0) >> 4) + db) * 1024 + fr * 32 + 8 * fq; \
          kf[db][0] = *(const bf16x8*)kp; kf[db][1] = *(const bf16x8*)(kp + 512); } \
        _Pragma("unroll") for (int eb = 0; eb < NEB; ++eb) { const bf16_t* vp = VT + (((size_t)bl * NCH + _nc) * (EI / 16) + ((h * DH + e0) >> 4) + eb) * 1024 + fr * 32 + 8 * fq; \
          vr[eb][0] = *(const u32x4*)vp; vr[eb][1] = *(const u32x4*)(vp + 512); } \
        _Pragma("unroll") for (int ks = 0; ks < 2; ++ks) { const float* wp = WSS + (size_t)seq * TOKB + _t0 + 32 * ks + 8 * fq; \
          wv[ks][0] = *(const f32x4*)wp; wv[ks][1] = *(const f32x4*)(wp + 4); } \
        const bf16_t* sp = SP + (size_t)(seq * NCH + _nc) * 4096 + tbo * 1024 + fr * 32 + 8 * fq; \
        sf0 = *(const bf16x8*)sp; sf1 = *(const bf16x8*)(sp + 512); } while (0)
    const int hd_lane = (tbo * 16 + 4 * fq) * EI + h * DH + e0 + ebo * 16 + fr;
    M2_LOAD_Q(0); M2_LOAD_KV(0);
    for (int st = 0; st < NCH; ++st) {
      const int nc = ml_nchunk(x, st), tok0 = nc * 64, stn = st + 1 < NCH ? st + 1 : st;
      const size_t tix = (size_t)seq * TOKB + tok0 + tbo * 16 + 4 * fq;
      const f32x4 win = *(const f32x4*)(WIN + tix), flo = *(const f32x4*)(FLO + tix), deni = *(const f32x4*)(DEN + tix);
      const float decay = DEC[seq * NCH + nc];
#pragma unroll
      for (int eb = 0; eb < NEB + 1; ++eb) {
        bf16x8 cb0, cb1;
        { const f32x4 lo = C[0][eb], hi = C[1][eb]; cb0 = mk8((u32x4){pk2(lo[0], lo[1]), pk2(lo[2], lo[3]), pk2(hi[0], hi[1]), pk2(hi[2], hi[3])}); }
        { const f32x4 lo = C[2][eb], hi = C[3][eb]; cb1 = mk8((u32x4){pk2(lo[0], lo[1]), pk2(lo[2], lo[3]), pk2(hi[0], hi[1]), pk2(hi[2], hi[3])}); }
        f32x4 pa[4];
#pragma unroll
        for (int tb = 0; tb < 4; ++tb) pa[tb] = MFMA16(qc[tb][0], cb0, ((f32x4){0.f, 0.f, 0.f, 0.f}));
#pragma unroll
        for (int tb = 0; tb < 4; ++tb) pa[tb] = MFMA16(qc[tb][1], cb1, pa[tb]);
#pragma unroll
        for (int tb = 0; tb < 4; ++tb) {
          if (eb < NEB) red[((wave * 4 + tb) * NEB + eb) * 64 + lane] = pa[tb];
          else if (fr == 0) rn[(wave * 4 + tb) * 4 + fq] = pa[tb];
        }
      }
      M2_LOAD_Q(stn);
      f32x4 oi = {0.f, 0.f, 0.f, 0.f};
#pragma unroll
      for (int eb = 0; eb < NEB + 1; ++eb) {
        bf16x8 vw0, vw1;
        if (eb < NEB) {
          const u32x4 r0 = vr[eb][0], r1 = vr[eb][1];
          if (eb == ebo) { oi = MFMA16(sf0, mk8(r0), oi); oi = MFMA16(sf1, mk8(r1), oi); }
          vw0 = mk8((u32x4){pkmul2(r0.x, wv[0][0][0], wv[0][0][1]), pkmul2(r0.y, wv[0][0][2], wv[0][0][3]), pkmul2(r0.z, wv[0][1][0], wv[0][1][1]), pkmul2(r0.w, wv[0][1][2], wv[0][1][3])});
          vw1 = mk8((u32x4){pkmul2(r1.x, wv[1][0][0], wv[1][0][1]), pkmul2(r1.y, wv[1][0][2], wv[1][0][3]), pkmul2(r1.z, wv[1][1][0], wv[1][1][1]), pkmul2(r1.w, wv[1][1][2], wv[1][1][3])});
        } else {
          vw0 = mk8((u32x4){pk2(wv[0][0][0], wv[0][0][1]), pk2(wv[0][0][2], wv[0][0][3]), pk2(wv[0][1][0], wv[0][1][1]), pk2(wv[0][1][2], wv[0][1][3])});
          vw1 = mk8((u32x4){pk2(wv[1][0][0], wv[1][0][1]), pk2(wv[1][0][2], wv[1][0][3]), pk2(wv[1][1][0], wv[1][1][1]), pk2(wv[1][1][2], wv[1][1][3])});
        }
#pragma unroll
        for (int db = 0; db < 4; ++db) {
          f32x4 c = C[db][eb] * decay;
          c = MFMA16(kf[db][0], vw0, c); c = MFMA16(kf[db][1], vw1, c);
          C[db][eb] = c;
        }
      }
      asm volatile("s_waitcnt lgkmcnt(0)" ::: "memory");
      __builtin_amdgcn_s_barrier();
      asm volatile("" ::: "memory");
      bf16_t* hdp = HD + ((size_t)x * RG + ml_lrow(bl, tok0)) * EI + hd_lane;
      f32x4 rdn[8], rd0[8];
#pragma unroll
      for (int w = 0; w < 8; ++w) { rdn[w] = rn[(w * 4 + tbo) * 4 + fq]; rd0[w] = red[((w * 4 + tbo) * NEB + ebo) * 64 + lane]; }
      const f32x4 pn = add4(add4(add4(rdn[0], rdn[1]), add4(rdn[2], rdn[3])), add4(add4(rdn[4], rdn[5]), add4(rdn[6], rdn[7])));
      const f32x4 pi = add4(add4(add4(rd0[0], rd0[1]), add4(rd0[2], rd0[3])), add4(add4(rd0[4], rd0[5]), add4(rd0[6], rd0[7])));
#pragma unroll
      for (int jj = 0; jj < 4; ++jj) {
        const float num = oi[jj] + win[jj] * pi[jj], den = deni[jj] + win[jj] * pn[jj];
        const float hv = num * __builtin_amdgcn_rcpf(fmaxf(fabsf(den), flo[jj]));
        hdp[(size_t)jj * EI] = (bf16_t)(pk2(hv, 0.f) & 0xffff);
      }
      M2_LOAD_KV(stn);
      asm volatile("s_waitcnt lgkmcnt(0)" ::: "memory");
      __builtin_amdgcn_s_barrier();
      asm volatile("" ::: "memory");
    }
    __syncthreads();
#undef M2_LOAD_Q
#undef M2_LOAD_KV
  }
}

__device__ __forceinline__ void ml_fin(const Params& p, const Ctx& cx, int j) {
  const int lane = cx.tid & 63, gw = cx.bid * 8 + (cx.tid >> 6), NGW = cx.nb * 8;
  char* ws = cx.ws;
  const bf16_t* XZ = (const bf16_t*)(ws + O_XZ); const bf16_t* HD = (const bf16_t*)(ws + O_HD);
  bf16_t* FIN = (bf16_t*)(ws + O_FIN);
  for (int u = gw; u < RG * 4; u += NGW) {
    const int lr = u >> 2, h = u & 3, f0 = h * DH + lane * 8;
    int pos, seglen;
    if (lr < GB * SEQ) { pos = lr & (SEQ - 1); seglen = SEQ; } else { pos = (lr - GB * SEQ) & (LC - 1); seglen = LC; }
    const u32x4 hf = *(const u32x4*)(HD + (size_t)lr * EI + f0), hb = *(const u32x4*)(HD + ((size_t)RG + lr) * EI + f0);
    const u32x4 zz = *(const u32x4*)(XZ + (size_t)lr * 4096 + 2048 + f0);
    const u32x4 x1 = *(const u32x4*)(XZ + (size_t)lr * 4096 + f0);
    u32x4 x0 = {0u, 0u, 0u, 0u}, x2 = {0u, 0u, 0u, 0u};
    if (pos > 0) x0 = *(const u32x4*)(XZ + (size_t)(lr - 1) * 4096 + f0);
    if (pos < seglen - 1) x2 = *(const u32x4*)(XZ + (size_t)(lr + 1) * 4096 + f0);
    float hv[8], xm0[8], xm1[8], xm2[8];
    const unsigned hfu[4] = {hf.x, hf.y, hf.z, hf.w}, hbu[4] = {hb.x, hb.y, hb.z, hb.w}, zu[4] = {zz.x, zz.y, zz.z, zz.w};
    const unsigned x0u[4] = {x0.x, x0.y, x0.z, x0.w}, x1u[4] = {x1.x, x1.y, x1.z, x1.w}, x2u[4] = {x2.x, x2.y, x2.z, x2.w};
    float s = 0.f;
#pragma unroll
    for (int i = 0; i < 4; ++i) {
      hv[2 * i] = (bflo(hfu[i]) + bflo(hbu[i])) * sigm_f(bflo(zu[i]));
      hv[2 * i + 1] = (bfhi(hfu[i]) + bfhi(hbu[i])) * sigm_f(bfhi(zu[i]));
      xm0[2 * i] = bflo(x0u[i]); xm0[2 * i + 1] = bfhi(x0u[i]); xm1[2 * i] = bflo(x1u[i]); xm1[2 * i + 1] = bfhi(x1u[i]); xm2[2 * i] = bflo(x2u[i]); xm2[2 * i + 1] = bfhi(x2u[i]);
      s += hv[2 * i] + hv[2 * i + 1];
    }
    const float mean = wave_sum(s, lane) * (1.f / DH); float s2 = 0.f;
#pragma unroll
    for (int i = 0; i < 8; ++i) { hv[i] -= mean; s2 += hv[i] * hv[i]; }
    const float rstd = __builtin_amdgcn_rsqf(wave_sum(s2, lane) * (1.f / DH) + LN_EPS);
    float o[8];
#pragma unroll
    for (int i = 0; i < 8; ++i) {
      const int f = f0 + i;
      const float xc = silu_f(IN(11)[(size_t)(j * 3 + 0) * EI + f] * xm0[i] + IN(11)[(size_t)(j * 3 + 1) * EI + f] * xm1[i] + IN(11)[(size_t)(j * 3 + 2) * EI + f] * xm2[i] + IN(12)[(size_t)j * EI + f]);
      o[i] = hv[i] * rstd * IN(17)[(size_t)j * EI + f] + IN(16)[(size_t)j * EI + f] * xc;
    }
    u32x4 ov; ov.x = pk2(o[0], o[1]); ov.y = pk2(o[2], o[3]); ov.z = pk2(o[4], o[5]); ov.w = pk2(o[6], o[7]);
    *(u32x4*)(FIN + nat(lr, f0, EI)) = ov;
  }
}

__device__ __forceinline__ void at_prep(const Params& p, const Ctx& cx) {
  const int lane = cx.tid & 63, gw = cx.bid * 8 + (cx.tid >> 6), NGW = cx.nb * 8;
  char* ws = cx.ws;
  bf16_t* ACT = (bf16_t*)(ws + O_ACT); bf16_t* KR = (bf16_t*)(ws + O_AKR); bf16_t* VT = (bf16_t*)(ws + O_AVT);
  const float* rc = (const float*)(ws + O_ROPE); const float* rs = rc + 4096 * 32;
  for (int row = gw; row < MROWS; row += NGW) {
    const bool lat = row < NLAT;
    const int b = lat ? row >> 12 : (row - NLAT) >> 8, pos = lat ? row & 4095 : (row - NLAT) & 255, tok = lat ? LC + pos : pos;
    bf16_t* rp = ACT + (size_t)row * 1536;
    {
      const u32x4 a = *(const u32x4*)(rp + 16 * lane), b2 = *(const u32x4*)(rp + 16 * lane + 8);
      const unsigned w[8] = {a.x, a.y, a.z, a.w, b2.x, b2.y, b2.z, b2.w};
      unsigned o[8];
      const int pp0 = (lane & 3) * 8;
#pragma unroll
      for (int i = 0; i < 8; ++i) {
        float x1 = bflo(w[i]) * 0.125f, x2 = bfhi(w[i]) * 0.125f;
        if (lat) { const float c = rc[pos * 32 + pp0 + i], s = rs[pos * 32 + pp0 + i]; const float y1 = x1 * c - x2 * s, y2 = x1 * s + x2 * c; x1 = y1; x2 = y2; }
        o[i] = pk2(x1, x2);
      }
      *(u32x4*)(rp + 16 * lane) = (u32x4){o[0], o[1], o[2], o[3]}; *(u32x4*)(rp + 16 * lane + 8) = (u32x4){o[4], o[5], o[6], o[7]};
    }
    {
      const u32x2 a = *(const u32x2*)(rp + 1024 + 4 * lane);
      const unsigned w[2] = {a.x, a.y}; unsigned o[2];
      const int g = lane >> 4, dd = (lane & 15) * 4, pp0 = dd >> 1;
#pragma unroll
      for (int i = 0; i < 2; ++i) {
        float x1 = bflo(w[i]), x2 = bfhi(w[i]);
        if (lat) { const float c = rc[pos * 32 + pp0 + i], s = rs[pos * 32 + pp0 + i]; const float y1 = x1 * c - x2 * s, y2 = x1 * s + x2 * c; x1 = y1; x2 = y2; }
        o[i] = pk2(x1, x2);
      }
      *(u32x2*)(KR + (((size_t)b * 4 + g) * TOKB + tok) * 64 + dd) = (u32x2){o[0], o[1]};
      const u32x2 v = *(const u32x2*)(rp + 1280 + 4 * lane);
      bf16_t* vp = VT + (((size_t)b * 4 + g) * 64 + dd) * TOKB + tok;
      vp[0] = (bf16_t)(v.x & 0xffff); vp[TOKB] = (bf16_t)(v.x >> 16); vp[2 * TOKB] = (bf16_t)(v.y & 0xffff); vp[3 * TOKB] = (bf16_t)(v.y >> 16);
    }
  }
}

__device__ __forceinline__ void at_core(const Params& p, const Ctx& cx) {
  const int lane = cx.tid & 63, gw = cx.bid * 8 + (cx.tid >> 6), NGW = cx.nb * 8, fr = lane & 15, fq = lane >> 4;
  char* ws = cx.ws;
  const bf16_t* ACT = (const bf16_t*)(ws + O_ACT); const bf16_t* KR = (const bf16_t*)(ws + O_AKR); const bf16_t* VT = (const bf16_t*)(ws + O_AVT);
  bf16_t* O = (bf16_t*)(ws + O_U);
  for (int u = gw; u < (MROWS / 16) * 4; u += NGW) {
    const int g = u & 3, qb = u >> 2, row0 = qb * 16;
    const bool lat = row0 < NLAT;
    const int b = lat ? row0 >> 12 : (row0 - NLAT) >> 8, q0 = lat ? row0 & 4095 : 0;
    bf16x8 qf[4][2];
    float mrun[4], lrun[4], sink[4];
    f32x4 oacc[4][4];
#pragma unroll
    for (int hh = 0; hh < 4; ++hh) {
      const bf16_t* qp = ACT + (size_t)(row0 + fr) * 1536 + (g * 4 + hh) * 64 + 8 * fq;
      qf[hh][0] = *(const bf16x8*)qp; qf[hh][1] = *(const bf16x8*)(qp + 32);
      sink[hh] = IN(20)[g * 4 + hh]; mrun[hh] = sink[hh]; lrun[hh] = 0.f;
#pragma unroll
      for (int d2 = 0; d2 < 4; ++d2) oacc[hh][d2] = (f32x4){0.f, 0.f, 0.f, 0.f};
    }
    const bf16_t* kbase = KR + ((size_t)b * 4 + g) * TOKB * 64;
    const bf16_t* vbase = VT + ((size_t)b * 4 + g) * 64 * TOKB;
    int wlo = 0, whi = -1;
    if (lat) { wlo = max(0, q0 - 128) & ~31; whi = min(SEQ - 1, q0 + 143); }
    const int nwin = lat ? (whi - wlo) / 32 + 1 : 0;
    for (int ti = 0; ti < 8 + nwin; ++ti) {
      const bool isw = ti >= 8;
      const int kpos0 = isw ? wlo + (ti - 8) * 32 : 0;
      const int tk0 = isw ? LC + kpos0 : ti * 32;
      const bf16_t* kp = kbase + (size_t)(tk0 + fr) * 64 + 8 * fq;
      const bf16x8 k00 = *(const bf16x8*)kp, k01 = *(const bf16x8*)(kp + 32), k10 = *(const bf16x8*)(kp + 16 * 64), k11 = *(const bf16x8*)(kp + 16 * 64 + 32);
      bf16x8 vfr[4];
#pragma unroll
      for (int d2 = 0; d2 < 4; ++d2) {
        const bf16_t* vp = vbase + (size_t)(d2 * 16 + fr) * TOKB + tk0 + 4 * fq;
        vfr[d2] = mk8(*(const u32x2*)vp, *(const u32x2*)(vp + 16));
      }
      bool okm[8];
#pragma unroll
      for (int i = 0; i < 8; ++i) {
        const int kpos = kpos0 + (i >> 2) * 16 + 4 * fq + (i & 3), dlt = (q0 + fr) - kpos;
        okm[i] = !isw || (dlt <= 128 && dlt >= -128);
      }
#pragma unroll
      for (int hh = 0; hh < 4; ++hh) {
        f32x4 s0 = {0.f, 0.f, 0.f, 0.f}, s1 = {0.f, 0.f, 0.f, 0.f};
        s0 = MFMA16(k00, qf[hh][0], s0); s0 = MFMA16(k01, qf[hh][1], s0);
        s1 = MFMA16(k10, qf[hh][0], s1); s1 = MFMA16(k11, qf[hh][1], s1);
        float sv[8]; float tmax = -3.0e38f;
#pragma unroll
        for (int i = 0; i < 8; ++i) { sv[i] = okm[i] ? (i < 4 ? s0[i] : s1[i - 4]) : -3.0e38f; tmax = fmaxf(tmax, sv[i]); }
        tmax = fmaxf(tmax, shx(tmax, 16, lane)); tmax = fmaxf(tmax, shx(tmax, 32, lane));
        const float mnew = fmaxf(mrun[hh], tmax), scale = __expf(mrun[hh] - mnew);
        mrun[hh] = mnew;
        float pv[8];
#pragma unroll
        for (int i = 0; i < 8; ++i) pv[i] = okm[i] ? __expf(sv[i] - mnew) : 0.f;
        const u32x4 pu = {pk2(pv[0], pv[1]), pk2(pv[2], pv[3]), pk2(pv[4], pv[5]), pk2(pv[6], pv[7])};
        const float ps = ((bflo(pu.x) + bfhi(pu.x)) + (bflo(pu.y) + bfhi(pu.y))) + ((bflo(pu.z) + bfhi(pu.z)) + (bflo(pu.w) + bfhi(pu.w)));
        lrun[hh] = lrun[hh] * scale + ps;
        const bf16x8 pf = mk8(pu);
        float scq[4];
#pragma unroll
        for (int jj = 0; jj < 4; ++jj) scq[jj] = shi(scale, 4 * fq + jj);
#pragma unroll
        for (int d2 = 0; d2 < 4; ++d2) {
          f32x4 o = oacc[hh][d2];
          o[0] *= scq[0]; o[1] *= scq[1]; o[2] *= scq[2]; o[3] *= scq[3];
          oacc[hh][d2] = MFMA16(pf, vfr[d2], o);
        }
      }
    }
#pragma unroll
    for (int hh = 0; hh < 4; ++hh) {
      float l = lrun[hh];
      l += shx(l, 16, lane); l += shx(l, 32, lane);
      l += __expf(sink[hh] - mrun[hh]);
      const float inv = __builtin_amdgcn_rcpf(l);
      float iq[4];
#pragma unroll
      for (int jj = 0; jj < 4; ++jj) iq[jj] = shi(inv, 4 * fq + jj);
#pragma unroll
      for (int d2 = 0; d2 < 4; ++d2)
#pragma unroll
        for (int jj = 0; jj < 4; ++jj)
          O[nat(row0 + 4 * fq + jj, (g * 4 + hh) * 64 + d2 * 16 + fr, D)] = (bf16_t)(pk2(oacc[hh][d2][jj] * iq[jj], 0.f) & 0xffff);
    }
  }
}

__device__ __forceinline__ void sc_conv(const Params& p, const Ctx& cx) {
  const int gt = cx.bid * 512 + cx.tid, gs = cx.nb * 512;
  const bf16_t* ACT = (const bf16_t*)(cx.ws + O_ACT); bf16_t* O = (bf16_t*)(cx.ws + O_U);
  const float* cw = IN(23);
  for (int i = gt; i < MROWS * 128; i += gs) {
    const int row = i >> 7, c0 = (i & 127) * 8;
    int pos, seglen;
    if (row < NLAT) { pos = row & (SEQ - 1); seglen = SEQ; } else { pos = (row - NLAT) & (LC - 1); seglen = LC; }
    float accv[8];
#pragma unroll
    for (int e = 0; e < 8; ++e) accv[e] = 0.f;
#pragma unroll
    for (int k = 0; k < 3; ++k) {
      const int pp = pos + k - 1;
      if (pp < 0 || pp >= seglen) continue;
      const bf16_t* rp = ACT + (size_t)(row + k - 1) * 3072;
      const u32x4 cgv = *(const u32x4*)(rp + 1024 + c0), xtv = *(const u32x4*)(rp + 2048 + c0);
      const unsigned cu[4] = {cgv.x, cgv.y, cgv.z, cgv.w}, xu[4] = {xtv.x, xtv.y, xtv.z, xtv.w};
#pragma unroll
      for (int e = 0; e < 4; ++e) {
        accv[2 * e] += cw[k * D + c0 + 2 * e] * (bflo(cu[e]) * bflo(xu[e]));
        accv[2 * e + 1] += cw[k * D + c0 + 2 * e + 1] * (bfhi(cu[e]) * bfhi(xu[e]));
      }
    }
    const u32x4 bgv = *(const u32x4*)(ACT + (size_t)row * 3072 + c0);
    const unsigned bu[4] = {bgv.x, bgv.y, bgv.z, bgv.w};
    u32x4 o;
    o.x = pk2(bflo(bu[0]) * accv[0], bfhi(bu[0]) * accv[1]); o.y = pk2(bflo(bu[1]) * accv[2], bfhi(bu[1]) * accv[3]);
    o.z = pk2(bflo(bu[2]) * accv[4], bfhi(bu[2]) * accv[5]); o.w = pk2(bflo(bu[3]) * accv[6], bfhi(bu[3]) * accv[7]);
    *(u32x4*)(O + nat(row, c0, D)) = o;
  }
}

#define XB_TMO      128
#define XB_XCNT(j)  (256  + 64 * (j))
#define XB_XSUB(j)  (1280 + 64 * (j))
#define XB_XGEN(j)  (2304 + 64 * (j))
#define XB_TOP      3328
#define XB_TOPGEN   3392
#define XCD_BAR_WORDS 3456
#define XB_SPIN_CAP (1u << 18)
__device__ __forceinline__ unsigned xb_ld(unsigned* p)              { return __hip_atomic_load(p, __ATOMIC_RELAXED, __HIP_MEMORY_SCOPE_AGENT); }
__device__ __forceinline__ unsigned xb_add(unsigned* p, unsigned v) { return __hip_atomic_fetch_add(p, v, __ATOMIC_RELAXED, __HIP_MEMORY_SCOPE_AGENT); }
__device__ __forceinline__ unsigned xb_xcc_id() { return (unsigned)__builtin_amdgcn_s_getreg((3 << 11) | 20) & 0xFu; }
#define XB_SPIN(cond, bar) do { unsigned _sp = 0; while (cond) { __builtin_amdgcn_s_sleep(1); \
    if ((++_sp & 255u) == 0u) { if (xb_ld(&(bar)[XB_TMO])) break; if (_sp > XB_SPIN_CAP) { atomicAdd(&(bar)[XB_TMO], 1u); break; } } } } while (0)
__device__ __forceinline__ void xcd_barrier_complete(unsigned* bar, unsigned x, unsigned& nloc, unsigned& nx) {
  const unsigned G = gridDim.x;
  unsigned sum, cnt, mine, sp = 0u;
  for (;;) {
    sum = 0u; cnt = 0u; mine = 0u;
#pragma unroll
    for (unsigned j = 0; j < 16; ++j) { const unsigned c = xb_ld(&bar[XB_XCNT(j)]); sum += c; cnt += (c > 0u) ? 1u : 0u; mine = (j == x) ? c : mine; }
    if (sum == G) break;
    __builtin_amdgcn_s_sleep(1);
    if ((++sp & 255u) == 0u) { if (xb_ld(&bar[XB_TMO])) break; if (sp > XB_SPIN_CAP) { atomicAdd(&bar[XB_TMO], 1u); break; } }
  }
  nloc = mine > 0u ? mine : 1u; nx = cnt > 0u ? cnt : 1u;
}
__device__ __forceinline__ void xcd_barrier(unsigned* bar, unsigned x, volatile LAS unsigned* st) {
  asm volatile("s_waitcnt vmcnt(0)" ::: "memory");
  __syncthreads();
  if (threadIdx.x == 0) {
    __builtin_amdgcn_s_waitcnt(0);
    unsigned nloc = st[0], nx = st[1];
    if (nloc == 0u) { xcd_barrier_complete(bar, x, nloc, nx); st[0] = nloc; st[1] = nx; }
    const unsigned old = xb_add(&bar[XB_XSUB(x)], 1u);
    const unsigned gen = old / nloc;
    if (old + 1u == (gen + 1u) * nloc) {
      __builtin_amdgcn_fence(__ATOMIC_RELEASE, "agent");
      asm volatile("s_waitcnt vmcnt(0)" ::: "memory");
      const unsigned og = xb_add(&bar[XB_TOP], 1u);
      const unsigned tg = og / nx;
      if (og + 1u == (tg + 1u) * nx) xb_add(&bar[XB_TOPGEN], 1u);
      else XB_SPIN(xb_ld(&bar[XB_TOPGEN]) == tg, bar);
      __builtin_amdgcn_fence(__ATOMIC_ACQUIRE, "agent");
      xb_add(&bar[XB_XGEN(x)], 1u);
      asm volatile("s_waitcnt vmcnt(0)" ::: "memory");
    } else {
      XB_SPIN(xb_ld(&bar[XB_XGEN(x)]) == gen, bar);
      __builtin_amdgcn_fence(__ATOMIC_ACQUIRE, "agent");
      asm volatile("s_waitcnt vmcnt(0)" ::: "memory");
    }
  }
  __syncthreads();
}

#ifndef ENMASK
#define ENMASK 0xffff
#endif
#define EN(i) ((ENMASK >> (i)) & 1)
enum { OP_PRO = 0, OP_LN0, OP_LN1, OP_LNF, OP_FFI, OP_FFO, OP_UP, OP_M0, OP_GAT, OP_S, OP_M2, OP_FIN, OP_DN, OP_AQ, OP_APREP, OP_ACORE, OP_AO, OP_SI, OP_SCONV, OP_SO, OP_DNUP };
__global__ void __launch_bounds__(512) fwd_megakernel(Params p) {
  cg::grid_group grid = cg::this_grid();
  const int wave_s = __builtin_amdgcn_readfirstlane((int)threadIdx.x >> 6);
  volatile LAS unsigned* xst = (volatile LAS unsigned*)((LAS unsigned char*)lds_raw + (LDS_BYTES - 16));
  if (threadIdx.x == 0) { xst[0] = 0u; xst[1] = 0u; }
  __syncthreads();
  unsigned* xbar = (unsigned*)(p.ws + O_BAR);
  const unsigned xcc = xb_xcc_id();
  if (threadIdx.x == 0) (void)xb_add(&xbar[XB_XCNT(xcc)], 1u);
#ifdef DUP_OP
  int rep = 0;
#endif
  for (int ph = 0; ph < p.nph; ++ph) {
    const unsigned w = p.prog[ph];
    const int op = w & 255, a = (w >> 8) & 255, b = (w >> 16) & 255, c = (w >> 24) & 255;
#define MKCTX int z; asm volatile("s_mov_b32 %0, 0" : "=s"(z)); \
    GAS char* wsq = (GAS char*)p.ws; GAS float* outq = (GAS float*)p.out; int bidq = (int)blockIdx.x, nbq = (int)gridDim.x; \
    asm volatile("" : "+s"(wsq), "+s"(outq), "+s"(bidq), "+s"(nbq)); \
    const Ctx cx{wave_s * 64 + (int)__builtin_amdgcn_mbcnt_hi(~0u, __builtin_amdgcn_mbcnt_lo(~0u, (unsigned)z)), bidq, nbq, z, (char*)wsq, (float*)outq};
    if (EN(0) && op == OP_PRO) { MKCTX prologue(p, cx); }
    else if (EN(1) && op == OP_LN0) { MKCTX lnmod_phase<0>(p, cx, 0, 0, 0); }
    else if (EN(1) && op == OP_LN1) { MKCTX lnmod_phase<1>(p, cx, a, b, c); }
    else if (EN(1) && op == OP_LNF) { MKCTX lnmod_phase<2>(p, cx, a, 0, 0); }
    else if (EN(2) && op == OP_M0) { MKCTX ml_m0(p, cx, a); }
    else if (EN(3) && op == OP_GAT) { MKCTX ml_gates(p, cx, a); }
    else if (EN(4) && op == OP_S) { MKCTX ml_s(p, cx); }
    else if (EN(5) && op == OP_M2) { MKCTX ml_m2(p, cx); }
    else if (EN(6) && op == OP_FIN) { MKCTX ml_fin(p, cx, a); }
    else if (EN(7) && op == OP_APREP) { MKCTX at_prep(p, cx); }
    else if (EN(8) && op == OP_ACORE) { MKCTX at_core(p, cx); }
    else if (EN(9) && op == OP_SCONV) { MKCTX sc_conv(p, cx); }
    else if (EN(10)) {
      MKCTX
      char* ws = cx.ws;
      const RowMap idm{0, 0, 1 << 30};
      bf16_t* U = (bf16_t*)(ws + O_U); bf16_t* ACT = (bf16_t*)(ws + O_ACT);
      const float* MODT = (const float*)(ws + O_MODT);
      const int nrep = op == OP_DNUP ? 2 : 1;
      for (int rep = 0; rep < nrep; ++rep) {
        const int op2 = op == OP_DNUP ? (rep == 0 ? (int)OP_UP : (int)OP_DN) : op;
        const int c2 = (op == OP_DNUP && rep == 0) ? c + 1 : c;
        Ctx cg_ = cx;
        if (op == OP_DNUP && rep == 1) cg_.bid = (cx.bid + cx.nb - 32) % cx.nb;
        const bf16_t* A = U; const bf16_t* Bt; int K = 1024, nM = MROWS / 256, nN; RowMap am = idm, cm = idm;
        Epi E; E.kind = 2; E.O = ACT; E.ldc = 0; E.modl = MODT + (size_t)b * 9 * 9216; E.slot = 1; E.wgt = 1.0f;
        E.ln = b * 3 + 1 - 1;
        if (op2 == OP_FFI) { Bt = (const bf16_t*)(ws + O_WFI) + (size_t)a * 5632 * 1024; nN = 22; E.kind = 1; if (c) nM = NLAT / 256; }
        else if (op2 == OP_FFO) { A = ACT; Bt = (const bf16_t*)(ws + O_WFO) + (size_t)a * 1024 * 2816; K = 2816; nN = 4; E.slot = c & 3; E.wgt = 0.5f; E.ln = b * 3 + (c & 3) - 1; if (c & 4) nM = NLAT / 256; }
        else if (op2 == OP_UP) { Bt = (const bf16_t*)(ws + O_WUP) + (size_t)a * 4096 * 1024; nM = RG / 256; nN = 16; am = RowMap{c2 * GB * SEQ, NLAT + c2 * GB * LC, GB * SEQ / 256}; E.kind = 0; E.O = (bf16_t*)(ws + O_XZ); E.ldc = 4096; }
        else if (op2 == OP_DN) { A = (const bf16_t*)(ws + O_FIN); Bt = (const bf16_t*)(ws + O_WDN) + (size_t)a * 1024 * 2048; K = 2048; nM = RG / 256; nN = 4; cm = RowMap{c2 * GB * SEQ, NLAT + c2 * GB * LC, GB * SEQ / 256}; }
        else if (op2 == OP_AQ) { Bt = (const bf16_t*)(ws + O_WAQ); nN = 6; E.kind = 0; E.ldc = 1536; }
        else if (op2 == OP_AO) { Bt = (const bf16_t*)(ws + O_WAO); nN = 4; }
        else if (op2 == OP_SI) { Bt = (const bf16_t*)(ws + O_WSI); nN = 12; E.kind = 0; E.ldc = 3072; }
        else { Bt = (const bf16_t*)(ws + O_WSO); nN = 4; }
        gemm_phase(cg_, A, am, Bt, K, nM, nN, cm, E);
      }
    }
    if (ph == 0) grid.sync(); else xcd_barrier(xbar, xcc, xst);
#ifdef DUP_OP
    if (op == DUP_OP && rep + 1 < DUP_N) { ++rep; --ph; } else rep = 0;
#endif
  }
}

static int build_program(unsigned* prog) {
  int n = 0;
  auto W = [&](int op, int a, int b, int c) { prog[n++] = (unsigned)op | ((unsigned)a << 8) | ((unsigned)b << 16) | ((unsigned)c << 24); };
  W(OP_PRO, 0, 0, 0);
  W(OP_LN0, 0, 0, 0);
  for (int layer = 0; layer < DEPTH; ++layer) {
    const int kind = layer % 3, j = layer / 3;
    W(OP_FFI, layer * 2, layer, 0); W(OP_FFO, layer * 2, layer, 0);
    W(OP_LN1, layer * 3 + 0, layer, 1);
    if (kind == 0) {
      for (int g = 0; g < NG; ++g) { if (g == 0) W(OP_UP, j, layer, g); W(OP_M0, j, 0, 0); W(OP_GAT, j, 0, 0); W(OP_S, 0, 0, 0); W(OP_M2, 0, 0, 0); W(OP_FIN, j, 0, 0); W(g + 1 < NG ? OP_DNUP : OP_DN, j, layer, g); }
    } else if (kind == 1) { W(OP_AQ, 0, layer, 0); W(OP_APREP, 0, 0, 0); W(OP_ACORE, 0, 0, 0); W(OP_AO, 0, layer, 0); }
    else { W(OP_SI, 0, layer, 0); W(OP_SCONV, 0, 0, 0); W(OP_SO, 0, layer, 0); }
    W(OP_LN1, layer * 3 + 1, layer, 2);
    const int lo = (layer + 1 == DEPTH) ? 1 : 0;
    W(OP_FFI, layer * 2 + 1, layer, lo); W(OP_FFO, layer * 2 + 1, layer, 2 | (lo << 2));
    if (layer + 1 < DEPTH) W(OP_LN1, layer * 3 + 2, layer + 1, 0); else W(OP_LNF, layer * 3 + 2, 0, 0);
  }
  return n;
}

extern "C" void kernel_launch(void* const* d_in, const int* in_sizes, int n_in, void* d_out, int out_size, void* d_ws, size_t ws_size, hipStream_t stream) {
  static int grid_blocks = 0;
  if (!grid_blocks) {
    int dev = 0, cus = 0, per_cu = 0;
    (void)hipGetDevice(&dev);
    (void)hipDeviceGetAttribute(&cus, hipDeviceAttributeMultiprocessorCount, dev);
    (void)hipFuncSetAttribute((const void*)fwd_megakernel, hipFuncAttributeMaxDynamicSharedMemorySize, LDS_BYTES);
    (void)hipOccupancyMaxActiveBlocksPerMultiprocessor(&per_cu, fwd_megakernel, 512, LDS_BYTES);
    if (cus <= 0) cus = 256;
    grid_blocks = cus;
    if (ws_size < WS_END || n_in != 25) fprintf(stderr, "kernel_launch: workspace %zu < %zu or n_in %d != 25\n", ws_size, (size_t)WS_END, n_in);
    if (per_cu < 1) fprintf(stderr, "kernel_launch: occupancy query says %d blocks per CU\n", per_cu);
  }
  Params p{};
  for (int i = 0; i < 25; ++i) p.in[i] = (const float*)d_in[i];
  p.out = (float*)d_out; p.ws = (char*)d_ws;
  p.nph = build_program(p.prog);
  (void)hipMemsetAsync((char*)d_ws + O_BAR, 0, XCD_BAR_WORDS * 4, stream);
  void* args[] = {&p};
  hipError_t e = hipLaunchCooperativeKernel((void*)fwd_megakernel, dim3(grid_blocks), dim3(512), args, LDS_BYTES, stream);
  if (e != hipSuccess) fprintf(stderr, "cooperative launch failed: %s (grid %d)\n", hipGetErrorString(e), grid_blocks);
}
```
